# Optimizing an MI355X kernel written in HIP

```python
import math
import jax, jax.numpy as jnp
from jax import lax
import numpy as np

D_MODEL = 1024
BATCH = 4
SEQ = 8192
DEPTH = 2

GLA_HEADS = 4
GLA_DK = 64
GLA_DV = 128
GLA_GATE_RANK = 16
GLA_GATE_TAU = 16.0
GLA_CHUNK = 64
ATT_HEADS = 8
ATT_HD = 64
DILATED_BRANCHES = ((128, 1), (512, 4), (2048, 16))
GLA_QK_W = GLA_HEADS * GLA_DK
GLA_V_W = GLA_HEADS * GLA_DV
ATT_W = ATT_HEADS * ATT_HD
AB_IN_W = 2 * GLA_QK_W + 2 * GLA_V_W + GLA_GATE_RANK + 3 * ATT_W
AB_OUT_W = GLA_V_W + ATT_W
D_RNN = 1024
RNN_BLOCKS = 8
RNN_BLOCK_W = D_RNN // RNN_BLOCKS
CONV_W = 4
LRU_C = 8.0
PEER_HEADS = 8
PEER_NKEYS = 128
PEER_EXPERTS = PEER_NKEYS * PEER_NKEYS
PEER_DQ = 256
PEER_TOPK = 16
PEER_BLOCK = 128
NORM_EPS = 1e-6
N_EVEN = (DEPTH + 1) // 2
N_ODD = DEPTH // 2

kernel_name = "hybrid_gla_dilated_rglru_peer"


def rms_norm(x, gain):
    xf = x.astype(jnp.float32)
    y = xf * lax.rsqrt(jnp.mean(xf * xf, axis=-1, keepdims=True) + NORM_EPS)
    return (y * gain.astype(jnp.float32)).astype(x.dtype)


def alibi_slopes(n):
    return 2.0 ** (-8.0 * jnp.arange(1, n + 1, dtype=jnp.float32) / n)


def gla_chunked(q, k, v, log_a):
    f32 = jnp.float32
    B, T, H, DK = q.shape
    DV = v.shape[-1]
    C = GLA_CHUNK
    N = T // C
    q = q.astype(f32).reshape(B, N, C, H, DK) * (DK ** -0.5)
    k = k.astype(f32).reshape(B, N, C, H, DK)
    v = v.astype(f32).reshape(B, N, C, H, DV)
    b = jnp.cumsum(log_a.astype(f32).reshape(B, N, C, H, DK), axis=2)
    b_last = b[:, :, -1]
    q_dec = q * jnp.exp(b)
    k_inv = k * jnp.exp(-b)
    causal = jnp.tril(jnp.ones((C, C), dtype=bool))
    att = jnp.where(causal, jnp.einsum('bnihk,bnjhk->bnhij', q_dec, k_inv), 0.0)
    o_intra = jnp.einsum('bnhij,bnjhv->bnihv', att, v)
    k_to_end = k * jnp.exp(b_last[:, :, None] - b)
    chunk_kv = jnp.einsum('bnjhk,bnjhv->bnhkv', k_to_end, v)

    def step(state, inp):
        decay, kv = inp
        return decay[..., None] * state + kv, state

    s0 = jnp.zeros((B, H, DK, DV), f32)
    _, s_prev = lax.scan(step, s0, (jnp.moveaxis(jnp.exp(b_last), 1, 0), jnp.moveaxis(chunk_kv, 1, 0)))
    s_prev = jnp.moveaxis(s_prev, 0, 1)
    o_inter = jnp.einsum('bnihk,bnhkv->bnihv', q_dec, s_prev)
    return (o_intra + o_inter).reshape(B, T, H, DV)


def strided_window_attention(q, k, v, n_sub, dilation, slopes):
    f32 = jnp.float32
    B, T, H, hd = q.shape
    L = T // dilation

    def to_sub(x):
        return x.reshape(B, L, dilation, H, hd).transpose(0, 2, 1, 3, 4).reshape(B * dilation, L, H, hd)

    def from_sub(x):
        rest = x.shape[2:]
        return x.reshape(B, dilation, L, *rest).swapaxes(1, 2).reshape(B, T, *rest)

    blk = n_sub
    nb = -(-L // blk)
    lp = nb * blk
    nn = B * dilation
    pad = ((0, 0), (0, lp - L), (0, 0), (0, 0))
    qs = jnp.pad(to_sub(q), pad)
    ks = jnp.pad(to_sub(k), pad)
    vs = jnp.pad(to_sub(v), pad)
    qb = qs.reshape(nn, nb, blk, H, hd)

    def with_prev(x):
        xp = jnp.pad(x, ((0, 0), (blk, 0), (0, 0), (0, 0)))
        prev = xp[:, :lp].reshape(nn, nb, blk, H, hd)
        cur = x.reshape(nn, nb, blk, H, hd)
        return jnp.concatenate([prev, cur], axis=2)

    kb, vb = with_prev(ks), with_prev(vs)
    s = jnp.einsum('nbqhd,nbkhd->nbhqk', qb, kb).astype(f32) * (hd ** -0.5)
    qi = jnp.arange(blk)[:, None]
    kj = jnp.arange(2 * blk)[None, :]
    delta = qi + blk - kj
    in_band = (delta >= 0) & (delta <= n_sub)
    not_front = (jnp.arange(nb)[:, None, None] > 0) | (kj >= blk)[None]
    valid = in_band[None] & not_front
    bias = -slopes[:, None, None] * (delta * dilation).astype(f32)
    s = jnp.where(valid[None, :, None], s + bias[None, None], -1e30)
    lse = jax.nn.logsumexp(s, axis=-1)
    p = jnp.exp(s - lse[..., None])
    o = jnp.einsum('nbhqk,nbkhd->nbqhd', p, vb.astype(f32)).reshape(nn, lp, H, hd)[:, :L]
    lse = jnp.moveaxis(lse, 2, 3).reshape(nn, lp, H)[:, :L]
    return from_sub(o), from_sub(lse)


def dilated_mixture_attention(q, k, v):
    slopes = alibi_slopes(ATT_HEADS)
    outs, lses = [], []
    for window, dil in DILATED_BRANCHES:
        o, l = strided_window_attention(q, k, v, window // dil, dil, slopes)
        outs.append(o)
        lses.append(l)
    w = jax.nn.softmax(jnp.stack(lses, axis=0), axis=0)
    return jnp.sum(w[..., None] * jnp.stack(outs, axis=0), axis=0)


def gla_dilated_mixer(h, w_in, w_alpha, b_alpha, head_gain, w_out):
    B, T, _ = h.shape
    f32 = jnp.float32
    proj = h @ w_in
    sizes = [GLA_QK_W, GLA_QK_W, GLA_V_W, GLA_V_W, GLA_GATE_RANK, ATT_W, ATT_W, ATT_W]
    splits = np.cumsum(sizes)[:-1].tolist()
    gq, gk, gv, gg, glr, aq, ak, av = jnp.split(proj, splits, axis=-1)
    log_a = jax.nn.log_sigmoid((glr @ w_alpha + b_alpha).astype(f32)) / GLA_GATE_TAU
    o_gla = gla_chunked(gq.reshape(B, T, GLA_HEADS, GLA_DK), gk.reshape(B, T, GLA_HEADS, GLA_DK),
                        gv.reshape(B, T, GLA_HEADS, GLA_DV), log_a.reshape(B, T, GLA_HEADS, GLA_DK))
    o_gla = o_gla * lax.rsqrt(jnp.mean(o_gla * o_gla, axis=-1, keepdims=True) + NORM_EPS)
    o_gla = o_gla.reshape(B, T, GLA_V_W) * head_gain.astype(f32) * jax.nn.silu(gg.astype(f32))
    o_att = dilated_mixture_attention(aq.reshape(B, T, ATT_HEADS, ATT_HD), ak.reshape(B, T, ATT_HEADS, ATT_HD),
                                      av.reshape(B, T, ATT_HEADS, ATT_HD)).reshape(B, T, ATT_W)
    mixed = jnp.concatenate([o_gla, o_att], axis=-1).astype(h.dtype)
    return mixed @ w_out


def rglru_mixer(h, w_in, conv_w, conv_b, w_rgate, b_rgate, w_igate, b_igate, lam, w_out):
    B, T, _ = h.shape
    f32 = jnp.float32
    proj = h @ w_in
    gate, xr = jnp.split(proj, 2, axis=-1)
    xc = lax.conv_general_dilated(xr, conv_w[:, None, :], window_strides=(1,), padding=[(CONV_W - 1, 0)],
                                  dimension_numbers=('NWC', 'WIO', 'NWC'), feature_group_count=D_RNN) + conv_b
    xb = xc.reshape(B, T, RNN_BLOCKS, RNN_BLOCK_W)
    r = jax.nn.sigmoid(jnp.einsum('btgi,gij->btgj', xb, w_rgate).reshape(B, T, D_RNN) + b_rgate)
    i = jax.nn.sigmoid(jnp.einsum('btgi,gij->btgj', xb, w_igate).reshape(B, T, D_RNN) + b_igate)
    log_a = -LRU_C * r.astype(f32) * jax.nn.softplus(-lam.astype(f32))
    a = jnp.exp(log_a)
    u = jnp.sqrt(-jnp.expm1(2.0 * log_a)) * (i * xc).astype(f32)

    def combine(left, right):
        a1, b1 = left
        a2, b2 = right
        return a1 * a2, a2 * b1 + b2

    _, hs = lax.associative_scan(combine, (a, u), axis=1)
    y = (jax.nn.gelu(gate.astype(f32)) * hs).astype(h.dtype)
    return y @ w_out


def peer_ffn(h, w_query, sub_keys, u_tab, v_tab):
    B, T, D = h.shape
    f32 = jnp.float32
    M = B * T
    K = PEER_TOPK
    H = PEER_HEADS
    hf = h.reshape(M, D)
    q = (hf @ w_query).reshape(M, H, 2, PEER_DQ // 2).astype(f32)
    s = jnp.einsum('mhpc,hpnc->mhpn', q, sub_keys.astype(f32))
    top_s, top_i = lax.top_k(s, K)
    cand_s = top_s[:, :, 0, :, None] + top_s[:, :, 1, None, :]
    cand_i = top_i[:, :, 0, :, None] * PEER_NKEYS + top_i[:, :, 1, None, :]
    best_s, best_c = lax.top_k(cand_s.reshape(M, H, K * K), K)
    ids = jnp.take_along_axis(cand_i.reshape(M, H, K * K), best_c, axis=-1)
    g = jax.nn.softmax(best_s, axis=-1)
    nblk = M // PEER_BLOCK
    ids = ids.reshape(nblk, PEER_BLOCK, H * K)
    g = g.reshape(nblk, PEER_BLOCK, H * K)
    hb = hf.reshape(nblk, PEER_BLOCK, D)

    def block(args):
        xb, idb, gb = args
        u = jnp.take(u_tab, idb, axis=0)
        v = jnp.take(v_tab, idb, axis=0)
        act = jax.nn.gelu(jnp.einsum('nkd,nd->nk', u, xb).astype(f32)) * gb
        return jnp.einsum('nk,nkd->nd', act.astype(v.dtype), v)

    out = lax.map(block, (hb, ids, g))
    return out.reshape(B, T, D).astype(h.dtype)


def setup_inputs(seed: int = 0) -> dict:
    key = jax.random.key(seed)
    ks = jax.random.split(key, 24)
    nrm = jax.random.normal
    D = D_MODEL
    lru_u = jax.random.uniform(ks[14], (N_ODD, D_RNN), minval=0.9, maxval=0.999)
    lru_a = lru_u ** (1.0 / LRU_C)
    return {
        "x": nrm(ks[0], (BATCH, SEQ, D), jnp.float32),
        "mix_norm": 1.0 + 0.02 * nrm(ks[1], (DEPTH, D)),
        "ffn_norm": 1.0 + 0.02 * nrm(ks[2], (DEPTH, D)),
        "ab_w_in": nrm(ks[3], (N_EVEN, D, AB_IN_W)) * D ** -0.5,
        "gla_w_alpha": nrm(ks[4], (N_EVEN, GLA_GATE_RANK, GLA_QK_W)) * GLA_GATE_RANK ** -0.5,
        "gla_b_alpha": 0.1 * nrm(ks[5], (N_EVEN, GLA_QK_W)),
        "gla_head_gain": 1.0 + 0.02 * nrm(ks[6], (N_EVEN, GLA_V_W)),
        "ab_w_out": nrm(ks[7], (N_EVEN, AB_OUT_W, D)) * AB_OUT_W ** -0.5,
        "c_w_in": nrm(ks[8], (N_ODD, D, 2 * D_RNN)) * D ** -0.5,
        "c_conv_w": nrm(ks[9], (N_ODD, CONV_W, D_RNN)) * CONV_W ** -0.5,
        "c_conv_b": 0.02 * nrm(ks[10], (N_ODD, D_RNN)),
        "c_w_rgate": nrm(ks[11], (N_ODD, RNN_BLOCKS, RNN_BLOCK_W, RNN_BLOCK_W)) * RNN_BLOCK_W ** -0.5,
        "c_b_rgate": 0.02 * nrm(ks[12], (N_ODD, D_RNN)),
        "c_w_igate": nrm(ks[13], (N_ODD, RNN_BLOCKS, RNN_BLOCK_W, RNN_BLOCK_W)) * RNN_BLOCK_W ** -0.5,
        "c_b_igate": 0.02 * nrm(ks[15], (N_ODD, D_RNN)),
        "c_lambda": jnp.log(lru_a) - jnp.log1p(-lru_a),
        "c_w_out": nrm(ks[16], (N_ODD, D_RNN, D)) * D_RNN ** -0.5,
        "peer_w_query": nrm(ks[17], (DEPTH, D, PEER_HEADS * PEER_DQ)) * D ** -0.5,
        "peer_sub_keys": nrm(ks[18], (DEPTH, PEER_HEADS, 2, PEER_NKEYS, PEER_DQ // 2)) * (PEER_DQ // 2) ** -0.5,
        "peer_u": nrm(ks[19], (DEPTH, PEER_EXPERTS, D)) * D ** -0.5,
        "peer_v": nrm(ks[20], (DEPTH, PEER_EXPERTS, D)) * (PEER_HEADS * PEER_TOPK) ** -0.5,
        "final_norm": 1.0 + 0.02 * nrm(ks[21], (D,)),
    }


def reference(x, mix_norm, ffn_norm, ab_w_in, gla_w_alpha, gla_b_alpha, gla_head_gain, ab_w_out,
              c_w_in, c_conv_w, c_conv_b, c_w_rgate, c_b_rgate, c_w_igate, c_b_igate, c_lambda, c_w_out,
              peer_w_query, peer_sub_keys, peer_u, peer_v, final_norm):
    h = x
    for layer in range(DEPTH):
        hn = rms_norm(h, mix_norm[layer])
        if layer % 2 == 0:
            e = layer // 2
            h = h + gla_dilated_mixer(hn, ab_w_in[e], gla_w_alpha[e], gla_b_alpha[e], gla_head_gain[e], ab_w_out[e])
        else:
            o = layer // 2
            h = h + rglru_mixer(hn, c_w_in[o], c_conv_w[o], c_conv_b[o], c_w_rgate[o], c_b_rgate[o],
                                c_w_igate[o], c_b_igate[o], c_lambda[o], c_w_out[o])
        hn = rms_norm(h, ffn_norm[layer])
        h = h + peer_ffn(hn, peer_w_query[layer], peer_sub_keys[layer], peer_u[layer], peer_v[layer])
    return rms_norm(h, final_norm)
```

```cpp
#include <hip/hip_runtime.h>
#include <hip/hip_bf16.h>
#include <cstdio>
#include <cstdint>
#include <cmath>
namespace pg8 {
#define PG8_LAS __attribute__((address_space(3)))
typedef unsigned short bf16_t;
typedef short bf16x8 __attribute__((ext_vector_type(8)));
typedef float f32x4 __attribute__((ext_vector_type(4)));
typedef unsigned u32x4 __attribute__((ext_vector_type(4)));
constexpr int BM = 256, BK = 64, HALF = 128, HTB = HALF * BK * 2  , STAGE_BYTES = 8 * HTB, NXCD = 8, WGM = 8;

__host__ __device__ __forceinline__ int lds_byte(int r, int c) { const int st = (r >> 4) * 2 + (c >> 5), rr = r & 15, cc = c & 31, ob = rr * 64 + cc * 2; return st * 1024 + (ob ^ (((ob >> 9) & 1) << 5)); }
__host__ __device__ __forceinline__ void stage_rc(int b, int& R, int& C) { const int st = b / 1024, sb = b % 1024, swz = sb ^ (((sb >> 9) & 1) << 5); R = (st >> 1) * 16 + swz / 64; C = (st & 1) * 32 + (swz % 64) / 2; }
__host__ __device__ __forceinline__ int perm32(int rho) { const int n = rho >> 4, i = rho & 15; return 8 * (i >> 2) + 4 * n + (i & 3); }

struct Unit { int pm, pn; };
struct Gemm { const bf16_t* A; const bf16_t* Bt; int M, N, K; };

struct StaticOrder {
    int nM, nN, nwg, G, c;
    __host__ __device__ void init(int M, int N, int G_, int c_) { nM = M / BM; nN = N / BM; nwg = nM * nN; G = G_; c = c_; }
    __host__ __device__ bool next(int i, Unit& u) const {
        const long L = (long)i * G + c; if (L >= nwg) return false;
        int wgid = (int)L; { const int q = nwg / NXCD, r = nwg % NXCD, xcd = wgid % NXCD, off = wgid / NXCD; wgid = (xcd < r ? xcd * (q + 1) : r * (q + 1) + (xcd - r) * q) + off; }
        const int nig = WGM * nN, gid = wgid / nig, fm = gid * WGM, gsz = (nM - fm) < WGM ? (nM - fm) : WGM;
        u.pm = fm + ((wgid % nig) % gsz); u.pn = (wgid % nig) / gsz; return true;
    }
    __device__ __forceinline__ void a_ready(const Unit&) const {}
    __device__ __forceinline__ void done(const Unit&) const {}
};

__device__ __forceinline__ unsigned cvt_pk_bf16(float lo, float hi) { unsigned r; asm volatile("v_cvt_pk_bf16_f32 %0, %1, %2" : "=v"(r) : "v"(lo), "v"(hi)); return r; }
typedef float f32x2 __attribute__((ext_vector_type(2)));
__device__ __forceinline__ f32x2 gelu_pk(f32x2 v) {
    const f32x2 av = __builtin_elementwise_abs(v), d = av * 0.2316418882f + 1.0f;
    f32x2 t; t.x = __builtin_amdgcn_rcpf(d.x); t.y = __builtin_amdgcn_rcpf(d.y);
    f32x2 q = t * 0.5307027145f + (-0.7265760135f); q = q * t + 0.7107068705f; q = q * t + (-0.142248368f); q = q * t + 0.127414796f; q = q * t;
    const f32x2 s = (v * v) * (-0.72134752044f);
    f32x2 e; e.x = __builtin_amdgcn_exp2f(s.x); e.y = __builtin_amdgcn_exp2f(s.y);
    const f32x2 m = v * (q * e), r = v - m;
    f32x2 o; o.x = v.x < 0.f ? m.x : r.x; o.y = v.y < 0.f ? m.y : r.y; return o;
}
template <int ACT  > struct EpiBf16 {
    static constexpr bool PERM = true, AFTER_DRAIN = false; static_assert(ACT == 0 || ACT == 1, "EpiBf16: ACT is 0 (none) or 1 (gelu_pk)");
    bf16_t* O; int ldc; const float* bias; int split_cols; size_t split_stride; float scale0;
    __device__ __forceinline__ void operator()(const f32x4 (&acc)[2][2][4][2], const Unit& u, int wr, int wc, int fr, int fq) const {
        const int row0 = u.pm * BM + wr * 64 + fr; int colt = u.pn * BM; bf16_t* base = O;
        float sc = 1.f; if (split_cols) { const int t = colt / split_cols; base += (size_t)t * split_stride; colt -= t * split_cols; if (t == 0) sc = scale0; }
        const int col0 = colt + wc * 32 + 8 * fq, bcol0 = u.pn * BM + wc * 32 + 8 * fq;
        f32x4 bv[2][2];
#pragma unroll
        for (int bj = 0; bj < 2; ++bj)
#pragma unroll
            for (int n = 0; n < 2; ++n) bv[bj][n] = bias ? *(const f32x4*)(bias + bcol0 + bj * HALF + 4 * n) : (f32x4){0.f, 0.f, 0.f, 0.f};
#pragma unroll
        for (int ai = 0; ai < 2; ++ai)
#pragma unroll
            for (int m = 0; m < 4; ++m) { bf16_t* rowp = base + (size_t)(row0 + ai * HALF + m * 16) * ldc + col0;
#pragma unroll
                for (int bj = 0; bj < 2; ++bj) { f32x4 v0 = acc[ai][bj][m][0] + bv[bj][0], v1 = acc[ai][bj][m][1] + bv[bj][1];
                    if (ACT == 1) { f32x2 a = gelu_pk((f32x2){v0[0], v0[1]}), b = gelu_pk((f32x2){v0[2], v0[3]}), c = gelu_pk((f32x2){v1[0], v1[1]}), d = gelu_pk((f32x2){v1[2], v1[3]});
                        v0 = (f32x4){a.x, a.y, b.x, b.y}; v1 = (f32x4){c.x, c.y, d.x, d.y}; }
                    v0 = v0 * sc; v1 = v1 * sc; u32x4 w; w.x = cvt_pk_bf16(v0[0], v0[1]); w.y = cvt_pk_bf16(v0[2], v0[3]); w.z = cvt_pk_bf16(v1[0], v1[1]); w.w = cvt_pk_bf16(v1[2], v1[3]);
                    *(u32x4*)(rowp + bj * HALF) = w; } }
    }
};
template <class Epi, class Sched, bool ALIGN_EPI = false, bool SP2 = false>
__device__ __forceinline__ void gemm_phase(PG8_LAS unsigned char* lds, const Gemm g, const Sched& S, const Epi& E) {
    const int tid = threadIdx.x, wid = __builtin_amdgcn_readfirstlane(tid >> 6), lane = tid & 63, wr = wid >> 2, wc = wid & 3, fr = lane & 15, fq = lane >> 4;
    const int K = g.K, nt = K / BK;
    unsigned voffA[2], voffB[2];
#pragma unroll
    for (int i = 0; i < 2; ++i) { int R, C; stage_rc(tid * 16 + i * 8192, R, C); const int Rb = Epi::PERM ? ((R & ~31) + perm32(R & 31)) : R;
        voffA[i] = (unsigned)(R * K + C) * 2u; voffB[i] = (unsigned)(Rb * K + C) * 2u; }
    const size_t kstep = (size_t)(BK * 2);
    const size_t hstep = (size_t)HALF * K * 2;
    const size_t tstep = 2 * hstep;
    const unsigned ldsw = (unsigned)wid * 1024u;
    const int aoff = lds_byte(wr * 64 + fr, fq * 8), boff = lds_byte(wc * 32 + fr, fq * 8);
#define PG8_SA(b, h) (((b) * 2 + (h)) * HTB)
#define PG8_SB(b, h) ((4 + (b) * 2 + (h)) * HTB)
#define PG8_STAGE(bufoff, gbase, voff) do { _Pragma("unroll") for (int _i = 0; _i < 2; ++_i) \
        __builtin_amdgcn_global_load_lds((const unsigned*)((const char*)(gbase) + (voff)[_i]), (PG8_LAS unsigned*)(lds + (bufoff) + ldsw + _i * 8192), 16, 0, 0); } while (0)
#define PG8_LDA(dst, b, h) do { _Pragma("unroll") for (int m = 0; m < 4; ++m) _Pragma("unroll") for (int k = 0; k < 2; ++k) dst[m][k] = *(const PG8_LAS bf16x8*)(lds + PG8_SA(b, h) + aoff + m * 2048 + k * 1024); } while (0)
#define PG8_LDB(dst, b, h) do { _Pragma("unroll") for (int n = 0; n < 2; ++n) _Pragma("unroll") for (int k = 0; k < 2; ++k) dst[n][k] = *(const PG8_LAS bf16x8*)(lds + PG8_SB(b, h) + boff + n * 2048 + k * 1024); } while (0)
#define PG8_MMA(ai, bj, At, Bt) do { __builtin_amdgcn_s_setprio(1); _Pragma("unroll") for (int m = 0; m < 4; ++m) _Pragma("unroll") for (int n = 0; n < 2; ++n) _Pragma("unroll") for (int k = 0; k < 2; ++k) \
        acc[ai][bj][m][n] = __builtin_amdgcn_mfma_f32_16x16x32_bf16(Bt[n][k], At[m][k], acc[ai][bj][m][n], 0, 0, 0); __builtin_amdgcn_s_setprio(0); } while (0)
#define PG8_WAIT_V(n) asm volatile("s_waitcnt vmcnt(" #n ")" ::: "memory")
#define PG8_WAIT_L(n) asm volatile("s_waitcnt lgkmcnt(" #n ")" ::: "memory")
#define PG8_BAR __builtin_amdgcn_s_barrier()
#define PG8_SCHED __builtin_amdgcn_sched_barrier(0)
    Unit cur, nxt; int ui = 0;
    if (!S.next(0, cur)) return;
    f32x4 acc[2][2][4][2];
#pragma unroll
    for (int a = 0; a < 2; ++a)
#pragma unroll
        for (int b = 0; b < 2; ++b)
#pragma unroll
            for (int m = 0; m < 4; ++m)
#pragma unroll
                for (int n = 0; n < 2; ++n) acc[a][b][m][n] = (f32x4){0.f, 0.f, 0.f, 0.f};
    bf16x8 At[4][2], B0[2][2], B1[2][2];
    const char* cA = (const char*)g.A + (size_t)cur.pm * tstep; const char* cB = (const char*)g.Bt + (size_t)cur.pn * tstep;
    S.a_ready(cur);
    if constexpr (SP2) {
        PG8_STAGE(PG8_SB(0, 0), cB, voffB); PG8_STAGE(PG8_SB(0, 1), cB + hstep, voffB); PG8_STAGE(PG8_SA(0, 0), cA, voffA); PG8_STAGE(PG8_SA(0, 1), cA + hstep, voffA);
        if (wr == 1) PG8_BAR;
        PG8_WAIT_V(2); PG8_BAR;
        PG8_STAGE(PG8_SB(1, 0), cB + kstep, voffB); PG8_STAGE(PG8_SA(1, 0), cA + kstep, voffA); PG8_STAGE(PG8_SB(1, 1), cB + hstep + kstep, voffB);
        PG8_WAIT_V(6); PG8_BAR;
    } else {
        PG8_STAGE(PG8_SB(0, 0), cB, voffB); PG8_STAGE(PG8_SA(0, 0), cA, voffA); PG8_STAGE(PG8_SB(0, 1), cB + hstep, voffB); PG8_STAGE(PG8_SA(0, 1), cA + hstep, voffA);
        if (wr == 1) PG8_BAR;
        PG8_WAIT_V(4); PG8_BAR;
        PG8_STAGE(PG8_SB(1, 0), cB + kstep, voffB); PG8_STAGE(PG8_SA(1, 0), cA + kstep, voffA); PG8_STAGE(PG8_SB(1, 1), cB + hstep + kstep, voffB);
        PG8_WAIT_V(6); PG8_BAR;
    }
    for (;;) {
        const bool has_next = S.next(ui + 1, nxt);
        const char* nA = has_next ? (const char*)g.A + (size_t)nxt.pm * tstep : cA; const char* nB = has_next ? (const char*)g.Bt + (size_t)nxt.pn * tstep : cB;
        for (int t = 0; t < nt; t += 2) {
            const bool last = (t == nt - 2);
            const char* a1 = cA + (size_t)(t + 1) * kstep;
            const char* a2 = last ? nA : cA + (size_t)(t + 2) * kstep; const char* b2 = last ? nB : cB + (size_t)(t + 2) * kstep;
            const char* a3 = a2 + kstep; const char* b3 = b2 + kstep;
            if (last && has_next) S.a_ready(nxt);
            if constexpr (SP2) {
            PG8_LDB(B0, 0, 0); PG8_LDB(B1, 0, 1); PG8_SCHED; PG8_LDA(At, 0, 0); PG8_STAGE(PG8_SA(1, 1), a1 + hstep, voffA);
            PG8_WAIT_V(8); PG8_WAIT_L(0); PG8_BAR; PG8_MMA(0, 0, At, B0); PG8_MMA(0, 1, At, B1); PG8_BAR; PG8_SCHED;
            PG8_LDA(At, 0, 1); PG8_STAGE(PG8_SB(0, 0), b2, voffB); PG8_STAGE(PG8_SB(0, 1), b2 + hstep, voffB); PG8_STAGE(PG8_SA(0, 0), a2, voffA);
            PG8_WAIT_V(8); PG8_WAIT_L(0); PG8_BAR; PG8_MMA(1, 0, At, B0); PG8_MMA(1, 1, At, B1); PG8_BAR; PG8_SCHED;
            PG8_LDB(B0, 1, 0); PG8_LDB(B1, 1, 1); PG8_SCHED; PG8_LDA(At, 1, 0); PG8_STAGE(PG8_SA(0, 1), a2 + hstep, voffA);
            PG8_WAIT_V(8); PG8_WAIT_L(0); PG8_BAR; PG8_MMA(0, 0, At, B0); PG8_MMA(0, 1, At, B1); PG8_BAR; PG8_SCHED;
            PG8_LDA(At, 1, 1); PG8_STAGE(PG8_SB(1, 0), b3, voffB); PG8_STAGE(PG8_SB(1, 1), b3 + hstep, voffB); PG8_STAGE(PG8_SA(1, 0), a3, voffA);
            PG8_WAIT_V(8); PG8_WAIT_L(0); PG8_BAR; PG8_MMA(1, 0, At, B0); PG8_MMA(1, 1, At, B1); PG8_BAR; PG8_SCHED;
            } else {
            PG8_LDB(B0, 0, 0); PG8_SCHED; PG8_LDA(At, 0, 0); PG8_STAGE(PG8_SA(1, 1), a1 + hstep, voffA);
            PG8_WAIT_L(8); PG8_BAR; PG8_WAIT_L(0); PG8_MMA(0, 0, At, B0); PG8_BAR; PG8_SCHED;
            PG8_LDB(B1, 0, 1); PG8_STAGE(PG8_SB(0, 0), b2, voffB);
            PG8_BAR; PG8_WAIT_L(0); PG8_MMA(0, 1, At, B1); PG8_BAR;
            PG8_LDA(At, 0, 1); PG8_STAGE(PG8_SA(0, 0), a2, voffA);
            PG8_BAR; PG8_WAIT_L(0); PG8_MMA(1, 0, At, B0); PG8_BAR; PG8_SCHED;
            PG8_STAGE(PG8_SB(0, 1), b2 + hstep, voffB);
            PG8_WAIT_V(6); PG8_BAR; PG8_MMA(1, 1, At, B1); PG8_BAR;
            PG8_LDB(B0, 1, 0); PG8_SCHED; PG8_LDA(At, 1, 0); PG8_STAGE(PG8_SA(0, 1), a2 + hstep, voffA);
            PG8_WAIT_L(8); PG8_BAR; PG8_WAIT_L(0); PG8_MMA(0, 0, At, B0); PG8_BAR; PG8_SCHED;
            PG8_LDB(B1, 1, 1); PG8_STAGE(PG8_SB(1, 0), b3, voffB);
            PG8_BAR; PG8_WAIT_L(0); PG8_MMA(0, 1, At, B1); PG8_BAR;
            PG8_LDA(At, 1, 1); PG8_STAGE(PG8_SA(1, 0), a3, voffA);
            PG8_BAR; PG8_WAIT_L(0); PG8_MMA(1, 0, At, B0); PG8_BAR; PG8_SCHED;
            PG8_STAGE(PG8_SB(1, 1), b3 + hstep, voffB);
            PG8_WAIT_V(6); PG8_BAR; PG8_MMA(1, 1, At, B1); PG8_BAR;
            }
        }
        if constexpr (ALIGN_EPI) { if (wr == 0) PG8_BAR; }
        if constexpr (!Epi::AFTER_DRAIN) { E(acc, cur, wr, wc, fr, fq); S.done(cur); }
        if (!has_next) break;
#pragma unroll
        for (int a = 0; a < 2; ++a)
#pragma unroll
            for (int b = 0; b < 2; ++b)
#pragma unroll
                for (int m = 0; m < 4; ++m)
#pragma unroll
                    for (int n = 0; n < 2; ++n) acc[a][b][m][n] = (f32x4){0.f, 0.f, 0.f, 0.f};
        cur = nxt; cA = nA; cB = nB; ++ui;
        if constexpr (ALIGN_EPI) { if (wr == 1) PG8_BAR; }
    }
    PG8_WAIT_V(0);
    if constexpr (!ALIGN_EPI) { if (wr == 0) PG8_BAR; }
    PG8_BAR;
    if constexpr (Epi::AFTER_DRAIN) { E.fused(acc, cur, wr, wc, fr, fq, lds, wid, lane); S.done(cur); }
#undef PG8_SA
#undef PG8_SB
#undef PG8_STAGE
#undef PG8_LDA
#undef PG8_LDB
#undef PG8_MMA
#undef PG8_WAIT_V
#undef PG8_WAIT_L
#undef PG8_BAR
#undef PG8_SCHED
}

struct EpiResF32 {
    static constexpr bool PERM = false, AFTER_DRAIN = false;
    const float* base; float* out; int ldc;
    __device__ __forceinline__ void operator()(const f32x4 (&acc)[2][2][4][2], const Unit& u, int wr, int wc, int fr, int fq) const {
        const int col0 = u.pn * BM + wc * 32 + 4 * fq;
#pragma unroll
        for (int ai = 0; ai < 2; ++ai)
#pragma unroll
            for (int m = 0; m < 4; ++m) { const int r = ai * HALF + wr * 64 + m * 16 + fr; const size_t off = (size_t)(u.pm * BM + r) * ldc + col0;
#pragma unroll
                for (int bj = 0; bj < 2; ++bj)
#pragma unroll
                    for (int n = 0; n < 2; ++n) { const f32x4 bs = *(const f32x4*)(base + off + bj * HALF + n * 16); *(f32x4*)(out + off + bj * HALF + n * 16) = bs + acc[ai][bj][m][n]; } }
    }
};
}

constexpr int BATCH = 4, SEQ = 8192, DM = 1024, M = BATCH * SEQ;
constexpr int NIN = 3088, NIN_PAD = 3328;
constexpr int C_GQ = 0, C_GK = 256, C_GV = 512, C_GG = 1024, C_AQ = 1536, C_AK = 2048, C_AV = 2560, C_GLR = 3072;
constexpr int NEXP = 16384;
constexpr float NORM_EPS = 1e-6f;
constexpr int NWAVES = 8, NTHREADS = 512;

constexpr size_t MiB = 1u << 20;
constexpr size_t WS_CTL = 0, CTL_ZERO_BYTES = 1 * MiB;
constexpr size_t WS_WT_IN = 1 * MiB;
constexpr size_t WS_WT_OUT = 8 * MiB;
constexpr size_t WS_WT_CIN = 10 * MiB;
constexpr size_t WS_WT_COUT = 14 * MiB;
constexpr size_t WS_WT_Q0 = 16 * MiB;
constexpr size_t WS_WT_Q1 = 20 * MiB;
constexpr size_t WS_ACT = 32 * MiB;
constexpr size_t WS_S = 96 * MiB;
constexpr size_t WS_PROJ = WS_S;
constexpr size_t WS_GLAO = WS_S + 208 * MiB;
constexpr size_t WS_TOPS = WS_S + 128 * MiB;
constexpr size_t WS_TOPI = WS_S + 160 * MiB;
constexpr size_t WS_IDS = WS_S + 192 * MiB;
constexpr size_t WS_G = WS_S + 208 * MiB;
constexpr size_t WS_XC = WS_ACT;
constexpr size_t WS_A = WS_S + 128 * MiB;
constexpr size_t WS_U = WS_S + 256 * MiB;
constexpr size_t WS_TAB = 448 * MiB;
constexpr size_t WS_END = 512 * MiB;
constexpr int CW_BAR = 4096;

constexpr int RING_BYTES = 131072;
constexpr int LDSCTL_OFF = RING_BYTES, MISC_OFF = LDSCTL_OFF + 320;
constexpr int LDS_BYTES = 147456;

#define LAS __attribute__((address_space(3)))
#define GAS __attribute__((address_space(1)))
typedef unsigned short bf16_t;
typedef float f32x4 __attribute__((ext_vector_type(4)));
typedef unsigned u32x4 __attribute__((ext_vector_type(4)));
typedef unsigned u32x2 __attribute__((ext_vector_type(2)));

struct Params {
    const float *x, *mix_norm, *ffn_norm, *ab_w_in, *gla_w_alpha, *gla_b_alpha, *gla_head_gain, *ab_w_out;
    const float *c_w_in, *c_conv_w, *c_conv_b, *c_w_rgate, *c_b_rgate, *c_w_igate, *c_b_igate, *c_lambda, *c_w_out;
    const float *peer_w_query, *peer_sub_keys, *peer_u, *peer_v, *final_norm;
    float* out; unsigned char* ws;
    int ph_lo, ph_hi;
};

__device__ __forceinline__ unsigned f2bf(float f) { unsigned u = __builtin_bit_cast(unsigned, f); return (u + 0x7fffu + ((u >> 16) & 1u)) >> 16; }
__device__ __forceinline__ unsigned pk2(float lo, float hi) { return f2bf(lo) | (f2bf(hi) << 16); }
__device__ __forceinline__ float bf2f(bf16_t b) { return __builtin_bit_cast(float, (unsigned)b << 16); }
__device__ __forceinline__ float bflo(unsigned w) { return __builtin_bit_cast(float, w << 16); }
__device__ __forceinline__ float bfhi(unsigned w) { return __builtin_bit_cast(float, w & 0xffff0000u); }
__device__ __forceinline__ float wave_sum(float v) {
#pragma unroll
    for (int o = 1; o < 64; o <<= 1) v += __shfl_xor(v, o);
    return v;
}
__device__ __forceinline__ float gelu_tanh(float x) {
    const float u = 0.7978845608028654f * (x + 0.044715f * x * x * x);
    const float e = __expf(2.f * u);
    const float th = 1.f - 2.f / (e + 1.f);
    return 0.5f * x * (1.f + th);
}
__device__ __forceinline__ float sigmoidf_(float x) { return 1.f / (1.f + __expf(-x)); }

struct Ctx { int tid, lane, wave, blk, nblk, gtid, gthreads, gwave, gwaves; LAS unsigned char* lds; };

template <class F> __device__ __forceinline__ void transpose_cvt(const float* W, int K, int Nsrc, bf16_t* WT, int Ndst, F srcmap, int gtid, int gthreads) {
    const int total = (K / 8) * Ndst;
    for (int idx = gtid; idx < total; idx += gthreads) {
        const int ko = idx / Ndst, n = idx - ko * Ndst; const int sn = srcmap(n);
        u32x4 w = {0u, 0u, 0u, 0u};
        if (sn >= 0) { const float* s = W + (size_t)(ko * 8) * Nsrc + sn;
            w.x = pk2(s[0], s[(size_t)Nsrc]); w.y = pk2(s[2 * (size_t)Nsrc], s[3 * (size_t)Nsrc]); w.z = pk2(s[4 * (size_t)Nsrc], s[5 * (size_t)Nsrc]); w.w = pk2(s[6 * (size_t)Nsrc], s[7 * (size_t)Nsrc]); }
        *(u32x4*)(WT + (size_t)n * K + ko * 8) = w;
    }
}
__device__ __forceinline__ void cvt_bf16(const float* src, bf16_t* dst, size_t n8, int gtid, int gthreads) {
    for (size_t i = gtid; i < n8; i += gthreads) { const f32x4 a = *(const f32x4*)(src + i * 8), b = *(const f32x4*)(src + i * 8 + 4);
        u32x4 w; w.x = pk2(a.x, a.y); w.y = pk2(a.z, a.w); w.z = pk2(b.x, b.y); w.w = pk2(b.z, b.w); *(u32x4*)(dst + i * 8) = w; }
}
__device__ __forceinline__ void norm_rows_bf16(const float* src, const float* gain, bf16_t* dst, const Ctx& c) {
    for (int m = c.gwave; m < M; m += c.gwaves) {
        const f32x4* xr = (const f32x4*)(src + (size_t)m * DM) + c.lane; f32x4 v[4]; float s = 0.f;
#pragma unroll
        for (int j = 0; j < 4; ++j) { v[j] = xr[64 * j]; s += (v[j].x * v[j].x + v[j].y * v[j].y) + (v[j].z * v[j].z + v[j].w * v[j].w); }
        const float rstd = 1.f / sqrtf(wave_sum(s) * (1.f / DM) + NORM_EPS);
        u32x2* o8 = (u32x2*)(dst + (size_t)m * DM) + c.lane;
#pragma unroll
        for (int j = 0; j < 4; ++j) { const f32x4 g = *((const f32x4*)gain + 64 * j + c.lane); u32x2 w; w.x = pk2(v[j].x * rstd * g.x, v[j].y * rstd * g.y); w.y = pk2(v[j].z * rstd * g.z, v[j].w * rstd * g.w); o8[64 * j] = w; }
    }
}
__device__ __forceinline__ void norm_rows_f32(float* buf, const float* gain, const Ctx& c) {
    for (int m = c.gwave; m < M; m += c.gwaves) {
        f32x4* xr = (f32x4*)(buf + (size_t)m * DM) + c.lane; f32x4 v[4]; float s = 0.f;
#pragma unroll
        for (int j = 0; j < 4; ++j) { v[j] = xr[64 * j]; s += (v[j].x * v[j].x + v[j].y * v[j].y) + (v[j].z * v[j].z + v[j].w * v[j].w); }
        const float rstd = 1.f / sqrtf(wave_sum(s) * (1.f / DM) + NORM_EPS);
#pragma unroll
        for (int j = 0; j < 4; ++j) { const f32x4 g = *((const f32x4*)gain + 64 * j + c.lane); xr[64 * j] = v[j] * rstd * g; }
    }
}

__device__ __forceinline__ void ph_gla_naive(const Params& p, const Ctx& c) {
    const int b = c.blk >> 2, h = c.blk & 3;
    LAS float* sq = (LAS float*)c.lds; LAS float* sk = sq + 4096; LAS float* sa = sk + 4096; LAS float* sv = sa + 4096;
    const bf16_t* proj = (const bf16_t*)(p.ws + WS_PROJ);
    float* go = (float*)(p.ws + WS_GLAO);
    const int tid = c.tid, v = tid >> 2, kq = tid & 3;
    float S[16];
#pragma unroll
    for (int i = 0; i < 16; ++i) S[i] = 0.f;
    for (int t0 = 0; t0 < SEQ; t0 += 64) {
        __syncthreads();
        for (int e = tid; e < 4096; e += NTHREADS) { const int tt = e >> 6, kk = e & 63; const bf16_t* pr = proj + (size_t)(b * SEQ + t0 + tt) * NIN_PAD;
            sq[e] = bf2f(pr[C_GQ + h * 64 + kk]); sk[e] = bf2f(pr[C_GK + h * 64 + kk]);
            float z = p.gla_b_alpha[h * 64 + kk];
#pragma unroll
            for (int r = 0; r < 16; ++r) z += bf2f(pr[C_GLR + r]) * p.gla_w_alpha[r * 256 + h * 64 + kk];
            const float ls = fminf(z, 0.f) - log1pf(expf(-fabsf(z)));
            sa[e] = expf(ls * (1.f / 16.f)); }
        for (int e = tid; e < 8192; e += NTHREADS) { const int tt = e >> 7, vv = e & 127; sv[e] = bf2f(proj[(size_t)(b * SEQ + t0 + tt) * NIN_PAD + C_GV + h * 128 + vv]); }
        __syncthreads();
        for (int tt = 0; tt < 64; ++tt) {
            const float vv = sv[tt * 128 + v]; float part = 0.f;
#pragma unroll
            for (int i = 0; i < 16; ++i) { const int kk = kq * 16 + i; S[i] = sa[tt * 64 + kk] * S[i] + sk[tt * 64 + kk] * vv; part += sq[tt * 64 + kk] * S[i]; }
            part += __shfl_xor(part, 1); part += __shfl_xor(part, 2);
            if (kq == 0) go[(size_t)(b * SEQ + t0 + tt) * 512 + h * 128 + v] = part * 0.125f;
        }
    }
}
__device__ __forceinline__ void ph_attn_naive(const Params& p, int gtid, int gthreads) {
    const bf16_t* proj = (const bf16_t*)(p.ws + WS_PROJ); bf16_t* mixed = (bf16_t*)(p.ws + WS_ACT);
    for (int idx = gtid; idx < M * 8; idx += gthreads) {
        const int t = idx & 8191, h = (idx >> 13) & 7, b = idx >> 16;
        const size_t row = (size_t)b * SEQ + t;
        float q[64], o[64];
        { const u32x4* qp = (const u32x4*)(proj + row * NIN_PAD + C_AQ + h * 64);
#pragma unroll
          for (int i = 0; i < 8; ++i) { const u32x4 w = qp[i]; q[8*i] = bflo(w.x); q[8*i+1] = bfhi(w.x); q[8*i+2] = bflo(w.y); q[8*i+3] = bfhi(w.y); q[8*i+4] = bflo(w.z); q[8*i+5] = bfhi(w.z); q[8*i+6] = bflo(w.w); q[8*i+7] = bfhi(w.w); } }
#pragma unroll
        for (int d = 0; d < 64; ++d) o[d] = 0.f;
        float mx = -1e30f, l = 0.f;
        const float slope = exp2f(-(float)(h + 1));
        for (int br = 0; br < 3; ++br) { const int dil = 1 << (2 * br);
            for (int j = 0; j <= 128; ++j) { const int tk = t - j * dil; if (tk < 0) break;
                const u32x4* kp = (const u32x4*)(proj + ((size_t)b * SEQ + tk) * NIN_PAD + C_AK + h * 64); const u32x4* vp = kp + 64;
                float s = 0.f;
#pragma unroll
                for (int i = 0; i < 8; ++i) { const u32x4 w = kp[i]; s += q[8*i] * bflo(w.x) + q[8*i+1] * bfhi(w.x) + q[8*i+2] * bflo(w.y) + q[8*i+3] * bfhi(w.y) + q[8*i+4] * bflo(w.z) + q[8*i+5] * bfhi(w.z) + q[8*i+6] * bflo(w.w) + q[8*i+7] * bfhi(w.w); }
                s = s * 0.125f - slope * (float)(j * dil);
                const float mn = fmaxf(mx, s), corr = __expf(mx - mn), pp = __expf(s - mn);
                l = l * corr + pp; mx = mn;
#pragma unroll
                for (int i = 0; i < 8; ++i) { const u32x4 w = vp[i];
                    o[8*i] = o[8*i] * corr + pp * bflo(w.x); o[8*i+1] = o[8*i+1] * corr + pp * bfhi(w.x); o[8*i+2] = o[8*i+2] * corr + pp * bflo(w.y); o[8*i+3] = o[8*i+3] * corr + pp * bfhi(w.y);
                    o[8*i+4] = o[8*i+4] * corr + pp * bflo(w.z); o[8*i+5] = o[8*i+5] * corr + pp * bfhi(w.z); o[8*i+6] = o[8*i+6] * corr + pp * bflo(w.w); o[8*i+7] = o[8*i+7] * corr + pp * bfhi(w.w); }
            } }
        const float rl = 1.f / l;
        u32x4* op = (u32x4*)(mixed + row * DM + 512 + h * 64);
#pragma unroll
        for (int i = 0; i < 8; ++i) { u32x4 w; w.x = pk2(o[8*i] * rl, o[8*i+1] * rl); w.y = pk2(o[8*i+2] * rl, o[8*i+3] * rl); w.z = pk2(o[8*i+4] * rl, o[8*i+5] * rl); w.w = pk2(o[8*i+6] * rl, o[8*i+7] * rl); op[i] = w; }
    }
}
__device__ __forceinline__ void ph_mix(const Params& p, const Ctx& c) {
    const bf16_t* proj = (const bf16_t*)(p.ws + WS_PROJ); const float* go = (const float*)(p.ws + WS_GLAO); bf16_t* mixed = (bf16_t*)(p.ws + WS_ACT);
    for (int m = c.gwave; m < M; m += c.gwaves) {
#pragma unroll
        for (int h = 0; h < 4; ++h) { const int col = h * 128 + 2 * c.lane;
            const float o0 = go[(size_t)m * 512 + col], o1 = go[(size_t)m * 512 + col + 1];
            const float rstd = 1.f / sqrtf(wave_sum(o0 * o0 + o1 * o1) * (1.f / 128.f) + NORM_EPS);
            const unsigned gw = *(const unsigned*)(proj + (size_t)m * NIN_PAD + C_GG + col); const float g0 = bflo(gw), g1 = bfhi(gw);
            const float r0 = o0 * rstd * p.gla_head_gain[col] * (g0 * sigmoidf_(g0)), r1 = o1 * rstd * p.gla_head_gain[col + 1] * (g1 * sigmoidf_(g1));
            *(unsigned*)(mixed + (size_t)m * DM + col) = pk2(r0, r1); }
    }
}

__device__ __forceinline__ void ph_topk1(const Params& p, int layer, const Ctx& c) {
    const bf16_t* Q = (const bf16_t*)(p.ws + WS_PROJ); float* tops = (float*)(p.ws + WS_TOPS); int* topi = (int*)(p.ws + WS_TOPI);
    const float* keys = p.peer_sub_keys + (size_t)layer * 16 * 128 * 128;
    for (int gid = c.gtid; gid < M * 32; gid += c.gthreads) {
        const int idx = gid >> 1, half = gid & 1;
        const int t = idx & (M - 1), hp = __builtin_amdgcn_readfirstlane(idx >> 15);
        float q[64];
        { const u32x4* qp = (const u32x4*)(Q + (size_t)t * 2048 + hp * 128 + half * 64);
#pragma unroll
          for (int i = 0; i < 8; ++i) { const u32x4 w = qp[i]; q[8*i] = bflo(w.x); q[8*i+1] = bfhi(w.x); q[8*i+2] = bflo(w.y); q[8*i+3] = bfhi(w.y); q[8*i+4] = bflo(w.z); q[8*i+5] = bfhi(w.z); q[8*i+6] = bflo(w.w); q[8*i+7] = bfhi(w.w); } }
        float ls[16]; int li[16];
#pragma unroll
        for (int j = 0; j < 16; ++j) { ls[j] = -3.0e38f; li[j] = 0; }
        for (int n = 0; n < 128; ++n) { const float* kr = keys + ((size_t)hp * 128 + n) * 128 + half * 64;
            float s = 0.f;
#pragma unroll
            for (int cc = 0; cc < 64; ++cc) s += q[cc] * kr[cc];
            s += __shfl_xor(s, 1);
            int ni = n;
#pragma unroll
            for (int j = 0; j < 16; ++j) { const bool gt = s > ls[j]; const float ts = gt ? ls[j] : s; const int ti = gt ? li[j] : ni; ls[j] = gt ? s : ls[j]; li[j] = gt ? ni : li[j]; s = ts; ni = ti; }
        }
        if (half == 0) { float* os = tops + ((size_t)t * 16 + hp) * 16; int* oi = topi + ((size_t)t * 16 + hp) * 16;
#pragma unroll
            for (int j = 0; j < 16; ++j) { os[j] = ls[j]; oi[j] = li[j]; } }
    }
}
__device__ __forceinline__ void ph_topk2(const Params& p, const Ctx& c) {
    const float* tops = (const float*)(p.ws + WS_TOPS); const int* topi = (const int*)(p.ws + WS_TOPI);
    int* ids = (int*)(p.ws + WS_IDS); float* gg = (float*)(p.ws + WS_G);
    for (int idx = c.gtid; idx < M * 8; idx += c.gthreads) {
        const int t = idx >> 3, h = idx & 7;
        float s1[16], s2[16]; int i1[16], i2[16];
        { const float* a = tops + ((size_t)t * 16 + h * 2) * 16; const int* ai = topi + ((size_t)t * 16 + h * 2) * 16;
#pragma unroll
          for (int j = 0; j < 16; ++j) { s1[j] = a[j]; s2[j] = a[16 + j]; i1[j] = ai[j]; i2[j] = ai[16 + j]; } }
        float ls[16]; int lc[16];
#pragma unroll
        for (int j = 0; j < 16; ++j) { ls[j] = -3.0e38f; lc[j] = 0; }
#pragma unroll
        for (int i = 0; i < 16; ++i)
#pragma unroll
            for (int j = 0; j < 16 / (i + 1); ++j) { float s = s1[i] + s2[j]; int cd = i * 16 + j;
#pragma unroll
                for (int k = 0; k < 16; ++k) { const bool gt = s > ls[k]; const float ts = gt ? ls[k] : s; const int tc = gt ? lc[k] : cd; ls[k] = gt ? s : ls[k]; lc[k] = gt ? cd : lc[k]; s = ts; cd = tc; } }
        float den = 0.f, e[16];
#pragma unroll
        for (int k = 0; k < 16; ++k) { e[k] = __expf(ls[k] - ls[0]); den += e[k]; }
        const float rd = 1.f / den;
#pragma unroll
        for (int k = 0; k < 16; ++k) { const int ci = lc[k] >> 4, cj = lc[k] & 15; int a = 0, bq = 0;
#pragma unroll
            for (int z = 0; z < 16; ++z) { a = (ci == z) ? i1[z] : a; bq = (cj == z) ? i2[z] : bq; }
            ids[(size_t)t * 128 + h * 16 + k] = a * 128 + bq; gg[(size_t)t * 128 + h * 16 + k] = e[k] * rd; }
    }
}
__device__ __forceinline__ void ph_gather(const Params& p, const Ctx& c) {
    const bf16_t* XN = (const bf16_t*)(p.ws + WS_ACT); const bf16_t* UT = (const bf16_t*)(p.ws + WS_TAB); const bf16_t* VT = UT + (size_t)NEXP * DM;
    const int* ids = (const int*)(p.ws + WS_IDS); const float* gg = (const float*)(p.ws + WS_G);
    for (int m = c.gwave; m < M; m += c.gwaves) {
        float x[16], o[16];
        { const u32x4 a = *((const u32x4*)(XN + (size_t)m * DM) + c.lane), b = *((const u32x4*)(XN + (size_t)m * DM + 512) + c.lane);
          x[0] = bflo(a.x); x[1] = bfhi(a.x); x[2] = bflo(a.y); x[3] = bfhi(a.y); x[4] = bflo(a.z); x[5] = bfhi(a.z); x[6] = bflo(a.w); x[7] = bfhi(a.w);
          x[8] = bflo(b.x); x[9] = bfhi(b.x); x[10] = bflo(b.y); x[11] = bfhi(b.y); x[12] = bflo(b.z); x[13] = bfhi(b.z); x[14] = bflo(b.w); x[15] = bfhi(b.w); }
#pragma unroll
        for (int i = 0; i < 16; ++i) o[i] = 0.f;
        const int id0 = ids[(size_t)m * 128 + c.lane], id1 = ids[(size_t)m * 128 + 64 + c.lane];
        const float g0 = gg[(size_t)m * 128 + c.lane], g1 = gg[(size_t)m * 128 + 64 + c.lane];
        for (int k0 = 0; k0 < 128; k0 += 4) {
            u32x4 ua[4], ub[4], va[4], vb[4]; float gk[4];
#pragma unroll
            for (int j = 0; j < 4; ++j) { const int k = k0 + j; const int id = (k < 64) ? __shfl(id0, k) : __shfl(id1, k - 64); gk[j] = (k < 64) ? __shfl(g0, k) : __shfl(g1, k - 64);
                const u32x4* ur = (const u32x4*)(UT + (size_t)id * DM); const u32x4* vr = (const u32x4*)(VT + (size_t)id * DM);
                ua[j] = ur[c.lane]; ub[j] = ur[64 + c.lane]; va[j] = vr[c.lane]; vb[j] = vr[64 + c.lane]; }
#pragma unroll
            for (int j = 0; j < 4; ++j) {
                float d = x[0] * bflo(ua[j].x) + x[1] * bfhi(ua[j].x) + x[2] * bflo(ua[j].y) + x[3] * bfhi(ua[j].y) + x[4] * bflo(ua[j].z) + x[5] * bfhi(ua[j].z) + x[6] * bflo(ua[j].w) + x[7] * bfhi(ua[j].w)
                        + x[8] * bflo(ub[j].x) + x[9] * bfhi(ub[j].x) + x[10] * bflo(ub[j].y) + x[11] * bfhi(ub[j].y) + x[12] * bflo(ub[j].z) + x[13] * bfhi(ub[j].z) + x[14] * bflo(ub[j].w) + x[15] * bfhi(ub[j].w);
                d = wave_sum(d);
                const float act = gelu_tanh(d) * gk[j];
                o[0] += act * bflo(va[j].x); o[1] += act * bfhi(va[j].x); o[2] += act * bflo(va[j].y); o[3] += act * bfhi(va[j].y); o[4] += act * bflo(va[j].z); o[5] += act * bfhi(va[j].z); o[6] += act * bflo(va[j].w); o[7] += act * bfhi(va[j].w);
                o[8] += act * bflo(vb[j].x); o[9] += act * bfhi(vb[j].x); o[10] += act * bflo(vb[j].y); o[11] += act * bfhi(vb[j].y); o[12] += act * bflo(vb[j].z); o[13] += act * bfhi(vb[j].z); o[14] += act * bflo(vb[j].w); o[15] += act * bfhi(vb[j].w);
            }
        }
        f32x4* hp = (f32x4*)(p.out + (size_t)m * DM);
        f32x4 h0 = hp[2 * c.lane], h1 = hp[2 * c.lane + 1], h2 = hp[128 + 2 * c.lane], h3 = hp[128 + 2 * c.lane + 1];
        h0 += (f32x4){o[0], o[1], o[2], o[3]}; h1 += (f32x4){o[4], o[5], o[6], o[7]}; h2 += (f32x4){o[8], o[9], o[10], o[11]}; h3 += (f32x4){o[12], o[13], o[14], o[15]};
        hp[2 * c.lane] = h0; hp[2 * c.lane + 1] = h1; hp[128 + 2 * c.lane] = h2; hp[128 + 2 * c.lane + 1] = h3;
    }
}

__device__ __forceinline__ void ph_g1(const Params& p, const Ctx& c) {
    const bf16_t* proj = (const bf16_t*)(p.ws + WS_PROJ); bf16_t* xc = (bf16_t*)(p.ws + WS_XC);
    for (size_t idx = c.gtid; idx < (size_t)M * DM; idx += c.gthreads) {
        const int ch = (int)(idx & 1023); const int row = (int)(idx >> 10); const int t = row & (SEQ - 1);
        float a = p.c_conv_b[ch];
#pragma unroll
        for (int j = 0; j < 4; ++j) { const int tt = t - 3 + j; if (tt >= 0) a += p.c_conv_w[j * 1024 + ch] * bf2f(proj[(size_t)(row - 3 + j) * 2048 + 1024 + ch]); }
        xc[idx] = (bf16_t)f2bf(a);
    }
}
__device__ __forceinline__ void ph_g2(const Params& p, const Ctx& c) {
    const bf16_t* xc = (const bf16_t*)(p.ws + WS_XC); float* A = (float*)(p.ws + WS_A); float* U = (float*)(p.ws + WS_U);
    for (size_t idx = c.gtid; idx < (size_t)M * DM; idx += c.gthreads) {
        const int ch = (int)(idx & 1023); const size_t row = idx >> 10; const int g = ch >> 7, j = ch & 127;
        const bf16_t* xr = xc + row * DM + g * 128; const float* wr = p.c_w_rgate + (size_t)g * 16384 + j; const float* wi = p.c_w_igate + (size_t)g * 16384 + j;
        float ar = p.c_b_rgate[ch], ai = p.c_b_igate[ch];
        for (int i = 0; i < 128; i += 8) { const u32x4 w = *(const u32x4*)(xr + i);
            const float x0 = bflo(w.x), x1 = bfhi(w.x), x2 = bflo(w.y), x3 = bfhi(w.y), x4 = bflo(w.z), x5 = bfhi(w.z), x6 = bflo(w.w), x7 = bfhi(w.w);
            ar += x0 * wr[(i) * 128] + x1 * wr[(i + 1) * 128] + x2 * wr[(i + 2) * 128] + x3 * wr[(i + 3) * 128] + x4 * wr[(i + 4) * 128] + x5 * wr[(i + 5) * 128] + x6 * wr[(i + 6) * 128] + x7 * wr[(i + 7) * 128];
            ai += x0 * wi[(i) * 128] + x1 * wi[(i + 1) * 128] + x2 * wi[(i + 2) * 128] + x3 * wi[(i + 3) * 128] + x4 * wi[(i + 4) * 128] + x5 * wi[(i + 5) * 128] + x6 * wi[(i + 6) * 128] + x7 * wi[(i + 7) * 128]; }
        const float r = sigmoidf_(ar), ig = sigmoidf_(ai);
        const float lam = p.c_lambda[ch]; const float sp = fmaxf(-lam, 0.f) + log1pf(expf(-fabsf(lam)));
        const float la = -8.f * r * sp;
        A[idx] = expf(la); U[idx] = sqrtf(-expm1f(2.f * la)) * (ig * bf2f(xc[idx]));
    }
}
__device__ __forceinline__ void ph_g3(const Params& p, const Ctx& c) {
    const bf16_t* proj = (const bf16_t*)(p.ws + WS_PROJ); const float* A = (const float*)(p.ws + WS_A); const float* U = (const float*)(p.ws + WS_U); bf16_t* y = (bf16_t*)(p.ws + WS_ACT);
    for (int idx = c.gtid; idx < BATCH * DM; idx += c.gthreads) {
        const int b = idx >> 10, ch = idx & 1023; float h = 0.f;
        for (int t0 = 0; t0 < SEQ; t0 += 8) {
            float a[8], u[8], g[8];
#pragma unroll
            for (int j = 0; j < 8; ++j) { const size_t e = (size_t)(b * SEQ + t0 + j) * DM + ch; a[j] = A[e]; u[j] = U[e]; g[j] = bf2f(proj[(size_t)(b * SEQ + t0 + j) * 2048 + ch]); }
#pragma unroll
            for (int j = 0; j < 8; ++j) { h = a[j] * h + u[j]; y[(size_t)(b * SEQ + t0 + j) * DM + ch] = (bf16_t)f2bf(gelu_tanh(g[j]) * h); }
        }
    }
}
#define XB_TMO      128
#define XB_XCNT(j)  (256  + 64 * (j))
#define XB_XSUB(j)  (1280 + 64 * (j))
#define XB_XGEN(j)  (2304 + 64 * (j))
#define XB_TOP      3328
#define XB_TOPGEN   3392
#define XCD_BAR_WORDS 3456
#define XB_SPIN_CAP (1u << 18)

__device__ __forceinline__ unsigned xb_ld(unsigned* p)              { return __hip_atomic_load(p, __ATOMIC_RELAXED, __HIP_MEMORY_SCOPE_AGENT); }
__device__ __forceinline__ unsigned xb_add(unsigned* p, unsigned v) { return __hip_atomic_fetch_add(p, v, __ATOMIC_RELAXED, __HIP_MEMORY_SCOPE_AGENT); }
__device__ __forceinline__ unsigned xb_xcc_id() { return (unsigned)__builtin_amdgcn_s_getreg((3 << 11) | 20) & 0xFu; }
#define XB_SPIN(cond, bar) do { unsigned _sp = 0; while (cond) { __builtin_amdgcn_s_sleep(1); \
    if ((++_sp & 255u) == 0u) { if (xb_ld(&(bar)[XB_TMO])) break; if (_sp > XB_SPIN_CAP) { atomicAdd(&(bar)[XB_TMO], 1u); break; } } } } while (0)

struct XcdBarrier {
    unsigned* bar; unsigned x;
    volatile LAS unsigned* st;
};

__device__ __forceinline__ XcdBarrier xcd_barrier_post(unsigned* bar, volatile LAS unsigned* st) {
    XcdBarrier b; b.bar = bar; b.x = xb_xcc_id(); b.st = st;
    if (threadIdx.x == 0) (void)xb_add(&bar[XB_XCNT(b.x)], 1u);
    return b;
}
__device__ __forceinline__ void xcd_barrier_complete(unsigned* bar, unsigned x, unsigned& nloc, unsigned& nx) {
    const unsigned G = gridDim.x * gridDim.y * gridDim.z;
    unsigned sum, cnt, mine, sp = 0u;
    for (;;) {
        sum = 0u; cnt = 0u; mine = 0u;
#pragma unroll
        for (unsigned j = 0; j < 16; ++j) { const unsigned c = xb_ld(&bar[XB_XCNT(j)]); sum += c; cnt += (c > 0u) ? 1u : 0u; mine = (j == x) ? c : mine; }
        if (sum == G) break;
        __builtin_amdgcn_s_sleep(1);
        if ((++sp & 255u) == 0u) { if (xb_ld(&bar[XB_TMO])) break; if (sp > XB_SPIN_CAP) { atomicAdd(&bar[XB_TMO], 1u); break; } }
    }
    nloc = mine > 0u ? mine : 1u; nx = cnt > 0u ? cnt : 1u;
}

__device__ __forceinline__ void xcd_barrier(const XcdBarrier& b) {
    asm volatile("s_waitcnt vmcnt(0)" ::: "memory");
    __syncthreads();
    if (threadIdx.x == 0) {
        unsigned* bar = b.bar;
        __builtin_amdgcn_s_waitcnt(0);
        unsigned nloc = b.st[0], nx = b.st[1];
        if (nloc == 0u) { xcd_barrier_complete(bar, b.x, nloc, nx); b.st[0] = nloc; b.st[1] = nx; }
        const unsigned old = xb_add(&bar[XB_XSUB(b.x)], 1u);
        const unsigned gen = old / nloc;
        if (old + 1u == (gen + 1u) * nloc) {
            __builtin_amdgcn_fence(__ATOMIC_RELEASE, "agent");
            asm volatile("s_waitcnt vmcnt(0)" ::: "memory");
            const unsigned og = xb_add(&bar[XB_TOP], 1u);
            const unsigned tg = og / nx;
            if (og + 1u == (tg + 1u) * nx) xb_add(&bar[XB_TOPGEN], 1u);
            else XB_SPIN(xb_ld(&bar[XB_TOPGEN]) == tg, bar);
            __builtin_amdgcn_fence(__ATOMIC_ACQUIRE, "agent");
            xb_add(&bar[XB_XGEN(b.x)], 1u);
            asm volatile("s_waitcnt vmcnt(0)" ::: "memory");
        } else {
            XB_SPIN(xb_ld(&bar[XB_XGEN(b.x)]) == gen, bar);
            __builtin_amdgcn_fence(__ATOMIC_ACQUIRE, "agent");
            asm volatile("s_waitcnt vmcnt(0)" ::: "memory");
        }
    }
    __syncthreads();
}

enum Phase { PH_PRO = 0, PH_GEMM_IN0, PH_MIXER0, PH_MIX0, PH_GEMM_OUT0, PH_NORM_F0, PH_GEMM_Q0, PH_TOPK1_0, PH_TOPK2_0, PH_GATHER0,
             PH_NORM_M1, PH_GEMM_CIN, PH_G1, PH_G2, PH_G3, PH_GEMM_OUT1, PH_NORM_F1, PH_GEMM_Q1, PH_TOPK1_1, PH_TOPK2_1, PH_GATHER1, PH_FINAL, NPHASES };

#ifndef PH_ONLY
#define PH_ONLY (-1)
#endif
#define PH_ENABLED(x) (PH_ONLY < 0 || PH_ONLY == (x))
#ifndef MK_N_LAUNCHES
#define MK_N_LAUNCHES 1
#endif

template <class Epi> __device__ __forceinline__ void run_gemm(const Ctx& c, const bf16_t* A, const bf16_t* Bt, int N, const Epi& E) {
    pg8::Gemm g{A, Bt, M, N, DM}; pg8::StaticOrder S; S.init(M, N, c.nblk, c.blk);
    pg8::gemm_phase<Epi, pg8::StaticOrder, true, true>(c.lds, g, S, E);
}

#define MKCTX() Ctx c; { int t_ = threadIdx.x; asm volatile("" : "+v"(t_)); c.lds = lds; c.tid = t_; c.lane = t_ & 63; c.wave = __builtin_amdgcn_readfirstlane(t_ >> 6); \
    c.blk = blockIdx.x; c.nblk = gridDim.x; c.gtid = c.blk * NTHREADS + c.tid; c.gthreads = c.nblk * NTHREADS; c.gwave = c.blk * NWAVES + c.wave; c.gwaves = c.nblk * NWAVES; }
__global__ void __launch_bounds__(NTHREADS, 2) mega_fwd(Params p) {
    extern __shared__ __attribute__((aligned(16))) unsigned char lds_raw[];
    volatile LAS unsigned* MISC = (volatile LAS unsigned*)((LAS unsigned char*)lds_raw + MISC_OFF);
    LAS unsigned char* const lds = (LAS unsigned char*)lds_raw;
    for (int u = threadIdx.x; u < (LDS_BYTES - LDSCTL_OFF) / 4; u += NTHREADS) ((LAS unsigned*)(lds + LDSCTL_OFF))[u] = 0u;
    __syncthreads();
    unsigned* ctl = (unsigned*)(p.ws + WS_CTL);
    XcdBarrier bar; bar.bar = ctl + CW_BAR; bar.x = 0; bar.st = nullptr;
    const bool multi = (p.ph_hi - p.ph_lo) > 1;
    if (multi) bar = xcd_barrier_post(ctl + CW_BAR, MISC + 8);
    unsigned char* ws = p.ws;
    bf16_t* ACT = (bf16_t*)(ws + WS_ACT); bf16_t* PROJ = (bf16_t*)(ws + WS_PROJ);

    const int lo = p.ph_lo, hi = p.ph_hi;
#define IN(k) (PH_ENABLED(k) && lo <= (k) && (k) < hi)
#define SEAM(k) do { if ((k) + 1 < hi) xcd_barrier(bar); } while (0)
    if (IN(PH_PRO)) { MKCTX();
        transpose_cvt(p.ab_w_in, DM, NIN, (bf16_t*)(ws + WS_WT_IN), NIN_PAD, [](int n) { return n < 1536 ? n : (n < 3072 ? n + 16 : (n < 3088 ? n - 3072 + 1536 : -1)); }, c.gtid, c.gthreads);
        transpose_cvt(p.ab_w_out, DM, DM, (bf16_t*)(ws + WS_WT_OUT), DM, [](int n) { return n; }, c.gtid, c.gthreads);
        transpose_cvt(p.c_w_in, DM, 2048, (bf16_t*)(ws + WS_WT_CIN), 2048, [](int n) { return n; }, c.gtid, c.gthreads);
        transpose_cvt(p.c_w_out, DM, DM, (bf16_t*)(ws + WS_WT_COUT), DM, [](int n) { return n; }, c.gtid, c.gthreads);
        transpose_cvt(p.peer_w_query, DM, 2048, (bf16_t*)(ws + WS_WT_Q0), 2048, [](int n) { return n; }, c.gtid, c.gthreads);
        transpose_cvt(p.peer_w_query + (size_t)DM * 2048, DM, 2048, (bf16_t*)(ws + WS_WT_Q1), 2048, [](int n) { return n; }, c.gtid, c.gthreads);
        cvt_bf16(p.peer_u, (bf16_t*)(ws + WS_TAB), (size_t)NEXP * DM / 8, c.gtid, c.gthreads);
        cvt_bf16(p.peer_v, (bf16_t*)(ws + WS_TAB) + (size_t)NEXP * DM, (size_t)NEXP * DM / 8, c.gtid, c.gthreads);
        norm_rows_bf16(p.x, p.mix_norm, ACT, c);
        SEAM(PH_PRO); }
    if (IN(PH_GEMM_IN0)) { MKCTX(); pg8::EpiBf16<0> E{PROJ, NIN_PAD, nullptr, 0, 0, 1.f}; run_gemm(c, ACT, (const bf16_t*)(ws + WS_WT_IN), NIN_PAD, E); SEAM(PH_GEMM_IN0); }
    if (IN(PH_MIXER0)) { MKCTX(); if (c.blk < 16) ph_gla_naive(p, c); else ph_attn_naive(p, (c.blk - 16) * NTHREADS + c.tid, (c.nblk - 16) * NTHREADS); SEAM(PH_MIXER0); }
    if (IN(PH_MIX0)) { MKCTX(); ph_mix(p, c); SEAM(PH_MIX0); }
    if (IN(PH_GEMM_OUT0)) { MKCTX(); pg8::EpiResF32 E{p.x, p.out, DM}; run_gemm(c, ACT, (const bf16_t*)(ws + WS_WT_OUT), DM, E); SEAM(PH_GEMM_OUT0); }
    if (IN(PH_NORM_F0)) { MKCTX(); norm_rows_bf16(p.out, p.ffn_norm, ACT, c); SEAM(PH_NORM_F0); }
    if (IN(PH_GEMM_Q0)) { MKCTX(); pg8::EpiBf16<0> E{PROJ, 2048, nullptr, 0, 0, 1.f}; run_gemm(c, ACT, (const bf16_t*)(ws + WS_WT_Q0), 2048, E); SEAM(PH_GEMM_Q0); }
    if (IN(PH_TOPK1_0)) { MKCTX(); ph_topk1(p, 0, c); SEAM(PH_TOPK1_0); }
    if (IN(PH_TOPK2_0)) { MKCTX(); ph_topk2(p, c); SEAM(PH_TOPK2_0); }
    if (IN(PH_GATHER0)) { MKCTX(); ph_gather(p, c); SEAM(PH_GATHER0); }
    if (IN(PH_NORM_M1)) { MKCTX(); norm_rows_bf16(p.out, p.mix_norm + DM, ACT, c); SEAM(PH_NORM_M1); }
    if (IN(PH_GEMM_CIN)) { MKCTX(); pg8::EpiBf16<0> E{PROJ, 2048, nullptr, 0, 0, 1.f}; run_gemm(c, ACT, (const bf16_t*)(ws + WS_WT_CIN), 2048, E); SEAM(PH_GEMM_CIN); }
    if (IN(PH_G1)) { MKCTX(); ph_g1(p, c); SEAM(PH_G1); }
    if (IN(PH_G2)) { MKCTX(); ph_g2(p, c); SEAM(PH_G2); }
    if (IN(PH_G3)) { MKCTX(); ph_g3(p, c); SEAM(PH_G3); }
    if (IN(PH_GEMM_OUT1)) { MKCTX(); pg8::EpiResF32 E{p.out, p.out, DM}; run_gemm(c, ACT, (const bf16_t*)(ws + WS_WT_COUT), DM, E); SEAM(PH_GEMM_OUT1); }
    if (IN(PH_NORM_F1)) { MKCTX();
        norm_rows_bf16(p.out, p.ffn_norm + DM, ACT, c);
        cvt_bf16(p.peer_u + (size_t)NEXP * DM, (bf16_t*)(ws + WS_TAB), (size_t)NEXP * DM / 8, c.gtid, c.gthreads);
        cvt_bf16(p.peer_v + (size_t)NEXP * DM, (bf16_t*)(ws + WS_TAB) + (size_t)NEXP * DM, (size_t)NEXP * DM / 8, c.gtid, c.gthreads);
        SEAM(PH_NORM_F1); }
    if (IN(PH_GEMM_Q1)) { MKCTX(); pg8::EpiBf16<0> E{PROJ, 2048, nullptr, 0, 0, 1.f}; run_gemm(c, ACT, (const bf16_t*)(ws + WS_WT_Q1), 2048, E); SEAM(PH_GEMM_Q1); }
    if (IN(PH_TOPK1_1)) { MKCTX(); ph_topk1(p, 1, c); SEAM(PH_TOPK1_1); }
    if (IN(PH_TOPK2_1)) { MKCTX(); ph_topk2(p, c); SEAM(PH_TOPK2_1); }
    if (IN(PH_GATHER1)) { MKCTX(); ph_gather(p, c); SEAM(PH_GATHER1); }
    if (IN(PH_FINAL)) { MKCTX(); norm_rows_f32(p.out, p.final_norm, c); }
#undef IN
#undef SEAM
}

extern "C" void kernel_launch(void* const* d_in, const int* in_sizes, int n_in, void* d_out, int out_size, void* d_ws, size_t ws_size, hipStream_t stream) {
    static int grid = 0;
    if (grid == 0) {
        if (n_in != 22 || out_size != M * DM || ws_size < WS_END) { fprintf(stderr, "kernel_launch: unexpected shapes: n_in %d out %d ws %zu (need %zu)\n", n_in, out_size, ws_size, (size_t)WS_END); grid = -1; return; }
        int dev = 0, cus = 0, per_cu = 0;
        if (hipGetDevice(&dev) != hipSuccess || hipDeviceGetAttribute(&cus, hipDeviceAttributeMultiprocessorCount, dev) != hipSuccess) { grid = -1; return; }
        if (hipFuncSetAttribute((const void*)mega_fwd, hipFuncAttributeMaxDynamicSharedMemorySize, LDS_BYTES) != hipSuccess) { fprintf(stderr, "kernel_launch: hipFuncSetAttribute failed\n"); grid = -1; return; }
        if (hipOccupancyMaxActiveBlocksPerMultiprocessor(&per_cu, (const void*)mega_fwd, NTHREADS, LDS_BYTES) != hipSuccess || per_cu < 1) { fprintf(stderr, "kernel_launch: occupancy query says %d blocks per CU\n", per_cu); per_cu = 1; }
        (void)hipGetLastError();
        grid = cus;
        if (grid % 8 != 0 || grid < 32) { fprintf(stderr, "kernel_launch: unexpected CU count %d\n", cus); }
    }
    if (grid < 0) return;
    (void)hipMemsetAsync((char*)d_ws + WS_CTL, 0, CTL_ZERO_BYTES, stream);
    Params p{};
    const float** pp = (const float**)&p;
    for (int i = 0; i < 22; ++i) pp[i] = (const float*)d_in[i];
    p.out = (float*)d_out; p.ws = (unsigned char*)d_ws;
#if MK_N_LAUNCHES == 1
    p.ph_lo = 0; p.ph_hi = NPHASES;
    void* args[] = {&p};
    hipError_t e = hipLaunchCooperativeKernel((const void*)mega_fwd, dim3(grid), dim3(NTHREADS), args, LDS_BYTES, stream);
    if (e != hipSuccess) fprintf(stderr, "cooperative launch failed: %s (grid %d)\n", hipGetErrorString(e), grid);
#else
    for (int ph = 0; ph < NPHASES; ++ph) { p.ph_lo = ph; p.ph_hi = ph + 1; hipLaunchKernelGGL(mega_fwd, dim3(grid), dim3(NTHREADS), LDS_BYTES, stream, p); }
#endif
}
```

```cpp
#include <hip/hip_runtime.h>
#include <hip/hip_bf16.h>
#include <cstdio>
#include <cstdint>
#include <cmath>
namespace pg8 {
#define PG8_LAS __attribute__((address_space(3)))
typedef unsigned short bf16_t;
typedef short bf16x8 __attribute__((ext_vector_type(8)));
typedef float f32x4 __attribute__((ext_vector_type(4)));
typedef unsigned u32x4 __attribute__((ext_vector_type(4)));
constexpr int BM = 256, BK = 64, HALF = 128, HTB = HALF * BK * 2  , STAGE_BYTES = 8 * HTB, NXCD = 8, WGM = 8;

__host__ __device__ __forceinline__ int lds_byte(int r, int c) { const int st = (r >> 4) * 2 + (c >> 5), rr = r & 15, cc = c & 31, ob = rr * 64 + cc * 2; return st * 1024 + (ob ^ (((ob >> 9) & 1) << 5)); }
__host__ __device__ __forceinline__ void stage_rc(int b, int& R, int& C) { const int st = b / 1024, sb = b % 1024, swz = sb ^ (((sb >> 9) & 1) << 5); R = (st >> 1) * 16 + swz / 64; C = (st & 1) * 32 + (swz % 64) / 2; }
__host__ __device__ __forceinline__ int perm32(int rho) { const int n = rho >> 4, i = rho & 15; return 8 * (i >> 2) + 4 * n + (i & 3); }

struct Unit { int pm, pn; };
struct Gemm { const bf16_t* A; const bf16_t* Bt; int M, N, K; };

struct StaticOrder {
    int nM, nN, nwg, G, c;
    __host__ __device__ void init(int M, int N, int G_, int c_) { nM = M / BM; nN = N / BM; nwg = nM * nN; G = G_; c = c_; }
    __host__ __device__ bool next(int i, Unit& u) const {
        const long L = (long)i * G + c; if (L >= nwg) return false;
        int wgid = (int)L; { const int q = nwg / NXCD, r = nwg % NXCD, xcd = wgid % NXCD, off = wgid / NXCD; wgid = (xcd < r ? xcd * (q + 1) : r * (q + 1) + (xcd - r) * q) + off; }
        const int nig = WGM * nN, gid = wgid / nig, fm = gid * WGM, gsz = (nM - fm) < WGM ? (nM - fm) : WGM;
        u.pm = fm + ((wgid % nig) % gsz); u.pn = (wgid % nig) / gsz; return true;
    }
    __device__ __forceinline__ void a_ready(const Unit&) const {}
    __device__ __forceinline__ void done(const Unit&) const {}
};

__device__ __forceinline__ unsigned cvt_pk_bf16(float lo, float hi) { unsigned r; asm volatile("v_cvt_pk_bf16_f32 %0, %1, %2" : "=v"(r) : "v"(lo), "v"(hi)); return r; }
typedef float f32x2 __attribute__((ext_vector_type(2)));
__device__ __forceinline__ f32x2 gelu_pk(f32x2 v) {
    const f32x2 av = __builtin_elementwise_abs(v), d = av * 0.2316418882f + 1.0f;
    f32x2 t; t.x = __builtin_amdgcn_rcpf(d.x); t.y = __builtin_amdgcn_rcpf(d.y);
    f32x2 q = t * 0.5307027145f + (-0.7265760135f); q = q * t + 0.7107068705f; q = q * t + (-0.142248368f); q = q * t + 0.127414796f; q = q * t;
    const f32x2 s = (v * v) * (-0.72134752044f);
    f32x2 e; e.x = __builtin_amdgcn_exp2f(s.x); e.y = __builtin_amdgcn_exp2f(s.y);
    const f32x2 m = v * (q * e), r = v - m;
    f32x2 o; o.x = v.x < 0.f ? m.x : r.x; o.y = v.y < 0.f ? m.y : r.y; return o;
}
template <int ACT  > struct EpiBf16 {
    static constexpr bool PERM = true, AFTER_DRAIN = false; static_assert(ACT == 0 || ACT == 1, "EpiBf16: ACT is 0 (none) or 1 (gelu_pk)");
    bf16_t* O; int ldc; const float* bias; int split_cols; size_t split_stride; float scale0;
    __device__ __forceinline__ void operator()(const f32x4 (&acc)[2][2][4][2], const Unit& u, int wr, int wc, int fr, int fq) const {
        const int row0 = u.pm * BM + wr * 64 + fr; int colt = u.pn * BM; bf16_t* base = O;
        float sc = 1.f; if (split_cols) { const int t = colt / split_cols; base += (size_t)t * split_stride; colt -= t * split_cols; if (t == 0) sc = scale0; }
        const int col0 = colt + wc * 32 + 8 * fq, bcol0 = u.pn * BM + wc * 32 + 8 * fq;
        f32x4 bv[2][2];
#pragma unroll
        for (int bj = 0; bj < 2; ++bj)
#pragma unroll
            for (int n = 0; n < 2; ++n) bv[bj][n] = bias ? *(const f32x4*)(bias + bcol0 + bj * HALF + 4 * n) : (f32x4){0.f, 0.f, 0.f, 0.f};
#pragma unroll
        for (int ai = 0; ai < 2; ++ai)
#pragma unroll
            for (int m = 0; m < 4; ++m) { bf16_t* rowp = base + (size_t)(row0 + ai * HALF + m * 16) * ldc + col0;
#pragma unroll
                for (int bj = 0; bj < 2; ++bj) { f32x4 v0 = acc[ai][bj][m][0] + bv[bj][0], v1 = acc[ai][bj][m][1] + bv[bj][1];
                    if (ACT == 1) { f32x2 a = gelu_pk((f32x2){v0[0], v0[1]}), b = gelu_pk((f32x2){v0[2], v0[3]}), c = gelu_pk((f32x2){v1[0], v1[1]}), d = gelu_pk((f32x2){v1[2], v1[3]});
                        v0 = (f32x4){a.x, a.y, b.x, b.y}; v1 = (f32x4){c.x, c.y, d.x, d.y}; }
                    v0 = v0 * sc; v1 = v1 * sc; u32x4 w; w.x = cvt_pk_bf16(v0[0], v0[1]); w.y = cvt_pk_bf16(v0[2], v0[3]); w.z = cvt_pk_bf16(v1[0], v1[1]); w.w = cvt_pk_bf16(v1[2], v1[3]);
                    *(u32x4*)(rowp + bj * HALF) = w; } }
    }
};
template <class Epi, class Sched, bool ALIGN_EPI = false, bool SP2 = false>
__device__ __forceinline__ void gemm_phase(PG8_LAS unsigned char* lds, const Gemm g, const Sched& S, const Epi& E) {
    const int tid = threadIdx.x, wid = __builtin_amdgcn_readfirstlane(tid >> 6), lane = tid & 63, wr = wid >> 2, wc = wid & 3, fr = lane & 15, fq = lane >> 4;
    const int K = g.K, nt = K / BK;
    unsigned voffA[2], voffB[2];
#pragma unroll
    for (int i = 0; i < 2; ++i) { int R, C; stage_rc(tid * 16 + i * 8192, R, C); const int Rb = Epi::PERM ? ((R & ~31) + perm32(R & 31)) : R;
        voffA[i] = (unsigned)(R * K + C) * 2u; voffB[i] = (unsigned)(Rb * K + C) * 2u; }
    const size_t kstep = (size_t)(BK * 2);
    const size_t hstep = (size_t)HALF * K * 2;
    const size_t tstep = 2 * hstep;
    const unsigned ldsw = (unsigned)wid * 1024u;
    const int aoff = lds_byte(wr * 64 + fr, fq * 8), boff = lds_byte(wc * 32 + fr, fq * 8);
#define PG8_SA(b, h) (((b) * 2 + (h)) * HTB)
#define PG8_SB(b, h) ((4 + (b) * 2 + (h)) * HTB)
#define PG8_STAGE(bufoff, gbase, voff) do { _Pragma("unroll") for (int _i = 0; _i < 2; ++_i) \
        __builtin_amdgcn_global_load_lds((const unsigned*)((const char*)(gbase) + (voff)[_i]), (PG8_LAS unsigned*)(lds + (bufoff) + ldsw + _i * 8192), 16, 0, 0); } while (0)
#define PG8_LDA(dst, b, h) do { _Pragma("unroll") for (int m = 0; m < 4; ++m) _Pragma("unroll") for (int k = 0; k < 2; ++k) dst[m][k] = *(const PG8_LAS bf16x8*)(lds + PG8_SA(b, h) + aoff + m * 2048 + k * 1024); } while (0)
#define PG8_LDB(dst, b, h) do { _Pragma("unroll") for (int n = 0; n < 2; ++n) _Pragma("unroll") for (int k = 0; k < 2; ++k) dst[n][k] = *(const PG8_LAS bf16x8*)(lds + PG8_SB(b, h) + boff + n * 2048 + k * 1024); } while (0)
#define PG8_MMA(ai, bj, At, Bt) do { __builtin_amdgcn_s_setprio(1); _Pragma("unroll") for (int m = 0; m < 4; ++m) _Pragma("unroll") for (int n = 0; n < 2; ++n) _Pragma("unroll") for (int k = 0; k < 2; ++k) \
        acc[ai][bj][m][n] = __builtin_amdgcn_mfma_f32_16x16x32_bf16(Bt[n][k], At[m][k], acc[ai][bj][m][n], 0, 0, 0); __builtin_amdgcn_s_setprio(0); } while (0)
#define PG8_WAIT_V(n) asm volatile("s_waitcnt vmcnt(" #n ")" ::: "memory")
#define PG8_WAIT_L(n) asm volatile("s_waitcnt lgkmcnt(" #n ")" ::: "memory")
#define PG8_BAR __builtin_amdgcn_s_barrier()
#define PG8_SCHED __builtin_amdgcn_sched_barrier(0)
    Unit cur, nxt; int ui = 0;
    if (!S.next(0, cur)) return;
    f32x4 acc[2][2][4][2];
#pragma unroll
    for (int a = 0; a < 2; ++a)
#pragma unroll
        for (int b = 0; b < 2; ++b)
#pragma unroll
            for (int m = 0; m < 4; ++m)
#pragma unroll
                for (int n = 0; n < 2; ++n) acc[a][b][m][n] = (f32x4){0.f, 0.f, 0.f, 0.f};
    bf16x8 At[4][2], B0[2][2], B1[2][2];
    const char* cA = (const char*)g.A + (size_t)cur.pm * tstep; const char* cB = (const char*)g.Bt + (size_t)cur.pn * tstep;
    S.a_ready(cur);
    if constexpr (SP2) {
        PG8_STAGE(PG8_SB(0, 0), cB, voffB); PG8_STAGE(PG8_SB(0, 1), cB + hstep, voffB); PG8_STAGE(PG8_SA(0, 0), cA, voffA); PG8_STAGE(PG8_SA(0, 1), cA + hstep, voffA);
        if (wr == 1) PG8_BAR;
        PG8_WAIT_V(2); PG8_BAR;
        PG8_STAGE(PG8_SB(1, 0), cB + kstep, voffB); PG8_STAGE(PG8_SA(1, 0), cA + kstep, voffA); PG8_STAGE(PG8_SB(1, 1), cB + hstep + kstep, voffB);
        PG8_WAIT_V(6); PG8_BAR;
    } else {
        PG8_STAGE(PG8_SB(0, 0), cB, voffB); PG8_STAGE(PG8_SA(0, 0), cA, voffA); PG8_STAGE(PG8_SB(0, 1), cB + hstep, voffB); PG8_STAGE(PG8_SA(0, 1), cA + hstep, voffA);
        if (wr == 1) PG8_BAR;
        PG8_WAIT_V(4); PG8_BAR;
        PG8_STAGE(PG8_SB(1, 0), cB + kstep, voffB); PG8_STAGE(PG8_SA(1, 0), cA + kstep, voffA); PG8_STAGE(PG8_SB(1, 1), cB + hstep + kstep, voffB);
        PG8_WAIT_V(6); PG8_BAR;
    }
    for (;;) {
        const bool has_next = S.next(ui + 1, nxt);
        const char* nA = has_next ? (const char*)g.A + (size_t)nxt.pm * tstep : cA; const char* nB = has_next ? (const char*)g.Bt + (size_t)nxt.pn * tstep : cB;
        for (int t = 0; t < nt; t += 2) {
            const bool last = (t == nt - 2);
            const char* a1 = cA + (size_t)(t + 1) * kstep;
            const char* a2 = last ? nA : cA + (size_t)(t + 2) * kstep; const char* b2 = last ? nB : cB + (size_t)(t + 2) * kstep;
            const char* a3 = a2 + kstep; const char* b3 = b2 + kstep;
            if (last && has_next) S.a_ready(nxt);
            if constexpr (SP2) {
            PG8_LDB(B0, 0, 0); PG8_LDB(B1, 0, 1); PG8_SCHED; PG8_LDA(At, 0, 0); PG8_STAGE(PG8_SA(1, 1), a1 + hstep, voffA);
            PG8_WAIT_V(8); PG8_WAIT_L(0); PG8_BAR; PG8_MMA(0, 0, At, B0); PG8_MMA(0, 1, At, B1); PG8_BAR; PG8_SCHED;
            PG8_LDA(At, 0, 1); PG8_STAGE(PG8_SB(0, 0), b2, voffB); PG8_STAGE(PG8_SB(0, 1), b2 + hstep, voffB); PG8_STAGE(PG8_SA(0, 0), a2, voffA);
            PG8_WAIT_V(8); PG8_WAIT_L(0); PG8_BAR; PG8_MMA(1, 0, At, B0); PG8_MMA(1, 1, At, B1); PG8_BAR; PG8_SCHED;
            PG8_LDB(B0, 1, 0); PG8_LDB(B1, 1, 1); PG8_SCHED; PG8_LDA(At, 1, 0); PG8_STAGE(PG8_SA(0, 1), a2 + hstep, voffA);
            PG8_WAIT_V(8); PG8_WAIT_L(0); PG8_BAR; PG8_MMA(0, 0, At, B0); PG8_MMA(0, 1, At, B1); PG8_BAR; PG8_SCHED;
            PG8_LDA(At, 1, 1); PG8_STAGE(PG8_SB(1, 0), b3, voffB); PG8_STAGE(PG8_SB(1, 1), b3 + hstep, voffB); PG8_STAGE(PG8_SA(1, 0), a3, voffA);
            PG8_WAIT_V(8); PG8_WAIT_L(0); PG8_BAR; PG8_MMA(1, 0, At, B0); PG8_MMA(1, 1, At, B1); PG8_BAR; PG8_SCHED;
            } else {
            PG8_LDB(B0, 0, 0); PG8_SCHED; PG8_LDA(At, 0, 0); PG8_STAGE(PG8_SA(1, 1), a1 + hstep, voffA);
            PG8_WAIT_L(8); PG8_BAR; PG8_WAIT_L(0); PG8_MMA(0, 0, At, B0); PG8_BAR; PG8_SCHED;
            PG8_LDB(B1, 0, 1); PG8_STAGE(PG8_SB(0, 0), b2, voffB);
            PG8_BAR; PG8_WAIT_L(0); PG8_MMA(0, 1, At, B1); PG8_BAR;
            PG8_LDA(At, 0, 1); PG8_STAGE(PG8_SA(0, 0), a2, voffA);
            PG8_BAR; PG8_WAIT_L(0); PG8_MMA(1, 0, At, B0); PG8_BAR; PG8_SCHED;
            PG8_STAGE(PG8_SB(0, 1), b2 + hstep, voffB);
            PG8_WAIT_V(6); PG8_BAR; PG8_MMA(1, 1, At, B1); PG8_BAR;
            PG8_LDB(B0, 1, 0); PG8_SCHED; PG8_LDA(At, 1, 0); PG8_STAGE(PG8_SA(0, 1), a2 + hstep, voffA);
            PG8_WAIT_L(8); PG8_BAR; PG8_WAIT_L(0); PG8_MMA(0, 0, At, B0); PG8_BAR; PG8_SCHED;
            PG8_LDB(B1, 1, 1); PG8_STAGE(PG8_SB(1, 0), b3, voffB);
            PG8_BAR; PG8_WAIT_L(0); PG8_MMA(0, 1, At, B1); PG8_BAR;
            PG8_LDA(At, 1, 1); PG8_STAGE(PG8_SA(1, 0), a3, voffA);
            PG8_BAR; PG8_WAIT_L(0); PG8_MMA(1, 0, At, B0); PG8_BAR; PG8_SCHED;
            PG8_STAGE(PG8_SB(1, 1), b3 + hstep, voffB);
            PG8_WAIT_V(6); PG8_BAR; PG8_MMA(1, 1, At, B1); PG8_BAR;
            }
        }
        if constexpr (ALIGN_EPI) { if (wr == 0) PG8_BAR; }
        if constexpr (!Epi::AFTER_DRAIN) { E(acc, cur, wr, wc, fr, fq); S.done(cur); }
        if (!has_next) break;
#pragma unroll
        for (int a = 0; a < 2; ++a)
#pragma unroll
            for (int b = 0; b < 2; ++b)
#pragma unroll
                for (int m = 0; m < 4; ++m)
#pragma unroll
                    for (int n = 0; n < 2; ++n) acc[a][b][m][n] = (f32x4){0.f, 0.f, 0.f, 0.f};
        cur = nxt; cA = nA; cB = nB; ++ui;
        if constexpr (ALIGN_EPI) { if (wr == 1) PG8_BAR; }
    }
    PG8_WAIT_V(0);
    if constexpr (!ALIGN_EPI) { if (wr == 0) PG8_BAR; }
    PG8_BAR;
    if constexpr (Epi::AFTER_DRAIN) { E.fused(acc, cur, wr, wc, fr, fq, lds, wid, lane); S.done(cur); }
#undef PG8_SA
#undef PG8_SB
#undef PG8_STAGE
#undef PG8_LDA
#undef PG8_LDB
#undef PG8_MMA
#undef PG8_WAIT_V
#undef PG8_WAIT_L
#undef PG8_BAR
#undef PG8_SCHED
}

struct EpiResF32 {
    static constexpr bool PERM = false, AFTER_DRAIN = false;
    const float* base; float* out; int ldc;
    __device__ __forceinline__ void operator()(const f32x4 (&acc)[2][2][4][2], const Unit& u, int wr, int wc, int fr, int fq) const {
        const int col0 = u.pn * BM + wc * 32 + 4 * fq;
#pragma unroll
        for (int ai = 0; ai < 2; ++ai)
#pragma unroll
            for (int m = 0; m < 4; ++m) { const int r = ai * HALF + wr * 64 + m * 16 + fr; const size_t off = (size_t)(u.pm * BM + r) * ldc + col0;
#pragma unroll
                for (int bj = 0; bj < 2; ++bj)
#pragma unroll
                    for (int n = 0; n < 2; ++n) { const f32x4 bs = *(const f32x4*)(base + off + bj * HALF + n * 16); *(f32x4*)(out + off + bj * HALF + n * 16) = bs + acc[ai][bj][m][n]; } }
    }
};
}

constexpr int BATCH = 4, SEQ = 8192, DM = 1024, M = BATCH * SEQ;
constexpr int NIN = 3088, NIN_PAD = 3328;
constexpr int C_GQ = 0, C_GK = 256, C_GV = 512, C_GG = 1024, C_AQ = 1536, C_AK = 2048, C_AV = 2560, C_GLR = 3072;
constexpr int NEXP = 16384;
constexpr float NORM_EPS = 1e-6f;
constexpr int NWAVES = 8, NTHREADS = 512;

constexpr size_t MiB = 1u << 20;
constexpr size_t WS_CTL = 0, CTL_ZERO_BYTES = 1 * MiB;
constexpr size_t WS_WT_IN = 1 * MiB;
constexpr size_t WS_WT_OUT = 8 * MiB;
constexpr size_t WS_WT_CIN = 10 * MiB;
constexpr size_t WS_WT_COUT = 14 * MiB;
constexpr size_t WS_WT_Q0 = 16 * MiB;
constexpr size_t WS_WT_Q1 = 20 * MiB;
constexpr size_t WS_ACT = 32 * MiB;
constexpr size_t WS_S = 96 * MiB;
constexpr size_t WS_PROJ = WS_S;
constexpr size_t WS_GLAO = WS_S + 208 * MiB;
constexpr size_t WS_TOPS = WS_S + 128 * MiB;
constexpr size_t WS_TOPI = WS_S + 160 * MiB;
constexpr size_t WS_IDS = WS_S + 192 * MiB;
constexpr size_t WS_G = WS_S + 208 * MiB;
constexpr size_t WS_XC = WS_ACT;
constexpr size_t WS_A = WS_S + 128 * MiB;
constexpr size_t WS_U = WS_S + 256 * MiB;
constexpr size_t WS_TAB = 448 * MiB;
constexpr size_t WS_TAB8 = 448 * MiB;
constexpr size_t WS_WG = 24 * MiB;
constexpr size_t WS_AGG = WS_S + 128 * MiB;
constexpr size_t WS_SCL = 26 * MiB;
constexpr size_t WS_END = 512 * MiB;
constexpr int CW_BAR = 4096;

constexpr int RING_BYTES = 131072;
constexpr int LDS_BYTES = 147456;
constexpr int LDSCTL_OFF = LDS_BYTES - 512, MISC_OFF = LDSCTL_OFF + 320;

#define LAS __attribute__((address_space(3)))
#define GAS __attribute__((address_space(1)))
typedef unsigned short bf16_t;
typedef float f32x4 __attribute__((ext_vector_type(4)));
typedef unsigned u32x4 __attribute__((ext_vector_type(4)));
typedef unsigned u32x2 __attribute__((ext_vector_type(2)));
typedef short bf16x8 __attribute__((ext_vector_type(8)));

struct Params {
    const float *x, *mix_norm, *ffn_norm, *ab_w_in, *gla_w_alpha, *gla_b_alpha, *gla_head_gain, *ab_w_out;
    const float *c_w_in, *c_conv_w, *c_conv_b, *c_w_rgate, *c_b_rgate, *c_w_igate, *c_b_igate, *c_lambda, *c_w_out;
    const float *peer_w_query, *peer_sub_keys, *peer_u, *peer_v, *final_norm;
    float* out; unsigned char* ws;
    int ph_lo, ph_hi;
};

__device__ __forceinline__ unsigned f2bf(float f) { unsigned u = __builtin_bit_cast(unsigned, f); return (u + 0x7fffu + ((u >> 16) & 1u)) >> 16; }
__device__ __forceinline__ unsigned pk2(float lo, float hi) { return f2bf(lo) | (f2bf(hi) << 16); }
__device__ __forceinline__ float bf2f(bf16_t b) { return __builtin_bit_cast(float, (unsigned)b << 16); }
__device__ __forceinline__ float bflo(unsigned w) { return __builtin_bit_cast(float, w << 16); }
__device__ __forceinline__ float bfhi(unsigned w) { return __builtin_bit_cast(float, w & 0xffff0000u); }
__device__ __forceinline__ float wave_sum(float v) {
#pragma unroll
    for (int o = 1; o < 64; o <<= 1) v += __shfl_xor(v, o);
    return v;
}
__device__ __forceinline__ float gelu_tanh(float x) {
    const float u = 0.7978845608028654f * (x + 0.044715f * x * x * x);
    const float e = __expf(2.f * u);
    const float th = 1.f - 2.f / (e + 1.f);
    return 0.5f * x * (1.f + th);
}
__device__ __forceinline__ float sigmoidf_(float x) { return 1.f / (1.f + __expf(-x)); }

struct Ctx { int tid, lane, wave, blk, nblk, gtid, gthreads, gwave, gwaves; LAS unsigned char* lds; };

template <class F> __device__ __forceinline__ void transpose_cvt(const float* W, int K, int Nsrc, bf16_t* WT, int Ndst, F srcmap, int gtid, int gthreads) {
    const int total = (K / 8) * Ndst;
    for (int idx = gtid; idx < total; idx += gthreads) {
        const int ko = idx / Ndst, n = idx - ko * Ndst; const int sn = srcmap(n);
        u32x4 w = {0u, 0u, 0u, 0u};
        if (sn >= 0) { const float* s = W + (size_t)(ko * 8) * Nsrc + sn;
            w.x = pk2(s[0], s[(size_t)Nsrc]); w.y = pk2(s[2 * (size_t)Nsrc], s[3 * (size_t)Nsrc]); w.z = pk2(s[4 * (size_t)Nsrc], s[5 * (size_t)Nsrc]); w.w = pk2(s[6 * (size_t)Nsrc], s[7 * (size_t)Nsrc]); }
        *(u32x4*)(WT + (size_t)n * K + ko * 8) = w;
    }
}
__device__ __forceinline__ void cvt_bf16(const float* src, bf16_t* dst, size_t n8, int gtid, int gthreads) {
    for (size_t i = gtid; i < n8; i += gthreads) { const f32x4 a = *(const f32x4*)(src + i * 8), b = *(const f32x4*)(src + i * 8 + 4);
        u32x4 w; w.x = pk2(a.x, a.y); w.y = pk2(a.z, a.w); w.z = pk2(b.x, b.y); w.w = pk2(b.z, b.w); *(u32x4*)(dst + i * 8) = w; }
}
__device__ __forceinline__ void norm_rows_bf16(const float* src, const float* gain, bf16_t* dst, const Ctx& c) {
    for (int m = c.gwave; m < M; m += c.gwaves) {
        const f32x4* xr = (const f32x4*)(src + (size_t)m * DM) + c.lane; f32x4 v[4]; float s = 0.f;
#pragma unroll
        for (int j = 0; j < 4; ++j) { v[j] = xr[64 * j]; s += (v[j].x * v[j].x + v[j].y * v[j].y) + (v[j].z * v[j].z + v[j].w * v[j].w); }
        const float rstd = 1.f / sqrtf(wave_sum(s) * (1.f / DM) + NORM_EPS);
        u32x2* o8 = (u32x2*)(dst + (size_t)m * DM) + c.lane;
#pragma unroll
        for (int j = 0; j < 4; ++j) { const f32x4 g = *((const f32x4*)gain + 64 * j + c.lane); u32x2 w; w.x = pk2(v[j].x * rstd * g.x, v[j].y * rstd * g.y); w.y = pk2(v[j].z * rstd * g.z, v[j].w * rstd * g.w); o8[64 * j] = w; }
    }
}
__device__ __forceinline__ void norm_rows_f32(float* buf, const float* gain, const Ctx& c) {
    for (int m = c.gwave; m < M; m += c.gwaves) {
        f32x4* xr = (f32x4*)(buf + (size_t)m * DM) + c.lane; f32x4 v[4]; float s = 0.f;
#pragma unroll
        for (int j = 0; j < 4; ++j) { v[j] = xr[64 * j]; s += (v[j].x * v[j].x + v[j].y * v[j].y) + (v[j].z * v[j].z + v[j].w * v[j].w); }
        const float rstd = 1.f / sqrtf(wave_sum(s) * (1.f / DM) + NORM_EPS);
#pragma unroll
        for (int j = 0; j < 4; ++j) { const f32x4 g = *((const f32x4*)gain + 64 * j + c.lane); xr[64 * j] = v[j] * rstd * g; }
    }
}

__device__ __forceinline__ void ph_gla_naive(const Params& p, const Ctx& c) {
    const int b = c.blk >> 2, h = c.blk & 3;
    LAS float* sq = (LAS float*)c.lds; LAS float* sk = sq + 4096; LAS float* sa = sk + 4096; LAS float* sv = sa + 4096;
    const bf16_t* proj = (const bf16_t*)(p.ws + WS_PROJ);
    float* go = (float*)(p.ws + WS_GLAO);
    const int tid = c.tid, v = tid >> 2, kq = tid & 3;
    float S[16];
#pragma unroll
    for (int i = 0; i < 16; ++i) S[i] = 0.f;
    for (int t0 = 0; t0 < SEQ; t0 += 64) {
        __syncthreads();
        for (int e = tid; e < 4096; e += NTHREADS) { const int tt = e >> 6, kk = e & 63; const bf16_t* pr = proj + (size_t)(b * SEQ + t0 + tt) * NIN_PAD;
            sq[e] = bf2f(pr[C_GQ + h * 64 + kk]); sk[e] = bf2f(pr[C_GK + h * 64 + kk]);
            float z = p.gla_b_alpha[h * 64 + kk];
#pragma unroll
            for (int r = 0; r < 16; ++r) z += bf2f(pr[C_GLR + r]) * p.gla_w_alpha[r * 256 + h * 64 + kk];
            const float ls = fminf(z, 0.f) - log1pf(expf(-fabsf(z)));
            sa[e] = expf(ls * (1.f / 16.f)); }
        for (int e = tid; e < 8192; e += NTHREADS) { const int tt = e >> 7, vv = e & 127; sv[e] = bf2f(proj[(size_t)(b * SEQ + t0 + tt) * NIN_PAD + C_GV + h * 128 + vv]); }
        __syncthreads();
        for (int tt = 0; tt < 64; ++tt) {
            const float vv = sv[tt * 128 + v]; float part = 0.f;
#pragma unroll
            for (int i = 0; i < 16; ++i) { const int kk = kq * 16 + i; S[i] = sa[tt * 64 + kk] * S[i] + sk[tt * 64 + kk] * vv; part += sq[tt * 64 + kk] * S[i]; }
            part += __shfl_xor(part, 1); part += __shfl_xor(part, 2);
            if (kq == 0) go[(size_t)(b * SEQ + t0 + tt) * 512 + h * 128 + v] = part * 0.125f;
        }
    }
}
__device__ __forceinline__ void ph_attn_naive(const Params& p, int gtid, int gthreads) {
    const bf16_t* proj = (const bf16_t*)(p.ws + WS_PROJ); bf16_t* mixed = (bf16_t*)(p.ws + WS_ACT);
    for (int idx = gtid; idx < M * 8; idx += gthreads) {
        const int t = idx & 8191, h = (idx >> 13) & 7, b = idx >> 16;
        const size_t row = (size_t)b * SEQ + t;
        float q[64], o[64];
        { const u32x4* qp = (const u32x4*)(proj + row * NIN_PAD + C_AQ + h * 64);
#pragma unroll
          for (int i = 0; i < 8; ++i) { const u32x4 w = qp[i]; q[8*i] = bflo(w.x); q[8*i+1] = bfhi(w.x); q[8*i+2] = bflo(w.y); q[8*i+3] = bfhi(w.y); q[8*i+4] = bflo(w.z); q[8*i+5] = bfhi(w.z); q[8*i+6] = bflo(w.w); q[8*i+7] = bfhi(w.w); } }
#pragma unroll
        for (int d = 0; d < 64; ++d) o[d] = 0.f;
        float mx = -1e30f, l = 0.f;
        const float slope = exp2f(-(float)(h + 1));
        for (int br = 0; br < 3; ++br) { const int dil = 1 << (2 * br);
            for (int j = 0; j <= 128; ++j) { const int tk = t - j * dil; if (tk < 0) break;
                const u32x4* kp = (const u32x4*)(proj + ((size_t)b * SEQ + tk) * NIN_PAD + C_AK + h * 64); const u32x4* vp = kp + 64;
                float s = 0.f;
#pragma unroll
                for (int i = 0; i < 8; ++i) { const u32x4 w = kp[i]; s += q[8*i] * bflo(w.x) + q[8*i+1] * bfhi(w.x) + q[8*i+2] * bflo(w.y) + q[8*i+3] * bfhi(w.y) + q[8*i+4] * bflo(w.z) + q[8*i+5] * bfhi(w.z) + q[8*i+6] * bflo(w.w) + q[8*i+7] * bfhi(w.w); }
                s = s * 0.125f - slope * (float)(j * dil);
                const float mn = fmaxf(mx, s), corr = __expf(mx - mn), pp = __expf(s - mn);
                l = l * corr + pp; mx = mn;
#pragma unroll
                for (int i = 0; i < 8; ++i) { const u32x4 w = vp[i];
                    o[8*i] = o[8*i] * corr + pp * bflo(w.x); o[8*i+1] = o[8*i+1] * corr + pp * bfhi(w.x); o[8*i+2] = o[8*i+2] * corr + pp * bflo(w.y); o[8*i+3] = o[8*i+3] * corr + pp * bfhi(w.y);
                    o[8*i+4] = o[8*i+4] * corr + pp * bflo(w.z); o[8*i+5] = o[8*i+5] * corr + pp * bfhi(w.z); o[8*i+6] = o[8*i+6] * corr + pp * bflo(w.w); o[8*i+7] = o[8*i+7] * corr + pp * bfhi(w.w); }
            } }
        const float rl = 1.f / l;
        u32x4* op = (u32x4*)(mixed + row * DM + 512 + h * 64);
#pragma unroll
        for (int i = 0; i < 8; ++i) { u32x4 w; w.x = pk2(o[8*i] * rl, o[8*i+1] * rl); w.y = pk2(o[8*i+2] * rl, o[8*i+3] * rl); w.z = pk2(o[8*i+4] * rl, o[8*i+5] * rl); w.w = pk2(o[8*i+6] * rl, o[8*i+7] * rl); op[i] = w; }
    }
}

constexpr int AT_K = 0, AT_V = 272 * 144, AT_END = 2 * 272 * 144;
typedef short s16x4 __attribute__((ext_vector_type(4)));
__device__ __forceinline__ s16x4 lds_tr16(LAS const unsigned char* pbyte) { return __builtin_bit_cast(s16x4, __builtin_amdgcn_ds_read_tr16_b64_v4i16((LAS s16x4*)pbyte)); }
__device__ __forceinline__ void ph_attn(const Params& p, const Ctx& c) {
    LAS unsigned char* L = c.lds;
    const bf16_t* proj = (const bf16_t*)(p.ws + WS_PROJ); bf16_t* AO = (bf16_t*)p.out; float* LSE = (float*)((unsigned char*)p.out + 96 * MiB);
    const int tid = c.tid, lane = c.lane, w = c.wave, r = lane & 15, qq = lane >> 4;
    constexpr float LOG2E = 1.4426950408889634f;
    __syncthreads();
    for (int i = tid; i < 16 * 144 / 4; i += NTHREADS) ((LAS unsigned*)(L + AT_V + 256 * 144))[i] = 0u;
    for (int item = c.blk; item < 6144; item += c.nblk) {
        const int h = item & 7, rest = item >> 3, br = rest >> 8, u = rest & 255, sh = 2 * br, dil = 1 << sh, nbm = (64 >> sh) - 1;
        const int bres = u >> (6 - sh), blk = u & nbm, b = bres >> sh, res = bres & (dil - 1);
        const size_t rowb = (size_t)b * SEQ; const int l0 = blk * 128;
        __syncthreads();
#pragma unroll
        for (int k = 0; k < 4; ++k) { const int idx = tid + NTHREADS * k, row = idx >> 3, ch = idx & 7, l = l0 - 128 + row;
            u32x4 kv = {0u, 0u, 0u, 0u}, vv = {0u, 0u, 0u, 0u};
            if (l >= 0) { const bf16_t* src = proj + (rowb + (size_t)l * dil + res) * NIN_PAD + C_AK + h * 64 + ch * 8; kv = *(const u32x4*)src; vv = *(const u32x4*)(src + 512); }
            *(LAS u32x4*)(L + AT_K + row * 144 + ch * 16) = kv; *(LAS u32x4*)(L + AT_V + row * 144 + ch * 16) = vv; }
        bf16x8 qf[2];
        { const bf16_t* qp = proj + (rowb + (size_t)(l0 + 16 * w + r) * dil + res) * NIN_PAD + C_AQ + h * 64 + 8 * qq;
          qf[0] = __builtin_bit_cast(bf16x8, *(const u32x4*)qp); qf[1] = __builtin_bit_cast(bf16x8, *(const u32x4*)(qp + 32)); }
        __syncthreads();
        f32x4 sa[9];
#pragma unroll
        for (int jn = 0; jn < 9; ++jn) { LAS const unsigned char* kp = L + AT_K + (16 * (w + jn) + r) * 144 + 16 * qq;
            const bf16x8 k0 = __builtin_bit_cast(bf16x8, *(const LAS u32x4*)kp), k1 = __builtin_bit_cast(bf16x8, *(const LAS u32x4*)(kp + 64));
            f32x4 z = {0.f, 0.f, 0.f, 0.f}; z = __builtin_amdgcn_mfma_f32_16x16x32_bf16(k0, qf[0], z, 0, 0, 0); sa[jn] = __builtin_amdgcn_mfma_f32_16x16x32_bf16(k1, qf[1], z, 0, 0, 0); }
        const float sc = 0.125f * LOG2E, sl = exp2f(-(float)(h + 1)) * (float)dil * LOG2E;
        float mx = -1e30f;
#pragma unroll
        for (int jn = 0; jn < 9; ++jn)
#pragma unroll
            for (int i = 0; i < 4; ++i) { const int delta = r + 128 - 16 * jn - 4 * qq - i, kj = 16 * (w + jn) + 4 * qq + i;
                const bool valid = (delta >= 0) && (delta <= 128) && (blk > 0 || kj >= 128);
                const float v = valid ? sa[jn][i] * sc - sl * (float)delta : -1e30f; sa[jn][i] = v; mx = fmaxf(mx, v); }
        mx = fmaxf(mx, __shfl_xor(mx, 16)); mx = fmaxf(mx, __shfl_xor(mx, 32));
        float sum = 0.f;
#pragma unroll
        for (int jn = 0; jn < 9; ++jn)
#pragma unroll
            for (int i = 0; i < 4; ++i) { const float e = __builtin_amdgcn_exp2f(sa[jn][i] - mx); sa[jn][i] = e; sum += e; }
        sum += __shfl_xor(sum, 16); sum += __shfl_xor(sum, 32);
        { const int qi = 16 * w + r; if (qq == 0) LSE[((size_t)br * M + rowb + (size_t)(l0 + qi) * dil + res) * 8 + h] = (mx + __builtin_amdgcn_logf(sum)) * (1.f / LOG2E); }
        f32x4 oa[4];
#pragma unroll
        for (int dt = 0; dt < 4; ++dt) oa[dt] = (f32x4){0.f, 0.f, 0.f, 0.f};
#pragma unroll
        for (int s2 = 0; s2 < 5; ++s2) { u32x4 pw; pw.x = pk2(sa[2 * s2][0], sa[2 * s2][1]); pw.y = pk2(sa[2 * s2][2], sa[2 * s2][3]);
            if (s2 < 4) { pw.z = pk2(sa[2 * s2 + 1][0], sa[2 * s2 + 1][1]); pw.w = pk2(sa[2 * s2 + 1][2], sa[2 * s2 + 1][3]); } else { pw.z = 0u; pw.w = 0u; }
            LAS const unsigned char* vp = L + AT_V + (16 * (w + 2 * s2) + 4 * qq + (r >> 2)) * 144 + 8 * (r & 3);
#pragma unroll
            for (int dt = 0; dt < 4; ++dt) { const s16x4 v0 = lds_tr16(vp + 32 * dt), v1 = lds_tr16(vp + 32 * dt + 16 * 144);
                const bf16x8 vf = {v0[0], v0[1], v0[2], v0[3], v1[0], v1[1], v1[2], v1[3]};
                oa[dt] = __builtin_amdgcn_mfma_f32_16x16x32_bf16(__builtin_bit_cast(bf16x8, pw), vf, oa[dt], 0, 0, 0); } }
        const float rs = __builtin_amdgcn_rcpf(sum);
#pragma unroll
        for (int i = 0; i < 4; ++i) { const float ri = __shfl(rs, 4 * qq + i); const int qi = 16 * w + 4 * qq + i;
            bf16_t* op = AO + ((size_t)br * M + rowb + (size_t)(l0 + qi) * dil + res) * 512 + h * 64 + r;
#pragma unroll
            for (int dt = 0; dt < 4; ++dt) op[16 * dt] = (bf16_t)f2bf(oa[dt][i] * ri); }
    }
}

constexpr size_t WS_CKV = WS_S + 272 * MiB;
constexpr size_t WS_DEC = WS_S + 336 * MiB;
constexpr size_t WS_SPREV = WS_ACT;
constexpr int GL_SEGT = 0, GL_V = 2048, GL_KT = GL_V + 64 * 272, GL_QD = GL_KT + 64 * 144, GL_KI = GL_QD + 64 * 144, GL_END = GL_KI + 64 * 144;
__device__ __forceinline__ void gla_cumdecay(const Params& p, const Ctx& c, const bf16_t* prow0, int h, float (&bcum)[8], float& blast) {
    LAS float* SEGT = (LAS float*)(c.lds + GL_SEGT);
    const int kk = c.tid & 63, w = c.wave;
    float wa[16];
#pragma unroll
    for (int r = 0; r < 16; ++r) wa[r] = p.gla_w_alpha[r * 256 + h * 64 + kk];
    const float ba = p.gla_b_alpha[h * 64 + kk];
    float run = 0.f;
#pragma unroll
    for (int k = 0; k < 8; ++k) { const bf16_t* pr = prow0 + (size_t)(8 * w + k) * NIN_PAD + C_GLR;
        const u32x4 g0 = *(const u32x4*)pr, g1 = *(const u32x4*)(pr + 8);
        float z = ba + bflo(g0.x) * wa[0] + bfhi(g0.x) * wa[1] + bflo(g0.y) * wa[2] + bfhi(g0.y) * wa[3] + bflo(g0.z) * wa[4] + bfhi(g0.z) * wa[5] + bflo(g0.w) * wa[6] + bfhi(g0.w) * wa[7]
                     + bflo(g1.x) * wa[8] + bfhi(g1.x) * wa[9] + bflo(g1.y) * wa[10] + bfhi(g1.y) * wa[11] + bflo(g1.z) * wa[12] + bfhi(g1.z) * wa[13] + bflo(g1.w) * wa[14] + bfhi(g1.w) * wa[15];
        const float ls = fminf(z, 0.f) - __logf(1.f + __expf(-fabsf(z)));
        run += ls * (1.f / 16.f); bcum[k] = run; }
    __syncthreads();
    SEGT[w * 64 + kk] = run;
    __syncthreads();
    float off = 0.f, tot = 0.f;
#pragma unroll
    for (int sg = 0; sg < 8; ++sg) { const float v = SEGT[sg * 64 + kk]; off += (sg < w) ? v : 0.f; tot += v; }
#pragma unroll
    for (int k = 0; k < 8; ++k) bcum[k] += off;
    blast = tot;
}
__device__ __forceinline__ void gla_stage_v(const Ctx& c, const bf16_t* prow0, int h) {
#pragma unroll
    for (int k = 0; k < 2; ++k) { const int idx = c.tid + NTHREADS * k, row = idx >> 4, ch = idx & 15;
        *(LAS u32x4*)(c.lds + GL_V + row * 272 + ch * 16) = *(const u32x4*)(prow0 + (size_t)row * NIN_PAD + C_GV + h * 128 + ch * 8); }
}
__device__ __forceinline__ void ph_gla_a(const Params& p, const Ctx& c) {
    LAS unsigned char* L = c.lds; const bf16_t* proj = (const bf16_t*)(p.ws + WS_PROJ);
    float* CKV = (float*)(p.ws + WS_CKV); float* DEC = (float*)(p.ws + WS_DEC);
    const int tid = c.tid, lane = c.lane, w = c.wave, r = lane & 15, qq = lane >> 4, kk = tid & 63;
    for (int item = c.blk; item < 2048; item += c.nblk) {
        const int h = item & 3, bn = item >> 2; const bf16_t* prow0 = proj + (size_t)bn * 64 * NIN_PAD;
        float bcum[8], blast; gla_cumdecay(p, c, prow0, h, bcum, blast);
        gla_stage_v(c, prow0, h);
        { u32x4 o; float e[8];
#pragma unroll
          for (int k = 0; k < 8; ++k) e[k] = bf2f(prow0[(size_t)(8 * w + k) * NIN_PAD + C_GK + h * 64 + kk]) * __expf(blast - bcum[k]);
          o.x = pk2(e[0], e[1]); o.y = pk2(e[2], e[3]); o.z = pk2(e[4], e[5]); o.w = pk2(e[6], e[7]);
          *(LAS u32x4*)(L + GL_KT + kk * 144 + 16 * w) = o; }
        if (w == 0) DEC[(size_t)item * 64 + kk] = __expf(blast);
        __syncthreads();
        f32x4 acc[4];
#pragma unroll
        for (int n = 0; n < 4; ++n) acc[n] = (f32x4){0.f, 0.f, 0.f, 0.f};
#pragma unroll
        for (int s2 = 0; s2 < 2; ++s2) { LAS const unsigned char* vp = L + GL_V + (32 * s2 + 8 * qq + (r >> 2)) * 272 + (16 * w + 4 * (r & 3)) * 2;
            const s16x4 v0 = lds_tr16(vp), v1 = lds_tr16(vp + 4 * 272); const bf16x8 af = {v0[0], v0[1], v0[2], v0[3], v1[0], v1[1], v1[2], v1[3]};
#pragma unroll
            for (int n = 0; n < 4; ++n) { const bf16x8 bfr = __builtin_bit_cast(bf16x8, *(const LAS u32x4*)(L + GL_KT + (16 * n + r) * 144 + (32 * s2 + 8 * qq) * 2));
                acc[n] = __builtin_amdgcn_mfma_f32_16x16x32_bf16(af, bfr, acc[n], 0, 0, 0); } }
        float* outp = CKV + (size_t)item * 8192 + (16 * w + 4 * qq) * 64 + r;
#pragma unroll
        for (int n = 0; n < 4; ++n)
#pragma unroll
            for (int i = 0; i < 4; ++i) outp[i * 64 + 16 * n] = acc[n][i];
    }
}
__device__ __forceinline__ void ph_gla_b(const Params& p, const Ctx& c) {
    const float* CKV = (const float*)(p.ws + WS_CKV); const float* DEC = (const float*)(p.ws + WS_DEC); bf16_t* SP = (bf16_t*)(p.ws + WS_SPREV);
    for (int idx = c.gtid; idx < 16 * 8192; idx += c.gthreads) { const int bh = idx >> 13, e = idx & 8191, b = bh >> 2, h = bh & 3; float S = 0.f;
        for (int n0 = 0; n0 < 128; n0 += 8) { float cv[8], dv[8];
#pragma unroll
            for (int k = 0; k < 8; ++k) { const size_t item = (size_t)(b * 128 + n0 + k) * 4 + h; cv[k] = CKV[item * 8192 + e]; dv[k] = DEC[item * 64 + (e & 63)]; }
#pragma unroll
            for (int k = 0; k < 8; ++k) { const size_t item = (size_t)(b * 128 + n0 + k) * 4 + h; SP[item * 8192 + e] = (bf16_t)f2bf(S); S = dv[k] * S + cv[k]; } } }
}
__device__ __forceinline__ void ph_gla_c(const Params& p, const Ctx& c) {
    LAS unsigned char* L = c.lds; const bf16_t* proj = (const bf16_t*)(p.ws + WS_PROJ); const bf16_t* SP = (const bf16_t*)(p.ws + WS_SPREV); float* go = (float*)(p.ws + WS_GLAO);
    const int tid = c.tid, lane = c.lane, w = c.wave, r = lane & 15, qq = lane >> 4, kk = tid & 63;
    for (int item = c.blk; item < 2048; item += c.nblk) {
        const int h = item & 3, bn = item >> 2; const bf16_t* prow0 = proj + (size_t)bn * 64 * NIN_PAD;
        float bcum[8], blast; gla_cumdecay(p, c, prow0, h, bcum, blast);
        gla_stage_v(c, prow0, h);
#pragma unroll
        for (int k = 0; k < 8; ++k) { const int i = 8 * w + k; const bf16_t* pr = prow0 + (size_t)i * NIN_PAD;
            const float qv = bf2f(pr[C_GQ + h * 64 + kk]) * 0.125f * __expf(bcum[k]), kv = bf2f(pr[C_GK + h * 64 + kk]) * __expf(-bcum[k]);
            *(LAS bf16_t*)(L + GL_QD + i * 144 + kk * 2) = (bf16_t)f2bf(qv); *(LAS bf16_t*)(L + GL_KI + i * 144 + kk * 2) = (bf16_t)f2bf(kv); }
        __syncthreads();
        const int it = w & 3, vh = w >> 2;
        bf16x8 qf[2];
#pragma unroll
        for (int s2 = 0; s2 < 2; ++s2) qf[s2] = __builtin_bit_cast(bf16x8, *(const LAS u32x4*)(L + GL_QD + (16 * it + r) * 144 + (32 * s2 + 8 * qq) * 2));
        u32x2 pw[4];
#pragma unroll
        for (int jt = 0; jt < 4; ++jt) { f32x4 z = {0.f, 0.f, 0.f, 0.f};
            if (jt <= it) {
#pragma unroll
                for (int s2 = 0; s2 < 2; ++s2) { const bf16x8 kf = __builtin_bit_cast(bf16x8, *(const LAS u32x4*)(L + GL_KI + (16 * jt + r) * 144 + (32 * s2 + 8 * qq) * 2));
                    z = __builtin_amdgcn_mfma_f32_16x16x32_bf16(kf, qf[s2], z, 0, 0, 0); }
#pragma unroll
                for (int ii = 0; ii < 4; ++ii) z[ii] = (16 * jt + 4 * qq + ii <= 16 * it + r) ? z[ii] : 0.f; }
            pw[jt].x = pk2(z[0], z[1]); pw[jt].y = pk2(z[2], z[3]); }
        f32x4 acc[4];
#pragma unroll
        for (int n = 0; n < 4; ++n) acc[n] = (f32x4){0.f, 0.f, 0.f, 0.f};
#pragma unroll
        for (int s2 = 0; s2 < 2; ++s2) { if (2 * s2 <= it) {
            const u32x4 pq = {pw[2 * s2].x, pw[2 * s2].y, pw[2 * s2 + 1].x, pw[2 * s2 + 1].y};
            LAS const unsigned char* vp = L + GL_V + (32 * s2 + 4 * qq + (r >> 2)) * 272 + (64 * vh + 4 * (r & 3)) * 2;
#pragma unroll
            for (int n = 0; n < 4; ++n) { const s16x4 v0 = lds_tr16(vp + 32 * n), v1 = lds_tr16(vp + 32 * n + 16 * 272);
                const bf16x8 vf = {v0[0], v0[1], v0[2], v0[3], v1[0], v1[1], v1[2], v1[3]};
                acc[n] = __builtin_amdgcn_mfma_f32_16x16x32_bf16(__builtin_bit_cast(bf16x8, pq), vf, acc[n], 0, 0, 0); } } }
#pragma unroll
        for (int s2 = 0; s2 < 2; ++s2)
#pragma unroll
            for (int n = 0; n < 4; ++n) { const bf16x8 sf = __builtin_bit_cast(bf16x8, *(const u32x4*)(SP + (size_t)item * 8192 + (64 * vh + 16 * n + r) * 64 + 32 * s2 + 8 * qq));
                acc[n] = __builtin_amdgcn_mfma_f32_16x16x32_bf16(qf[s2], sf, acc[n], 0, 0, 0); }
        float* outp = go + ((size_t)bn * 64 + 16 * it + 4 * qq) * 512 + h * 128 + 64 * vh + r;
#pragma unroll
        for (int n = 0; n < 4; ++n)
#pragma unroll
            for (int ii = 0; ii < 4; ++ii) outp[ii * 512 + 16 * n] = acc[n][ii];
    }
}
#ifndef ATT_COMBINE
#define ATT_COMBINE 1
#endif
__device__ __forceinline__ void ph_mix(const Params& p, const Ctx& c) {
    const bf16_t* proj = (const bf16_t*)(p.ws + WS_PROJ); const float* go = (const float*)(p.ws + WS_GLAO); bf16_t* mixed = (bf16_t*)(p.ws + WS_ACT);
    for (int m = c.gwave; m < M; m += c.gwaves) {
#pragma unroll
        for (int h = 0; h < 4; ++h) { const int col = h * 128 + 2 * c.lane;
            const float o0 = go[(size_t)m * 512 + col], o1 = go[(size_t)m * 512 + col + 1];
            const float rstd = 1.f / sqrtf(wave_sum(o0 * o0 + o1 * o1) * (1.f / 128.f) + NORM_EPS);
            const unsigned gw = *(const unsigned*)(proj + (size_t)m * NIN_PAD + C_GG + col); const float g0 = bflo(gw), g1 = bfhi(gw);
            const float r0 = o0 * rstd * p.gla_head_gain[col] * (g0 * sigmoidf_(g0)), r1 = o1 * rstd * p.gla_head_gain[col + 1] * (g1 * sigmoidf_(g1));
            *(unsigned*)(mixed + (size_t)m * DM + col) = pk2(r0, r1); }
        if (ATT_COMBINE) {
            const bf16_t* AO = (const bf16_t*)p.out; const float* LSE = (const float*)((const unsigned char*)p.out + 96 * MiB); const int hh = c.lane >> 3;
            const float l0 = LSE[((size_t)0 * M + m) * 8 + hh], l1 = LSE[((size_t)1 * M + m) * 8 + hh], l2 = LSE[((size_t)2 * M + m) * 8 + hh];
            const float lm = fmaxf(l0, fmaxf(l1, l2)), e0 = __expf(l0 - lm), e1 = __expf(l1 - lm), e2 = __expf(l2 - lm), rd = 1.f / (e0 + e1 + e2);
            const float w0 = e0 * rd, w1 = e1 * rd, w2 = e2 * rd;
            const u32x4 a0 = *((const u32x4*)(AO + ((size_t)0 * M + m) * 512) + c.lane), a1 = *((const u32x4*)(AO + ((size_t)1 * M + m) * 512) + c.lane), a2 = *((const u32x4*)(AO + ((size_t)2 * M + m) * 512) + c.lane);
            u32x4 o;
            o.x = pk2(w0 * bflo(a0.x) + w1 * bflo(a1.x) + w2 * bflo(a2.x), w0 * bfhi(a0.x) + w1 * bfhi(a1.x) + w2 * bfhi(a2.x));
            o.y = pk2(w0 * bflo(a0.y) + w1 * bflo(a1.y) + w2 * bflo(a2.y), w0 * bfhi(a0.y) + w1 * bfhi(a1.y) + w2 * bfhi(a2.y));
            o.z = pk2(w0 * bflo(a0.z) + w1 * bflo(a1.z) + w2 * bflo(a2.z), w0 * bfhi(a0.z) + w1 * bfhi(a1.z) + w2 * bfhi(a2.z));
            o.w = pk2(w0 * bflo(a0.w) + w1 * bflo(a1.w) + w2 * bflo(a2.w), w0 * bfhi(a0.w) + w1 * bfhi(a1.w) + w2 * bfhi(a2.w));
            *((u32x4*)(mixed + (size_t)m * DM + 512) + c.lane) = o; }
    }
}


constexpr int GR_WGT = 0, GR_XC = 65536, GR_A = 81920, GR_U = 115712, GR_SEG = 132608, GR_CW = 136704, GR_GB = 139264;
__device__ __forceinline__ float fast_sigmoid(float x) { return __builtin_amdgcn_rcpf(1.f + __expf(-x)); }
template <bool FULL> __device__ __forceinline__ void griffin_pass(const Params& p, const Ctx& c) {
    LAS unsigned char* L = c.lds;
    const int tid = c.tid, lane = c.lane, wave = c.wave, g = c.blk & 7;
    const bf16_t* proj = (const bf16_t*)(p.ws + WS_PROJ); bf16_t* yout = (bf16_t*)(p.ws + WS_ACT);
    float* AGA = (float*)(p.ws + WS_AGG); float* AGH = AGA + BATCH * 128 * 1024; const float* CAR = AGH + BATCH * 128 * 1024;
    LAS float* A_ = (LAS float*)(L + GR_A); LAS bf16_t* U_ = (LAS bf16_t*)(L + GR_U); LAS float* SEG = (LAS float*)(L + GR_SEG); LAS float* CW = (LAS float*)(L + GR_CW); LAS float* GB = (LAS float*)(L + GR_GB);
    __syncthreads();
    { const bf16_t* wg = (const bf16_t*)(p.ws + WS_WG);
      for (int ch = tid; ch < 4096; ch += NTHREADS) { const int gate = ch >> 11, j = (ch >> 4) & 127, cc = ch & 15;
          const u32x4 v = *(const u32x4*)(wg + ((size_t)(gate * 8 + g) * 128 + j) * 128 + cc * 8);
          *(LAS u32x4*)(L + GR_WGT + gate * 32768 + j * 256 + ((cc ^ (j & 15)) << 4)) = v; }
      if (tid < 128) { const int ch = g * 128 + tid;
#pragma unroll
          for (int jj = 0; jj < 4; ++jj) CW[jj * 128 + tid] = p.c_conv_w[jj * 1024 + ch];
          CW[4 * 128 + tid] = p.c_conv_b[ch]; GB[tid] = p.c_b_rgate[ch]; GB[128 + tid] = p.c_b_igate[ch];
          const float lam = p.c_lambda[ch]; GB[256 + tid] = fmaxf(-lam, 0.f) + log1pf(expf(-fabsf(lam))); } }
    __syncthreads();
    const int nslot = BATCH * 128, sstep = c.nblk >> 3;
    for (int slot = c.blk >> 3; slot < nslot; slot += sstep) {
        const int b = slot >> 7, tile = slot & 127, t0 = tile * 64; const size_t row0 = (size_t)b * SEQ + t0;
        { const int co = tid & 15, tp = tid >> 4;
          u32x4 xr[5];
#pragma unroll
          for (int jj = 0; jj < 5; ++jj) { const int tt = t0 + 2 * tp - 3 + jj; xr[jj] = (u32x4){0u, 0u, 0u, 0u};
              if (tt >= 0) xr[jj] = *(const u32x4*)(proj + (row0 + 2 * tp - 3 + jj) * 2048 + 1024 + g * 128 + co * 8); }
          f32x4 w[5][2];
#pragma unroll
          for (int jj = 0; jj < 5; ++jj) { w[jj][0] = *(const LAS f32x4*)(CW + jj * 128 + co * 8); w[jj][1] = *(const LAS f32x4*)(CW + jj * 128 + co * 8 + 4); }
#pragma unroll
          for (int tl = 0; tl < 2; ++tl) { float a8[8];
#pragma unroll
              for (int e = 0; e < 8; ++e) a8[e] = w[4][e >> 2][e & 3];
#pragma unroll
              for (int jj = 0; jj < 4; ++jj) { const u32x4 xv = xr[tl + jj]; const unsigned xw[4] = {xv.x, xv.y, xv.z, xv.w};
#pragma unroll
                  for (int e = 0; e < 8; ++e) { const float xe = (e & 1) ? bfhi(xw[e >> 1]) : bflo(xw[e >> 1]); a8[e] += w[jj][e >> 2][e & 3] * xe; } }
              const int t = 2 * tp + tl; u32x4 o; o.x = pk2(a8[0], a8[1]); o.y = pk2(a8[2], a8[3]); o.z = pk2(a8[4], a8[5]); o.w = pk2(a8[6], a8[7]);
              *(LAS u32x4*)(L + GR_XC + t * 256 + ((co ^ (t & 15)) << 4)) = o; } }
        __syncthreads();
        { const int tt = wave & 3, jh = wave >> 2, r = lane & 15, q = lane >> 4, t = 16 * tt + r;
          f32x4 ar[4], ai[4];
#pragma unroll
          for (int n = 0; n < 4; ++n) { ar[n] = (f32x4){0.f, 0.f, 0.f, 0.f}; ai[n] = (f32x4){0.f, 0.f, 0.f, 0.f}; }
#pragma unroll
          for (int s = 0; s < 4; ++s) { const bf16x8 xb = __builtin_bit_cast(bf16x8, *(const LAS u32x4*)(L + GR_XC + t * 256 + (((4 * s + q) ^ (t & 15)) << 4)));
#pragma unroll
              for (int n = 0; n < 4; ++n) { const int j = 64 * jh + 16 * n + r;
                  const bf16x8 wr = __builtin_bit_cast(bf16x8, *(const LAS u32x4*)(L + GR_WGT + j * 256 + (((4 * s + q) ^ (j & 15)) << 4)));
                  const bf16x8 wi = __builtin_bit_cast(bf16x8, *(const LAS u32x4*)(L + GR_WGT + 32768 + j * 256 + (((4 * s + q) ^ (j & 15)) << 4)));
                  ar[n] = __builtin_amdgcn_mfma_f32_16x16x32_bf16(wr, xb, ar[n], 0, 0, 0); ai[n] = __builtin_amdgcn_mfma_f32_16x16x32_bf16(wi, xb, ai[n], 0, 0, 0); } }
#pragma unroll
          for (int n = 0; n < 4; ++n) { const int j0 = 64 * jh + 16 * n + 4 * q;
              const f32x4 br = *(const LAS f32x4*)(GB + j0), bi = *(const LAS f32x4*)(GB + 128 + j0), sp = *(const LAS f32x4*)(GB + 256 + j0);
              const u32x2 xw = *(const LAS u32x2*)(L + GR_XC + t * 256 + ((((j0 >> 3) ^ (t & 15)) << 4) + (j0 & 7) * 2));
              const float xc[4] = {bflo(xw.x), bfhi(xw.x), bflo(xw.y), bfhi(xw.y)};
              f32x4 av; float uv[4];
#pragma unroll
              for (int i = 0; i < 4; ++i) { const float rr = fast_sigmoid(ar[n][i] + br[i]), ii = fast_sigmoid(ai[n][i] + bi[i]);
                  const float a = __expf(-8.f * rr * sp[i]); av[i] = a; uv[i] = sqrtf(fmaxf(1.f - a * a, 0.f)) * (ii * xc[i]); }
              *(LAS f32x4*)(A_ + t * 132 + j0) = av; u32x2 uo; uo.x = pk2(uv[0], uv[1]); uo.y = pk2(uv[2], uv[3]); *(LAS u32x2*)(U_ + t * 132 + j0) = uo; } }
        __syncthreads();
        const int j = tid & 127, seg = tid >> 7;
        { float aa = 1.f, hh = 0.f;
#pragma unroll
          for (int i = 0; i < 16; ++i) { const int t = seg * 16 + i; const float a = A_[t * 132 + j], u = bf2f(U_[t * 132 + j]); hh = a * hh + u; aa *= a; }
          SEG[seg * 128 + j] = aa; SEG[512 + seg * 128 + j] = hh; }
        __syncthreads();
        if (!FULL) {
            if (tid < 128) { float A = 1.f, H = 0.f;
#pragma unroll
                for (int sgi = 0; sgi < 4; ++sgi) { H = SEG[sgi * 128 + tid] * H + SEG[512 + sgi * 128 + tid]; A *= SEG[sgi * 128 + tid]; }
                const size_t e = ((size_t)b * 128 + tile) * 1024 + g * 128 + tid; AGA[e] = A; AGH[e] = H; }
        } else {
            float h = CAR[((size_t)b * 128 + tile) * 1024 + g * 128 + j];
            for (int sgi = 0; sgi < seg; ++sgi) h = SEG[sgi * 128 + j] * h + SEG[512 + sgi * 128 + j];
#pragma unroll
            for (int i = 0; i < 16; ++i) { const int t = seg * 16 + i; const float a = A_[t * 132 + j], u = bf2f(U_[t * 132 + j]); h = a * h + u; A_[t * 132 + j] = h; }
            __syncthreads();
            { const int co = tid & 15, tp = tid >> 4;
#pragma unroll
              for (int tl = 0; tl < 2; ++tl) { const int t = 2 * tp + tl;
                  const f32x4 h0 = *(const LAS f32x4*)(A_ + t * 132 + co * 8), h1 = *(const LAS f32x4*)(A_ + t * 132 + co * 8 + 4);
                  const u32x4 gw = *(const u32x4*)(proj + (row0 + t) * 2048 + g * 128 + co * 8);
                  u32x4 o; o.x = pk2(gelu_tanh(bflo(gw.x)) * h0.x, gelu_tanh(bfhi(gw.x)) * h0.y); o.y = pk2(gelu_tanh(bflo(gw.y)) * h0.z, gelu_tanh(bfhi(gw.y)) * h0.w);
                  o.z = pk2(gelu_tanh(bflo(gw.z)) * h1.x, gelu_tanh(bfhi(gw.z)) * h1.y); o.w = pk2(gelu_tanh(bflo(gw.w)) * h1.z, gelu_tanh(bfhi(gw.w)) * h1.w);
                  *(u32x4*)(yout + (row0 + t) * DM + g * 128 + co * 8) = o; } }
        }
    }
}
__device__ __forceinline__ void ph_carry(const Params& p, const Ctx& c) {
    const float* AGA = (const float*)(p.ws + WS_AGG); const float* AGH = AGA + BATCH * 128 * 1024; float* CAR = (float*)(AGH + BATCH * 128 * 1024);
    for (int idx = c.gtid; idx < BATCH * 1024; idx += c.gthreads) { const int b = idx >> 10, ch = idx & 1023; float cy = 0.f;
        for (int t0 = 0; t0 < 128; t0 += 8) { float a[8], h[8];
#pragma unroll
            for (int k = 0; k < 8; ++k) { const size_t e = ((size_t)b * 128 + t0 + k) * 1024 + ch; a[k] = AGA[e]; h[k] = AGH[e]; }
#pragma unroll
            for (int k = 0; k < 8; ++k) { CAR[((size_t)b * 128 + t0 + k) * 1024 + ch] = cy; cy = a[k] * cy + h[k]; } } }
}
__device__ __forceinline__ void cvt_gate_weights(const Params& p, const Ctx& c) {
    bf16_t* wg = (bf16_t*)(p.ws + WS_WG);
    for (int idx = c.gtid; idx < 2 * 8 * 16 * 128; idx += c.gthreads) { const int j = idx & 127, io = (idx >> 7) & 15, g = (idx >> 11) & 7, gate = idx >> 14;
        const float* s = (gate ? p.c_w_igate : p.c_w_rgate) + (size_t)g * 16384 + (io * 8) * 128 + j;
        u32x4 w; w.x = pk2(s[0], s[128]); w.y = pk2(s[256], s[384]); w.z = pk2(s[512], s[640]); w.w = pk2(s[768], s[896]);
        *(u32x4*)(wg + ((size_t)(gate * 8 + g) * 128 + j) * 128 + io * 8) = w; }
}


constexpr size_t WS_SK = 25 * MiB;
constexpr int TK_SK = 0, TK_Q = 69632, TK_S = 86528, TK_L = 119552, TK_C = 123648, TK_O = 131840, TK_TAB = 135936;
typedef int i32x4 __attribute__((ext_vector_type(4)));
__device__ __forceinline__ int key_xform(int b) { return b ^ ((b >> 31) & 0x7fffffff); }
#define CEX(a, b) do { const int hi_ = max((a), (b)), lo_ = min((a), (b)); (a) = hi_; (b) = lo_; } while (0)
__device__ __forceinline__ void bitonic_merge16_desc(int (&v)[16]) {
#pragma unroll
    for (int j = 8; j >= 1; j >>= 1)
#pragma unroll
        for (int i = 0; i < 16; ++i) if ((i & j) == 0) CEX(v[i], v[i | j]);
}
__device__ __forceinline__ void bitonic_sort16_desc(int (&v)[16]) {
#pragma unroll
    for (int k = 2; k <= 16; k <<= 1)
#pragma unroll
        for (int j = k >> 1; j >= 1; j >>= 1)
#pragma unroll
            for (int i = 0; i < 16; ++i) { const int l = i ^ j; if (l > i) { if ((i & k) == 0 || k == 16) CEX(v[i], v[l]); else CEX(v[l], v[i]); } }
}
__device__ __forceinline__ void ph_topk(const Params& p, int layer, const Ctx& c) {
    LAS unsigned char* L = c.lds; const bf16_t* Q = (const bf16_t*)(p.ws + WS_PROJ);
    int* ids = (int*)(p.ws + WS_IDS); float* gg = (float*)(p.ws + WS_G);
    const int tid = c.tid, lane = c.lane, w = c.wave, r = lane & 15, qq = lane >> 4, h = c.blk & 7;
    LAS float* S = (LAS float*)(L + TK_S); LAS int* LST = (LAS int*)(L + TK_L); LAS int* CND = (LAS int*)(L + TK_C); LAS int* OUTK = (LAS int*)(L + TK_O); LAS int* TAB = (LAS int*)(L + TK_TAB);
    __syncthreads();
    { const bf16_t* sk = (const bf16_t*)(p.ws + WS_SK) + ((size_t)layer * 8 + h) * 2 * 128 * 128;
      for (int ch = tid; ch < 4096; ch += NTHREADS) { const int row = ch >> 4, cc = ch & 15;
          *(LAS u32x4*)(L + TK_SK + row * 272 + cc * 16) = *(const u32x4*)(sk + (size_t)row * 128 + cc * 8); }
      if (tid < 64) { int cnt = 0, code = -1;
          for (int i = 0; i < 16; ++i) for (int j = 0; j < 16 / (i + 1); ++j) { if (cnt == tid) code = i * 16 + j; ++cnt; }
          TAB[tid] = code; } }
    const int nslot = M / 32, sstep = c.nblk >> 3;
    for (int slot = c.blk >> 3; slot < nslot; slot += sstep) {
        const int m0 = slot * 32;
        __syncthreads();
#pragma unroll
        for (int k = 0; k < 2; ++k) { const int idx = tid + NTHREADS * k, row = idx >> 5, ch = idx & 31;
            *(LAS u32x4*)(L + TK_Q + row * 528 + ch * 16) = *(const u32x4*)(Q + (size_t)(m0 + row) * 2048 + h * 256 + ch * 8); }
        __syncthreads();
        { const int pp = w >> 2, mt = (w >> 1) & 1, nh = w & 1;
          f32x4 acc[4];
#pragma unroll
          for (int nt = 0; nt < 4; ++nt) acc[nt] = (f32x4){0.f, 0.f, 0.f, 0.f};
#pragma unroll
          for (int s2 = 0; s2 < 4; ++s2) { const bf16x8 af = __builtin_bit_cast(bf16x8, *(const LAS u32x4*)(L + TK_Q + (16 * mt + r) * 528 + (pp * 128 + 32 * s2 + 8 * qq) * 2));
#pragma unroll
              for (int nt = 0; nt < 4; ++nt) { const bf16x8 bfr = __builtin_bit_cast(bf16x8, *(const LAS u32x4*)(L + TK_SK + (pp * 128 + 16 * (4 * nh + nt) + r) * 272 + (32 * s2 + 8 * qq) * 2));
                  acc[nt] = __builtin_amdgcn_mfma_f32_16x16x32_bf16(af, bfr, acc[nt], 0, 0, 0); } }
#pragma unroll
          for (int nt = 0; nt < 4; ++nt)
#pragma unroll
              for (int i = 0; i < 4; ++i) S[(pp * 32 + 16 * mt + 4 * qq + i) * 129 + 16 * (4 * nh + nt) + r] = acc[nt][i]; }
        __syncthreads();
        const int m = tid >> 4, sub = tid & 15;
        { const int pp = sub >> 3, part = sub & 7; int v[16];
#pragma unroll
          for (int k = 0; k < 16; ++k) { const int n = 8 * k + part; v[k] = key_xform((__builtin_bit_cast(int, S[(pp * 32 + m) * 129 + n]) & ~127) | n); }
          bitonic_sort16_desc(v);
#pragma unroll
          for (int rd = 1; rd <= 4; rd <<= 1) { int o[16];
#pragma unroll
              for (int i = 0; i < 16; ++i) o[i] = __shfl_xor(v[15 - i], rd);
#pragma unroll
              for (int i = 0; i < 16; ++i) v[i] = max(v[i], o[i]);
              bitonic_merge16_desc(v); }
          if (part == 0) {
#pragma unroll
              for (int k = 0; k < 16; ++k) LST[(m * 2 + pp) * 16 + k] = key_xform(v[k]); } }
        asm volatile("s_waitcnt lgkmcnt(0)" ::: "memory");
        { int mykey[4];
#pragma unroll
          for (int cc = 0; cc < 4; ++cc) { const int ci = sub * 4 + cc; const int code = TAB[ci]; int key = (int)0x80000000;
              if (code >= 0) { const float s1 = __builtin_bit_cast(float, LST[(m * 2 + 0) * 16 + (code >> 4)] & ~127), s2v = __builtin_bit_cast(float, LST[(m * 2 + 1) * 16 + (code & 15)] & ~127);
                  key = key_xform((__builtin_bit_cast(int, s1 + s2v) & ~63) | (63 - ci)); }
              mykey[cc] = key; CND[m * 64 + ci] = key; }
          asm volatile("s_waitcnt lgkmcnt(0)" ::: "memory");
          int rank[4] = {0, 0, 0, 0};
#pragma unroll
          for (int k4 = 0; k4 < 16; ++k4) { const i32x4 o = *(const LAS i32x4*)(CND + m * 64 + 4 * k4);
#pragma unroll
              for (int cc = 0; cc < 4; ++cc) rank[cc] += (o.x > mykey[cc]) + (o.y > mykey[cc]) + (o.z > mykey[cc]) + (o.w > mykey[cc]); }
#pragma unroll
          for (int cc = 0; cc < 4; ++cc) if (rank[cc] < 16) OUTK[m * 16 + rank[cc]] = mykey[cc];
          asm volatile("s_waitcnt lgkmcnt(0)" ::: "memory");
          const int kb = key_xform(OUTK[m * 16 + sub]), k0b = key_xform(OUTK[m * 16]);
          const float sv = __builtin_bit_cast(float, kb & ~63), smax = __builtin_bit_cast(float, k0b & ~63);
          const float e = __expf(sv - smax); float den = e;
          den += __shfl_xor(den, 1); den += __shfl_xor(den, 2); den += __shfl_xor(den, 4); den += __shfl_xor(den, 8);
          const int code = TAB[63 - (kb & 63)];
          const int i1 = LST[(m * 2 + 0) * 16 + (code >> 4)] & 127, i2 = LST[(m * 2 + 1) * 16 + (code & 15)] & 127;
          ids[(size_t)(m0 + m) * 128 + h * 16 + sub] = i1 * 128 + i2; gg[(size_t)(m0 + m) * 128 + h * 16 + sub] = e / den; }
    }
}

__device__ __forceinline__ void ph_topk1(const Params& p, int layer, const Ctx& c) {
    const bf16_t* Q = (const bf16_t*)(p.ws + WS_PROJ); float* tops = (float*)(p.ws + WS_TOPS); int* topi = (int*)(p.ws + WS_TOPI);
    const float* keys = p.peer_sub_keys + (size_t)layer * 16 * 128 * 128;
    for (int gid = c.gtid; gid < M * 32; gid += c.gthreads) {
        const int idx = gid >> 1, half = gid & 1;
        const int t = idx & (M - 1), hp = __builtin_amdgcn_readfirstlane(idx >> 15);
        float q[64];
        { const u32x4* qp = (const u32x4*)(Q + (size_t)t * 2048 + hp * 128 + half * 64);
#pragma unroll
          for (int i = 0; i < 8; ++i) { const u32x4 w = qp[i]; q[8*i] = bflo(w.x); q[8*i+1] = bfhi(w.x); q[8*i+2] = bflo(w.y); q[8*i+3] = bfhi(w.y); q[8*i+4] = bflo(w.z); q[8*i+5] = bfhi(w.z); q[8*i+6] = bflo(w.w); q[8*i+7] = bfhi(w.w); } }
        float ls[16]; int li[16];
#pragma unroll
        for (int j = 0; j < 16; ++j) { ls[j] = -3.0e38f; li[j] = 0; }
        for (int n = 0; n < 128; ++n) { const float* kr = keys + ((size_t)hp * 128 + n) * 128 + half * 64;
            float s = 0.f;
#pragma unroll
            for (int cc = 0; cc < 64; ++cc) s += q[cc] * kr[cc];
            s += __shfl_xor(s, 1);
            int ni = n;
#pragma unroll
            for (int j = 0; j < 16; ++j) { const bool gt = s > ls[j]; const float ts = gt ? ls[j] : s; const int ti = gt ? li[j] : ni; ls[j] = gt ? s : ls[j]; li[j] = gt ? ni : li[j]; s = ts; ni = ti; }
        }
        if (half == 0) { float* os = tops + ((size_t)t * 16 + hp) * 16; int* oi = topi + ((size_t)t * 16 + hp) * 16;
#pragma unroll
            for (int j = 0; j < 16; ++j) { os[j] = ls[j]; oi[j] = li[j]; } }
    }
}
__device__ __forceinline__ void ph_topk2(const Params& p, const Ctx& c) {
    const float* tops = (const float*)(p.ws + WS_TOPS); const int* topi = (const int*)(p.ws + WS_TOPI);
    int* ids = (int*)(p.ws + WS_IDS); float* gg = (float*)(p.ws + WS_G);
    for (int idx = c.gtid; idx < M * 8; idx += c.gthreads) {
        const int t = idx >> 3, h = idx & 7;
        float s1[16], s2[16]; int i1[16], i2[16];
        { const float* a = tops + ((size_t)t * 16 + h * 2) * 16; const int* ai = topi + ((size_t)t * 16 + h * 2) * 16;
#pragma unroll
          for (int j = 0; j < 16; ++j) { s1[j] = a[j]; s2[j] = a[16 + j]; i1[j] = ai[j]; i2[j] = ai[16 + j]; } }
        float ls[16]; int lc[16];
#pragma unroll
        for (int j = 0; j < 16; ++j) { ls[j] = -3.0e38f; lc[j] = 0; }
#pragma unroll
        for (int i = 0; i < 16; ++i)
#pragma unroll
            for (int j = 0; j < 16 / (i + 1); ++j) { float s = s1[i] + s2[j]; int cd = i * 16 + j;
#pragma unroll
                for (int k = 0; k < 16; ++k) { const bool gt = s > ls[k]; const float ts = gt ? ls[k] : s; const int tc = gt ? lc[k] : cd; ls[k] = gt ? s : ls[k]; lc[k] = gt ? cd : lc[k]; s = ts; cd = tc; } }
        float den = 0.f, e[16];
#pragma unroll
        for (int k = 0; k < 16; ++k) { e[k] = __expf(ls[k] - ls[0]); den += e[k]; }
        const float rd = 1.f / den;
#pragma unroll
        for (int k = 0; k < 16; ++k) { const int ci = lc[k] >> 4, cj = lc[k] & 15; int a = 0, bq = 0;
#pragma unroll
            for (int z = 0; z < 16; ++z) { a = (ci == z) ? i1[z] : a; bq = (cj == z) ? i2[z] : bq; }
            ids[(size_t)t * 128 + h * 16 + k] = a * 128 + bq; gg[(size_t)t * 128 + h * 16 + k] = e[k] * rd; }
    }
}
__device__ __forceinline__ void ph_gather(const Params& p, const Ctx& c) {
    const bf16_t* XN = (const bf16_t*)(p.ws + WS_ACT); const bf16_t* UT = (const bf16_t*)(p.ws + WS_TAB); const bf16_t* VT = UT + (size_t)NEXP * DM;
    const int* ids = (const int*)(p.ws + WS_IDS); const float* gg = (const float*)(p.ws + WS_G);
    for (int m = c.gwave; m < M; m += c.gwaves) {
        float x[16], o[16];
        { const u32x4 a = *((const u32x4*)(XN + (size_t)m * DM) + c.lane), b = *((const u32x4*)(XN + (size_t)m * DM + 512) + c.lane);
          x[0] = bflo(a.x); x[1] = bfhi(a.x); x[2] = bflo(a.y); x[3] = bfhi(a.y); x[4] = bflo(a.z); x[5] = bfhi(a.z); x[6] = bflo(a.w); x[7] = bfhi(a.w);
          x[8] = bflo(b.x); x[9] = bfhi(b.x); x[10] = bflo(b.y); x[11] = bfhi(b.y); x[12] = bflo(b.z); x[13] = bfhi(b.z); x[14] = bflo(b.w); x[15] = bfhi(b.w); }
#pragma unroll
        for (int i = 0; i < 16; ++i) o[i] = 0.f;
        const int id0 = ids[(size_t)m * 128 + c.lane], id1 = ids[(size_t)m * 128 + 64 + c.lane];
        const float g0 = gg[(size_t)m * 128 + c.lane], g1 = gg[(size_t)m * 128 + 64 + c.lane];
        for (int k0 = 0; k0 < 128; k0 += 4) {
            u32x4 ua[4], ub[4], va[4], vb[4]; float gk[4];
#pragma unroll
            for (int j = 0; j < 4; ++j) { const int k = k0 + j; const int id = (k < 64) ? __shfl(id0, k) : __shfl(id1, k - 64); gk[j] = (k < 64) ? __shfl(g0, k) : __shfl(g1, k - 64);
                const u32x4* ur = (const u32x4*)(UT + (size_t)id * DM); const u32x4* vr = (const u32x4*)(VT + (size_t)id * DM);
                ua[j] = ur[c.lane]; ub[j] = ur[64 + c.lane]; va[j] = vr[c.lane]; vb[j] = vr[64 + c.lane]; }
#pragma unroll
            for (int j = 0; j < 4; ++j) {
                float d = x[0] * bflo(ua[j].x) + x[1] * bfhi(ua[j].x) + x[2] * bflo(ua[j].y) + x[3] * bfhi(ua[j].y) + x[4] * bflo(ua[j].z) + x[5] * bfhi(ua[j].z) + x[6] * bflo(ua[j].w) + x[7] * bfhi(ua[j].w)
                        + x[8] * bflo(ub[j].x) + x[9] * bfhi(ub[j].x) + x[10] * bflo(ub[j].y) + x[11] * bfhi(ub[j].y) + x[12] * bflo(ub[j].z) + x[13] * bfhi(ub[j].z) + x[14] * bflo(ub[j].w) + x[15] * bfhi(ub[j].w);
                d = wave_sum(d);
                const float act = gelu_tanh(d) * gk[j];
                o[0] += act * bflo(va[j].x); o[1] += act * bfhi(va[j].x); o[2] += act * bflo(va[j].y); o[3] += act * bfhi(va[j].y); o[4] += act * bflo(va[j].z); o[5] += act * bfhi(va[j].z); o[6] += act * bflo(va[j].w); o[7] += act * bfhi(va[j].w);
                o[8] += act * bflo(vb[j].x); o[9] += act * bfhi(vb[j].x); o[10] += act * bflo(vb[j].y); o[11] += act * bfhi(vb[j].y); o[12] += act * bflo(vb[j].z); o[13] += act * bfhi(vb[j].z); o[14] += act * bflo(vb[j].w); o[15] += act * bfhi(vb[j].w);
            }
        }
        f32x4* hp = (f32x4*)(p.out + (size_t)m * DM);
        f32x4 h0 = hp[2 * c.lane], h1 = hp[2 * c.lane + 1], h2 = hp[128 + 2 * c.lane], h3 = hp[128 + 2 * c.lane + 1];
        h0 += (f32x4){o[0], o[1], o[2], o[3]}; h1 += (f32x4){o[4], o[5], o[6], o[7]}; h2 += (f32x4){o[8], o[9], o[10], o[11]}; h3 += (f32x4){o[12], o[13], o[14], o[15]};
        hp[2 * c.lane] = h0; hp[2 * c.lane + 1] = h1; hp[128 + 2 * c.lane] = h2; hp[128 + 2 * c.lane + 1] = h3;
    }
}

__device__ __forceinline__ void ph_gather2(const Params& p, const Ctx& c) {
    const bf16_t* XN = (const bf16_t*)(p.ws + WS_ACT); const bf16_t* UT = (const bf16_t*)(p.ws + WS_TAB); const bf16_t* VT = UT + (size_t)NEXP * DM;
    const int* ids = (const int*)(p.ws + WS_IDS); const float* gg = (const float*)(p.ws + WS_G);
    LAS unsigned char* wl = c.lds + c.wave * 4096;
    LAS bf16_t* xs = (LAS bf16_t*)wl; LAS float* dsm = (LAS float*)(wl + 2048);
    const int lane = c.lane, r = lane & 15, q = lane >> 4;
    for (int m = c.gwave; m < M; m += c.gwaves) {
        { const u32x4 xa = *((const u32x4*)(XN + (size_t)m * DM) + lane), xb = *((const u32x4*)(XN + (size_t)m * DM + 512) + lane);
          *((LAS u32x4*)xs + lane) = xa; *((LAS u32x4*)(xs + 512) + lane) = xb; }
        const int id0 = ids[(size_t)m * 128 + lane], id1 = ids[(size_t)m * 128 + 64 + lane];
        const float g0 = gg[(size_t)m * 128 + lane], g1 = gg[(size_t)m * 128 + 64 + lane];
        const char* rowp[8];
#pragma unroll
        for (int g = 0; g < 8; ++g) { const int idg = __shfl(g < 4 ? id0 : id1, 16 * (g & 3) + r); rowp[g] = (const char*)(UT + (size_t)idg * DM) + q * 16; }
        f32x4 acc[8];
#pragma unroll
        for (int g = 0; g < 8; ++g) acc[g] = (f32x4){0.f, 0.f, 0.f, 0.f};
#pragma unroll 1
        for (int kc = 0; kc < 4; ++kc) {
            bf16x8 xb8[8];
#pragma unroll
            for (int s = 0; s < 8; ++s) xb8[s] = *(const LAS bf16x8*)(xs + (kc * 8 + s) * 32 + 8 * q);
#pragma unroll
            for (int g = 0; g < 8; ++g) { bf16x8 a[8];
#pragma unroll
                for (int s = 0; s < 8; ++s) a[s] = *(const bf16x8*)(rowp[g] + (kc * 8 + s) * 64);
#pragma unroll
                for (int s = 0; s < 8; ++s) acc[g] = __builtin_amdgcn_mfma_f32_16x16x32_bf16(a[s], xb8[s], acc[g], 0, 0, 0); }
        }
#pragma unroll
        for (int g = 0; g < 8; ++g) if (r == 0) *(LAS f32x4*)(dsm + 16 * g + 4 * q) = acc[g];
        const float d0 = dsm[lane], d1 = dsm[64 + lane];
        const int act0 = __builtin_bit_cast(int, gelu_tanh(d0) * g0), act1 = __builtin_bit_cast(int, gelu_tanh(d1) * g1);
        float o[16];
#pragma unroll
        for (int i = 0; i < 16; ++i) o[i] = 0.f;
#pragma unroll
        for (int hh = 0; hh < 2; ++hh) { const int idv = hh ? id1 : id0; const int actv = hh ? act1 : act0;
#pragma unroll 1
            for (int e0 = 0; e0 < 64; e0 += 8) {
                u32x4 va[8], vb[8]; float ae[8];
#pragma unroll
                for (int j = 0; j < 8; ++j) { const int id = __builtin_amdgcn_readlane(idv, e0 + j); ae[j] = __builtin_bit_cast(float, __builtin_amdgcn_readlane(actv, e0 + j));
                    const u32x4* vr = (const u32x4*)(VT + (size_t)id * DM); va[j] = vr[lane]; vb[j] = vr[64 + lane]; }
#pragma unroll
                for (int j = 0; j < 8; ++j) { const float act = ae[j];
                    o[0] += act * bflo(va[j].x); o[1] += act * bfhi(va[j].x); o[2] += act * bflo(va[j].y); o[3] += act * bfhi(va[j].y); o[4] += act * bflo(va[j].z); o[5] += act * bfhi(va[j].z); o[6] += act * bflo(va[j].w); o[7] += act * bfhi(va[j].w);
                    o[8] += act * bflo(vb[j].x); o[9] += act * bfhi(vb[j].x); o[10] += act * bflo(vb[j].y); o[11] += act * bfhi(vb[j].y); o[12] += act * bflo(vb[j].z); o[13] += act * bfhi(vb[j].z); o[14] += act * bflo(vb[j].w); o[15] += act * bfhi(vb[j].w); }
            } }
        f32x4* hp = (f32x4*)(p.out + (size_t)m * DM);
        f32x4 h0 = hp[2 * lane], h1 = hp[2 * lane + 1], h2 = hp[128 + 2 * lane], h3 = hp[128 + 2 * lane + 1];
        h0 += (f32x4){o[0], o[1], o[2], o[3]}; h1 += (f32x4){o[4], o[5], o[6], o[7]}; h2 += (f32x4){o[8], o[9], o[10], o[11]}; h3 += (f32x4){o[12], o[13], o[14], o[15]};
        hp[2 * lane] = h0; hp[2 * lane + 1] = h1; hp[128 + 2 * lane] = h2; hp[128 + 2 * lane + 1] = h3;
    }
}

__device__ __forceinline__ float wave_max(float v) {
#pragma unroll
    for (int o = 1; o < 64; o <<= 1) v = fmaxf(v, __shfl_xor(v, o));
    return v;
}
__device__ __forceinline__ void cvt_fp8_rows(const float* src, unsigned char* dst, float* scl, int nrows, const Ctx& c) {
    for (int row = c.gwave; row < nrows; row += c.gwaves) {
        const f32x4* sp = (const f32x4*)(src + (size_t)row * DM) + 4 * c.lane; f32x4 v[4]; float mx = 0.f;
#pragma unroll
        for (int j = 0; j < 4; ++j) { v[j] = sp[j]; mx = fmaxf(mx, fmaxf(fmaxf(fabsf(v[j].x), fabsf(v[j].y)), fmaxf(fabsf(v[j].z), fabsf(v[j].w)))); }
        mx = wave_max(mx);
        const float sc = mx > 0.f ? mx * (1.f / 416.f) : 1.f, inv = 1.f / sc;
        u32x4 w; int t;
        t = __builtin_amdgcn_cvt_pk_fp8_f32(v[0].x * inv, v[0].y * inv, 0, false); t = __builtin_amdgcn_cvt_pk_fp8_f32(v[0].z * inv, v[0].w * inv, t, true); w.x = (unsigned)t;
        t = __builtin_amdgcn_cvt_pk_fp8_f32(v[1].x * inv, v[1].y * inv, 0, false); t = __builtin_amdgcn_cvt_pk_fp8_f32(v[1].z * inv, v[1].w * inv, t, true); w.y = (unsigned)t;
        t = __builtin_amdgcn_cvt_pk_fp8_f32(v[2].x * inv, v[2].y * inv, 0, false); t = __builtin_amdgcn_cvt_pk_fp8_f32(v[2].z * inv, v[2].w * inv, t, true); w.z = (unsigned)t;
        t = __builtin_amdgcn_cvt_pk_fp8_f32(v[3].x * inv, v[3].y * inv, 0, false); t = __builtin_amdgcn_cvt_pk_fp8_f32(v[3].z * inv, v[3].w * inv, t, true); w.w = (unsigned)t;
        *((u32x4*)(dst + (size_t)row * DM) + c.lane) = w;
        if (c.lane == 0) scl[row] = sc;
    }
}
typedef float f32x2 __attribute__((ext_vector_type(2)));
__device__ __forceinline__ void cvt_fp8_roundtrip_rows(const float* src, bf16_t* dst, int nrows, const Ctx& c) {
    for (int row = c.gwave; row < nrows; row += c.gwaves) {
        const f32x4* sp = (const f32x4*)(src + (size_t)row * DM) + 4 * c.lane; f32x4 v[4]; float mx = 0.f;
#pragma unroll
        for (int j = 0; j < 4; ++j) { v[j] = sp[j]; mx = fmaxf(mx, fmaxf(fmaxf(fabsf(v[j].x), fabsf(v[j].y)), fmaxf(fabsf(v[j].z), fabsf(v[j].w)))); }
        mx = wave_max(mx);
        const float sc = mx > 0.f ? mx * (1.f / 416.f) : 1.f, inv = 1.f / sc;
        u32x4 o0, o1;
#pragma unroll
        for (int j = 0; j < 4; ++j) { int t = __builtin_amdgcn_cvt_pk_fp8_f32(v[j].x * inv, v[j].y * inv, 0, false); t = __builtin_amdgcn_cvt_pk_fp8_f32(v[j].z * inv, v[j].w * inv, t, true);
            const f32x2 a = __builtin_amdgcn_cvt_pk_f32_fp8(t, false), b = __builtin_amdgcn_cvt_pk_f32_fp8(t, true);
            const unsigned lo = pk2(a.x * sc, a.y * sc), hi = pk2(b.x * sc, b.y * sc);
            if (j == 0) { o0.x = lo; o0.y = hi; } else if (j == 1) { o0.z = lo; o0.w = hi; } else if (j == 2) { o1.x = lo; o1.y = hi; } else { o1.z = lo; o1.w = hi; } }
        u32x4* dp = (u32x4*)(dst + (size_t)row * DM) + 2 * c.lane; dp[0] = o0; dp[1] = o1;
    }
}
__device__ __forceinline__ u32x2 fp8x4_to_bf16x4(unsigned w) {
    const f32x2 a = __builtin_amdgcn_cvt_pk_f32_fp8((int)w, false), b = __builtin_amdgcn_cvt_pk_f32_fp8((int)w, true);
    u32x2 o;
    asm("v_cvt_pk_bf16_f32 %0, %1, %2" : "=v"(o.x) : "v"(a.x), "v"(a.y));
    asm("v_cvt_pk_bf16_f32 %0, %1, %2" : "=v"(o.y) : "v"(b.x), "v"(b.y));
    return o;
}
__device__ __forceinline__ void ph_gather3(const Params& p, int layer, const Ctx& c) {
    const bf16_t* XN = (const bf16_t*)(p.ws + WS_ACT);
    const unsigned char* UT = p.ws + WS_TAB8 + (size_t)layer * 2 * NEXP * DM; const unsigned char* VT = UT + (size_t)NEXP * DM;
    const float* SU = (const float*)(p.ws + WS_SCL) + (size_t)layer * 2 * NEXP; const float* SV = SU + NEXP;
    const int* ids = (const int*)(p.ws + WS_IDS); const float* gg = (const float*)(p.ws + WS_G);
    LAS unsigned char* wl = c.lds + c.wave * 4096;
    LAS bf16_t* xs = (LAS bf16_t*)wl; LAS float* dsm = (LAS float*)(wl + 2048);
    const int lane = c.lane, r = lane & 15, q = lane >> 4;
    for (int m = c.gwave; m < M; m += c.gwaves) {
        { const u32x4 xa = *((const u32x4*)(XN + (size_t)m * DM) + lane), xb = *((const u32x4*)(XN + (size_t)m * DM + 512) + lane);
          asm volatile("" ::: "memory"); *((LAS u32x4*)xs + lane) = xa; *((LAS u32x4*)(xs + 512) + lane) = xb; asm volatile("" ::: "memory"); }
        const int id0 = ids[(size_t)m * 128 + lane], id1 = ids[(size_t)m * 128 + 64 + lane];
#ifdef PROBE_VF32
        const float g0 = gg[(size_t)m * 128 + lane], g1 = gg[(size_t)m * 128 + 64 + lane];
#else
        const float g0 = gg[(size_t)m * 128 + lane] * SV[id0], g1 = gg[(size_t)m * 128 + 64 + lane] * SV[id1];
#endif
        const float su0 = SU[id0], su1 = SU[id1];
#pragma unroll 1
        for (int gp = 0; gp < 4; ++gp) {
            const int idsel = gp < 2 ? id0 : id1;
            const int ida = __shfl(idsel, (gp & 1) * 32 + r), idb = __shfl(idsel, (gp & 1) * 32 + 16 + r);
            const unsigned char* rowa = UT + (size_t)ida * DM + q * 16; const unsigned char* rowb = UT + (size_t)idb * DM + q * 16;
            f32x4 acca = {0.f, 0.f, 0.f, 0.f}, accb = {0.f, 0.f, 0.f, 0.f};
#pragma unroll 1
            for (int kc = 0; kc < 4; ++kc) {
                u32x4 a[4], bb[4];
#pragma unroll
                for (int s = 0; s < 4; ++s) { a[s] = *(const u32x4*)(rowa + (kc * 4 + s) * 64); bb[s] = *(const u32x4*)(rowb + (kc * 4 + s) * 64); }
                bf16x8 xb8[8];
#pragma unroll
                for (int s = 0; s < 4; ++s) { xb8[2 * s] = __builtin_bit_cast(bf16x8, *(const LAS u32x4*)(xs + (kc * 4 + s) * 64 + 16 * q)); xb8[2 * s + 1] = __builtin_bit_cast(bf16x8, *(const LAS u32x4*)(xs + (kc * 4 + s) * 64 + 16 * q + 8)); }
#pragma unroll
                for (int s = 0; s < 4; ++s) {
                    { const u32x2 c0 = fp8x4_to_bf16x4(a[s].x), c1 = fp8x4_to_bf16x4(a[s].y), c2 = fp8x4_to_bf16x4(a[s].z), c3 = fp8x4_to_bf16x4(a[s].w); const u32x4 b0 = {c0.x, c0.y, c1.x, c1.y}, b1 = {c2.x, c2.y, c3.x, c3.y};
                      acca = __builtin_amdgcn_mfma_f32_16x16x32_bf16(__builtin_bit_cast(bf16x8, b0), xb8[2 * s], acca, 0, 0, 0);
                      acca = __builtin_amdgcn_mfma_f32_16x16x32_bf16(__builtin_bit_cast(bf16x8, b1), xb8[2 * s + 1], acca, 0, 0, 0); }
                    { const u32x2 c0 = fp8x4_to_bf16x4(bb[s].x), c1 = fp8x4_to_bf16x4(bb[s].y), c2 = fp8x4_to_bf16x4(bb[s].z), c3 = fp8x4_to_bf16x4(bb[s].w); const u32x4 b0 = {c0.x, c0.y, c1.x, c1.y}, b1 = {c2.x, c2.y, c3.x, c3.y};
                      accb = __builtin_amdgcn_mfma_f32_16x16x32_bf16(__builtin_bit_cast(bf16x8, b0), xb8[2 * s], accb, 0, 0, 0);
                      accb = __builtin_amdgcn_mfma_f32_16x16x32_bf16(__builtin_bit_cast(bf16x8, b1), xb8[2 * s + 1], accb, 0, 0, 0); }
                    __builtin_amdgcn_sched_barrier(0); }
            }
            if (r == 0) { *(LAS f32x4*)(dsm + 32 * gp + 4 * q) = acca; *(LAS f32x4*)(dsm + 32 * gp + 16 + 4 * q) = accb; }
        }
        asm volatile("" ::: "memory");
        const float d0 = dsm[lane] * su0, d1 = dsm[64 + lane] * su1;
        asm volatile("" ::: "memory");
        const int act0 = __builtin_bit_cast(int, gelu_tanh(d0) * g0), act1 = __builtin_bit_cast(int, gelu_tanh(d1) * g1);
        float o[16];
#pragma unroll
        for (int i = 0; i < 16; ++i) o[i] = 0.f;
#pragma unroll
        for (int hh = 0; hh < 2; ++hh) { const int idv = hh ? id1 : id0; const int actv = hh ? act1 : act0;
#ifdef PROBE_VF32
#pragma unroll 1
            for (int e0 = 0; e0 < 64; ++e0) { const int id = __builtin_amdgcn_readlane(idv, e0); const float act = __builtin_bit_cast(float, __builtin_amdgcn_readlane(actv, e0));
                const f32x4* vr = (const f32x4*)(p.peer_v + ((size_t)layer * NEXP + id) * DM) + 4 * lane; const f32x4 v0 = vr[0], v1 = vr[1], v2 = vr[2], v3 = vr[3];
                o[0] += act * v0.x; o[1] += act * v0.y; o[2] += act * v0.z; o[3] += act * v0.w; o[4] += act * v1.x; o[5] += act * v1.y; o[6] += act * v1.z; o[7] += act * v1.w;
                o[8] += act * v2.x; o[9] += act * v2.y; o[10] += act * v2.z; o[11] += act * v2.w; o[12] += act * v3.x; o[13] += act * v3.y; o[14] += act * v3.z; o[15] += act * v3.w; } }
#else
#pragma unroll 1
            for (int e0 = 0; e0 < 64; e0 += 16) {
                u32x4 va[16]; float ae[16];
#pragma unroll
                for (int j = 0; j < 16; ++j) { const int id = __builtin_amdgcn_readlane(idv, e0 + j); ae[j] = __builtin_bit_cast(float, __builtin_amdgcn_readlane(actv, e0 + j));
                    va[j] = *((const u32x4*)(VT + (size_t)id * DM) + lane); }
#pragma unroll
                for (int j = 0; j < 16; ++j) { const float act = ae[j];
                    f32x2 t;
                    t = __builtin_amdgcn_cvt_pk_f32_fp8((int)va[j].x, false); o[0] += act * t.x; o[1] += act * t.y; t = __builtin_amdgcn_cvt_pk_f32_fp8((int)va[j].x, true); o[2] += act * t.x; o[3] += act * t.y;
                    t = __builtin_amdgcn_cvt_pk_f32_fp8((int)va[j].y, false); o[4] += act * t.x; o[5] += act * t.y; t = __builtin_amdgcn_cvt_pk_f32_fp8((int)va[j].y, true); o[6] += act * t.x; o[7] += act * t.y;
                    t = __builtin_amdgcn_cvt_pk_f32_fp8((int)va[j].z, false); o[8] += act * t.x; o[9] += act * t.y; t = __builtin_amdgcn_cvt_pk_f32_fp8((int)va[j].z, true); o[10] += act * t.x; o[11] += act * t.y;
                    t = __builtin_amdgcn_cvt_pk_f32_fp8((int)va[j].w, false); o[12] += act * t.x; o[13] += act * t.y; t = __builtin_amdgcn_cvt_pk_f32_fp8((int)va[j].w, true); o[14] += act * t.x; o[15] += act * t.y; }
            } }
#endif
        f32x4* hp = (f32x4*)(p.out + (size_t)m * DM) + 4 * lane;
        f32x4 h0 = hp[0], h1 = hp[1], h2 = hp[2], h3 = hp[3];
        h0 += (f32x4){o[0], o[1], o[2], o[3]}; h1 += (f32x4){o[4], o[5], o[6], o[7]}; h2 += (f32x4){o[8], o[9], o[10], o[11]}; h3 += (f32x4){o[12], o[13], o[14], o[15]};
        hp[0] = h0; hp[1] = h1; hp[2] = h2; hp[3] = h3;
    }
}

__device__ __forceinline__ void ph_g1(const Params& p, const Ctx& c) {
    const bf16_t* proj = (const bf16_t*)(p.ws + WS_PROJ); bf16_t* xc = (bf16_t*)(p.ws + WS_XC);
    for (size_t idx = c.gtid; idx < (size_t)M * DM; idx += c.gthreads) {
        const int ch = (int)(idx & 1023); const int row = (int)(idx >> 10); const int t = row & (SEQ - 1);
        float a = p.c_conv_b[ch];
#pragma unroll
        for (int j = 0; j < 4; ++j) { const int tt = t - 3 + j; if (tt >= 0) a += p.c_conv_w[j * 1024 + ch] * bf2f(proj[(size_t)(row - 3 + j) * 2048 + 1024 + ch]); }
        xc[idx] = (bf16_t)f2bf(a);
    }
}
__device__ __forceinline__ void ph_g2(const Params& p, const Ctx& c) {
    const bf16_t* xc = (const bf16_t*)(p.ws + WS_XC); float* A = (float*)(p.ws + WS_A); float* U = (float*)(p.ws + WS_U);
    for (size_t idx = c.gtid; idx < (size_t)M * DM; idx += c.gthreads) {
        const int ch = (int)(idx & 1023); const size_t row = idx >> 10; const int g = ch >> 7, j = ch & 127;
        const bf16_t* xr = xc + row * DM + g * 128; const float* wr = p.c_w_rgate + (size_t)g * 16384 + j; const float* wi = p.c_w_igate + (size_t)g * 16384 + j;
        float ar = p.c_b_rgate[ch], ai = p.c_b_igate[ch];
        for (int i = 0; i < 128; i += 8) { const u32x4 w = *(const u32x4*)(xr + i);
            const float x0 = bflo(w.x), x1 = bfhi(w.x), x2 = bflo(w.y), x3 = bfhi(w.y), x4 = bflo(w.z), x5 = bfhi(w.z), x6 = bflo(w.w), x7 = bfhi(w.w);
            ar += x0 * wr[(i) * 128] + x1 * wr[(i + 1) * 128] + x2 * wr[(i + 2) * 128] + x3 * wr[(i + 3) * 128] + x4 * wr[(i + 4) * 128] + x5 * wr[(i + 5) * 128] + x6 * wr[(i + 6) * 128] + x7 * wr[(i + 7) * 128];
            ai += x0 * wi[(i) * 128] + x1 * wi[(i + 1) * 128] + x2 * wi[(i + 2) * 128] + x3 * wi[(i + 3) * 128] + x4 * wi[(i + 4) * 128] + x5 * wi[(i + 5) * 128] + x6 * wi[(i + 6) * 128] + x7 * wi[(i + 7) * 128]; }
        const float r = sigmoidf_(ar), ig = sigmoidf_(ai);
        const float lam = p.c_lambda[ch]; const float sp = fmaxf(-lam, 0.f) + log1pf(expf(-fabsf(lam)));
        const float la = -8.f * r * sp;
        A[idx] = expf(la); U[idx] = sqrtf(-expm1f(2.f * la)) * (ig * bf2f(xc[idx]));
    }
}
__device__ __forceinline__ void ph_g3(const Params& p, const Ctx& c) {
    const bf16_t* proj = (const bf16_t*)(p.ws + WS_PROJ); const float* A = (const float*)(p.ws + WS_A); const float* U = (const float*)(p.ws + WS_U); bf16_t* y = (bf16_t*)(p.ws + WS_ACT);
    for (int idx = c.gtid; idx < BATCH * DM; idx += c.gthreads) {
        const int b = idx >> 10, ch = idx & 1023; float h = 0.f;
        for (int t0 = 0; t0 < SEQ; t0 += 8) {
            float a[8], u[8], g[8];
#pragma unroll
            for (int j = 0; j < 8; ++j) { const size_t e = (size_t)(b * SEQ + t0 + j) * DM + ch; a[j] = A[e]; u[j] = U[e]; g[j] = bf2f(proj[(size_t)(b * SEQ + t0 + j) * 2048 + ch]); }
#pragma unroll
            for (int j = 0; j < 8; ++j) { h = a[j] * h + u[j]; y[(size_t)(b * SEQ + t0 + j) * DM + ch] = (bf16_t)f2bf(gelu_tanh(g[j]) * h); }
        }
    }
}
#define XB_TMO      128
#define XB_XCNT(j)  (256  + 64 * (j))
#define XB_XSUB(j)  (1280 + 64 * (j))
#define XB_XGEN(j)  (2304 + 64 * (j))
#define XB_TOP      3328
#define XB_TOPGEN   3392
#define XCD_BAR_WORDS 3456
#define XB_SPIN_CAP (1u << 18)

__device__ __forceinline__ unsigned xb_ld(unsigned* p)              { return __hip_atomic_load(p, __ATOMIC_RELAXED, __HIP_MEMORY_SCOPE_AGENT); }
__device__ __forceinline__ unsigned xb_add(unsigned* p, unsigned v) { return __hip_atomic_fetch_add(p, v, __ATOMIC_RELAXED, __HIP_MEMORY_SCOPE_AGENT); }
__device__ __forceinline__ unsigned xb_xcc_id() { return (unsigned)__builtin_amdgcn_s_getreg((3 << 11) | 20) & 0xFu; }
#define XB_SPIN(cond, bar) do { unsigned _sp = 0; while (cond) { __builtin_amdgcn_s_sleep(1); \
    if ((++_sp & 255u) == 0u) { if (xb_ld(&(bar)[XB_TMO])) break; if (_sp > XB_SPIN_CAP) { atomicAdd(&(bar)[XB_TMO], 1u); break; } } } } while (0)

struct XcdBarrier {
    unsigned* bar; unsigned x;
    volatile LAS unsigned* st;
};

__device__ __forceinline__ XcdBarrier xcd_barrier_post(unsigned* bar, volatile LAS unsigned* st) {
    XcdBarrier b; b.bar = bar; b.x = xb_xcc_id(); b.st = st;
    if (threadIdx.x == 0) (void)xb_add(&bar[XB_XCNT(b.x)], 1u);
    return b;
}
__device__ __forceinline__ void xcd_barrier_complete(unsigned* bar, unsigned x, unsigned& nloc, unsigned& nx) {
    const unsigned G = gridDim.x * gridDim.y * gridDim.z;
    unsigned sum, cnt, mine, sp = 0u;
    for (;;) {
        sum = 0u; cnt = 0u; mine = 0u;
#pragma unroll
        for (unsigned j = 0; j < 16; ++j) { const unsigned c = xb_ld(&bar[XB_XCNT(j)]); sum += c; cnt += (c > 0u) ? 1u : 0u; mine = (j == x) ? c : mine; }
        if (sum == G) break;
        __builtin_amdgcn_s_sleep(1);
        if ((++sp & 255u) == 0u) { if (xb_ld(&bar[XB_TMO])) break; if (sp > XB_SPIN_CAP) { atomicAdd(&bar[XB_TMO], 1u); break; } }
    }
    nloc = mine > 0u ? mine : 1u; nx = cnt > 0u ? cnt : 1u;
}

__device__ __forceinline__ void xcd_barrier(const XcdBarrier& b) {
    asm volatile("s_waitcnt vmcnt(0)" ::: "memory");
    __syncthreads();
    if (threadIdx.x == 0) {
        unsigned* bar = b.bar;
        __builtin_amdgcn_s_waitcnt(0);
        unsigned nloc = b.st[0], nx = b.st[1];
        if (nloc == 0u) { xcd_barrier_complete(bar, b.x, nloc, nx); b.st[0] = nloc; b.st[1] = nx; }
        const unsigned old = xb_add(&bar[XB_XSUB(b.x)], 1u);
        const unsigned gen = old / nloc;
        if (old + 1u == (gen + 1u) * nloc) {
            __builtin_amdgcn_fence(__ATOMIC_RELEASE, "agent");
            asm volatile("s_waitcnt vmcnt(0)" ::: "memory");
            const unsigned og = xb_add(&bar[XB_TOP], 1u);
            const unsigned tg = og / nx;
            if (og + 1u == (tg + 1u) * nx) xb_add(&bar[XB_TOPGEN], 1u);
            else XB_SPIN(xb_ld(&bar[XB_TOPGEN]) == tg, bar);
            __builtin_amdgcn_fence(__ATOMIC_ACQUIRE, "agent");
            xb_add(&bar[XB_XGEN(b.x)], 1u);
            asm volatile("s_waitcnt vmcnt(0)" ::: "memory");
        } else {
            XB_SPIN(xb_ld(&bar[XB_XGEN(b.x)]) == gen, bar);
            __builtin_amdgcn_fence(__ATOMIC_ACQUIRE, "agent");
            asm volatile("s_waitcnt vmcnt(0)" ::: "memory");
        }
    }
    __syncthreads();
}

enum Phase { PH_PRO = 0, PH_GEMM_IN0, PH_MIXER0, PH_GLA_B, PH_GLA_C, PH_MIX0, PH_GEMM_OUT0, PH_NORM_F0, PH_GEMM_Q0, PH_TOPK1_0, PH_GATHER0,
             PH_NORM_M1, PH_GEMM_CIN, PH_G1, PH_G2, PH_G3, PH_GEMM_OUT1, PH_NORM_F1, PH_GEMM_Q1, PH_TOPK1_1, PH_GATHER1, PH_FINAL, NPHASES };

#ifndef PH_ONLY
#define PH_ONLY (-1)
#endif
#define PH_ENABLED(x) (PH_ONLY < 0 || PH_ONLY == (x))
#ifndef MK_N_LAUNCHES
#define MK_N_LAUNCHES 1
#endif

template <class Epi> __device__ __forceinline__ void run_gemm(const Ctx& c, const bf16_t* A, const bf16_t* Bt, int N, const Epi& E) {
    pg8::Gemm g{A, Bt, M, N, DM}; pg8::StaticOrder S; S.init(M, N, c.nblk, c.blk);
    pg8::gemm_phase<Epi, pg8::StaticOrder, true, true>(c.lds, g, S, E);
}

#ifdef PROBE_RT
#define GATHER_CALL(l) ph_gather2(p, c)
#else
#define GATHER_CALL(l) ph_gather3(p, l, c)
#endif
#define MKCTX() Ctx c; { int t_ = threadIdx.x; asm volatile("" : "+v"(t_)); c.lds = lds; c.tid = t_; c.lane = t_ & 63; c.wave = __builtin_amdgcn_readfirstlane(t_ >> 6); \
    c.blk = blockIdx.x; c.nblk = gridDim.x; c.gtid = c.blk * NTHREADS + c.tid; c.gthreads = c.nblk * NTHREADS; c.gwave = c.blk * NWAVES + c.wave; c.gwaves = c.nblk * NWAVES; }
__global__ void __launch_bounds__(NTHREADS, 2) mega_fwd(Params p) {
    extern __shared__ __attribute__((aligned(16))) unsigned char lds_raw[];
    volatile LAS unsigned* MISC = (volatile LAS unsigned*)((LAS unsigned char*)lds_raw + MISC_OFF);
    LAS unsigned char* const lds = (LAS unsigned char*)lds_raw;
    for (int u = threadIdx.x; u < (LDS_BYTES - LDSCTL_OFF) / 4; u += NTHREADS) ((LAS unsigned*)(lds + LDSCTL_OFF))[u] = 0u;
    __syncthreads();
    unsigned* ctl = (unsigned*)(p.ws + WS_CTL);
    XcdBarrier bar; bar.bar = ctl + CW_BAR; bar.x = 0; bar.st = nullptr;
    const bool multi = (p.ph_hi - p.ph_lo) > 1;
    if (multi) bar = xcd_barrier_post(ctl + CW_BAR, MISC + 8);
    unsigned char* ws = p.ws;
    bf16_t* ACT = (bf16_t*)(ws + WS_ACT); bf16_t* PROJ = (bf16_t*)(ws + WS_PROJ);

    const int lo = p.ph_lo, hi = p.ph_hi;
#define IN(k) (PH_ENABLED(k) && lo <= (k) && (k) < hi)
#define SEAM(k) do { if ((k) + 1 < hi) xcd_barrier(bar); } while (0)
    if (IN(PH_PRO)) { MKCTX();
        transpose_cvt(p.ab_w_in, DM, NIN, (bf16_t*)(ws + WS_WT_IN), NIN_PAD, [](int n) { return n < 1536 ? n : (n < 3072 ? n + 16 : (n < 3088 ? n - 3072 + 1536 : -1)); }, c.gtid, c.gthreads);
        transpose_cvt(p.ab_w_out, DM, DM, (bf16_t*)(ws + WS_WT_OUT), DM, [](int n) { return n; }, c.gtid, c.gthreads);
        transpose_cvt(p.c_w_in, DM, 2048, (bf16_t*)(ws + WS_WT_CIN), 2048, [](int n) { return n; }, c.gtid, c.gthreads);
        transpose_cvt(p.c_w_out, DM, DM, (bf16_t*)(ws + WS_WT_COUT), DM, [](int n) { return n; }, c.gtid, c.gthreads);
        transpose_cvt(p.peer_w_query, DM, 2048, (bf16_t*)(ws + WS_WT_Q0), 2048, [](int n) { return n; }, c.gtid, c.gthreads);
        transpose_cvt(p.peer_w_query + (size_t)DM * 2048, DM, 2048, (bf16_t*)(ws + WS_WT_Q1), 2048, [](int n) { return n; }, c.gtid, c.gthreads);
#ifdef PROBE_RT
        cvt_fp8_roundtrip_rows(p.peer_u, (bf16_t*)(ws + WS_TAB), NEXP, c);
        cvt_fp8_roundtrip_rows(p.peer_v, (bf16_t*)(ws + WS_TAB) + (size_t)NEXP * DM, NEXP, c);
#else
        cvt_fp8_rows(p.peer_u, ws + WS_TAB8, (float*)(ws + WS_SCL), NEXP, c);
        cvt_fp8_rows(p.peer_v, ws + WS_TAB8 + (size_t)NEXP * DM, (float*)(ws + WS_SCL) + NEXP, NEXP, c);
#endif
        cvt_gate_weights(p, c);
        cvt_bf16(p.peer_sub_keys, (bf16_t*)(ws + WS_SK), (size_t)2 * 8 * 2 * 128 * 128 / 8, c.gtid, c.gthreads);
        norm_rows_bf16(p.x, p.mix_norm, ACT, c);
        SEAM(PH_PRO); }
    if (IN(PH_GEMM_IN0)) { MKCTX(); pg8::EpiBf16<0> E{PROJ, NIN_PAD, nullptr, 0, 0, 1.f}; run_gemm(c, ACT, (const bf16_t*)(ws + WS_WT_IN), NIN_PAD, E); SEAM(PH_GEMM_IN0); }
    if (IN(PH_MIXER0)) { MKCTX(); ph_gla_a(p, c); ph_attn(p, c); SEAM(PH_MIXER0); }
    if (IN(PH_GLA_B)) { MKCTX(); ph_gla_b(p, c); SEAM(PH_GLA_B); }
    if (IN(PH_GLA_C)) { MKCTX(); ph_gla_c(p, c); SEAM(PH_GLA_C); }
    if (IN(PH_MIX0)) { MKCTX(); ph_mix(p, c); SEAM(PH_MIX0); }
    if (IN(PH_GEMM_OUT0)) { MKCTX(); pg8::EpiResF32 E{p.x, p.out, DM}; run_gemm(c, ACT, (const bf16_t*)(ws + WS_WT_OUT), DM, E); SEAM(PH_GEMM_OUT0); }
    if (IN(PH_NORM_F0)) { MKCTX(); norm_rows_bf16(p.out, p.ffn_norm, ACT, c); SEAM(PH_NORM_F0); }
    if (IN(PH_GEMM_Q0)) { MKCTX(); pg8::EpiBf16<0> E{PROJ, 2048, nullptr, 0, 0, 1.f}; run_gemm(c, ACT, (const bf16_t*)(ws + WS_WT_Q0), 2048, E); SEAM(PH_GEMM_Q0); }
    if (IN(PH_TOPK1_0)) { MKCTX(); ph_topk(p, 0, c); SEAM(PH_TOPK1_0); }
    if (IN(PH_GATHER0)) { MKCTX(); GATHER_CALL(0); SEAM(PH_GATHER0); }
    if (IN(PH_NORM_M1)) { MKCTX(); norm_rows_bf16(p.out, p.mix_norm + DM, ACT, c); SEAM(PH_NORM_M1); }
    if (IN(PH_GEMM_CIN)) { MKCTX(); pg8::EpiBf16<0> E{PROJ, 2048, nullptr, 0, 0, 1.f}; run_gemm(c, ACT, (const bf16_t*)(ws + WS_WT_CIN), 2048, E); SEAM(PH_GEMM_CIN); }
    if (IN(PH_G1)) { MKCTX(); griffin_pass<false>(p, c); SEAM(PH_G1); }
    if (IN(PH_G2)) { MKCTX(); ph_carry(p, c); SEAM(PH_G2); }
    if (IN(PH_G3)) { MKCTX(); griffin_pass<true>(p, c); SEAM(PH_G3); }
    if (IN(PH_GEMM_OUT1)) { MKCTX(); pg8::EpiResF32 E{p.out, p.out, DM}; run_gemm(c, ACT, (const bf16_t*)(ws + WS_WT_COUT), DM, E); SEAM(PH_GEMM_OUT1); }
    if (IN(PH_NORM_F1)) { MKCTX();
        norm_rows_bf16(p.out, p.ffn_norm + DM, ACT, c);
#ifdef PROBE_RT
        cvt_fp8_roundtrip_rows(p.peer_u + (size_t)NEXP * DM, (bf16_t*)(ws + WS_TAB), NEXP, c);
        cvt_fp8_roundtrip_rows(p.peer_v + (size_t)NEXP * DM, (bf16_t*)(ws + WS_TAB) + (size_t)NEXP * DM, NEXP, c);
#else
        cvt_fp8_rows(p.peer_u + (size_t)NEXP * DM, ws + WS_TAB8 + (size_t)2 * NEXP * DM, (float*)(ws + WS_SCL) + 2 * NEXP, NEXP, c);
        cvt_fp8_rows(p.peer_v + (size_t)NEXP * DM, ws + WS_TAB8 + (size_t)3 * NEXP * DM, (float*)(ws + WS_SCL) + 3 * NEXP, NEXP, c);
#endif
        SEAM(PH_NORM_F1); }
    if (IN(PH_GEMM_Q1)) { MKCTX(); pg8::EpiBf16<0> E{PROJ, 2048, nullptr, 0, 0, 1.f}; run_gemm(c, ACT, (const bf16_t*)(ws + WS_WT_Q1), 2048, E); SEAM(PH_GEMM_Q1); }
    if (IN(PH_TOPK1_1)) { MKCTX(); ph_topk(p, 1, c); SEAM(PH_TOPK1_1); }
    if (IN(PH_GATHER1)) { MKCTX(); GATHER_CALL(1); SEAM(PH_GATHER1); }
    if (IN(PH_FINAL)) { MKCTX(); norm_rows_f32(p.out, p.final_norm, c); }
#undef IN
#undef SEAM
}

extern "C" void kernel_launch(void* const* d_in, const int* in_sizes, int n_in, void* d_out, int out_size, void* d_ws, size_t ws_size, hipStream_t stream) {
    static int grid = 0;
    if (grid == 0) {
        if (n_in != 22 || out_size != M * DM || ws_size < WS_END) { fprintf(stderr, "kernel_launch: unexpected shapes: n_in %d out %d ws %zu (need %zu)\n", n_in, out_size, ws_size, (size_t)WS_END); grid = -1; return; }
        int dev = 0, cus = 0, per_cu = 0;
        if (hipGetDevice(&dev) != hipSuccess || hipDeviceGetAttribute(&cus, hipDeviceAttributeMultiprocessorCount, dev) != hipSuccess) { grid = -1; return; }
        if (hipFuncSetAttribute((const void*)mega_fwd, hipFuncAttributeMaxDynamicSharedMemorySize, LDS_BYTES) != hipSuccess) { fprintf(stderr, "kernel_launch: hipFuncSetAttribute failed\n"); grid = -1; return; }
        if (hipOccupancyMaxActiveBlocksPerMultiprocessor(&per_cu, (const void*)mega_fwd, NTHREADS, LDS_BYTES) != hipSuccess || per_cu < 1) { fprintf(stderr, "kernel_launch: occupancy query says %d blocks per CU\n", per_cu); per_cu = 1; }
        (void)hipGetLastError();
        grid = cus;
        if (grid % 8 != 0 || grid < 32) { fprintf(stderr, "kernel_launch: unexpected CU count %d\n", cus); }
    }
    if (grid < 0) return;
    (void)hipMemsetAsync((char*)d_ws + WS_CTL, 0, CTL_ZERO_BYTES, stream);
    Params p{};
    const float** pp = (const float**)&p;
    for (int i = 0; i < 22; ++i) pp[i] = (const float*)d_in[i];
    p.out = (float*)d_out; p.ws = (unsigned char*)d_ws;
#if MK_N_LAUNCHES == 1
    p.ph_lo = 0; p.ph_hi = NPHASES;
    void* args[] = {&p};
    hipError_t e = hipLaunchCooperativeKernel((const void*)mega_fwd, dim3(grid), dim3(NTHREADS), args, LDS_BYTES, stream);
    if (e != hipSuccess) fprintf(stderr, "cooperative launch failed: %s (grid %d)\n", hipGetErrorString(e), grid);
#else
    for (int ph = 0; ph < NPHASES; ++ph) { p.ph_lo = ph; p.ph_hi = ph + 1; hipLaunchKernelGGL(mega_fwd, dim3(grid), dim3(NTHREADS), LDS_BYTES, stream, p); }
#endif
}
```

```cpp
#include <hip/hip_runtime.h>
#include <hip/hip_bf16.h>
#include <cstdio>
#include <cstdint>
#include <cmath>
namespace pg8 {
#define PG8_LAS __attribute__((address_space(3)))
typedef unsigned short bf16_t;
typedef short bf16x8 __attribute__((ext_vector_type(8)));
typedef float f32x4 __attribute__((ext_vector_type(4)));
typedef unsigned u32x4 __attribute__((ext_vector_type(4)));
constexpr int BM = 256, BK = 64, HALF = 128, HTB = HALF * BK * 2  , STAGE_BYTES = 8 * HTB, NXCD = 8, WGM = 8;

__host__ __device__ __forceinline__ int lds_byte(int r, int c) { const int st = (r >> 4) * 2 + (c >> 5), rr = r & 15, cc = c & 31, ob = rr * 64 + cc * 2; return st * 1024 + (ob ^ (((ob >> 9) & 1) << 5)); }
__host__ __device__ __forceinline__ void stage_rc(int b, int& R, int& C) { const int st = b / 1024, sb = b % 1024, swz = sb ^ (((sb >> 9) & 1) << 5); R = (st >> 1) * 16 + swz / 64; C = (st & 1) * 32 + (swz % 64) / 2; }
__host__ __device__ __forceinline__ int perm32(int rho) { const int n = rho >> 4, i = rho & 15; return 8 * (i >> 2) + 4 * n + (i & 3); }

struct Unit { int pm, pn; };
struct Gemm { const bf16_t* A; const bf16_t* Bt; int M, N, K; };

struct StaticOrder {
    int nM, nN, nwg, G, c;
    __host__ __device__ void init(int M, int N, int G_, int c_) { nM = M / BM; nN = N / BM; nwg = nM * nN; G = G_; c = c_; }
    __host__ __device__ bool next(int i, Unit& u) const {
        const long L = (long)i * G + c; if (L >= nwg) return false;
        int wgid = (int)L; { const int q = nwg / NXCD, r = nwg % NXCD, xcd = wgid % NXCD, off = wgid / NXCD; wgid = (xcd < r ? xcd * (q + 1) : r * (q + 1) + (xcd - r) * q) + off; }
        const int nig = WGM * nN, gid = wgid / nig, fm = gid * WGM, gsz = (nM - fm) < WGM ? (nM - fm) : WGM;
        u.pm = fm + ((wgid % nig) % gsz); u.pn = (wgid % nig) / gsz; return true;
    }
    __device__ __forceinline__ void a_ready(const Unit&) const {}
    __device__ __forceinline__ void done(const Unit&) const {}
};

__device__ __forceinline__ unsigned cvt_pk_bf16(float lo, float hi) { unsigned r; asm volatile("v_cvt_pk_bf16_f32 %0, %1, %2" : "=v"(r) : "v"(lo), "v"(hi)); return r; }
typedef float f32x2 __attribute__((ext_vector_type(2)));
__device__ __forceinline__ f32x2 gelu_pk(f32x2 v) {
    const f32x2 av = __builtin_elementwise_abs(v), d = av * 0.2316418882f + 1.0f;
    f32x2 t; t.x = __builtin_amdgcn_rcpf(d.x); t.y = __builtin_amdgcn_rcpf(d.y);
    f32x2 q = t * 0.5307027145f + (-0.7265760135f); q = q * t + 0.7107068705f; q = q * t + (-0.142248368f); q = q * t + 0.127414796f; q = q * t;
    const f32x2 s = (v * v) * (-0.72134752044f);
    f32x2 e; e.x = __builtin_amdgcn_exp2f(s.x); e.y = __builtin_amdgcn_exp2f(s.y);
    const f32x2 m = v * (q * e), r = v - m;
    f32x2 o; o.x = v.x < 0.f ? m.x : r.x; o.y = v.y < 0.f ? m.y : r.y; return o;
}
template <int ACT  > struct EpiBf16 {
    static constexpr bool PERM = true, AFTER_DRAIN = false; static_assert(ACT == 0 || ACT == 1, "EpiBf16: ACT is 0 (none) or 1 (gelu_pk)");
    bf16_t* O; int ldc; const float* bias; int split_cols; size_t split_stride; float scale0;
    __device__ __forceinline__ void operator()(const f32x4 (&acc)[2][2][4][2], const Unit& u, int wr, int wc, int fr, int fq) const {
        const int row0 = u.pm * BM + wr * 64 + fr; int colt = u.pn * BM; bf16_t* base = O;
        float sc = 1.f; if (split_cols) { const int t = colt / split_cols; base += (size_t)t * split_stride; colt -= t * split_cols; if (t == 0) sc = scale0; }
        const int col0 = colt + wc * 32 + 8 * fq, bcol0 = u.pn * BM + wc * 32 + 8 * fq;
        f32x4 bv[2][2];
#pragma unroll
        for (int bj = 0; bj < 2; ++bj)
#pragma unroll
            for (int n = 0; n < 2; ++n) bv[bj][n] = bias ? *(const f32x4*)(bias + bcol0 + bj * HALF + 4 * n) : (f32x4){0.f, 0.f, 0.f, 0.f};
#pragma unroll
        for (int ai = 0; ai < 2; ++ai)
#pragma unroll
            for (int m = 0; m < 4; ++m) { bf16_t* rowp = base + (size_t)(row0 + ai * HALF + m * 16) * ldc + col0;
#pragma unroll
                for (int bj = 0; bj < 2; ++bj) { f32x4 v0 = acc[ai][bj][m][0] + bv[bj][0], v1 = acc[ai][bj][m][1] + bv[bj][1];
                    if (ACT == 1) { f32x2 a = gelu_pk((f32x2){v0[0], v0[1]}), b = gelu_pk((f32x2){v0[2], v0[3]}), c = gelu_pk((f32x2){v1[0], v1[1]}), d = gelu_pk((f32x2){v1[2], v1[3]});
                        v0 = (f32x4){a.x, a.y, b.x, b.y}; v1 = (f32x4){c.x, c.y, d.x, d.y}; }
                    v0 = v0 * sc; v1 = v1 * sc; u32x4 w; w.x = cvt_pk_bf16(v0[0], v0[1]); w.y = cvt_pk_bf16(v0[2], v0[3]); w.z = cvt_pk_bf16(v1[0], v1[1]); w.w = cvt_pk_bf16(v1[2], v1[3]);
                    *(u32x4*)(rowp + bj * HALF) = w; } }
    }
};
template <class Epi, class Sched, bool ALIGN_EPI = false, bool SP2 = false>
__device__ __forceinline__ void gemm_phase(PG8_LAS unsigned char* lds, const Gemm g, const Sched& S, const Epi& E) {
    const int tid = threadIdx.x, wid = __builtin_amdgcn_readfirstlane(tid >> 6), lane = tid & 63, wr = wid >> 2, wc = wid & 3, fr = lane & 15, fq = lane >> 4;
    const int K = g.K, nt = K / BK;
    unsigned voffA[2], voffB[2];
#pragma unroll
    for (int i = 0; i < 2; ++i) { int R, C; stage_rc(tid * 16 + i * 8192, R, C); const int Rb = Epi::PERM ? ((R & ~31) + perm32(R & 31)) : R;
        voffA[i] = (unsigned)(R * K + C) * 2u; voffB[i] = (unsigned)(Rb * K + C) * 2u; }
    const size_t kstep = (size_t)(BK * 2);
    const size_t hstep = (size_t)HALF * K * 2;
    const size_t tstep = 2 * hstep;
    const unsigned ldsw = (unsigned)wid * 1024u;
    const int aoff = lds_byte(wr * 64 + fr, fq * 8), boff = lds_byte(wc * 32 + fr, fq * 8);
#define PG8_SA(b, h) (((b) * 2 + (h)) * HTB)
#define PG8_SB(b, h) ((4 + (b) * 2 + (h)) * HTB)
#define PG8_STAGE(bufoff, gbase, voff) do { _Pragma("unroll") for (int _i = 0; _i < 2; ++_i) \
        __builtin_amdgcn_global_load_lds((const unsigned*)((const char*)(gbase) + (voff)[_i]), (PG8_LAS unsigned*)(lds + (bufoff) + ldsw + _i * 8192), 16, 0, 0); } while (0)
#define PG8_LDA(dst, b, h) do { _Pragma("unroll") for (int m = 0; m < 4; ++m) _Pragma("unroll") for (int k = 0; k < 2; ++k) dst[m][k] = *(const PG8_LAS bf16x8*)(lds + PG8_SA(b, h) + aoff + m * 2048 + k * 1024); } while (0)
#define PG8_LDB(dst, b, h) do { _Pragma("unroll") for (int n = 0; n < 2; ++n) _Pragma("unroll") for (int k = 0; k < 2; ++k) dst[n][k] = *(const PG8_LAS bf16x8*)(lds + PG8_SB(b, h) + boff + n * 2048 + k * 1024); } while (0)
#define PG8_MMA(ai, bj, At, Bt) do { __builtin_amdgcn_s_setprio(1); _Pragma("unroll") for (int m = 0; m < 4; ++m) _Pragma("unroll") for (int n = 0; n < 2; ++n) _Pragma("unroll") for (int k = 0; k < 2; ++k) \
        acc[ai][bj][m][n] = __builtin_amdgcn_mfma_f32_16x16x32_bf16(Bt[n][k], At[m][k], acc[ai][bj][m][n], 0, 0, 0); __builtin_amdgcn_s_setprio(0); } while (0)
#define PG8_WAIT_V(n) asm volatile("s_waitcnt vmcnt(" #n ")" ::: "memory")
#define PG8_WAIT_L(n) asm volatile("s_waitcnt lgkmcnt(" #n ")" ::: "memory")
#define PG8_BAR __builtin_amdgcn_s_barrier()
#define PG8_SCHED __builtin_amdgcn_sched_barrier(0)
    Unit cur, nxt; int ui = 0;
    if (!S.next(0, cur)) return;
    f32x4 acc[2][2][4][2];
#pragma unroll
    for (int a = 0; a < 2; ++a)
#pragma unroll
        for (int b = 0; b < 2; ++b)
#pragma unroll
            for (int m = 0; m < 4; ++m)
#pragma unroll
                for (int n = 0; n < 2; ++n) acc[a][b][m][n] = (f32x4){0.f, 0.f, 0.f, 0.f};
    bf16x8 At[4][2], B0[2][2], B1[2][2];
    const char* cA = (const char*)g.A + (size_t)cur.pm * tstep; const char* cB = (const char*)g.Bt + (size_t)cur.pn * tstep;
    S.a_ready(cur);
    if constexpr (SP2) {
        PG8_STAGE(PG8_SB(0, 0), cB, voffB); PG8_STAGE(PG8_SB(0, 1), cB + hstep, voffB); PG8_STAGE(PG8_SA(0, 0), cA, voffA); PG8_STAGE(PG8_SA(0, 1), cA + hstep, voffA);
        if (wr == 1) PG8_BAR;
        PG8_WAIT_V(2); PG8_BAR;
        PG8_STAGE(PG8_SB(1, 0), cB + kstep, voffB); PG8_STAGE(PG8_SA(1, 0), cA + kstep, voffA); PG8_STAGE(PG8_SB(1, 1), cB + hstep + kstep, voffB);
        PG8_WAIT_V(6); PG8_BAR;
    } else {
        PG8_STAGE(PG8_SB(0, 0), cB, voffB); PG8_STAGE(PG8_SA(0, 0), cA, voffA); PG8_STAGE(PG8_SB(0, 1), cB + hstep, voffB); PG8_STAGE(PG8_SA(0, 1), cA + hstep, voffA);
        if (wr == 1) PG8_BAR;
        PG8_WAIT_V(4); PG8_BAR;
        PG8_STAGE(PG8_SB(1, 0), cB + kstep, voffB); PG8_STAGE(PG8_SA(1, 0), cA + kstep, voffA); PG8_STAGE(PG8_SB(1, 1), cB + hstep + kstep, voffB);
        PG8_WAIT_V(6); PG8_BAR;
    }
    for (;;) {
        const bool has_next = S.next(ui + 1, nxt);
        const char* nA = has_next ? (const char*)g.A + (size_t)nxt.pm * tstep : cA; const char* nB = has_next ? (const char*)g.Bt + (size_t)nxt.pn * tstep : cB;
        for (int t = 0; t < nt; t += 2) {
            const bool last = (t == nt - 2);
            const char* a1 = cA + (size_t)(t + 1) * kstep;
            const char* a2 = last ? nA : cA + (size_t)(t + 2) * kstep; const char* b2 = last ? nB : cB + (size_t)(t + 2) * kstep;
            const char* a3 = a2 + kstep; const char* b3 = b2 + kstep;
            if (last && has_next) S.a_ready(nxt);
            if constexpr (SP2) {
            PG8_LDB(B0, 0, 0); PG8_LDB(B1, 0, 1); PG8_SCHED; PG8_LDA(At, 0, 0); PG8_STAGE(PG8_SA(1, 1), a1 + hstep, voffA);
            PG8_WAIT_V(8); PG8_WAIT_L(0); PG8_BAR; PG8_MMA(0, 0, At, B0); PG8_MMA(0, 1, At, B1); PG8_BAR; PG8_SCHED;
            PG8_LDA(At, 0, 1); PG8_STAGE(PG8_SB(0, 0), b2, voffB); PG8_STAGE(PG8_SB(0, 1), b2 + hstep, voffB); PG8_STAGE(PG8_SA(0, 0), a2, voffA);
            PG8_WAIT_V(8); PG8_WAIT_L(0); PG8_BAR; PG8_MMA(1, 0, At, B0); PG8_MMA(1, 1, At, B1); PG8_BAR; PG8_SCHED;
            PG8_LDB(B0, 1, 0); PG8_LDB(B1, 1, 1); PG8_SCHED; PG8_LDA(At, 1, 0); PG8_STAGE(PG8_SA(0, 1), a2 + hstep, voffA);
            PG8_WAIT_V(8); PG8_WAIT_L(0); PG8_BAR; PG8_MMA(0, 0, At, B0); PG8_MMA(0, 1, At, B1); PG8_BAR; PG8_SCHED;
            PG8_LDA(At, 1, 1); PG8_STAGE(PG8_SB(1, 0), b3, voffB); PG8_STAGE(PG8_SB(1, 1), b3 + hstep, voffB); PG8_STAGE(PG8_SA(1, 0), a3, voffA);
            PG8_WAIT_V(8); PG8_WAIT_L(0); PG8_BAR; PG8_MMA(1, 0, At, B0); PG8_MMA(1, 1, At, B1); PG8_BAR; PG8_SCHED;
            } else {
            PG8_LDB(B0, 0, 0); PG8_SCHED; PG8_LDA(At, 0, 0); PG8_STAGE(PG8_SA(1, 1), a1 + hstep, voffA);
            PG8_WAIT_L(8); PG8_BAR; PG8_WAIT_L(0); PG8_MMA(0, 0, At, B0); PG8_BAR; PG8_SCHED;
            PG8_LDB(B1, 0, 1); PG8_STAGE(PG8_SB(0, 0), b2, voffB);
            PG8_BAR; PG8_WAIT_L(0); PG8_MMA(0, 1, At, B1); PG8_BAR;
            PG8_LDA(At, 0, 1); PG8_STAGE(PG8_SA(0, 0), a2, voffA);
            PG8_BAR; PG8_WAIT_L(0); PG8_MMA(1, 0, At, B0); PG8_BAR; PG8_SCHED;
            PG8_STAGE(PG8_SB(0, 1), b2 + hstep, voffB);
            PG8_WAIT_V(6); PG8_BAR; PG8_MMA(1, 1, At, B1); PG8_BAR;
            PG8_LDB(B0, 1, 0); PG8_SCHED; PG8_LDA(At, 1, 0); PG8_STAGE(PG8_SA(0, 1), a2 + hstep, voffA);
            PG8_WAIT_L(8); PG8_BAR; PG8_WAIT_L(0); PG8_MMA(0, 0, At, B0); PG8_BAR; PG8_SCHED;
            PG8_LDB(B1, 1, 1); PG8_STAGE(PG8_SB(1, 0), b3, voffB);
            PG8_BAR; PG8_WAIT_L(0); PG8_MMA(0, 1, At, B1); PG8_BAR;
            PG8_LDA(At, 1, 1); PG8_STAGE(PG8_SA(1, 0), a3, voffA);
            PG8_BAR; PG8_WAIT_L(0); PG8_MMA(1, 0, At, B0); PG8_BAR; PG8_SCHED;
            PG8_STAGE(PG8_SB(1, 1), b3 + hstep, voffB);
            PG8_WAIT_V(6); PG8_BAR; PG8_MMA(1, 1, At, B1); PG8_BAR;
            }
        }
        if constexpr (ALIGN_EPI) { if (wr == 0) PG8_BAR; }
        if constexpr (!Epi::AFTER_DRAIN) { E(acc, cur, wr, wc, fr, fq); S.done(cur); }
        if (!has_next) break;
#pragma unroll
        for (int a = 0; a < 2; ++a)
#pragma unroll
            for (int b = 0; b < 2; ++b)
#pragma unroll
                for (int m = 0; m < 4; ++m)
#pragma unroll
                    for (int n = 0; n < 2; ++n) acc[a][b][m][n] = (f32x4){0.f, 0.f, 0.f, 0.f};
        cur = nxt; cA = nA; cB = nB; ++ui;
        if constexpr (ALIGN_EPI) { if (wr == 1) PG8_BAR; }
    }
    PG8_WAIT_V(0);
    if constexpr (!ALIGN_EPI) { if (wr == 0) PG8_BAR; }
    PG8_BAR;
    if constexpr (Epi::AFTER_DRAIN) { E.fused(acc, cur, wr, wc, fr, fq, lds, wid, lane); S.done(cur); }
#undef PG8_SA
#undef PG8_SB
#undef PG8_STAGE
#undef PG8_LDA
#undef PG8_LDB
#undef PG8_MMA
#undef PG8_WAIT_V
#undef PG8_WAIT_L
#undef PG8_BAR
#undef PG8_SCHED
}

struct EpiResF32 {
    static constexpr bool PERM = false, AFTER_DRAIN = false;
    const float* base; float* out; int ldc;
    __device__ __forceinline__ void operator()(const f32x4 (&acc)[2][2][4][2], const Unit& u, int wr, int wc, int fr, int fq) const {
        const int col0 = u.pn * BM + wc * 32 + 4 * fq;
#pragma unroll
        for (int ai = 0; ai < 2; ++ai)
#pragma unroll
            for (int m = 0; m < 4; ++m) { const int r = ai * HALF + wr * 64 + m * 16 + fr; const size_t off = (size_t)(u.pm * BM + r) * ldc + col0;
#pragma unroll
                for (int bj = 0; bj < 2; ++bj)
#pragma unroll
                    for (int n = 0; n < 2; ++n) { const f32x4 bs = *(const f32x4*)(base + off + bj * HALF + n * 16); *(f32x4*)(out + off + bj * HALF + n * 16) = bs + acc[ai][bj][m][n]; } }
    }
};
}

constexpr int BATCH = 4, SEQ = 8192, DM = 1024, M = BATCH * SEQ;
constexpr int NIN = 3088, NIN_PAD = 3328;
constexpr int C_GQ = 0, C_GK = 256, C_GV = 512, C_GG = 1024, C_AQ = 1536, C_AK = 2048, C_AV = 2560, C_GLR = 3072;
constexpr int NEXP = 16384;
constexpr float NORM_EPS = 1e-6f;
constexpr int NWAVES = 8, NTHREADS = 512;

constexpr size_t MiB = 1u << 20;
constexpr size_t WS_CTL = 0, CTL_ZERO_BYTES = 1 * MiB;
constexpr size_t WS_WT_IN = 1 * MiB;
constexpr size_t WS_WT_OUT = 8 * MiB;
constexpr size_t WS_WT_CIN = 10 * MiB;
constexpr size_t WS_WT_COUT = 14 * MiB;
constexpr size_t WS_WT_Q0 = 16 * MiB;
constexpr size_t WS_WT_Q1 = 20 * MiB;
constexpr size_t WS_ACT = 32 * MiB;
constexpr size_t WS_S = 96 * MiB;
constexpr size_t WS_PROJ = WS_S;
constexpr size_t WS_GLAO = WS_S + 208 * MiB;
constexpr size_t WS_TOPS = WS_S + 128 * MiB;
constexpr size_t WS_TOPI = WS_S + 160 * MiB;
constexpr size_t WS_IDS = WS_S + 192 * MiB;
constexpr size_t WS_G = WS_S + 208 * MiB;
constexpr size_t WS_XC = WS_ACT;
constexpr size_t WS_A = WS_S + 128 * MiB;
constexpr size_t WS_U = WS_S + 256 * MiB;
constexpr size_t WS_TAB = 448 * MiB;
constexpr size_t WS_TAB8 = 448 * MiB;
constexpr size_t WS_WG = 24 * MiB;
constexpr size_t WS_AGG = WS_S + 128 * MiB;
constexpr size_t WS_SCL = 26 * MiB;
constexpr size_t WS_END = 512 * MiB;
constexpr int CW_BAR = 4096, CW_RANK = 8192;

constexpr int RING_BYTES = 131072;
constexpr int LDS_BYTES = 147456;
constexpr int LDSCTL_OFF = LDS_BYTES - 512, MISC_OFF = LDSCTL_OFF + 320;

#define LAS __attribute__((address_space(3)))
#define GAS __attribute__((address_space(1)))
typedef unsigned short bf16_t;
typedef float f32x4 __attribute__((ext_vector_type(4)));
typedef unsigned u32x4 __attribute__((ext_vector_type(4)));
typedef unsigned u32x2 __attribute__((ext_vector_type(2)));
typedef short bf16x8 __attribute__((ext_vector_type(8)));

struct Params {
    const float *x, *mix_norm, *ffn_norm, *ab_w_in, *gla_w_alpha, *gla_b_alpha, *gla_head_gain, *ab_w_out;
    const float *c_w_in, *c_conv_w, *c_conv_b, *c_w_rgate, *c_b_rgate, *c_w_igate, *c_b_igate, *c_lambda, *c_w_out;
    const float *peer_w_query, *peer_sub_keys, *peer_u, *peer_v, *final_norm;
    float* out; unsigned char* ws;
    int ph_lo, ph_hi;
};

__device__ __forceinline__ unsigned f2bf(float f) { unsigned u = __builtin_bit_cast(unsigned, f); return (u + 0x7fffu + ((u >> 16) & 1u)) >> 16; }
__device__ __forceinline__ unsigned pk2(float lo, float hi) { return f2bf(lo) | (f2bf(hi) << 16); }
__device__ __forceinline__ float bf2f(bf16_t b) { return __builtin_bit_cast(float, (unsigned)b << 16); }
__device__ __forceinline__ float bflo(unsigned w) { return __builtin_bit_cast(float, w << 16); }
__device__ __forceinline__ float bfhi(unsigned w) { return __builtin_bit_cast(float, w & 0xffff0000u); }
__device__ __forceinline__ float wave_sum(float v) {
#pragma unroll
    for (int o = 1; o < 64; o <<= 1) v += __shfl_xor(v, o);
    return v;
}
__device__ __forceinline__ float gelu_tanh(float x) {
    const float u = 0.7978845608028654f * (x + 0.044715f * x * x * x);
    const float e = __expf(2.f * u);
    const float th = 1.f - 2.f / (e + 1.f);
    return 0.5f * x * (1.f + th);
}
__device__ __forceinline__ float sigmoidf_(float x) { return 1.f / (1.f + __expf(-x)); }

struct Ctx { int tid, lane, wave, blk, nblk, gtid, gthreads, gwave, gwaves; LAS unsigned char* lds; };

template <class F> __device__ __forceinline__ void transpose_cvt(const float* W, int K, int Nsrc, bf16_t* WT, int Ndst, F srcmap, int gtid, int gthreads) {
    const int total = (K / 8) * Ndst;
    for (int idx = gtid; idx < total; idx += gthreads) {
        const int ko = idx / Ndst, n = idx - ko * Ndst; const int sn = srcmap(n);
        u32x4 w = {0u, 0u, 0u, 0u};
        if (sn >= 0) { const float* s = W + (size_t)(ko * 8) * Nsrc + sn;
            w.x = pk2(s[0], s[(size_t)Nsrc]); w.y = pk2(s[2 * (size_t)Nsrc], s[3 * (size_t)Nsrc]); w.z = pk2(s[4 * (size_t)Nsrc], s[5 * (size_t)Nsrc]); w.w = pk2(s[6 * (size_t)Nsrc], s[7 * (size_t)Nsrc]); }
        *(u32x4*)(WT + (size_t)n * K + ko * 8) = w;
    }
}
__device__ __forceinline__ void cvt_bf16(const float* src, bf16_t* dst, size_t n8, int gtid, int gthreads) {
    for (size_t i = gtid; i < n8; i += gthreads) { const f32x4 a = *(const f32x4*)(src + i * 8), b = *(const f32x4*)(src + i * 8 + 4);
        u32x4 w; w.x = pk2(a.x, a.y); w.y = pk2(a.z, a.w); w.z = pk2(b.x, b.y); w.w = pk2(b.z, b.w); *(u32x4*)(dst + i * 8) = w; }
}
__device__ __forceinline__ void norm_rows_bf16(const float* src, const float* gain, bf16_t* dst, const Ctx& c) {
    for (int m = c.gwave; m < M; m += c.gwaves) {
        const f32x4* xr = (const f32x4*)(src + (size_t)m * DM) + c.lane; f32x4 v[4]; float s = 0.f;
#pragma unroll
        for (int j = 0; j < 4; ++j) { v[j] = xr[64 * j]; s += (v[j].x * v[j].x + v[j].y * v[j].y) + (v[j].z * v[j].z + v[j].w * v[j].w); }
        const float rstd = 1.f / sqrtf(wave_sum(s) * (1.f / DM) + NORM_EPS);
        u32x2* o8 = (u32x2*)(dst + (size_t)m * DM) + c.lane;
#pragma unroll
        for (int j = 0; j < 4; ++j) { const f32x4 g = *((const f32x4*)gain + 64 * j + c.lane); u32x2 w; w.x = pk2(v[j].x * rstd * g.x, v[j].y * rstd * g.y); w.y = pk2(v[j].z * rstd * g.z, v[j].w * rstd * g.w); o8[64 * j] = w; }
    }
}
__device__ __forceinline__ void norm_rows_f32(float* buf, const float* gain, const Ctx& c) {
    for (int m = c.gwave; m < M; m += c.gwaves) {
        f32x4* xr = (f32x4*)(buf + (size_t)m * DM) + c.lane; f32x4 v[4]; float s = 0.f;
#pragma unroll
        for (int j = 0; j < 4; ++j) { v[j] = xr[64 * j]; s += (v[j].x * v[j].x + v[j].y * v[j].y) + (v[j].z * v[j].z + v[j].w * v[j].w); }
        const float rstd = 1.f / sqrtf(wave_sum(s) * (1.f / DM) + NORM_EPS);
#pragma unroll
        for (int j = 0; j < 4; ++j) { const f32x4 g = *((const f32x4*)gain + 64 * j + c.lane); xr[64 * j] = v[j] * rstd * g; }
    }
}

__device__ __forceinline__ void ph_gla_naive(const Params& p, const Ctx& c) {
    const int b = c.blk >> 2, h = c.blk & 3;
    LAS float* sq = (LAS float*)c.lds; LAS float* sk = sq + 4096; LAS float* sa = sk + 4096; LAS float* sv = sa + 4096;
    const bf16_t* proj = (const bf16_t*)(p.ws + WS_PROJ);
    float* go = (float*)(p.ws + WS_GLAO);
    const int tid = c.tid, v = tid >> 2, kq = tid & 3;
    float S[16];
#pragma unroll
    for (int i = 0; i < 16; ++i) S[i] = 0.f;
    for (int t0 = 0; t0 < SEQ; t0 += 64) {
        __syncthreads();
        for (int e = tid; e < 4096; e += NTHREADS) { const int tt = e >> 6, kk = e & 63; const bf16_t* pr = proj + (size_t)(b * SEQ + t0 + tt) * NIN_PAD;
            sq[e] = bf2f(pr[C_GQ + h * 64 + kk]); sk[e] = bf2f(pr[C_GK + h * 64 + kk]);
            float z = p.gla_b_alpha[h * 64 + kk];
#pragma unroll
            for (int r = 0; r < 16; ++r) z += bf2f(pr[C_GLR + r]) * p.gla_w_alpha[r * 256 + h * 64 + kk];
            const float ls = fminf(z, 0.f) - log1pf(expf(-fabsf(z)));
            sa[e] = expf(ls * (1.f / 16.f)); }
        for (int e = tid; e < 8192; e += NTHREADS) { const int tt = e >> 7, vv = e & 127; sv[e] = bf2f(proj[(size_t)(b * SEQ + t0 + tt) * NIN_PAD + C_GV + h * 128 + vv]); }
        __syncthreads();
        for (int tt = 0; tt < 64; ++tt) {
            const float vv = sv[tt * 128 + v]; float part = 0.f;
#pragma unroll
            for (int i = 0; i < 16; ++i) { const int kk = kq * 16 + i; S[i] = sa[tt * 64 + kk] * S[i] + sk[tt * 64 + kk] * vv; part += sq[tt * 64 + kk] * S[i]; }
            part += __shfl_xor(part, 1); part += __shfl_xor(part, 2);
            if (kq == 0) go[(size_t)(b * SEQ + t0 + tt) * 512 + h * 128 + v] = part * 0.125f;
        }
    }
}
__device__ __forceinline__ void ph_attn_naive(const Params& p, int gtid, int gthreads) {
    const bf16_t* proj = (const bf16_t*)(p.ws + WS_PROJ); bf16_t* mixed = (bf16_t*)(p.ws + WS_ACT);
    for (int idx = gtid; idx < M * 8; idx += gthreads) {
        const int t = idx & 8191, h = (idx >> 13) & 7, b = idx >> 16;
        const size_t row = (size_t)b * SEQ + t;
        float q[64], o[64];
        { const u32x4* qp = (const u32x4*)(proj + row * NIN_PAD + C_AQ + h * 64);
#pragma unroll
          for (int i = 0; i < 8; ++i) { const u32x4 w = qp[i]; q[8*i] = bflo(w.x); q[8*i+1] = bfhi(w.x); q[8*i+2] = bflo(w.y); q[8*i+3] = bfhi(w.y); q[8*i+4] = bflo(w.z); q[8*i+5] = bfhi(w.z); q[8*i+6] = bflo(w.w); q[8*i+7] = bfhi(w.w); } }
#pragma unroll
        for (int d = 0; d < 64; ++d) o[d] = 0.f;
        float mx = -1e30f, l = 0.f;
        const float slope = exp2f(-(float)(h + 1));
        for (int br = 0; br < 3; ++br) { const int dil = 1 << (2 * br);
            for (int j = 0; j <= 128; ++j) { const int tk = t - j * dil; if (tk < 0) break;
                const u32x4* kp = (const u32x4*)(proj + ((size_t)b * SEQ + tk) * NIN_PAD + C_AK + h * 64); const u32x4* vp = kp + 64;
                float s = 0.f;
#pragma unroll
                for (int i = 0; i < 8; ++i) { const u32x4 w = kp[i]; s += q[8*i] * bflo(w.x) + q[8*i+1] * bfhi(w.x) + q[8*i+2] * bflo(w.y) + q[8*i+3] * bfhi(w.y) + q[8*i+4] * bflo(w.z) + q[8*i+5] * bfhi(w.z) + q[8*i+6] * bflo(w.w) + q[8*i+7] * bfhi(w.w); }
                s = s * 0.125f - slope * (float)(j * dil);
                const float mn = fmaxf(mx, s), corr = __expf(mx - mn), pp = __expf(s - mn);
                l = l * corr + pp; mx = mn;
#pragma unroll
                for (int i = 0; i < 8; ++i) { const u32x4 w = vp[i];
                    o[8*i] = o[8*i] * corr + pp * bflo(w.x); o[8*i+1] = o[8*i+1] * corr + pp * bfhi(w.x); o[8*i+2] = o[8*i+2] * corr + pp * bflo(w.y); o[8*i+3] = o[8*i+3] * corr + pp * bfhi(w.y);
                    o[8*i+4] = o[8*i+4] * corr + pp * bflo(w.z); o[8*i+5] = o[8*i+5] * corr + pp * bfhi(w.z); o[8*i+6] = o[8*i+6] * corr + pp * bflo(w.w); o[8*i+7] = o[8*i+7] * corr + pp * bfhi(w.w); }
            } }
        const float rl = 1.f / l;
        u32x4* op = (u32x4*)(mixed + row * DM + 512 + h * 64);
#pragma unroll
        for (int i = 0; i < 8; ++i) { u32x4 w; w.x = pk2(o[8*i] * rl, o[8*i+1] * rl); w.y = pk2(o[8*i+2] * rl, o[8*i+3] * rl); w.z = pk2(o[8*i+4] * rl, o[8*i+5] * rl); w.w = pk2(o[8*i+6] * rl, o[8*i+7] * rl); op[i] = w; }
    }
}

constexpr int AT_K = 0, AT_V = 272 * 144, AT_END = 2 * 272 * 144;
typedef short s16x4 __attribute__((ext_vector_type(4)));
__device__ __forceinline__ s16x4 lds_tr16(LAS const unsigned char* pbyte) { return __builtin_bit_cast(s16x4, __builtin_amdgcn_ds_read_tr16_b64_v4i16((LAS s16x4*)pbyte)); }
__device__ __forceinline__ void ph_attn(const Params& p, const Ctx& c) {
    LAS unsigned char* L = c.lds;
    const bf16_t* proj = (const bf16_t*)(p.ws + WS_PROJ); bf16_t* AO = (bf16_t*)p.out; float* LSE = (float*)((unsigned char*)p.out + 96 * MiB);
    const int tid = c.tid, lane = c.lane, w = c.wave, r = lane & 15, qq = lane >> 4;
    constexpr float LOG2E = 1.4426950408889634f;
    __syncthreads();
    for (int i = tid; i < 16 * 144 / 4; i += NTHREADS) ((LAS unsigned*)(L + AT_V + 256 * 144))[i] = 0u;
    u32x4 kreg[4], vreg[4], qreg[2];
#define AT_DECODE(it_) const int h = (it_) & 7, rest = (it_) >> 3, br = rest >> 8, u = rest & 255, sh = 2 * br, dil = 1 << sh, nbm = (64 >> sh) - 1; \
        const int bres = u >> (6 - sh), blk = u & nbm, b = bres >> sh, res = bres & (dil - 1); const size_t rowb = (size_t)b * SEQ; const int l0 = blk * 128
#define AT_ISSUE(it_) do { AT_DECODE(it_); (void)br; \
        _Pragma("unroll") for (int k = 0; k < 4; ++k) { const int idx = tid + NTHREADS * k, row = idx >> 3, ch = idx & 7, l = l0 - 128 + row; kreg[k] = (u32x4){0u, 0u, 0u, 0u}; vreg[k] = kreg[k]; \
            if (l >= 0) { const bf16_t* src = proj + (rowb + (size_t)l * dil + res) * NIN_PAD + C_AK + h * 64 + ch * 8; kreg[k] = *(const u32x4*)src; vreg[k] = *(const u32x4*)(src + 512); } } \
        const bf16_t* qp = proj + (rowb + (size_t)(l0 + 16 * w + r) * dil + res) * NIN_PAD + C_AQ + h * 64 + 8 * qq; qreg[0] = *(const u32x4*)qp; qreg[1] = *(const u32x4*)(qp + 32); } while (0)
    if (c.blk < 6144) AT_ISSUE(c.blk);
    for (int item = c.blk; item < 6144; item += c.nblk) {
        AT_DECODE(item);
        __syncthreads();
#pragma unroll
        for (int k = 0; k < 4; ++k) { const int idx = tid + NTHREADS * k, row = idx >> 3, ch = idx & 7;
            *(LAS u32x4*)(L + AT_K + row * 144 + ch * 16) = kreg[k]; *(LAS u32x4*)(L + AT_V + row * 144 + ch * 16) = vreg[k]; }
        bf16x8 qf[2]; qf[0] = __builtin_bit_cast(bf16x8, qreg[0]); qf[1] = __builtin_bit_cast(bf16x8, qreg[1]);
        { const int nit = item + c.nblk; if (nit < 6144) AT_ISSUE(nit); }
        __syncthreads();
        f32x4 sa[9];
#pragma unroll
        for (int jn = 0; jn < 9; ++jn) { LAS const unsigned char* kp = L + AT_K + (16 * (w + jn) + r) * 144 + 16 * qq;
            const bf16x8 k0 = __builtin_bit_cast(bf16x8, *(const LAS u32x4*)kp), k1 = __builtin_bit_cast(bf16x8, *(const LAS u32x4*)(kp + 64));
            f32x4 z = {0.f, 0.f, 0.f, 0.f}; z = __builtin_amdgcn_mfma_f32_16x16x32_bf16(k0, qf[0], z, 0, 0, 0); sa[jn] = __builtin_amdgcn_mfma_f32_16x16x32_bf16(k1, qf[1], z, 0, 0, 0); }
        const float sc = 0.125f * LOG2E, sl = exp2f(-(float)(h + 1)) * (float)dil * LOG2E;
        float mx = -1e30f;
#pragma unroll
        for (int jn = 0; jn < 9; ++jn)
#pragma unroll
            for (int i = 0; i < 4; ++i) { const int delta = r + 128 - 16 * jn - 4 * qq - i, kj = 16 * (w + jn) + 4 * qq + i;
                const bool valid = (delta >= 0) && (delta <= 128) && (blk > 0 || kj >= 128);
                const float v = valid ? sa[jn][i] * sc - sl * (float)delta : -1e30f; sa[jn][i] = v; mx = fmaxf(mx, v); }
        mx = fmaxf(mx, __shfl_xor(mx, 16)); mx = fmaxf(mx, __shfl_xor(mx, 32));
        float sum = 0.f;
#pragma unroll
        for (int jn = 0; jn < 9; ++jn)
#pragma unroll
            for (int i = 0; i < 4; ++i) { const float e = __builtin_amdgcn_exp2f(sa[jn][i] - mx); sa[jn][i] = e; sum += e; }
        sum += __shfl_xor(sum, 16); sum += __shfl_xor(sum, 32);
        { const int qi = 16 * w + r; if (qq == 0) LSE[((size_t)br * M + rowb + (size_t)(l0 + qi) * dil + res) * 8 + h] = (mx + __builtin_amdgcn_logf(sum)) * (1.f / LOG2E); }
        f32x4 oa[4];
#pragma unroll
        for (int dt = 0; dt < 4; ++dt) oa[dt] = (f32x4){0.f, 0.f, 0.f, 0.f};
#pragma unroll
        for (int s2 = 0; s2 < 5; ++s2) { u32x4 pw; pw.x = pk2(sa[2 * s2][0], sa[2 * s2][1]); pw.y = pk2(sa[2 * s2][2], sa[2 * s2][3]);
            if (s2 < 4) { pw.z = pk2(sa[2 * s2 + 1][0], sa[2 * s2 + 1][1]); pw.w = pk2(sa[2 * s2 + 1][2], sa[2 * s2 + 1][3]); } else { pw.z = 0u; pw.w = 0u; }
            LAS const unsigned char* vp = L + AT_V + (16 * (w + 2 * s2) + 4 * qq + (r >> 2)) * 144 + 8 * (r & 3);
#pragma unroll
            for (int dt = 0; dt < 4; ++dt) { const s16x4 v0 = lds_tr16(vp + 32 * dt), v1 = lds_tr16(vp + 32 * dt + 16 * 144);
                const bf16x8 vf = {v0[0], v0[1], v0[2], v0[3], v1[0], v1[1], v1[2], v1[3]};
                oa[dt] = __builtin_amdgcn_mfma_f32_16x16x32_bf16(__builtin_bit_cast(bf16x8, pw), vf, oa[dt], 0, 0, 0); } }
        const float rs = __builtin_amdgcn_rcpf(sum);
#pragma unroll
        for (int i = 0; i < 4; ++i) { const float ri = __shfl(rs, 4 * qq + i); const int qi = 16 * w + 4 * qq + i;
            bf16_t* op = AO + ((size_t)br * M + rowb + (size_t)(l0 + qi) * dil + res) * 512 + h * 64 + r;
#pragma unroll
            for (int dt = 0; dt < 4; ++dt) op[16 * dt] = (bf16_t)f2bf(oa[dt][i] * ri); }
    }
#undef AT_DECODE
#undef AT_ISSUE
}

constexpr size_t WS_CKV = WS_S + 272 * MiB;
constexpr size_t WS_DEC = WS_S + 336 * MiB;
constexpr size_t WS_SPREV = WS_ACT;
constexpr int GL_SEGT = 0, GL_V = 2048, GL_KT = GL_V + 64 * 272, GL_QD = GL_KT + 64 * 144, GL_KI = GL_QD + 64 * 144, GL_END = GL_KI + 64 * 144;
__device__ __forceinline__ void gla_cumdecay(const Params& p, const Ctx& c, const bf16_t* prow0, int h, float (&bcum)[8], float& blast) {
    LAS float* SEGT = (LAS float*)(c.lds + GL_SEGT);
    const int kk = c.tid & 63, w = c.wave;
    float wa[16];
#pragma unroll
    for (int r = 0; r < 16; ++r) wa[r] = p.gla_w_alpha[r * 256 + h * 64 + kk];
    const float ba = p.gla_b_alpha[h * 64 + kk];
    float run = 0.f;
#pragma unroll
    for (int k = 0; k < 8; ++k) { const bf16_t* pr = prow0 + (size_t)(8 * w + k) * NIN_PAD + C_GLR;
        const u32x4 g0 = *(const u32x4*)pr, g1 = *(const u32x4*)(pr + 8);
        float z = ba + bflo(g0.x) * wa[0] + bfhi(g0.x) * wa[1] + bflo(g0.y) * wa[2] + bfhi(g0.y) * wa[3] + bflo(g0.z) * wa[4] + bfhi(g0.z) * wa[5] + bflo(g0.w) * wa[6] + bfhi(g0.w) * wa[7]
                     + bflo(g1.x) * wa[8] + bfhi(g1.x) * wa[9] + bflo(g1.y) * wa[10] + bfhi(g1.y) * wa[11] + bflo(g1.z) * wa[12] + bfhi(g1.z) * wa[13] + bflo(g1.w) * wa[14] + bfhi(g1.w) * wa[15];
        const float ls = fminf(z, 0.f) - __logf(1.f + __expf(-fabsf(z)));
        run += ls * (1.f / 16.f); bcum[k] = run; }
    __syncthreads();
    SEGT[w * 64 + kk] = run;
    __syncthreads();
    float off = 0.f, tot = 0.f;
#pragma unroll
    for (int sg = 0; sg < 8; ++sg) { const float v = SEGT[sg * 64 + kk]; off += (sg < w) ? v : 0.f; tot += v; }
#pragma unroll
    for (int k = 0; k < 8; ++k) bcum[k] += off;
    blast = tot;
}
__device__ __forceinline__ void gla_stage_v(const Ctx& c, const bf16_t* prow0, int h) {
#pragma unroll
    for (int k = 0; k < 2; ++k) { const int idx = c.tid + NTHREADS * k, row = idx >> 4, ch = idx & 15;
        *(LAS u32x4*)(c.lds + GL_V + row * 272 + ch * 16) = *(const u32x4*)(prow0 + (size_t)row * NIN_PAD + C_GV + h * 128 + ch * 8); }
}
__device__ __forceinline__ void ph_gla_a(const Params& p, const Ctx& c) {
    LAS unsigned char* L = c.lds; const bf16_t* proj = (const bf16_t*)(p.ws + WS_PROJ);
    float* CKV = (float*)(p.ws + WS_CKV); float* DEC = (float*)(p.ws + WS_DEC);
    const int tid = c.tid, lane = c.lane, w = c.wave, r = lane & 15, qq = lane >> 4, kk = tid & 63;
    for (int item = c.blk; item < 2048; item += c.nblk) {
        const int h = item & 3, bn = item >> 2; const bf16_t* prow0 = proj + (size_t)bn * 64 * NIN_PAD;
        float bcum[8], blast; gla_cumdecay(p, c, prow0, h, bcum, blast);
        gla_stage_v(c, prow0, h);
        { u32x4 o; float e[8];
#pragma unroll
          for (int k = 0; k < 8; ++k) e[k] = bf2f(prow0[(size_t)(8 * w + k) * NIN_PAD + C_GK + h * 64 + kk]) * __expf(blast - bcum[k]);
          o.x = pk2(e[0], e[1]); o.y = pk2(e[2], e[3]); o.z = pk2(e[4], e[5]); o.w = pk2(e[6], e[7]);
          *(LAS u32x4*)(L + GL_KT + kk * 144 + 16 * w) = o; }
        if (w == 0) DEC[(size_t)item * 64 + kk] = __expf(blast);
        __syncthreads();
        f32x4 acc[4];
#pragma unroll
        for (int n = 0; n < 4; ++n) acc[n] = (f32x4){0.f, 0.f, 0.f, 0.f};
#pragma unroll
        for (int s2 = 0; s2 < 2; ++s2) { LAS const unsigned char* vp = L + GL_V + (32 * s2 + 8 * qq + (r >> 2)) * 272 + (16 * w + 4 * (r & 3)) * 2;
            const s16x4 v0 = lds_tr16(vp), v1 = lds_tr16(vp + 4 * 272); const bf16x8 af = {v0[0], v0[1], v0[2], v0[3], v1[0], v1[1], v1[2], v1[3]};
#pragma unroll
            for (int n = 0; n < 4; ++n) { const bf16x8 bfr = __builtin_bit_cast(bf16x8, *(const LAS u32x4*)(L + GL_KT + (16 * n + r) * 144 + (32 * s2 + 8 * qq) * 2));
                acc[n] = __builtin_amdgcn_mfma_f32_16x16x32_bf16(af, bfr, acc[n], 0, 0, 0); } }
        float* outp = CKV + (size_t)item * 8192 + (16 * w + 4 * qq) * 64 + r;
#pragma unroll
        for (int n = 0; n < 4; ++n)
#pragma unroll
            for (int i = 0; i < 4; ++i) outp[i * 64 + 16 * n] = acc[n][i];
    }
}
__device__ __forceinline__ void ph_gla_b(const Params& p, const Ctx& c) {
    const float* CKV = (const float*)(p.ws + WS_CKV); const float* DEC = (const float*)(p.ws + WS_DEC); bf16_t* SP = (bf16_t*)(p.ws + WS_SPREV);
    for (int idx = c.gtid; idx < 16 * 8192; idx += c.gthreads) { const int bh = idx >> 13, e = idx & 8191, b = bh >> 2, h = bh & 3; float S = 0.f;
        for (int n0 = 0; n0 < 128; n0 += 8) { float cv[8], dv[8];
#pragma unroll
            for (int k = 0; k < 8; ++k) { const size_t item = (size_t)(b * 128 + n0 + k) * 4 + h; cv[k] = CKV[item * 8192 + e]; dv[k] = DEC[item * 64 + (e & 63)]; }
#pragma unroll
            for (int k = 0; k < 8; ++k) { const size_t item = (size_t)(b * 128 + n0 + k) * 4 + h; SP[item * 8192 + e] = (bf16_t)f2bf(S); S = dv[k] * S + cv[k]; } } }
}
__device__ __forceinline__ void ph_gla_c(const Params& p, const Ctx& c) {
    LAS unsigned char* L = c.lds; const bf16_t* proj = (const bf16_t*)(p.ws + WS_PROJ); const bf16_t* SP = (const bf16_t*)(p.ws + WS_SPREV); float* go = (float*)(p.ws + WS_GLAO);
    const int tid = c.tid, lane = c.lane, w = c.wave, r = lane & 15, qq = lane >> 4, kk = tid & 63;
    for (int item = c.blk; item < 2048; item += c.nblk) {
        const int h = item & 3, bn = item >> 2; const bf16_t* prow0 = proj + (size_t)bn * 64 * NIN_PAD;
        float bcum[8], blast; gla_cumdecay(p, c, prow0, h, bcum, blast);
        gla_stage_v(c, prow0, h);
#pragma unroll
        for (int k = 0; k < 8; ++k) { const int i = 8 * w + k; const bf16_t* pr = prow0 + (size_t)i * NIN_PAD;
            const float qv = bf2f(pr[C_GQ + h * 64 + kk]) * 0.125f * __expf(bcum[k]), kv = bf2f(pr[C_GK + h * 64 + kk]) * __expf(-bcum[k]);
            *(LAS bf16_t*)(L + GL_QD + i * 144 + kk * 2) = (bf16_t)f2bf(qv); *(LAS bf16_t*)(L + GL_KI + i * 144 + kk * 2) = (bf16_t)f2bf(kv); }
        __syncthreads();
        const int it = w & 3, vh = w >> 2;
        bf16x8 qf[2];
#pragma unroll
        for (int s2 = 0; s2 < 2; ++s2) qf[s2] = __builtin_bit_cast(bf16x8, *(const LAS u32x4*)(L + GL_QD + (16 * it + r) * 144 + (32 * s2 + 8 * qq) * 2));
        u32x2 pw[4];
#pragma unroll
        for (int jt = 0; jt < 4; ++jt) { f32x4 z = {0.f, 0.f, 0.f, 0.f};
            if (jt <= it) {
#pragma unroll
                for (int s2 = 0; s2 < 2; ++s2) { const bf16x8 kf = __builtin_bit_cast(bf16x8, *(const LAS u32x4*)(L + GL_KI + (16 * jt + r) * 144 + (32 * s2 + 8 * qq) * 2));
                    z = __builtin_amdgcn_mfma_f32_16x16x32_bf16(kf, qf[s2], z, 0, 0, 0); }
#pragma unroll
                for (int ii = 0; ii < 4; ++ii) z[ii] = (16 * jt + 4 * qq + ii <= 16 * it + r) ? z[ii] : 0.f; }
            pw[jt].x = pk2(z[0], z[1]); pw[jt].y = pk2(z[2], z[3]); }
        f32x4 acc[4];
#pragma unroll
        for (int n = 0; n < 4; ++n) acc[n] = (f32x4){0.f, 0.f, 0.f, 0.f};
#pragma unroll
        for (int s2 = 0; s2 < 2; ++s2) { if (2 * s2 <= it) {
            const u32x4 pq = {pw[2 * s2].x, pw[2 * s2].y, pw[2 * s2 + 1].x, pw[2 * s2 + 1].y};
            LAS const unsigned char* vp = L + GL_V + (32 * s2 + 4 * qq + (r >> 2)) * 272 + (64 * vh + 4 * (r & 3)) * 2;
#pragma unroll
            for (int n = 0; n < 4; ++n) { const s16x4 v0 = lds_tr16(vp + 32 * n), v1 = lds_tr16(vp + 32 * n + 16 * 272);
                const bf16x8 vf = {v0[0], v0[1], v0[2], v0[3], v1[0], v1[1], v1[2], v1[3]};
                acc[n] = __builtin_amdgcn_mfma_f32_16x16x32_bf16(__builtin_bit_cast(bf16x8, pq), vf, acc[n], 0, 0, 0); } } }
#pragma unroll
        for (int s2 = 0; s2 < 2; ++s2)
#pragma unroll
            for (int n = 0; n < 4; ++n) { const bf16x8 sf = __builtin_bit_cast(bf16x8, *(const u32x4*)(SP + (size_t)item * 8192 + (64 * vh + 16 * n + r) * 64 + 32 * s2 + 8 * qq));
                acc[n] = __builtin_amdgcn_mfma_f32_16x16x32_bf16(qf[s2], sf, acc[n], 0, 0, 0); }
        float* outp = go + ((size_t)bn * 64 + 16 * it + 4 * qq) * 512 + h * 128 + 64 * vh + r;
#pragma unroll
        for (int n = 0; n < 4; ++n)
#pragma unroll
            for (int ii = 0; ii < 4; ++ii) outp[ii * 512 + 16 * n] = acc[n][ii];
    }
}
#ifndef ATT_COMBINE
#define ATT_COMBINE 1
#endif
__device__ __forceinline__ void ph_mix(const Params& p, const Ctx& c) {
    const bf16_t* proj = (const bf16_t*)(p.ws + WS_PROJ); const float* go = (const float*)(p.ws + WS_GLAO); bf16_t* mixed = (bf16_t*)(p.ws + WS_ACT);
    for (int m = c.gwave; m < M; m += c.gwaves) {
#pragma unroll
        for (int h = 0; h < 4; ++h) { const int col = h * 128 + 2 * c.lane;
            const float o0 = go[(size_t)m * 512 + col], o1 = go[(size_t)m * 512 + col + 1];
            const float rstd = 1.f / sqrtf(wave_sum(o0 * o0 + o1 * o1) * (1.f / 128.f) + NORM_EPS);
            const unsigned gw = *(const unsigned*)(proj + (size_t)m * NIN_PAD + C_GG + col); const float g0 = bflo(gw), g1 = bfhi(gw);
            const float r0 = o0 * rstd * p.gla_head_gain[col] * (g0 * sigmoidf_(g0)), r1 = o1 * rstd * p.gla_head_gain[col + 1] * (g1 * sigmoidf_(g1));
            *(unsigned*)(mixed + (size_t)m * DM + col) = pk2(r0, r1); }
        if (ATT_COMBINE) {
            const bf16_t* AO = (const bf16_t*)p.out; const float* LSE = (const float*)((const unsigned char*)p.out + 96 * MiB); const int hh = c.lane >> 3;
            const float l0 = LSE[((size_t)0 * M + m) * 8 + hh], l1 = LSE[((size_t)1 * M + m) * 8 + hh], l2 = LSE[((size_t)2 * M + m) * 8 + hh];
            const float lm = fmaxf(l0, fmaxf(l1, l2)), e0 = __expf(l0 - lm), e1 = __expf(l1 - lm), e2 = __expf(l2 - lm), rd = 1.f / (e0 + e1 + e2);
            const float w0 = e0 * rd, w1 = e1 * rd, w2 = e2 * rd;
            const u32x4 a0 = *((const u32x4*)(AO + ((size_t)0 * M + m) * 512) + c.lane), a1 = *((const u32x4*)(AO + ((size_t)1 * M + m) * 512) + c.lane), a2 = *((const u32x4*)(AO + ((size_t)2 * M + m) * 512) + c.lane);
            u32x4 o;
            o.x = pk2(w0 * bflo(a0.x) + w1 * bflo(a1.x) + w2 * bflo(a2.x), w0 * bfhi(a0.x) + w1 * bfhi(a1.x) + w2 * bfhi(a2.x));
            o.y = pk2(w0 * bflo(a0.y) + w1 * bflo(a1.y) + w2 * bflo(a2.y), w0 * bfhi(a0.y) + w1 * bfhi(a1.y) + w2 * bfhi(a2.y));
            o.z = pk2(w0 * bflo(a0.z) + w1 * bflo(a1.z) + w2 * bflo(a2.z), w0 * bfhi(a0.z) + w1 * bfhi(a1.z) + w2 * bfhi(a2.z));
            o.w = pk2(w0 * bflo(a0.w) + w1 * bflo(a1.w) + w2 * bflo(a2.w), w0 * bfhi(a0.w) + w1 * bfhi(a1.w) + w2 * bfhi(a2.w));
            *((u32x4*)(mixed + (size_t)m * DM + 512) + c.lane) = o; }
    }
}


constexpr int GR_WGT = 0, GR_XC = 65536, GR_A = 81920, GR_U = 115712, GR_SEG = 132608, GR_CW = 136704, GR_GB = 139264;
__device__ __forceinline__ float fast_sigmoid(float x) { return __builtin_amdgcn_rcpf(1.f + __expf(-x)); }
template <bool FULL> __device__ __forceinline__ void griffin_pass(const Params& p, const Ctx& c) {
    LAS unsigned char* L = c.lds;
    const int tid = c.tid, lane = c.lane, wave = c.wave, g = c.blk & 7;
    const bf16_t* proj = (const bf16_t*)(p.ws + WS_PROJ); bf16_t* yout = (bf16_t*)(p.ws + WS_ACT);
    float* AGA = (float*)(p.ws + WS_AGG); float* AGH = AGA + BATCH * 128 * 1024; const float* CAR = AGH + BATCH * 128 * 1024;
    LAS float* A_ = (LAS float*)(L + GR_A); LAS bf16_t* U_ = (LAS bf16_t*)(L + GR_U); LAS float* SEG = (LAS float*)(L + GR_SEG); LAS float* CW = (LAS float*)(L + GR_CW); LAS float* GB = (LAS float*)(L + GR_GB);
    __syncthreads();
    { const bf16_t* wg = (const bf16_t*)(p.ws + WS_WG);
      for (int ch = tid; ch < 4096; ch += NTHREADS) { const int gate = ch >> 11, j = (ch >> 4) & 127, cc = ch & 15;
          const u32x4 v = *(const u32x4*)(wg + ((size_t)(gate * 8 + g) * 128 + j) * 128 + cc * 8);
          *(LAS u32x4*)(L + GR_WGT + gate * 32768 + j * 256 + ((cc ^ (j & 15)) << 4)) = v; }
      if (tid < 128) { const int ch = g * 128 + tid;
#pragma unroll
          for (int jj = 0; jj < 4; ++jj) CW[jj * 128 + tid] = p.c_conv_w[jj * 1024 + ch];
          CW[4 * 128 + tid] = p.c_conv_b[ch]; GB[tid] = p.c_b_rgate[ch]; GB[128 + tid] = p.c_b_igate[ch];
          const float lam = p.c_lambda[ch]; GB[256 + tid] = fmaxf(-lam, 0.f) + log1pf(expf(-fabsf(lam))); } }
    __syncthreads();
    const int nslot = BATCH * 128, sstep = c.nblk >> 3;
    u32x4 xr[5];
#define GR_XLOAD(sl_) do { const int b_ = (sl_) >> 7, t0_ = ((sl_) & 127) * 64; const size_t r0_ = (size_t)b_ * SEQ + t0_; const int co_ = tid & 15, tp_ = tid >> 4; \
        _Pragma("unroll") for (int jj = 0; jj < 5; ++jj) { const int tt = t0_ + 2 * tp_ - 3 + jj; xr[jj] = (u32x4){0u, 0u, 0u, 0u}; \
            if (tt >= 0) xr[jj] = *(const u32x4*)(proj + (r0_ + 2 * tp_ - 3 + jj) * 2048 + 1024 + g * 128 + co_ * 8); } } while (0)
    if ((c.blk >> 3) < nslot) GR_XLOAD(c.blk >> 3);
    for (int slot = c.blk >> 3; slot < nslot; slot += sstep) {
        const int b = slot >> 7, tile = slot & 127, t0 = tile * 64; const size_t row0 = (size_t)b * SEQ + t0;
        u32x4 gpre[2];
        if (FULL) { const int co = tid & 15, tp = tid >> 4;
#pragma unroll
            for (int tl = 0; tl < 2; ++tl) gpre[tl] = *(const u32x4*)(proj + (row0 + 2 * tp + tl) * 2048 + g * 128 + co * 8); }
        { const int co = tid & 15, tp = tid >> 4;
          f32x4 w[5][2];
#pragma unroll
          for (int jj = 0; jj < 5; ++jj) { w[jj][0] = *(const LAS f32x4*)(CW + jj * 128 + co * 8); w[jj][1] = *(const LAS f32x4*)(CW + jj * 128 + co * 8 + 4); }
#pragma unroll
          for (int tl = 0; tl < 2; ++tl) { float a8[8];
#pragma unroll
              for (int e = 0; e < 8; ++e) a8[e] = w[4][e >> 2][e & 3];
#pragma unroll
              for (int jj = 0; jj < 4; ++jj) { const u32x4 xv = xr[tl + jj]; const unsigned xw[4] = {xv.x, xv.y, xv.z, xv.w};
#pragma unroll
                  for (int e = 0; e < 8; ++e) { const float xe = (e & 1) ? bfhi(xw[e >> 1]) : bflo(xw[e >> 1]); a8[e] += w[jj][e >> 2][e & 3] * xe; } }
              const int t = 2 * tp + tl; u32x4 o; o.x = pk2(a8[0], a8[1]); o.y = pk2(a8[2], a8[3]); o.z = pk2(a8[4], a8[5]); o.w = pk2(a8[6], a8[7]);
              *(LAS u32x4*)(L + GR_XC + t * 256 + ((co ^ (t & 15)) << 4)) = o; } }
        if (slot + sstep < nslot) GR_XLOAD(slot + sstep);
        __syncthreads();
        { const int tt = wave & 3, jh = wave >> 2, r = lane & 15, q = lane >> 4, t = 16 * tt + r;
          f32x4 ar[4], ai[4];
#pragma unroll
          for (int n = 0; n < 4; ++n) { ar[n] = (f32x4){0.f, 0.f, 0.f, 0.f}; ai[n] = (f32x4){0.f, 0.f, 0.f, 0.f}; }
#pragma unroll
          for (int s = 0; s < 4; ++s) { const bf16x8 xb = __builtin_bit_cast(bf16x8, *(const LAS u32x4*)(L + GR_XC + t * 256 + (((4 * s + q) ^ (t & 15)) << 4)));
#pragma unroll
              for (int n = 0; n < 4; ++n) { const int j = 64 * jh + 16 * n + r;
                  const bf16x8 wr = __builtin_bit_cast(bf16x8, *(const LAS u32x4*)(L + GR_WGT + j * 256 + (((4 * s + q) ^ (j & 15)) << 4)));
                  const bf16x8 wi = __builtin_bit_cast(bf16x8, *(const LAS u32x4*)(L + GR_WGT + 32768 + j * 256 + (((4 * s + q) ^ (j & 15)) << 4)));
                  ar[n] = __builtin_amdgcn_mfma_f32_16x16x32_bf16(wr, xb, ar[n], 0, 0, 0); ai[n] = __builtin_amdgcn_mfma_f32_16x16x32_bf16(wi, xb, ai[n], 0, 0, 0); } }
#pragma unroll
          for (int n = 0; n < 4; ++n) { const int j0 = 64 * jh + 16 * n + 4 * q;
              const f32x4 br = *(const LAS f32x4*)(GB + j0), bi = *(const LAS f32x4*)(GB + 128 + j0), sp = *(const LAS f32x4*)(GB + 256 + j0);
              const u32x2 xw = *(const LAS u32x2*)(L + GR_XC + t * 256 + ((((j0 >> 3) ^ (t & 15)) << 4) + (j0 & 7) * 2));
              const float xc[4] = {bflo(xw.x), bfhi(xw.x), bflo(xw.y), bfhi(xw.y)};
              f32x4 av; float uv[4];
#pragma unroll
              for (int i = 0; i < 4; ++i) { const float rr = fast_sigmoid(ar[n][i] + br[i]), ii = fast_sigmoid(ai[n][i] + bi[i]);
                  const float a = __expf(-8.f * rr * sp[i]); av[i] = a; uv[i] = sqrtf(fmaxf(1.f - a * a, 0.f)) * (ii * xc[i]); }
              *(LAS f32x4*)(A_ + t * 132 + j0) = av; u32x2 uo; uo.x = pk2(uv[0], uv[1]); uo.y = pk2(uv[2], uv[3]); *(LAS u32x2*)(U_ + t * 132 + j0) = uo; } }
        __syncthreads();
        const int j = tid & 127, seg = tid >> 7;
        { float aa = 1.f, hh = 0.f;
#pragma unroll
          for (int i = 0; i < 16; ++i) { const int t = seg * 16 + i; const float a = A_[t * 132 + j], u = bf2f(U_[t * 132 + j]); hh = a * hh + u; aa *= a; }
          SEG[seg * 128 + j] = aa; SEG[512 + seg * 128 + j] = hh; }
        __syncthreads();
        if (!FULL) {
            if (tid < 128) { float A = 1.f, H = 0.f;
#pragma unroll
                for (int sgi = 0; sgi < 4; ++sgi) { H = SEG[sgi * 128 + tid] * H + SEG[512 + sgi * 128 + tid]; A *= SEG[sgi * 128 + tid]; }
                const size_t e = ((size_t)b * 128 + tile) * 1024 + g * 128 + tid; AGA[e] = A; AGH[e] = H; }
        } else {
            float h = CAR[((size_t)b * 128 + tile) * 1024 + g * 128 + j];
            for (int sgi = 0; sgi < seg; ++sgi) h = SEG[sgi * 128 + j] * h + SEG[512 + sgi * 128 + j];
#pragma unroll
            for (int i = 0; i < 16; ++i) { const int t = seg * 16 + i; const float a = A_[t * 132 + j], u = bf2f(U_[t * 132 + j]); h = a * h + u; A_[t * 132 + j] = h; }
            __syncthreads();
            { const int co = tid & 15, tp = tid >> 4;
#pragma unroll
              for (int tl = 0; tl < 2; ++tl) { const int t = 2 * tp + tl;
                  const f32x4 h0 = *(const LAS f32x4*)(A_ + t * 132 + co * 8), h1 = *(const LAS f32x4*)(A_ + t * 132 + co * 8 + 4);
                  const u32x4 gw = gpre[tl];
                  u32x4 o; o.x = pk2(gelu_tanh(bflo(gw.x)) * h0.x, gelu_tanh(bfhi(gw.x)) * h0.y); o.y = pk2(gelu_tanh(bflo(gw.y)) * h0.z, gelu_tanh(bfhi(gw.y)) * h0.w);
                  o.z = pk2(gelu_tanh(bflo(gw.z)) * h1.x, gelu_tanh(bfhi(gw.z)) * h1.y); o.w = pk2(gelu_tanh(bflo(gw.w)) * h1.z, gelu_tanh(bfhi(gw.w)) * h1.w);
                  *(u32x4*)(yout + (row0 + t) * DM + g * 128 + co * 8) = o; } }
        }
    }
#undef GR_XLOAD
}
__device__ __forceinline__ void ph_carry(const Params& p, const Ctx& c) {
    const float* AGA = (const float*)(p.ws + WS_AGG); const float* AGH = AGA + BATCH * 128 * 1024; float* CAR = (float*)(AGH + BATCH * 128 * 1024);
    for (int idx = c.gtid; idx < BATCH * 1024; idx += c.gthreads) { const int b = idx >> 10, ch = idx & 1023; float cy = 0.f;
        for (int t0 = 0; t0 < 128; t0 += 8) { float a[8], h[8];
#pragma unroll
            for (int k = 0; k < 8; ++k) { const size_t e = ((size_t)b * 128 + t0 + k) * 1024 + ch; a[k] = AGA[e]; h[k] = AGH[e]; }
#pragma unroll
            for (int k = 0; k < 8; ++k) { CAR[((size_t)b * 128 + t0 + k) * 1024 + ch] = cy; cy = a[k] * cy + h[k]; } } }
}
__device__ __forceinline__ void cvt_gate_weights(const Params& p, const Ctx& c) {
    bf16_t* wg = (bf16_t*)(p.ws + WS_WG);
    for (int idx = c.gtid; idx < 2 * 8 * 16 * 128; idx += c.gthreads) { const int j = idx & 127, io = (idx >> 7) & 15, g = (idx >> 11) & 7, gate = idx >> 14;
        const float* s = (gate ? p.c_w_igate : p.c_w_rgate) + (size_t)g * 16384 + (io * 8) * 128 + j;
        u32x4 w; w.x = pk2(s[0], s[128]); w.y = pk2(s[256], s[384]); w.z = pk2(s[512], s[640]); w.w = pk2(s[768], s[896]);
        *(u32x4*)(wg + ((size_t)(gate * 8 + g) * 128 + j) * 128 + io * 8) = w; }
}


constexpr size_t WS_SK = 25 * MiB;
constexpr int TK_SK = 0, TK_Q = 69632, TK_S = 86528, TK_L = 119552, TK_C = 123648, TK_O = 131840, TK_TAB = 135936;
typedef int i32x4 __attribute__((ext_vector_type(4)));
__device__ __forceinline__ int key_xform(int b) { return b ^ ((b >> 31) & 0x7fffffff); }
#define CEX(a, b) do { const int hi_ = max((a), (b)), lo_ = min((a), (b)); (a) = hi_; (b) = lo_; } while (0)
__device__ __forceinline__ void bitonic_merge16_desc(int (&v)[16]) {
#pragma unroll
    for (int j = 8; j >= 1; j >>= 1)
#pragma unroll
        for (int i = 0; i < 16; ++i) if ((i & j) == 0) CEX(v[i], v[i | j]);
}
__device__ __forceinline__ void bitonic_sort16_desc(int (&v)[16]) {
#pragma unroll
    for (int k = 2; k <= 16; k <<= 1)
#pragma unroll
        for (int j = k >> 1; j >= 1; j >>= 1)
#pragma unroll
            for (int i = 0; i < 16; ++i) { const int l = i ^ j; if (l > i) { if ((i & k) == 0 || k == 16) CEX(v[i], v[l]); else CEX(v[l], v[i]); } }
}
__device__ __forceinline__ void ph_topk(const Params& p, int layer, const Ctx& c) {
    LAS unsigned char* L = c.lds; const bf16_t* Q = (const bf16_t*)(p.ws + WS_PROJ);
    int* ids = (int*)(p.ws + WS_IDS); float* gg = (float*)(p.ws + WS_G);
    const int tid = c.tid, lane = c.lane, w = c.wave, r = lane & 15, qq = lane >> 4, h = c.blk & 7;
    LAS float* S = (LAS float*)(L + TK_S); LAS int* LST = (LAS int*)(L + TK_L); LAS int* CND = (LAS int*)(L + TK_C); LAS int* OUTK = (LAS int*)(L + TK_O); LAS int* TAB = (LAS int*)(L + TK_TAB);
    __syncthreads();
    { const bf16_t* sk = (const bf16_t*)(p.ws + WS_SK) + ((size_t)layer * 8 + h) * 2 * 128 * 128;
      for (int ch = tid; ch < 4096; ch += NTHREADS) { const int row = ch >> 4, cc = ch & 15;
          *(LAS u32x4*)(L + TK_SK + row * 272 + cc * 16) = *(const u32x4*)(sk + (size_t)row * 128 + cc * 8); }
      if (tid < 64) { int cnt = 0, code = -1;
          for (int i = 0; i < 16; ++i) for (int j = 0; j < 16 / (i + 1); ++j) { if (cnt == tid) code = i * 16 + j; ++cnt; }
          TAB[tid] = code; } }
    const int nslot = M / 32, sstep = c.nblk >> 3;
    u32x4 qpre[2];
#define TK_QLOAD(sl_) do { _Pragma("unroll") for (int k = 0; k < 2; ++k) { const int idx = tid + NTHREADS * k, row = idx >> 5, ch = idx & 31; \
        qpre[k] = *(const u32x4*)(Q + (size_t)(min((sl_), nslot - 1) * 32 + row) * 2048 + h * 256 + ch * 8); } } while (0)
    TK_QLOAD(c.blk >> 3);
    for (int slot = c.blk >> 3; slot < nslot; slot += sstep) {
        const int m0 = slot * 32;
        __syncthreads();
#pragma unroll
        for (int k = 0; k < 2; ++k) { const int idx = tid + NTHREADS * k, row = idx >> 5, ch = idx & 31; *(LAS u32x4*)(L + TK_Q + row * 528 + ch * 16) = qpre[k]; }
        TK_QLOAD(slot + sstep);
        __syncthreads();
        { const int pp = w >> 2, mt = (w >> 1) & 1, nh = w & 1;
          f32x4 acc[4];
#pragma unroll
          for (int nt = 0; nt < 4; ++nt) acc[nt] = (f32x4){0.f, 0.f, 0.f, 0.f};
#pragma unroll
          for (int s2 = 0; s2 < 4; ++s2) { const bf16x8 af = __builtin_bit_cast(bf16x8, *(const LAS u32x4*)(L + TK_Q + (16 * mt + r) * 528 + (pp * 128 + 32 * s2 + 8 * qq) * 2));
#pragma unroll
              for (int nt = 0; nt < 4; ++nt) { const bf16x8 bfr = __builtin_bit_cast(bf16x8, *(const LAS u32x4*)(L + TK_SK + (pp * 128 + 16 * (4 * nh + nt) + r) * 272 + (32 * s2 + 8 * qq) * 2));
                  acc[nt] = __builtin_amdgcn_mfma_f32_16x16x32_bf16(af, bfr, acc[nt], 0, 0, 0); } }
#pragma unroll
          for (int nt = 0; nt < 4; ++nt)
#pragma unroll
              for (int i = 0; i < 4; ++i) S[(pp * 32 + 16 * mt + 4 * qq + i) * 129 + 16 * (4 * nh + nt) + r] = acc[nt][i]; }
        __syncthreads();
        const int m = tid >> 4, sub = tid & 15;
        { const int pp = sub >> 3, part = sub & 7; int v[16];
#pragma unroll
          for (int k = 0; k < 16; ++k) { const int n = 8 * k + part; v[k] = key_xform((__builtin_bit_cast(int, S[(pp * 32 + m) * 129 + n]) & ~127) | n); }
          bitonic_sort16_desc(v);
#define TK_MERGE(CTRL) do { int o_[16]; _Pragma("unroll") for (int i = 0; i < 16; ++i) o_[i] = __builtin_amdgcn_update_dpp(0, v[15 - i], (CTRL), 0xf, 0xf, false); \
              _Pragma("unroll") for (int i = 0; i < 16; ++i) v[i] = max(v[i], o_[i]); bitonic_merge16_desc(v); } while (0)
          TK_MERGE(0xB1);
          TK_MERGE(0x4E);
          TK_MERGE(0x141);
#undef TK_MERGE
          if (part == 0) {
#pragma unroll
              for (int k = 0; k < 16; ++k) LST[(m * 2 + pp) * 16 + k] = key_xform(v[k]); } }
        asm volatile("s_waitcnt lgkmcnt(0)" ::: "memory");
        {
          int v[16];
#pragma unroll
          for (int k = 0; k < 16; ++k) { const int ci = (sub & 3) * 16 + k; const int code = TAB[ci]; int key = (int)0x80000000;
              if (code >= 0) { const float s1 = __builtin_bit_cast(float, LST[(m * 2 + 0) * 16 + (code >> 4)] & ~127), s2v = __builtin_bit_cast(float, LST[(m * 2 + 1) * 16 + (code & 15)] & ~127);
                  key = key_xform((__builtin_bit_cast(int, s1 + s2v) & ~63) | (63 - ci)); }
              v[k] = key; }
          bitonic_sort16_desc(v);
#define TK_MERGE(CTRL) do { int o_[16]; _Pragma("unroll") for (int i = 0; i < 16; ++i) o_[i] = __builtin_amdgcn_update_dpp(0, v[15 - i], (CTRL), 0xf, 0xf, false); \
              _Pragma("unroll") for (int i = 0; i < 16; ++i) v[i] = max(v[i], o_[i]); bitonic_merge16_desc(v); } while (0)
          TK_MERGE(0xB1); TK_MERGE(0x4E);
#undef TK_MERGE
          if (sub == 0) {
#pragma unroll
              for (int k = 0; k < 16; ++k) OUTK[m * 16 + k] = v[k]; }
          asm volatile("s_waitcnt lgkmcnt(0)" ::: "memory");
          const int kb = key_xform(OUTK[m * 16 + sub]), k0b = key_xform(OUTK[m * 16]);
          const float sv = __builtin_bit_cast(float, kb & ~63), smax = __builtin_bit_cast(float, k0b & ~63);
          const float e = __expf(sv - smax); float den = e;
          den += __shfl_xor(den, 1); den += __shfl_xor(den, 2); den += __shfl_xor(den, 4); den += __shfl_xor(den, 8);
          const int code = TAB[63 - (kb & 63)];
          const int i1 = LST[(m * 2 + 0) * 16 + (code >> 4)] & 127, i2 = LST[(m * 2 + 1) * 16 + (code & 15)] & 127;
          ids[(size_t)(m0 + m) * 128 + h * 16 + sub] = i1 * 128 + i2; gg[(size_t)(m0 + m) * 128 + h * 16 + sub] = e / den; }
    }
#undef TK_QLOAD
}

__device__ __forceinline__ void ph_topk1(const Params& p, int layer, const Ctx& c) {
    const bf16_t* Q = (const bf16_t*)(p.ws + WS_PROJ); float* tops = (float*)(p.ws + WS_TOPS); int* topi = (int*)(p.ws + WS_TOPI);
    const float* keys = p.peer_sub_keys + (size_t)layer * 16 * 128 * 128;
    for (int gid = c.gtid; gid < M * 32; gid += c.gthreads) {
        const int idx = gid >> 1, half = gid & 1;
        const int t = idx & (M - 1), hp = __builtin_amdgcn_readfirstlane(idx >> 15);
        float q[64];
        { const u32x4* qp = (const u32x4*)(Q + (size_t)t * 2048 + hp * 128 + half * 64);
#pragma unroll
          for (int i = 0; i < 8; ++i) { const u32x4 w = qp[i]; q[8*i] = bflo(w.x); q[8*i+1] = bfhi(w.x); q[8*i+2] = bflo(w.y); q[8*i+3] = bfhi(w.y); q[8*i+4] = bflo(w.z); q[8*i+5] = bfhi(w.z); q[8*i+6] = bflo(w.w); q[8*i+7] = bfhi(w.w); } }
        float ls[16]; int li[16];
#pragma unroll
        for (int j = 0; j < 16; ++j) { ls[j] = -3.0e38f; li[j] = 0; }
        for (int n = 0; n < 128; ++n) { const float* kr = keys + ((size_t)hp * 128 + n) * 128 + half * 64;
            float s = 0.f;
#pragma unroll
            for (int cc = 0; cc < 64; ++cc) s += q[cc] * kr[cc];
            s += __shfl_xor(s, 1);
            int ni = n;
#pragma unroll
            for (int j = 0; j < 16; ++j) { const bool gt = s > ls[j]; const float ts = gt ? ls[j] : s; const int ti = gt ? li[j] : ni; ls[j] = gt ? s : ls[j]; li[j] = gt ? ni : li[j]; s = ts; ni = ti; }
        }
        if (half == 0) { float* os = tops + ((size_t)t * 16 + hp) * 16; int* oi = topi + ((size_t)t * 16 + hp) * 16;
#pragma unroll
            for (int j = 0; j < 16; ++j) { os[j] = ls[j]; oi[j] = li[j]; } }
    }
}
__device__ __forceinline__ void ph_topk2(const Params& p, const Ctx& c) {
    const float* tops = (const float*)(p.ws + WS_TOPS); const int* topi = (const int*)(p.ws + WS_TOPI);
    int* ids = (int*)(p.ws + WS_IDS); float* gg = (float*)(p.ws + WS_G);
    for (int idx = c.gtid; idx < M * 8; idx += c.gthreads) {
        const int t = idx >> 3, h = idx & 7;
        float s1[16], s2[16]; int i1[16], i2[16];
        { const float* a = tops + ((size_t)t * 16 + h * 2) * 16; const int* ai = topi + ((size_t)t * 16 + h * 2) * 16;
#pragma unroll
          for (int j = 0; j < 16; ++j) { s1[j] = a[j]; s2[j] = a[16 + j]; i1[j] = ai[j]; i2[j] = ai[16 + j]; } }
        float ls[16]; int lc[16];
#pragma unroll
        for (int j = 0; j < 16; ++j) { ls[j] = -3.0e38f; lc[j] = 0; }
#pragma unroll
        for (int i = 0; i < 16; ++i)
#pragma unroll
            for (int j = 0; j < 16 / (i + 1); ++j) { float s = s1[i] + s2[j]; int cd = i * 16 + j;
#pragma unroll
                for (int k = 0; k < 16; ++k) { const bool gt = s > ls[k]; const float ts = gt ? ls[k] : s; const int tc = gt ? lc[k] : cd; ls[k] = gt ? s : ls[k]; lc[k] = gt ? cd : lc[k]; s = ts; cd = tc; } }
        float den = 0.f, e[16];
#pragma unroll
        for (int k = 0; k < 16; ++k) { e[k] = __expf(ls[k] - ls[0]); den += e[k]; }
        const float rd = 1.f / den;
#pragma unroll
        for (int k = 0; k < 16; ++k) { const int ci = lc[k] >> 4, cj = lc[k] & 15; int a = 0, bq = 0;
#pragma unroll
            for (int z = 0; z < 16; ++z) { a = (ci == z) ? i1[z] : a; bq = (cj == z) ? i2[z] : bq; }
            ids[(size_t)t * 128 + h * 16 + k] = a * 128 + bq; gg[(size_t)t * 128 + h * 16 + k] = e[k] * rd; }
    }
}
__device__ __forceinline__ void ph_gather(const Params& p, const Ctx& c) {
    const bf16_t* XN = (const bf16_t*)(p.ws + WS_ACT); const bf16_t* UT = (const bf16_t*)(p.ws + WS_TAB); const bf16_t* VT = UT + (size_t)NEXP * DM;
    const int* ids = (const int*)(p.ws + WS_IDS); const float* gg = (const float*)(p.ws + WS_G);
    for (int m = c.gwave; m < M; m += c.gwaves) {
        float x[16], o[16];
        { const u32x4 a = *((const u32x4*)(XN + (size_t)m * DM) + c.lane), b = *((const u32x4*)(XN + (size_t)m * DM + 512) + c.lane);
          x[0] = bflo(a.x); x[1] = bfhi(a.x); x[2] = bflo(a.y); x[3] = bfhi(a.y); x[4] = bflo(a.z); x[5] = bfhi(a.z); x[6] = bflo(a.w); x[7] = bfhi(a.w);
          x[8] = bflo(b.x); x[9] = bfhi(b.x); x[10] = bflo(b.y); x[11] = bfhi(b.y); x[12] = bflo(b.z); x[13] = bfhi(b.z); x[14] = bflo(b.w); x[15] = bfhi(b.w); }
#pragma unroll
        for (int i = 0; i < 16; ++i) o[i] = 0.f;
        const int id0 = ids[(size_t)m * 128 + c.lane], id1 = ids[(size_t)m * 128 + 64 + c.lane];
        const float g0 = gg[(size_t)m * 128 + c.lane], g1 = gg[(size_t)m * 128 + 64 + c.lane];
        for (int k0 = 0; k0 < 128; k0 += 4) {
            u32x4 ua[4], ub[4], va[4], vb[4]; float gk[4];
#pragma unroll
            for (int j = 0; j < 4; ++j) { const int k = k0 + j; const int id = (k < 64) ? __shfl(id0, k) : __shfl(id1, k - 64); gk[j] = (k < 64) ? __shfl(g0, k) : __shfl(g1, k - 64);
                const u32x4* ur = (const u32x4*)(UT + (size_t)id * DM); const u32x4* vr = (const u32x4*)(VT + (size_t)id * DM);
                ua[j] = ur[c.lane]; ub[j] = ur[64 + c.lane]; va[j] = vr[c.lane]; vb[j] = vr[64 + c.lane]; }
#pragma unroll
            for (int j = 0; j < 4; ++j) {
                float d = x[0] * bflo(ua[j].x) + x[1] * bfhi(ua[j].x) + x[2] * bflo(ua[j].y) + x[3] * bfhi(ua[j].y) + x[4] * bflo(ua[j].z) + x[5] * bfhi(ua[j].z) + x[6] * bflo(ua[j].w) + x[7] * bfhi(ua[j].w)
                        + x[8] * bflo(ub[j].x) + x[9] * bfhi(ub[j].x) + x[10] * bflo(ub[j].y) + x[11] * bfhi(ub[j].y) + x[12] * bflo(ub[j].z) + x[13] * bfhi(ub[j].z) + x[14] * bflo(ub[j].w) + x[15] * bfhi(ub[j].w);
                d = wave_sum(d);
                const float act = gelu_tanh(d) * gk[j];
                o[0] += act * bflo(va[j].x); o[1] += act * bfhi(va[j].x); o[2] += act * bflo(va[j].y); o[3] += act * bfhi(va[j].y); o[4] += act * bflo(va[j].z); o[5] += act * bfhi(va[j].z); o[6] += act * bflo(va[j].w); o[7] += act * bfhi(va[j].w);
                o[8] += act * bflo(vb[j].x); o[9] += act * bfhi(vb[j].x); o[10] += act * bflo(vb[j].y); o[11] += act * bfhi(vb[j].y); o[12] += act * bflo(vb[j].z); o[13] += act * bfhi(vb[j].z); o[14] += act * bflo(vb[j].w); o[15] += act * bfhi(vb[j].w);
            }
        }
        f32x4* hp = (f32x4*)(p.out + (size_t)m * DM);
        f32x4 h0 = hp[2 * c.lane], h1 = hp[2 * c.lane + 1], h2 = hp[128 + 2 * c.lane], h3 = hp[128 + 2 * c.lane + 1];
        h0 += (f32x4){o[0], o[1], o[2], o[3]}; h1 += (f32x4){o[4], o[5], o[6], o[7]}; h2 += (f32x4){o[8], o[9], o[10], o[11]}; h3 += (f32x4){o[12], o[13], o[14], o[15]};
        hp[2 * c.lane] = h0; hp[2 * c.lane + 1] = h1; hp[128 + 2 * c.lane] = h2; hp[128 + 2 * c.lane + 1] = h3;
    }
}

__device__ __forceinline__ void ph_gather2(const Params& p, const Ctx& c) {
    const bf16_t* XN = (const bf16_t*)(p.ws + WS_ACT); const bf16_t* UT = (const bf16_t*)(p.ws + WS_TAB); const bf16_t* VT = UT + (size_t)NEXP * DM;
    const int* ids = (const int*)(p.ws + WS_IDS); const float* gg = (const float*)(p.ws + WS_G);
    LAS unsigned char* wl = c.lds + c.wave * 4096;
    LAS bf16_t* xs = (LAS bf16_t*)wl; LAS float* dsm = (LAS float*)(wl + 2048);
    const int lane = c.lane, r = lane & 15, q = lane >> 4;
    for (int m = c.gwave; m < M; m += c.gwaves) {
        { const u32x4 xa = *((const u32x4*)(XN + (size_t)m * DM) + lane), xb = *((const u32x4*)(XN + (size_t)m * DM + 512) + lane);
          *((LAS u32x4*)xs + lane) = xa; *((LAS u32x4*)(xs + 512) + lane) = xb; }
        const int id0 = ids[(size_t)m * 128 + lane], id1 = ids[(size_t)m * 128 + 64 + lane];
        const float g0 = gg[(size_t)m * 128 + lane], g1 = gg[(size_t)m * 128 + 64 + lane];
        const char* rowp[8];
#pragma unroll
        for (int g = 0; g < 8; ++g) { const int idg = __shfl(g < 4 ? id0 : id1, 16 * (g & 3) + r); rowp[g] = (const char*)(UT + (size_t)idg * DM) + q * 16; }
        f32x4 acc[8];
#pragma unroll
        for (int g = 0; g < 8; ++g) acc[g] = (f32x4){0.f, 0.f, 0.f, 0.f};
#pragma unroll 1
        for (int kc = 0; kc < 4; ++kc) {
            bf16x8 xb8[8];
#pragma unroll
            for (int s = 0; s < 8; ++s) xb8[s] = *(const LAS bf16x8*)(xs + (kc * 8 + s) * 32 + 8 * q);
#pragma unroll
            for (int g = 0; g < 8; ++g) { bf16x8 a[8];
#pragma unroll
                for (int s = 0; s < 8; ++s) a[s] = *(const bf16x8*)(rowp[g] + (kc * 8 + s) * 64);
#pragma unroll
                for (int s = 0; s < 8; ++s) acc[g] = __builtin_amdgcn_mfma_f32_16x16x32_bf16(a[s], xb8[s], acc[g], 0, 0, 0); }
        }
#pragma unroll
        for (int g = 0; g < 8; ++g) if (r == 0) *(LAS f32x4*)(dsm + 16 * g + 4 * q) = acc[g];
        const float d0 = dsm[lane], d1 = dsm[64 + lane];
        const int act0 = __builtin_bit_cast(int, gelu_tanh(d0) * g0), act1 = __builtin_bit_cast(int, gelu_tanh(d1) * g1);
        float o[16];
#pragma unroll
        for (int i = 0; i < 16; ++i) o[i] = 0.f;
#pragma unroll
        for (int hh = 0; hh < 2; ++hh) { const int idv = hh ? id1 : id0; const int actv = hh ? act1 : act0;
#pragma unroll 1
            for (int e0 = 0; e0 < 64; e0 += 8) {
                u32x4 va[8], vb[8]; float ae[8];
#pragma unroll
                for (int j = 0; j < 8; ++j) { const int id = __builtin_amdgcn_readlane(idv, e0 + j); ae[j] = __builtin_bit_cast(float, __builtin_amdgcn_readlane(actv, e0 + j));
                    const u32x4* vr = (const u32x4*)(VT + (size_t)id * DM); va[j] = vr[lane]; vb[j] = vr[64 + lane]; }
#pragma unroll
                for (int j = 0; j < 8; ++j) { const float act = ae[j];
                    o[0] += act * bflo(va[j].x); o[1] += act * bfhi(va[j].x); o[2] += act * bflo(va[j].y); o[3] += act * bfhi(va[j].y); o[4] += act * bflo(va[j].z); o[5] += act * bfhi(va[j].z); o[6] += act * bflo(va[j].w); o[7] += act * bfhi(va[j].w);
                    o[8] += act * bflo(vb[j].x); o[9] += act * bfhi(vb[j].x); o[10] += act * bflo(vb[j].y); o[11] += act * bfhi(vb[j].y); o[12] += act * bflo(vb[j].z); o[13] += act * bfhi(vb[j].z); o[14] += act * bflo(vb[j].w); o[15] += act * bfhi(vb[j].w); }
            } }
        f32x4* hp = (f32x4*)(p.out + (size_t)m * DM);
        f32x4 h0 = hp[2 * lane], h1 = hp[2 * lane + 1], h2 = hp[128 + 2 * lane], h3 = hp[128 + 2 * lane + 1];
        h0 += (f32x4){o[0], o[1], o[2], o[3]}; h1 += (f32x4){o[4], o[5], o[6], o[7]}; h2 += (f32x4){o[8], o[9], o[10], o[11]}; h3 += (f32x4){o[12], o[13], o[14], o[15]};
        hp[2 * lane] = h0; hp[2 * lane + 1] = h1; hp[128 + 2 * lane] = h2; hp[128 + 2 * lane + 1] = h3;
    }
}

__device__ __forceinline__ float wave_max(float v) {
#pragma unroll
    for (int o = 1; o < 64; o <<= 1) v = fmaxf(v, __shfl_xor(v, o));
    return v;
}
__device__ __forceinline__ void cvt_fp8_rows(const float* src, unsigned char* dst, float* scl, int nrows, const Ctx& c) {
    for (int row = c.gwave; row < nrows; row += c.gwaves) {
        const f32x4* sp = (const f32x4*)(src + (size_t)row * DM) + 4 * c.lane; f32x4 v[4]; float mx = 0.f;
#pragma unroll
        for (int j = 0; j < 4; ++j) { v[j] = sp[j]; mx = fmaxf(mx, fmaxf(fmaxf(fabsf(v[j].x), fabsf(v[j].y)), fmaxf(fabsf(v[j].z), fabsf(v[j].w)))); }
        mx = wave_max(mx);
        const float sc = mx > 0.f ? mx * (1.f / 416.f) : 1.f, inv = 1.f / sc;
        u32x4 w; int t;
        t = __builtin_amdgcn_cvt_pk_fp8_f32(v[0].x * inv, v[0].y * inv, 0, false); t = __builtin_amdgcn_cvt_pk_fp8_f32(v[0].z * inv, v[0].w * inv, t, true); w.x = (unsigned)t;
        t = __builtin_amdgcn_cvt_pk_fp8_f32(v[1].x * inv, v[1].y * inv, 0, false); t = __builtin_amdgcn_cvt_pk_fp8_f32(v[1].z * inv, v[1].w * inv, t, true); w.y = (unsigned)t;
        t = __builtin_amdgcn_cvt_pk_fp8_f32(v[2].x * inv, v[2].y * inv, 0, false); t = __builtin_amdgcn_cvt_pk_fp8_f32(v[2].z * inv, v[2].w * inv, t, true); w.z = (unsigned)t;
        t = __builtin_amdgcn_cvt_pk_fp8_f32(v[3].x * inv, v[3].y * inv, 0, false); t = __builtin_amdgcn_cvt_pk_fp8_f32(v[3].z * inv, v[3].w * inv, t, true); w.w = (unsigned)t;
        *(u32x4*)(dst + (size_t)(c.lane >> 3) * NEXP * 128 + (size_t)row * 128 + (c.lane & 7) * 16) = w;
        if (c.lane == 0) scl[row] = sc;
    }
}
typedef float f32x2 __attribute__((ext_vector_type(2)));
__device__ __forceinline__ void cvt_fp8_roundtrip_rows(const float* src, bf16_t* dst, int nrows, const Ctx& c) {
    for (int row = c.gwave; row < nrows; row += c.gwaves) {
        const f32x4* sp = (const f32x4*)(src + (size_t)row * DM) + 4 * c.lane; f32x4 v[4]; float mx = 0.f;
#pragma unroll
        for (int j = 0; j < 4; ++j) { v[j] = sp[j]; mx = fmaxf(mx, fmaxf(fmaxf(fabsf(v[j].x), fabsf(v[j].y)), fmaxf(fabsf(v[j].z), fabsf(v[j].w)))); }
        mx = wave_max(mx);
        const float sc = mx > 0.f ? mx * (1.f / 416.f) : 1.f, inv = 1.f / sc;
        u32x4 o0, o1;
#pragma unroll
        for (int j = 0; j < 4; ++j) { int t = __builtin_amdgcn_cvt_pk_fp8_f32(v[j].x * inv, v[j].y * inv, 0, false); t = __builtin_amdgcn_cvt_pk_fp8_f32(v[j].z * inv, v[j].w * inv, t, true);
            const f32x2 a = __builtin_amdgcn_cvt_pk_f32_fp8(t, false), b = __builtin_amdgcn_cvt_pk_f32_fp8(t, true);
            const unsigned lo = pk2(a.x * sc, a.y * sc), hi = pk2(b.x * sc, b.y * sc);
            if (j == 0) { o0.x = lo; o0.y = hi; } else if (j == 1) { o0.z = lo; o0.w = hi; } else if (j == 2) { o1.x = lo; o1.y = hi; } else { o1.z = lo; o1.w = hi; } }
        u32x4* dp = (u32x4*)(dst + (size_t)row * DM) + 2 * c.lane; dp[0] = o0; dp[1] = o1;
    }
}
__device__ __forceinline__ u32x2 fp8x4_to_bf16x4(unsigned w) {
    const f32x2 a = __builtin_amdgcn_cvt_pk_f32_fp8((int)w, false), b = __builtin_amdgcn_cvt_pk_f32_fp8((int)w, true);
    u32x2 o;
    asm("v_cvt_pk_bf16_f32 %0, %1, %2" : "=v"(o.x) : "v"(a.x), "v"(a.y));
    asm("v_cvt_pk_bf16_f32 %0, %1, %2" : "=v"(o.y) : "v"(b.x), "v"(b.y));
    return o;
}
__device__ __forceinline__ void ph_gather3(const Params& p, int layer, const Ctx& c, float* hdst) {
    const bf16_t* XN = (const bf16_t*)(p.ws + WS_ACT);
    const unsigned char* UT = p.ws + WS_TAB8 + (size_t)layer * 2 * NEXP * DM; const unsigned char* VT = UT + (size_t)NEXP * DM;
    const float* SU = (const float*)(p.ws + WS_SCL) + (size_t)layer * 2 * NEXP; const float* SV = SU + NEXP;
    const int* ids = (const int*)(p.ws + WS_IDS); const float* gg = (const float*)(p.ws + WS_G);
    LAS unsigned char* wl = c.lds + c.wave * 4096;
    LAS bf16_t* xs = (LAS bf16_t*)wl; LAS float* dsm = (LAS float*)(wl + 2048);
    const int lane = c.lane, r = lane & 15, q = lane >> 4;
    for (int m = c.gwave; m < M; m += c.gwaves) {
        { const u32x4 xa = *((const u32x4*)(XN + (size_t)m * DM) + lane), xb = *((const u32x4*)(XN + (size_t)m * DM + 512) + lane);
          asm volatile("" ::: "memory"); *((LAS u32x4*)xs + lane) = xa; *((LAS u32x4*)(xs + 512) + lane) = xb; asm volatile("" ::: "memory"); }
        const int id0 = ids[(size_t)m * 128 + lane], id1 = ids[(size_t)m * 128 + 64 + lane];
#ifdef PROBE_VF32
        const float g0 = gg[(size_t)m * 128 + lane], g1 = gg[(size_t)m * 128 + 64 + lane];
#else
        const float g0 = gg[(size_t)m * 128 + lane] * SV[id0], g1 = gg[(size_t)m * 128 + 64 + lane] * SV[id1];
#endif
        const float su0 = SU[id0], su1 = SU[id1];
#pragma unroll 1
        for (int gp = 0; gp < 4; ++gp) {
            const int idsel = gp < 2 ? id0 : id1;
            const int ida = __shfl(idsel, (gp & 1) * 32 + r), idb = __shfl(idsel, (gp & 1) * 32 + 16 + r);
            const unsigned char* rowa = UT + (size_t)ida * DM + q * 16; const unsigned char* rowb = UT + (size_t)idb * DM + q * 16;
            f32x4 acca = {0.f, 0.f, 0.f, 0.f}, accb = {0.f, 0.f, 0.f, 0.f};
#pragma unroll 1
            for (int kc = 0; kc < 4; ++kc) {
                u32x4 a[4], bb[4];
#pragma unroll
                for (int s = 0; s < 4; ++s) { a[s] = *(const u32x4*)(rowa + (kc * 4 + s) * 64); bb[s] = *(const u32x4*)(rowb + (kc * 4 + s) * 64); }
                bf16x8 xb8[8];
#pragma unroll
                for (int s = 0; s < 4; ++s) { xb8[2 * s] = __builtin_bit_cast(bf16x8, *(const LAS u32x4*)(xs + (kc * 4 + s) * 64 + 16 * q)); xb8[2 * s + 1] = __builtin_bit_cast(bf16x8, *(const LAS u32x4*)(xs + (kc * 4 + s) * 64 + 16 * q + 8)); }
#pragma unroll
                for (int s = 0; s < 4; ++s) {
                    { const u32x2 c0 = fp8x4_to_bf16x4(a[s].x), c1 = fp8x4_to_bf16x4(a[s].y), c2 = fp8x4_to_bf16x4(a[s].z), c3 = fp8x4_to_bf16x4(a[s].w); const u32x4 b0 = {c0.x, c0.y, c1.x, c1.y}, b1 = {c2.x, c2.y, c3.x, c3.y};
                      acca = __builtin_amdgcn_mfma_f32_16x16x32_bf16(__builtin_bit_cast(bf16x8, b0), xb8[2 * s], acca, 0, 0, 0);
                      acca = __builtin_amdgcn_mfma_f32_16x16x32_bf16(__builtin_bit_cast(bf16x8, b1), xb8[2 * s + 1], acca, 0, 0, 0); }
                    { const u32x2 c0 = fp8x4_to_bf16x4(bb[s].x), c1 = fp8x4_to_bf16x4(bb[s].y), c2 = fp8x4_to_bf16x4(bb[s].z), c3 = fp8x4_to_bf16x4(bb[s].w); const u32x4 b0 = {c0.x, c0.y, c1.x, c1.y}, b1 = {c2.x, c2.y, c3.x, c3.y};
                      accb = __builtin_amdgcn_mfma_f32_16x16x32_bf16(__builtin_bit_cast(bf16x8, b0), xb8[2 * s], accb, 0, 0, 0);
                      accb = __builtin_amdgcn_mfma_f32_16x16x32_bf16(__builtin_bit_cast(bf16x8, b1), xb8[2 * s + 1], accb, 0, 0, 0); }
                    __builtin_amdgcn_sched_barrier(0); }
            }
            if (r == 0) { *(LAS f32x4*)(dsm + 32 * gp + 4 * q) = acca; *(LAS f32x4*)(dsm + 32 * gp + 16 + 4 * q) = accb; }
        }
        asm volatile("" ::: "memory");
        const float d0 = dsm[lane] * su0, d1 = dsm[64 + lane] * su1;
        asm volatile("" ::: "memory");
        const int act0 = __builtin_bit_cast(int, gelu_tanh(d0) * g0), act1 = __builtin_bit_cast(int, gelu_tanh(d1) * g1);
        float o[16];
#pragma unroll
        for (int i = 0; i < 16; ++i) o[i] = 0.f;
#pragma unroll
        for (int hh = 0; hh < 2; ++hh) { const int idv = hh ? id1 : id0; const int actv = hh ? act1 : act0;
#ifdef PROBE_VF32
#pragma unroll 1
            for (int e0 = 0; e0 < 64; ++e0) { const int id = __builtin_amdgcn_readlane(idv, e0); const float act = __builtin_bit_cast(float, __builtin_amdgcn_readlane(actv, e0));
                const f32x4* vr = (const f32x4*)(p.peer_v + ((size_t)layer * NEXP + id) * DM) + 4 * lane; const f32x4 v0 = vr[0], v1 = vr[1], v2 = vr[2], v3 = vr[3];
                o[0] += act * v0.x; o[1] += act * v0.y; o[2] += act * v0.z; o[3] += act * v0.w; o[4] += act * v1.x; o[5] += act * v1.y; o[6] += act * v1.z; o[7] += act * v1.w;
                o[8] += act * v2.x; o[9] += act * v2.y; o[10] += act * v2.z; o[11] += act * v2.w; o[12] += act * v3.x; o[13] += act * v3.y; o[14] += act * v3.z; o[15] += act * v3.w; } }
#else
#pragma unroll 1
            for (int e0 = 0; e0 < 64; e0 += 16) {
                u32x4 va[16]; float ae[16];
#pragma unroll
                for (int j = 0; j < 16; ++j) { const int id = __builtin_amdgcn_readlane(idv, e0 + j); ae[j] = __builtin_bit_cast(float, __builtin_amdgcn_readlane(actv, e0 + j));
                    va[j] = *((const u32x4*)(VT + (size_t)id * DM) + lane); }
#pragma unroll
                for (int j = 0; j < 16; ++j) { const float act = ae[j];
                    f32x2 t;
                    t = __builtin_amdgcn_cvt_pk_f32_fp8((int)va[j].x, false); o[0] += act * t.x; o[1] += act * t.y; t = __builtin_amdgcn_cvt_pk_f32_fp8((int)va[j].x, true); o[2] += act * t.x; o[3] += act * t.y;
                    t = __builtin_amdgcn_cvt_pk_f32_fp8((int)va[j].y, false); o[4] += act * t.x; o[5] += act * t.y; t = __builtin_amdgcn_cvt_pk_f32_fp8((int)va[j].y, true); o[6] += act * t.x; o[7] += act * t.y;
                    t = __builtin_amdgcn_cvt_pk_f32_fp8((int)va[j].z, false); o[8] += act * t.x; o[9] += act * t.y; t = __builtin_amdgcn_cvt_pk_f32_fp8((int)va[j].z, true); o[10] += act * t.x; o[11] += act * t.y;
                    t = __builtin_amdgcn_cvt_pk_f32_fp8((int)va[j].w, false); o[12] += act * t.x; o[13] += act * t.y; t = __builtin_amdgcn_cvt_pk_f32_fp8((int)va[j].w, true); o[14] += act * t.x; o[15] += act * t.y; }
            } }
#endif
        f32x4* hp = (f32x4*)(p.out + (size_t)m * DM) + 4 * lane;
        f32x4 h0 = hp[0], h1 = hp[1], h2 = hp[2], h3 = hp[3];
        h0 += (f32x4){o[0], o[1], o[2], o[3]}; h1 += (f32x4){o[4], o[5], o[6], o[7]}; h2 += (f32x4){o[8], o[9], o[10], o[11]}; h3 += (f32x4){o[12], o[13], o[14], o[15]};
        f32x4* hq = (f32x4*)(hdst + (size_t)m * DM) + 4 * lane; hq[0] = h0; hq[1] = h1; hq[2] = h2; hq[3] = h3;
    }
}


constexpr size_t WS_PD = WS_S;
constexpr size_t WS_ACTB = WS_S + 224 * MiB;
struct XI { int xr, nx, jr, nloc; };
typedef long i64_t;
__device__ __forceinline__ i64_t pack64(unsigned lo, unsigned hi) { return (i64_t)(((unsigned long long)hi << 32) | lo); }
__device__ __forceinline__ void peer_u_half(const u32x4 (&v)[8], const i64_t (&xh)[4], const i64_t (&xl)[4], LAS unsigned char* img, LAS float* pdp, int lane) {
    const int e8 = lane >> 3, cc = lane & 7, r = lane & 15, q = lane >> 4;
#pragma unroll
    for (int j = 0; j < 8; ++j) *(LAS u32x4*)(img + (8 * e8 + j) * 128 + ((cc ^ j) << 4)) = v[j];
    asm volatile("" ::: "memory");
#pragma unroll
    for (int g = 0; g < 4; ++g) { f32x4 ah = {0.f, 0.f, 0.f, 0.f}, al = {0.f, 0.f, 0.f, 0.f}; const int row = 16 * g + r;
#pragma unroll
        for (int s4 = 0; s4 < 4; ++s4) { const i64_t w = *(const LAS i64_t*)(img + row * 128 + (((2 * s4 + (q >> 1)) ^ (row & 7)) << 4) + 8 * (q & 1));
            ah = __builtin_amdgcn_mfma_f32_16x16x32_fp8_fp8(w, xh[s4], ah, 0, 0, 0); al = __builtin_amdgcn_mfma_f32_16x16x32_fp8_fp8(w, xl[s4], al, 0, 0, 0); }
        if (r == 0) *(LAS f32x4*)(pdp + 16 * g + 4 * q) = ah + al * 0.0625f; }
    asm volatile("" ::: "memory");
}
__device__ __forceinline__ void split_x8(const u32x4 xv, i64_t& xh, i64_t& xl) {
    const float f[8] = {bflo(xv.x), bfhi(xv.x), bflo(xv.y), bfhi(xv.y), bflo(xv.z), bfhi(xv.z), bflo(xv.w), bfhi(xv.w)};
    int h0 = __builtin_amdgcn_cvt_pk_fp8_f32(f[0], f[1], 0, false); h0 = __builtin_amdgcn_cvt_pk_fp8_f32(f[2], f[3], h0, true);
    int h1 = __builtin_amdgcn_cvt_pk_fp8_f32(f[4], f[5], 0, false); h1 = __builtin_amdgcn_cvt_pk_fp8_f32(f[6], f[7], h1, true);
    const f32x2 d0 = __builtin_amdgcn_cvt_pk_f32_fp8(h0, false), d1 = __builtin_amdgcn_cvt_pk_f32_fp8(h0, true), d2 = __builtin_amdgcn_cvt_pk_f32_fp8(h1, false), d3 = __builtin_amdgcn_cvt_pk_f32_fp8(h1, true);
    int l0 = __builtin_amdgcn_cvt_pk_fp8_f32((f[0] - d0.x) * 16.f, (f[1] - d0.y) * 16.f, 0, false); l0 = __builtin_amdgcn_cvt_pk_fp8_f32((f[2] - d1.x) * 16.f, (f[3] - d1.y) * 16.f, l0, true);
    int l1 = __builtin_amdgcn_cvt_pk_fp8_f32((f[4] - d2.x) * 16.f, (f[5] - d2.y) * 16.f, 0, false); l1 = __builtin_amdgcn_cvt_pk_fp8_f32((f[6] - d3.x) * 16.f, (f[7] - d3.y) * 16.f, l1, true);
    xh = pack64((unsigned)h0, (unsigned)h1); xl = pack64((unsigned)l0, (unsigned)l1);
}
__device__ __forceinline__ void ph_peer_u(const Params& p, int layer, const Ctx& c, const XI xi, int idmask) {
    const bf16_t* XN = (const bf16_t*)(p.ws + WS_ACT); const unsigned char* UT = p.ws + WS_TAB8 + (size_t)layer * 2 * NEXP * DM;
    const int* ids = (const int*)(p.ws + WS_IDS); float* PD = (float*)(p.ws + WS_PD);
    const int lane = c.lane, e8 = lane >> 3, cc = lane & 7, q = lane >> 4;
    const int tstep = xi.nloc * NWAVES;
    LAS unsigned char* img = c.lds + c.wave * 8192; LAS float* stg = (LAS float*)(c.lds + 65536 + c.wave * 512);
#pragma unroll 1
    for (int sl = xi.xr; sl < 8; sl += xi.nx) {
        const unsigned char* Us = UT + (size_t)sl * NEXP * 128; const unsigned uo = 16u * (unsigned)cc;
        int t = xi.jr * NWAVES + c.wave;
        if (t >= M) continue;
#define PU_LD(k) ((idmask & 0x10000) ? (u32x4){(unsigned)(k), (unsigned)(k), uo, uo} : *(const u32x4*)(Us + (((unsigned)((k) & (idmask & 0xffff)) << 7) + uo)))
#define PU_ROWS(dst, ia, ib) do { dst[0] = PU_LD((ia).x); dst[1] = PU_LD((ia).y); dst[2] = PU_LD((ia).z); dst[3] = PU_LD((ia).w); dst[4] = PU_LD((ib).x); dst[5] = PU_LD((ib).y); dst[6] = PU_LD((ib).z); dst[7] = PU_LD((ib).w); } while (0)
#define PU_X(tt) do { const bf16_t* xp = XN + (size_t)(tt) * DM + 128 * sl + 8 * q; xv[0] = *(const u32x4*)xp; xv[1] = *(const u32x4*)(xp + 32); xv[2] = *(const u32x4*)(xp + 64); xv[3] = *(const u32x4*)(xp + 96); } while (0)
#define PU_SPLIT() do { _Pragma("unroll") for (int k_ = 0; k_ < 4; ++k_) split_x8(xv[k_], xh[k_], xl[k_]); } while (0)
        u32x4 v[8], vn[8], xv[4]; i64_t xh[4], xl[4]; i32x4 ic2, ic3;
        { const i32x4* ip = (const i32x4*)(ids + (size_t)t * 128 + 8 * e8); const i32x4 i0 = ip[0], i1 = ip[1]; ic2 = ip[16]; ic3 = ip[17]; PU_ROWS(v, i0, i1); PU_X(t); }
#pragma unroll 1
        for (; t < M; t += tstep) {
            const int tn = min(t + tstep, M - 1);
            const i32x4* ipn = (const i32x4*)(ids + (size_t)tn * 128 + 8 * e8); const i32x4 in0 = ipn[0], in1 = ipn[1], in2 = ipn[16], in3 = ipn[17];
            PU_ROWS(vn, ic2, ic3);
            PU_SPLIT();
            __builtin_amdgcn_sched_barrier(0);
            if (!(idmask & 0x20000)) peer_u_half(v, xh, xl, img, stg, lane); else { _Pragma("unroll") for (int j_ = 0; j_ < 8; ++j_) asm volatile("" :: "v"(v[j_])); }
#pragma unroll
            for (int j = 0; j < 8; ++j) v[j] = vn[j];
            PU_ROWS(vn, in0, in1);
            __builtin_amdgcn_sched_barrier(0);
            if (!(idmask & 0x20000)) peer_u_half(v, xh, xl, img, stg + 64, lane); else { _Pragma("unroll") for (int j_ = 0; j_ < 8; ++j_) asm volatile("" :: "v"(v[j_])); }
#pragma unroll
            for (int j = 0; j < 8; ++j) v[j] = vn[j];
            ic2 = in2; ic3 = in3;
            asm volatile("" ::: "memory");
            *(f32x2*)(PD + ((size_t)sl * M + t) * 128 + 2 * lane) = *(const LAS f32x2*)(stg + 2 * lane);
            asm volatile("" ::: "memory");
            PU_X(tn);
        }
#undef PU_LD
#undef PU_ROWS
#undef PU_X
#undef PU_SPLIT
    }
}
__device__ __forceinline__ void ph_peer_act(const Params& p, int layer, const Ctx& c) {
    const float* PD = (const float*)(p.ws + WS_PD); float* ACTB = (float*)(p.ws + WS_ACTB);
    const float* SU = (const float*)(p.ws + WS_SCL) + (size_t)layer * 2 * NEXP; const float* SV = SU + NEXP;
    const int* ids = (const int*)(p.ws + WS_IDS); const float* gg = (const float*)(p.ws + WS_G);
    for (int idx = c.gtid; idx < M * 128; idx += c.gthreads) { float d = 0.f;
#pragma unroll
        for (int sl = 0; sl < 8; ++sl) d += PD[(size_t)sl * M * 128 + idx];
        const int id = ids[idx]; ACTB[idx] = gelu_tanh(d * SU[id]) * gg[idx] * SV[id]; }
}
#define PIN16(o) asm volatile("" : "+v"(o[0]), "+v"(o[1]), "+v"(o[2]), "+v"(o[3]), "+v"(o[4]), "+v"(o[5]), "+v"(o[6]), "+v"(o[7]), "+v"(o[8]), "+v"(o[9]), "+v"(o[10]), "+v"(o[11]), "+v"(o[12]), "+v"(o[13]), "+v"(o[14]), "+v"(o[15]))
__device__ __forceinline__ void peer_v_half(const u32x4 (&vin)[8], const f32x4& a0, const f32x4& a1, float (&o)[16]) {
#pragma unroll
    for (int j = 0; j < 8; ++j) { const float act = (j < 4) ? a0[j & 3] : a1[j & 3]; f32x2 tt; u32x4 vr = vin[j];
        asm volatile("" : "+v"(vr.x), "+v"(vr.y), "+v"(vr.z), "+v"(vr.w));
        tt = __builtin_amdgcn_cvt_pk_f32_fp8((int)vr.x, false); o[0] += act * tt.x; o[1] += act * tt.y; tt = __builtin_amdgcn_cvt_pk_f32_fp8((int)vr.x, true); o[2] += act * tt.x; o[3] += act * tt.y;
        tt = __builtin_amdgcn_cvt_pk_f32_fp8((int)vr.y, false); o[4] += act * tt.x; o[5] += act * tt.y; tt = __builtin_amdgcn_cvt_pk_f32_fp8((int)vr.y, true); o[6] += act * tt.x; o[7] += act * tt.y;
        tt = __builtin_amdgcn_cvt_pk_f32_fp8((int)vr.z, false); o[8] += act * tt.x; o[9] += act * tt.y; tt = __builtin_amdgcn_cvt_pk_f32_fp8((int)vr.z, true); o[10] += act * tt.x; o[11] += act * tt.y;
        tt = __builtin_amdgcn_cvt_pk_f32_fp8((int)vr.w, false); o[12] += act * tt.x; o[13] += act * tt.y; tt = __builtin_amdgcn_cvt_pk_f32_fp8((int)vr.w, true); o[14] += act * tt.x; o[15] += act * tt.y;
        PIN16(o); }
}
__device__ __forceinline__ void ph_peer_v(const Params& p, int layer, const Ctx& c, const XI xi, float* hdst, int idmask) {
    const unsigned char* VT = p.ws + WS_TAB8 + (size_t)layer * 2 * NEXP * DM + (size_t)NEXP * DM;
    const int* ids = (const int*)(p.ws + WS_IDS); const float* ACTB = (const float*)(p.ws + WS_ACTB);
    const int lane = c.lane, e8 = lane >> 3, cc = lane & 7;
    const int tstep = xi.nloc * NWAVES;
    const bool b5 = (lane & 32) != 0, b4 = (lane & 16) != 0, b3 = (lane & 8) != 0;
#pragma unroll 1
    for (int sl = xi.xr; sl < 8; sl += xi.nx) {
        const unsigned char* Vs = VT + (size_t)sl * NEXP * 128; const unsigned vo = 16u * (unsigned)cc;
        int t = xi.jr * NWAVES + c.wave;
        if (t >= M) continue;
#define PV_LD(k) ((idmask & 0x10000) ? (u32x4){(unsigned)(k), (unsigned)(k), vo, vo} : *(const u32x4*)(Vs + (((unsigned)((k) & (idmask & 0xffff)) << 7) + vo)))
#define PV_ROWS(dst, ia, ib) do { dst[0] = PV_LD((ia).x); dst[1] = PV_LD((ia).y); dst[2] = PV_LD((ia).z); dst[3] = PV_LD((ia).w); dst[4] = PV_LD((ib).x); dst[5] = PV_LD((ib).y); dst[6] = PV_LD((ib).z); dst[7] = PV_LD((ib).w); } while (0)
        u32x4 v[8], vn[8]; f32x4 av[4]; f32x2 hv; i32x4 ic2, ic3;
        { const i32x4* ip = (const i32x4*)(ids + (size_t)t * 128 + 16 * e8); const i32x4 i0 = ip[0], i1 = ip[1]; ic2 = ip[2]; ic3 = ip[3]; PV_ROWS(v, i0, i1);
          const f32x4* ap = (const f32x4*)(ACTB + (size_t)t * 128 + 16 * e8); av[0] = ap[0]; av[1] = ap[1]; av[2] = ap[2]; av[3] = ap[3];
          hv = *(const f32x2*)(p.out + (size_t)t * DM + 128 * sl + 16 * cc + 2 * e8); }
#pragma unroll 1
        for (; t < M; t += tstep) {
            const int tn = min(t + tstep, M - 1);
            const i32x4* ipn = (const i32x4*)(ids + (size_t)tn * 128 + 16 * e8); const i32x4 in0 = ipn[0], in1 = ipn[1], in2 = ipn[2], in3 = ipn[3];
            float o[16];
#pragma unroll
            for (int i = 0; i < 16; ++i) o[i] = 0.f;
            PV_ROWS(vn, ic2, ic3);
            __builtin_amdgcn_sched_barrier(0);
            if (!(idmask & 0x20000)) peer_v_half(v, av[0], av[1], o); else { _Pragma("unroll") for (int j_ = 0; j_ < 8; ++j_) asm volatile("" :: "v"(v[j_])); }
            __builtin_amdgcn_sched_barrier(0);
#pragma unroll
            for (int j = 0; j < 8; ++j) v[j] = vn[j];
            PV_ROWS(vn, in0, in1);
            __builtin_amdgcn_sched_barrier(0);
            if (!(idmask & 0x20000)) peer_v_half(v, av[2], av[3], o); else { _Pragma("unroll") for (int j_ = 0; j_ < 8; ++j_) asm volatile("" :: "v"(v[j_])); }
            __builtin_amdgcn_sched_barrier(0);
#pragma unroll
            for (int j = 0; j < 8; ++j) v[j] = vn[j];
            ic2 = in2; ic3 = in3;
#pragma unroll
            for (int i = 0; i < 8; ++i) { const float keep = b5 ? o[i + 8] : o[i], send = b5 ? o[i] : o[i + 8]; o[i] = keep + __shfl_xor(send, 32); }
#pragma unroll
            for (int i = 0; i < 4; ++i) { const float keep = b4 ? o[i + 4] : o[i], send = b4 ? o[i] : o[i + 4]; o[i] = keep + __shfl_xor(send, 16); }
#pragma unroll
            for (int i = 0; i < 2; ++i) { const float keep = b3 ? o[i + 2] : o[i], send = b3 ? o[i] : o[i + 2]; o[i] = keep + __shfl_xor(send, 8); }
            hv.x += o[0]; hv.y += o[1]; *(f32x2*)(hdst + (size_t)t * DM + 128 * sl + 16 * cc + 2 * e8) = hv;
            { const f32x4* ap = (const f32x4*)(ACTB + (size_t)tn * 128 + 16 * e8); av[0] = ap[0]; av[1] = ap[1]; av[2] = ap[2]; av[3] = ap[3];
              hv = *(const f32x2*)(p.out + (size_t)tn * DM + 128 * sl + 16 * cc + 2 * e8); }
        }
#undef PV_ROWS
#undef PV_LD
    }
}

__device__ __forceinline__ void ph_g1(const Params& p, const Ctx& c) {
    const bf16_t* proj = (const bf16_t*)(p.ws + WS_PROJ); bf16_t* xc = (bf16_t*)(p.ws + WS_XC);
    for (size_t idx = c.gtid; idx < (size_t)M * DM; idx += c.gthreads) {
        const int ch = (int)(idx & 1023); const int row = (int)(idx >> 10); const int t = row & (SEQ - 1);
        float a = p.c_conv_b[ch];
#pragma unroll
        for (int j = 0; j < 4; ++j) { const int tt = t - 3 + j; if (tt >= 0) a += p.c_conv_w[j * 1024 + ch] * bf2f(proj[(size_t)(row - 3 + j) * 2048 + 1024 + ch]); }
        xc[idx] = (bf16_t)f2bf(a);
    }
}
__device__ __forceinline__ void ph_g2(const Params& p, const Ctx& c) {
    const bf16_t* xc = (const bf16_t*)(p.ws + WS_XC); float* A = (float*)(p.ws + WS_A); float* U = (float*)(p.ws + WS_U);
    for (size_t idx = c.gtid; idx < (size_t)M * DM; idx += c.gthreads) {
        const int ch = (int)(idx & 1023); const size_t row = idx >> 10; const int g = ch >> 7, j = ch & 127;
        const bf16_t* xr = xc + row * DM + g * 128; const float* wr = p.c_w_rgate + (size_t)g * 16384 + j; const float* wi = p.c_w_igate + (size_t)g * 16384 + j;
        float ar = p.c_b_rgate[ch], ai = p.c_b_igate[ch];
        for (int i = 0; i < 128; i += 8) { const u32x4 w = *(const u32x4*)(xr + i);
            const float x0 = bflo(w.x), x1 = bfhi(w.x), x2 = bflo(w.y), x3 = bfhi(w.y), x4 = bflo(w.z), x5 = bfhi(w.z), x6 = bflo(w.w), x7 = bfhi(w.w);
            ar += x0 * wr[(i) * 128] + x1 * wr[(i + 1) * 128] + x2 * wr[(i + 2) * 128] + x3 * wr[(i + 3) * 128] + x4 * wr[(i + 4) * 128] + x5 * wr[(i + 5) * 128] + x6 * wr[(i + 6) * 128] + x7 * wr[(i + 7) * 128];
            ai += x0 * wi[(i) * 128] + x1 * wi[(i + 1) * 128] + x2 * wi[(i + 2) * 128] + x3 * wi[(i + 3) * 128] + x4 * wi[(i + 4) * 128] + x5 * wi[(i + 5) * 128] + x6 * wi[(i + 6) * 128] + x7 * wi[(i + 7) * 128]; }
        const float r = sigmoidf_(ar), ig = sigmoidf_(ai);
        const float lam = p.c_lambda[ch]; const float sp = fmaxf(-lam, 0.f) + log1pf(expf(-fabsf(lam)));
        const float la = -8.f * r * sp;
        A[idx] = expf(la); U[idx] = sqrtf(-expm1f(2.f * la)) * (ig * bf2f(xc[idx]));
    }
}
__device__ __forceinline__ void ph_g3(const Params& p, const Ctx& c) {
    const bf16_t* proj = (const bf16_t*)(p.ws + WS_PROJ); const float* A = (const float*)(p.ws + WS_A); const float* U = (const float*)(p.ws + WS_U); bf16_t* y = (bf16_t*)(p.ws + WS_ACT);
    for (int idx = c.gtid; idx < BATCH * DM; idx += c.gthreads) {
        const int b = idx >> 10, ch = idx & 1023; float h = 0.f;
        for (int t0 = 0; t0 < SEQ; t0 += 8) {
            float a[8], u[8], g[8];
#pragma unroll
            for (int j = 0; j < 8; ++j) { const size_t e = (size_t)(b * SEQ + t0 + j) * DM + ch; a[j] = A[e]; u[j] = U[e]; g[j] = bf2f(proj[(size_t)(b * SEQ + t0 + j) * 2048 + ch]); }
#pragma unroll
            for (int j = 0; j < 8; ++j) { h = a[j] * h + u[j]; y[(size_t)(b * SEQ + t0 + j) * DM + ch] = (bf16_t)f2bf(gelu_tanh(g[j]) * h); }
        }
    }
}
#define XB_TMO      128
#define XB_XCNT(j)  (256  + 64 * (j))
#define XB_XSUB(j)  (1280 + 64 * (j))
#define XB_XGEN(j)  (2304 + 64 * (j))
#define XB_TOP      3328
#define XB_TOPGEN   3392
#define XCD_BAR_WORDS 3456
#define XB_SPIN_CAP (1u << 18)

__device__ __forceinline__ unsigned xb_ld(unsigned* p)              { return __hip_atomic_load(p, __ATOMIC_RELAXED, __HIP_MEMORY_SCOPE_AGENT); }
__device__ __forceinline__ unsigned xb_add(unsigned* p, unsigned v) { return __hip_atomic_fetch_add(p, v, __ATOMIC_RELAXED, __HIP_MEMORY_SCOPE_AGENT); }
__device__ __forceinline__ unsigned xb_xcc_id() { return (unsigned)__builtin_amdgcn_s_getreg((3 << 11) | 20) & 0xFu; }
#define XB_SPIN(cond, bar) do { unsigned _sp = 0; while (cond) { __builtin_amdgcn_s_sleep(1); \
    if ((++_sp & 255u) == 0u) { if (xb_ld(&(bar)[XB_TMO])) break; if (_sp > XB_SPIN_CAP) { atomicAdd(&(bar)[XB_TMO], 1u); break; } } } } while (0)

struct XcdBarrier {
    unsigned* bar; unsigned x;
    volatile LAS unsigned* st;
};

__device__ __forceinline__ XcdBarrier xcd_barrier_post(unsigned* bar, volatile LAS unsigned* st) {
    XcdBarrier b; b.bar = bar; b.x = xb_xcc_id(); b.st = st;
    if (threadIdx.x == 0) (void)xb_add(&bar[XB_XCNT(b.x)], 1u);
    return b;
}
__device__ __forceinline__ void xcd_barrier_complete(unsigned* bar, unsigned x, unsigned& nloc, unsigned& nx) {
    const unsigned G = gridDim.x * gridDim.y * gridDim.z;
    unsigned sum, cnt, mine, sp = 0u;
    for (;;) {
        sum = 0u; cnt = 0u; mine = 0u;
#pragma unroll
        for (unsigned j = 0; j < 16; ++j) { const unsigned c = xb_ld(&bar[XB_XCNT(j)]); sum += c; cnt += (c > 0u) ? 1u : 0u; mine = (j == x) ? c : mine; }
        if (sum == G) break;
        __builtin_amdgcn_s_sleep(1);
        if ((++sp & 255u) == 0u) { if (xb_ld(&bar[XB_TMO])) break; if (sp > XB_SPIN_CAP) { atomicAdd(&bar[XB_TMO], 1u); break; } }
    }
    nloc = mine > 0u ? mine : 1u; nx = cnt > 0u ? cnt : 1u;
}

__device__ __forceinline__ void xcd_barrier(const XcdBarrier& b) {
    asm volatile("s_waitcnt vmcnt(0)" ::: "memory");
    __syncthreads();
    if (threadIdx.x == 0) {
        unsigned* bar = b.bar;
        __builtin_amdgcn_s_waitcnt(0);
        unsigned nloc = b.st[0], nx = b.st[1];
        if (nloc == 0u) { xcd_barrier_complete(bar, b.x, nloc, nx); b.st[0] = nloc; b.st[1] = nx; }
        const unsigned old = xb_add(&bar[XB_XSUB(b.x)], 1u);
        const unsigned gen = old / nloc;
        if (old + 1u == (gen + 1u) * nloc) {
            __builtin_amdgcn_fence(__ATOMIC_RELEASE, "agent");
            asm volatile("s_waitcnt vmcnt(0)" ::: "memory");
            const unsigned og = xb_add(&bar[XB_TOP], 1u);
            const unsigned tg = og / nx;
            if (og + 1u == (tg + 1u) * nx) xb_add(&bar[XB_TOPGEN], 1u);
            else XB_SPIN(xb_ld(&bar[XB_TOPGEN]) == tg, bar);
            __builtin_amdgcn_fence(__ATOMIC_ACQUIRE, "agent");
            xb_add(&bar[XB_XGEN(b.x)], 1u);
            asm volatile("s_waitcnt vmcnt(0)" ::: "memory");
        } else {
            XB_SPIN(xb_ld(&bar[XB_XGEN(b.x)]) == gen, bar);
            __builtin_amdgcn_fence(__ATOMIC_ACQUIRE, "agent");
            asm volatile("s_waitcnt vmcnt(0)" ::: "memory");
        }
    }
    __syncthreads();
}

enum Phase { PH_PRO = 0, PH_GEMM_IN0, PH_MIXER0, PH_GLA_B, PH_GLA_C, PH_MIX0, PH_GEMM_OUT0, PH_NORM_F0, PH_GEMM_Q0, PH_TOPK1_0, PH_PU0, PH_PA0, PH_PV0,
             PH_NORM_M1, PH_GEMM_CIN, PH_G1, PH_G2, PH_G3, PH_GEMM_OUT1, PH_NORM_F1, PH_GEMM_Q1, PH_TOPK1_1, PH_PU1, PH_PA1, PH_PV1, PH_FINAL, NPHASES };

#ifndef PH_ONLY
#define PH_ONLY (-1)
#endif
#define PH_ENABLED(x) (PH_ONLY < 0 || PH_ONLY == (x))
#ifndef MK_N_LAUNCHES
#define MK_N_LAUNCHES 1
#endif

template <class Epi> __device__ __forceinline__ void run_gemm(const Ctx& c, const bf16_t* A, const bf16_t* Bt, int N, const Epi& E, int vblk) {
    pg8::Gemm g{A, Bt, M, N, DM}; pg8::StaticOrder S; S.init(M, N, c.nblk, vblk);
    pg8::gemm_phase<Epi, pg8::StaticOrder, true, true>(c.lds, g, S, E);
}

#ifdef PROBE_RT
#define GATHER_CALL(l) ph_gather2(p, c)
#else
#define GATHER_CALL(l) ph_gather3(p, l, c, (rep_ + 1 < NREP(PH_GATHER##l)) ? (float*)(ws + WS_S) : p.out)
#endif
#ifndef PROBE_IDMASK
#define PROBE_IDMASK 0x3fff
#endif
#ifndef DUP_MASK
#define DUP_MASK 0u
#endif
#define NREP(k) ((((unsigned)(DUP_MASK) >> (k)) & 1u) ? 2 : 1)
#define GETXI() XI xi; { if (multi) { if (threadIdx.x == 0) { unsigned xr_ = 0; for (unsigned j_ = 0; j_ < bar.x; ++j_) xr_ += xb_ld(&ctl[CW_BAR + XB_XCNT(j_)]) > 0u ? 1u : 0u; MISC[11] = xr_; } __syncthreads(); \
    xi.nloc = (int)MISC[8]; xi.nx = (int)MISC[9]; xi.jr = (int)MISC[10]; xi.xr = (int)MISC[11]; if (xi.nloc < 1 || xi.nx < 1 || xi.nx > 8 || xi.jr >= xi.nloc || xi.xr >= xi.nx) { xi.xr = 0; xi.nx = 1; xi.jr = blockIdx.x; xi.nloc = gridDim.x; } } \
    else { xi.xr = 0; xi.nx = 1; xi.jr = blockIdx.x; xi.nloc = gridDim.x; } }
#define MKCTX() Ctx c; { int t_ = threadIdx.x; asm volatile("" : "+v"(t_)); c.lds = lds; c.tid = t_; c.lane = t_ & 63; c.wave = __builtin_amdgcn_readfirstlane(t_ >> 6); \
    c.blk = blockIdx.x; c.nblk = gridDim.x; c.gtid = c.blk * NTHREADS + c.tid; c.gthreads = c.nblk * NTHREADS; c.gwave = c.blk * NWAVES + c.wave; c.gwaves = c.nblk * NWAVES; }
__global__ void __launch_bounds__(NTHREADS, 2) mega_fwd(Params p) {
    extern __shared__ __attribute__((aligned(16))) unsigned char lds_raw[];
    volatile LAS unsigned* MISC = (volatile LAS unsigned*)((LAS unsigned char*)lds_raw + MISC_OFF);
    LAS unsigned char* const lds = (LAS unsigned char*)lds_raw;
    for (int u = threadIdx.x; u < (LDS_BYTES - LDSCTL_OFF) / 4; u += NTHREADS) ((LAS unsigned*)(lds + LDSCTL_OFF))[u] = 0u;
    __syncthreads();
    unsigned* ctl = (unsigned*)(p.ws + WS_CTL);
    XcdBarrier bar; bar.bar = ctl + CW_BAR; bar.x = 0; bar.st = nullptr;
    const bool multi = (p.ph_hi - p.ph_lo) > 1;
    if (multi) { bar = xcd_barrier_post(ctl + CW_BAR, MISC + 8); if (threadIdx.x == 0) MISC[10] = xb_add(&ctl[CW_RANK + 64 * bar.x], 1u); }
    unsigned char* ws = p.ws;
    bf16_t* ACT = (bf16_t*)(ws + WS_ACT); bf16_t* PROJ = (bf16_t*)(ws + WS_PROJ);

    const int lo = p.ph_lo, hi = p.ph_hi;
#define IN(k) (PH_ENABLED(k) && lo <= (k) && (k) < hi)
#define SEAM(k) do { if ((k) + 1 < hi) xcd_barrier(bar); } while (0)
    if (IN(PH_PRO)) { for (int rep_ = 0; rep_ < NREP(PH_PRO); ++rep_) { MKCTX();
        transpose_cvt(p.ab_w_in, DM, NIN, (bf16_t*)(ws + WS_WT_IN), NIN_PAD, [](int n) { return n < 1536 ? n : (n < 3072 ? n + 16 : (n < 3088 ? n - 3072 + 1536 : -1)); }, c.gtid, c.gthreads);
        transpose_cvt(p.ab_w_out, DM, DM, (bf16_t*)(ws + WS_WT_OUT), DM, [](int n) { return n; }, c.gtid, c.gthreads);
        transpose_cvt(p.c_w_in, DM, 2048, (bf16_t*)(ws + WS_WT_CIN), 2048, [](int n) { return n; }, c.gtid, c.gthreads);
        transpose_cvt(p.c_w_out, DM, DM, (bf16_t*)(ws + WS_WT_COUT), DM, [](int n) { return n; }, c.gtid, c.gthreads);
        transpose_cvt(p.peer_w_query, DM, 2048, (bf16_t*)(ws + WS_WT_Q0), 2048, [](int n) { return n; }, c.gtid, c.gthreads);
        transpose_cvt(p.peer_w_query + (size_t)DM * 2048, DM, 2048, (bf16_t*)(ws + WS_WT_Q1), 2048, [](int n) { return n; }, c.gtid, c.gthreads);
#ifdef PROBE_RT
        cvt_fp8_roundtrip_rows(p.peer_u, (bf16_t*)(ws + WS_TAB), NEXP, c);
        cvt_fp8_roundtrip_rows(p.peer_v, (bf16_t*)(ws + WS_TAB) + (size_t)NEXP * DM, NEXP, c);
#else
        cvt_fp8_rows(p.peer_u, ws + WS_TAB8, (float*)(ws + WS_SCL), NEXP, c);
        cvt_fp8_rows(p.peer_v, ws + WS_TAB8 + (size_t)NEXP * DM, (float*)(ws + WS_SCL) + NEXP, NEXP, c);
#endif
        cvt_gate_weights(p, c);
        cvt_bf16(p.peer_sub_keys, (bf16_t*)(ws + WS_SK), (size_t)2 * 8 * 2 * 128 * 128 / 8, c.gtid, c.gthreads);
        norm_rows_bf16(p.x, p.mix_norm, ACT, c);
        if (rep_ + 1 < NREP(PH_PRO)) xcd_barrier(bar); } SEAM(PH_PRO); }
    if (IN(PH_GEMM_IN0)) { for (int rep_ = 0; rep_ < NREP(PH_GEMM_IN0); ++rep_) { MKCTX();  pg8::EpiBf16<0> E{PROJ, NIN_PAD, nullptr, 0, 0, 1.f}; GETXI(); run_gemm(c, ACT, (const bf16_t*)(ws + WS_WT_IN), NIN_PAD, E, (xi.nx == 8 && xi.nloc * 8 == (int)gridDim.x) ? xi.jr * 8 + xi.xr : (int)blockIdx.x); if (rep_ + 1 < NREP(PH_GEMM_IN0)) xcd_barrier(bar); } SEAM(PH_GEMM_IN0); }
    if (IN(PH_MIXER0)) { for (int rep_ = 0; rep_ < NREP(PH_MIXER0); ++rep_) { MKCTX();  ph_gla_a(p, c); ph_attn(p, c); if (rep_ + 1 < NREP(PH_MIXER0)) xcd_barrier(bar); } SEAM(PH_MIXER0); }
    if (IN(PH_GLA_B)) { for (int rep_ = 0; rep_ < NREP(PH_GLA_B); ++rep_) { MKCTX();  ph_gla_b(p, c); if (rep_ + 1 < NREP(PH_GLA_B)) xcd_barrier(bar); } SEAM(PH_GLA_B); }
    if (IN(PH_GLA_C)) { for (int rep_ = 0; rep_ < NREP(PH_GLA_C); ++rep_) { MKCTX();  ph_gla_c(p, c); if (rep_ + 1 < NREP(PH_GLA_C)) xcd_barrier(bar); } SEAM(PH_GLA_C); }
    if (IN(PH_MIX0)) { for (int rep_ = 0; rep_ < NREP(PH_MIX0); ++rep_) { MKCTX();  ph_mix(p, c); if (rep_ + 1 < NREP(PH_MIX0)) xcd_barrier(bar); } SEAM(PH_MIX0); }
    if (IN(PH_GEMM_OUT0)) { for (int rep_ = 0; rep_ < NREP(PH_GEMM_OUT0); ++rep_) { MKCTX();  pg8::EpiResF32 E{p.x, p.out, DM}; GETXI(); run_gemm(c, ACT, (const bf16_t*)(ws + WS_WT_OUT), DM, E, (xi.nx == 8 && xi.nloc * 8 == (int)gridDim.x) ? xi.jr * 8 + xi.xr : (int)blockIdx.x); if (rep_ + 1 < NREP(PH_GEMM_OUT0)) xcd_barrier(bar); } SEAM(PH_GEMM_OUT0); }
    if (IN(PH_NORM_F0)) { for (int rep_ = 0; rep_ < NREP(PH_NORM_F0); ++rep_) { MKCTX();  norm_rows_bf16(p.out, p.ffn_norm, ACT, c); if (rep_ + 1 < NREP(PH_NORM_F0)) xcd_barrier(bar); } SEAM(PH_NORM_F0); }
    if (IN(PH_GEMM_Q0)) { for (int rep_ = 0; rep_ < NREP(PH_GEMM_Q0); ++rep_) { MKCTX();  pg8::EpiBf16<0> E{PROJ, 2048, nullptr, 0, 0, 1.f}; GETXI(); run_gemm(c, ACT, (const bf16_t*)(ws + WS_WT_Q0), 2048, E, (xi.nx == 8 && xi.nloc * 8 == (int)gridDim.x) ? xi.jr * 8 + xi.xr : (int)blockIdx.x); if (rep_ + 1 < NREP(PH_GEMM_Q0)) xcd_barrier(bar); } SEAM(PH_GEMM_Q0); }
    if (IN(PH_TOPK1_0)) { for (int rep_ = 0; rep_ < NREP(PH_TOPK1_0); ++rep_) { MKCTX();  ph_topk(p, 0, c); if (rep_ + 1 < NREP(PH_TOPK1_0)) xcd_barrier(bar); } SEAM(PH_TOPK1_0); }
    if (IN(PH_PU0)) { for (int rep_ = 0; rep_ < NREP(PH_PU0); ++rep_) { MKCTX();  GETXI(); ph_peer_u(p, 0, c, xi, (rep_ + 1 < NREP(PH_PU0)) ? PROBE_IDMASK : 0x3fff); if (rep_ + 1 < NREP(PH_PU0)) xcd_barrier(bar); } SEAM(PH_PU0); }
    if (IN(PH_PA0)) { for (int rep_ = 0; rep_ < NREP(PH_PA0); ++rep_) { MKCTX();  ph_peer_act(p, 0, c); if (rep_ + 1 < NREP(PH_PA0)) xcd_barrier(bar); } SEAM(PH_PA0); }
    if (IN(PH_PV0)) { for (int rep_ = 0; rep_ < NREP(PH_PV0); ++rep_) { MKCTX();  GETXI(); ph_peer_v(p, 0, c, xi, (rep_ + 1 < NREP(PH_PV0)) ? (float*)(ws + WS_S) : p.out, (rep_ + 1 < NREP(PH_PV0)) ? PROBE_IDMASK : 0x3fff); if (rep_ + 1 < NREP(PH_PV0)) xcd_barrier(bar); } SEAM(PH_PV0); }
    if (IN(PH_NORM_M1)) { for (int rep_ = 0; rep_ < NREP(PH_NORM_M1); ++rep_) { MKCTX();  norm_rows_bf16(p.out, p.mix_norm + DM, ACT, c); if (rep_ + 1 < NREP(PH_NORM_M1)) xcd_barrier(bar); } SEAM(PH_NORM_M1); }
    if (IN(PH_GEMM_CIN)) { for (int rep_ = 0; rep_ < NREP(PH_GEMM_CIN); ++rep_) { MKCTX();  pg8::EpiBf16<0> E{PROJ, 2048, nullptr, 0, 0, 1.f}; GETXI(); run_gemm(c, ACT, (const bf16_t*)(ws + WS_WT_CIN), 2048, E, (xi.nx == 8 && xi.nloc * 8 == (int)gridDim.x) ? xi.jr * 8 + xi.xr : (int)blockIdx.x); if (rep_ + 1 < NREP(PH_GEMM_CIN)) xcd_barrier(bar); } SEAM(PH_GEMM_CIN); }
    if (IN(PH_G1)) { for (int rep_ = 0; rep_ < NREP(PH_G1); ++rep_) { MKCTX();  griffin_pass<false>(p, c); if (rep_ + 1 < NREP(PH_G1)) xcd_barrier(bar); } SEAM(PH_G1); }
    if (IN(PH_G2)) { for (int rep_ = 0; rep_ < NREP(PH_G2); ++rep_) { MKCTX();  ph_carry(p, c); if (rep_ + 1 < NREP(PH_G2)) xcd_barrier(bar); } SEAM(PH_G2); }
    if (IN(PH_G3)) { for (int rep_ = 0; rep_ < NREP(PH_G3); ++rep_) { MKCTX();  griffin_pass<true>(p, c); if (rep_ + 1 < NREP(PH_G3)) xcd_barrier(bar); } SEAM(PH_G3); }
    if (IN(PH_GEMM_OUT1)) { for (int rep_ = 0; rep_ < NREP(PH_GEMM_OUT1); ++rep_) { MKCTX();  pg8::EpiResF32 E{p.out, p.out, DM}; GETXI(); run_gemm(c, ACT, (const bf16_t*)(ws + WS_WT_COUT), DM, E, (xi.nx == 8 && xi.nloc * 8 == (int)gridDim.x) ? xi.jr * 8 + xi.xr : (int)blockIdx.x); if (rep_ + 1 < NREP(PH_GEMM_OUT1)) xcd_barrier(bar); } SEAM(PH_GEMM_OUT1); }
    if (IN(PH_NORM_F1)) { for (int rep_ = 0; rep_ < NREP(PH_NORM_F1); ++rep_) { MKCTX();
        norm_rows_bf16(p.out, p.ffn_norm + DM, ACT, c);
#ifdef PROBE_RT
        cvt_fp8_roundtrip_rows(p.peer_u + (size_t)NEXP * DM, (bf16_t*)(ws + WS_TAB), NEXP, c);
        cvt_fp8_roundtrip_rows(p.peer_v + (size_t)NEXP * DM, (bf16_t*)(ws + WS_TAB) + (size_t)NEXP * DM, NEXP, c);
#else
        cvt_fp8_rows(p.peer_u + (size_t)NEXP * DM, ws + WS_TAB8 + (size_t)2 * NEXP * DM, (float*)(ws + WS_SCL) + 2 * NEXP, NEXP, c);
        cvt_fp8_rows(p.peer_v + (size_t)NEXP * DM, ws + WS_TAB8 + (size_t)3 * NEXP * DM, (float*)(ws + WS_SCL) + 3 * NEXP, NEXP, c);
#endif
        if (rep_ + 1 < NREP(PH_NORM_F1)) xcd_barrier(bar); } SEAM(PH_NORM_F1); }
    if (IN(PH_GEMM_Q1)) { for (int rep_ = 0; rep_ < NREP(PH_GEMM_Q1); ++rep_) { MKCTX();  pg8::EpiBf16<0> E{PROJ, 2048, nullptr, 0, 0, 1.f}; GETXI(); run_gemm(c, ACT, (const bf16_t*)(ws + WS_WT_Q1), 2048, E, (xi.nx == 8 && xi.nloc * 8 == (int)gridDim.x) ? xi.jr * 8 + xi.xr : (int)blockIdx.x); if (rep_ + 1 < NREP(PH_GEMM_Q1)) xcd_barrier(bar); } SEAM(PH_GEMM_Q1); }
    if (IN(PH_TOPK1_1)) { for (int rep_ = 0; rep_ < NREP(PH_TOPK1_1); ++rep_) { MKCTX();  ph_topk(p, 1, c); if (rep_ + 1 < NREP(PH_TOPK1_1)) xcd_barrier(bar); } SEAM(PH_TOPK1_1); }
    if (IN(PH_PU1)) { for (int rep_ = 0; rep_ < NREP(PH_PU1); ++rep_) { MKCTX();  GETXI(); ph_peer_u(p, 1, c, xi, (rep_ + 1 < NREP(PH_PU1)) ? PROBE_IDMASK : 0x3fff); if (rep_ + 1 < NREP(PH_PU1)) xcd_barrier(bar); } SEAM(PH_PU1); }
    if (IN(PH_PA1)) { for (int rep_ = 0; rep_ < NREP(PH_PA1); ++rep_) { MKCTX();  ph_peer_act(p, 1, c); if (rep_ + 1 < NREP(PH_PA1)) xcd_barrier(bar); } SEAM(PH_PA1); }
    if (IN(PH_PV1)) { for (int rep_ = 0; rep_ < NREP(PH_PV1); ++rep_) { MKCTX();  GETXI(); ph_peer_v(p, 1, c, xi, (rep_ + 1 < NREP(PH_PV1)) ? (float*)(ws + WS_S) : p.out, (rep_ + 1 < NREP(PH_PV1)) ? PROBE_IDMASK : 0x3fff); if (rep_ + 1 < NREP(PH_PV1)) xcd_barrier(bar); } SEAM(PH_PV1); }
    if (IN(PH_FINAL)) { MKCTX(); norm_rows_f32(p.out, p.final_norm, c); }
#undef IN
#undef SEAM
}

extern "C" void kernel_launch(void* const* d_in, const int* in_sizes, int n_in, void* d_out, int out_size, void* d_ws, size_t ws_size, hipStream_t stream) {
    static int grid = 0;
    if (grid == 0) {
        if (n_in != 22 || out_size != M * DM || ws_size < WS_END) { fprintf(stderr, "kernel_launch: unexpected shapes: n_in %d out %d ws %zu (need %zu)\n", n_in, out_size, ws_size, (size_t)WS_END); grid = -1; return; }
        int dev = 0, cus = 0, per_cu = 0;
        if (hipGetDevice(&dev) != hipSuccess || hipDeviceGetAttribute(&cus, hipDeviceAttributeMultiprocessorCount, dev) != hipSuccess) { grid = -1; return; }
        if (hipFuncSetAttribute((const void*)mega_fwd, hipFuncAttributeMaxDynamicSharedMemorySize, LDS_BYTES) != hipSuccess) { fprintf(stderr, "kernel_launch: hipFuncSetAttribute failed\n"); grid = -1; return; }
        if (hipOccupancyMaxActiveBlocksPerMultiprocessor(&per_cu, (const void*)mega_fwd, NTHREADS, LDS_BYTES) != hipSuccess || per_cu < 1) { fprintf(stderr, "kernel_launch: occupancy query says %d blocks per CU\n", per_cu); per_cu = 1; }
        (void)hipGetLastError();
        grid = cus;
        if (grid % 8 != 0 || grid < 32) { fprintf(stderr, "kernel_launch: unexpected CU count %d\n", cus); }
    }
    if (grid < 0) return;
    (void)hipMemsetAsync((char*)d_ws + WS_CTL, 0, CTL_ZERO_BYTES, stream);
    Params p{};
    const float** pp = (const float**)&p;
    for (int i = 0; i < 22; ++i) pp[i] = (const float*)d_in[i];
    p.out = (float*)d_out; p.ws = (unsigned char*)d_ws;
#if MK_N_LAUNCHES == 1
    p.ph_lo = 0; p.ph_hi = NPHASES;
    void* args[] = {&p};
    hipError_t e = hipLaunchCooperativeKernel((const void*)mega_fwd, dim3(grid), dim3(NTHREADS), args, LDS_BYTES, stream);
    if (e != hipSuccess) fprintf(stderr, "cooperative launch failed: %s (grid %d)\n", hipGetErrorString(e), grid);
#else
    for (int ph = 0; ph < NPHASES; ++ph) { p.ph_lo = ph; p.ph_hi = ph + 1; hipLaunchKernelGGL(mega_fwd, dim3(grid), dim3(NTHREADS), LDS_BYTES, stream, p); }
#endif
}
```

```cpp
#include <hip/hip_runtime.h>
#include <hip/hip_bf16.h>
#include <cstdio>
#include <cstdint>
#include <cmath>
namespace pg8 {
#define PG8_LAS __attribute__((address_space(3)))
typedef unsigned short bf16_t;
typedef short bf16x8 __attribute__((ext_vector_type(8)));
typedef float f32x4 __attribute__((ext_vector_type(4)));
typedef unsigned u32x4 __attribute__((ext_vector_type(4)));
constexpr int BM = 256, BK = 64, HALF = 128, HTB = HALF * BK * 2  , STAGE_BYTES = 8 * HTB, NXCD = 8, WGM = 8;

__host__ __device__ __forceinline__ int lds_byte(int r, int c) { const int st = (r >> 4) * 2 + (c >> 5), rr = r & 15, cc = c & 31, ob = rr * 64 + cc * 2; return st * 1024 + (ob ^ (((ob >> 9) & 1) << 5)); }
__host__ __device__ __forceinline__ void stage_rc(int b, int& R, int& C) { const int st = b / 1024, sb = b % 1024, swz = sb ^ (((sb >> 9) & 1) << 5); R = (st >> 1) * 16 + swz / 64; C = (st & 1) * 32 + (swz % 64) / 2; }
__host__ __device__ __forceinline__ int perm32(int rho) { const int n = rho >> 4, i = rho & 15; return 8 * (i >> 2) + 4 * n + (i & 3); }

struct Unit { int pm, pn; };
struct Gemm { const bf16_t* A; const bf16_t* Bt; int M, N, K; };

struct StaticOrder {
    int nM, nN, nwg, G, c;
    __host__ __device__ void init(int M, int N, int G_, int c_) { nM = M / BM; nN = N / BM; nwg = nM * nN; G = G_; c = c_; }
    __host__ __device__ bool next(int i, Unit& u) const {
        const long L = (long)i * G + c; if (L >= nwg) return false;
        int wgid = (int)L; { const int q = nwg / NXCD, r = nwg % NXCD, xcd = wgid % NXCD, off = wgid / NXCD; wgid = (xcd < r ? xcd * (q + 1) : r * (q + 1) + (xcd - r) * q) + off; }
        const int nig = WGM * nN, gid = wgid / nig, fm = gid * WGM, gsz = (nM - fm) < WGM ? (nM - fm) : WGM;
        u.pm = fm + ((wgid % nig) % gsz); u.pn = (wgid % nig) / gsz; return true;
    }
    __device__ __forceinline__ void a_ready(const Unit&) const {}
    __device__ __forceinline__ void done(const Unit&) const {}
};

__device__ __forceinline__ unsigned cvt_pk_bf16(float lo, float hi) { unsigned r; asm volatile("v_cvt_pk_bf16_f32 %0, %1, %2" : "=v"(r) : "v"(lo), "v"(hi)); return r; }
typedef float f32x2 __attribute__((ext_vector_type(2)));
__device__ __forceinline__ f32x2 gelu_pk(f32x2 v) {
    const f32x2 av = __builtin_elementwise_abs(v), d = av * 0.2316418882f + 1.0f;
    f32x2 t; t.x = __builtin_amdgcn_rcpf(d.x); t.y = __builtin_amdgcn_rcpf(d.y);
    f32x2 q = t * 0.5307027145f + (-0.7265760135f); q = q * t + 0.7107068705f; q = q * t + (-0.142248368f); q = q * t + 0.127414796f; q = q * t;
    const f32x2 s = (v * v) * (-0.72134752044f);
    f32x2 e; e.x = __builtin_amdgcn_exp2f(s.x); e.y = __builtin_amdgcn_exp2f(s.y);
    const f32x2 m = v * (q * e), r = v - m;
    f32x2 o; o.x = v.x < 0.f ? m.x : r.x; o.y = v.y < 0.f ? m.y : r.y; return o;
}
template <int ACT  > struct EpiBf16 {
    static constexpr bool PERM = true, AFTER_DRAIN = false; static_assert(ACT == 0 || ACT == 1, "EpiBf16: ACT is 0 (none) or 1 (gelu_pk)");
    bf16_t* O; int ldc; const float* bias; int split_cols; size_t split_stride; float scale0;
    __device__ __forceinline__ void operator()(const f32x4 (&acc)[2][2][4][2], const Unit& u, int wr, int wc, int fr, int fq) const {
        const int row0 = u.pm * BM + wr * 64 + fr; int colt = u.pn * BM; bf16_t* base = O;
        float sc = 1.f; if (split_cols) { const int t = colt / split_cols; base += (size_t)t * split_stride; colt -= t * split_cols; if (t == 0) sc = scale0; }
        const int col0 = colt + wc * 32 + 8 * fq, bcol0 = u.pn * BM + wc * 32 + 8 * fq;
        f32x4 bv[2][2];
#pragma unroll
        for (int bj = 0; bj < 2; ++bj)
#pragma unroll
            for (int n = 0; n < 2; ++n) bv[bj][n] = bias ? *(const f32x4*)(bias + bcol0 + bj * HALF + 4 * n) : (f32x4){0.f, 0.f, 0.f, 0.f};
#pragma unroll
        for (int ai = 0; ai < 2; ++ai)
#pragma unroll
            for (int m = 0; m < 4; ++m) { bf16_t* rowp = base + (size_t)(row0 + ai * HALF + m * 16) * ldc + col0;
#pragma unroll
                for (int bj = 0; bj < 2; ++bj) { f32x4 v0 = acc[ai][bj][m][0] + bv[bj][0], v1 = acc[ai][bj][m][1] + bv[bj][1];
                    if (ACT == 1) { f32x2 a = gelu_pk((f32x2){v0[0], v0[1]}), b = gelu_pk((f32x2){v0[2], v0[3]}), c = gelu_pk((f32x2){v1[0], v1[1]}), d = gelu_pk((f32x2){v1[2], v1[3]});
                        v0 = (f32x4){a.x, a.y, b.x, b.y}; v1 = (f32x4){c.x, c.y, d.x, d.y}; }
                    v0 = v0 * sc; v1 = v1 * sc; u32x4 w; w.x = cvt_pk_bf16(v0[0], v0[1]); w.y = cvt_pk_bf16(v0[2], v0[3]); w.z = cvt_pk_bf16(v1[0], v1[1]); w.w = cvt_pk_bf16(v1[2], v1[3]);
                    *(u32x4*)(rowp + bj * HALF) = w; } }
    }
};
template <class Epi, class Sched, bool ALIGN_EPI = false, bool SP2 = false>
__device__ __forceinline__ void gemm_phase(PG8_LAS unsigned char* lds, const Gemm g, const Sched& S, const Epi& E) {
    const int tid = threadIdx.x, wid = __builtin_amdgcn_readfirstlane(tid >> 6), lane = tid & 63, wr = wid >> 2, wc = wid & 3, fr = lane & 15, fq = lane >> 4;
    const int K = g.K, nt = K / BK;
    unsigned voffA[2], voffB[2];
#pragma unroll
    for (int i = 0; i < 2; ++i) { int R, C; stage_rc(tid * 16 + i * 8192, R, C); const int Rb = Epi::PERM ? ((R & ~31) + perm32(R & 31)) : R;
        voffA[i] = (unsigned)(R * K + C) * 2u; voffB[i] = (unsigned)(Rb * K + C) * 2u; }
    const size_t kstep = (size_t)(BK * 2);
    const size_t hstep = (size_t)HALF * K * 2;
    const size_t tstep = 2 * hstep;
    const unsigned ldsw = (unsigned)wid * 1024u;
    const int aoff = lds_byte(wr * 64 + fr, fq * 8), boff = lds_byte(wc * 32 + fr, fq * 8);
#define PG8_SA(b, h) (((b) * 2 + (h)) * HTB)
#define PG8_SB(b, h) ((4 + (b) * 2 + (h)) * HTB)
#define PG8_STAGE(bufoff, gbase, voff) do { _Pragma("unroll") for (int _i = 0; _i < 2; ++_i) \
        __builtin_amdgcn_global_load_lds((const unsigned*)((const char*)(gbase) + (voff)[_i]), (PG8_LAS unsigned*)(lds + (bufoff) + ldsw + _i * 8192), 16, 0, 0); } while (0)
#define PG8_LDA(dst, b, h) do { _Pragma("unroll") for (int m = 0; m < 4; ++m) _Pragma("unroll") for (int k = 0; k < 2; ++k) dst[m][k] = *(const PG8_LAS bf16x8*)(lds + PG8_SA(b, h) + aoff + m * 2048 + k * 1024); } while (0)
#define PG8_LDB(dst, b, h) do { _Pragma("unroll") for (int n = 0; n < 2; ++n) _Pragma("unroll") for (int k = 0; k < 2; ++k) dst[n][k] = *(const PG8_LAS bf16x8*)(lds + PG8_SB(b, h) + boff + n * 2048 + k * 1024); } while (0)
#define PG8_MMA(ai, bj, At, Bt) do { __builtin_amdgcn_s_setprio(1); _Pragma("unroll") for (int m = 0; m < 4; ++m) _Pragma("unroll") for (int n = 0; n < 2; ++n) _Pragma("unroll") for (int k = 0; k < 2; ++k) \
        acc[ai][bj][m][n] = __builtin_amdgcn_mfma_f32_16x16x32_bf16(Bt[n][k], At[m][k], acc[ai][bj][m][n], 0, 0, 0); __builtin_amdgcn_s_setprio(0); } while (0)
#define PG8_WAIT_V(n) asm volatile("s_waitcnt vmcnt(" #n ")" ::: "memory")
#define PG8_WAIT_L(n) asm volatile("s_waitcnt lgkmcnt(" #n ")" ::: "memory")
#define PG8_BAR __builtin_amdgcn_s_barrier()
#define PG8_SCHED __builtin_amdgcn_sched_barrier(0)
    Unit cur, nxt; int ui = 0;
    if (!S.next(0, cur)) return;
    f32x4 acc[2][2][4][2];
#pragma unroll
    for (int a = 0; a < 2; ++a)
#pragma unroll
        for (int b = 0; b < 2; ++b)
#pragma unroll
            for (int m = 0; m < 4; ++m)
#pragma unroll
                for (int n = 0; n < 2; ++n) acc[a][b][m][n] = (f32x4){0.f, 0.f, 0.f, 0.f};
    bf16x8 At[4][2], B0[2][2], B1[2][2];
    const char* cA = (const char*)g.A + (size_t)cur.pm * tstep; const char* cB = (const char*)g.Bt + (size_t)cur.pn * tstep;
    S.a_ready(cur);
    if constexpr (SP2) {
        PG8_STAGE(PG8_SB(0, 0), cB, voffB); PG8_STAGE(PG8_SB(0, 1), cB + hstep, voffB); PG8_STAGE(PG8_SA(0, 0), cA, voffA); PG8_STAGE(PG8_SA(0, 1), cA + hstep, voffA);
        if (wr == 1) PG8_BAR;
        PG8_WAIT_V(2); PG8_BAR;
        PG8_STAGE(PG8_SB(1, 0), cB + kstep, voffB); PG8_STAGE(PG8_SA(1, 0), cA + kstep, voffA); PG8_STAGE(PG8_SB(1, 1), cB + hstep + kstep, voffB);
        PG8_WAIT_V(6); PG8_BAR;
    } else {
        PG8_STAGE(PG8_SB(0, 0), cB, voffB); PG8_STAGE(PG8_SA(0, 0), cA, voffA); PG8_STAGE(PG8_SB(0, 1), cB + hstep, voffB); PG8_STAGE(PG8_SA(0, 1), cA + hstep, voffA);
        if (wr == 1) PG8_BAR;
        PG8_WAIT_V(4); PG8_BAR;
        PG8_STAGE(PG8_SB(1, 0), cB + kstep, voffB); PG8_STAGE(PG8_SA(1, 0), cA + kstep, voffA); PG8_STAGE(PG8_SB(1, 1), cB + hstep + kstep, voffB);
        PG8_WAIT_V(6); PG8_BAR;
    }
    for (;;) {
        const bool has_next = S.next(ui + 1, nxt);
        const char* nA = has_next ? (const char*)g.A + (size_t)nxt.pm * tstep : cA; const char* nB = has_next ? (const char*)g.Bt + (size_t)nxt.pn * tstep : cB;
        for (int t = 0; t < nt; t += 2) {
            const bool last = (t == nt - 2);
            const char* a1 = cA + (size_t)(t + 1) * kstep;
            const char* a2 = last ? nA : cA + (size_t)(t + 2) * kstep; const char* b2 = last ? nB : cB + (size_t)(t + 2) * kstep;
            const char* a3 = a2 + kstep; const char* b3 = b2 + kstep;
            if (last && has_next) S.a_ready(nxt);
            if constexpr (SP2) {
            PG8_LDB(B0, 0, 0); PG8_LDB(B1, 0, 1); PG8_SCHED; PG8_LDA(At, 0, 0); PG8_STAGE(PG8_SA(1, 1), a1 + hstep, voffA);
            PG8_WAIT_V(8); PG8_WAIT_L(0); PG8_BAR; PG8_MMA(0, 0, At, B0); PG8_MMA(0, 1, At, B1); PG8_BAR; PG8_SCHED;
            PG8_LDA(At, 0, 1); PG8_STAGE(PG8_SB(0, 0), b2, voffB); PG8_STAGE(PG8_SB(0, 1), b2 + hstep, voffB); PG8_STAGE(PG8_SA(0, 0), a2, voffA);
            PG8_WAIT_V(8); PG8_WAIT_L(0); PG8_BAR; PG8_MMA(1, 0, At, B0); PG8_MMA(1, 1, At, B1); PG8_BAR; PG8_SCHED;
            PG8_LDB(B0, 1, 0); PG8_LDB(B1, 1, 1); PG8_SCHED; PG8_LDA(At, 1, 0); PG8_STAGE(PG8_SA(0, 1), a2 + hstep, voffA);
            PG8_WAIT_V(8); PG8_WAIT_L(0); PG8_BAR; PG8_MMA(0, 0, At, B0); PG8_MMA(0, 1, At, B1); PG8_BAR; PG8_SCHED;
            PG8_LDA(At, 1, 1); PG8_STAGE(PG8_SB(1, 0), b3, voffB); PG8_STAGE(PG8_SB(1, 1), b3 + hstep, voffB); PG8_STAGE(PG8_SA(1, 0), a3, voffA);
            PG8_WAIT_V(8); PG8_WAIT_L(0); PG8_BAR; PG8_MMA(1, 0, At, B0); PG8_MMA(1, 1, At, B1); PG8_BAR; PG8_SCHED;
            } else {
            PG8_LDB(B0, 0, 0); PG8_SCHED; PG8_LDA(At, 0, 0); PG8_STAGE(PG8_SA(1, 1), a1 + hstep, voffA);
            PG8_WAIT_L(8); PG8_BAR; PG8_WAIT_L(0); PG8_MMA(0, 0, At, B0); PG8_BAR; PG8_SCHED;
            PG8_LDB(B1, 0, 1); PG8_STAGE(PG8_SB(0, 0), b2, voffB);
            PG8_BAR; PG8_WAIT_L(0); PG8_MMA(0, 1, At, B1); PG8_BAR;
            PG8_LDA(At, 0, 1); PG8_STAGE(PG8_SA(0, 0), a2, voffA);
            PG8_BAR; PG8_WAIT_L(0); PG8_MMA(1, 0, At, B0); PG8_BAR; PG8_SCHED;
            PG8_STAGE(PG8_SB(0, 1), b2 + hstep, voffB);
            PG8_WAIT_V(6); PG8_BAR; PG8_MMA(1, 1, At, B1); PG8_BAR;
            PG8_LDB(B0, 1, 0); PG8_SCHED; PG8_LDA(At, 1, 0); PG8_STAGE(PG8_SA(0, 1), a2 + hstep, voffA);
            PG8_WAIT_L(8); PG8_BAR; PG8_WAIT_L(0); PG8_MMA(0, 0, At, B0); PG8_BAR; PG8_SCHED;
            PG8_LDB(B1, 1, 1); PG8_STAGE(PG8_SB(1, 0), b3, voffB);
            PG8_BAR; PG8_WAIT_L(0); PG8_MMA(0, 1, At, B1); PG8_BAR;
            PG8_LDA(At, 1, 1); PG8_STAGE(PG8_SA(1, 0), a3, voffA);
            PG8_BAR; PG8_WAIT_L(0); PG8_MMA(1, 0, At, B0); PG8_BAR; PG8_SCHED;
            PG8_STAGE(PG8_SB(1, 1), b3 + hstep, voffB);
            PG8_WAIT_V(6); PG8_BAR; PG8_MMA(1, 1, At, B1); PG8_BAR;
            }
        }
        if constexpr (ALIGN_EPI) { if (wr == 0) PG8_BAR; }
        if constexpr (!Epi::AFTER_DRAIN) { E(acc, cur, wr, wc, fr, fq); S.done(cur); }
        if (!has_next) break;
#pragma unroll
        for (int a = 0; a < 2; ++a)
#pragma unroll
            for (int b = 0; b < 2; ++b)
#pragma unroll
                for (int m = 0; m < 4; ++m)
#pragma unroll
                    for (int n = 0; n < 2; ++n) acc[a][b][m][n] = (f32x4){0.f, 0.f, 0.f, 0.f};
        cur = nxt; cA = nA; cB = nB; ++ui;
        if constexpr (ALIGN_EPI) { if (wr == 1) PG8_BAR; }
    }
    PG8_WAIT_V(0);
    if constexpr (!ALIGN_EPI) { if (wr == 0) PG8_BAR; }
    PG8_BAR;
    if constexpr (Epi::AFTER_DRAIN) { E.fused(acc, cur, wr, wc, fr, fq, lds, wid, lane); S.done(cur); }
#undef PG8_SA
#undef PG8_SB
#undef PG8_STAGE
#undef PG8_LDA
#undef PG8_LDB
#undef PG8_MMA
#undef PG8_WAIT_V
#undef PG8_WAIT_L
#undef PG8_BAR
#undef PG8_SCHED
}

struct EpiResF32 {
    static constexpr bool PERM = false, AFTER_DRAIN = false;
    const float* base; float* out; int ldc;
    __device__ __forceinline__ void operator()(const f32x4 (&acc)[2][2][4][2], const Unit& u, int wr, int wc, int fr, int fq) const {
        const int col0 = u.pn * BM + wc * 32 + 4 * fq;
#pragma unroll
        for (int ai = 0; ai < 2; ++ai)
#pragma unroll
            for (int m = 0; m < 4; ++m) { const int r = ai * HALF + wr * 64 + m * 16 + fr; const size_t off = (size_t)(u.pm * BM + r) * ldc + col0;
#pragma unroll
                for (int bj = 0; bj < 2; ++bj)
#pragma unroll
                    for (int n = 0; n < 2; ++n) { const f32x4 bs = *(const f32x4*)(base + off + bj * HALF + n * 16); *(f32x4*)(out + off + bj * HALF + n * 16) = bs + acc[ai][bj][m][n]; } }
    }
};
}

constexpr int BATCH = 4, SEQ = 8192, DM = 1024, M = BATCH * SEQ;
constexpr int NIN = 3088, NIN_PAD = 3328;
constexpr int C_GQ = 0, C_GK = 256, C_GV = 512, C_GG = 1024, C_AQ = 1536, C_AK = 2048, C_AV = 2560, C_GLR = 3072;
constexpr int NEXP = 16384;
constexpr float NORM_EPS = 1e-6f;
constexpr int NWAVES = 8, NTHREADS = 512;

constexpr size_t MiB = 1u << 20;
constexpr size_t WS_CTL = 0, CTL_ZERO_BYTES = 1 * MiB;
constexpr size_t WS_WT_IN = 1 * MiB;
constexpr size_t WS_WT_OUT = 8 * MiB;
constexpr size_t WS_WT_CIN = 10 * MiB;
constexpr size_t WS_WT_COUT = 14 * MiB;
constexpr size_t WS_WT_Q0 = 16 * MiB;
constexpr size_t WS_WT_Q1 = 20 * MiB;
constexpr size_t WS_ACT = 32 * MiB;
constexpr size_t WS_S = 96 * MiB;
constexpr size_t WS_PROJ = WS_S;
constexpr size_t WS_GLAO = WS_S + 208 * MiB;
constexpr size_t WS_TOPS = WS_S + 128 * MiB;
constexpr size_t WS_TOPI = WS_S + 160 * MiB;
constexpr size_t WS_IDS = WS_S + 192 * MiB;
constexpr size_t WS_G = WS_S + 208 * MiB;
constexpr size_t WS_XC = WS_ACT;
constexpr size_t WS_A = WS_S + 128 * MiB;
constexpr size_t WS_U = WS_S + 256 * MiB;
constexpr size_t WS_TAB = 448 * MiB;
constexpr size_t WS_TAB8 = 448 * MiB;
constexpr size_t WS_WG = 24 * MiB;
constexpr size_t WS_AGG = WS_S + 128 * MiB;
constexpr size_t WS_SCL = 26 * MiB;
constexpr size_t WS_END = 512 * MiB;
constexpr int CW_BAR = 4096, CW_RANK = 8192;

constexpr int RING_BYTES = 131072;
constexpr int LDS_BYTES = 147456;
constexpr int LDSCTL_OFF = LDS_BYTES - 512, MISC_OFF = LDSCTL_OFF + 320;

#define LAS __attribute__((address_space(3)))
#define GAS __attribute__((address_space(1)))
typedef unsigned short bf16_t;
typedef float f32x4 __attribute__((ext_vector_type(4)));
typedef unsigned u32x4 __attribute__((ext_vector_type(4)));
typedef unsigned u32x2 __attribute__((ext_vector_type(2)));
typedef short bf16x8 __attribute__((ext_vector_type(8)));

struct Params {
    const float *x, *mix_norm, *ffn_norm, *ab_w_in, *gla_w_alpha, *gla_b_alpha, *gla_head_gain, *ab_w_out;
    const float *c_w_in, *c_conv_w, *c_conv_b, *c_w_rgate, *c_b_rgate, *c_w_igate, *c_b_igate, *c_lambda, *c_w_out;
    const float *peer_w_query, *peer_sub_keys, *peer_u, *peer_v, *final_norm;
    float* out; unsigned char* ws;
    int ph_lo, ph_hi;
};

__device__ __forceinline__ unsigned f2bf(float f) { unsigned u = __builtin_bit_cast(unsigned, f); return (u + 0x7fffu + ((u >> 16) & 1u)) >> 16; }
__device__ __forceinline__ unsigned pk2(float lo, float hi) { return f2bf(lo) | (f2bf(hi) << 16); }
__device__ __forceinline__ float bf2f(bf16_t b) { return __builtin_bit_cast(float, (unsigned)b << 16); }
__device__ __forceinline__ float bflo(unsigned w) { return __builtin_bit_cast(float, w << 16); }
__device__ __forceinline__ float bfhi(unsigned w) { return __builtin_bit_cast(float, w & 0xffff0000u); }
__device__ __forceinline__ float wave_sum(float v) {
#pragma unroll
    for (int o = 1; o < 64; o <<= 1) v += __shfl_xor(v, o);
    return v;
}
__device__ __forceinline__ float gelu_tanh(float x) {
    const float u = 0.7978845608028654f * (x + 0.044715f * x * x * x);
    const float e = __expf(2.f * u);
    const float th = 1.f - 2.f / (e + 1.f);
    return 0.5f * x * (1.f + th);
}
__device__ __forceinline__ float sigmoidf_(float x) { return 1.f / (1.f + __expf(-x)); }

struct Ctx { int tid, lane, wave, blk, nblk, gtid, gthreads, gwave, gwaves; LAS unsigned char* lds; };

template <class F> __device__ __forceinline__ void transpose_cvt(const float* W, int K, int Nsrc, bf16_t* WT, int Ndst, F srcmap, int gtid, int gthreads) {
    const int total = (K / 8) * Ndst;
    for (int idx = gtid; idx < total; idx += gthreads) {
        const int ko = idx / Ndst, n = idx - ko * Ndst; const int sn = srcmap(n);
        u32x4 w = {0u, 0u, 0u, 0u};
        if (sn >= 0) { const float* s = W + (size_t)(ko * 8) * Nsrc + sn;
            w.x = pk2(s[0], s[(size_t)Nsrc]); w.y = pk2(s[2 * (size_t)Nsrc], s[3 * (size_t)Nsrc]); w.z = pk2(s[4 * (size_t)Nsrc], s[5 * (size_t)Nsrc]); w.w = pk2(s[6 * (size_t)Nsrc], s[7 * (size_t)Nsrc]); }
        *(u32x4*)(WT + (size_t)n * K + ko * 8) = w;
    }
}
__device__ __forceinline__ void cvt_bf16(const float* src, bf16_t* dst, size_t n8, int gtid, int gthreads) {
    for (size_t i = gtid; i < n8; i += gthreads) { const f32x4 a = *(const f32x4*)(src + i * 8), b = *(const f32x4*)(src + i * 8 + 4);
        u32x4 w; w.x = pk2(a.x, a.y); w.y = pk2(a.z, a.w); w.z = pk2(b.x, b.y); w.w = pk2(b.z, b.w); *(u32x4*)(dst + i * 8) = w; }
}
__device__ __forceinline__ void norm_rows_bf16(const float* src, const float* gain, bf16_t* dst, const Ctx& c) {
    for (int m = c.gwave; m < M; m += c.gwaves) {
        const f32x4* xr = (const f32x4*)(src + (size_t)m * DM) + c.lane; f32x4 v[4]; float s = 0.f;
#pragma unroll
        for (int j = 0; j < 4; ++j) { v[j] = xr[64 * j]; s += (v[j].x * v[j].x + v[j].y * v[j].y) + (v[j].z * v[j].z + v[j].w * v[j].w); }
        const float rstd = 1.f / sqrtf(wave_sum(s) * (1.f / DM) + NORM_EPS);
        u32x2* o8 = (u32x2*)(dst + (size_t)m * DM) + c.lane;
#pragma unroll
        for (int j = 0; j < 4; ++j) { const f32x4 g = *((const f32x4*)gain + 64 * j + c.lane); u32x2 w; w.x = pk2(v[j].x * rstd * g.x, v[j].y * rstd * g.y); w.y = pk2(v[j].z * rstd * g.z, v[j].w * rstd * g.w); o8[64 * j] = w; }
    }
}
__device__ __forceinline__ void norm_rows_f32(float* buf, const float* gain, const Ctx& c) {
    for (int m = c.gwave; m < M; m += c.gwaves) {
        f32x4* xr = (f32x4*)(buf + (size_t)m * DM) + c.lane; f32x4 v[4]; float s = 0.f;
#pragma unroll
        for (int j = 0; j < 4; ++j) { v[j] = xr[64 * j]; s += (v[j].x * v[j].x + v[j].y * v[j].y) + (v[j].z * v[j].z + v[j].w * v[j].w); }
        const float rstd = 1.f / sqrtf(wave_sum(s) * (1.f / DM) + NORM_EPS);
#pragma unroll
        for (int j = 0; j < 4; ++j) { const f32x4 g = *((const f32x4*)gain + 64 * j + c.lane); xr[64 * j] = v[j] * rstd * g; }
    }
}

__device__ __forceinline__ void ph_gla_naive(const Params& p, const Ctx& c) {
    const int b = c.blk >> 2, h = c.blk & 3;
    LAS float* sq = (LAS float*)c.lds; LAS float* sk = sq + 4096; LAS float* sa = sk + 4096; LAS float* sv = sa + 4096;
    const bf16_t* proj = (const bf16_t*)(p.ws + WS_PROJ);
    float* go = (float*)(p.ws + WS_GLAO);
    const int tid = c.tid, v = tid >> 2, kq = tid & 3;
    float S[16];
#pragma unroll
    for (int i = 0; i < 16; ++i) S[i] = 0.f;
    for (int t0 = 0; t0 < SEQ; t0 += 64) {
        __syncthreads();
        for (int e = tid; e < 4096; e += NTHREADS) { const int tt = e >> 6, kk = e & 63; const bf16_t* pr = proj + (size_t)(b * SEQ + t0 + tt) * NIN_PAD;
            sq[e] = bf2f(pr[C_GQ + h * 64 + kk]); sk[e] = bf2f(pr[C_GK + h * 64 + kk]);
            float z = p.gla_b_alpha[h * 64 + kk];
#pragma unroll
            for (int r = 0; r < 16; ++r) z += bf2f(pr[C_GLR + r]) * p.gla_w_alpha[r * 256 + h * 64 + kk];
            const float ls = fminf(z, 0.f) - log1pf(expf(-fabsf(z)));
            sa[e] = expf(ls * (1.f / 16.f)); }
        for (int e = tid; e < 8192; e += NTHREADS) { const int tt = e >> 7, vv = e & 127; sv[e] = bf2f(proj[(size_t)(b * SEQ + t0 + tt) * NIN_PAD + C_GV + h * 128 + vv]); }
        __syncthreads();
        for (int tt = 0; tt < 64; ++tt) {
            const float vv = sv[tt * 128 + v]; float part = 0.f;
#pragma unroll
            for (int i = 0; i < 16; ++i) { const int kk = kq * 16 + i; S[i] = sa[tt * 64 + kk] * S[i] + sk[tt * 64 + kk] * vv; part += sq[tt * 64 + kk] * S[i]; }
            part += __shfl_xor(part, 1); part += __shfl_xor(part, 2);
            if (kq == 0) go[(size_t)(b * SEQ + t0 + tt) * 512 + h * 128 + v] = part * 0.125f;
        }
    }
}
__device__ __forceinline__ void ph_attn_naive(const Params& p, int gtid, int gthreads) {
    const bf16_t* proj = (const bf16_t*)(p.ws + WS_PROJ); bf16_t* mixed = (bf16_t*)(p.ws + WS_ACT);
    for (int idx = gtid; idx < M * 8; idx += gthreads) {
        const int t = idx & 8191, h = (idx >> 13) & 7, b = idx >> 16;
        const size_t row = (size_t)b * SEQ + t;
        float q[64], o[64];
        { const u32x4* qp = (const u32x4*)(proj + row * NIN_PAD + C_AQ + h * 64);
#pragma unroll
          for (int i = 0; i < 8; ++i) { const u32x4 w = qp[i]; q[8*i] = bflo(w.x); q[8*i+1] = bfhi(w.x); q[8*i+2] = bflo(w.y); q[8*i+3] = bfhi(w.y); q[8*i+4] = bflo(w.z); q[8*i+5] = bfhi(w.z); q[8*i+6] = bflo(w.w); q[8*i+7] = bfhi(w.w); } }
#pragma unroll
        for (int d = 0; d < 64; ++d) o[d] = 0.f;
        float mx = -1e30f, l = 0.f;
        const float slope = exp2f(-(float)(h + 1));
        for (int br = 0; br < 3; ++br) { const int dil = 1 << (2 * br);
            for (int j = 0; j <= 128; ++j) { const int tk = t - j * dil; if (tk < 0) break;
                const u32x4* kp = (const u32x4*)(proj + ((size_t)b * SEQ + tk) * NIN_PAD + C_AK + h * 64); const u32x4* vp = kp + 64;
                float s = 0.f;
#pragma unroll
                for (int i = 0; i < 8; ++i) { const u32x4 w = kp[i]; s += q[8*i] * bflo(w.x) + q[8*i+1] * bfhi(w.x) + q[8*i+2] * bflo(w.y) + q[8*i+3] * bfhi(w.y) + q[8*i+4] * bflo(w.z) + q[8*i+5] * bfhi(w.z) + q[8*i+6] * bflo(w.w) + q[8*i+7] * bfhi(w.w); }
                s = s * 0.125f - slope * (float)(j * dil);
                const float mn = fmaxf(mx, s), corr = __expf(mx - mn), pp = __expf(s - mn);
                l = l * corr + pp; mx = mn;
#pragma unroll
                for (int i = 0; i < 8; ++i) { const u32x4 w = vp[i];
                    o[8*i] = o[8*i] * corr + pp * bflo(w.x); o[8*i+1] = o[8*i+1] * corr + pp * bfhi(w.x); o[8*i+2] = o[8*i+2] * corr + pp * bflo(w.y); o[8*i+3] = o[8*i+3] * corr + pp * bfhi(w.y);
                    o[8*i+4] = o[8*i+4] * corr + pp * bflo(w.z); o[8*i+5] = o[8*i+5] * corr + pp * bfhi(w.z); o[8*i+6] = o[8*i+6] * corr + pp * bflo(w.w); o[8*i+7] = o[8*i+7] * corr + pp * bfhi(w.w); }
            } }
        const float rl = 1.f / l;
        u32x4* op = (u32x4*)(mixed + row * DM + 512 + h * 64);
#pragma unroll
        for (int i = 0; i < 8; ++i) { u32x4 w; w.x = pk2(o[8*i] * rl, o[8*i+1] * rl); w.y = pk2(o[8*i+2] * rl, o[8*i+3] * rl); w.z = pk2(o[8*i+4] * rl, o[8*i+5] * rl); w.w = pk2(o[8*i+6] * rl, o[8*i+7] * rl); op[i] = w; }
    }
}

constexpr int AT_K = 0, AT_V = 272 * 144, AT_END = 2 * 272 * 144;
typedef short s16x4 __attribute__((ext_vector_type(4)));
__device__ __forceinline__ s16x4 lds_tr16(LAS const unsigned char* pbyte) { return __builtin_bit_cast(s16x4, __builtin_amdgcn_ds_read_tr16_b64_v4i16((LAS s16x4*)pbyte)); }
__device__ __forceinline__ void ph_attn(const Params& p, const Ctx& c) {
    LAS unsigned char* L = c.lds;
    const bf16_t* proj = (const bf16_t*)(p.ws + WS_PROJ); bf16_t* AO = (bf16_t*)p.out; float* LSE = (float*)((unsigned char*)p.out + 96 * MiB);
    const int tid = c.tid, lane = c.lane, w = c.wave, r = lane & 15, qq = lane >> 4;
    constexpr float LOG2E = 1.4426950408889634f;
    __syncthreads();
    for (int i = tid; i < 16 * 144 / 4; i += NTHREADS) ((LAS unsigned*)(L + AT_V + 256 * 144))[i] = 0u;
    u32x4 kreg[4], vreg[4], qreg[2];
#define AT_DECODE(it_) const int h = (it_) & 7, rest = (it_) >> 3, br = rest >> 8, u = rest & 255, sh = 2 * br, dil = 1 << sh, nbm = (64 >> sh) - 1; \
        const int bres = u >> (6 - sh), blk = u & nbm, b = bres >> sh, res = bres & (dil - 1); const size_t rowb = (size_t)b * SEQ; const int l0 = blk * 128
#define AT_ISSUE(it_) do { AT_DECODE(it_); (void)br; \
        _Pragma("unroll") for (int k = 0; k < 4; ++k) { const int idx = tid + NTHREADS * k, row = idx >> 3, ch = idx & 7, l = l0 - 128 + row; kreg[k] = (u32x4){0u, 0u, 0u, 0u}; vreg[k] = kreg[k]; \
            if (l >= 0) { const bf16_t* src = proj + (rowb + (size_t)l * dil + res) * NIN_PAD + C_AK + h * 64 + ch * 8; kreg[k] = *(const u32x4*)src; vreg[k] = *(const u32x4*)(src + 512); } } \
        const bf16_t* qp = proj + (rowb + (size_t)(l0 + 16 * w + r) * dil + res) * NIN_PAD + C_AQ + h * 64 + 8 * qq; qreg[0] = *(const u32x4*)qp; qreg[1] = *(const u32x4*)(qp + 32); } while (0)
    if (c.blk < 6144) AT_ISSUE(c.blk);
    for (int item = c.blk; item < 6144; item += c.nblk) {
        AT_DECODE(item);
        __syncthreads();
#pragma unroll
        for (int k = 0; k < 4; ++k) { const int idx = tid + NTHREADS * k, row = idx >> 3, ch = idx & 7;
            *(LAS u32x4*)(L + AT_K + row * 144 + ch * 16) = kreg[k]; *(LAS u32x4*)(L + AT_V + row * 144 + ch * 16) = vreg[k]; }
        bf16x8 qf[2]; qf[0] = __builtin_bit_cast(bf16x8, qreg[0]); qf[1] = __builtin_bit_cast(bf16x8, qreg[1]);
        { const int nit = item + c.nblk; if (nit < 6144) AT_ISSUE(nit); }
        __syncthreads();
        f32x4 sa[9];
#pragma unroll
        for (int jn = 0; jn < 9; ++jn) { LAS const unsigned char* kp = L + AT_K + (16 * (w + jn) + r) * 144 + 16 * qq;
            const bf16x8 k0 = __builtin_bit_cast(bf16x8, *(const LAS u32x4*)kp), k1 = __builtin_bit_cast(bf16x8, *(const LAS u32x4*)(kp + 64));
            f32x4 z = {0.f, 0.f, 0.f, 0.f}; z = __builtin_amdgcn_mfma_f32_16x16x32_bf16(k0, qf[0], z, 0, 0, 0); sa[jn] = __builtin_amdgcn_mfma_f32_16x16x32_bf16(k1, qf[1], z, 0, 0, 0); }
        const float sc = 0.125f * LOG2E, sl = exp2f(-(float)(h + 1)) * (float)dil * LOG2E;
        float mx = -1e30f;
#pragma unroll
        for (int jn = 0; jn < 9; ++jn)
#pragma unroll
            for (int i = 0; i < 4; ++i) { const int delta = r + 128 - 16 * jn - 4 * qq - i, kj = 16 * (w + jn) + 4 * qq + i;
                const bool valid = (delta >= 0) && (delta <= 128) && (blk > 0 || kj >= 128);
                const float v = valid ? sa[jn][i] * sc - sl * (float)delta : -1e30f; sa[jn][i] = v; mx = fmaxf(mx, v); }
        mx = fmaxf(mx, __shfl_xor(mx, 16)); mx = fmaxf(mx, __shfl_xor(mx, 32));
        float sum = 0.f;
#pragma unroll
        for (int jn = 0; jn < 9; ++jn)
#pragma unroll
            for (int i = 0; i < 4; ++i) { const float e = __builtin_amdgcn_exp2f(sa[jn][i] - mx); sa[jn][i] = e; sum += e; }
        sum += __shfl_xor(sum, 16); sum += __shfl_xor(sum, 32);
        { const int qi = 16 * w + r; if (qq == 0) LSE[((size_t)br * M + rowb + (size_t)(l0 + qi) * dil + res) * 8 + h] = (mx + __builtin_amdgcn_logf(sum)) * (1.f / LOG2E); }
        f32x4 oa[4];
#pragma unroll
        for (int dt = 0; dt < 4; ++dt) oa[dt] = (f32x4){0.f, 0.f, 0.f, 0.f};
#pragma unroll
        for (int s2 = 0; s2 < 5; ++s2) { u32x4 pw; pw.x = pk2(sa[2 * s2][0], sa[2 * s2][1]); pw.y = pk2(sa[2 * s2][2], sa[2 * s2][3]);
            if (s2 < 4) { pw.z = pk2(sa[2 * s2 + 1][0], sa[2 * s2 + 1][1]); pw.w = pk2(sa[2 * s2 + 1][2], sa[2 * s2 + 1][3]); } else { pw.z = 0u; pw.w = 0u; }
            LAS const unsigned char* vp = L + AT_V + (16 * (w + 2 * s2) + 4 * qq + (r >> 2)) * 144 + 8 * (r & 3);
#pragma unroll
            for (int dt = 0; dt < 4; ++dt) { const s16x4 v0 = lds_tr16(vp + 32 * dt), v1 = lds_tr16(vp + 32 * dt + 16 * 144);
                const bf16x8 vf = {v0[0], v0[1], v0[2], v0[3], v1[0], v1[1], v1[2], v1[3]};
                oa[dt] = __builtin_amdgcn_mfma_f32_16x16x32_bf16(__builtin_bit_cast(bf16x8, pw), vf, oa[dt], 0, 0, 0); } }
        const float rs = __builtin_amdgcn_rcpf(sum);
        LAS bf16_t* ost = (LAS bf16_t*)(L + AT_END + w * 2304);
#pragma unroll
        for (int i = 0; i < 4; ++i) { const float ri = __shfl(rs, 4 * qq + i);
#pragma unroll
            for (int dt = 0; dt < 4; ++dt) ost[(4 * qq + i) * 72 + 16 * dt + r] = (bf16_t)f2bf(oa[dt][i] * ri); }
        asm volatile("" ::: "memory");
        { const int qi = lane >> 2, dc = (lane & 3) * 16;
          const u32x4 o0 = *(const LAS u32x4*)(ost + qi * 72 + dc), o1 = *(const LAS u32x4*)(ost + qi * 72 + dc + 8);
          bf16_t* op = AO + ((size_t)br * M + rowb + (size_t)(l0 + 16 * w + qi) * dil + res) * 512 + h * 64 + dc;
          *(u32x4*)op = o0; *(u32x4*)(op + 8) = o1; }
        asm volatile("" ::: "memory");
    }
#undef AT_DECODE
#undef AT_ISSUE
}

constexpr size_t WS_CKV = WS_S + 272 * MiB;
constexpr size_t WS_DEC = WS_S + 336 * MiB;
constexpr size_t WS_SPREV = WS_ACT;
constexpr int GL_SEGT = 0, GL_V = 2048, GL_KT = GL_V + 64 * 272, GL_QD = GL_KT + 64 * 144, GL_KI = GL_QD + 64 * 144, GL_END = GL_KI + 64 * 144;
__device__ __forceinline__ void gla_cumdecay(const Params& p, const Ctx& c, const bf16_t* prow0, int h, float (&bcum)[8], float& blast) {
    LAS float* SEGT = (LAS float*)(c.lds + GL_SEGT);
    const int kk = c.tid & 63, w = c.wave;
    float wa[16];
#pragma unroll
    for (int r = 0; r < 16; ++r) wa[r] = p.gla_w_alpha[r * 256 + h * 64 + kk];
    const float ba = p.gla_b_alpha[h * 64 + kk];
    float run = 0.f;
#pragma unroll
    for (int k = 0; k < 8; ++k) { const bf16_t* pr = prow0 + (size_t)(8 * w + k) * NIN_PAD + C_GLR;
        const u32x4 g0 = *(const u32x4*)pr, g1 = *(const u32x4*)(pr + 8);
        float z = ba + bflo(g0.x) * wa[0] + bfhi(g0.x) * wa[1] + bflo(g0.y) * wa[2] + bfhi(g0.y) * wa[3] + bflo(g0.z) * wa[4] + bfhi(g0.z) * wa[5] + bflo(g0.w) * wa[6] + bfhi(g0.w) * wa[7]
                     + bflo(g1.x) * wa[8] + bfhi(g1.x) * wa[9] + bflo(g1.y) * wa[10] + bfhi(g1.y) * wa[11] + bflo(g1.z) * wa[12] + bfhi(g1.z) * wa[13] + bflo(g1.w) * wa[14] + bfhi(g1.w) * wa[15];
        const float ls = fminf(z, 0.f) - __logf(1.f + __expf(-fabsf(z)));
        run += ls * (1.f / 16.f); bcum[k] = run; }
    __syncthreads();
    SEGT[w * 64 + kk] = run;
    __syncthreads();
    float off = 0.f, tot = 0.f;
#pragma unroll
    for (int sg = 0; sg < 8; ++sg) { const float v = SEGT[sg * 64 + kk]; off += (sg < w) ? v : 0.f; tot += v; }
#pragma unroll
    for (int k = 0; k < 8; ++k) bcum[k] += off;
    blast = tot;
}
__device__ __forceinline__ void gla_stage_v(const Ctx& c, const bf16_t* prow0, int h) {
#pragma unroll
    for (int k = 0; k < 2; ++k) { const int idx = c.tid + NTHREADS * k, row = idx >> 4, ch = idx & 15;
        *(LAS u32x4*)(c.lds + GL_V + row * 272 + ch * 16) = *(const u32x4*)(prow0 + (size_t)row * NIN_PAD + C_GV + h * 128 + ch * 8); }
}
__device__ __forceinline__ void ph_gla_a(const Params& p, const Ctx& c) {
    LAS unsigned char* L = c.lds; const bf16_t* proj = (const bf16_t*)(p.ws + WS_PROJ);
    float* CKV = (float*)(p.ws + WS_CKV); float* DEC = (float*)(p.ws + WS_DEC);
    const int tid = c.tid, lane = c.lane, w = c.wave, r = lane & 15, qq = lane >> 4, kk = tid & 63;
    for (int item = c.blk; item < 2048; item += c.nblk) {
        const int h = item & 3, bn = item >> 2; const bf16_t* prow0 = proj + (size_t)bn * 64 * NIN_PAD;
        float bcum[8], blast; gla_cumdecay(p, c, prow0, h, bcum, blast);
        gla_stage_v(c, prow0, h);
        { u32x4 o; float e[8];
#pragma unroll
          for (int k = 0; k < 8; ++k) e[k] = bf2f(prow0[(size_t)(8 * w + k) * NIN_PAD + C_GK + h * 64 + kk]) * __expf(blast - bcum[k]);
          o.x = pk2(e[0], e[1]); o.y = pk2(e[2], e[3]); o.z = pk2(e[4], e[5]); o.w = pk2(e[6], e[7]);
          *(LAS u32x4*)(L + GL_KT + kk * 144 + 16 * w) = o; }
        if (w == 0) DEC[(size_t)item * 64 + kk] = __expf(blast);
        __syncthreads();
        f32x4 acc[4];
#pragma unroll
        for (int n = 0; n < 4; ++n) acc[n] = (f32x4){0.f, 0.f, 0.f, 0.f};
#pragma unroll
        for (int s2 = 0; s2 < 2; ++s2) { LAS const unsigned char* vp = L + GL_V + (32 * s2 + 8 * qq + (r >> 2)) * 272 + (16 * w + 4 * (r & 3)) * 2;
            const s16x4 v0 = lds_tr16(vp), v1 = lds_tr16(vp + 4 * 272); const bf16x8 af = {v0[0], v0[1], v0[2], v0[3], v1[0], v1[1], v1[2], v1[3]};
#pragma unroll
            for (int n = 0; n < 4; ++n) { const bf16x8 bfr = __builtin_bit_cast(bf16x8, *(const LAS u32x4*)(L + GL_KT + (16 * n + r) * 144 + (32 * s2 + 8 * qq) * 2));
                acc[n] = __builtin_amdgcn_mfma_f32_16x16x32_bf16(af, bfr, acc[n], 0, 0, 0); } }
        float* outp = CKV + (size_t)item * 8192 + (16 * w + 4 * qq) * 64 + r;
#pragma unroll
        for (int n = 0; n < 4; ++n)
#pragma unroll
            for (int i = 0; i < 4; ++i) outp[i * 64 + 16 * n] = acc[n][i];
    }
}
__device__ __forceinline__ void ph_gla_b(const Params& p, const Ctx& c) {
    const float* CKV = (const float*)(p.ws + WS_CKV); const float* DEC = (const float*)(p.ws + WS_DEC); bf16_t* SP = (bf16_t*)(p.ws + WS_SPREV);
    for (int idx = c.gtid; idx < 16 * 8192; idx += c.gthreads) { const int bh = idx >> 13, e = idx & 8191, b = bh >> 2, h = bh & 3; float S = 0.f;
        for (int n0 = 0; n0 < 128; n0 += 8) { float cv[8], dv[8];
#pragma unroll
            for (int k = 0; k < 8; ++k) { const size_t item = (size_t)(b * 128 + n0 + k) * 4 + h; cv[k] = CKV[item * 8192 + e]; dv[k] = DEC[item * 64 + (e & 63)]; }
#pragma unroll
            for (int k = 0; k < 8; ++k) { const size_t item = (size_t)(b * 128 + n0 + k) * 4 + h; SP[item * 8192 + e] = (bf16_t)f2bf(S); S = dv[k] * S + cv[k]; } } }
}
__device__ __forceinline__ void ph_gla_c(const Params& p, const Ctx& c) {
    LAS unsigned char* L = c.lds; const bf16_t* proj = (const bf16_t*)(p.ws + WS_PROJ); const bf16_t* SP = (const bf16_t*)(p.ws + WS_SPREV); float* go = (float*)(p.ws + WS_GLAO);
    const int tid = c.tid, lane = c.lane, w = c.wave, r = lane & 15, qq = lane >> 4, kk = tid & 63;
    for (int item = c.blk; item < 2048; item += c.nblk) {
        const int h = item & 3, bn = item >> 2; const bf16_t* prow0 = proj + (size_t)bn * 64 * NIN_PAD;
        float bcum[8], blast; gla_cumdecay(p, c, prow0, h, bcum, blast);
        gla_stage_v(c, prow0, h);
#pragma unroll
        for (int k = 0; k < 8; ++k) { const int i = 8 * w + k; const bf16_t* pr = prow0 + (size_t)i * NIN_PAD;
            const float qv = bf2f(pr[C_GQ + h * 64 + kk]) * 0.125f * __expf(bcum[k]), kv = bf2f(pr[C_GK + h * 64 + kk]) * __expf(-bcum[k]);
            *(LAS bf16_t*)(L + GL_QD + i * 144 + kk * 2) = (bf16_t)f2bf(qv); *(LAS bf16_t*)(L + GL_KI + i * 144 + kk * 2) = (bf16_t)f2bf(kv); }
        __syncthreads();
        const int it = w & 3, vh = w >> 2;
        bf16x8 qf[2];
#pragma unroll
        for (int s2 = 0; s2 < 2; ++s2) qf[s2] = __builtin_bit_cast(bf16x8, *(const LAS u32x4*)(L + GL_QD + (16 * it + r) * 144 + (32 * s2 + 8 * qq) * 2));
        u32x2 pw[4];
#pragma unroll
        for (int jt = 0; jt < 4; ++jt) { f32x4 z = {0.f, 0.f, 0.f, 0.f};
            if (jt <= it) {
#pragma unroll
                for (int s2 = 0; s2 < 2; ++s2) { const bf16x8 kf = __builtin_bit_cast(bf16x8, *(const LAS u32x4*)(L + GL_KI + (16 * jt + r) * 144 + (32 * s2 + 8 * qq) * 2));
                    z = __builtin_amdgcn_mfma_f32_16x16x32_bf16(kf, qf[s2], z, 0, 0, 0); }
#pragma unroll
                for (int ii = 0; ii < 4; ++ii) z[ii] = (16 * jt + 4 * qq + ii <= 16 * it + r) ? z[ii] : 0.f; }
            pw[jt].x = pk2(z[0], z[1]); pw[jt].y = pk2(z[2], z[3]); }
        f32x4 acc[4];
#pragma unroll
        for (int n = 0; n < 4; ++n) acc[n] = (f32x4){0.f, 0.f, 0.f, 0.f};
#pragma unroll
        for (int s2 = 0; s2 < 2; ++s2) { if (2 * s2 <= it) {
            const u32x4 pq = {pw[2 * s2].x, pw[2 * s2].y, pw[2 * s2 + 1].x, pw[2 * s2 + 1].y};
            LAS const unsigned char* vp = L + GL_V + (32 * s2 + 4 * qq + (r >> 2)) * 272 + (64 * vh + 4 * (r & 3)) * 2;
#pragma unroll
            for (int n = 0; n < 4; ++n) { const s16x4 v0 = lds_tr16(vp + 32 * n), v1 = lds_tr16(vp + 32 * n + 16 * 272);
                const bf16x8 vf = {v0[0], v0[1], v0[2], v0[3], v1[0], v1[1], v1[2], v1[3]};
                acc[n] = __builtin_amdgcn_mfma_f32_16x16x32_bf16(__builtin_bit_cast(bf16x8, pq), vf, acc[n], 0, 0, 0); } } }
#pragma unroll
        for (int s2 = 0; s2 < 2; ++s2)
#pragma unroll
            for (int n = 0; n < 4; ++n) { const bf16x8 sf = __builtin_bit_cast(bf16x8, *(const u32x4*)(SP + (size_t)item * 8192 + (64 * vh + 16 * n + r) * 64 + 32 * s2 + 8 * qq));
                acc[n] = __builtin_amdgcn_mfma_f32_16x16x32_bf16(qf[s2], sf, acc[n], 0, 0, 0); }
        float* outp = go + ((size_t)bn * 64 + 16 * it + 4 * qq) * 512 + h * 128 + 64 * vh + r;
#pragma unroll
        for (int n = 0; n < 4; ++n)
#pragma unroll
            for (int ii = 0; ii < 4; ++ii) outp[ii * 512 + 16 * n] = acc[n][ii];
    }
}
#ifndef ATT_COMBINE
#define ATT_COMBINE 1
#endif
__device__ __forceinline__ void ph_mix(const Params& p, const Ctx& c) {
    const bf16_t* proj = (const bf16_t*)(p.ws + WS_PROJ); const float* go = (const float*)(p.ws + WS_GLAO); bf16_t* mixed = (bf16_t*)(p.ws + WS_ACT);
    for (int m = c.gwave; m < M; m += c.gwaves) {
#pragma unroll
        for (int h = 0; h < 4; ++h) { const int col = h * 128 + 2 * c.lane;
            const float o0 = go[(size_t)m * 512 + col], o1 = go[(size_t)m * 512 + col + 1];
            const float rstd = 1.f / sqrtf(wave_sum(o0 * o0 + o1 * o1) * (1.f / 128.f) + NORM_EPS);
            const unsigned gw = *(const unsigned*)(proj + (size_t)m * NIN_PAD + C_GG + col); const float g0 = bflo(gw), g1 = bfhi(gw);
            const float r0 = o0 * rstd * p.gla_head_gain[col] * (g0 * sigmoidf_(g0)), r1 = o1 * rstd * p.gla_head_gain[col + 1] * (g1 * sigmoidf_(g1));
            *(unsigned*)(mixed + (size_t)m * DM + col) = pk2(r0, r1); }
        if (ATT_COMBINE) {
            const bf16_t* AO = (const bf16_t*)p.out; const float* LSE = (const float*)((const unsigned char*)p.out + 96 * MiB); const int hh = c.lane >> 3;
            const float l0 = LSE[((size_t)0 * M + m) * 8 + hh], l1 = LSE[((size_t)1 * M + m) * 8 + hh], l2 = LSE[((size_t)2 * M + m) * 8 + hh];
            const float lm = fmaxf(l0, fmaxf(l1, l2)), e0 = __expf(l0 - lm), e1 = __expf(l1 - lm), e2 = __expf(l2 - lm), rd = 1.f / (e0 + e1 + e2);
            const float w0 = e0 * rd, w1 = e1 * rd, w2 = e2 * rd;
            const u32x4 a0 = *((const u32x4*)(AO + ((size_t)0 * M + m) * 512) + c.lane), a1 = *((const u32x4*)(AO + ((size_t)1 * M + m) * 512) + c.lane), a2 = *((const u32x4*)(AO + ((size_t)2 * M + m) * 512) + c.lane);
            u32x4 o;
            o.x = pk2(w0 * bflo(a0.x) + w1 * bflo(a1.x) + w2 * bflo(a2.x), w0 * bfhi(a0.x) + w1 * bfhi(a1.x) + w2 * bfhi(a2.x));
            o.y = pk2(w0 * bflo(a0.y) + w1 * bflo(a1.y) + w2 * bflo(a2.y), w0 * bfhi(a0.y) + w1 * bfhi(a1.y) + w2 * bfhi(a2.y));
            o.z = pk2(w0 * bflo(a0.z) + w1 * bflo(a1.z) + w2 * bflo(a2.z), w0 * bfhi(a0.z) + w1 * bfhi(a1.z) + w2 * bfhi(a2.z));
            o.w = pk2(w0 * bflo(a0.w) + w1 * bflo(a1.w) + w2 * bflo(a2.w), w0 * bfhi(a0.w) + w1 * bfhi(a1.w) + w2 * bfhi(a2.w));
            *((u32x4*)(mixed + (size_t)m * DM + 512) + c.lane) = o; }
    }
}


constexpr int GR_WGT = 0, GR_XC = 65536, GR_A = 81920, GR_U = 115712, GR_SEG = 132608, GR_CW = 136704, GR_GB = 139264;
__device__ __forceinline__ float fast_sigmoid(float x) { return __builtin_amdgcn_rcpf(1.f + __expf(-x)); }
template <bool FULL> __device__ __forceinline__ void griffin_pass(const Params& p, const Ctx& c) {
    LAS unsigned char* L = c.lds;
    const int tid = c.tid, lane = c.lane, wave = c.wave, g = c.blk & 7;
    const bf16_t* proj = (const bf16_t*)(p.ws + WS_PROJ); bf16_t* yout = (bf16_t*)(p.ws + WS_ACT);
    float* AGA = (float*)(p.ws + WS_AGG); float* AGH = AGA + BATCH * 128 * 1024; const float* CAR = AGH + BATCH * 128 * 1024;
    LAS float* A_ = (LAS float*)(L + GR_A); LAS bf16_t* U_ = (LAS bf16_t*)(L + GR_U); LAS float* SEG = (LAS float*)(L + GR_SEG); LAS float* CW = (LAS float*)(L + GR_CW); LAS float* GB = (LAS float*)(L + GR_GB);
    __syncthreads();
    { const bf16_t* wg = (const bf16_t*)(p.ws + WS_WG);
      for (int ch = tid; ch < 4096; ch += NTHREADS) { const int gate = ch >> 11, j = (ch >> 4) & 127, cc = ch & 15;
          const u32x4 v = *(const u32x4*)(wg + ((size_t)(gate * 8 + g) * 128 + j) * 128 + cc * 8);
          *(LAS u32x4*)(L + GR_WGT + gate * 32768 + j * 256 + ((cc ^ (j & 15)) << 4)) = v; }
      if (tid < 128) { const int ch = g * 128 + tid;
#pragma unroll
          for (int jj = 0; jj < 4; ++jj) CW[jj * 128 + tid] = p.c_conv_w[jj * 1024 + ch];
          CW[4 * 128 + tid] = p.c_conv_b[ch]; GB[tid] = p.c_b_rgate[ch]; GB[128 + tid] = p.c_b_igate[ch];
          const float lam = p.c_lambda[ch]; GB[256 + tid] = fmaxf(-lam, 0.f) + log1pf(expf(-fabsf(lam))); } }
    __syncthreads();
    const int nslot = BATCH * 128, sstep = c.nblk >> 3;
    u32x4 xr[5];
#define GR_XLOAD(sl_) do { const int b_ = (sl_) >> 7, t0_ = ((sl_) & 127) * 64; const size_t r0_ = (size_t)b_ * SEQ + t0_; const int co_ = tid & 15, tp_ = tid >> 4; \
        _Pragma("unroll") for (int jj = 0; jj < 5; ++jj) { const int tt = t0_ + 2 * tp_ - 3 + jj; xr[jj] = (u32x4){0u, 0u, 0u, 0u}; \
            if (tt >= 0) xr[jj] = *(const u32x4*)(proj + (r0_ + 2 * tp_ - 3 + jj) * 2048 + 1024 + g * 128 + co_ * 8); } } while (0)
    if ((c.blk >> 3) < nslot) GR_XLOAD(c.blk >> 3);
    for (int slot = c.blk >> 3; slot < nslot; slot += sstep) {
        const int b = slot >> 7, tile = slot & 127, t0 = tile * 64; const size_t row0 = (size_t)b * SEQ + t0;
        u32x4 gpre[2];
        if (FULL) { const int co = tid & 15, tp = tid >> 4;
#pragma unroll
            for (int tl = 0; tl < 2; ++tl) gpre[tl] = *(const u32x4*)(proj + (row0 + 2 * tp + tl) * 2048 + g * 128 + co * 8); }
        { const int co = tid & 15, tp = tid >> 4;
          f32x4 w[5][2];
#pragma unroll
          for (int jj = 0; jj < 5; ++jj) { w[jj][0] = *(const LAS f32x4*)(CW + jj * 128 + co * 8); w[jj][1] = *(const LAS f32x4*)(CW + jj * 128 + co * 8 + 4); }
#pragma unroll
          for (int tl = 0; tl < 2; ++tl) { float a8[8];
#pragma unroll
              for (int e = 0; e < 8; ++e) a8[e] = w[4][e >> 2][e & 3];
#pragma unroll
              for (int jj = 0; jj < 4; ++jj) { const u32x4 xv = xr[tl + jj]; const unsigned xw[4] = {xv.x, xv.y, xv.z, xv.w};
#pragma unroll
                  for (int e = 0; e < 8; ++e) { const float xe = (e & 1) ? bfhi(xw[e >> 1]) : bflo(xw[e >> 1]); a8[e] += w[jj][e >> 2][e & 3] * xe; } }
              const int t = 2 * tp + tl; u32x4 o; o.x = pk2(a8[0], a8[1]); o.y = pk2(a8[2], a8[3]); o.z = pk2(a8[4], a8[5]); o.w = pk2(a8[6], a8[7]);
              *(LAS u32x4*)(L + GR_XC + t * 256 + ((co ^ (t & 15)) << 4)) = o; } }
        if (slot + sstep < nslot) GR_XLOAD(slot + sstep);
        __syncthreads();
        { const int tt = wave & 3, jh = wave >> 2, r = lane & 15, q = lane >> 4, t = 16 * tt + r;
          f32x4 ar[4], ai[4];
#pragma unroll
          for (int n = 0; n < 4; ++n) { ar[n] = (f32x4){0.f, 0.f, 0.f, 0.f}; ai[n] = (f32x4){0.f, 0.f, 0.f, 0.f}; }
#pragma unroll
          for (int s = 0; s < 4; ++s) { const bf16x8 xb = __builtin_bit_cast(bf16x8, *(const LAS u32x4*)(L + GR_XC + t * 256 + (((4 * s + q) ^ (t & 15)) << 4)));
#pragma unroll
              for (int n = 0; n < 4; ++n) { const int j = 64 * jh + 16 * n + r;
                  const bf16x8 wr = __builtin_bit_cast(bf16x8, *(const LAS u32x4*)(L + GR_WGT + j * 256 + (((4 * s + q) ^ (j & 15)) << 4)));
                  const bf16x8 wi = __builtin_bit_cast(bf16x8, *(const LAS u32x4*)(L + GR_WGT + 32768 + j * 256 + (((4 * s + q) ^ (j & 15)) << 4)));
                  ar[n] = __builtin_amdgcn_mfma_f32_16x16x32_bf16(wr, xb, ar[n], 0, 0, 0); ai[n] = __builtin_amdgcn_mfma_f32_16x16x32_bf16(wi, xb, ai[n], 0, 0, 0); } }
#pragma unroll
          for (int n = 0; n < 4; ++n) { const int j0 = 64 * jh + 16 * n + 4 * q;
              const f32x4 br = *(const LAS f32x4*)(GB + j0), bi = *(const LAS f32x4*)(GB + 128 + j0), sp = *(const LAS f32x4*)(GB + 256 + j0);
              const u32x2 xw = *(const LAS u32x2*)(L + GR_XC + t * 256 + ((((j0 >> 3) ^ (t & 15)) << 4) + (j0 & 7) * 2));
              const float xc[4] = {bflo(xw.x), bfhi(xw.x), bflo(xw.y), bfhi(xw.y)};
              f32x4 av; float uv[4];
#pragma unroll
              for (int i = 0; i < 4; ++i) { const float rr = fast_sigmoid(ar[n][i] + br[i]), ii = fast_sigmoid(ai[n][i] + bi[i]);
                  const float a = __expf(-8.f * rr * sp[i]); av[i] = a; uv[i] = sqrtf(fmaxf(1.f - a * a, 0.f)) * (ii * xc[i]); }
              *(LAS f32x4*)(A_ + t * 132 + j0) = av; u32x2 uo; uo.x = pk2(uv[0], uv[1]); uo.y = pk2(uv[2], uv[3]); *(LAS u32x2*)(U_ + t * 132 + j0) = uo; } }
        __syncthreads();
        const int j = tid & 127, seg = tid >> 7;
        { float aa = 1.f, hh = 0.f;
#pragma unroll
          for (int i = 0; i < 16; ++i) { const int t = seg * 16 + i; const float a = A_[t * 132 + j], u = bf2f(U_[t * 132 + j]); hh = a * hh + u; aa *= a; }
          SEG[seg * 128 + j] = aa; SEG[512 + seg * 128 + j] = hh; }
        __syncthreads();
        if (!FULL) {
            if (tid < 128) { float A = 1.f, H = 0.f;
#pragma unroll
                for (int sgi = 0; sgi < 4; ++sgi) { H = SEG[sgi * 128 + tid] * H + SEG[512 + sgi * 128 + tid]; A *= SEG[sgi * 128 + tid]; }
                const size_t e = ((size_t)b * 128 + tile) * 1024 + g * 128 + tid; AGA[e] = A; AGH[e] = H; }
        } else {
            float h = CAR[((size_t)b * 128 + tile) * 1024 + g * 128 + j];
            for (int sgi = 0; sgi < seg; ++sgi) h = SEG[sgi * 128 + j] * h + SEG[512 + sgi * 128 + j];
#pragma unroll
            for (int i = 0; i < 16; ++i) { const int t = seg * 16 + i; const float a = A_[t * 132 + j], u = bf2f(U_[t * 132 + j]); h = a * h + u; A_[t * 132 + j] = h; }
            __syncthreads();
            { const int co = tid & 15, tp = tid >> 4;
#pragma unroll
              for (int tl = 0; tl < 2; ++tl) { const int t = 2 * tp + tl;
                  const f32x4 h0 = *(const LAS f32x4*)(A_ + t * 132 + co * 8), h1 = *(const LAS f32x4*)(A_ + t * 132 + co * 8 + 4);
                  const u32x4 gw = gpre[tl];
                  u32x4 o; o.x = pk2(gelu_tanh(bflo(gw.x)) * h0.x, gelu_tanh(bfhi(gw.x)) * h0.y); o.y = pk2(gelu_tanh(bflo(gw.y)) * h0.z, gelu_tanh(bfhi(gw.y)) * h0.w);
                  o.z = pk2(gelu_tanh(bflo(gw.z)) * h1.x, gelu_tanh(bfhi(gw.z)) * h1.y); o.w = pk2(gelu_tanh(bflo(gw.w)) * h1.z, gelu_tanh(bfhi(gw.w)) * h1.w);
                  *(u32x4*)(yout + (row0 + t) * DM + g * 128 + co * 8) = o; } }
        }
    }
#undef GR_XLOAD
}
__device__ __forceinline__ void ph_carry(const Params& p, const Ctx& c) {
    const float* AGA = (const float*)(p.ws + WS_AGG); const float* AGH = AGA + BATCH * 128 * 1024; float* CAR = (float*)(AGH + BATCH * 128 * 1024);
    for (int idx = c.gtid; idx < BATCH * 1024; idx += c.gthreads) { const int b = idx >> 10, ch = idx & 1023; float cy = 0.f;
        for (int t0 = 0; t0 < 128; t0 += 8) { float a[8], h[8];
#pragma unroll
            for (int k = 0; k < 8; ++k) { const size_t e = ((size_t)b * 128 + t0 + k) * 1024 + ch; a[k] = AGA[e]; h[k] = AGH[e]; }
#pragma unroll
            for (int k = 0; k < 8; ++k) { CAR[((size_t)b * 128 + t0 + k) * 1024 + ch] = cy; cy = a[k] * cy + h[k]; } } }
}
__device__ __forceinline__ void cvt_gate_weights(const Params& p, const Ctx& c) {
    bf16_t* wg = (bf16_t*)(p.ws + WS_WG);
    for (int idx = c.gtid; idx < 2 * 8 * 16 * 128; idx += c.gthreads) { const int j = idx & 127, io = (idx >> 7) & 15, g = (idx >> 11) & 7, gate = idx >> 14;
        const float* s = (gate ? p.c_w_igate : p.c_w_rgate) + (size_t)g * 16384 + (io * 8) * 128 + j;
        u32x4 w; w.x = pk2(s[0], s[128]); w.y = pk2(s[256], s[384]); w.z = pk2(s[512], s[640]); w.w = pk2(s[768], s[896]);
        *(u32x4*)(wg + ((size_t)(gate * 8 + g) * 128 + j) * 128 + io * 8) = w; }
}


constexpr size_t WS_SK = 25 * MiB;
constexpr int TK_SK = 0, TK_Q = 69632, TK_S = 86528, TK_L = 119552  , TK_O = 135936, TK_TAB = 144128;
typedef int i32x4 __attribute__((ext_vector_type(4)));
__device__ __forceinline__ int key_xform(int b) { return b ^ ((b >> 31) & 0x7fffffff); }
#define CEX(a, b) do { const int hi_ = max((a), (b)), lo_ = min((a), (b)); (a) = hi_; (b) = lo_; } while (0)
__device__ __forceinline__ void bitonic_merge16_desc(int (&v)[16]) {
#pragma unroll
    for (int j = 8; j >= 1; j >>= 1)
#pragma unroll
        for (int i = 0; i < 16; ++i) if ((i & j) == 0) CEX(v[i], v[i | j]);
}
__device__ __forceinline__ void bitonic_sort16_desc(int (&v)[16]) {
#pragma unroll
    for (int k = 2; k <= 16; k <<= 1)
#pragma unroll
        for (int j = k >> 1; j >= 1; j >>= 1)
#pragma unroll
            for (int i = 0; i < 16; ++i) { const int l = i ^ j; if (l > i) { if ((i & k) == 0 || k == 16) CEX(v[i], v[l]); else CEX(v[l], v[i]); } }
}
__device__ __forceinline__ void ph_topk(const Params& p, int layer, const Ctx& c) {
    LAS unsigned char* L = c.lds; const bf16_t* Q = (const bf16_t*)(p.ws + WS_PROJ);
    int* ids = (int*)(p.ws + WS_IDS); float* gg = (float*)(p.ws + WS_G);
    const int tid = c.tid, lane = c.lane, w = c.wave, r = lane & 15, qq = lane >> 4, h = c.blk & 7;
    LAS float* S = (LAS float*)(L + TK_S); LAS int* LST = (LAS int*)(L + TK_L); LAS int* OUTK = (LAS int*)(L + TK_O); LAS int* TAB = (LAS int*)(L + TK_TAB);
    __syncthreads();
    { const bf16_t* sk = (const bf16_t*)(p.ws + WS_SK) + ((size_t)layer * 8 + h) * 2 * 128 * 128;
      for (int ch = tid; ch < 4096; ch += NTHREADS) { const int row = ch >> 4, cc = ch & 15;
          *(LAS u32x4*)(L + TK_SK + row * 272 + cc * 16) = *(const u32x4*)(sk + (size_t)row * 128 + cc * 8); }
      if (tid < 64) { int cnt = 0, code = -1;
          for (int i = 0; i < 16; ++i) for (int j = 0; j < 16 / (i + 1); ++j) { if (cnt == tid) code = i * 16 + j; ++cnt; }
          TAB[tid] = code; } }
    const int nslot = M / 32, sstep = c.nblk >> 3;
    u32x4 qpre[2];
#define TK_QLOAD(sl_) do { _Pragma("unroll") for (int k = 0; k < 2; ++k) { const int idx = tid + NTHREADS * k, row = idx >> 5, ch = idx & 31; \
        qpre[k] = *(const u32x4*)(Q + (size_t)(min((sl_), nslot - 1) * 32 + row) * 2048 + h * 256 + ch * 8); } } while (0)
#define TK_MERGE(CTRL) do { int o_[16]; _Pragma("unroll") for (int i = 0; i < 16; ++i) o_[i] = __builtin_amdgcn_update_dpp(0, v[15 - i], (CTRL), 0xf, 0xf, false); \
        _Pragma("unroll") for (int i = 0; i < 16; ++i) v[i] = max(v[i], o_[i]); bitonic_merge16_desc(v); } while (0)
    TK_QLOAD(c.blk >> 3);
    int gfirst = 0, gi = 0;
    for (int slot = c.blk >> 3; slot < nslot; slot += sstep) {
        __syncthreads();
#pragma unroll
        for (int k = 0; k < 2; ++k) { const int idx = tid + NTHREADS * k, row = idx >> 5, ch = idx & 31; *(LAS u32x4*)(L + TK_Q + row * 528 + ch * 16) = qpre[k]; }
        TK_QLOAD(slot + sstep);
        __syncthreads();
        { const int pp = w >> 2, mt = (w >> 1) & 1, nh = w & 1;
          f32x4 acc[4];
#pragma unroll
          for (int nt = 0; nt < 4; ++nt) acc[nt] = (f32x4){0.f, 0.f, 0.f, 0.f};
#pragma unroll
          for (int s2 = 0; s2 < 4; ++s2) { const bf16x8 af = __builtin_bit_cast(bf16x8, *(const LAS u32x4*)(L + TK_Q + (16 * mt + r) * 528 + (pp * 128 + 32 * s2 + 8 * qq) * 2));
#pragma unroll
              for (int nt = 0; nt < 4; ++nt) { const bf16x8 bfr = __builtin_bit_cast(bf16x8, *(const LAS u32x4*)(L + TK_SK + (pp * 128 + 16 * (4 * nh + nt) + r) * 272 + (32 * s2 + 8 * qq) * 2));
                  acc[nt] = __builtin_amdgcn_mfma_f32_16x16x32_bf16(af, bfr, acc[nt], 0, 0, 0); } }
#pragma unroll
          for (int nt = 0; nt < 4; ++nt)
#pragma unroll
              for (int i = 0; i < 4; ++i) S[(pp * 32 + 16 * mt + 4 * qq + i) * 129 + 16 * (4 * nh + nt) + r] = acc[nt][i]; }
        __syncthreads();
        {
          const int m = tid >> 4, sub = tid & 15, pp = sub >> 3, part = sub & 7; int v[16];
#pragma unroll
          for (int k = 0; k < 16; ++k) { const int n = 8 * k + part; v[k] = key_xform((__builtin_bit_cast(int, S[(pp * 32 + m) * 129 + n]) & ~127) | n); }
          bitonic_sort16_desc(v);
          TK_MERGE(0xB1);
          TK_MERGE(0x4E);
          TK_MERGE(0x141);
          if (part == 0) {
#pragma unroll
              for (int k = 0; k < 16; ++k) LST[((gi * 32 + m) * 2 + pp) * 16 + k] = key_xform(v[k]); } }
        if (gi == 0) gfirst = slot;
        ++gi;
        if (gi < 4 && slot + sstep < nslot) continue;
        __syncthreads();
        {
          const int tq = tid >> 2, sub = tid & 3, grp = tq >> 5, m = tq & 31;
          if (grp < gi) {
              const int slot_g = gfirst + grp * sstep;
              LAS const int* L1 = LST + (tq * 2 + 0) * 16; LAS const int* L2 = LST + (tq * 2 + 1) * 16;
              int v[16];
#pragma unroll
              for (int k = 0; k < 16; ++k) { const int ci = sub * 16 + k; const int code = TAB[ci]; int key = (int)0x80000000;
                  if (code >= 0) { const float s1 = __builtin_bit_cast(float, L1[code >> 4] & ~127), s2v = __builtin_bit_cast(float, L2[code & 15] & ~127);
                      key = key_xform((__builtin_bit_cast(int, s1 + s2v) & ~63) | (63 - ci)); }
                  v[k] = key; }
              bitonic_sort16_desc(v);
              TK_MERGE(0xB1); TK_MERGE(0x4E);
              const float smax = __builtin_bit_cast(float, key_xform(v[0]) & ~63);
              if (sub == 0) {
#pragma unroll
                  for (int k4 = 0; k4 < 4; ++k4) *(LAS i32x4*)(OUTK + tq * 16 + 4 * k4) = (i32x4){v[4 * k4], v[4 * k4 + 1], v[4 * k4 + 2], v[4 * k4 + 3]}; }
              asm volatile("s_waitcnt lgkmcnt(0)" ::: "memory");
              const i32x4 mine = *(const LAS i32x4*)(OUTK + tq * 16 + 4 * sub);
              float e[4]; int kb[4];
#pragma unroll
              for (int j = 0; j < 4; ++j) { kb[j] = key_xform(mine[j]); e[j] = __expf(__builtin_bit_cast(float, kb[j] & ~63) - smax); }
              float den = (e[0] + e[1]) + (e[2] + e[3]);
              den += __builtin_bit_cast(float, __builtin_amdgcn_update_dpp(0, __builtin_bit_cast(int, den), 0xB1, 0xf, 0xf, false));
              den += __builtin_bit_cast(float, __builtin_amdgcn_update_dpp(0, __builtin_bit_cast(int, den), 0x4E, 0xf, 0xf, false));
              const float rden = 1.f / den; i32x4 oi; f32x4 og;
#pragma unroll
              for (int j = 0; j < 4; ++j) { const int code = TAB[63 - (kb[j] & 63)]; oi[j] = (L1[code >> 4] & 127) * 128 + (L2[code & 15] & 127); og[j] = e[j] * rden; }
              const size_t o = (size_t)(slot_g * 32 + m) * 128 + h * 16 + 4 * sub;
              *(i32x4*)(ids + o) = oi; *(f32x4*)(gg + o) = og; } }
        gi = 0;
    }
#undef TK_QLOAD
#undef TK_MERGE
}

__device__ __forceinline__ void ph_topk1(const Params& p, int layer, const Ctx& c) {
    const bf16_t* Q = (const bf16_t*)(p.ws + WS_PROJ); float* tops = (float*)(p.ws + WS_TOPS); int* topi = (int*)(p.ws + WS_TOPI);
    const float* keys = p.peer_sub_keys + (size_t)layer * 16 * 128 * 128;
    for (int gid = c.gtid; gid < M * 32; gid += c.gthreads) {
        const int idx = gid >> 1, half = gid & 1;
        const int t = idx & (M - 1), hp = __builtin_amdgcn_readfirstlane(idx >> 15);
        float q[64];
        { const u32x4* qp = (const u32x4*)(Q + (size_t)t * 2048 + hp * 128 + half * 64);
#pragma unroll
          for (int i = 0; i < 8; ++i) { const u32x4 w = qp[i]; q[8*i] = bflo(w.x); q[8*i+1] = bfhi(w.x); q[8*i+2] = bflo(w.y); q[8*i+3] = bfhi(w.y); q[8*i+4] = bflo(w.z); q[8*i+5] = bfhi(w.z); q[8*i+6] = bflo(w.w); q[8*i+7] = bfhi(w.w); } }
        float ls[16]; int li[16];
#pragma unroll
        for (int j = 0; j < 16; ++j) { ls[j] = -3.0e38f; li[j] = 0; }
        for (int n = 0; n < 128; ++n) { const float* kr = keys + ((size_t)hp * 128 + n) * 128 + half * 64;
            float s = 0.f;
#pragma unroll
            for (int cc = 0; cc < 64; ++cc) s += q[cc] * kr[cc];
            s += __shfl_xor(s, 1);
            int ni = n;
#pragma unroll
            for (int j = 0; j < 16; ++j) { const bool gt = s > ls[j]; const float ts = gt ? ls[j] : s; const int ti = gt ? li[j] : ni; ls[j] = gt ? s : ls[j]; li[j] = gt ? ni : li[j]; s = ts; ni = ti; }
        }
        if (half == 0) { float* os = tops + ((size_t)t * 16 + hp) * 16; int* oi = topi + ((size_t)t * 16 + hp) * 16;
#pragma unroll
            for (int j = 0; j < 16; ++j) { os[j] = ls[j]; oi[j] = li[j]; } }
    }
}
__device__ __forceinline__ void ph_topk2(const Params& p, const Ctx& c) {
    const float* tops = (const float*)(p.ws + WS_TOPS); const int* topi = (const int*)(p.ws + WS_TOPI);
    int* ids = (int*)(p.ws + WS_IDS); float* gg = (float*)(p.ws + WS_G);
    for (int idx = c.gtid; idx < M * 8; idx += c.gthreads) {
        const int t = idx >> 3, h = idx & 7;
        float s1[16], s2[16]; int i1[16], i2[16];
        { const float* a = tops + ((size_t)t * 16 + h * 2) * 16; const int* ai = topi + ((size_t)t * 16 + h * 2) * 16;
#pragma unroll
          for (int j = 0; j < 16; ++j) { s1[j] = a[j]; s2[j] = a[16 + j]; i1[j] = ai[j]; i2[j] = ai[16 + j]; } }
        float ls[16]; int lc[16];
#pragma unroll
        for (int j = 0; j < 16; ++j) { ls[j] = -3.0e38f; lc[j] = 0; }
#pragma unroll
        for (int i = 0; i < 16; ++i)
#pragma unroll
            for (int j = 0; j < 16 / (i + 1); ++j) { float s = s1[i] + s2[j]; int cd = i * 16 + j;
#pragma unroll
                for (int k = 0; k < 16; ++k) { const bool gt = s > ls[k]; const float ts = gt ? ls[k] : s; const int tc = gt ? lc[k] : cd; ls[k] = gt ? s : ls[k]; lc[k] = gt ? cd : lc[k]; s = ts; cd = tc; } }
        float den = 0.f, e[16];
#pragma unroll
        for (int k = 0; k < 16; ++k) { e[k] = __expf(ls[k] - ls[0]); den += e[k]; }
        const float rd = 1.f / den;
#pragma unroll
        for (int k = 0; k < 16; ++k) { const int ci = lc[k] >> 4, cj = lc[k] & 15; int a = 0, bq = 0;
#pragma unroll
            for (int z = 0; z < 16; ++z) { a = (ci == z) ? i1[z] : a; bq = (cj == z) ? i2[z] : bq; }
            ids[(size_t)t * 128 + h * 16 + k] = a * 128 + bq; gg[(size_t)t * 128 + h * 16 + k] = e[k] * rd; }
    }
}
__device__ __forceinline__ void ph_gather(const Params& p, const Ctx& c) {
    const bf16_t* XN = (const bf16_t*)(p.ws + WS_ACT); const bf16_t* UT = (const bf16_t*)(p.ws + WS_TAB); const bf16_t* VT = UT + (size_t)NEXP * DM;
    const int* ids = (const int*)(p.ws + WS_IDS); const float* gg = (const float*)(p.ws + WS_G);
    for (int m = c.gwave; m < M; m += c.gwaves) {
        float x[16], o[16];
        { const u32x4 a = *((const u32x4*)(XN + (size_t)m * DM) + c.lane), b = *((const u32x4*)(XN + (size_t)m * DM + 512) + c.lane);
          x[0] = bflo(a.x); x[1] = bfhi(a.x); x[2] = bflo(a.y); x[3] = bfhi(a.y); x[4] = bflo(a.z); x[5] = bfhi(a.z); x[6] = bflo(a.w); x[7] = bfhi(a.w);
          x[8] = bflo(b.x); x[9] = bfhi(b.x); x[10] = bflo(b.y); x[11] = bfhi(b.y); x[12] = bflo(b.z); x[13] = bfhi(b.z); x[14] = bflo(b.w); x[15] = bfhi(b.w); }
#pragma unroll
        for (int i = 0; i < 16; ++i) o[i] = 0.f;
        const int id0 = ids[(size_t)m * 128 + c.lane], id1 = ids[(size_t)m * 128 + 64 + c.lane];
        const float g0 = gg[(size_t)m * 128 + c.lane], g1 = gg[(size_t)m * 128 + 64 + c.lane];
        for (int k0 = 0; k0 < 128; k0 += 4) {
            u32x4 ua[4], ub[4], va[4], vb[4]; float gk[4];
#pragma unroll
            for (int j = 0; j < 4; ++j) { const int k = k0 + j; const int id = (k < 64) ? __shfl(id0, k) : __shfl(id1, k - 64); gk[j] = (k < 64) ? __shfl(g0, k) : __shfl(g1, k - 64);
                const u32x4* ur = (const u32x4*)(UT + (size_t)id * DM); const u32x4* vr = (const u32x4*)(VT + (size_t)id * DM);
                ua[j] = ur[c.lane]; ub[j] = ur[64 + c.lane]; va[j] = vr[c.lane]; vb[j] = vr[64 + c.lane]; }
#pragma unroll
            for (int j = 0; j < 4; ++j) {
                float d = x[0] * bflo(ua[j].x) + x[1] * bfhi(ua[j].x) + x[2] * bflo(ua[j].y) + x[3] * bfhi(ua[j].y) + x[4] * bflo(ua[j].z) + x[5] * bfhi(ua[j].z) + x[6] * bflo(ua[j].w) + x[7] * bfhi(ua[j].w)
                        + x[8] * bflo(ub[j].x) + x[9] * bfhi(ub[j].x) + x[10] * bflo(ub[j].y) + x[11] * bfhi(ub[j].y) + x[12] * bflo(ub[j].z) + x[13] * bfhi(ub[j].z) + x[14] * bflo(ub[j].w) + x[15] * bfhi(ub[j].w);
                d = wave_sum(d);
                const float act = gelu_tanh(d) * gk[j];
                o[0] += act * bflo(va[j].x); o[1] += act * bfhi(va[j].x); o[2] += act * bflo(va[j].y); o[3] += act * bfhi(va[j].y); o[4] += act * bflo(va[j].z); o[5] += act * bfhi(va[j].z); o[6] += act * bflo(va[j].w); o[7] += act * bfhi(va[j].w);
                o[8] += act * bflo(vb[j].x); o[9] += act * bfhi(vb[j].x); o[10] += act * bflo(vb[j].y); o[11] += act * bfhi(vb[j].y); o[12] += act * bflo(vb[j].z); o[13] += act * bfhi(vb[j].z); o[14] += act * bflo(vb[j].w); o[15] += act * bfhi(vb[j].w);
            }
        }
        f32x4* hp = (f32x4*)(p.out + (size_t)m * DM);
        f32x4 h0 = hp[2 * c.lane], h1 = hp[2 * c.lane + 1], h2 = hp[128 + 2 * c.lane], h3 = hp[128 + 2 * c.lane + 1];
        h0 += (f32x4){o[0], o[1], o[2], o[3]}; h1 += (f32x4){o[4], o[5], o[6], o[7]}; h2 += (f32x4){o[8], o[9], o[10], o[11]}; h3 += (f32x4){o[12], o[13], o[14], o[15]};
        hp[2 * c.lane] = h0; hp[2 * c.lane + 1] = h1; hp[128 + 2 * c.lane] = h2; hp[128 + 2 * c.lane + 1] = h3;
    }
}

__device__ __forceinline__ void ph_gather2(const Params& p, const Ctx& c) {
    const bf16_t* XN = (const bf16_t*)(p.ws + WS_ACT); const bf16_t* UT = (const bf16_t*)(p.ws + WS_TAB); const bf16_t* VT = UT + (size_t)NEXP * DM;
    const int* ids = (const int*)(p.ws + WS_IDS); const float* gg = (const float*)(p.ws + WS_G);
    LAS unsigned char* wl = c.lds + c.wave * 4096;
    LAS bf16_t* xs = (LAS bf16_t*)wl; LAS float* dsm = (LAS float*)(wl + 2048);
    const int lane = c.lane, r = lane & 15, q = lane >> 4;
    for (int m = c.gwave; m < M; m += c.gwaves) {
        { const u32x4 xa = *((const u32x4*)(XN + (size_t)m * DM) + lane), xb = *((const u32x4*)(XN + (size_t)m * DM + 512) + lane);
          *((LAS u32x4*)xs + lane) = xa; *((LAS u32x4*)(xs + 512) + lane) = xb; }
        const int id0 = ids[(size_t)m * 128 + lane], id1 = ids[(size_t)m * 128 + 64 + lane];
        const float g0 = gg[(size_t)m * 128 + lane], g1 = gg[(size_t)m * 128 + 64 + lane];
        const char* rowp[8];
#pragma unroll
        for (int g = 0; g < 8; ++g) { const int idg = __shfl(g < 4 ? id0 : id1, 16 * (g & 3) + r); rowp[g] = (const char*)(UT + (size_t)idg * DM) + q * 16; }
        f32x4 acc[8];
#pragma unroll
        for (int g = 0; g < 8; ++g) acc[g] = (f32x4){0.f, 0.f, 0.f, 0.f};
#pragma unroll 1
        for (int kc = 0; kc < 4; ++kc) {
            bf16x8 xb8[8];
#pragma unroll
            for (int s = 0; s < 8; ++s) xb8[s] = *(const LAS bf16x8*)(xs + (kc * 8 + s) * 32 + 8 * q);
#pragma unroll
            for (int g = 0; g < 8; ++g) { bf16x8 a[8];
#pragma unroll
                for (int s = 0; s < 8; ++s) a[s] = *(const bf16x8*)(rowp[g] + (kc * 8 + s) * 64);
#pragma unroll
                for (int s = 0; s < 8; ++s) acc[g] = __builtin_amdgcn_mfma_f32_16x16x32_bf16(a[s], xb8[s], acc[g], 0, 0, 0); }
        }
#pragma unroll
        for (int g = 0; g < 8; ++g) if (r == 0) *(LAS f32x4*)(dsm + 16 * g + 4 * q) = acc[g];
        const float d0 = dsm[lane], d1 = dsm[64 + lane];
        const int act0 = __builtin_bit_cast(int, gelu_tanh(d0) * g0), act1 = __builtin_bit_cast(int, gelu_tanh(d1) * g1);
        float o[16];
#pragma unroll
        for (int i = 0; i < 16; ++i) o[i] = 0.f;
#pragma unroll
        for (int hh = 0; hh < 2; ++hh) { const int idv = hh ? id1 : id0; const int actv = hh ? act1 : act0;
#pragma unroll 1
            for (int e0 = 0; e0 < 64; e0 += 8) {
                u32x4 va[8], vb[8]; float ae[8];
#pragma unroll
                for (int j = 0; j < 8; ++j) { const int id = __builtin_amdgcn_readlane(idv, e0 + j); ae[j] = __builtin_bit_cast(float, __builtin_amdgcn_readlane(actv, e0 + j));
                    const u32x4* vr = (const u32x4*)(VT + (size_t)id * DM); va[j] = vr[lane]; vb[j] = vr[64 + lane]; }
#pragma unroll
                for (int j = 0; j < 8; ++j) { const float act = ae[j];
                    o[0] += act * bflo(va[j].x); o[1] += act * bfhi(va[j].x); o[2] += act * bflo(va[j].y); o[3] += act * bfhi(va[j].y); o[4] += act * bflo(va[j].z); o[5] += act * bfhi(va[j].z); o[6] += act * bflo(va[j].w); o[7] += act * bfhi(va[j].w);
                    o[8] += act * bflo(vb[j].x); o[9] += act * bfhi(vb[j].x); o[10] += act * bflo(vb[j].y); o[11] += act * bfhi(vb[j].y); o[12] += act * bflo(vb[j].z); o[13] += act * bfhi(vb[j].z); o[14] += act * bflo(vb[j].w); o[15] += act * bfhi(vb[j].w); }
            } }
        f32x4* hp = (f32x4*)(p.out + (size_t)m * DM);
        f32x4 h0 = hp[2 * lane], h1 = hp[2 * lane + 1], h2 = hp[128 + 2 * lane], h3 = hp[128 + 2 * lane + 1];
        h0 += (f32x4){o[0], o[1], o[2], o[3]}; h1 += (f32x4){o[4], o[5], o[6], o[7]}; h2 += (f32x4){o[8], o[9], o[10], o[11]}; h3 += (f32x4){o[12], o[13], o[14], o[15]};
        hp[2 * lane] = h0; hp[2 * lane + 1] = h1; hp[128 + 2 * lane] = h2; hp[128 + 2 * lane + 1] = h3;
    }
}

__device__ __forceinline__ float wave_max(float v) {
#pragma unroll
    for (int o = 1; o < 64; o <<= 1) v = fmaxf(v, __shfl_xor(v, o));
    return v;
}
__device__ __forceinline__ void cvt_fp8_rows(const float* src, unsigned char* dst, float* scl, int nrows, const Ctx& c) {
    for (int row = c.gwave; row < nrows; row += c.gwaves) {
        const f32x4* sp = (const f32x4*)(src + (size_t)row * DM) + 4 * c.lane; f32x4 v[4]; float mx = 0.f;
#pragma unroll
        for (int j = 0; j < 4; ++j) { v[j] = sp[j]; mx = fmaxf(mx, fmaxf(fmaxf(fabsf(v[j].x), fabsf(v[j].y)), fmaxf(fabsf(v[j].z), fabsf(v[j].w)))); }
        mx = wave_max(mx);
        const float sc = mx > 0.f ? mx * (1.f / 416.f) : 1.f, inv = 1.f / sc;
        u32x4 w; int t;
        t = __builtin_amdgcn_cvt_pk_fp8_f32(v[0].x * inv, v[0].y * inv, 0, false); t = __builtin_amdgcn_cvt_pk_fp8_f32(v[0].z * inv, v[0].w * inv, t, true); w.x = (unsigned)t;
        t = __builtin_amdgcn_cvt_pk_fp8_f32(v[1].x * inv, v[1].y * inv, 0, false); t = __builtin_amdgcn_cvt_pk_fp8_f32(v[1].z * inv, v[1].w * inv, t, true); w.y = (unsigned)t;
        t = __builtin_amdgcn_cvt_pk_fp8_f32(v[2].x * inv, v[2].y * inv, 0, false); t = __builtin_amdgcn_cvt_pk_fp8_f32(v[2].z * inv, v[2].w * inv, t, true); w.z = (unsigned)t;
        t = __builtin_amdgcn_cvt_pk_fp8_f32(v[3].x * inv, v[3].y * inv, 0, false); t = __builtin_amdgcn_cvt_pk_fp8_f32(v[3].z * inv, v[3].w * inv, t, true); w.w = (unsigned)t;
        *(u32x4*)(dst + (size_t)(c.lane >> 3) * NEXP * 128 + (size_t)row * 128 + (c.lane & 7) * 16) = w;
        if (c.lane == 0) scl[row] = sc;
    }
}
typedef float f32x2 __attribute__((ext_vector_type(2)));
__device__ __forceinline__ void cvt_fp8_roundtrip_rows(const float* src, bf16_t* dst, int nrows, const Ctx& c) {
    for (int row = c.gwave; row < nrows; row += c.gwaves) {
        const f32x4* sp = (const f32x4*)(src + (size_t)row * DM) + 4 * c.lane; f32x4 v[4]; float mx = 0.f;
#pragma unroll
        for (int j = 0; j < 4; ++j) { v[j] = sp[j]; mx = fmaxf(mx, fmaxf(fmaxf(fabsf(v[j].x), fabsf(v[j].y)), fmaxf(fabsf(v[j].z), fabsf(v[j].w)))); }
        mx = wave_max(mx);
        const float sc = mx > 0.f ? mx * (1.f / 416.f) : 1.f, inv = 1.f / sc;
        u32x4 o0, o1;
#pragma unroll
        for (int j = 0; j < 4; ++j) { int t = __builtin_amdgcn_cvt_pk_fp8_f32(v[j].x * inv, v[j].y * inv, 0, false); t = __builtin_amdgcn_cvt_pk_fp8_f32(v[j].z * inv, v[j].w * inv, t, true);
            const f32x2 a = __builtin_amdgcn_cvt_pk_f32_fp8(t, false), b = __builtin_amdgcn_cvt_pk_f32_fp8(t, true);
            const unsigned lo = pk2(a.x * sc, a.y * sc), hi = pk2(b.x * sc, b.y * sc);
            if (j == 0) { o0.x = lo; o0.y = hi; } else if (j == 1) { o0.z = lo; o0.w = hi; } else if (j == 2) { o1.x = lo; o1.y = hi; } else { o1.z = lo; o1.w = hi; } }
        u32x4* dp = (u32x4*)(dst + (size_t)row * DM) + 2 * c.lane; dp[0] = o0; dp[1] = o1;
    }
}
__device__ __forceinline__ u32x2 fp8x4_to_bf16x4(unsigned w) {
    const f32x2 a = __builtin_amdgcn_cvt_pk_f32_fp8((int)w, false), b = __builtin_amdgcn_cvt_pk_f32_fp8((int)w, true);
    u32x2 o;
    asm("v_cvt_pk_bf16_f32 %0, %1, %2" : "=v"(o.x) : "v"(a.x), "v"(a.y));
    asm("v_cvt_pk_bf16_f32 %0, %1, %2" : "=v"(o.y) : "v"(b.x), "v"(b.y));
    return o;
}
__device__ __forceinline__ void ph_gather3(const Params& p, int layer, const Ctx& c, float* hdst) {
    const bf16_t* XN = (const bf16_t*)(p.ws + WS_ACT);
    const unsigned char* UT = p.ws + WS_TAB8 + (size_t)layer * 2 * NEXP * DM; const unsigned char* VT = UT + (size_t)NEXP * DM;
    const float* SU = (const float*)(p.ws + WS_SCL) + (size_t)layer * 2 * NEXP; const float* SV = SU + NEXP;
    const int* ids = (const int*)(p.ws + WS_IDS); const float* gg = (const float*)(p.ws + WS_G);
    LAS unsigned char* wl = c.lds + c.wave * 4096;
    LAS bf16_t* xs = (LAS bf16_t*)wl; LAS float* dsm = (LAS float*)(wl + 2048);
    const int lane = c.lane, r = lane & 15, q = lane >> 4;
    for (int m = c.gwave; m < M; m += c.gwaves) {
        { const u32x4 xa = *((const u32x4*)(XN + (size_t)m * DM) + lane), xb = *((const u32x4*)(XN + (size_t)m * DM + 512) + lane);
          asm volatile("" ::: "memory"); *((LAS u32x4*)xs + lane) = xa; *((LAS u32x4*)(xs + 512) + lane) = xb; asm volatile("" ::: "memory"); }
        const int id0 = ids[(size_t)m * 128 + lane], id1 = ids[(size_t)m * 128 + 64 + lane];
#ifdef PROBE_VF32
        const float g0 = gg[(size_t)m * 128 + lane], g1 = gg[(size_t)m * 128 + 64 + lane];
#else
        const float g0 = gg[(size_t)m * 128 + lane] * SV[id0], g1 = gg[(size_t)m * 128 + 64 + lane] * SV[id1];
#endif
        const float su0 = SU[id0], su1 = SU[id1];
#pragma unroll 1
        for (int gp = 0; gp < 4; ++gp) {
            const int idsel = gp < 2 ? id0 : id1;
            const int ida = __shfl(idsel, (gp & 1) * 32 + r), idb = __shfl(idsel, (gp & 1) * 32 + 16 + r);
            const unsigned char* rowa = UT + (size_t)ida * DM + q * 16; const unsigned char* rowb = UT + (size_t)idb * DM + q * 16;
            f32x4 acca = {0.f, 0.f, 0.f, 0.f}, accb = {0.f, 0.f, 0.f, 0.f};
#pragma unroll 1
            for (int kc = 0; kc < 4; ++kc) {
                u32x4 a[4], bb[4];
#pragma unroll
                for (int s = 0; s < 4; ++s) { a[s] = *(const u32x4*)(rowa + (kc * 4 + s) * 64); bb[s] = *(const u32x4*)(rowb + (kc * 4 + s) * 64); }
                bf16x8 xb8[8];
#pragma unroll
                for (int s = 0; s < 4; ++s) { xb8[2 * s] = __builtin_bit_cast(bf16x8, *(const LAS u32x4*)(xs + (kc * 4 + s) * 64 + 16 * q)); xb8[2 * s + 1] = __builtin_bit_cast(bf16x8, *(const LAS u32x4*)(xs + (kc * 4 + s) * 64 + 16 * q + 8)); }
#pragma unroll
                for (int s = 0; s < 4; ++s) {
                    { const u32x2 c0 = fp8x4_to_bf16x4(a[s].x), c1 = fp8x4_to_bf16x4(a[s].y), c2 = fp8x4_to_bf16x4(a[s].z), c3 = fp8x4_to_bf16x4(a[s].w); const u32x4 b0 = {c0.x, c0.y, c1.x, c1.y}, b1 = {c2.x, c2.y, c3.x, c3.y};
                      acca = __builtin_amdgcn_mfma_f32_16x16x32_bf16(__builtin_bit_cast(bf16x8, b0), xb8[2 * s], acca, 0, 0, 0);
                      acca = __builtin_amdgcn_mfma_f32_16x16x32_bf16(__builtin_bit_cast(bf16x8, b1), xb8[2 * s + 1], acca, 0, 0, 0); }
                    { const u32x2 c0 = fp8x4_to_bf16x4(bb[s].x), c1 = fp8x4_to_bf16x4(bb[s].y), c2 = fp8x4_to_bf16x4(bb[s].z), c3 = fp8x4_to_bf16x4(bb[s].w); const u32x4 b0 = {c0.x, c0.y, c1.x, c1.y}, b1 = {c2.x, c2.y, c3.x, c3.y};
                      accb = __builtin_amdgcn_mfma_f32_16x16x32_bf16(__builtin_bit_cast(bf16x8, b0), xb8[2 * s], accb, 0, 0, 0);
                      accb = __builtin_amdgcn_mfma_f32_16x16x32_bf16(__builtin_bit_cast(bf16x8, b1), xb8[2 * s + 1], accb, 0, 0, 0); }
                    __builtin_amdgcn_sched_barrier(0); }
            }
            if (r == 0) { *(LAS f32x4*)(dsm + 32 * gp + 4 * q) = acca; *(LAS f32x4*)(dsm + 32 * gp + 16 + 4 * q) = accb; }
        }
        asm volatile("" ::: "memory");
        const float d0 = dsm[lane] * su0, d1 = dsm[64 + lane] * su1;
        asm volatile("" ::: "memory");
        const int act0 = __builtin_bit_cast(int, gelu_tanh(d0) * g0), act1 = __builtin_bit_cast(int, gelu_tanh(d1) * g1);
        float o[16];
#pragma unroll
        for (int i = 0; i < 16; ++i) o[i] = 0.f;
#pragma unroll
        for (int hh = 0; hh < 2; ++hh) { const int idv = hh ? id1 : id0; const int actv = hh ? act1 : act0;
#ifdef PROBE_VF32
#pragma unroll 1
            for (int e0 = 0; e0 < 64; ++e0) { const int id = __builtin_amdgcn_readlane(idv, e0); const float act = __builtin_bit_cast(float, __builtin_amdgcn_readlane(actv, e0));
                const f32x4* vr = (const f32x4*)(p.peer_v + ((size_t)layer * NEXP + id) * DM) + 4 * lane; const f32x4 v0 = vr[0], v1 = vr[1], v2 = vr[2], v3 = vr[3];
                o[0] += act * v0.x; o[1] += act * v0.y; o[2] += act * v0.z; o[3] += act * v0.w; o[4] += act * v1.x; o[5] += act * v1.y; o[6] += act * v1.z; o[7] += act * v1.w;
                o[8] += act * v2.x; o[9] += act * v2.y; o[10] += act * v2.z; o[11] += act * v2.w; o[12] += act * v3.x; o[13] += act * v3.y; o[14] += act * v3.z; o[15] += act * v3.w; } }
#else
#pragma unroll 1
            for (int e0 = 0; e0 < 64; e0 += 16) {
                u32x4 va[16]; float ae[16];
#pragma unroll
                for (int j = 0; j < 16; ++j) { const int id = __builtin_amdgcn_readlane(idv, e0 + j); ae[j] = __builtin_bit_cast(float, __builtin_amdgcn_readlane(actv, e0 + j));
                    va[j] = *((const u32x4*)(VT + (size_t)id * DM) + lane); }
#pragma unroll
                for (int j = 0; j < 16; ++j) { const float act = ae[j];
                    f32x2 t;
                    t = __builtin_amdgcn_cvt_pk_f32_fp8((int)va[j].x, false); o[0] += act * t.x; o[1] += act * t.y; t = __builtin_amdgcn_cvt_pk_f32_fp8((int)va[j].x, true); o[2] += act * t.x; o[3] += act * t.y;
                    t = __builtin_amdgcn_cvt_pk_f32_fp8((int)va[j].y, false); o[4] += act * t.x; o[5] += act * t.y; t = __builtin_amdgcn_cvt_pk_f32_fp8((int)va[j].y, true); o[6] += act * t.x; o[7] += act * t.y;
                    t = __builtin_amdgcn_cvt_pk_f32_fp8((int)va[j].z, false); o[8] += act * t.x; o[9] += act * t.y; t = __builtin_amdgcn_cvt_pk_f32_fp8((int)va[j].z, true); o[10] += act * t.x; o[11] += act * t.y;
                    t = __builtin_amdgcn_cvt_pk_f32_fp8((int)va[j].w, false); o[12] += act * t.x; o[13] += act * t.y; t = __builtin_amdgcn_cvt_pk_f32_fp8((int)va[j].w, true); o[14] += act * t.x; o[15] += act * t.y; }
            } }
#endif
        f32x4* hp = (f32x4*)(p.out + (size_t)m * DM) + 4 * lane;
        f32x4 h0 = hp[0], h1 = hp[1], h2 = hp[2], h3 = hp[3];
        h0 += (f32x4){o[0], o[1], o[2], o[3]}; h1 += (f32x4){o[4], o[5], o[6], o[7]}; h2 += (f32x4){o[8], o[9], o[10], o[11]}; h3 += (f32x4){o[12], o[13], o[14], o[15]};
        f32x4* hq = (f32x4*)(hdst + (size_t)m * DM) + 4 * lane; hq[0] = h0; hq[1] = h1; hq[2] = h2; hq[3] = h3;
    }
}


constexpr size_t WS_PD = WS_S;
constexpr size_t WS_ACTB = WS_S + 224 * MiB;
struct XI { int xr, nx, jr, nloc; };
typedef long i64_t;
__device__ __forceinline__ i64_t pack64(unsigned lo, unsigned hi) { return (i64_t)(((unsigned long long)hi << 32) | lo); }
__device__ __forceinline__ void peer_u_half(const u32x4 (&v)[8], const i64_t (&xh)[4], const i64_t (&xl)[4], LAS unsigned char* img, LAS float* pdp, int lane) {
    const int e8 = lane >> 3, cc = lane & 7, r = lane & 15, q = lane >> 4;
#pragma unroll
    for (int j = 0; j < 8; ++j) *(LAS u32x4*)(img + (8 * e8 + j) * 128 + ((cc ^ j) << 4)) = v[j];
    asm volatile("" ::: "memory");
#pragma unroll
    for (int g = 0; g < 4; ++g) { f32x4 ah = {0.f, 0.f, 0.f, 0.f}, al = {0.f, 0.f, 0.f, 0.f}; const int row = 16 * g + r;
#pragma unroll
        for (int s4 = 0; s4 < 4; ++s4) { const i64_t w = *(const LAS i64_t*)(img + row * 128 + (((2 * s4 + (q >> 1)) ^ (row & 7)) << 4) + 8 * (q & 1));
            ah = __builtin_amdgcn_mfma_f32_16x16x32_fp8_fp8(w, xh[s4], ah, 0, 0, 0); al = __builtin_amdgcn_mfma_f32_16x16x32_fp8_fp8(w, xl[s4], al, 0, 0, 0); }
        if (r == 0) *(LAS f32x4*)(pdp + 16 * g + 4 * q) = ah + al * 0.0625f; }
    asm volatile("" ::: "memory");
}
__device__ __forceinline__ void split_x8(const u32x4 xv, i64_t& xh, i64_t& xl) {
    const float f[8] = {bflo(xv.x), bfhi(xv.x), bflo(xv.y), bfhi(xv.y), bflo(xv.z), bfhi(xv.z), bflo(xv.w), bfhi(xv.w)};
    int h0 = __builtin_amdgcn_cvt_pk_fp8_f32(f[0], f[1], 0, false); h0 = __builtin_amdgcn_cvt_pk_fp8_f32(f[2], f[3], h0, true);
    int h1 = __builtin_amdgcn_cvt_pk_fp8_f32(f[4], f[5], 0, false); h1 = __builtin_amdgcn_cvt_pk_fp8_f32(f[6], f[7], h1, true);
    const f32x2 d0 = __builtin_amdgcn_cvt_pk_f32_fp8(h0, false), d1 = __builtin_amdgcn_cvt_pk_f32_fp8(h0, true), d2 = __builtin_amdgcn_cvt_pk_f32_fp8(h1, false), d3 = __builtin_amdgcn_cvt_pk_f32_fp8(h1, true);
    int l0 = __builtin_amdgcn_cvt_pk_fp8_f32((f[0] - d0.x) * 16.f, (f[1] - d0.y) * 16.f, 0, false); l0 = __builtin_amdgcn_cvt_pk_fp8_f32((f[2] - d1.x) * 16.f, (f[3] - d1.y) * 16.f, l0, true);
    int l1 = __builtin_amdgcn_cvt_pk_fp8_f32((f[4] - d2.x) * 16.f, (f[5] - d2.y) * 16.f, 0, false); l1 = __builtin_amdgcn_cvt_pk_fp8_f32((f[6] - d3.x) * 16.f, (f[7] - d3.y) * 16.f, l1, true);
    xh = pack64((unsigned)h0, (unsigned)h1); xl = pack64((unsigned)l0, (unsigned)l1);
}
__device__ __forceinline__ void ph_peer_u(const Params& p, int layer, const Ctx& c, const XI xi, int idmask) {
    const bf16_t* XN = (const bf16_t*)(p.ws + WS_ACT); const unsigned char* UT = p.ws + WS_TAB8 + (size_t)layer * 2 * NEXP * DM;
    const int* ids = (const int*)(p.ws + WS_IDS); bf16_t* PDh = (bf16_t*)(p.ws + WS_PD);
    const int lane = c.lane, e8 = lane >> 3, cc = lane & 7, q = lane >> 4;
    const int tstep = xi.nloc * NWAVES;
    LAS unsigned char* img = c.lds + c.wave * 8192; LAS float* stg = (LAS float*)(c.lds + 65536 + c.wave * 512);
#pragma unroll 1
    for (int sl = xi.xr; sl < 8; sl += xi.nx) {
        const unsigned char* Us = UT + (size_t)sl * NEXP * 128; const unsigned uo = 16u * (unsigned)cc;
        int t = xi.jr * NWAVES + c.wave;
        if (t >= M) continue;
#define PU_LD(k) ((idmask & 0x10000) ? (u32x4){(unsigned)(k), (unsigned)(k), uo, uo} : *(const u32x4*)(Us + (((unsigned)((k) & (idmask & 0xffff)) << 7) + uo)))
#define PU_ROWS(dst, ia, ib) do { dst[0] = PU_LD((ia).x); dst[1] = PU_LD((ia).y); dst[2] = PU_LD((ia).z); dst[3] = PU_LD((ia).w); dst[4] = PU_LD((ib).x); dst[5] = PU_LD((ib).y); dst[6] = PU_LD((ib).z); dst[7] = PU_LD((ib).w); } while (0)
#define PU_X(tt) do { const bf16_t* xp = XN + (size_t)(tt) * DM + 128 * sl + 8 * q; xv[0] = *(const u32x4*)xp; xv[1] = *(const u32x4*)(xp + 32); xv[2] = *(const u32x4*)(xp + 64); xv[3] = *(const u32x4*)(xp + 96); } while (0)
#define PU_SPLIT() do { _Pragma("unroll") for (int k_ = 0; k_ < 4; ++k_) split_x8(xv[k_], xh[k_], xl[k_]); } while (0)
        u32x4 v[8], vn[8], xv[4]; i64_t xh[4], xl[4]; i32x4 ic2, ic3;
        { const i32x4* ip = (const i32x4*)(ids + (size_t)t * 128 + 8 * e8); const i32x4 i0 = ip[0], i1 = ip[1]; ic2 = ip[16]; ic3 = ip[17]; PU_ROWS(v, i0, i1); PU_X(t); }
#pragma unroll 1
        for (; t < M; t += tstep) {
            const int tn = min(t + tstep, M - 1);
            const i32x4* ipn = (const i32x4*)(ids + (size_t)tn * 128 + 8 * e8); const i32x4 in0 = ipn[0], in1 = ipn[1], in2 = ipn[16], in3 = ipn[17];
            PU_ROWS(vn, ic2, ic3);
            PU_SPLIT();
            __builtin_amdgcn_sched_barrier(0);
            if (!(idmask & 0x20000)) peer_u_half(v, xh, xl, img, stg, lane); else { _Pragma("unroll") for (int j_ = 0; j_ < 8; ++j_) asm volatile("" :: "v"(v[j_])); }
#pragma unroll
            for (int j = 0; j < 8; ++j) v[j] = vn[j];
            PU_ROWS(vn, in0, in1);
            __builtin_amdgcn_sched_barrier(0);
            if (!(idmask & 0x20000)) peer_u_half(v, xh, xl, img, stg + 64, lane); else { _Pragma("unroll") for (int j_ = 0; j_ < 8; ++j_) asm volatile("" :: "v"(v[j_])); }
#pragma unroll
            for (int j = 0; j < 8; ++j) v[j] = vn[j];
            ic2 = in2; ic3 = in3;
            asm volatile("" ::: "memory");
            { const f32x2 pv = *(const LAS f32x2*)(stg + 2 * lane); *(unsigned*)(PDh + ((size_t)sl * M + t) * 128 + 2 * lane) = pk2(pv.x, pv.y); }
            asm volatile("" ::: "memory");
            PU_X(tn);
        }
#undef PU_LD
#undef PU_ROWS
#undef PU_X
#undef PU_SPLIT
    }
}
__device__ __forceinline__ void ph_peer_act(const Params& p, int layer, const Ctx& c) {
    const bf16_t* PDh = (const bf16_t*)(p.ws + WS_PD); float* ACTB = (float*)(p.ws + WS_ACTB);
    const float* SU = (const float*)(p.ws + WS_SCL) + (size_t)layer * 2 * NEXP; const float* SV = SU + NEXP;
    const int* ids = (const int*)(p.ws + WS_IDS); const float* gg = (const float*)(p.ws + WS_G);
    for (int idx = c.gtid; idx < M * 128; idx += c.gthreads) { float d = 0.f;
#pragma unroll
        for (int sl = 0; sl < 8; ++sl) d += bf2f(PDh[(size_t)sl * M * 128 + idx]);
        const int id = ids[idx]; ACTB[idx] = gelu_tanh(d * SU[id]) * gg[idx] * SV[id]; }
}
#define PIN16(o) asm volatile("" : "+v"(o[0]), "+v"(o[1]), "+v"(o[2]), "+v"(o[3]), "+v"(o[4]), "+v"(o[5]), "+v"(o[6]), "+v"(o[7]), "+v"(o[8]), "+v"(o[9]), "+v"(o[10]), "+v"(o[11]), "+v"(o[12]), "+v"(o[13]), "+v"(o[14]), "+v"(o[15]))
__device__ __forceinline__ void peer_v_half(const u32x4 (&vin)[8], const f32x4& a0, const f32x4& a1, float (&o)[16]) {
#pragma unroll
    for (int j = 0; j < 8; ++j) { const float act = (j < 4) ? a0[j & 3] : a1[j & 3]; f32x2 tt; u32x4 vr = vin[j];
        asm volatile("" : "+v"(vr.x), "+v"(vr.y), "+v"(vr.z), "+v"(vr.w));
        tt = __builtin_amdgcn_cvt_pk_f32_fp8((int)vr.x, false); o[0] += act * tt.x; o[1] += act * tt.y; tt = __builtin_amdgcn_cvt_pk_f32_fp8((int)vr.x, true); o[2] += act * tt.x; o[3] += act * tt.y;
        tt = __builtin_amdgcn_cvt_pk_f32_fp8((int)vr.y, false); o[4] += act * tt.x; o[5] += act * tt.y; tt = __builtin_amdgcn_cvt_pk_f32_fp8((int)vr.y, true); o[6] += act * tt.x; o[7] += act * tt.y;
        tt = __builtin_amdgcn_cvt_pk_f32_fp8((int)vr.z, false); o[8] += act * tt.x; o[9] += act * tt.y; tt = __builtin_amdgcn_cvt_pk_f32_fp8((int)vr.z, true); o[10] += act * tt.x; o[11] += act * tt.y;
        tt = __builtin_amdgcn_cvt_pk_f32_fp8((int)vr.w, false); o[12] += act * tt.x; o[13] += act * tt.y; tt = __builtin_amdgcn_cvt_pk_f32_fp8((int)vr.w, true); o[14] += act * tt.x; o[15] += act * tt.y;
        PIN16(o); }
}
__device__ __forceinline__ void ph_peer_v(const Params& p, int layer, const Ctx& c, const XI xi, float* hdst, int idmask) {
    const unsigned char* VT = p.ws + WS_TAB8 + (size_t)layer * 2 * NEXP * DM + (size_t)NEXP * DM;
    const int* ids = (const int*)(p.ws + WS_IDS); const float* ACTB = (const float*)(p.ws + WS_ACTB);
    const int lane = c.lane, e8 = lane >> 3, cc = lane & 7;
    const int tstep = xi.nloc * NWAVES;
    const bool b5 = (lane & 32) != 0, b4 = (lane & 16) != 0, b3 = (lane & 8) != 0;
#pragma unroll 1
    for (int sl = xi.xr; sl < 8; sl += xi.nx) {
        const unsigned char* Vs = VT + (size_t)sl * NEXP * 128; const unsigned vo = 16u * (unsigned)cc;
        int t = xi.jr * NWAVES + c.wave;
        if (t >= M) continue;
#define PV_LD(k) ((idmask & 0x10000) ? (u32x4){(unsigned)(k), (unsigned)(k), vo, vo} : *(const u32x4*)(Vs + (((unsigned)((k) & (idmask & 0xffff)) << 7) + vo)))
#define PV_ROWS(dst, ia, ib) do { dst[0] = PV_LD((ia).x); dst[1] = PV_LD((ia).y); dst[2] = PV_LD((ia).z); dst[3] = PV_LD((ia).w); dst[4] = PV_LD((ib).x); dst[5] = PV_LD((ib).y); dst[6] = PV_LD((ib).z); dst[7] = PV_LD((ib).w); } while (0)
        u32x4 v[8], vn[8]; f32x4 av[4]; f32x2 hv; i32x4 ic2, ic3;
        { const i32x4* ip = (const i32x4*)(ids + (size_t)t * 128 + 16 * e8); const i32x4 i0 = ip[0], i1 = ip[1]; ic2 = ip[2]; ic3 = ip[3]; PV_ROWS(v, i0, i1);
          const f32x4* ap = (const f32x4*)(ACTB + (size_t)t * 128 + 16 * e8); av[0] = ap[0]; av[1] = ap[1]; av[2] = ap[2]; av[3] = ap[3];
          hv = *(const f32x2*)(p.out + (size_t)t * DM + 128 * sl + 16 * cc + 2 * e8); }
#pragma unroll 1
        for (; t < M; t += tstep) {
            const int tn = min(t + tstep, M - 1);
            const i32x4* ipn = (const i32x4*)(ids + (size_t)tn * 128 + 16 * e8); const i32x4 in0 = ipn[0], in1 = ipn[1], in2 = ipn[2], in3 = ipn[3];
            float o[16];
#pragma unroll
            for (int i = 0; i < 16; ++i) o[i] = 0.f;
            PV_ROWS(vn, ic2, ic3);
            __builtin_amdgcn_sched_barrier(0);
            if (!(idmask & 0x20000)) peer_v_half(v, av[0], av[1], o); else { _Pragma("unroll") for (int j_ = 0; j_ < 8; ++j_) asm volatile("" :: "v"(v[j_])); }
            __builtin_amdgcn_sched_barrier(0);
#pragma unroll
            for (int j = 0; j < 8; ++j) v[j] = vn[j];
            PV_ROWS(vn, in0, in1);
            __builtin_amdgcn_sched_barrier(0);
            if (!(idmask & 0x20000)) peer_v_half(v, av[2], av[3], o); else { _Pragma("unroll") for (int j_ = 0; j_ < 8; ++j_) asm volatile("" :: "v"(v[j_])); }
            __builtin_amdgcn_sched_barrier(0);
#pragma unroll
            for (int j = 0; j < 8; ++j) v[j] = vn[j];
            ic2 = in2; ic3 = in3;
#pragma unroll
            for (int i = 0; i < 8; ++i) { const float keep = b5 ? o[i + 8] : o[i], send = b5 ? o[i] : o[i + 8]; o[i] = keep + __shfl_xor(send, 32); }
#pragma unroll
            for (int i = 0; i < 4; ++i) { const float keep = b4 ? o[i + 4] : o[i], send = b4 ? o[i] : o[i + 4]; o[i] = keep + __shfl_xor(send, 16); }
#pragma unroll
            for (int i = 0; i < 2; ++i) { const float keep = b3 ? o[i + 2] : o[i], send = b3 ? o[i] : o[i + 2]; o[i] = keep + __shfl_xor(send, 8); }
            hv.x += o[0]; hv.y += o[1]; *(f32x2*)(hdst + (size_t)t * DM + 128 * sl + 16 * cc + 2 * e8) = hv;
            { const f32x4* ap = (const f32x4*)(ACTB + (size_t)tn * 128 + 16 * e8); av[0] = ap[0]; av[1] = ap[1]; av[2] = ap[2]; av[3] = ap[3];
              hv = *(const f32x2*)(p.out + (size_t)tn * DM + 128 * sl + 16 * cc + 2 * e8); }
        }
#undef PV_ROWS
#undef PV_LD
    }
}

__device__ __forceinline__ void ph_g1(const Params& p, const Ctx& c) {
    const bf16_t* proj = (const bf16_t*)(p.ws + WS_PROJ); bf16_t* xc = (bf16_t*)(p.ws + WS_XC);
    for (size_t idx = c.gtid; idx < (size_t)M * DM; idx += c.gthreads) {
        const int ch = (int)(idx & 1023); const int row = (int)(idx >> 10); const int t = row & (SEQ - 1);
        float a = p.c_conv_b[ch];
#pragma unroll
        for (int j = 0; j < 4; ++j) { const int tt = t - 3 + j; if (tt >= 0) a += p.c_conv_w[j * 1024 + ch] * bf2f(proj[(size_t)(row - 3 + j) * 2048 + 1024 + ch]); }
        xc[idx] = (bf16_t)f2bf(a);
    }
}
__device__ __forceinline__ void ph_g2(const Params& p, const Ctx& c) {
    const bf16_t* xc = (const bf16_t*)(p.ws + WS_XC); float* A = (float*)(p.ws + WS_A); float* U = (float*)(p.ws + WS_U);
    for (size_t idx = c.gtid; idx < (size_t)M * DM; idx += c.gthreads) {
        const int ch = (int)(idx & 1023); const size_t row = idx >> 10; const int g = ch >> 7, j = ch & 127;
        const bf16_t* xr = xc + row * DM + g * 128; const float* wr = p.c_w_rgate + (size_t)g * 16384 + j; const float* wi = p.c_w_igate + (size_t)g * 16384 + j;
        float ar = p.c_b_rgate[ch], ai = p.c_b_igate[ch];
        for (int i = 0; i < 128; i += 8) { const u32x4 w = *(const u32x4*)(xr + i);
            const float x0 = bflo(w.x), x1 = bfhi(w.x), x2 = bflo(w.y), x3 = bfhi(w.y), x4 = bflo(w.z), x5 = bfhi(w.z), x6 = bflo(w.w), x7 = bfhi(w.w);
            ar += x0 * wr[(i) * 128] + x1 * wr[(i + 1) * 128] + x2 * wr[(i + 2) * 128] + x3 * wr[(i + 3) * 128] + x4 * wr[(i + 4) * 128] + x5 * wr[(i + 5) * 128] + x6 * wr[(i + 6) * 128] + x7 * wr[(i + 7) * 128];
            ai += x0 * wi[(i) * 128] + x1 * wi[(i + 1) * 128] + x2 * wi[(i + 2) * 128] + x3 * wi[(i + 3) * 128] + x4 * wi[(i + 4) * 128] + x5 * wi[(i + 5) * 128] + x6 * wi[(i + 6) * 128] + x7 * wi[(i + 7) * 128]; }
        const float r = sigmoidf_(ar), ig = sigmoidf_(ai);
        const float lam = p.c_lambda[ch]; const float sp = fmaxf(-lam, 0.f) + log1pf(expf(-fabsf(lam)));
        const float la = -8.f * r * sp;
        A[idx] = expf(la); U[idx] = sqrtf(-expm1f(2.f * la)) * (ig * bf2f(xc[idx]));
    }
}
__device__ __forceinline__ void ph_g3(const Params& p, const Ctx& c) {
    const bf16_t* proj = (const bf16_t*)(p.ws + WS_PROJ); const float* A = (const float*)(p.ws + WS_A); const float* U = (const float*)(p.ws + WS_U); bf16_t* y = (bf16_t*)(p.ws + WS_ACT);
    for (int idx = c.gtid; idx < BATCH * DM; idx += c.gthreads) {
        const int b = idx >> 10, ch = idx & 1023; float h = 0.f;
        for (int t0 = 0; t0 < SEQ; t0 += 8) {
            float a[8], u[8], g[8];
#pragma unroll
            for (int j = 0; j < 8; ++j) { const size_t e = (size_t)(b * SEQ + t0 + j) * DM + ch; a[j] = A[e]; u[j] = U[e]; g[j] = bf2f(proj[(size_t)(b * SEQ + t0 + j) * 2048 + ch]); }
#pragma unroll
            for (int j = 0; j < 8; ++j) { h = a[j] * h + u[j]; y[(size_t)(b * SEQ + t0 + j) * DM + ch] = (bf16_t)f2bf(gelu_tanh(g[j]) * h); }
        }
    }
}
#define XB_TMO      128
#define XB_XCNT(j)  (256  + 64 * (j))
#define XB_XSUB(j)  (1280 + 64 * (j))
#define XB_XGEN(j)  (2304 + 64 * (j))
#define XB_TOP      3328
#define XB_TOPGEN   3392
#define XCD_BAR_WORDS 3456
#define XB_SPIN_CAP (1u << 18)

__device__ __forceinline__ unsigned xb_ld(unsigned* p)              { return __hip_atomic_load(p, __ATOMIC_RELAXED, __HIP_MEMORY_SCOPE_AGENT); }
__device__ __forceinline__ unsigned xb_add(unsigned* p, unsigned v) { return __hip_atomic_fetch_add(p, v, __ATOMIC_RELAXED, __HIP_MEMORY_SCOPE_AGENT); }
__device__ __forceinline__ unsigned xb_xcc_id() { return (unsigned)__builtin_amdgcn_s_getreg((3 << 11) | 20) & 0xFu; }
#define XB_SPIN(cond, bar) do { unsigned _sp = 0; while (cond) { __builtin_amdgcn_s_sleep(1); \
    if ((++_sp & 255u) == 0u) { if (xb_ld(&(bar)[XB_TMO])) break; if (_sp > XB_SPIN_CAP) { atomicAdd(&(bar)[XB_TMO], 1u); break; } } } } while (0)

struct XcdBarrier {
    unsigned* bar; unsigned x;
    volatile LAS unsigned* st;
};

__device__ __forceinline__ XcdBarrier xcd_barrier_post(unsigned* bar, volatile LAS unsigned* st) {
    XcdBarrier b; b.bar = bar; b.x = xb_xcc_id(); b.st = st;
    if (threadIdx.x == 0) (void)xb_add(&bar[XB_XCNT(b.x)], 1u);
    return b;
}
__device__ __forceinline__ void xcd_barrier_complete(unsigned* bar, unsigned x, unsigned& nloc, unsigned& nx) {
    const unsigned G = gridDim.x * gridDim.y * gridDim.z;
    unsigned sum, cnt, mine, sp = 0u;
    for (;;) {
        sum = 0u; cnt = 0u; mine = 0u;
#pragma unroll
        for (unsigned j = 0; j < 16; ++j) { const unsigned c = xb_ld(&bar[XB_XCNT(j)]); sum += c; cnt += (c > 0u) ? 1u : 0u; mine = (j == x) ? c : mine; }
        if (sum == G) break;
        __builtin_amdgcn_s_sleep(1);
        if ((++sp & 255u) == 0u) { if (xb_ld(&bar[XB_TMO])) break; if (sp > XB_SPIN_CAP) { atomicAdd(&bar[XB_TMO], 1u); break; } }
    }
    nloc = mine > 0u ? mine : 1u; nx = cnt > 0u ? cnt : 1u;
}

__device__ __forceinline__ void xcd_barrier(const XcdBarrier& b) {
    asm volatile("s_waitcnt vmcnt(0)" ::: "memory");
    __syncthreads();
    if (threadIdx.x == 0) {
        unsigned* bar = b.bar;
        __builtin_amdgcn_s_waitcnt(0);
        unsigned nloc = b.st[0], nx = b.st[1];
        if (nloc == 0u) { xcd_barrier_complete(bar, b.x, nloc, nx); b.st[0] = nloc; b.st[1] = nx; }
        const unsigned old = xb_add(&bar[XB_XSUB(b.x)], 1u);
        const unsigned gen = old / nloc;
        if (old + 1u == (gen + 1u) * nloc) {
            __builtin_amdgcn_fence(__ATOMIC_RELEASE, "agent");
            asm volatile("s_waitcnt vmcnt(0)" ::: "memory");
            const unsigned og = xb_add(&bar[XB_TOP], 1u);
            const unsigned tg = og / nx;
            if (og + 1u == (tg + 1u) * nx) xb_add(&bar[XB_TOPGEN], 1u);
            else XB_SPIN(xb_ld(&bar[XB_TOPGEN]) == tg, bar);
            __builtin_amdgcn_fence(__ATOMIC_ACQUIRE, "agent");
            xb_add(&bar[XB_XGEN(b.x)], 1u);
            asm volatile("s_waitcnt vmcnt(0)" ::: "memory");
        } else {
            XB_SPIN(xb_ld(&bar[XB_XGEN(b.x)]) == gen, bar);
            __builtin_amdgcn_fence(__ATOMIC_ACQUIRE, "agent");
            asm volatile("s_waitcnt vmcnt(0)" ::: "memory");
        }
    }
    __syncthreads();
}

enum Phase { PH_PRO = 0, PH_GEMM_IN0, PH_MIXER0, PH_GLA_B, PH_GLA_C, PH_MIX0, PH_GEMM_OUT0, PH_NORM_F0, PH_GEMM_Q0, PH_TOPK1_0, PH_PU0, PH_PA0, PH_PV0,
             PH_NORM_M1, PH_GEMM_CIN, PH_G1, PH_G2, PH_G3, PH_GEMM_OUT1, PH_NORM_F1, PH_GEMM_Q1, PH_TOPK1_1, PH_PU1, PH_PA1, PH_PV1, PH_FINAL, NPHASES };

#ifndef PH_ONLY
#define PH_ONLY (-1)
#endif
#define PH_ENABLED(x) (PH_ONLY < 0 || PH_ONLY == (x))
#ifndef MK_N_LAUNCHES
#define MK_N_LAUNCHES 1
#endif

template <class Epi> __device__ __forceinline__ void run_gemm(const Ctx& c, const bf16_t* A, const bf16_t* Bt, int N, const Epi& E, int vblk) {
    pg8::Gemm g{A, Bt, M, N, DM}; pg8::StaticOrder S; S.init(M, N, c.nblk, vblk);
    pg8::gemm_phase<Epi, pg8::StaticOrder, true, true>(c.lds, g, S, E);
}

#ifdef PROBE_RT
#define GATHER_CALL(l) ph_gather2(p, c)
#else
#define GATHER_CALL(l) ph_gather3(p, l, c, (rep_ + 1 < NREP(PH_GATHER##l)) ? (float*)(ws + WS_S) : p.out)
#endif
#ifndef PROBE_IDMASK
#define PROBE_IDMASK 0x3fff
#endif
#ifndef DUP_MASK
#define DUP_MASK 0u
#endif
#define NREP(k) ((((unsigned)(DUP_MASK) >> (k)) & 1u) ? 2 : 1)
#define GETXI() XI xi; { if (multi) { if (threadIdx.x == 0) { unsigned xr_ = 0; for (unsigned j_ = 0; j_ < bar.x; ++j_) xr_ += xb_ld(&ctl[CW_BAR + XB_XCNT(j_)]) > 0u ? 1u : 0u; MISC[11] = xr_; } __syncthreads(); \
    xi.nloc = (int)MISC[8]; xi.nx = (int)MISC[9]; xi.jr = (int)MISC[10]; xi.xr = (int)MISC[11]; if (xi.nloc < 1 || xi.nx < 1 || xi.nx > 8 || xi.jr >= xi.nloc || xi.xr >= xi.nx) { xi.xr = 0; xi.nx = 1; xi.jr = blockIdx.x; xi.nloc = gridDim.x; } } \
    else { xi.xr = 0; xi.nx = 1; xi.jr = blockIdx.x; xi.nloc = gridDim.x; } }
#define MKCTX() Ctx c; { int t_ = threadIdx.x; asm volatile("" : "+v"(t_)); c.lds = lds; c.tid = t_; c.lane = t_ & 63; c.wave = __builtin_amdgcn_readfirstlane(t_ >> 6); \
    c.blk = blockIdx.x; c.nblk = gridDim.x; c.gtid = c.blk * NTHREADS + c.tid; c.gthreads = c.nblk * NTHREADS; c.gwave = c.blk * NWAVES + c.wave; c.gwaves = c.nblk * NWAVES; }
__global__ void __launch_bounds__(NTHREADS, 2) mega_fwd(Params p) {
    extern __shared__ __attribute__((aligned(16))) unsigned char lds_raw[];
    volatile LAS unsigned* MISC = (volatile LAS unsigned*)((LAS unsigned char*)lds_raw + MISC_OFF);
    LAS unsigned char* const lds = (LAS unsigned char*)lds_raw;
    for (int u = threadIdx.x; u < (LDS_BYTES - LDSCTL_OFF) / 4; u += NTHREADS) ((LAS unsigned*)(lds + LDSCTL_OFF))[u] = 0u;
    __syncthreads();
    unsigned* ctl = (unsigned*)(p.ws + WS_CTL);
    XcdBarrier bar; bar.bar = ctl + CW_BAR; bar.x = 0; bar.st = nullptr;
    const bool multi = (p.ph_hi - p.ph_lo) > 1;
    if (multi) { bar = xcd_barrier_post(ctl + CW_BAR, MISC + 8); if (threadIdx.x == 0) MISC[10] = xb_add(&ctl[CW_RANK + 64 * bar.x], 1u); }
    unsigned char* ws = p.ws;
    bf16_t* ACT = (bf16_t*)(ws + WS_ACT); bf16_t* PROJ = (bf16_t*)(ws + WS_PROJ);

    const int lo = p.ph_lo, hi = p.ph_hi;
#define IN(k) (PH_ENABLED(k) && lo <= (k) && (k) < hi)
#define SEAM(k) do { if ((k) + 1 < hi) xcd_barrier(bar); } while (0)
    if (IN(PH_PRO)) { for (int rep_ = 0; rep_ < NREP(PH_PRO); ++rep_) { MKCTX();
        transpose_cvt(p.ab_w_in, DM, NIN, (bf16_t*)(ws + WS_WT_IN), NIN_PAD, [](int n) { return n < 1536 ? n : (n < 3072 ? n + 16 : (n < 3088 ? n - 3072 + 1536 : -1)); }, c.gtid, c.gthreads);
        transpose_cvt(p.ab_w_out, DM, DM, (bf16_t*)(ws + WS_WT_OUT), DM, [](int n) { return n; }, c.gtid, c.gthreads);
        transpose_cvt(p.c_w_in, DM, 2048, (bf16_t*)(ws + WS_WT_CIN), 2048, [](int n) { return n; }, c.gtid, c.gthreads);
        transpose_cvt(p.c_w_out, DM, DM, (bf16_t*)(ws + WS_WT_COUT), DM, [](int n) { return n; }, c.gtid, c.gthreads);
        transpose_cvt(p.peer_w_query, DM, 2048, (bf16_t*)(ws + WS_WT_Q0), 2048, [](int n) { return n; }, c.gtid, c.gthreads);
        transpose_cvt(p.peer_w_query + (size_t)DM * 2048, DM, 2048, (bf16_t*)(ws + WS_WT_Q1), 2048, [](int n) { return n; }, c.gtid, c.gthreads);
#ifdef PROBE_RT
        cvt_fp8_roundtrip_rows(p.peer_u, (bf16_t*)(ws + WS_TAB), NEXP, c);
        cvt_fp8_roundtrip_rows(p.peer_v, (bf16_t*)(ws + WS_TAB) + (size_t)NEXP * DM, NEXP, c);
#else
        cvt_fp8_rows(p.peer_u, ws + WS_TAB8, (float*)(ws + WS_SCL), NEXP, c);
        cvt_fp8_rows(p.peer_v, ws + WS_TAB8 + (size_t)NEXP * DM, (float*)(ws + WS_SCL) + NEXP, NEXP, c);
#endif
        cvt_gate_weights(p, c);
        cvt_bf16(p.peer_sub_keys, (bf16_t*)(ws + WS_SK), (size_t)2 * 8 * 2 * 128 * 128 / 8, c.gtid, c.gthreads);
        norm_rows_bf16(p.x, p.mix_norm, ACT, c);
        if (rep_ + 1 < NREP(PH_PRO)) xcd_barrier(bar); } SEAM(PH_PRO); }
    if (IN(PH_GEMM_IN0)) { for (int rep_ = 0; rep_ < NREP(PH_GEMM_IN0); ++rep_) { MKCTX();  pg8::EpiBf16<0> E{PROJ, NIN_PAD, nullptr, 0, 0, 1.f}; GETXI(); run_gemm(c, ACT, (const bf16_t*)(ws + WS_WT_IN), NIN_PAD, E, (xi.nx == 8 && xi.nloc * 8 == (int)gridDim.x) ? xi.jr * 8 + xi.xr : (int)blockIdx.x); if (rep_ + 1 < NREP(PH_GEMM_IN0)) xcd_barrier(bar); } SEAM(PH_GEMM_IN0); }
    if (IN(PH_MIXER0)) { for (int rep_ = 0; rep_ < NREP(PH_MIXER0); ++rep_) { MKCTX();  ph_gla_a(p, c); ph_attn(p, c); if (rep_ + 1 < NREP(PH_MIXER0)) xcd_barrier(bar); } SEAM(PH_MIXER0); }
    if (IN(PH_GLA_B)) { for (int rep_ = 0; rep_ < NREP(PH_GLA_B); ++rep_) { MKCTX();  ph_gla_b(p, c); if (rep_ + 1 < NREP(PH_GLA_B)) xcd_barrier(bar); } SEAM(PH_GLA_B); }
    if (IN(PH_GLA_C)) { for (int rep_ = 0; rep_ < NREP(PH_GLA_C); ++rep_) { MKCTX();  ph_gla_c(p, c); if (rep_ + 1 < NREP(PH_GLA_C)) xcd_barrier(bar); } SEAM(PH_GLA_C); }
    if (IN(PH_MIX0)) { for (int rep_ = 0; rep_ < NREP(PH_MIX0); ++rep_) { MKCTX();  ph_mix(p, c); if (rep_ + 1 < NREP(PH_MIX0)) xcd_barrier(bar); } SEAM(PH_MIX0); }
    if (IN(PH_GEMM_OUT0)) { for (int rep_ = 0; rep_ < NREP(PH_GEMM_OUT0); ++rep_) { MKCTX();  pg8::EpiResF32 E{p.x, p.out, DM}; GETXI(); run_gemm(c, ACT, (const bf16_t*)(ws + WS_WT_OUT), DM, E, (xi.nx == 8 && xi.nloc * 8 == (int)gridDim.x) ? xi.jr * 8 + xi.xr : (int)blockIdx.x); if (rep_ + 1 < NREP(PH_GEMM_OUT0)) xcd_barrier(bar); } SEAM(PH_GEMM_OUT0); }
    if (IN(PH_NORM_F0)) { for (int rep_ = 0; rep_ < NREP(PH_NORM_F0); ++rep_) { MKCTX();  norm_rows_bf16(p.out, p.ffn_norm, ACT, c); if (rep_ + 1 < NREP(PH_NORM_F0)) xcd_barrier(bar); } SEAM(PH_NORM_F0); }
    if (IN(PH_GEMM_Q0)) { for (int rep_ = 0; rep_ < NREP(PH_GEMM_Q0); ++rep_) { MKCTX();  pg8::EpiBf16<0> E{PROJ, 2048, nullptr, 0, 0, 1.f}; GETXI(); run_gemm(c, ACT, (const bf16_t*)(ws + WS_WT_Q0), 2048, E, (xi.nx == 8 && xi.nloc * 8 == (int)gridDim.x) ? xi.jr * 8 + xi.xr : (int)blockIdx.x); if (rep_ + 1 < NREP(PH_GEMM_Q0)) xcd_barrier(bar); } SEAM(PH_GEMM_Q0); }
    if (IN(PH_TOPK1_0)) { for (int rep_ = 0; rep_ < NREP(PH_TOPK1_0); ++rep_) { MKCTX();  ph_topk(p, 0, c); if (rep_ + 1 < NREP(PH_TOPK1_0)) xcd_barrier(bar); } SEAM(PH_TOPK1_0); }
    if (IN(PH_PU0)) { for (int rep_ = 0; rep_ < NREP(PH_PU0); ++rep_) { MKCTX();  GETXI(); ph_peer_u(p, 0, c, xi, (rep_ + 1 < NREP(PH_PU0)) ? PROBE_IDMASK : 0x3fff); if (rep_ + 1 < NREP(PH_PU0)) xcd_barrier(bar); } SEAM(PH_PU0); }
    if (IN(PH_PA0)) { for (int rep_ = 0; rep_ < NREP(PH_PA0); ++rep_) { MKCTX();  ph_peer_act(p, 0, c); if (rep_ + 1 < NREP(PH_PA0)) xcd_barrier(bar); } SEAM(PH_PA0); }
    if (IN(PH_PV0)) { for (int rep_ = 0; rep_ < NREP(PH_PV0); ++rep_) { MKCTX();  GETXI(); ph_peer_v(p, 0, c, xi, (rep_ + 1 < NREP(PH_PV0)) ? (float*)(ws + WS_S) : p.out, (rep_ + 1 < NREP(PH_PV0)) ? PROBE_IDMASK : 0x3fff); if (rep_ + 1 < NREP(PH_PV0)) xcd_barrier(bar); } SEAM(PH_PV0); }
    if (IN(PH_NORM_M1)) { for (int rep_ = 0; rep_ < NREP(PH_NORM_M1); ++rep_) { MKCTX();  norm_rows_bf16(p.out, p.mix_norm + DM, ACT, c); if (rep_ + 1 < NREP(PH_NORM_M1)) xcd_barrier(bar); } SEAM(PH_NORM_M1); }
    if (IN(PH_GEMM_CIN)) { for (int rep_ = 0; rep_ < NREP(PH_GEMM_CIN); ++rep_) { MKCTX();  pg8::EpiBf16<0> E{PROJ, 2048, nullptr, 0, 0, 1.f}; GETXI(); run_gemm(c, ACT, (const bf16_t*)(ws + WS_WT_CIN), 2048, E, (xi.nx == 8 && xi.nloc * 8 == (int)gridDim.x) ? xi.jr * 8 + xi.xr : (int)blockIdx.x); if (rep_ + 1 < NREP(PH_GEMM_CIN)) xcd_barrier(bar); } SEAM(PH_GEMM_CIN); }
    if (IN(PH_G1)) { for (int rep_ = 0; rep_ < NREP(PH_G1); ++rep_) { MKCTX();  griffin_pass<false>(p, c); if (rep_ + 1 < NREP(PH_G1)) xcd_barrier(bar); } SEAM(PH_G1); }
    if (IN(PH_G2)) { for (int rep_ = 0; rep_ < NREP(PH_G2); ++rep_) { MKCTX();  ph_carry(p, c); if (rep_ + 1 < NREP(PH_G2)) xcd_barrier(bar); } SEAM(PH_G2); }
    if (IN(PH_G3)) { for (int rep_ = 0; rep_ < NREP(PH_G3); ++rep_) { MKCTX();  griffin_pass<true>(p, c); if (rep_ + 1 < NREP(PH_G3)) xcd_barrier(bar); } SEAM(PH_G3); }
    if (IN(PH_GEMM_OUT1)) { for (int rep_ = 0; rep_ < NREP(PH_GEMM_OUT1); ++rep_) { MKCTX();  pg8::EpiResF32 E{p.out, p.out, DM}; GETXI(); run_gemm(c, ACT, (const bf16_t*)(ws + WS_WT_COUT), DM, E, (xi.nx == 8 && xi.nloc * 8 == (int)gridDim.x) ? xi.jr * 8 + xi.xr : (int)blockIdx.x); if (rep_ + 1 < NREP(PH_GEMM_OUT1)) xcd_barrier(bar); } SEAM(PH_GEMM_OUT1); }
    if (IN(PH_NORM_F1)) { for (int rep_ = 0; rep_ < NREP(PH_NORM_F1); ++rep_) { MKCTX();
        norm_rows_bf16(p.out, p.ffn_norm + DM, ACT, c);
#ifdef PROBE_RT
        cvt_fp8_roundtrip_rows(p.peer_u + (size_t)NEXP * DM, (bf16_t*)(ws + WS_TAB), NEXP, c);
        cvt_fp8_roundtrip_rows(p.peer_v + (size_t)NEXP * DM, (bf16_t*)(ws + WS_TAB) + (size_t)NEXP * DM, NEXP, c);
#else
        cvt_fp8_rows(p.peer_u + (size_t)NEXP * DM, ws + WS_TAB8 + (size_t)2 * NEXP * DM, (float*)(ws + WS_SCL) + 2 * NEXP, NEXP, c);
        cvt_fp8_rows(p.peer_v + (size_t)NEXP * DM, ws + WS_TAB8 + (size_t)3 * NEXP * DM, (float*)(ws + WS_SCL) + 3 * NEXP, NEXP, c);
#endif
        if (rep_ + 1 < NREP(PH_NORM_F1)) xcd_barrier(bar); } SEAM(PH_NORM_F1); }
    if (IN(PH_GEMM_Q1)) { for (int rep_ = 0; rep_ < NREP(PH_GEMM_Q1); ++rep_) { MKCTX();  pg8::EpiBf16<0> E{PROJ, 2048, nullptr, 0, 0, 1.f}; GETXI(); run_gemm(c, ACT, (const bf16_t*)(ws + WS_WT_Q1), 2048, E, (xi.nx == 8 && xi.nloc * 8 == (int)gridDim.x) ? xi.jr * 8 + xi.xr : (int)blockIdx.x); if (rep_ + 1 < NREP(PH_GEMM_Q1)) xcd_barrier(bar); } SEAM(PH_GEMM_Q1); }
    if (IN(PH_TOPK1_1)) { for (int rep_ = 0; rep_ < NREP(PH_TOPK1_1); ++rep_) { MKCTX();  ph_topk(p, 1, c); if (rep_ + 1 < NREP(PH_TOPK1_1)) xcd_barrier(bar); } SEAM(PH_TOPK1_1); }
    if (IN(PH_PU1)) { for (int rep_ = 0; rep_ < NREP(PH_PU1); ++rep_) { MKCTX();  GETXI(); ph_peer_u(p, 1, c, xi, (rep_ + 1 < NREP(PH_PU1)) ? PROBE_IDMASK : 0x3fff); if (rep_ + 1 < NREP(PH_PU1)) xcd_barrier(bar); } SEAM(PH_PU1); }
    if (IN(PH_PA1)) { for (int rep_ = 0; rep_ < NREP(PH_PA1); ++rep_) { MKCTX();  ph_peer_act(p, 1, c); if (rep_ + 1 < NREP(PH_PA1)) xcd_barrier(bar); } SEAM(PH_PA1); }
    if (IN(PH_PV1)) { for (int rep_ = 0; rep_ < NREP(PH_PV1); ++rep_) { MKCTX();  GETXI(); ph_peer_v(p, 1, c, xi, (rep_ + 1 < NREP(PH_PV1)) ? (float*)(ws + WS_S) : p.out, (rep_ + 1 < NREP(PH_PV1)) ? PROBE_IDMASK : 0x3fff); if (rep_ + 1 < NREP(PH_PV1)) xcd_barrier(bar); } SEAM(PH_PV1); }
    if (IN(PH_FINAL)) { MKCTX(); norm_rows_f32(p.out, p.final_norm, c); }
#undef IN
#undef SEAM
}

extern "C" void kernel_launch(void* const* d_in, const int* in_sizes, int n_in, void* d_out, int out_size, void* d_ws, size_t ws_size, hipStream_t stream) {
    static int grid = 0;
    if (grid == 0) {
        if (n_in != 22 || out_size != M * DM || ws_size < WS_END) { fprintf(stderr, "kernel_launch: unexpected shapes: n_in %d out %d ws %zu (need %zu)\n", n_in, out_size, ws_size, (size_t)WS_END); grid = -1; return; }
        int dev = 0, cus = 0, per_cu = 0;
        if (hipGetDevice(&dev) != hipSuccess || hipDeviceGetAttribute(&cus, hipDeviceAttributeMultiprocessorCount, dev) != hipSuccess) { grid = -1; return; }
        if (hipFuncSetAttribute((const void*)mega_fwd, hipFuncAttributeMaxDynamicSharedMemorySize, LDS_BYTES) != hipSuccess) { fprintf(stderr, "kernel_launch: hipFuncSetAttribute failed\n"); grid = -1; return; }
        if (hipOccupancyMaxActiveBlocksPerMultiprocessor(&per_cu, (const void*)mega_fwd, NTHREADS, LDS_BYTES) != hipSuccess || per_cu < 1) { fprintf(stderr, "kernel_launch: occupancy query says %d blocks per CU\n", per_cu); per_cu = 1; }
        (void)hipGetLastError();
        grid = cus;
        if (grid % 8 != 0 || grid < 32) { fprintf(stderr, "kernel_launch: unexpected CU count %d\n", cus); }
    }
    if (grid < 0) return;
    (void)hipMemsetAsync((char*)d_ws + WS_CTL, 0, CTL_ZERO_BYTES, stream);
    Params p{};
    const float** pp = (const float**)&p;
    for (int i = 0; i < 22; ++i) pp[i] = (const float*)d_in[i];
    p.out = (float*)d_out; p.ws = (unsigned char*)d_ws;
#if MK_N_LAUNCHES == 1
    p.ph_lo = 0; p.ph_hi = NPHASES;
    void* args[] = {&p};
    hipError_t e = hipLaunchCooperativeKernel((const void*)mega_fwd, dim3(grid), dim3(NTHREADS), args, LDS_BYTES, stream);
    if (e != hipSuccess) fprintf(stderr, "cooperative launch failed: %s (grid %d)\n", hipGetErrorString(e), grid);
#else
    for (int ph = 0; ph < NPHASES; ++ph) { p.ph_lo = ph; p.ph_hi = ph + 1; hipLaunchKernelGGL(mega_fwd, dim3(grid), dim3(NTHREADS), LDS_BYTES, stream, p); }
#endif
}
```

```cpp
#include <hip/hip_runtime.h>
#include <hip/hip_bf16.h>
#include <cstdio>
#include <cstdint>
#include <cmath>
namespace pg8 {
#define PG8_LAS __attribute__((address_space(3)))
typedef unsigned short bf16_t;
typedef short bf16x8 __attribute__((ext_vector_type(8)));
typedef float f32x4 __attribute__((ext_vector_type(4)));
typedef unsigned u32x4 __attribute__((ext_vector_type(4)));
constexpr int BM = 256, BK = 64, HALF = 128, HTB = HALF * BK * 2  , STAGE_BYTES = 8 * HTB, NXCD = 8, WGM = 8;

__host__ __device__ __forceinline__ int lds_byte(int r, int c) { const int st = (r >> 4) * 2 + (c >> 5), rr = r & 15, cc = c & 31, ob = rr * 64 + cc * 2; return st * 1024 + (ob ^ (((ob >> 9) & 1) << 5)); }
__host__ __device__ __forceinline__ void stage_rc(int b, int& R, int& C) { const int st = b / 1024, sb = b % 1024, swz = sb ^ (((sb >> 9) & 1) << 5); R = (st >> 1) * 16 + swz / 64; C = (st & 1) * 32 + (swz % 64) / 2; }
__host__ __device__ __forceinline__ int perm32(int rho) { const int n = rho >> 4, i = rho & 15; return 8 * (i >> 2) + 4 * n + (i & 3); }

struct Unit { int pm, pn; };
struct Gemm { const bf16_t* A; const bf16_t* Bt; int M, N, K; };

struct StaticOrder {
    int nM, nN, nwg, G, c;
    __host__ __device__ void init(int M, int N, int G_, int c_) { nM = M / BM; nN = N / BM; nwg = nM * nN; G = G_; c = c_; }
    __host__ __device__ bool next(int i, Unit& u) const {
        const long L = (long)i * G + c; if (L >= nwg) return false;
        int wgid = (int)L; { const int q = nwg / NXCD, r = nwg % NXCD, xcd = wgid % NXCD, off = wgid / NXCD; wgid = (xcd < r ? xcd * (q + 1) : r * (q + 1) + (xcd - r) * q) + off; }
        const int nig = WGM * nN, gid = wgid / nig, fm = gid * WGM, gsz = (nM - fm) < WGM ? (nM - fm) : WGM;
        u.pm = fm + ((wgid % nig) % gsz); u.pn = (wgid % nig) / gsz; return true;
    }
    __device__ __forceinline__ void a_ready(const Unit&) const {}
    __device__ __forceinline__ void done(const Unit&) const {}
};

__device__ __forceinline__ unsigned cvt_pk_bf16(float lo, float hi) { unsigned r; asm volatile("v_cvt_pk_bf16_f32 %0, %1, %2" : "=v"(r) : "v"(lo), "v"(hi)); return r; }
typedef float f32x2 __attribute__((ext_vector_type(2)));
__device__ __forceinline__ f32x2 gelu_pk(f32x2 v) {
    const f32x2 av = __builtin_elementwise_abs(v), d = av * 0.2316418882f + 1.0f;
    f32x2 t; t.x = __builtin_amdgcn_rcpf(d.x); t.y = __builtin_amdgcn_rcpf(d.y);
    f32x2 q = t * 0.5307027145f + (-0.7265760135f); q = q * t + 0.7107068705f; q = q * t + (-0.142248368f); q = q * t + 0.127414796f; q = q * t;
    const f32x2 s = (v * v) * (-0.72134752044f);
    f32x2 e; e.x = __builtin_amdgcn_exp2f(s.x); e.y = __builtin_amdgcn_exp2f(s.y);
    const f32x2 m = v * (q * e), r = v - m;
    f32x2 o; o.x = v.x < 0.f ? m.x : r.x; o.y = v.y < 0.f ? m.y : r.y; return o;
}
template <int ACT  > struct EpiBf16 {
    static constexpr bool PERM = true, AFTER_DRAIN = false; static_assert(ACT == 0 || ACT == 1, "EpiBf16: ACT is 0 (none) or 1 (gelu_pk)");
    bf16_t* O; int ldc; const float* bias; int split_cols; size_t split_stride; float scale0;
    __device__ __forceinline__ void operator()(const f32x4 (&acc)[2][2][4][2], const Unit& u, int wr, int wc, int fr, int fq) const {
        const int row0 = u.pm * BM + wr * 64 + fr; int colt = u.pn * BM; bf16_t* base = O;
        float sc = 1.f; if (split_cols) { const int t = colt / split_cols; base += (size_t)t * split_stride; colt -= t * split_cols; if (t == 0) sc = scale0; }
        const int col0 = colt + wc * 32 + 8 * fq, bcol0 = u.pn * BM + wc * 32 + 8 * fq;
        f32x4 bv[2][2];
#pragma unroll
        for (int bj = 0; bj < 2; ++bj)
#pragma unroll
            for (int n = 0; n < 2; ++n) bv[bj][n] = bias ? *(const f32x4*)(bias + bcol0 + bj * HALF + 4 * n) : (f32x4){0.f, 0.f, 0.f, 0.f};
#pragma unroll
        for (int ai = 0; ai < 2; ++ai)
#pragma unroll
            for (int m = 0; m < 4; ++m) { bf16_t* rowp = base + (size_t)(row0 + ai * HALF + m * 16) * ldc + col0;
#pragma unroll
                for (int bj = 0; bj < 2; ++bj) { f32x4 v0 = acc[ai][bj][m][0] + bv[bj][0], v1 = acc[ai][bj][m][1] + bv[bj][1];
                    if (ACT == 1) { f32x2 a = gelu_pk((f32x2){v0[0], v0[1]}), b = gelu_pk((f32x2){v0[2], v0[3]}), c = gelu_pk((f32x2){v1[0], v1[1]}), d = gelu_pk((f32x2){v1[2], v1[3]});
                        v0 = (f32x4){a.x, a.y, b.x, b.y}; v1 = (f32x4){c.x, c.y, d.x, d.y}; }
                    v0 = v0 * sc; v1 = v1 * sc; u32x4 w; w.x = cvt_pk_bf16(v0[0], v0[1]); w.y = cvt_pk_bf16(v0[2], v0[3]); w.z = cvt_pk_bf16(v1[0], v1[1]); w.w = cvt_pk_bf16(v1[2], v1[3]);
                    *(u32x4*)(rowp + bj * HALF) = w; } }
    }
};
template <class Epi, class Sched, bool ALIGN_EPI = false, bool SP2 = false>
__device__ __forceinline__ void gemm_phase(PG8_LAS unsigned char* lds, const Gemm g, const Sched& S, const Epi& E) {
    const int tid = threadIdx.x, wid = __builtin_amdgcn_readfirstlane(tid >> 6), lane = tid & 63, wr = wid >> 2, wc = wid & 3, fr = lane & 15, fq = lane >> 4;
    const int K = g.K, nt = K / BK;
    unsigned voffA[2], voffB[2];
#pragma unroll
    for (int i = 0; i < 2; ++i) { int R, C; stage_rc(tid * 16 + i * 8192, R, C); const int Rb = Epi::PERM ? ((R & ~31) + perm32(R & 31)) : R;
        voffA[i] = (unsigned)(R * K + C) * 2u; voffB[i] = (unsigned)(Rb * K + C) * 2u; }
    const size_t kstep = (size_t)(BK * 2);
    const size_t hstep = (size_t)HALF * K * 2;
    const size_t tstep = 2 * hstep;
    const unsigned ldsw = (unsigned)wid * 1024u;
    const int aoff = lds_byte(wr * 64 + fr, fq * 8), boff = lds_byte(wc * 32 + fr, fq * 8);
#define PG8_SA(b, h) (((b) * 2 + (h)) * HTB)
#define PG8_SB(b, h) ((4 + (b) * 2 + (h)) * HTB)
#define PG8_STAGE(bufoff, gbase, voff) do { _Pragma("unroll") for (int _i = 0; _i < 2; ++_i) \
        __builtin_amdgcn_global_load_lds((const unsigned*)((const char*)(gbase) + (voff)[_i]), (PG8_LAS unsigned*)(lds + (bufoff) + ldsw + _i * 8192), 16, 0, 0); } while (0)
#define PG8_LDA(dst, b, h) do { _Pragma("unroll") for (int m = 0; m < 4; ++m) _Pragma("unroll") for (int k = 0; k < 2; ++k) dst[m][k] = *(const PG8_LAS bf16x8*)(lds + PG8_SA(b, h) + aoff + m * 2048 + k * 1024); } while (0)
#define PG8_LDB(dst, b, h) do { _Pragma("unroll") for (int n = 0; n < 2; ++n) _Pragma("unroll") for (int k = 0; k < 2; ++k) dst[n][k] = *(const PG8_LAS bf16x8*)(lds + PG8_SB(b, h) + boff + n * 2048 + k * 1024); } while (0)
#define PG8_MMA(ai, bj, At, Bt) do { __builtin_amdgcn_s_setprio(1); _Pragma("unroll") for (int m = 0; m < 4; ++m) _Pragma("unroll") for (int n = 0; n < 2; ++n) _Pragma("unroll") for (int k = 0; k < 2; ++k) \
        acc[ai][bj][m][n] = __builtin_amdgcn_mfma_f32_16x16x32_bf16(Bt[n][k], At[m][k], acc[ai][bj][m][n], 0, 0, 0); __builtin_amdgcn_s_setprio(0); } while (0)
#define PG8_WAIT_V(n) asm volatile("s_waitcnt vmcnt(" #n ")" ::: "memory")
#define PG8_WAIT_L(n) asm volatile("s_waitcnt lgkmcnt(" #n ")" ::: "memory")
#define PG8_BAR __builtin_amdgcn_s_barrier()
#define PG8_SCHED __builtin_amdgcn_sched_barrier(0)
    Unit cur, nxt; int ui = 0;
    if (!S.next(0, cur)) return;
    f32x4 acc[2][2][4][2];
#pragma unroll
    for (int a = 0; a < 2; ++a)
#pragma unroll
        for (int b = 0; b < 2; ++b)
#pragma unroll
            for (int m = 0; m < 4; ++m)
#pragma unroll
                for (int n = 0; n < 2; ++n) acc[a][b][m][n] = (f32x4){0.f, 0.f, 0.f, 0.f};
    bf16x8 At[4][2], B0[2][2], B1[2][2];
    const char* cA = (const char*)g.A + (size_t)cur.pm * tstep; const char* cB = (const char*)g.Bt + (size_t)cur.pn * tstep;
    S.a_ready(cur);
    if constexpr (SP2) {
        PG8_STAGE(PG8_SB(0, 0), cB, voffB); PG8_STAGE(PG8_SB(0, 1), cB + hstep, voffB); PG8_STAGE(PG8_SA(0, 0), cA, voffA); PG8_STAGE(PG8_SA(0, 1), cA + hstep, voffA);
        if (wr == 1) PG8_BAR;
        PG8_WAIT_V(2); PG8_BAR;
        PG8_STAGE(PG8_SB(1, 0), cB + kstep, voffB); PG8_STAGE(PG8_SA(1, 0), cA + kstep, voffA); PG8_STAGE(PG8_SB(1, 1), cB + hstep + kstep, voffB);
        PG8_WAIT_V(6); PG8_BAR;
    } else {
        PG8_STAGE(PG8_SB(0, 0), cB, voffB); PG8_STAGE(PG8_SA(0, 0), cA, voffA); PG8_STAGE(PG8_SB(0, 1), cB + hstep, voffB); PG8_STAGE(PG8_SA(0, 1), cA + hstep, voffA);
        if (wr == 1) PG8_BAR;
        PG8_WAIT_V(4); PG8_BAR;
        PG8_STAGE(PG8_SB(1, 0), cB + kstep, voffB); PG8_STAGE(PG8_SA(1, 0), cA + kstep, voffA); PG8_STAGE(PG8_SB(1, 1), cB + hstep + kstep, voffB);
        PG8_WAIT_V(6); PG8_BAR;
    }
    for (;;) {
        const bool has_next = S.next(ui + 1, nxt);
        const char* nA = has_next ? (const char*)g.A + (size_t)nxt.pm * tstep : cA; const char* nB = has_next ? (const char*)g.Bt + (size_t)nxt.pn * tstep : cB;
        for (int t = 0; t < nt; t += 2) {
            const bool last = (t == nt - 2);
            const char* a1 = cA + (size_t)(t + 1) * kstep;
            const char* a2 = last ? nA : cA + (size_t)(t + 2) * kstep; const char* b2 = last ? nB : cB + (size_t)(t + 2) * kstep;
            const char* a3 = a2 + kstep; const char* b3 = b2 + kstep;
            if (last && has_next) S.a_ready(nxt);
            if constexpr (SP2) {
            PG8_LDB(B0, 0, 0); PG8_LDB(B1, 0, 1); PG8_SCHED; PG8_LDA(At, 0, 0); PG8_STAGE(PG8_SA(1, 1), a1 + hstep, voffA);
            PG8_WAIT_V(8); PG8_WAIT_L(0); PG8_BAR; PG8_MMA(0, 0, At, B0); PG8_MMA(0, 1, At, B1); PG8_BAR; PG8_SCHED;
            PG8_LDA(At, 0, 1); PG8_STAGE(PG8_SB(0, 0), b2, voffB); PG8_STAGE(PG8_SB(0, 1), b2 + hstep, voffB); PG8_STAGE(PG8_SA(0, 0), a2, voffA);
            PG8_WAIT_V(8); PG8_WAIT_L(0); PG8_BAR; PG8_MMA(1, 0, At, B0); PG8_MMA(1, 1, At, B1); PG8_BAR; PG8_SCHED;
            PG8_LDB(B0, 1, 0); PG8_LDB(B1, 1, 1); PG8_SCHED; PG8_LDA(At, 1, 0); PG8_STAGE(PG8_SA(0, 1), a2 + hstep, voffA);
            PG8_WAIT_V(8); PG8_WAIT_L(0); PG8_BAR; PG8_MMA(0, 0, At, B0); PG8_MMA(0, 1, At, B1); PG8_BAR; PG8_SCHED;
            PG8_LDA(At, 1, 1); PG8_STAGE(PG8_SB(1, 0), b3, voffB); PG8_STAGE(PG8_SB(1, 1), b3 + hstep, voffB); PG8_STAGE(PG8_SA(1, 0), a3, voffA);
            PG8_WAIT_V(8); PG8_WAIT_L(0); PG8_BAR; PG8_MMA(1, 0, At, B0); PG8_MMA(1, 1, At, B1); PG8_BAR; PG8_SCHED;
            } else {
            PG8_LDB(B0, 0, 0); PG8_SCHED; PG8_LDA(At, 0, 0); PG8_STAGE(PG8_SA(1, 1), a1 + hstep, voffA);
            PG8_WAIT_L(8); PG8_BAR; PG8_WAIT_L(0); PG8_MMA(0, 0, At, B0); PG8_BAR; PG8_SCHED;
            PG8_LDB(B1, 0, 1); PG8_STAGE(PG8_SB(0, 0), b2, voffB);
            PG8_BAR; PG8_WAIT_L(0); PG8_MMA(0, 1, At, B1); PG8_BAR;
            PG8_LDA(At, 0, 1); PG8_STAGE(PG8_SA(0, 0), a2, voffA);
            PG8_BAR; PG8_WAIT_L(0); PG8_MMA(1, 0, At, B0); PG8_BAR; PG8_SCHED;
            PG8_STAGE(PG8_SB(0, 1), b2 + hstep, voffB);
            PG8_WAIT_V(6); PG8_BAR; PG8_MMA(1, 1, At, B1); PG8_BAR;
            PG8_LDB(B0, 1, 0); PG8_SCHED; PG8_LDA(At, 1, 0); PG8_STAGE(PG8_SA(0, 1), a2 + hstep, voffA);
            PG8_WAIT_L(8); PG8_BAR; PG8_WAIT_L(0); PG8_MMA(0, 0, At, B0); PG8_BAR; PG8_SCHED;
            PG8_LDB(B1, 1, 1); PG8_STAGE(PG8_SB(1, 0), b3, voffB);
            PG8_BAR; PG8_WAIT_L(0); PG8_MMA(0, 1, At, B1); PG8_BAR;
            PG8_LDA(At, 1, 1); PG8_STAGE(PG8_SA(1, 0), a3, voffA);
            PG8_BAR; PG8_WAIT_L(0); PG8_MMA(1, 0, At, B0); PG8_BAR; PG8_SCHED;
            PG8_STAGE(PG8_SB(1, 1), b3 + hstep, voffB);
            PG8_WAIT_V(6); PG8_BAR; PG8_MMA(1, 1, At, B1); PG8_BAR;
            }
        }
        if constexpr (ALIGN_EPI) { if (wr == 0) PG8_BAR; }
        if constexpr (!Epi::AFTER_DRAIN) { E(acc, cur, wr, wc, fr, fq); S.done(cur); }
        if (!has_next) break;
#pragma unroll
        for (int a = 0; a < 2; ++a)
#pragma unroll
            for (int b = 0; b < 2; ++b)
#pragma unroll
                for (int m = 0; m < 4; ++m)
#pragma unroll
                    for (int n = 0; n < 2; ++n) acc[a][b][m][n] = (f32x4){0.f, 0.f, 0.f, 0.f};
        cur = nxt; cA = nA; cB = nB; ++ui;
        if constexpr (ALIGN_EPI) { if (wr == 1) PG8_BAR; }
    }
    PG8_WAIT_V(0);
    if constexpr (!ALIGN_EPI) { if (wr == 0) PG8_BAR; }
    PG8_BAR;
    if constexpr (Epi::AFTER_DRAIN) { E.fused(acc, cur, wr, wc, fr, fq, lds, wid, lane); S.done(cur); }
#undef PG8_SA
#undef PG8_SB
#undef PG8_STAGE
#undef PG8_LDA
#undef PG8_LDB
#undef PG8_MMA
#undef PG8_WAIT_V
#undef PG8_WAIT_L
#undef PG8_BAR
#undef PG8_SCHED
}

struct EpiResF32 {
    static constexpr bool PERM = false, AFTER_DRAIN = false;
    const float* base; float* out; int ldc;
    __device__ __forceinline__ void operator()(const f32x4 (&acc)[2][2][4][2], const Unit& u, int wr, int wc, int fr, int fq) const {
        const int col0 = u.pn * BM + wc * 32 + 4 * fq;
#pragma unroll
        for (int ai = 0; ai < 2; ++ai)
#pragma unroll
            for (int m = 0; m < 4; ++m) { const int r = ai * HALF + wr * 64 + m * 16 + fr; const size_t off = (size_t)(u.pm * BM + r) * ldc + col0;
#pragma unroll
                for (int bj = 0; bj < 2; ++bj)
#pragma unroll
                    for (int n = 0; n < 2; ++n) { const f32x4 bs = *(const f32x4*)(base + off + bj * HALF + n * 16); *(f32x4*)(out + off + bj * HALF + n * 16) = bs + acc[ai][bj][m][n]; } }
    }
};
}

constexpr int BATCH = 4, SEQ = 8192, DM = 1024, M = BATCH * SEQ;
constexpr int NIN = 3088, NIN_PAD = 3328;
constexpr int C_GQ = 0, C_GK = 256, C_GV = 512, C_GG = 1024, C_AQ = 1536, C_AK = 2048, C_AV = 2560, C_GLR = 3072;
constexpr int NEXP = 16384;
constexpr float NORM_EPS = 1e-6f;
constexpr int NWAVES = 8, NTHREADS = 512;

constexpr size_t MiB = 1u << 20;
constexpr size_t WS_CTL = 0, CTL_ZERO_BYTES = 1 * MiB;
constexpr size_t WS_WT_IN = 1 * MiB;
constexpr size_t WS_WT_OUT = 8 * MiB;
constexpr size_t WS_WT_CIN = 10 * MiB;
constexpr size_t WS_WT_COUT = 14 * MiB;
constexpr size_t WS_WT_Q0 = 16 * MiB;
constexpr size_t WS_WT_Q1 = 20 * MiB;
constexpr size_t WS_ACT = 32 * MiB;
constexpr size_t WS_S = 96 * MiB;
constexpr size_t WS_PROJ = WS_S;
constexpr size_t WS_GLAO = WS_S + 208 * MiB;
constexpr size_t WS_TOPS = WS_S + 128 * MiB;
constexpr size_t WS_TOPI = WS_S + 160 * MiB;
constexpr size_t WS_IDS = WS_S + 192 * MiB;
constexpr size_t WS_G = WS_S + 208 * MiB;
constexpr size_t WS_XC = WS_ACT;
constexpr size_t WS_A = WS_S + 128 * MiB;
constexpr size_t WS_U = WS_S + 256 * MiB;
constexpr size_t WS_TAB = 448 * MiB;
constexpr size_t WS_TAB8 = 448 * MiB;
constexpr size_t WS_WG = 24 * MiB;
constexpr size_t WS_AGG = WS_S + 128 * MiB;
constexpr size_t WS_SCL = 26 * MiB;
constexpr size_t WS_END = 512 * MiB;
constexpr int CW_BAR = 4096, CW_RANK = 8192;

constexpr int RING_BYTES = 131072;
constexpr int LDS_BYTES = 147456;
constexpr int LDSCTL_OFF = LDS_BYTES - 512, MISC_OFF = LDSCTL_OFF + 320;

#define LAS __attribute__((address_space(3)))
#define GAS __attribute__((address_space(1)))
typedef unsigned short bf16_t;
typedef float f32x4 __attribute__((ext_vector_type(4)));
typedef unsigned u32x4 __attribute__((ext_vector_type(4)));
typedef unsigned u32x2 __attribute__((ext_vector_type(2)));
typedef short bf16x8 __attribute__((ext_vector_type(8)));

struct Params {
    const float *x, *mix_norm, *ffn_norm, *ab_w_in, *gla_w_alpha, *gla_b_alpha, *gla_head_gain, *ab_w_out;
    const float *c_w_in, *c_conv_w, *c_conv_b, *c_w_rgate, *c_b_rgate, *c_w_igate, *c_b_igate, *c_lambda, *c_w_out;
    const float *peer_w_query, *peer_sub_keys, *peer_u, *peer_v, *final_norm;
    float* out; unsigned char* ws;
    int ph_lo, ph_hi;
};

__device__ __forceinline__ unsigned f2bf(float f) { unsigned r; asm("v_cvt_pk_bf16_f32 %0, %1, %1" : "=v"(r) : "v"(f)); return r & 0xffffu; }
__device__ __forceinline__ unsigned pk2(float lo, float hi) { unsigned r; asm("v_cvt_pk_bf16_f32 %0, %1, %2" : "=v"(r) : "v"(lo), "v"(hi)); return r; }
__device__ __forceinline__ float bf2f(bf16_t b) { return __builtin_bit_cast(float, (unsigned)b << 16); }
__device__ __forceinline__ float bflo(unsigned w) { return __builtin_bit_cast(float, w << 16); }
__device__ __forceinline__ float bfhi(unsigned w) { return __builtin_bit_cast(float, w & 0xffff0000u); }
__device__ __forceinline__ float wave_sum(float v) {
#pragma unroll
    for (int o = 1; o < 64; o <<= 1) v += __shfl_xor(v, o);
    return v;
}
__device__ __forceinline__ float gelu_tanh(float x) {
    const float x2 = x * x, u2 = x * (2.3022082f + 0.10294324f * x2);
    const float e = __builtin_amdgcn_exp2f(u2);
    return x - x * __builtin_amdgcn_rcpf(e + 1.f);
}
__device__ __forceinline__ float sigmoidf_(float x) { return __builtin_amdgcn_rcpf(1.f + __expf(-x)); }

struct Ctx { int tid, lane, wave, blk, nblk, gtid, gthreads, gwave, gwaves; LAS unsigned char* lds; };

template <class F> __device__ __forceinline__ void transpose_cvt(const float* W, int K, int Nsrc, bf16_t* WT, int Ndst, F srcmap, int gtid, int gthreads) {
    const int total = (K / 8) * Ndst;
    for (int idx = gtid; idx < total; idx += gthreads) {
        const int ko = idx / Ndst, n = idx - ko * Ndst; const int sn = srcmap(n);
        u32x4 w = {0u, 0u, 0u, 0u};
        if (sn >= 0) { const float* s = W + (size_t)(ko * 8) * Nsrc + sn;
            w.x = pk2(s[0], s[(size_t)Nsrc]); w.y = pk2(s[2 * (size_t)Nsrc], s[3 * (size_t)Nsrc]); w.z = pk2(s[4 * (size_t)Nsrc], s[5 * (size_t)Nsrc]); w.w = pk2(s[6 * (size_t)Nsrc], s[7 * (size_t)Nsrc]); }
        *(u32x4*)(WT + (size_t)n * K + ko * 8) = w;
    }
}
__device__ __forceinline__ void cvt_bf16(const float* src, bf16_t* dst, size_t n8, int gtid, int gthreads) {
    for (size_t i = gtid; i < n8; i += gthreads) { const f32x4 a = *(const f32x4*)(src + i * 8), b = *(const f32x4*)(src + i * 8 + 4);
        u32x4 w; w.x = pk2(a.x, a.y); w.y = pk2(a.z, a.w); w.z = pk2(b.x, b.y); w.w = pk2(b.z, b.w); *(u32x4*)(dst + i * 8) = w; }
}
__device__ __forceinline__ void norm_rows_bf16(const float* src, const float* gain, bf16_t* dst, const Ctx& c) {
    for (int m = c.gwave; m < M; m += c.gwaves) {
        const f32x4* xr = (const f32x4*)(src + (size_t)m * DM) + c.lane; f32x4 v[4]; float s = 0.f;
#pragma unroll
        for (int j = 0; j < 4; ++j) { v[j] = xr[64 * j]; s += (v[j].x * v[j].x + v[j].y * v[j].y) + (v[j].z * v[j].z + v[j].w * v[j].w); }
        const float rstd = 1.f / sqrtf(wave_sum(s) * (1.f / DM) + NORM_EPS);
        u32x2* o8 = (u32x2*)(dst + (size_t)m * DM) + c.lane;
#pragma unroll
        for (int j = 0; j < 4; ++j) { const f32x4 g = *((const f32x4*)gain + 64 * j + c.lane); u32x2 w; w.x = pk2(v[j].x * rstd * g.x, v[j].y * rstd * g.y); w.y = pk2(v[j].z * rstd * g.z, v[j].w * rstd * g.w); o8[64 * j] = w; }
    }
}
__device__ __forceinline__ void norm_rows_f32(float* buf, const float* gain, const Ctx& c) {
    for (int m = c.gwave; m < M; m += c.gwaves) {
        f32x4* xr = (f32x4*)(buf + (size_t)m * DM) + c.lane; f32x4 v[4]; float s = 0.f;
#pragma unroll
        for (int j = 0; j < 4; ++j) { v[j] = xr[64 * j]; s += (v[j].x * v[j].x + v[j].y * v[j].y) + (v[j].z * v[j].z + v[j].w * v[j].w); }
        const float rstd = 1.f / sqrtf(wave_sum(s) * (1.f / DM) + NORM_EPS);
#pragma unroll
        for (int j = 0; j < 4; ++j) { const f32x4 g = *((const f32x4*)gain + 64 * j + c.lane); xr[64 * j] = v[j] * rstd * g; }
    }
}

__device__ __forceinline__ void ph_gla_naive(const Params& p, const Ctx& c) {
    const int b = c.blk >> 2, h = c.blk & 3;
    LAS float* sq = (LAS float*)c.lds; LAS float* sk = sq + 4096; LAS float* sa = sk + 4096; LAS float* sv = sa + 4096;
    const bf16_t* proj = (const bf16_t*)(p.ws + WS_PROJ);
    float* go = (float*)(p.ws + WS_GLAO);
    const int tid = c.tid, v = tid >> 2, kq = tid & 3;
    float S[16];
#pragma unroll
    for (int i = 0; i < 16; ++i) S[i] = 0.f;
    for (int t0 = 0; t0 < SEQ; t0 += 64) {
        __syncthreads();
        for (int e = tid; e < 4096; e += NTHREADS) { const int tt = e >> 6, kk = e & 63; const bf16_t* pr = proj + (size_t)(b * SEQ + t0 + tt) * NIN_PAD;
            sq[e] = bf2f(pr[C_GQ + h * 64 + kk]); sk[e] = bf2f(pr[C_GK + h * 64 + kk]);
            float z = p.gla_b_alpha[h * 64 + kk];
#pragma unroll
            for (int r = 0; r < 16; ++r) z += bf2f(pr[C_GLR + r]) * p.gla_w_alpha[r * 256 + h * 64 + kk];
            const float ls = fminf(z, 0.f) - log1pf(expf(-fabsf(z)));
            sa[e] = expf(ls * (1.f / 16.f)); }
        for (int e = tid; e < 8192; e += NTHREADS) { const int tt = e >> 7, vv = e & 127; sv[e] = bf2f(proj[(size_t)(b * SEQ + t0 + tt) * NIN_PAD + C_GV + h * 128 + vv]); }
        __syncthreads();
        for (int tt = 0; tt < 64; ++tt) {
            const float vv = sv[tt * 128 + v]; float part = 0.f;
#pragma unroll
            for (int i = 0; i < 16; ++i) { const int kk = kq * 16 + i; S[i] = sa[tt * 64 + kk] * S[i] + sk[tt * 64 + kk] * vv; part += sq[tt * 64 + kk] * S[i]; }
            part += __shfl_xor(part, 1); part += __shfl_xor(part, 2);
            if (kq == 0) go[(size_t)(b * SEQ + t0 + tt) * 512 + h * 128 + v] = part * 0.125f;
        }
    }
}
__device__ __forceinline__ void ph_attn_naive(const Params& p, int gtid, int gthreads) {
    const bf16_t* proj = (const bf16_t*)(p.ws + WS_PROJ); bf16_t* mixed = (bf16_t*)(p.ws + WS_ACT);
    for (int idx = gtid; idx < M * 8; idx += gthreads) {
        const int t = idx & 8191, h = (idx >> 13) & 7, b = idx >> 16;
        const size_t row = (size_t)b * SEQ + t;
        float q[64], o[64];
        { const u32x4* qp = (const u32x4*)(proj + row * NIN_PAD + C_AQ + h * 64);
#pragma unroll
          for (int i = 0; i < 8; ++i) { const u32x4 w = qp[i]; q[8*i] = bflo(w.x); q[8*i+1] = bfhi(w.x); q[8*i+2] = bflo(w.y); q[8*i+3] = bfhi(w.y); q[8*i+4] = bflo(w.z); q[8*i+5] = bfhi(w.z); q[8*i+6] = bflo(w.w); q[8*i+7] = bfhi(w.w); } }
#pragma unroll
        for (int d = 0; d < 64; ++d) o[d] = 0.f;
        float mx = -1e30f, l = 0.f;
        const float slope = exp2f(-(float)(h + 1));
        for (int br = 0; br < 3; ++br) { const int dil = 1 << (2 * br);
            for (int j = 0; j <= 128; ++j) { const int tk = t - j * dil; if (tk < 0) break;
                const u32x4* kp = (const u32x4*)(proj + ((size_t)b * SEQ + tk) * NIN_PAD + C_AK + h * 64); const u32x4* vp = kp + 64;
                float s = 0.f;
#pragma unroll
                for (int i = 0; i < 8; ++i) { const u32x4 w = kp[i]; s += q[8*i] * bflo(w.x) + q[8*i+1] * bfhi(w.x) + q[8*i+2] * bflo(w.y) + q[8*i+3] * bfhi(w.y) + q[8*i+4] * bflo(w.z) + q[8*i+5] * bfhi(w.z) + q[8*i+6] * bflo(w.w) + q[8*i+7] * bfhi(w.w); }
                s = s * 0.125f - slope * (float)(j * dil);
                const float mn = fmaxf(mx, s), corr = __expf(mx - mn), pp = __expf(s - mn);
                l = l * corr + pp; mx = mn;
#pragma unroll
                for (int i = 0; i < 8; ++i) { const u32x4 w = vp[i];
                    o[8*i] = o[8*i] * corr + pp * bflo(w.x); o[8*i+1] = o[8*i+1] * corr + pp * bfhi(w.x); o[8*i+2] = o[8*i+2] * corr + pp * bflo(w.y); o[8*i+3] = o[8*i+3] * corr + pp * bfhi(w.y);
                    o[8*i+4] = o[8*i+4] * corr + pp * bflo(w.z); o[8*i+5] = o[8*i+5] * corr + pp * bfhi(w.z); o[8*i+6] = o[8*i+6] * corr + pp * bflo(w.w); o[8*i+7] = o[8*i+7] * corr + pp * bfhi(w.w); }
            } }
        const float rl = 1.f / l;
        u32x4* op = (u32x4*)(mixed + row * DM + 512 + h * 64);
#pragma unroll
        for (int i = 0; i < 8; ++i) { u32x4 w; w.x = pk2(o[8*i] * rl, o[8*i+1] * rl); w.y = pk2(o[8*i+2] * rl, o[8*i+3] * rl); w.z = pk2(o[8*i+4] * rl, o[8*i+5] * rl); w.w = pk2(o[8*i+6] * rl, o[8*i+7] * rl); op[i] = w; }
    }
}

constexpr int AT_K = 0, AT_V = 272 * 144, AT_END = 2 * 272 * 144;
typedef short s16x4 __attribute__((ext_vector_type(4)));
__device__ __forceinline__ s16x4 lds_tr16(LAS const unsigned char* pbyte) { return __builtin_bit_cast(s16x4, __builtin_amdgcn_ds_read_tr16_b64_v4i16((LAS s16x4*)pbyte)); }
__device__ __forceinline__ void ph_attn(const Params& p, const Ctx& c) {
    LAS unsigned char* L = c.lds;
    const bf16_t* proj = (const bf16_t*)(p.ws + WS_PROJ); bf16_t* AO = (bf16_t*)p.out; float* LSE = (float*)((unsigned char*)p.out + 96 * MiB);
    const int tid = c.tid, lane = c.lane, w = c.wave, r = lane & 15, qq = lane >> 4;
    constexpr float LOG2E = 1.4426950408889634f;
    __syncthreads();
    for (int i = tid; i < 16 * 144 / 4; i += NTHREADS) ((LAS unsigned*)(L + AT_V + 256 * 144))[i] = 0u;
    u32x4 kreg[4], vreg[4], qreg[2];
#define AT_DECODE(it_) const int h = (it_) & 7, rest = (it_) >> 3, br = rest >> 8, u = rest & 255, sh = 2 * br, dil = 1 << sh, nbm = (64 >> sh) - 1; \
        const int bres = u >> (6 - sh), blk = u & nbm, b = bres >> sh, res = bres & (dil - 1); const size_t rowb = (size_t)b * SEQ; const int l0 = blk * 128
#define AT_ISSUE(it_) do { AT_DECODE(it_); (void)br; \
        _Pragma("unroll") for (int k = 0; k < 4; ++k) { const int idx = tid + NTHREADS * k, row = idx >> 3, ch = idx & 7, l = l0 - 128 + row; kreg[k] = (u32x4){0u, 0u, 0u, 0u}; vreg[k] = kreg[k]; \
            if (l >= 0) { const bf16_t* src = proj + (rowb + (size_t)l * dil + res) * NIN_PAD + C_AK + h * 64 + ch * 8; kreg[k] = *(const u32x4*)src; vreg[k] = *(const u32x4*)(src + 512); } } \
        const bf16_t* qp = proj + (rowb + (size_t)(l0 + 16 * w + r) * dil + res) * NIN_PAD + C_AQ + h * 64 + 8 * qq; qreg[0] = *(const u32x4*)qp; qreg[1] = *(const u32x4*)(qp + 32); } while (0)
    if (c.blk < 6144) AT_ISSUE(c.blk);
    for (int item = c.blk; item < 6144; item += c.nblk) {
        AT_DECODE(item);
        __syncthreads();
#pragma unroll
        for (int k = 0; k < 4; ++k) { const int idx = tid + NTHREADS * k, row = idx >> 3, ch = idx & 7;
            *(LAS u32x4*)(L + AT_K + row * 144 + ch * 16) = kreg[k]; *(LAS u32x4*)(L + AT_V + row * 144 + ch * 16) = vreg[k]; }
        bf16x8 qf[2]; qf[0] = __builtin_bit_cast(bf16x8, qreg[0]); qf[1] = __builtin_bit_cast(bf16x8, qreg[1]);
        { const int nit = item + c.nblk; if (nit < 6144) AT_ISSUE(nit); }
        __syncthreads();
        f32x4 sa[9];
#pragma unroll
        for (int jn = 0; jn < 9; ++jn) { LAS const unsigned char* kp = L + AT_K + (16 * (w + jn) + r) * 144 + 16 * qq;
            const bf16x8 k0 = __builtin_bit_cast(bf16x8, *(const LAS u32x4*)kp), k1 = __builtin_bit_cast(bf16x8, *(const LAS u32x4*)(kp + 64));
            f32x4 z = {0.f, 0.f, 0.f, 0.f}; z = __builtin_amdgcn_mfma_f32_16x16x32_bf16(k0, qf[0], z, 0, 0, 0); sa[jn] = __builtin_amdgcn_mfma_f32_16x16x32_bf16(k1, qf[1], z, 0, 0, 0); }
        const float sc = 0.125f * LOG2E, sl = exp2f(-(float)(h + 1)) * (float)dil * LOG2E;
        const int delta0 = r + 128 - 4 * qq;
        const float b0 = -sl * (float)delta0;
        float mx = -1e30f;
        if (blk > 0) {
#pragma unroll
            for (int jn = 0; jn < 9; ++jn)
#pragma unroll
                for (int i = 0; i < 4; ++i) { const bool valid = (unsigned)(delta0 - (16 * jn + i)) <= 128u;
                    const float v = valid ? __builtin_fmaf(sa[jn][i], sc, __builtin_fmaf(sl, (float)(16 * jn + i), b0)) : -1e30f; sa[jn][i] = v; mx = fmaxf(mx, v); }
        } else {
#pragma unroll
            for (int jn = 0; jn < 9; ++jn)
#pragma unroll
                for (int i = 0; i < 4; ++i) { const bool valid = ((unsigned)(delta0 - (16 * jn + i)) <= 128u) && (16 * (w + jn) + 4 * qq + i >= 128);
                    const float v = valid ? __builtin_fmaf(sa[jn][i], sc, __builtin_fmaf(sl, (float)(16 * jn + i), b0)) : -1e30f; sa[jn][i] = v; mx = fmaxf(mx, v); }
        }
        mx = fmaxf(mx, __shfl_xor(mx, 16)); mx = fmaxf(mx, __shfl_xor(mx, 32));
        float sum = 0.f;
#pragma unroll
        for (int jn = 0; jn < 9; ++jn)
#pragma unroll
            for (int i = 0; i < 4; ++i) { const float e = __builtin_amdgcn_exp2f(sa[jn][i] - mx); sa[jn][i] = e; sum += e; }
        sum += __shfl_xor(sum, 16); sum += __shfl_xor(sum, 32);
        { const int qi = 16 * w + r; if (qq == 0) LSE[((size_t)br * M + rowb + (size_t)(l0 + qi) * dil + res) * 8 + h] = (mx + __builtin_amdgcn_logf(sum)) * (1.f / LOG2E); }
        f32x4 oa[4];
#pragma unroll
        for (int dt = 0; dt < 4; ++dt) oa[dt] = (f32x4){0.f, 0.f, 0.f, 0.f};
#pragma unroll
        for (int s2 = 0; s2 < 5; ++s2) { u32x4 pw; pw.x = pk2(sa[2 * s2][0], sa[2 * s2][1]); pw.y = pk2(sa[2 * s2][2], sa[2 * s2][3]);
            if (s2 < 4) { pw.z = pk2(sa[2 * s2 + 1][0], sa[2 * s2 + 1][1]); pw.w = pk2(sa[2 * s2 + 1][2], sa[2 * s2 + 1][3]); } else { pw.z = 0u; pw.w = 0u; }
            LAS const unsigned char* vp = L + AT_V + (16 * (w + 2 * s2) + 4 * qq + (r >> 2)) * 144 + 8 * (r & 3);
#pragma unroll
            for (int dt = 0; dt < 4; ++dt) { const s16x4 v0 = lds_tr16(vp + 32 * dt), v1 = lds_tr16(vp + 32 * dt + 16 * 144);
                const bf16x8 vf = {v0[0], v0[1], v0[2], v0[3], v1[0], v1[1], v1[2], v1[3]};
                oa[dt] = __builtin_amdgcn_mfma_f32_16x16x32_bf16(__builtin_bit_cast(bf16x8, pw), vf, oa[dt], 0, 0, 0); } }
        const float rs = __builtin_amdgcn_rcpf(sum);
        LAS bf16_t* ost = (LAS bf16_t*)(L + AT_END + w * 2304);
#pragma unroll
        for (int i = 0; i < 4; ++i) { const float ri = __shfl(rs, 4 * qq + i);
#pragma unroll
            for (int dt = 0; dt < 4; ++dt) ost[(4 * qq + i) * 72 + 16 * dt + r] = (bf16_t)f2bf(oa[dt][i] * ri); }
        asm volatile("" ::: "memory");
        { const int qi = lane >> 2, dc = (lane & 3) * 16;
          const u32x4 o0 = *(const LAS u32x4*)(ost + qi * 72 + dc), o1 = *(const LAS u32x4*)(ost + qi * 72 + dc + 8);
          bf16_t* op = AO + ((size_t)br * M + rowb + (size_t)(l0 + 16 * w + qi) * dil + res) * 512 + h * 64 + dc;
          *(u32x4*)op = o0; *(u32x4*)(op + 8) = o1; }
        asm volatile("" ::: "memory");
    }
#undef AT_DECODE
#undef AT_ISSUE
}

constexpr size_t WS_CKV = WS_S + 272 * MiB;
constexpr size_t WS_DEC = WS_S + 336 * MiB;
constexpr size_t WS_SPREV = WS_ACT;
constexpr int GL_SEGT = 0, GL_V = 2048, GL_KT = GL_V + 64 * 272, GL_QD = GL_KT + 64 * 144, GL_KI = GL_QD + 64 * 144, GL_END = GL_KI + 64 * 144;
__device__ __forceinline__ void gla_cumdecay(const Params& p, const Ctx& c, const bf16_t* prow0, int h, float (&bcum)[8], float& blast) {
    LAS float* SEGT = (LAS float*)(c.lds + GL_SEGT);
    const int kk = c.tid & 63, w = c.wave;
    float wa[16];
#pragma unroll
    for (int r = 0; r < 16; ++r) wa[r] = p.gla_w_alpha[r * 256 + h * 64 + kk];
    const float ba = p.gla_b_alpha[h * 64 + kk];
    float run = 0.f;
#pragma unroll
    for (int k = 0; k < 8; ++k) { const bf16_t* pr = prow0 + (size_t)(8 * w + k) * NIN_PAD + C_GLR;
        const u32x4 g0 = *(const u32x4*)pr, g1 = *(const u32x4*)(pr + 8);
        float z = ba + bflo(g0.x) * wa[0] + bfhi(g0.x) * wa[1] + bflo(g0.y) * wa[2] + bfhi(g0.y) * wa[3] + bflo(g0.z) * wa[4] + bfhi(g0.z) * wa[5] + bflo(g0.w) * wa[6] + bfhi(g0.w) * wa[7]
                     + bflo(g1.x) * wa[8] + bfhi(g1.x) * wa[9] + bflo(g1.y) * wa[10] + bfhi(g1.y) * wa[11] + bflo(g1.z) * wa[12] + bfhi(g1.z) * wa[13] + bflo(g1.w) * wa[14] + bfhi(g1.w) * wa[15];
        const float ls = fminf(z, 0.f) - __logf(1.f + __expf(-fabsf(z)));
        run += ls * (1.f / 16.f); bcum[k] = run; }
    __syncthreads();
    SEGT[w * 64 + kk] = run;
    __syncthreads();
    float off = 0.f, tot = 0.f;
#pragma unroll
    for (int sg = 0; sg < 8; ++sg) { const float v = SEGT[sg * 64 + kk]; off += (sg < w) ? v : 0.f; tot += v; }
#pragma unroll
    for (int k = 0; k < 8; ++k) bcum[k] += off;
    blast = tot;
}
__device__ __forceinline__ void gla_stage_v(const Ctx& c, const bf16_t* prow0, int h) {
#pragma unroll
    for (int k = 0; k < 2; ++k) { const int idx = c.tid + NTHREADS * k, row = idx >> 4, ch = idx & 15;
        *(LAS u32x4*)(c.lds + GL_V + row * 272 + ch * 16) = *(const u32x4*)(prow0 + (size_t)row * NIN_PAD + C_GV + h * 128 + ch * 8); }
}
__device__ __forceinline__ void ph_gla_a(const Params& p, const Ctx& c) {
    LAS unsigned char* L = c.lds; const bf16_t* proj = (const bf16_t*)(p.ws + WS_PROJ);
    float* CKV = (float*)(p.ws + WS_CKV); float* DEC = (float*)(p.ws + WS_DEC);
    const int tid = c.tid, lane = c.lane, w = c.wave, r = lane & 15, qq = lane >> 4, kk = tid & 63;
    for (int item = c.blk; item < 2048; item += c.nblk) {
        const int h = item & 3, bn = item >> 2; const bf16_t* prow0 = proj + (size_t)bn * 64 * NIN_PAD;
        float bcum[8], blast; gla_cumdecay(p, c, prow0, h, bcum, blast);
        gla_stage_v(c, prow0, h);
        { u32x4 o; float e[8];
#pragma unroll
          for (int k = 0; k < 8; ++k) e[k] = bf2f(prow0[(size_t)(8 * w + k) * NIN_PAD + C_GK + h * 64 + kk]) * __expf(blast - bcum[k]);
          o.x = pk2(e[0], e[1]); o.y = pk2(e[2], e[3]); o.z = pk2(e[4], e[5]); o.w = pk2(e[6], e[7]);
          *(LAS u32x4*)(L + GL_KT + kk * 144 + 16 * w) = o; }
        if (w == 0) DEC[(size_t)item * 64 + kk] = __expf(blast);
        __syncthreads();
        f32x4 acc[4];
#pragma unroll
        for (int n = 0; n < 4; ++n) acc[n] = (f32x4){0.f, 0.f, 0.f, 0.f};
#pragma unroll
        for (int s2 = 0; s2 < 2; ++s2) { LAS const unsigned char* vp = L + GL_V + (32 * s2 + 8 * qq + (r >> 2)) * 272 + (16 * w + 4 * (r & 3)) * 2;
            const s16x4 v0 = lds_tr16(vp), v1 = lds_tr16(vp + 4 * 272); const bf16x8 af = {v0[0], v0[1], v0[2], v0[3], v1[0], v1[1], v1[2], v1[3]};
#pragma unroll
            for (int n = 0; n < 4; ++n) { const bf16x8 bfr = __builtin_bit_cast(bf16x8, *(const LAS u32x4*)(L + GL_KT + (16 * n + r) * 144 + (32 * s2 + 8 * qq) * 2));
                acc[n] = __builtin_amdgcn_mfma_f32_16x16x32_bf16(af, bfr, acc[n], 0, 0, 0); } }
        float* outp = CKV + (size_t)item * 8192 + (16 * w + 4 * qq) * 64 + r;
#pragma unroll
        for (int n = 0; n < 4; ++n)
#pragma unroll
            for (int i = 0; i < 4; ++i) outp[i * 64 + 16 * n] = acc[n][i];
    }
}
__device__ __forceinline__ void ph_gla_b(const Params& p, const Ctx& c) {
    const float* CKV = (const float*)(p.ws + WS_CKV); const float* DEC = (const float*)(p.ws + WS_DEC); bf16_t* SP = (bf16_t*)(p.ws + WS_SPREV);
    for (int idx = c.gtid; idx < 16 * 8192; idx += c.gthreads) { const int bh = idx >> 13, e = idx & 8191, b = bh >> 2, h = bh & 3; float S = 0.f;
        for (int n0 = 0; n0 < 128; n0 += 8) { float cv[8], dv[8];
#pragma unroll
            for (int k = 0; k < 8; ++k) { const size_t item = (size_t)(b * 128 + n0 + k) * 4 + h; cv[k] = CKV[item * 8192 + e]; dv[k] = DEC[item * 64 + (e & 63)]; }
#pragma unroll
            for (int k = 0; k < 8; ++k) { const size_t item = (size_t)(b * 128 + n0 + k) * 4 + h; SP[item * 8192 + e] = (bf16_t)f2bf(S); S = dv[k] * S + cv[k]; } } }
}
__device__ __forceinline__ void ph_gla_c(const Params& p, const Ctx& c) {
    LAS unsigned char* L = c.lds; const bf16_t* proj = (const bf16_t*)(p.ws + WS_PROJ); const bf16_t* SP = (const bf16_t*)(p.ws + WS_SPREV); float* go = (float*)(p.ws + WS_GLAO);
    const int tid = c.tid, lane = c.lane, w = c.wave, r = lane & 15, qq = lane >> 4, kk = tid & 63;
    for (int item = c.blk; item < 2048; item += c.nblk) {
        const int h = item & 3, bn = item >> 2; const bf16_t* prow0 = proj + (size_t)bn * 64 * NIN_PAD;
        float bcum[8], blast; gla_cumdecay(p, c, prow0, h, bcum, blast);
        gla_stage_v(c, prow0, h);
#pragma unroll
        for (int k = 0; k < 8; ++k) { const int i = 8 * w + k; const bf16_t* pr = prow0 + (size_t)i * NIN_PAD;
            const float qv = bf2f(pr[C_GQ + h * 64 + kk]) * 0.125f * __expf(bcum[k]), kv = bf2f(pr[C_GK + h * 64 + kk]) * __expf(-bcum[k]);
            *(LAS bf16_t*)(L + GL_QD + i * 144 + kk * 2) = (bf16_t)f2bf(qv); *(LAS bf16_t*)(L + GL_KI + i * 144 + kk * 2) = (bf16_t)f2bf(kv); }
        __syncthreads();
        const int it = w & 3, vh = w >> 2;
        bf16x8 qf[2];
#pragma unroll
        for (int s2 = 0; s2 < 2; ++s2) qf[s2] = __builtin_bit_cast(bf16x8, *(const LAS u32x4*)(L + GL_QD + (16 * it + r) * 144 + (32 * s2 + 8 * qq) * 2));
        u32x2 pw[4];
#pragma unroll
        for (int jt = 0; jt < 4; ++jt) { f32x4 z = {0.f, 0.f, 0.f, 0.f};
            if (jt <= it) {
#pragma unroll
                for (int s2 = 0; s2 < 2; ++s2) { const bf16x8 kf = __builtin_bit_cast(bf16x8, *(const LAS u32x4*)(L + GL_KI + (16 * jt + r) * 144 + (32 * s2 + 8 * qq) * 2));
                    z = __builtin_amdgcn_mfma_f32_16x16x32_bf16(kf, qf[s2], z, 0, 0, 0); }
#pragma unroll
                for (int ii = 0; ii < 4; ++ii) z[ii] = (16 * jt + 4 * qq + ii <= 16 * it + r) ? z[ii] : 0.f; }
            pw[jt].x = pk2(z[0], z[1]); pw[jt].y = pk2(z[2], z[3]); }
        f32x4 acc[4];
#pragma unroll
        for (int n = 0; n < 4; ++n) acc[n] = (f32x4){0.f, 0.f, 0.f, 0.f};
#pragma unroll
        for (int s2 = 0; s2 < 2; ++s2) { if (2 * s2 <= it) {
            const u32x4 pq = {pw[2 * s2].x, pw[2 * s2].y, pw[2 * s2 + 1].x, pw[2 * s2 + 1].y};
            LAS const unsigned char* vp = L + GL_V + (32 * s2 + 4 * qq + (r >> 2)) * 272 + (64 * vh + 4 * (r & 3)) * 2;
#pragma unroll
            for (int n = 0; n < 4; ++n) { const s16x4 v0 = lds_tr16(vp + 32 * n), v1 = lds_tr16(vp + 32 * n + 16 * 272);
                const bf16x8 vf = {v0[0], v0[1], v0[2], v0[3], v1[0], v1[1], v1[2], v1[3]};
                acc[n] = __builtin_amdgcn_mfma_f32_16x16x32_bf16(__builtin_bit_cast(bf16x8, pq), vf, acc[n], 0, 0, 0); } } }
#pragma unroll
        for (int s2 = 0; s2 < 2; ++s2)
#pragma unroll
            for (int n = 0; n < 4; ++n) { const bf16x8 sf = __builtin_bit_cast(bf16x8, *(const u32x4*)(SP + (size_t)item * 8192 + (64 * vh + 16 * n + r) * 64 + 32 * s2 + 8 * qq));
                acc[n] = __builtin_amdgcn_mfma_f32_16x16x32_bf16(qf[s2], sf, acc[n], 0, 0, 0); }
        float* outp = go + ((size_t)bn * 64 + 16 * it + 4 * qq) * 512 + h * 128 + 64 * vh + r;
#pragma unroll
        for (int n = 0; n < 4; ++n)
#pragma unroll
            for (int ii = 0; ii < 4; ++ii) outp[ii * 512 + 16 * n] = acc[n][ii];
    }
}
#ifndef ATT_COMBINE
#define ATT_COMBINE 1
#endif
__device__ __forceinline__ void ph_mix(const Params& p, const Ctx& c) {
    const bf16_t* proj = (const bf16_t*)(p.ws + WS_PROJ); const float* go = (const float*)(p.ws + WS_GLAO); bf16_t* mixed = (bf16_t*)(p.ws + WS_ACT);
    for (int m = c.gwave; m < M; m += c.gwaves) {
#pragma unroll
        for (int h = 0; h < 4; ++h) { const int col = h * 128 + 2 * c.lane;
            const float o0 = go[(size_t)m * 512 + col], o1 = go[(size_t)m * 512 + col + 1];
            const float rstd = 1.f / sqrtf(wave_sum(o0 * o0 + o1 * o1) * (1.f / 128.f) + NORM_EPS);
            const unsigned gw = *(const unsigned*)(proj + (size_t)m * NIN_PAD + C_GG + col); const float g0 = bflo(gw), g1 = bfhi(gw);
            const float r0 = o0 * rstd * p.gla_head_gain[col] * (g0 * sigmoidf_(g0)), r1 = o1 * rstd * p.gla_head_gain[col + 1] * (g1 * sigmoidf_(g1));
            *(unsigned*)(mixed + (size_t)m * DM + col) = pk2(r0, r1); }
        if (ATT_COMBINE) {
            const bf16_t* AO = (const bf16_t*)p.out; const float* LSE = (const float*)((const unsigned char*)p.out + 96 * MiB); const int hh = c.lane >> 3;
            const float l0 = LSE[((size_t)0 * M + m) * 8 + hh], l1 = LSE[((size_t)1 * M + m) * 8 + hh], l2 = LSE[((size_t)2 * M + m) * 8 + hh];
            const float lm = fmaxf(l0, fmaxf(l1, l2)), e0 = __expf(l0 - lm), e1 = __expf(l1 - lm), e2 = __expf(l2 - lm), rd = __builtin_amdgcn_rcpf(e0 + e1 + e2);
            const float w0 = e0 * rd, w1 = e1 * rd, w2 = e2 * rd;
            const u32x4 a0 = *((const u32x4*)(AO + ((size_t)0 * M + m) * 512) + c.lane), a1 = *((const u32x4*)(AO + ((size_t)1 * M + m) * 512) + c.lane), a2 = *((const u32x4*)(AO + ((size_t)2 * M + m) * 512) + c.lane);
            u32x4 o;
            o.x = pk2(w0 * bflo(a0.x) + w1 * bflo(a1.x) + w2 * bflo(a2.x), w0 * bfhi(a0.x) + w1 * bfhi(a1.x) + w2 * bfhi(a2.x));
            o.y = pk2(w0 * bflo(a0.y) + w1 * bflo(a1.y) + w2 * bflo(a2.y), w0 * bfhi(a0.y) + w1 * bfhi(a1.y) + w2 * bfhi(a2.y));
            o.z = pk2(w0 * bflo(a0.z) + w1 * bflo(a1.z) + w2 * bflo(a2.z), w0 * bfhi(a0.z) + w1 * bfhi(a1.z) + w2 * bfhi(a2.z));
            o.w = pk2(w0 * bflo(a0.w) + w1 * bflo(a1.w) + w2 * bflo(a2.w), w0 * bfhi(a0.w) + w1 * bfhi(a1.w) + w2 * bfhi(a2.w));
            *((u32x4*)(mixed + (size_t)m * DM + 512) + c.lane) = o; }
    }
}


constexpr int GR_WGT = 0, GR_XC = 65536, GR_A = 81920, GR_U = 115712, GR_SEG = 132608, GR_CW = 136704, GR_GB = 139264;
__device__ __forceinline__ float fast_sigmoid(float x) { return __builtin_amdgcn_rcpf(1.f + __expf(-x)); }
template <bool FULL> __device__ __forceinline__ void griffin_pass(const Params& p, const Ctx& c) {
    LAS unsigned char* L = c.lds;
    const int tid = c.tid, lane = c.lane, wave = c.wave, g = c.blk & 7;
    const bf16_t* proj = (const bf16_t*)(p.ws + WS_PROJ); bf16_t* yout = (bf16_t*)(p.ws + WS_ACT);
    float* AGA = (float*)(p.ws + WS_AGG); float* AGH = AGA + BATCH * 128 * 1024; const float* CAR = AGH + BATCH * 128 * 1024;
    LAS float* A_ = (LAS float*)(L + GR_A); LAS bf16_t* U_ = (LAS bf16_t*)(L + GR_U); LAS float* SEG = (LAS float*)(L + GR_SEG); LAS float* CW = (LAS float*)(L + GR_CW); LAS float* GB = (LAS float*)(L + GR_GB);
    __syncthreads();
    { const bf16_t* wg = (const bf16_t*)(p.ws + WS_WG);
      for (int ch = tid; ch < 4096; ch += NTHREADS) { const int gate = ch >> 11, j = (ch >> 4) & 127, cc = ch & 15;
          const u32x4 v = *(const u32x4*)(wg + ((size_t)(gate * 8 + g) * 128 + j) * 128 + cc * 8);
          *(LAS u32x4*)(L + GR_WGT + gate * 32768 + j * 256 + ((cc ^ (j & 15)) << 4)) = v; }
      if (tid < 128) { const int ch = g * 128 + tid;
#pragma unroll
          for (int jj = 0; jj < 4; ++jj) CW[jj * 128 + tid] = p.c_conv_w[jj * 1024 + ch];
          CW[4 * 128 + tid] = p.c_conv_b[ch]; GB[tid] = p.c_b_rgate[ch]; GB[128 + tid] = p.c_b_igate[ch];
          const float lam = p.c_lambda[ch]; GB[256 + tid] = fmaxf(-lam, 0.f) + log1pf(expf(-fabsf(lam))); } }
    __syncthreads();
    const int nslot = BATCH * 128, sstep = c.nblk >> 3;
    u32x4 xr[5];
#define GR_XLOAD(sl_) do { const int b_ = (sl_) >> 7, t0_ = ((sl_) & 127) * 64; const size_t r0_ = (size_t)b_ * SEQ + t0_; const int co_ = tid & 15, tp_ = tid >> 4; \
        _Pragma("unroll") for (int jj = 0; jj < 5; ++jj) { const int tt = t0_ + 2 * tp_ - 3 + jj; xr[jj] = (u32x4){0u, 0u, 0u, 0u}; \
            if (tt >= 0) xr[jj] = *(const u32x4*)(proj + (r0_ + 2 * tp_ - 3 + jj) * 2048 + 1024 + g * 128 + co_ * 8); } } while (0)
    if ((c.blk >> 3) < nslot) GR_XLOAD(c.blk >> 3);
    for (int slot = c.blk >> 3; slot < nslot; slot += sstep) {
        const int b = slot >> 7, tile = slot & 127, t0 = tile * 64; const size_t row0 = (size_t)b * SEQ + t0;
        u32x4 gpre[2];
        if (FULL) { const int co = tid & 15, tp = tid >> 4;
#pragma unroll
            for (int tl = 0; tl < 2; ++tl) gpre[tl] = *(const u32x4*)(proj + (row0 + 2 * tp + tl) * 2048 + g * 128 + co * 8); }
        { const int co = tid & 15, tp = tid >> 4;
          f32x4 w[5][2];
#pragma unroll
          for (int jj = 0; jj < 5; ++jj) { w[jj][0] = *(const LAS f32x4*)(CW + jj * 128 + co * 8); w[jj][1] = *(const LAS f32x4*)(CW + jj * 128 + co * 8 + 4); }
#pragma unroll
          for (int tl = 0; tl < 2; ++tl) { float a8[8];
#pragma unroll
              for (int e = 0; e < 8; ++e) a8[e] = w[4][e >> 2][e & 3];
#pragma unroll
              for (int jj = 0; jj < 4; ++jj) { const u32x4 xv = xr[tl + jj]; const unsigned xw[4] = {xv.x, xv.y, xv.z, xv.w};
#pragma unroll
                  for (int e = 0; e < 8; ++e) { const float xe = (e & 1) ? bfhi(xw[e >> 1]) : bflo(xw[e >> 1]); a8[e] += w[jj][e >> 2][e & 3] * xe; } }
              const int t = 2 * tp + tl; u32x4 o; o.x = pk2(a8[0], a8[1]); o.y = pk2(a8[2], a8[3]); o.z = pk2(a8[4], a8[5]); o.w = pk2(a8[6], a8[7]);
              *(LAS u32x4*)(L + GR_XC + t * 256 + ((co ^ (t & 15)) << 4)) = o; } }
        if (slot + sstep < nslot) GR_XLOAD(slot + sstep);
        __syncthreads();
        { const int tt = wave & 3, jh = wave >> 2, r = lane & 15, q = lane >> 4, t = 16 * tt + r;
          f32x4 ar[4], ai[4];
#pragma unroll
          for (int n = 0; n < 4; ++n) { ar[n] = (f32x4){0.f, 0.f, 0.f, 0.f}; ai[n] = (f32x4){0.f, 0.f, 0.f, 0.f}; }
#pragma unroll
          for (int s = 0; s < 4; ++s) { const bf16x8 xb = __builtin_bit_cast(bf16x8, *(const LAS u32x4*)(L + GR_XC + t * 256 + (((4 * s + q) ^ (t & 15)) << 4)));
#pragma unroll
              for (int n = 0; n < 4; ++n) { const int j = 64 * jh + 16 * n + r;
                  const bf16x8 wr = __builtin_bit_cast(bf16x8, *(const LAS u32x4*)(L + GR_WGT + j * 256 + (((4 * s + q) ^ (j & 15)) << 4)));
                  const bf16x8 wi = __builtin_bit_cast(bf16x8, *(const LAS u32x4*)(L + GR_WGT + 32768 + j * 256 + (((4 * s + q) ^ (j & 15)) << 4)));
                  ar[n] = __builtin_amdgcn_mfma_f32_16x16x32_bf16(wr, xb, ar[n], 0, 0, 0); ai[n] = __builtin_amdgcn_mfma_f32_16x16x32_bf16(wi, xb, ai[n], 0, 0, 0); } }
#pragma unroll
          for (int n = 0; n < 4; ++n) { const int j0 = 64 * jh + 16 * n + 4 * q;
              const f32x4 br = *(const LAS f32x4*)(GB + j0), bi = *(const LAS f32x4*)(GB + 128 + j0), sp = *(const LAS f32x4*)(GB + 256 + j0);
              const u32x2 xw = *(const LAS u32x2*)(L + GR_XC + t * 256 + ((((j0 >> 3) ^ (t & 15)) << 4) + (j0 & 7) * 2));
              const float xc[4] = {bflo(xw.x), bfhi(xw.x), bflo(xw.y), bfhi(xw.y)};
              f32x4 av; float uv[4];
#pragma unroll
              for (int i = 0; i < 4; ++i) { const float rr = fast_sigmoid(ar[n][i] + br[i]), ii = fast_sigmoid(ai[n][i] + bi[i]);
                  const float a = __expf(-8.f * rr * sp[i]); av[i] = a; uv[i] = __builtin_amdgcn_sqrtf(fmaxf(1.f - a * a, 0.f)) * (ii * xc[i]); }
              *(LAS f32x4*)(A_ + t * 132 + j0) = av; u32x2 uo; uo.x = pk2(uv[0], uv[1]); uo.y = pk2(uv[2], uv[3]); *(LAS u32x2*)(U_ + t * 132 + j0) = uo; } }
        __syncthreads();
        const int j = tid & 127, seg = tid >> 7;
        { float aa = 1.f, hh = 0.f;
#pragma unroll
          for (int i = 0; i < 16; ++i) { const int t = seg * 16 + i; const float a = A_[t * 132 + j], u = bf2f(U_[t * 132 + j]); hh = a * hh + u; aa *= a; }
          SEG[seg * 128 + j] = aa; SEG[512 + seg * 128 + j] = hh; }
        __syncthreads();
        if (!FULL) {
            if (tid < 128) { float A = 1.f, H = 0.f;
#pragma unroll
                for (int sgi = 0; sgi < 4; ++sgi) { H = SEG[sgi * 128 + tid] * H + SEG[512 + sgi * 128 + tid]; A *= SEG[sgi * 128 + tid]; }
                const size_t e = ((size_t)b * 128 + tile) * 1024 + g * 128 + tid; AGA[e] = A; AGH[e] = H; }
        } else {
            float h = CAR[((size_t)b * 128 + tile) * 1024 + g * 128 + j];
            for (int sgi = 0; sgi < seg; ++sgi) h = SEG[sgi * 128 + j] * h + SEG[512 + sgi * 128 + j];
#pragma unroll
            for (int i = 0; i < 16; ++i) { const int t = seg * 16 + i; const float a = A_[t * 132 + j], u = bf2f(U_[t * 132 + j]); h = a * h + u; A_[t * 132 + j] = h; }
            __syncthreads();
            { const int co = tid & 15, tp = tid >> 4;
#pragma unroll
              for (int tl = 0; tl < 2; ++tl) { const int t = 2 * tp + tl;
                  const f32x4 h0 = *(const LAS f32x4*)(A_ + t * 132 + co * 8), h1 = *(const LAS f32x4*)(A_ + t * 132 + co * 8 + 4);
                  const u32x4 gw = gpre[tl];
                  u32x4 o; o.x = pk2(gelu_tanh(bflo(gw.x)) * h0.x, gelu_tanh(bfhi(gw.x)) * h0.y); o.y = pk2(gelu_tanh(bflo(gw.y)) * h0.z, gelu_tanh(bfhi(gw.y)) * h0.w);
                  o.z = pk2(gelu_tanh(bflo(gw.z)) * h1.x, gelu_tanh(bfhi(gw.z)) * h1.y); o.w = pk2(gelu_tanh(bflo(gw.w)) * h1.z, gelu_tanh(bfhi(gw.w)) * h1.w);
                  *(u32x4*)(yout + (row0 + t) * DM + g * 128 + co * 8) = o; } }
        }
    }
#undef GR_XLOAD
}
__device__ __forceinline__ void ph_carry(const Params& p, const Ctx& c) {
    const float* AGA = (const float*)(p.ws + WS_AGG); const float* AGH = AGA + BATCH * 128 * 1024; float* CAR = (float*)(AGH + BATCH * 128 * 1024);
    for (int idx = c.gtid; idx < BATCH * 1024; idx += c.gthreads) { const int b = idx >> 10, ch = idx & 1023; float cy = 0.f;
        for (int t0 = 0; t0 < 128; t0 += 8) { float a[8], h[8];
#pragma unroll
            for (int k = 0; k < 8; ++k) { const size_t e = ((size_t)b * 128 + t0 + k) * 1024 + ch; a[k] = AGA[e]; h[k] = AGH[e]; }
#pragma unroll
            for (int k = 0; k < 8; ++k) { CAR[((size_t)b * 128 + t0 + k) * 1024 + ch] = cy; cy = a[k] * cy + h[k]; } } }
}
__device__ __forceinline__ void cvt_gate_weights(const Params& p, const Ctx& c) {
    bf16_t* wg = (bf16_t*)(p.ws + WS_WG);
    for (int idx = c.gtid; idx < 2 * 8 * 16 * 128; idx += c.gthreads) { const int j = idx & 127, io = (idx >> 7) & 15, g = (idx >> 11) & 7, gate = idx >> 14;
        const float* s = (gate ? p.c_w_igate : p.c_w_rgate) + (size_t)g * 16384 + (io * 8) * 128 + j;
        u32x4 w; w.x = pk2(s[0], s[128]); w.y = pk2(s[256], s[384]); w.z = pk2(s[512], s[640]); w.w = pk2(s[768], s[896]);
        *(u32x4*)(wg + ((size_t)(gate * 8 + g) * 128 + j) * 128 + io * 8) = w; }
}


constexpr size_t WS_SK = 25 * MiB;
constexpr int TK_SK = 0, TK_Q = 69632, TK_S = 86528, TK_L = 119552  , TK_O = 135936, TK_TAB = 144128;
typedef int i32x4 __attribute__((ext_vector_type(4)));
__device__ __forceinline__ int key_xform(int b) { return b ^ ((b >> 31) & 0x7fffffff); }
#define CEX(a, b) do { const int hi_ = max((a), (b)), lo_ = min((a), (b)); (a) = hi_; (b) = lo_; } while (0)
__device__ __forceinline__ void bitonic_merge16_desc(int (&v)[16]) {
#pragma unroll
    for (int j = 8; j >= 1; j >>= 1)
#pragma unroll
        for (int i = 0; i < 16; ++i) if ((i & j) == 0) CEX(v[i], v[i | j]);
}
__device__ __forceinline__ void bitonic_sort16_desc(int (&v)[16]) {
#pragma unroll
    for (int k = 2; k <= 16; k <<= 1)
#pragma unroll
        for (int j = k >> 1; j >= 1; j >>= 1)
#pragma unroll
            for (int i = 0; i < 16; ++i) { const int l = i ^ j; if (l > i) { if ((i & k) == 0 || k == 16) CEX(v[i], v[l]); else CEX(v[l], v[i]); } }
}
__device__ __forceinline__ void ph_topk(const Params& p, int layer, const Ctx& c) {
    LAS unsigned char* L = c.lds; const bf16_t* Q = (const bf16_t*)(p.ws + WS_PROJ);
    int* ids = (int*)(p.ws + WS_IDS); float* gg = (float*)(p.ws + WS_G);
    const int tid = c.tid, lane = c.lane, w = c.wave, r = lane & 15, qq = lane >> 4, h = c.blk & 7;
    LAS float* S = (LAS float*)(L + TK_S); LAS int* LST = (LAS int*)(L + TK_L); LAS int* OUTK = (LAS int*)(L + TK_O); LAS int* TAB = (LAS int*)(L + TK_TAB);
    __syncthreads();
    { const bf16_t* sk = (const bf16_t*)(p.ws + WS_SK) + ((size_t)layer * 8 + h) * 2 * 128 * 128;
      for (int ch = tid; ch < 4096; ch += NTHREADS) { const int row = ch >> 4, cc = ch & 15;
          *(LAS u32x4*)(L + TK_SK + row * 272 + cc * 16) = *(const u32x4*)(sk + (size_t)row * 128 + cc * 8); }
      if (tid < 64) { int cnt = 0, code = -1;
          for (int i = 0; i < 16; ++i) for (int j = 0; j < 16 / (i + 1); ++j) { if (cnt == tid) code = i * 16 + j; ++cnt; }
          TAB[tid] = code; } }
    const int nslot = M / 32, sstep = c.nblk >> 3;
    u32x4 qpre[2];
#define TK_QLOAD(sl_) do { _Pragma("unroll") for (int k = 0; k < 2; ++k) { const int idx = tid + NTHREADS * k, row = idx >> 5, ch = idx & 31; \
        qpre[k] = *(const u32x4*)(Q + (size_t)(min((sl_), nslot - 1) * 32 + row) * 2048 + h * 256 + ch * 8); } } while (0)
#define TK_MERGE(CTRL) do { int o_[16]; _Pragma("unroll") for (int i = 0; i < 16; ++i) o_[i] = __builtin_amdgcn_update_dpp(0, v[15 - i], (CTRL), 0xf, 0xf, false); \
        _Pragma("unroll") for (int i = 0; i < 16; ++i) v[i] = max(v[i], o_[i]); bitonic_merge16_desc(v); } while (0)
    TK_QLOAD(c.blk >> 3);
    int gfirst = 0, gi = 0;
    for (int slot = c.blk >> 3; slot < nslot; slot += sstep) {
        __syncthreads();
#pragma unroll
        for (int k = 0; k < 2; ++k) { const int idx = tid + NTHREADS * k, row = idx >> 5, ch = idx & 31; *(LAS u32x4*)(L + TK_Q + row * 528 + ch * 16) = qpre[k]; }
        TK_QLOAD(slot + sstep);
        __syncthreads();
        { const int pp = w >> 2, mt = (w >> 1) & 1, nh = w & 1;
          f32x4 acc[4];
#pragma unroll
          for (int nt = 0; nt < 4; ++nt) acc[nt] = (f32x4){0.f, 0.f, 0.f, 0.f};
#pragma unroll
          for (int s2 = 0; s2 < 4; ++s2) { const bf16x8 af = __builtin_bit_cast(bf16x8, *(const LAS u32x4*)(L + TK_Q + (16 * mt + r) * 528 + (pp * 128 + 32 * s2 + 8 * qq) * 2));
#pragma unroll
              for (int nt = 0; nt < 4; ++nt) { const bf16x8 bfr = __builtin_bit_cast(bf16x8, *(const LAS u32x4*)(L + TK_SK + (pp * 128 + 16 * (4 * nh + nt) + r) * 272 + (32 * s2 + 8 * qq) * 2));
                  acc[nt] = __builtin_amdgcn_mfma_f32_16x16x32_bf16(af, bfr, acc[nt], 0, 0, 0); } }
#pragma unroll
          for (int nt = 0; nt < 4; ++nt)
#pragma unroll
              for (int i = 0; i < 4; ++i) S[(pp * 32 + 16 * mt + 4 * qq + i) * 129 + 16 * (4 * nh + nt) + r] = acc[nt][i]; }
        __syncthreads();
        {
          const int m = tid >> 4, sub = tid & 15, pp = sub >> 3, part = sub & 7; int v[16];
#pragma unroll
          for (int k = 0; k < 16; ++k) { const int n = 8 * k + part; v[k] = key_xform((__builtin_bit_cast(int, S[(pp * 32 + m) * 129 + n]) & ~127) | n); }
          bitonic_sort16_desc(v);
          TK_MERGE(0xB1);
          TK_MERGE(0x4E);
          TK_MERGE(0x141);
          if (part == 0) {
#pragma unroll
              for (int k = 0; k < 16; ++k) LST[((gi * 32 + m) * 2 + pp) * 16 + k] = key_xform(v[k]); } }
        if (gi == 0) gfirst = slot;
        ++gi;
        if (gi < 4 && slot + sstep < nslot) continue;
        __syncthreads();
        {
          const int tq = tid >> 2, sub = tid & 3, grp = tq >> 5, m = tq & 31;
          if (grp < gi) {
              const int slot_g = gfirst + grp * sstep;
              LAS const int* L1 = LST + (tq * 2 + 0) * 16; LAS const int* L2 = LST + (tq * 2 + 1) * 16;
              int v[16];
#pragma unroll
              for (int k = 0; k < 16; ++k) { const int ci = sub * 16 + k; const int code = TAB[ci]; int key = (int)0x80000000;
                  if (code >= 0) { const float s1 = __builtin_bit_cast(float, L1[code >> 4] & ~127), s2v = __builtin_bit_cast(float, L2[code & 15] & ~127);
                      key = key_xform((__builtin_bit_cast(int, s1 + s2v) & ~63) | (63 - ci)); }
                  v[k] = key; }
              bitonic_sort16_desc(v);
              TK_MERGE(0xB1); TK_MERGE(0x4E);
              const float smax = __builtin_bit_cast(float, key_xform(v[0]) & ~63);
              if (sub == 0) {
#pragma unroll
                  for (int k4 = 0; k4 < 4; ++k4) *(LAS i32x4*)(OUTK + tq * 16 + 4 * k4) = (i32x4){v[4 * k4], v[4 * k4 + 1], v[4 * k4 + 2], v[4 * k4 + 3]}; }
              asm volatile("s_waitcnt lgkmcnt(0)" ::: "memory");
              const i32x4 mine = *(const LAS i32x4*)(OUTK + tq * 16 + 4 * sub);
              float e[4]; int kb[4];
#pragma unroll
              for (int j = 0; j < 4; ++j) { kb[j] = key_xform(mine[j]); e[j] = __expf(__builtin_bit_cast(float, kb[j] & ~63) - smax); }
              float den = (e[0] + e[1]) + (e[2] + e[3]);
              den += __builtin_bit_cast(float, __builtin_amdgcn_update_dpp(0, __builtin_bit_cast(int, den), 0xB1, 0xf, 0xf, false));
              den += __builtin_bit_cast(float, __builtin_amdgcn_update_dpp(0, __builtin_bit_cast(int, den), 0x4E, 0xf, 0xf, false));
              const float rden = __builtin_amdgcn_rcpf(den); i32x4 oi; f32x4 og;
#pragma unroll
              for (int j = 0; j < 4; ++j) { const int code = TAB[63 - (kb[j] & 63)]; oi[j] = (L1[code >> 4] & 127) * 128 + (L2[code & 15] & 127); og[j] = e[j] * rden; }
              const size_t o = (size_t)(slot_g * 32 + m) * 128 + h * 16 + 4 * sub;
              *(i32x4*)(ids + o) = oi; *(f32x4*)(gg + o) = og; } }
        gi = 0;
    }
#undef TK_QLOAD
#undef TK_MERGE
}

__device__ __forceinline__ void ph_topk1(const Params& p, int layer, const Ctx& c) {
    const bf16_t* Q = (const bf16_t*)(p.ws + WS_PROJ); float* tops = (float*)(p.ws + WS_TOPS); int* topi = (int*)(p.ws + WS_TOPI);
    const float* keys = p.peer_sub_keys + (size_t)layer * 16 * 128 * 128;
    for (int gid = c.gtid; gid < M * 32; gid += c.gthreads) {
        const int idx = gid >> 1, half = gid & 1;
        const int t = idx & (M - 1), hp = __builtin_amdgcn_readfirstlane(idx >> 15);
        float q[64];
        { const u32x4* qp = (const u32x4*)(Q + (size_t)t * 2048 + hp * 128 + half * 64);
#pragma unroll
          for (int i = 0; i < 8; ++i) { const u32x4 w = qp[i]; q[8*i] = bflo(w.x); q[8*i+1] = bfhi(w.x); q[8*i+2] = bflo(w.y); q[8*i+3] = bfhi(w.y); q[8*i+4] = bflo(w.z); q[8*i+5] = bfhi(w.z); q[8*i+6] = bflo(w.w); q[8*i+7] = bfhi(w.w); } }
        float ls[16]; int li[16];
#pragma unroll
        for (int j = 0; j < 16; ++j) { ls[j] = -3.0e38f; li[j] = 0; }
        for (int n = 0; n < 128; ++n) { const float* kr = keys + ((size_t)hp * 128 + n) * 128 + half * 64;
            float s = 0.f;
#pragma unroll
            for (int cc = 0; cc < 64; ++cc) s += q[cc] * kr[cc];
            s += __shfl_xor(s, 1);
            int ni = n;
#pragma unroll
            for (int j = 0; j < 16; ++j) { const bool gt = s > ls[j]; const float ts = gt ? ls[j] : s; const int ti = gt ? li[j] : ni; ls[j] = gt ? s : ls[j]; li[j] = gt ? ni : li[j]; s = ts; ni = ti; }
        }
        if (half == 0) { float* os = tops + ((size_t)t * 16 + hp) * 16; int* oi = topi + ((size_t)t * 16 + hp) * 16;
#pragma unroll
            for (int j = 0; j < 16; ++j) { os[j] = ls[j]; oi[j] = li[j]; } }
    }
}
__device__ __forceinline__ void ph_topk2(const Params& p, const Ctx& c) {
    const float* tops = (const float*)(p.ws + WS_TOPS); const int* topi = (const int*)(p.ws + WS_TOPI);
    int* ids = (int*)(p.ws + WS_IDS); float* gg = (float*)(p.ws + WS_G);
    for (int idx = c.gtid; idx < M * 8; idx += c.gthreads) {
        const int t = idx >> 3, h = idx & 7;
        float s1[16], s2[16]; int i1[16], i2[16];
        { const float* a = tops + ((size_t)t * 16 + h * 2) * 16; const int* ai = topi + ((size_t)t * 16 + h * 2) * 16;
#pragma unroll
          for (int j = 0; j < 16; ++j) { s1[j] = a[j]; s2[j] = a[16 + j]; i1[j] = ai[j]; i2[j] = ai[16 + j]; } }
        float ls[16]; int lc[16];
#pragma unroll
        for (int j = 0; j < 16; ++j) { ls[j] = -3.0e38f; lc[j] = 0; }
#pragma unroll
        for (int i = 0; i < 16; ++i)
#pragma unroll
            for (int j = 0; j < 16 / (i + 1); ++j) { float s = s1[i] + s2[j]; int cd = i * 16 + j;
#pragma unroll
                for (int k = 0; k < 16; ++k) { const bool gt = s > ls[k]; const float ts = gt ? ls[k] : s; const int tc = gt ? lc[k] : cd; ls[k] = gt ? s : ls[k]; lc[k] = gt ? cd : lc[k]; s = ts; cd = tc; } }
        float den = 0.f, e[16];
#pragma unroll
        for (int k = 0; k < 16; ++k) { e[k] = __expf(ls[k] - ls[0]); den += e[k]; }
        const float rd = 1.f / den;
#pragma unroll
        for (int k = 0; k < 16; ++k) { const int ci = lc[k] >> 4, cj = lc[k] & 15; int a = 0, bq = 0;
#pragma unroll
            for (int z = 0; z < 16; ++z) { a = (ci == z) ? i1[z] : a; bq = (cj == z) ? i2[z] : bq; }
            ids[(size_t)t * 128 + h * 16 + k] = a * 128 + bq; gg[(size_t)t * 128 + h * 16 + k] = e[k] * rd; }
    }
}
__device__ __forceinline__ void ph_gather(const Params& p, const Ctx& c) {
    const bf16_t* XN = (const bf16_t*)(p.ws + WS_ACT); const bf16_t* UT = (const bf16_t*)(p.ws + WS_TAB); const bf16_t* VT = UT + (size_t)NEXP * DM;
    const int* ids = (const int*)(p.ws + WS_IDS); const float* gg = (const float*)(p.ws + WS_G);
    for (int m = c.gwave; m < M; m += c.gwaves) {
        float x[16], o[16];
        { const u32x4 a = *((const u32x4*)(XN + (size_t)m * DM) + c.lane), b = *((const u32x4*)(XN + (size_t)m * DM + 512) + c.lane);
          x[0] = bflo(a.x); x[1] = bfhi(a.x); x[2] = bflo(a.y); x[3] = bfhi(a.y); x[4] = bflo(a.z); x[5] = bfhi(a.z); x[6] = bflo(a.w); x[7] = bfhi(a.w);
          x[8] = bflo(b.x); x[9] = bfhi(b.x); x[10] = bflo(b.y); x[11] = bfhi(b.y); x[12] = bflo(b.z); x[13] = bfhi(b.z); x[14] = bflo(b.w); x[15] = bfhi(b.w); }
#pragma unroll
        for (int i = 0; i < 16; ++i) o[i] = 0.f;
        const int id0 = ids[(size_t)m * 128 + c.lane], id1 = ids[(size_t)m * 128 + 64 + c.lane];
        const float g0 = gg[(size_t)m * 128 + c.lane], g1 = gg[(size_t)m * 128 + 64 + c.lane];
        for (int k0 = 0; k0 < 128; k0 += 4) {
            u32x4 ua[4], ub[4], va[4], vb[4]; float gk[4];
#pragma unroll
            for (int j = 0; j < 4; ++j) { const int k = k0 + j; const int id = (k < 64) ? __shfl(id0, k) : __shfl(id1, k - 64); gk[j] = (k < 64) ? __shfl(g0, k) : __shfl(g1, k - 64);
                const u32x4* ur = (const u32x4*)(UT + (size_t)id * DM); const u32x4* vr = (const u32x4*)(VT + (size_t)id * DM);
                ua[j] = ur[c.lane]; ub[j] = ur[64 + c.lane]; va[j] = vr[c.lane]; vb[j] = vr[64 + c.lane]; }
#pragma unroll
            for (int j = 0; j < 4; ++j) {
                float d = x[0] * bflo(ua[j].x) + x[1] * bfhi(ua[j].x) + x[2] * bflo(ua[j].y) + x[3] * bfhi(ua[j].y) + x[4] * bflo(ua[j].z) + x[5] * bfhi(ua[j].z) + x[6] * bflo(ua[j].w) + x[7] * bfhi(ua[j].w)
                        + x[8] * bflo(ub[j].x) + x[9] * bfhi(ub[j].x) + x[10] * bflo(ub[j].y) + x[11] * bfhi(ub[j].y) + x[12] * bflo(ub[j].z) + x[13] * bfhi(ub[j].z) + x[14] * bflo(ub[j].w) + x[15] * bfhi(ub[j].w);
                d = wave_sum(d);
                const float act = gelu_tanh(d) * gk[j];
                o[0] += act * bflo(va[j].x); o[1] += act * bfhi(va[j].x); o[2] += act * bflo(va[j].y); o[3] += act * bfhi(va[j].y); o[4] += act * bflo(va[j].z); o[5] += act * bfhi(va[j].z); o[6] += act * bflo(va[j].w); o[7] += act * bfhi(va[j].w);
                o[8] += act * bflo(vb[j].x); o[9] += act * bfhi(vb[j].x); o[10] += act * bflo(vb[j].y); o[11] += act * bfhi(vb[j].y); o[12] += act * bflo(vb[j].z); o[13] += act * bfhi(vb[j].z); o[14] += act * bflo(vb[j].w); o[15] += act * bfhi(vb[j].w);
            }
        }
        f32x4* hp = (f32x4*)(p.out + (size_t)m * DM);
        f32x4 h0 = hp[2 * c.lane], h1 = hp[2 * c.lane + 1], h2 = hp[128 + 2 * c.lane], h3 = hp[128 + 2 * c.lane + 1];
        h0 += (f32x4){o[0], o[1], o[2], o[3]}; h1 += (f32x4){o[4], o[5], o[6], o[7]}; h2 += (f32x4){o[8], o[9], o[10], o[11]}; h3 += (f32x4){o[12], o[13], o[14], o[15]};
        hp[2 * c.lane] = h0; hp[2 * c.lane + 1] = h1; hp[128 + 2 * c.lane] = h2; hp[128 + 2 * c.lane + 1] = h3;
    }
}

__device__ __forceinline__ void ph_gather2(const Params& p, const Ctx& c) {
    const bf16_t* XN = (const bf16_t*)(p.ws + WS_ACT); const bf16_t* UT = (const bf16_t*)(p.ws + WS_TAB); const bf16_t* VT = UT + (size_t)NEXP * DM;
    const int* ids = (const int*)(p.ws + WS_IDS); const float* gg = (const float*)(p.ws + WS_G);
    LAS unsigned char* wl = c.lds + c.wave * 4096;
    LAS bf16_t* xs = (LAS bf16_t*)wl; LAS float* dsm = (LAS float*)(wl + 2048);
    const int lane = c.lane, r = lane & 15, q = lane >> 4;
    for (int m = c.gwave; m < M; m += c.gwaves) {
        { const u32x4 xa = *((const u32x4*)(XN + (size_t)m * DM) + lane), xb = *((const u32x4*)(XN + (size_t)m * DM + 512) + lane);
          *((LAS u32x4*)xs + lane) = xa; *((LAS u32x4*)(xs + 512) + lane) = xb; }
        const int id0 = ids[(size_t)m * 128 + lane], id1 = ids[(size_t)m * 128 + 64 + lane];
        const float g0 = gg[(size_t)m * 128 + lane], g1 = gg[(size_t)m * 128 + 64 + lane];
        const char* rowp[8];
#pragma unroll
        for (int g = 0; g < 8; ++g) { const int idg = __shfl(g < 4 ? id0 : id1, 16 * (g & 3) + r); rowp[g] = (const char*)(UT + (size_t)idg * DM) + q * 16; }
        f32x4 acc[8];
#pragma unroll
        for (int g = 0; g < 8; ++g) acc[g] = (f32x4){0.f, 0.f, 0.f, 0.f};
#pragma unroll 1
        for (int kc = 0; kc < 4; ++kc) {
            bf16x8 xb8[8];
#pragma unroll
            for (int s = 0; s < 8; ++s) xb8[s] = *(const LAS bf16x8*)(xs + (kc * 8 + s) * 32 + 8 * q);
#pragma unroll
            for (int g = 0; g < 8; ++g) { bf16x8 a[8];
#pragma unroll
                for (int s = 0; s < 8; ++s) a[s] = *(const bf16x8*)(rowp[g] + (kc * 8 + s) * 64);
#pragma unroll
                for (int s = 0; s < 8; ++s) acc[g] = __builtin_amdgcn_mfma_f32_16x16x32_bf16(a[s], xb8[s], acc[g], 0, 0, 0); }
        }
#pragma unroll
        for (int g = 0; g < 8; ++g) if (r == 0) *(LAS f32x4*)(dsm + 16 * g + 4 * q) = acc[g];
        const float d0 = dsm[lane], d1 = dsm[64 + lane];
        const int act0 = __builtin_bit_cast(int, gelu_tanh(d0) * g0), act1 = __builtin_bit_cast(int, gelu_tanh(d1) * g1);
        float o[16];
#pragma unroll
        for (int i = 0; i < 16; ++i) o[i] = 0.f;
#pragma unroll
        for (int hh = 0; hh < 2; ++hh) { const int idv = hh ? id1 : id0; const int actv = hh ? act1 : act0;
#pragma unroll 1
            for (int e0 = 0; e0 < 64; e0 += 8) {
                u32x4 va[8], vb[8]; float ae[8];
#pragma unroll
                for (int j = 0; j < 8; ++j) { const int id = __builtin_amdgcn_readlane(idv, e0 + j); ae[j] = __builtin_bit_cast(float, __builtin_amdgcn_readlane(actv, e0 + j));
                    const u32x4* vr = (const u32x4*)(VT + (size_t)id * DM); va[j] = vr[lane]; vb[j] = vr[64 + lane]; }
#pragma unroll
                for (int j = 0; j < 8; ++j) { const float act = ae[j];
                    o[0] += act * bflo(va[j].x); o[1] += act * bfhi(va[j].x); o[2] += act * bflo(va[j].y); o[3] += act * bfhi(va[j].y); o[4] += act * bflo(va[j].z); o[5] += act * bfhi(va[j].z); o[6] += act * bflo(va[j].w); o[7] += act * bfhi(va[j].w);
                    o[8] += act * bflo(vb[j].x); o[9] += act * bfhi(vb[j].x); o[10] += act * bflo(vb[j].y); o[11] += act * bfhi(vb[j].y); o[12] += act * bflo(vb[j].z); o[13] += act * bfhi(vb[j].z); o[14] += act * bflo(vb[j].w); o[15] += act * bfhi(vb[j].w); }
            } }
        f32x4* hp = (f32x4*)(p.out + (size_t)m * DM);
        f32x4 h0 = hp[2 * lane], h1 = hp[2 * lane + 1], h2 = hp[128 + 2 * lane], h3 = hp[128 + 2 * lane + 1];
        h0 += (f32x4){o[0], o[1], o[2], o[3]}; h1 += (f32x4){o[4], o[5], o[6], o[7]}; h2 += (f32x4){o[8], o[9], o[10], o[11]}; h3 += (f32x4){o[12], o[13], o[14], o[15]};
        hp[2 * lane] = h0; hp[2 * lane + 1] = h1; hp[128 + 2 * lane] = h2; hp[128 + 2 * lane + 1] = h3;
    }
}

__device__ __forceinline__ float wave_max(float v) {
#pragma unroll
    for (int o = 1; o < 64; o <<= 1) v = fmaxf(v, __shfl_xor(v, o));
    return v;
}
__device__ __forceinline__ void cvt_fp8_rows(const float* src, unsigned char* dst, float* scl, int nrows, const Ctx& c) {
    for (int row = c.gwave; row < nrows; row += c.gwaves) {
        const f32x4* sp = (const f32x4*)(src + (size_t)row * DM) + 4 * c.lane; f32x4 v[4]; float mx = 0.f;
#pragma unroll
        for (int j = 0; j < 4; ++j) { v[j] = sp[j]; mx = fmaxf(mx, fmaxf(fmaxf(fabsf(v[j].x), fabsf(v[j].y)), fmaxf(fabsf(v[j].z), fabsf(v[j].w)))); }
        mx = wave_max(mx);
        const float sc = mx > 0.f ? mx * (1.f / 416.f) : 1.f, inv = 1.f / sc;
        u32x4 w; int t;
        t = __builtin_amdgcn_cvt_pk_fp8_f32(v[0].x * inv, v[0].y * inv, 0, false); t = __builtin_amdgcn_cvt_pk_fp8_f32(v[0].z * inv, v[0].w * inv, t, true); w.x = (unsigned)t;
        t = __builtin_amdgcn_cvt_pk_fp8_f32(v[1].x * inv, v[1].y * inv, 0, false); t = __builtin_amdgcn_cvt_pk_fp8_f32(v[1].z * inv, v[1].w * inv, t, true); w.y = (unsigned)t;
        t = __builtin_amdgcn_cvt_pk_fp8_f32(v[2].x * inv, v[2].y * inv, 0, false); t = __builtin_amdgcn_cvt_pk_fp8_f32(v[2].z * inv, v[2].w * inv, t, true); w.z = (unsigned)t;
        t = __builtin_amdgcn_cvt_pk_fp8_f32(v[3].x * inv, v[3].y * inv, 0, false); t = __builtin_amdgcn_cvt_pk_fp8_f32(v[3].z * inv, v[3].w * inv, t, true); w.w = (unsigned)t;
        *(u32x4*)(dst + (size_t)(c.lane >> 3) * NEXP * 128 + (size_t)row * 128 + (c.lane & 7) * 16) = w;
        if (c.lane == 0) scl[row] = sc;
    }
}
typedef float f32x2 __attribute__((ext_vector_type(2)));
__device__ __forceinline__ void cvt_fp8_roundtrip_rows(const float* src, bf16_t* dst, int nrows, const Ctx& c) {
    for (int row = c.gwave; row < nrows; row += c.gwaves) {
        const f32x4* sp = (const f32x4*)(src + (size_t)row * DM) + 4 * c.lane; f32x4 v[4]; float mx = 0.f;
#pragma unroll
        for (int j = 0; j < 4; ++j) { v[j] = sp[j]; mx = fmaxf(mx, fmaxf(fmaxf(fabsf(v[j].x), fabsf(v[j].y)), fmaxf(fabsf(v[j].z), fabsf(v[j].w)))); }
        mx = wave_max(mx);
        const float sc = mx > 0.f ? mx * (1.f / 416.f) : 1.f, inv = 1.f / sc;
        u32x4 o0, o1;
#pragma unroll
        for (int j = 0; j < 4; ++j) { int t = __builtin_amdgcn_cvt_pk_fp8_f32(v[j].x * inv, v[j].y * inv, 0, false); t = __builtin_amdgcn_cvt_pk_fp8_f32(v[j].z * inv, v[j].w * inv, t, true);
            const f32x2 a = __builtin_amdgcn_cvt_pk_f32_fp8(t, false), b = __builtin_amdgcn_cvt_pk_f32_fp8(t, true);
            const unsigned lo = pk2(a.x * sc, a.y * sc), hi = pk2(b.x * sc, b.y * sc);
            if (j == 0) { o0.x = lo; o0.y = hi; } else if (j == 1) { o0.z = lo; o0.w = hi; } else if (j == 2) { o1.x = lo; o1.y = hi; } else { o1.z = lo; o1.w = hi; } }
        u32x4* dp = (u32x4*)(dst + (size_t)row * DM) + 2 * c.lane; dp[0] = o0; dp[1] = o1;
    }
}
__device__ __forceinline__ u32x2 fp8x4_to_bf16x4(unsigned w) {
    const f32x2 a = __builtin_amdgcn_cvt_pk_f32_fp8((int)w, false), b = __builtin_amdgcn_cvt_pk_f32_fp8((int)w, true);
    u32x2 o;
    asm("v_cvt_pk_bf16_f32 %0, %1, %2" : "=v"(o.x) : "v"(a.x), "v"(a.y));
    asm("v_cvt_pk_bf16_f32 %0, %1, %2" : "=v"(o.y) : "v"(b.x), "v"(b.y));
    return o;
}
__device__ __forceinline__ void ph_gather3(const Params& p, int layer, const Ctx& c, float* hdst) {
    const bf16_t* XN = (const bf16_t*)(p.ws + WS_ACT);
    const unsigned char* UT = p.ws + WS_TAB8 + (size_t)layer * 2 * NEXP * DM; const unsigned char* VT = UT + (size_t)NEXP * DM;
    const float* SU = (const float*)(p.ws + WS_SCL) + (size_t)layer * 2 * NEXP; const float* SV = SU + NEXP;
    const int* ids = (const int*)(p.ws + WS_IDS); const float* gg = (const float*)(p.ws + WS_G);
    LAS unsigned char* wl = c.lds + c.wave * 4096;
    LAS bf16_t* xs = (LAS bf16_t*)wl; LAS float* dsm = (LAS float*)(wl + 2048);
    const int lane = c.lane, r = lane & 15, q = lane >> 4;
    for (int m = c.gwave; m < M; m += c.gwaves) {
        { const u32x4 xa = *((const u32x4*)(XN + (size_t)m * DM) + lane), xb = *((const u32x4*)(XN + (size_t)m * DM + 512) + lane);
          asm volatile("" ::: "memory"); *((LAS u32x4*)xs + lane) = xa; *((LAS u32x4*)(xs + 512) + lane) = xb; asm volatile("" ::: "memory"); }
        const int id0 = ids[(size_t)m * 128 + lane], id1 = ids[(size_t)m * 128 + 64 + lane];
#ifdef PROBE_VF32
        const float g0 = gg[(size_t)m * 128 + lane], g1 = gg[(size_t)m * 128 + 64 + lane];
#else
        const float g0 = gg[(size_t)m * 128 + lane] * SV[id0], g1 = gg[(size_t)m * 128 + 64 + lane] * SV[id1];
#endif
        const float su0 = SU[id0], su1 = SU[id1];
#pragma unroll 1
        for (int gp = 0; gp < 4; ++gp) {
            const int idsel = gp < 2 ? id0 : id1;
            const int ida = __shfl(idsel, (gp & 1) * 32 + r), idb = __shfl(idsel, (gp & 1) * 32 + 16 + r);
            const unsigned char* rowa = UT + (size_t)ida * DM + q * 16; const unsigned char* rowb = UT + (size_t)idb * DM + q * 16;
            f32x4 acca = {0.f, 0.f, 0.f, 0.f}, accb = {0.f, 0.f, 0.f, 0.f};
#pragma unroll 1
            for (int kc = 0; kc < 4; ++kc) {
                u32x4 a[4], bb[4];
#pragma unroll
                for (int s = 0; s < 4; ++s) { a[s] = *(const u32x4*)(rowa + (kc * 4 + s) * 64); bb[s] = *(const u32x4*)(rowb + (kc * 4 + s) * 64); }
                bf16x8 xb8[8];
#pragma unroll
                for (int s = 0; s < 4; ++s) { xb8[2 * s] = __builtin_bit_cast(bf16x8, *(const LAS u32x4*)(xs + (kc * 4 + s) * 64 + 16 * q)); xb8[2 * s + 1] = __builtin_bit_cast(bf16x8, *(const LAS u32x4*)(xs + (kc * 4 + s) * 64 + 16 * q + 8)); }
#pragma unroll
                for (int s = 0; s < 4; ++s) {
                    { const u32x2 c0 = fp8x4_to_bf16x4(a[s].x), c1 = fp8x4_to_bf16x4(a[s].y), c2 = fp8x4_to_bf16x4(a[s].z), c3 = fp8x4_to_bf16x4(a[s].w); const u32x4 b0 = {c0.x, c0.y, c1.x, c1.y}, b1 = {c2.x, c2.y, c3.x, c3.y};
                      acca = __builtin_amdgcn_mfma_f32_16x16x32_bf16(__builtin_bit_cast(bf16x8, b0), xb8[2 * s], acca, 0, 0, 0);
                      acca = __builtin_amdgcn_mfma_f32_16x16x32_bf16(__builtin_bit_cast(bf16x8, b1), xb8[2 * s + 1], acca, 0, 0, 0); }
                    { const u32x2 c0 = fp8x4_to_bf16x4(bb[s].x), c1 = fp8x4_to_bf16x4(bb[s].y), c2 = fp8x4_to_bf16x4(bb[s].z), c3 = fp8x4_to_bf16x4(bb[s].w); const u32x4 b0 = {c0.x, c0.y, c1.x, c1.y}, b1 = {c2.x, c2.y, c3.x, c3.y};
                      accb = __builtin_amdgcn_mfma_f32_16x16x32_bf16(__builtin_bit_cast(bf16x8, b0), xb8[2 * s], accb, 0, 0, 0);
                      accb = __builtin_amdgcn_mfma_f32_16x16x32_bf16(__builtin_bit_cast(bf16x8, b1), xb8[2 * s + 1], accb, 0, 0, 0); }
                    __builtin_amdgcn_sched_barrier(0); }
            }
            if (r == 0) { *(LAS f32x4*)(dsm + 32 * gp + 4 * q) = acca; *(LAS f32x4*)(dsm + 32 * gp + 16 + 4 * q) = accb; }
        }
        asm volatile("" ::: "memory");
        const float d0 = dsm[lane] * su0, d1 = dsm[64 + lane] * su1;
        asm volatile("" ::: "memory");
        const int act0 = __builtin_bit_cast(int, gelu_tanh(d0) * g0), act1 = __builtin_bit_cast(int, gelu_tanh(d1) * g1);
        float o[16];
#pragma unroll
        for (int i = 0; i < 16; ++i) o[i] = 0.f;
#pragma unroll
        for (int hh = 0; hh < 2; ++hh) { const int idv = hh ? id1 : id0; const int actv = hh ? act1 : act0;
#ifdef PROBE_VF32
#pragma unroll 1
            for (int e0 = 0; e0 < 64; ++e0) { const int id = __builtin_amdgcn_readlane(idv, e0); const float act = __builtin_bit_cast(float, __builtin_amdgcn_readlane(actv, e0));
                const f32x4* vr = (const f32x4*)(p.peer_v + ((size_t)layer * NEXP + id) * DM) + 4 * lane; const f32x4 v0 = vr[0], v1 = vr[1], v2 = vr[2], v3 = vr[3];
                o[0] += act * v0.x; o[1] += act * v0.y; o[2] += act * v0.z; o[3] += act * v0.w; o[4] += act * v1.x; o[5] += act * v1.y; o[6] += act * v1.z; o[7] += act * v1.w;
                o[8] += act * v2.x; o[9] += act * v2.y; o[10] += act * v2.z; o[11] += act * v2.w; o[12] += act * v3.x; o[13] += act * v3.y; o[14] += act * v3.z; o[15] += act * v3.w; } }
#else
#pragma unroll 1
            for (int e0 = 0; e0 < 64; e0 += 16) {
                u32x4 va[16]; float ae[16];
#pragma unroll
                for (int j = 0; j < 16; ++j) { const int id = __builtin_amdgcn_readlane(idv, e0 + j); ae[j] = __builtin_bit_cast(float, __builtin_amdgcn_readlane(actv, e0 + j));
                    va[j] = *((const u32x4*)(VT + (size_t)id * DM) + lane); }
#pragma unroll
                for (int j = 0; j < 16; ++j) { const float act = ae[j];
                    f32x2 t;
                    t = __builtin_amdgcn_cvt_pk_f32_fp8((int)va[j].x, false); o[0] += act * t.x; o[1] += act * t.y; t = __builtin_amdgcn_cvt_pk_f32_fp8((int)va[j].x, true); o[2] += act * t.x; o[3] += act * t.y;
                    t = __builtin_amdgcn_cvt_pk_f32_fp8((int)va[j].y, false); o[4] += act * t.x; o[5] += act * t.y; t = __builtin_amdgcn_cvt_pk_f32_fp8((int)va[j].y, true); o[6] += act * t.x; o[7] += act * t.y;
                    t = __builtin_amdgcn_cvt_pk_f32_fp8((int)va[j].z, false); o[8] += act * t.x; o[9] += act * t.y; t = __builtin_amdgcn_cvt_pk_f32_fp8((int)va[j].z, true); o[10] += act * t.x; o[11] += act * t.y;
                    t = __builtin_amdgcn_cvt_pk_f32_fp8((int)va[j].w, false); o[12] += act * t.x; o[13] += act * t.y; t = __builtin_amdgcn_cvt_pk_f32_fp8((int)va[j].w, true); o[14] += act * t.x; o[15] += act * t.y; }
            } }
#endif
        f32x4* hp = (f32x4*)(p.out + (size_t)m * DM) + 4 * lane;
        f32x4 h0 = hp[0], h1 = hp[1], h2 = hp[2], h3 = hp[3];
        h0 += (f32x4){o[0], o[1], o[2], o[3]}; h1 += (f32x4){o[4], o[5], o[6], o[7]}; h2 += (f32x4){o[8], o[9], o[10], o[11]}; h3 += (f32x4){o[12], o[13], o[14], o[15]};
        f32x4* hq = (f32x4*)(hdst + (size_t)m * DM) + 4 * lane; hq[0] = h0; hq[1] = h1; hq[2] = h2; hq[3] = h3;
    }
}


constexpr size_t WS_PD = WS_S;
constexpr size_t WS_ACTB = WS_S + 224 * MiB;
struct XI { int xr, nx, jr, nloc; };
typedef long i64_t;
__device__ __forceinline__ i64_t pack64(unsigned lo, unsigned hi) { return (i64_t)(((unsigned long long)hi << 32) | lo); }
typedef int i32x8 __attribute__((ext_vector_type(8)));
__device__ __forceinline__ void peer_u_half(const u32x4 (&v)[8], const i32x8& xh, const i32x8& xl, LAS unsigned char* img, LAS float* pdp, int lane) {
    const int e8 = lane >> 3, cc = lane & 7, r = lane & 15, q = lane >> 4;
#pragma unroll
    for (int j = 0; j < 8; ++j) *(LAS u32x4*)(img + (8 * e8 + j) * 128 + ((cc ^ j) << 4)) = v[j];
    asm volatile("" ::: "memory");
#pragma unroll
    for (int g = 0; g < 4; ++g) { const int row = 16 * g + r;
        const u32x4 w0 = *(const LAS u32x4*)(img + row * 128 + (((2 * q) ^ (row & 7)) << 4)), w1 = *(const LAS u32x4*)(img + row * 128 + (((2 * q + 1) ^ (row & 7)) << 4));
        const i32x8 aw = {(int)w0.x, (int)w0.y, (int)w0.z, (int)w0.w, (int)w1.x, (int)w1.y, (int)w1.z, (int)w1.w};
        f32x4 ah = {0.f, 0.f, 0.f, 0.f}, al = {0.f, 0.f, 0.f, 0.f};
        ah = __builtin_amdgcn_mfma_scale_f32_16x16x128_f8f6f4(aw, xh, ah, 0, 0, 0, 0, 0, 0); al = __builtin_amdgcn_mfma_scale_f32_16x16x128_f8f6f4(aw, xl, al, 0, 0, 0, 0, 0, 0);
        if (r == 0) *(LAS f32x4*)(pdp + 16 * g + 4 * q) = ah + al * 0.0625f; }
    asm volatile("" ::: "memory");
}
__device__ __forceinline__ void split_x8(const u32x4 xv, i64_t& xh, i64_t& xl) {
    const float f[8] = {bflo(xv.x), bfhi(xv.x), bflo(xv.y), bfhi(xv.y), bflo(xv.z), bfhi(xv.z), bflo(xv.w), bfhi(xv.w)};
    int h0 = __builtin_amdgcn_cvt_pk_fp8_f32(f[0], f[1], 0, false); h0 = __builtin_amdgcn_cvt_pk_fp8_f32(f[2], f[3], h0, true);
    int h1 = __builtin_amdgcn_cvt_pk_fp8_f32(f[4], f[5], 0, false); h1 = __builtin_amdgcn_cvt_pk_fp8_f32(f[6], f[7], h1, true);
    const f32x2 d0 = __builtin_amdgcn_cvt_pk_f32_fp8(h0, false), d1 = __builtin_amdgcn_cvt_pk_f32_fp8(h0, true), d2 = __builtin_amdgcn_cvt_pk_f32_fp8(h1, false), d3 = __builtin_amdgcn_cvt_pk_f32_fp8(h1, true);
    int l0 = __builtin_amdgcn_cvt_pk_fp8_f32((f[0] - d0.x) * 16.f, (f[1] - d0.y) * 16.f, 0, false); l0 = __builtin_amdgcn_cvt_pk_fp8_f32((f[2] - d1.x) * 16.f, (f[3] - d1.y) * 16.f, l0, true);
    int l1 = __builtin_amdgcn_cvt_pk_fp8_f32((f[4] - d2.x) * 16.f, (f[5] - d2.y) * 16.f, 0, false); l1 = __builtin_amdgcn_cvt_pk_fp8_f32((f[6] - d3.x) * 16.f, (f[7] - d3.y) * 16.f, l1, true);
    xh = pack64((unsigned)h0, (unsigned)h1); xl = pack64((unsigned)l0, (unsigned)l1);
}
__device__ __forceinline__ void ph_peer_u(const Params& p, int layer, const Ctx& c, const XI xi, int idmask) {
    const bf16_t* XN = (const bf16_t*)(p.ws + WS_ACT); const unsigned char* UT = p.ws + WS_TAB8 + (size_t)layer * 2 * NEXP * DM;
    const int* ids = (const int*)(p.ws + WS_IDS); bf16_t* PDh = (bf16_t*)(p.ws + WS_PD);
    const int lane = c.lane, e8 = lane >> 3, cc = lane & 7, q = lane >> 4;
    const int tstep = xi.nloc * NWAVES;
    LAS unsigned char* img = c.lds + c.wave * 8192; LAS float* stg = (LAS float*)(c.lds + 65536 + c.wave * 512);
#pragma unroll 1
    for (int sl = xi.xr; sl < 8; sl += xi.nx) {
        const unsigned char* Us = UT + (size_t)sl * NEXP * 128; const unsigned uo = 16u * (unsigned)cc;
        int t = xi.jr * NWAVES + c.wave;
        if (t >= M) continue;
#define PU_LD(k) ((idmask & 0x10000) ? (u32x4){(unsigned)(k), (unsigned)(k), uo, uo} : *(const u32x4*)(Us + (((unsigned)((k) & (idmask & 0xffff)) << 7) + uo)))
#define PU_ROWS(dst, ia, ib) do { dst[0] = PU_LD((ia).x); dst[1] = PU_LD((ia).y); dst[2] = PU_LD((ia).z); dst[3] = PU_LD((ia).w); dst[4] = PU_LD((ib).x); dst[5] = PU_LD((ib).y); dst[6] = PU_LD((ib).z); dst[7] = PU_LD((ib).w); } while (0)
#define PU_X(tt) do { const bf16_t* xp = XN + (size_t)(tt) * DM + 128 * sl + 32 * q; xv[0] = *(const u32x4*)xp; xv[1] = *(const u32x4*)(xp + 8); xv[2] = *(const u32x4*)(xp + 16); xv[3] = *(const u32x4*)(xp + 24); } while (0)
#define PU_SPLIT() do { i64_t h_[4], l_[4]; _Pragma("unroll") for (int k_ = 0; k_ < 4; ++k_) split_x8(xv[k_], h_[k_], l_[k_]); \
        xh = (i32x8){(int)h_[0], (int)(h_[0] >> 32), (int)h_[1], (int)(h_[1] >> 32), (int)h_[2], (int)(h_[2] >> 32), (int)h_[3], (int)(h_[3] >> 32)}; \
        xl = (i32x8){(int)l_[0], (int)(l_[0] >> 32), (int)l_[1], (int)(l_[1] >> 32), (int)l_[2], (int)(l_[2] >> 32), (int)l_[3], (int)(l_[3] >> 32)}; } while (0)
        u32x4 v[8], vn[8], xv[4]; i32x8 xh, xl; i32x4 ic2, ic3;
        { const i32x4* ip = (const i32x4*)(ids + (size_t)t * 128 + 8 * e8); const i32x4 i0 = ip[0], i1 = ip[1]; ic2 = ip[16]; ic3 = ip[17]; PU_ROWS(v, i0, i1); PU_X(t); }
#pragma unroll 1
        for (; t < M; t += tstep) {
            const int tn = min(t + tstep, M - 1);
            const i32x4* ipn = (const i32x4*)(ids + (size_t)tn * 128 + 8 * e8); const i32x4 in0 = ipn[0], in1 = ipn[1], in2 = ipn[16], in3 = ipn[17];
            PU_ROWS(vn, ic2, ic3);
            PU_SPLIT();
            __builtin_amdgcn_sched_barrier(0);
            if (!(idmask & 0x20000)) peer_u_half(v, xh, xl, img, stg, lane); else { _Pragma("unroll") for (int j_ = 0; j_ < 8; ++j_) asm volatile("" :: "v"(v[j_])); }
#pragma unroll
            for (int j = 0; j < 8; ++j) v[j] = vn[j];
            PU_ROWS(vn, in0, in1);
            __builtin_amdgcn_sched_barrier(0);
            if (!(idmask & 0x20000)) peer_u_half(v, xh, xl, img, stg + 64, lane); else { _Pragma("unroll") for (int j_ = 0; j_ < 8; ++j_) asm volatile("" :: "v"(v[j_])); }
#pragma unroll
            for (int j = 0; j < 8; ++j) v[j] = vn[j];
            ic2 = in2; ic3 = in3;
            asm volatile("" ::: "memory");
            { const f32x2 pv = *(const LAS f32x2*)(stg + 2 * lane); *(unsigned*)(PDh + ((size_t)sl * M + t) * 128 + 2 * lane) = pk2(pv.x, pv.y); }
            asm volatile("" ::: "memory");
            PU_X(tn);
        }
#undef PU_LD
#undef PU_ROWS
#undef PU_X
#undef PU_SPLIT
    }
}
__device__ __forceinline__ void ph_peer_act(const Params& p, int layer, const Ctx& c) {
    const bf16_t* PDh = (const bf16_t*)(p.ws + WS_PD); float* ACTB = (float*)(p.ws + WS_ACTB);
    const float* SU = (const float*)(p.ws + WS_SCL) + (size_t)layer * 2 * NEXP; const float* SV = SU + NEXP;
    const int* ids = (const int*)(p.ws + WS_IDS); const float* gg = (const float*)(p.ws + WS_G);
    for (int idx = c.gtid; idx < M * 128; idx += c.gthreads) { float d = 0.f;
#pragma unroll
        for (int sl = 0; sl < 8; ++sl) d += bf2f(PDh[(size_t)sl * M * 128 + idx]);
        const int id = ids[idx]; ACTB[idx] = gelu_tanh(d * SU[id]) * gg[idx] * SV[id]; }
}
#define PIN16(o) asm volatile("" : "+v"(o[0]), "+v"(o[1]), "+v"(o[2]), "+v"(o[3]), "+v"(o[4]), "+v"(o[5]), "+v"(o[6]), "+v"(o[7]), "+v"(o[8]), "+v"(o[9]), "+v"(o[10]), "+v"(o[11]), "+v"(o[12]), "+v"(o[13]), "+v"(o[14]), "+v"(o[15]))
__device__ __forceinline__ void peer_v_half(const u32x4 (&vin)[8], const f32x4& a0, const f32x4& a1, float (&o)[16]) {
#pragma unroll
    for (int j = 0; j < 8; ++j) { const float act = (j < 4) ? a0[j & 3] : a1[j & 3]; f32x2 tt; u32x4 vr = vin[j];
        asm volatile("" : "+v"(vr.x), "+v"(vr.y), "+v"(vr.z), "+v"(vr.w));
        tt = __builtin_amdgcn_cvt_pk_f32_fp8((int)vr.x, false); o[0] += act * tt.x; o[1] += act * tt.y; tt = __builtin_amdgcn_cvt_pk_f32_fp8((int)vr.x, true); o[2] += act * tt.x; o[3] += act * tt.y;
        tt = __builtin_amdgcn_cvt_pk_f32_fp8((int)vr.y, false); o[4] += act * tt.x; o[5] += act * tt.y; tt = __builtin_amdgcn_cvt_pk_f32_fp8((int)vr.y, true); o[6] += act * tt.x; o[7] += act * tt.y;
        tt = __builtin_amdgcn_cvt_pk_f32_fp8((int)vr.z, false); o[8] += act * tt.x; o[9] += act * tt.y; tt = __builtin_amdgcn_cvt_pk_f32_fp8((int)vr.z, true); o[10] += act * tt.x; o[11] += act * tt.y;
        tt = __builtin_amdgcn_cvt_pk_f32_fp8((int)vr.w, false); o[12] += act * tt.x; o[13] += act * tt.y; tt = __builtin_amdgcn_cvt_pk_f32_fp8((int)vr.w, true); o[14] += act * tt.x; o[15] += act * tt.y;
        PIN16(o); }
}
__device__ __forceinline__ void ph_peer_v(const Params& p, int layer, const Ctx& c, const XI xi, float* hdst, int idmask) {
    const unsigned char* VT = p.ws + WS_TAB8 + (size_t)layer * 2 * NEXP * DM + (size_t)NEXP * DM;
    const int* ids = (const int*)(p.ws + WS_IDS); const float* ACTB = (const float*)(p.ws + WS_ACTB);
    const int lane = c.lane, e8 = lane >> 3, cc = lane & 7;
    const int tstep = xi.nloc * NWAVES;
    const bool b5 = (lane & 32) != 0, b4 = (lane & 16) != 0, b3 = (lane & 8) != 0;
#pragma unroll 1
    for (int sl = xi.xr; sl < 8; sl += xi.nx) {
        const unsigned char* Vs = VT + (size_t)sl * NEXP * 128; const unsigned vo = 16u * (unsigned)cc;
        int t = xi.jr * NWAVES + c.wave;
        if (t >= M) continue;
#define PV_LD(k) ((idmask & 0x10000) ? (u32x4){(unsigned)(k), (unsigned)(k), vo, vo} : *(const u32x4*)(Vs + (((unsigned)((k) & (idmask & 0xffff)) << 7) + vo)))
#define PV_ROWS(dst, ia, ib) do { dst[0] = PV_LD((ia).x); dst[1] = PV_LD((ia).y); dst[2] = PV_LD((ia).z); dst[3] = PV_LD((ia).w); dst[4] = PV_LD((ib).x); dst[5] = PV_LD((ib).y); dst[6] = PV_LD((ib).z); dst[7] = PV_LD((ib).w); } while (0)
        u32x4 v[8], vn[8]; f32x4 av[4]; f32x2 hv; i32x4 ic2, ic3;
        { const i32x4* ip = (const i32x4*)(ids + (size_t)t * 128 + 16 * e8); const i32x4 i0 = ip[0], i1 = ip[1]; ic2 = ip[2]; ic3 = ip[3]; PV_ROWS(v, i0, i1);
          const f32x4* ap = (const f32x4*)(ACTB + (size_t)t * 128 + 16 * e8); av[0] = ap[0]; av[1] = ap[1]; av[2] = ap[2]; av[3] = ap[3];
          hv = *(const f32x2*)(p.out + (size_t)t * DM + 128 * sl + 16 * cc + 2 * e8); }
#pragma unroll 1
        for (; t < M; t += tstep) {
            const int tn = min(t + tstep, M - 1);
            const i32x4* ipn = (const i32x4*)(ids + (size_t)tn * 128 + 16 * e8); const i32x4 in0 = ipn[0], in1 = ipn[1], in2 = ipn[2], in3 = ipn[3];
            float o[16];
#pragma unroll
            for (int i = 0; i < 16; ++i) o[i] = 0.f;
            PV_ROWS(vn, ic2, ic3);
            __builtin_amdgcn_sched_barrier(0);
            if (!(idmask & 0x20000)) peer_v_half(v, av[0], av[1], o); else { _Pragma("unroll") for (int j_ = 0; j_ < 8; ++j_) asm volatile("" :: "v"(v[j_])); }
            __builtin_amdgcn_sched_barrier(0);
#pragma unroll
            for (int j = 0; j < 8; ++j) v[j] = vn[j];
            PV_ROWS(vn, in0, in1);
            __builtin_amdgcn_sched_barrier(0);
            if (!(idmask & 0x20000)) peer_v_half(v, av[2], av[3], o); else { _Pragma("unroll") for (int j_ = 0; j_ < 8; ++j_) asm volatile("" :: "v"(v[j_])); }
            __builtin_amdgcn_sched_barrier(0);
#pragma unroll
            for (int j = 0; j < 8; ++j) v[j] = vn[j];
            ic2 = in2; ic3 = in3;
#pragma unroll
            for (int i = 0; i < 8; ++i) { const float keep = b5 ? o[i + 8] : o[i], send = b5 ? o[i] : o[i + 8]; o[i] = keep + __shfl_xor(send, 32); }
#pragma unroll
            for (int i = 0; i < 4; ++i) { const float keep = b4 ? o[i + 4] : o[i], send = b4 ? o[i] : o[i + 4]; o[i] = keep + __shfl_xor(send, 16); }
#pragma unroll
            for (int i = 0; i < 2; ++i) { const float keep = b3 ? o[i + 2] : o[i], send = b3 ? o[i] : o[i + 2]; o[i] = keep + __shfl_xor(send, 8); }
            hv.x += o[0]; hv.y += o[1]; *(f32x2*)(hdst + (size_t)t * DM + 128 * sl + 16 * cc + 2 * e8) = hv;
            { const f32x4* ap = (const f32x4*)(ACTB + (size_t)tn * 128 + 16 * e8); av[0] = ap[0]; av[1] = ap[1]; av[2] = ap[2]; av[3] = ap[3];
              hv = *(const f32x2*)(p.out + (size_t)tn * DM + 128 * sl + 16 * cc + 2 * e8); }
        }
#undef PV_ROWS
#undef PV_LD
    }
}

constexpr size_t WS_ACT8 = WS_S + 224 * MiB;
constexpr size_t WS_SA = WS_S + 240 * MiB;
__device__ __forceinline__ void ph_peer_act2(const Params& p, int layer, const Ctx& c) {
    const bf16_t* PDh = (const bf16_t*)(p.ws + WS_PD); unsigned char* A8 = p.ws + WS_ACT8; float* SA = (float*)(p.ws + WS_SA);
    const float* SU = (const float*)(p.ws + WS_SCL) + (size_t)layer * 2 * NEXP; const float* SV = SU + NEXP;
    const int* ids = (const int*)(p.ws + WS_IDS); const float* gg = (const float*)(p.ws + WS_G);
    const int lane = c.lane;
    for (int t = c.gwave; t < M; t += c.gwaves) {
        float d0 = 0.f, d1 = 0.f;
#pragma unroll
        for (int sl = 0; sl < 8; ++sl) { d0 += bf2f(PDh[((size_t)sl * M + t) * 128 + lane]); d1 += bf2f(PDh[((size_t)sl * M + t) * 128 + 64 + lane]); }
        const int id0 = ids[(size_t)t * 128 + lane], id1 = ids[(size_t)t * 128 + 64 + lane];
        const float a0 = gelu_tanh(d0 * SU[id0]) * gg[(size_t)t * 128 + lane] * SV[id0], a1 = gelu_tanh(d1 * SU[id1]) * gg[(size_t)t * 128 + 64 + lane] * SV[id1];
        const float mx = wave_max(fmaxf(fabsf(a0), fabsf(a1)));
        const float sa = mx > 0.f ? mx * (1.f / 256.f) : 1.f, inv = 1.f / sa;
        const float b0 = a0 * inv, b1 = a1 * inv;
        const int hq = __builtin_amdgcn_cvt_pk_fp8_f32(b0, b1, 0, false);
        const f32x2 hd = __builtin_amdgcn_cvt_pk_f32_fp8(hq, false);
        const int lq = __builtin_amdgcn_cvt_pk_fp8_f32((b0 - hd.x) * 16.f, (b1 - hd.y) * 16.f, 0, false);
        unsigned char* o = A8 + (size_t)t * 256;
        o[lane] = (unsigned char)(hq & 0xff); o[64 + lane] = (unsigned char)((hq >> 8) & 0xff); o[128 + lane] = (unsigned char)(lq & 0xff); o[192 + lane] = (unsigned char)((lq >> 8) & 0xff);
        if (lane == 0) SA[t] = sa;
    }
}
typedef int i32x2 __attribute__((ext_vector_type(2)));
__device__ __forceinline__ i32x2 lds_tr8(LAS const unsigned char* pb) { return __builtin_amdgcn_ds_read_tr8_b64_v2i32((LAS i32x2*)pb); }
__device__ __forceinline__ void ph_peer_v2(const Params& p, int layer, const Ctx& c, const XI xi, float* hdst, int idmask) {
    const unsigned char* VT = p.ws + WS_TAB8 + (size_t)layer * 2 * NEXP * DM + (size_t)NEXP * DM;
    const int* ids = (const int*)(p.ws + WS_IDS); const unsigned char* A8 = p.ws + WS_ACT8; const float* SA = (const float*)(p.ws + WS_SA);
    const int lane = c.lane, e8 = lane >> 3, cc = lane & 7, r = lane & 15, q = lane >> 4;
    const int tstep = xi.nloc * NWAVES;
    LAS unsigned char* img = c.lds + c.wave * 16384;
#pragma unroll 1
    for (int sl = xi.xr; sl < 8; sl += xi.nx) {
        const unsigned char* Vs = VT + (size_t)sl * NEXP * 128; const unsigned vo = 16u * (unsigned)cc;
        int t = xi.jr * NWAVES + c.wave;
        if (t >= M) continue;
#define PV_LD(k) (*(const u32x4*)(Vs + (((unsigned)((k) & (idmask & 0xffff)) << 7) + vo)))
#define PV_ROWS(dst, ia, ib) do { dst[0] = PV_LD((ia).x); dst[1] = PV_LD((ia).y); dst[2] = PV_LD((ia).z); dst[3] = PV_LD((ia).w); dst[4] = PV_LD((ib).x); dst[5] = PV_LD((ib).y); dst[6] = PV_LD((ib).z); dst[7] = PV_LD((ib).w); } while (0)
#define PV_IMG(src, half) do { _Pragma("unroll") for (int j = 0; j < 8; ++j) *(LAS u32x4*)(img + (64 * (half) + 8 * e8 + j) * 128 + ((cc ^ j) << 4)) = src[j]; } while (0)
        u32x4 v[8], vn[8];
        { const i32x4* ip = (const i32x4*)(ids + (size_t)t * 128 + 8 * e8); const i32x4 i0 = ip[0], i1 = ip[1], i2 = ip[16], i3 = ip[17]; PV_ROWS(v, i0, i1); PV_ROWS(vn, i2, i3); }
#pragma unroll 1
        for (; t < M; t += tstep) {
            const int tn = min(t + tstep, M - 1);
            const i32x4* ipn = (const i32x4*)(ids + (size_t)tn * 128 + 8 * e8); const i32x4 in0 = ipn[0], in1 = ipn[1], in2 = ipn[16], in3 = ipn[17];
            const u32x4* ap = (const u32x4*)(A8 + (size_t)t * 256 + 32 * q); const u32x4 ah0 = ap[0], ah1 = ap[1], al0 = ap[8], al1 = ap[9];
            const float sa = SA[t];
            const size_t ho = (size_t)t * DM + 128 * sl + 32 * q + r;
            float h0 = p.out[ho], h1 = p.out[ho + 16];
            PV_IMG(v, 0); PV_IMG(vn, 1);
            PV_ROWS(v, in0, in1); PV_ROWS(vn, in2, in3);
            asm volatile("" ::: "memory");
            const i32x8 ahv = {(int)ah0.x, (int)ah0.y, (int)ah0.z, (int)ah0.w, (int)ah1.x, (int)ah1.y, (int)ah1.z, (int)ah1.w};
            const i32x8 alv = {(int)al0.x, (int)al0.y, (int)al0.z, (int)al0.w, (int)al1.x, (int)al1.y, (int)al1.z, (int)al1.w};
            float oa = 0.f, ob = 0.f;
#pragma unroll
            for (int dt = 0; dt < 8; ++dt) {
                i32x8 bw;
#pragma unroll
                for (int i4 = 0; i4 < 4; ++i4) { const int row = 32 * q + 8 * i4 + (r >> 1);
                    const i32x2 tv = lds_tr8(img + row * 128 + ((dt ^ (row & 7)) << 4) + 8 * (r & 1)); bw[2 * i4] = tv.x; bw[2 * i4 + 1] = tv.y; }
                f32x4 ch = {0.f, 0.f, 0.f, 0.f}, cl = {0.f, 0.f, 0.f, 0.f};
                ch = __builtin_amdgcn_mfma_scale_f32_16x16x128_f8f6f4(ahv, bw, ch, 0, 0, 0, 0, 0, 0); cl = __builtin_amdgcn_mfma_scale_f32_16x16x128_f8f6f4(alv, bw, cl, 0, 0, 0, 0, 0, 0);
                const float od = ch[0] + cl[0] * 0.0625f;
                oa = (dt == 2 * q) ? od : oa; ob = (dt == 2 * q + 1) ? od : ob; }
            h0 += oa * sa; h1 += ob * sa;
            hdst[ho] = h0; hdst[ho + 16] = h1;
            asm volatile("" ::: "memory");
        }
#undef PV_LD
#undef PV_ROWS
#undef PV_IMG
    }
}

__device__ __forceinline__ void ph_g1(const Params& p, const Ctx& c) {
    const bf16_t* proj = (const bf16_t*)(p.ws + WS_PROJ); bf16_t* xc = (bf16_t*)(p.ws + WS_XC);
    for (size_t idx = c.gtid; idx < (size_t)M * DM; idx += c.gthreads) {
        const int ch = (int)(idx & 1023); const int row = (int)(idx >> 10); const int t = row & (SEQ - 1);
        float a = p.c_conv_b[ch];
#pragma unroll
        for (int j = 0; j < 4; ++j) { const int tt = t - 3 + j; if (tt >= 0) a += p.c_conv_w[j * 1024 + ch] * bf2f(proj[(size_t)(row - 3 + j) * 2048 + 1024 + ch]); }
        xc[idx] = (bf16_t)f2bf(a);
    }
}
__device__ __forceinline__ void ph_g2(const Params& p, const Ctx& c) {
    const bf16_t* xc = (const bf16_t*)(p.ws + WS_XC); float* A = (float*)(p.ws + WS_A); float* U = (float*)(p.ws + WS_U);
    for (size_t idx = c.gtid; idx < (size_t)M * DM; idx += c.gthreads) {
        const int ch = (int)(idx & 1023); const size_t row = idx >> 10; const int g = ch >> 7, j = ch & 127;
        const bf16_t* xr = xc + row * DM + g * 128; const float* wr = p.c_w_rgate + (size_t)g * 16384 + j; const float* wi = p.c_w_igate + (size_t)g * 16384 + j;
        float ar = p.c_b_rgate[ch], ai = p.c_b_igate[ch];
        for (int i = 0; i < 128; i += 8) { const u32x4 w = *(const u32x4*)(xr + i);
            const float x0 = bflo(w.x), x1 = bfhi(w.x), x2 = bflo(w.y), x3 = bfhi(w.y), x4 = bflo(w.z), x5 = bfhi(w.z), x6 = bflo(w.w), x7 = bfhi(w.w);
            ar += x0 * wr[(i) * 128] + x1 * wr[(i + 1) * 128] + x2 * wr[(i + 2) * 128] + x3 * wr[(i + 3) * 128] + x4 * wr[(i + 4) * 128] + x5 * wr[(i + 5) * 128] + x6 * wr[(i + 6) * 128] + x7 * wr[(i + 7) * 128];
            ai += x0 * wi[(i) * 128] + x1 * wi[(i + 1) * 128] + x2 * wi[(i + 2) * 128] + x3 * wi[(i + 3) * 128] + x4 * wi[(i + 4) * 128] + x5 * wi[(i + 5) * 128] + x6 * wi[(i + 6) * 128] + x7 * wi[(i + 7) * 128]; }
        const float r = sigmoidf_(ar), ig = sigmoidf_(ai);
        const float lam = p.c_lambda[ch]; const float sp = fmaxf(-lam, 0.f) + log1pf(expf(-fabsf(lam)));
        const float la = -8.f * r * sp;
        A[idx] = expf(la); U[idx] = sqrtf(-expm1f(2.f * la)) * (ig * bf2f(xc[idx]));
    }
}
__device__ __forceinline__ void ph_g3(const Params& p, const Ctx& c) {
    const bf16_t* proj = (const bf16_t*)(p.ws + WS_PROJ); const float* A = (const float*)(p.ws + WS_A); const float* U = (const float*)(p.ws + WS_U); bf16_t* y = (bf16_t*)(p.ws + WS_ACT);
    for (int idx = c.gtid; idx < BATCH * DM; idx += c.gthreads) {
        const int b = idx >> 10, ch = idx & 1023; float h = 0.f;
        for (int t0 = 0; t0 < SEQ; t0 += 8) {
            float a[8], u[8], g[8];
#pragma unroll
            for (int j = 0; j < 8; ++j) { const size_t e = (size_t)(b * SEQ + t0 + j) * DM + ch; a[j] = A[e]; u[j] = U[e]; g[j] = bf2f(proj[(size_t)(b * SEQ + t0 + j) * 2048 + ch]); }
#pragma unroll
            for (int j = 0; j < 8; ++j) { h = a[j] * h + u[j]; y[(size_t)(b * SEQ + t0 + j) * DM + ch] = (bf16_t)f2bf(gelu_tanh(g[j]) * h); }
        }
    }
}
#define XB_TMO      128
#define XB_XCNT(j)  (256  + 64 * (j))
#define XB_XSUB(j)  (1280 + 64 * (j))
#define XB_XGEN(j)  (2304 + 64 * (j))
#define XB_TOP      3328
#define XB_TOPGEN   3392
#define XCD_BAR_WORDS 3456
#define XB_SPIN_CAP (1u << 18)

__device__ __forceinline__ unsigned xb_ld(unsigned* p)              { return __hip_atomic_load(p, __ATOMIC_RELAXED, __HIP_MEMORY_SCOPE_AGENT); }
__device__ __forceinline__ unsigned xb_add(unsigned* p, unsigned v) { return __hip_atomic_fetch_add(p, v, __ATOMIC_RELAXED, __HIP_MEMORY_SCOPE_AGENT); }
__device__ __forceinline__ unsigned xb_xcc_id() { return (unsigned)__builtin_amdgcn_s_getreg((3 << 11) | 20) & 0xFu; }
#define XB_SPIN(cond, bar) do { unsigned _sp = 0; while (cond) { __builtin_amdgcn_s_sleep(1); \
    if ((++_sp & 255u) == 0u) { if (xb_ld(&(bar)[XB_TMO])) break; if (_sp > XB_SPIN_CAP) { atomicAdd(&(bar)[XB_TMO], 1u); break; } } } } while (0)

struct XcdBarrier {
    unsigned* bar; unsigned x;
    volatile LAS unsigned* st;
};

__device__ __forceinline__ XcdBarrier xcd_barrier_post(unsigned* bar, volatile LAS unsigned* st) {
    XcdBarrier b; b.bar = bar; b.x = xb_xcc_id(); b.st = st;
    if (threadIdx.x == 0) (void)xb_add(&bar[XB_XCNT(b.x)], 1u);
    return b;
}
__device__ __forceinline__ void xcd_barrier_complete(unsigned* bar, unsigned x, unsigned& nloc, unsigned& nx) {
    const unsigned G = gridDim.x * gridDim.y * gridDim.z;
    unsigned sum, cnt, mine, sp = 0u;
    for (;;) {
        sum = 0u; cnt = 0u; mine = 0u;
#pragma unroll
        for (unsigned j = 0; j < 16; ++j) { const unsigned c = xb_ld(&bar[XB_XCNT(j)]); sum += c; cnt += (c > 0u) ? 1u : 0u; mine = (j == x) ? c : mine; }
        if (sum == G) break;
        __builtin_amdgcn_s_sleep(1);
        if ((++sp & 255u) == 0u) { if (xb_ld(&bar[XB_TMO])) break; if (sp > XB_SPIN_CAP) { atomicAdd(&bar[XB_TMO], 1u); break; } }
    }
    nloc = mine > 0u ? mine : 1u; nx = cnt > 0u ? cnt : 1u;
}

__device__ __forceinline__ void xcd_barrier(const XcdBarrier& b) {
    asm volatile("s_waitcnt vmcnt(0)" ::: "memory");
    __syncthreads();
    if (threadIdx.x == 0) {
        unsigned* bar = b.bar;
        __builtin_amdgcn_s_waitcnt(0);
        unsigned nloc = b.st[0], nx = b.st[1];
        if (nloc == 0u) { xcd_barrier_complete(bar, b.x, nloc, nx); b.st[0] = nloc; b.st[1] = nx; }
        const unsigned old = xb_add(&bar[XB_XSUB(b.x)], 1u);
        const unsigned gen = old / nloc;
        if (old + 1u == (gen + 1u) * nloc) {
            __builtin_amdgcn_fence(__ATOMIC_RELEASE, "agent");
            asm volatile("s_waitcnt vmcnt(0)" ::: "memory");
            const unsigned og = xb_add(&bar[XB_TOP], 1u);
            const unsigned tg = og / nx;
            if (og + 1u == (tg + 1u) * nx) xb_add(&bar[XB_TOPGEN], 1u);
            else XB_SPIN(xb_ld(&bar[XB_TOPGEN]) == tg, bar);
            __builtin_amdgcn_fence(__ATOMIC_ACQUIRE, "agent");
            xb_add(&bar[XB_XGEN(b.x)], 1u);
            asm volatile("s_waitcnt vmcnt(0)" ::: "memory");
        } else {
            XB_SPIN(xb_ld(&bar[XB_XGEN(b.x)]) == gen, bar);
            __builtin_amdgcn_fence(__ATOMIC_ACQUIRE, "agent");
            asm volatile("s_waitcnt vmcnt(0)" ::: "memory");
        }
    }
    __syncthreads();
}

enum Phase { PH_PRO = 0, PH_GEMM_IN0, PH_MIXER0, PH_GLA_B, PH_GLA_C, PH_MIX0, PH_GEMM_OUT0, PH_NORM_F0, PH_GEMM_Q0, PH_TOPK1_0, PH_PU0, PH_PA0, PH_PV0,
             PH_NORM_M1, PH_GEMM_CIN, PH_G1, PH_G2, PH_G3, PH_GEMM_OUT1, PH_NORM_F1, PH_GEMM_Q1, PH_TOPK1_1, PH_PU1, PH_PA1, PH_PV1, PH_FINAL, NPHASES };

#ifndef PH_ONLY
#define PH_ONLY (-1)
#endif
#define PH_ENABLED(x) (PH_ONLY < 0 || PH_ONLY == (x))
#ifndef MK_N_LAUNCHES
#define MK_N_LAUNCHES 1
#endif

template <class Epi> __device__ __forceinline__ void run_gemm(const Ctx& c, const bf16_t* A, const bf16_t* Bt, int N, const Epi& E, int vblk) {
    pg8::Gemm g{A, Bt, M, N, DM}; pg8::StaticOrder S; S.init(M, N, c.nblk, vblk);
    pg8::gemm_phase<Epi, pg8::StaticOrder, true, true>(c.lds, g, S, E);
}

#ifdef PROBE_RT
#define GATHER_CALL(l) ph_gather2(p, c)
#else
#define GATHER_CALL(l) ph_gather3(p, l, c, (rep_ + 1 < NREP(PH_GATHER##l)) ? (float*)(ws + WS_S) : p.out)
#endif
#ifndef PROBE_IDMASK
#define PROBE_IDMASK 0x3fff
#endif
#ifndef DUP_MASK
#define DUP_MASK 0u
#endif
#define NREP(k) ((((unsigned)(DUP_MASK) >> (k)) & 1u) ? 2 : 1)
#define GETXI() XI xi; { if (multi) { if (threadIdx.x == 0) { unsigned xr_ = 0; for (unsigned j_ = 0; j_ < bar.x; ++j_) xr_ += xb_ld(&ctl[CW_BAR + XB_XCNT(j_)]) > 0u ? 1u : 0u; MISC[11] = xr_; } __syncthreads(); \
    xi.nloc = (int)MISC[8]; xi.nx = (int)MISC[9]; xi.jr = (int)MISC[10]; xi.xr = (int)MISC[11]; if (xi.nloc < 1 || xi.nx < 1 || xi.nx > 8 || xi.jr >= xi.nloc || xi.xr >= xi.nx) { xi.xr = 0; xi.nx = 1; xi.jr = blockIdx.x; xi.nloc = gridDim.x; } } \
    else { xi.xr = 0; xi.nx = 1; xi.jr = blockIdx.x; xi.nloc = gridDim.x; } }
#define MKCTX() Ctx c; { int t_ = threadIdx.x; asm volatile("" : "+v"(t_)); c.lds = lds; c.tid = t_; c.lane = t_ & 63; c.wave = __builtin_amdgcn_readfirstlane(t_ >> 6); \
    c.blk = blockIdx.x; c.nblk = gridDim.x; c.gtid = c.blk * NTHREADS + c.tid; c.gthreads = c.nblk * NTHREADS; c.gwave = c.blk * NWAVES + c.wave; c.gwaves = c.nblk * NWAVES; }
__global__ void __launch_bounds__(NTHREADS, 2) mega_fwd(Params p) {
    extern __shared__ __attribute__((aligned(16))) unsigned char lds_raw[];
    volatile LAS unsigned* MISC = (volatile LAS unsigned*)((LAS unsigned char*)lds_raw + MISC_OFF);
    LAS unsigned char* const lds = (LAS unsigned char*)lds_raw;
    for (int u = threadIdx.x; u < (LDS_BYTES - LDSCTL_OFF) / 4; u += NTHREADS) ((LAS unsigned*)(lds + LDSCTL_OFF))[u] = 0u;
    __syncthreads();
    unsigned* ctl = (unsigned*)(p.ws + WS_CTL);
    XcdBarrier bar; bar.bar = ctl + CW_BAR; bar.x = 0; bar.st = nullptr;
    const bool multi = (p.ph_hi - p.ph_lo) > 1;
    if (multi) { bar = xcd_barrier_post(ctl + CW_BAR, MISC + 8); if (threadIdx.x == 0) MISC[10] = xb_add(&ctl[CW_RANK + 64 * bar.x], 1u); }
    unsigned char* ws = p.ws;
    bf16_t* ACT = (bf16_t*)(ws + WS_ACT); bf16_t* PROJ = (bf16_t*)(ws + WS_PROJ);

    const int lo = p.ph_lo, hi = p.ph_hi;
#define IN(k) (PH_ENABLED(k) && lo <= (k) && (k) < hi)
#define SEAM(k) do { if ((k) + 1 < hi) xcd_barrier(bar); } while (0)
    if (IN(PH_PRO)) { for (int rep_ = 0; rep_ < NREP(PH_PRO); ++rep_) { MKCTX();
        transpose_cvt(p.ab_w_in, DM, NIN, (bf16_t*)(ws + WS_WT_IN), NIN_PAD, [](int n) { return n < 1536 ? n : (n < 3072 ? n + 16 : (n < 3088 ? n - 3072 + 1536 : -1)); }, c.gtid, c.gthreads);
        transpose_cvt(p.ab_w_out, DM, DM, (bf16_t*)(ws + WS_WT_OUT), DM, [](int n) { return n; }, c.gtid, c.gthreads);
        transpose_cvt(p.c_w_in, DM, 2048, (bf16_t*)(ws + WS_WT_CIN), 2048, [](int n) { return n; }, c.gtid, c.gthreads);
        transpose_cvt(p.c_w_out, DM, DM, (bf16_t*)(ws + WS_WT_COUT), DM, [](int n) { return n; }, c.gtid, c.gthreads);
        transpose_cvt(p.peer_w_query, DM, 2048, (bf16_t*)(ws + WS_WT_Q0), 2048, [](int n) { return n; }, c.gtid, c.gthreads);
        transpose_cvt(p.peer_w_query + (size_t)DM * 2048, DM, 2048, (bf16_t*)(ws + WS_WT_Q1), 2048, [](int n) { return n; }, c.gtid, c.gthreads);
#ifdef PROBE_RT
        cvt_fp8_roundtrip_rows(p.peer_u, (bf16_t*)(ws + WS_TAB), NEXP, c);
        cvt_fp8_roundtrip_rows(p.peer_v, (bf16_t*)(ws + WS_TAB) + (size_t)NEXP * DM, NEXP, c);
#else
        cvt_fp8_rows(p.peer_u, ws + WS_TAB8, (float*)(ws + WS_SCL), NEXP, c);
        cvt_fp8_rows(p.peer_v, ws + WS_TAB8 + (size_t)NEXP * DM, (float*)(ws + WS_SCL) + NEXP, NEXP, c);
#endif
        cvt_gate_weights(p, c);
        cvt_bf16(p.peer_sub_keys, (bf16_t*)(ws + WS_SK), (size_t)2 * 8 * 2 * 128 * 128 / 8, c.gtid, c.gthreads);
        norm_rows_bf16(p.x, p.mix_norm, ACT, c);
        if (rep_ + 1 < NREP(PH_PRO)) xcd_barrier(bar); } SEAM(PH_PRO); }
    if (IN(PH_GEMM_IN0)) { for (int rep_ = 0; rep_ < NREP(PH_GEMM_IN0); ++rep_) { MKCTX();  pg8::EpiBf16<0> E{PROJ, NIN_PAD, nullptr, 0, 0, 1.f}; GETXI(); run_gemm(c, ACT, (const bf16_t*)(ws + WS_WT_IN), NIN_PAD, E, (xi.nx == 8 && xi.nloc * 8 == (int)gridDim.x) ? xi.jr * 8 + xi.xr : (int)blockIdx.x); if (rep_ + 1 < NREP(PH_GEMM_IN0)) xcd_barrier(bar); } SEAM(PH_GEMM_IN0); }
    if (IN(PH_MIXER0)) { for (int rep_ = 0; rep_ < NREP(PH_MIXER0); ++rep_) { MKCTX();  ph_gla_a(p, c); ph_attn(p, c); if (rep_ + 1 < NREP(PH_MIXER0)) xcd_barrier(bar); } SEAM(PH_MIXER0); }
    if (IN(PH_GLA_B)) { for (int rep_ = 0; rep_ < NREP(PH_GLA_B); ++rep_) { MKCTX();  ph_gla_b(p, c); if (rep_ + 1 < NREP(PH_GLA_B)) xcd_barrier(bar); } SEAM(PH_GLA_B); }
    if (IN(PH_GLA_C)) { for (int rep_ = 0; rep_ < NREP(PH_GLA_C); ++rep_) { MKCTX();  ph_gla_c(p, c); if (rep_ + 1 < NREP(PH_GLA_C)) xcd_barrier(bar); } SEAM(PH_GLA_C); }
    if (IN(PH_MIX0)) { for (int rep_ = 0; rep_ < NREP(PH_MIX0); ++rep_) { MKCTX();  ph_mix(p, c); if (rep_ + 1 < NREP(PH_MIX0)) xcd_barrier(bar); } SEAM(PH_MIX0); }
    if (IN(PH_GEMM_OUT0)) { for (int rep_ = 0; rep_ < NREP(PH_GEMM_OUT0); ++rep_) { MKCTX();  pg8::EpiResF32 E{p.x, p.out, DM}; GETXI(); run_gemm(c, ACT, (const bf16_t*)(ws + WS_WT_OUT), DM, E, (xi.nx == 8 && xi.nloc * 8 == (int)gridDim.x) ? xi.jr * 8 + xi.xr : (int)blockIdx.x); if (rep_ + 1 < NREP(PH_GEMM_OUT0)) xcd_barrier(bar); } SEAM(PH_GEMM_OUT0); }
    if (IN(PH_NORM_F0)) { for (int rep_ = 0; rep_ < NREP(PH_NORM_F0); ++rep_) { MKCTX();  norm_rows_bf16(p.out, p.ffn_norm, ACT, c); if (rep_ + 1 < NREP(PH_NORM_F0)) xcd_barrier(bar); } SEAM(PH_NORM_F0); }
    if (IN(PH_GEMM_Q0)) { for (int rep_ = 0; rep_ < NREP(PH_GEMM_Q0); ++rep_) { MKCTX();  pg8::EpiBf16<0> E{PROJ, 2048, nullptr, 0, 0, 1.f}; GETXI(); run_gemm(c, ACT, (const bf16_t*)(ws + WS_WT_Q0), 2048, E, (xi.nx == 8 && xi.nloc * 8 == (int)gridDim.x) ? xi.jr * 8 + xi.xr : (int)blockIdx.x); if (rep_ + 1 < NREP(PH_GEMM_Q0)) xcd_barrier(bar); } SEAM(PH_GEMM_Q0); }
    if (IN(PH_TOPK1_0)) { for (int rep_ = 0; rep_ < NREP(PH_TOPK1_0); ++rep_) { MKCTX();  ph_topk(p, 0, c); if (rep_ + 1 < NREP(PH_TOPK1_0)) xcd_barrier(bar); } SEAM(PH_TOPK1_0); }
    if (IN(PH_PU0)) { for (int rep_ = 0; rep_ < NREP(PH_PU0); ++rep_) { MKCTX();  GETXI(); ph_peer_u(p, 0, c, xi, (rep_ + 1 < NREP(PH_PU0)) ? PROBE_IDMASK : 0x3fff); if (rep_ + 1 < NREP(PH_PU0)) xcd_barrier(bar); } SEAM(PH_PU0); }
    if (IN(PH_PA0)) { for (int rep_ = 0; rep_ < NREP(PH_PA0); ++rep_) { MKCTX();  ph_peer_act2(p, 0, c); if (rep_ + 1 < NREP(PH_PA0)) xcd_barrier(bar); } SEAM(PH_PA0); }
    if (IN(PH_PV0)) { for (int rep_ = 0; rep_ < NREP(PH_PV0); ++rep_) { MKCTX();  GETXI(); ph_peer_v2(p, 0, c, xi, (rep_ + 1 < NREP(PH_PV0)) ? (float*)(ws + WS_S) : p.out, (rep_ + 1 < NREP(PH_PV0)) ? PROBE_IDMASK : 0x3fff); if (rep_ + 1 < NREP(PH_PV0)) xcd_barrier(bar); } SEAM(PH_PV0); }
    if (IN(PH_NORM_M1)) { for (int rep_ = 0; rep_ < NREP(PH_NORM_M1); ++rep_) { MKCTX();  norm_rows_bf16(p.out, p.mix_norm + DM, ACT, c); if (rep_ + 1 < NREP(PH_NORM_M1)) xcd_barrier(bar); } SEAM(PH_NORM_M1); }
    if (IN(PH_GEMM_CIN)) { for (int rep_ = 0; rep_ < NREP(PH_GEMM_CIN); ++rep_) { MKCTX();  pg8::EpiBf16<0> E{PROJ, 2048, nullptr, 0, 0, 1.f}; GETXI(); run_gemm(c, ACT, (const bf16_t*)(ws + WS_WT_CIN), 2048, E, (xi.nx == 8 && xi.nloc * 8 == (int)gridDim.x) ? xi.jr * 8 + xi.xr : (int)blockIdx.x); if (rep_ + 1 < NREP(PH_GEMM_CIN)) xcd_barrier(bar); } SEAM(PH_GEMM_CIN); }
    if (IN(PH_G1)) { for (int rep_ = 0; rep_ < NREP(PH_G1); ++rep_) { MKCTX();  griffin_pass<false>(p, c); if (rep_ + 1 < NREP(PH_G1)) xcd_barrier(bar); } SEAM(PH_G1); }
    if (IN(PH_G2)) { for (int rep_ = 0; rep_ < NREP(PH_G2); ++rep_) { MKCTX();  ph_carry(p, c); if (rep_ + 1 < NREP(PH_G2)) xcd_barrier(bar); } SEAM(PH_G2); }
    if (IN(PH_G3)) { for (int rep_ = 0; rep_ < NREP(PH_G3); ++rep_) { MKCTX();  griffin_pass<true>(p, c); if (rep_ + 1 < NREP(PH_G3)) xcd_barrier(bar); } SEAM(PH_G3); }
    if (IN(PH_GEMM_OUT1)) { for (int rep_ = 0; rep_ < NREP(PH_GEMM_OUT1); ++rep_) { MKCTX();  pg8::EpiResF32 E{p.out, p.out, DM}; GETXI(); run_gemm(c, ACT, (const bf16_t*)(ws + WS_WT_COUT), DM, E, (xi.nx == 8 && xi.nloc * 8 == (int)gridDim.x) ? xi.jr * 8 + xi.xr : (int)blockIdx.x); if (rep_ + 1 < NREP(PH_GEMM_OUT1)) xcd_barrier(bar); } SEAM(PH_GEMM_OUT1); }
    if (IN(PH_NORM_F1)) { for (int rep_ = 0; rep_ < NREP(PH_NORM_F1); ++rep_) { MKCTX();
        norm_rows_bf16(p.out, p.ffn_norm + DM, ACT, c);
#ifdef PROBE_RT
        cvt_fp8_roundtrip_rows(p.peer_u + (size_t)NEXP * DM, (bf16_t*)(ws + WS_TAB), NEXP, c);
        cvt_fp8_roundtrip_rows(p.peer_v + (size_t)NEXP * DM, (bf16_t*)(ws + WS_TAB) + (size_t)NEXP * DM, NEXP, c);
#else
        cvt_fp8_rows(p.peer_u + (size_t)NEXP * DM, ws + WS_TAB8 + (size_t)2 * NEXP * DM, (float*)(ws + WS_SCL) + 2 * NEXP, NEXP, c);
        cvt_fp8_rows(p.peer_v + (size_t)NEXP * DM, ws + WS_TAB8 + (size_t)3 * NEXP * DM, (float*)(ws + WS_SCL) + 3 * NEXP, NEXP, c);
#endif
        if (rep_ + 1 < NREP(PH_NORM_F1)) xcd_barrier(bar); } SEAM(PH_NORM_F1); }
    if (IN(PH_GEMM_Q1)) { for (int rep_ = 0; rep_ < NREP(PH_GEMM_Q1); ++rep_) { MKCTX();  pg8::EpiBf16<0> E{PROJ, 2048, nullptr, 0, 0, 1.f}; GETXI(); run_gemm(c, ACT, (const bf16_t*)(ws + WS_WT_Q1), 2048, E, (xi.nx == 8 && xi.nloc * 8 == (int)gridDim.x) ? xi.jr * 8 + xi.xr : (int)blockIdx.x); if (rep_ + 1 < NREP(PH_GEMM_Q1)) xcd_barrier(bar); } SEAM(PH_GEMM_Q1); }
    if (IN(PH_TOPK1_1)) { for (int rep_ = 0; rep_ < NREP(PH_TOPK1_1); ++rep_) { MKCTX();  ph_topk(p, 1, c); if (rep_ + 1 < NREP(PH_TOPK1_1)) xcd_barrier(bar); } SEAM(PH_TOPK1_1); }
    if (IN(PH_PU1)) { for (int rep_ = 0; rep_ < NREP(PH_PU1); ++rep_) { MKCTX();  GETXI(); ph_peer_u(p, 1, c, xi, (rep_ + 1 < NREP(PH_PU1)) ? PROBE_IDMASK : 0x3fff); if (rep_ + 1 < NREP(PH_PU1)) xcd_barrier(bar); } SEAM(PH_PU1); }
    if (IN(PH_PA1)) { for (int rep_ = 0; rep_ < NREP(PH_PA1); ++rep_) { MKCTX();  ph_peer_act2(p, 1, c); if (rep_ + 1 < NREP(PH_PA1)) xcd_barrier(bar); } SEAM(PH_PA1); }
    if (IN(PH_PV1)) { for (int rep_ = 0; rep_ < NREP(PH_PV1); ++rep_) { MKCTX();  GETXI(); ph_peer_v2(p, 1, c, xi, (rep_ + 1 < NREP(PH_PV1)) ? (float*)(ws + WS_S) : p.out, (rep_ + 1 < NREP(PH_PV1)) ? PROBE_IDMASK : 0x3fff); if (rep_ + 1 < NREP(PH_PV1)) xcd_barrier(bar); } SEAM(PH_PV1); }
    if (IN(PH_FINAL)) { MKCTX(); norm_rows_f32(p.out, p.final_norm, c); }
#undef IN
#undef SEAM
}

extern "C" void kernel_launch(void* const* d_in, const int* in_sizes, int n_in, void* d_out, int out_size, void* d_ws, size_t ws_size, hipStream_t stream) {
    static int grid = 0;
    if (grid == 0) {
        if (n_in != 22 || out_size != M * DM || ws_size < WS_END) { fprintf(stderr, "kernel_launch: unexpected shapes: n_in %d out %d ws %zu (need %zu)\n", n_in, out_size, ws_size, (size_t)WS_END); grid = -1; return; }
        int dev = 0, cus = 0, per_cu = 0;
        if (hipGetDevice(&dev) != hipSuccess || hipDeviceGetAttribute(&cus, hipDeviceAttributeMultiprocessorCount, dev) != hipSuccess) { grid = -1; return; }
        if (hipFuncSetAttribute((const void*)mega_fwd, hipFuncAttributeMaxDynamicSharedMemorySize, LDS_BYTES) != hipSuccess) { fprintf(stderr, "kernel_launch: hipFuncSetAttribute failed\n"); grid = -1; return; }
        if (hipOccupancyMaxActiveBlocksPerMultiprocessor(&per_cu, (const void*)mega_fwd, NTHREADS, LDS_BYTES) != hipSuccess || per_cu < 1) { fprintf(stderr, "kernel_launch: occupancy query says %d blocks per CU\n", per_cu); per_cu = 1; }
        (void)hipGetLastError();
        grid = cus;
        if (grid % 8 != 0 || grid < 32) { fprintf(stderr, "kernel_launch: unexpected CU count %d\n", cus); }
    }
    if (grid < 0) return;
    (void)hipMemsetAsync((char*)d_ws + WS_CTL, 0, CTL_ZERO_BYTES, stream);
    Params p{};
    const float** pp = (const float**)&p;
    for (int i = 0; i < 22; ++i) pp[i] = (const float*)d_in[i];
    p.out = (float*)d_out; p.ws = (unsigned char*)d_ws;
#if MK_N_LAUNCHES == 1
    p.ph_lo = 0; p.ph_hi = NPHASES;
    void* args[] = {&p};
    hipError_t e = hipLaunchCooperativeKernel((const void*)mega_fwd, dim3(grid), dim3(NTHREADS), args, LDS_BYTES, stream);
    if (e != hipSuccess) fprintf(stderr, "cooperative launch failed: %s (grid %d)\n", hipGetErrorString(e), grid);
#else
    for (int ph = 0; ph < NPHASES; ++ph) { p.ph_lo = ph; p.ph_hi = ph + 1; hipLaunchKernelGGL(mega_fwd, dim3(grid), dim3(NTHREADS), LDS_BYTES, stream, p); }
#endif
}
```

```cpp
#include <hip/hip_runtime.h>
#include <hip/hip_bf16.h>
#include <cstdio>
#include <cstdint>
#include <cmath>
namespace pg8 {
#define PG8_LAS __attribute__((address_space(3)))
typedef unsigned short bf16_t;
typedef short bf16x8 __attribute__((ext_vector_type(8)));
typedef float f32x4 __attribute__((ext_vector_type(4)));
typedef unsigned u32x4 __attribute__((ext_vector_type(4)));
constexpr int BM = 256, BK = 64, HALF = 128, HTB = HALF * BK * 2  , STAGE_BYTES = 8 * HTB, NXCD = 8, WGM = 8;

__host__ __device__ __forceinline__ int lds_byte(int r, int c) { const int st = (r >> 4) * 2 + (c >> 5), rr = r & 15, cc = c & 31, ob = rr * 64 + cc * 2; return st * 1024 + (ob ^ (((ob >> 9) & 1) << 5)); }
__host__ __device__ __forceinline__ void stage_rc(int b, int& R, int& C) { const int st = b / 1024, sb = b % 1024, swz = sb ^ (((sb >> 9) & 1) << 5); R = (st >> 1) * 16 + swz / 64; C = (st & 1) * 32 + (swz % 64) / 2; }
__host__ __device__ __forceinline__ int perm32(int rho) { const int n = rho >> 4, i = rho & 15; return 8 * (i >> 2) + 4 * n + (i & 3); }

struct Unit { int pm, pn; };
struct Gemm { const bf16_t* A; const bf16_t* Bt; int M, N, K; };

struct StaticOrder {
    int nM, nN, nwg, G, c;
    __host__ __device__ void init(int M, int N, int G_, int c_) { nM = M / BM; nN = N / BM; nwg = nM * nN; G = G_; c = c_; }
    __host__ __device__ bool next(int i, Unit& u) const {
        const long L = (long)i * G + c; if (L >= nwg) return false;
        int wgid = (int)L; { const int q = nwg / NXCD, r = nwg % NXCD, xcd = wgid % NXCD, off = wgid / NXCD; wgid = (xcd < r ? xcd * (q + 1) : r * (q + 1) + (xcd - r) * q) + off; }
        const int nig = WGM * nN, gid = wgid / nig, fm = gid * WGM, gsz = (nM - fm) < WGM ? (nM - fm) : WGM;
        u.pm = fm + ((wgid % nig) % gsz); u.pn = (wgid % nig) / gsz; return true;
    }
    __device__ __forceinline__ void a_ready(const Unit&) const {}
    __device__ __forceinline__ void done(const Unit&) const {}
};

__device__ __forceinline__ unsigned cvt_pk_bf16(float lo, float hi) { unsigned r; asm volatile("v_cvt_pk_bf16_f32 %0, %1, %2" : "=v"(r) : "v"(lo), "v"(hi)); return r; }
typedef float f32x2 __attribute__((ext_vector_type(2)));
__device__ __forceinline__ f32x2 gelu_pk(f32x2 v) {
    const f32x2 av = __builtin_elementwise_abs(v), d = av * 0.2316418882f + 1.0f;
    f32x2 t; t.x = __builtin_amdgcn_rcpf(d.x); t.y = __builtin_amdgcn_rcpf(d.y);
    f32x2 q = t * 0.5307027145f + (-0.7265760135f); q = q * t + 0.7107068705f; q = q * t + (-0.142248368f); q = q * t + 0.127414796f; q = q * t;
    const f32x2 s = (v * v) * (-0.72134752044f);
    f32x2 e; e.x = __builtin_amdgcn_exp2f(s.x); e.y = __builtin_amdgcn_exp2f(s.y);
    const f32x2 m = v * (q * e), r = v - m;
    f32x2 o; o.x = v.x < 0.f ? m.x : r.x; o.y = v.y < 0.f ? m.y : r.y; return o;
}
template <int ACT  > struct EpiBf16 {
    static constexpr bool PERM = true, AFTER_DRAIN = false; static_assert(ACT == 0 || ACT == 1, "EpiBf16: ACT is 0 (none) or 1 (gelu_pk)");
    bf16_t* O; int ldc; const float* bias; int split_cols; size_t split_stride; float scale0;
    __device__ __forceinline__ void operator()(const f32x4 (&acc)[2][2][4][2], const Unit& u, int wr, int wc, int fr, int fq) const {
        const int row0 = u.pm * BM + wr * 64 + fr; int colt = u.pn * BM; bf16_t* base = O;
        float sc = 1.f; if (split_cols) { const int t = colt / split_cols; base += (size_t)t * split_stride; colt -= t * split_cols; if (t == 0) sc = scale0; }
        const int col0 = colt + wc * 32 + 8 * fq, bcol0 = u.pn * BM + wc * 32 + 8 * fq;
        f32x4 bv[2][2];
#pragma unroll
        for (int bj = 0; bj < 2; ++bj)
#pragma unroll
            for (int n = 0; n < 2; ++n) bv[bj][n] = bias ? *(const f32x4*)(bias + bcol0 + bj * HALF + 4 * n) : (f32x4){0.f, 0.f, 0.f, 0.f};
#pragma unroll
        for (int ai = 0; ai < 2; ++ai)
#pragma unroll
            for (int m = 0; m < 4; ++m) { bf16_t* rowp = base + (size_t)(row0 + ai * HALF + m * 16) * ldc + col0;
#pragma unroll
                for (int bj = 0; bj < 2; ++bj) { f32x4 v0 = acc[ai][bj][m][0] + bv[bj][0], v1 = acc[ai][bj][m][1] + bv[bj][1];
                    if (ACT == 1) { f32x2 a = gelu_pk((f32x2){v0[0], v0[1]}), b = gelu_pk((f32x2){v0[2], v0[3]}), c = gelu_pk((f32x2){v1[0], v1[1]}), d = gelu_pk((f32x2){v1[2], v1[3]});
                        v0 = (f32x4){a.x, a.y, b.x, b.y}; v1 = (f32x4){c.x, c.y, d.x, d.y}; }
                    v0 = v0 * sc; v1 = v1 * sc; u32x4 w; w.x = cvt_pk_bf16(v0[0], v0[1]); w.y = cvt_pk_bf16(v0[2], v0[3]); w.z = cvt_pk_bf16(v1[0], v1[1]); w.w = cvt_pk_bf16(v1[2], v1[3]);
                    *(u32x4*)(rowp + bj * HALF) = w; } }
    }
};
template <class Epi, class Sched, bool ALIGN_EPI = false, bool SP2 = false>
__device__ __forceinline__ void gemm_phase(PG8_LAS unsigned char* lds, const Gemm g, const Sched& S, const Epi& E) {
    const int tid = threadIdx.x, wid = __builtin_amdgcn_readfirstlane(tid >> 6), lane = tid & 63, wr = wid >> 2, wc = wid & 3, fr = lane & 15, fq = lane >> 4;
    const int K = g.K, nt = K / BK;
    unsigned voffA[2], voffB[2];
#pragma unroll
    for (int i = 0; i < 2; ++i) { int R, C; stage_rc(tid * 16 + i * 8192, R, C); const int Rb = Epi::PERM ? ((R & ~31) + perm32(R & 31)) : R;
        voffA[i] = (unsigned)(R * K + C) * 2u; voffB[i] = (unsigned)(Rb * K + C) * 2u; }
    const size_t kstep = (size_t)(BK * 2);
    const size_t hstep = (size_t)HALF * K * 2;
    const size_t tstep = 2 * hstep;
    const unsigned ldsw = (unsigned)wid * 1024u;
    const int aoff = lds_byte(wr * 64 + fr, fq * 8), boff = lds_byte(wc * 32 + fr, fq * 8);
#define PG8_SA(b, h) (((b) * 2 + (h)) * HTB)
#define PG8_SB(b, h) ((4 + (b) * 2 + (h)) * HTB)
#define PG8_STAGE(bufoff, gbase, voff) do { _Pragma("unroll") for (int _i = 0; _i < 2; ++_i) \
        __builtin_amdgcn_global_load_lds((const unsigned*)((const char*)(gbase) + (voff)[_i]), (PG8_LAS unsigned*)(lds + (bufoff) + ldsw + _i * 8192), 16, 0, 0); } while (0)
#define PG8_LDA(dst, b, h) do { _Pragma("unroll") for (int m = 0; m < 4; ++m) _Pragma("unroll") for (int k = 0; k < 2; ++k) dst[m][k] = *(const PG8_LAS bf16x8*)(lds + PG8_SA(b, h) + aoff + m * 2048 + k * 1024); } while (0)
#define PG8_LDB(dst, b, h) do { _Pragma("unroll") for (int n = 0; n < 2; ++n) _Pragma("unroll") for (int k = 0; k < 2; ++k) dst[n][k] = *(const PG8_LAS bf16x8*)(lds + PG8_SB(b, h) + boff + n * 2048 + k * 1024); } while (0)
#define PG8_MMA(ai, bj, At, Bt) do { __builtin_amdgcn_s_setprio(1); _Pragma("unroll") for (int m = 0; m < 4; ++m) _Pragma("unroll") for (int n = 0; n < 2; ++n) _Pragma("unroll") for (int k = 0; k < 2; ++k) \
        acc[ai][bj][m][n] = __builtin_amdgcn_mfma_f32_16x16x32_bf16(Bt[n][k], At[m][k], acc[ai][bj][m][n], 0, 0, 0); __builtin_amdgcn_s_setprio(0); } while (0)
#define PG8_WAIT_V(n) asm volatile("s_waitcnt vmcnt(" #n ")" ::: "memory")
#define PG8_WAIT_L(n) asm volatile("s_waitcnt lgkmcnt(" #n ")" ::: "memory")
#define PG8_BAR __builtin_amdgcn_s_barrier()
#define PG8_SCHED __builtin_amdgcn_sched_barrier(0)
    Unit cur, nxt; int ui = 0;
    if (!S.next(0, cur)) return;
    f32x4 acc[2][2][4][2];
#pragma unroll
    for (int a = 0; a < 2; ++a)
#pragma unroll
        for (int b = 0; b < 2; ++b)
#pragma unroll
            for (int m = 0; m < 4; ++m)
#pragma unroll
                for (int n = 0; n < 2; ++n) acc[a][b][m][n] = (f32x4){0.f, 0.f, 0.f, 0.f};
    bf16x8 At[4][2], B0[2][2], B1[2][2];
    const char* cA = (const char*)g.A + (size_t)cur.pm * tstep; const char* cB = (const char*)g.Bt + (size_t)cur.pn * tstep;
    S.a_ready(cur);
    if constexpr (SP2) {
        PG8_STAGE(PG8_SB(0, 0), cB, voffB); PG8_STAGE(PG8_SB(0, 1), cB + hstep, voffB); PG8_STAGE(PG8_SA(0, 0), cA, voffA); PG8_STAGE(PG8_SA(0, 1), cA + hstep, voffA);
        if (wr == 1) PG8_BAR;
        PG8_WAIT_V(2); PG8_BAR;
        PG8_STAGE(PG8_SB(1, 0), cB + kstep, voffB); PG8_STAGE(PG8_SA(1, 0), cA + kstep, voffA); PG8_STAGE(PG8_SB(1, 1), cB + hstep + kstep, voffB);
        PG8_WAIT_V(6); PG8_BAR;
    } else {
        PG8_STAGE(PG8_SB(0, 0), cB, voffB); PG8_STAGE(PG8_SA(0, 0), cA, voffA); PG8_STAGE(PG8_SB(0, 1), cB + hstep, voffB); PG8_STAGE(PG8_SA(0, 1), cA + hstep, voffA);
        if (wr == 1) PG8_BAR;
        PG8_WAIT_V(4); PG8_BAR;
        PG8_STAGE(PG8_SB(1, 0), cB + kstep, voffB); PG8_STAGE(PG8_SA(1, 0), cA + kstep, voffA); PG8_STAGE(PG8_SB(1, 1), cB + hstep + kstep, voffB);
        PG8_WAIT_V(6); PG8_BAR;
    }
    for (;;) {
        const bool has_next = S.next(ui + 1, nxt);
        const char* nA = has_next ? (const char*)g.A + (size_t)nxt.pm * tstep : cA; const char* nB = has_next ? (const char*)g.Bt + (size_t)nxt.pn * tstep : cB;
        for (int t = 0; t < nt; t += 2) {
            const bool last = (t == nt - 2);
            const char* a1 = cA + (size_t)(t + 1) * kstep;
            const char* a2 = last ? nA : cA + (size_t)(t + 2) * kstep; const char* b2 = last ? nB : cB + (size_t)(t + 2) * kstep;
            const char* a3 = a2 + kstep; const char* b3 = b2 + kstep;
            if (last && has_next) S.a_ready(nxt);
            if constexpr (SP2) {
            PG8_LDB(B0, 0, 0); PG8_LDB(B1, 0, 1); PG8_SCHED; PG8_LDA(At, 0, 0); PG8_STAGE(PG8_SA(1, 1), a1 + hstep, voffA);
            PG8_WAIT_V(8); PG8_WAIT_L(0); PG8_BAR; PG8_MMA(0, 0, At, B0); PG8_MMA(0, 1, At, B1); PG8_BAR; PG8_SCHED;
            PG8_LDA(At, 0, 1); PG8_STAGE(PG8_SB(0, 0), b2, voffB); PG8_STAGE(PG8_SB(0, 1), b2 + hstep, voffB); PG8_STAGE(PG8_SA(0, 0), a2, voffA);
            PG8_WAIT_V(8); PG8_WAIT_L(0); PG8_BAR; PG8_MMA(1, 0, At, B0); PG8_MMA(1, 1, At, B1); PG8_BAR; PG8_SCHED;
            PG8_LDB(B0, 1, 0); PG8_LDB(B1, 1, 1); PG8_SCHED; PG8_LDA(At, 1, 0); PG8_STAGE(PG8_SA(0, 1), a2 + hstep, voffA);
            PG8_WAIT_V(8); PG8_WAIT_L(0); PG8_BAR; PG8_MMA(0, 0, At, B0); PG8_MMA(0, 1, At, B1); PG8_BAR; PG8_SCHED;
            PG8_LDA(At, 1, 1); PG8_STAGE(PG8_SB(1, 0), b3, voffB); PG8_STAGE(PG8_SB(1, 1), b3 + hstep, voffB); PG8_STAGE(PG8_SA(1, 0), a3, voffA);
            PG8_WAIT_V(8); PG8_WAIT_L(0); PG8_BAR; PG8_MMA(1, 0, At, B0); PG8_MMA(1, 1, At, B1); PG8_BAR; PG8_SCHED;
            } else {
            PG8_LDB(B0, 0, 0); PG8_SCHED; PG8_LDA(At, 0, 0); PG8_STAGE(PG8_SA(1, 1), a1 + hstep, voffA);
            PG8_WAIT_L(8); PG8_BAR; PG8_WAIT_L(0); PG8_MMA(0, 0, At, B0); PG8_BAR; PG8_SCHED;
            PG8_LDB(B1, 0, 1); PG8_STAGE(PG8_SB(0, 0), b2, voffB);
            PG8_BAR; PG8_WAIT_L(0); PG8_MMA(0, 1, At, B1); PG8_BAR;
            PG8_LDA(At, 0, 1); PG8_STAGE(PG8_SA(0, 0), a2, voffA);
            PG8_BAR; PG8_WAIT_L(0); PG8_MMA(1, 0, At, B0); PG8_BAR; PG8_SCHED;
            PG8_STAGE(PG8_SB(0, 1), b2 + hstep, voffB);
            PG8_WAIT_V(6); PG8_BAR; PG8_MMA(1, 1, At, B1); PG8_BAR;
            PG8_LDB(B0, 1, 0); PG8_SCHED; PG8_LDA(At, 1, 0); PG8_STAGE(PG8_SA(0, 1), a2 + hstep, voffA);
            PG8_WAIT_L(8); PG8_BAR; PG8_WAIT_L(0); PG8_MMA(0, 0, At, B0); PG8_BAR; PG8_SCHED;
            PG8_LDB(B1, 1, 1); PG8_STAGE(PG8_SB(1, 0), b3, voffB);
            PG8_BAR; PG8_WAIT_L(0); PG8_MMA(0, 1, At, B1); PG8_BAR;
            PG8_LDA(At, 1, 1); PG8_STAGE(PG8_SA(1, 0), a3, voffA);
            PG8_BAR; PG8_WAIT_L(0); PG8_MMA(1, 0, At, B0); PG8_BAR; PG8_SCHED;
            PG8_STAGE(PG8_SB(1, 1), b3 + hstep, voffB);
            PG8_WAIT_V(6); PG8_BAR; PG8_MMA(1, 1, At, B1); PG8_BAR;
            }
        }
        if constexpr (ALIGN_EPI) { if (wr == 0) PG8_BAR; }
        if constexpr (!Epi::AFTER_DRAIN) { E(acc, cur, wr, wc, fr, fq); S.done(cur); }
        if (!has_next) break;
#pragma unroll
        for (int a = 0; a < 2; ++a)
#pragma unroll
            for (int b = 0; b < 2; ++b)
#pragma unroll
                for (int m = 0; m < 4; ++m)
#pragma unroll
                    for (int n = 0; n < 2; ++n) acc[a][b][m][n] = (f32x4){0.f, 0.f, 0.f, 0.f};
        cur = nxt; cA = nA; cB = nB; ++ui;
        if constexpr (ALIGN_EPI) { if (wr == 1) PG8_BAR; }
    }
    PG8_WAIT_V(0);
    if constexpr (!ALIGN_EPI) { if (wr == 0) PG8_BAR; }
    PG8_BAR;
    if constexpr (Epi::AFTER_DRAIN) { E.fused(acc, cur, wr, wc, fr, fq, lds, wid, lane); S.done(cur); }
#undef PG8_SA
#undef PG8_SB
#undef PG8_STAGE
#undef PG8_LDA
#undef PG8_LDB
#undef PG8_MMA
#undef PG8_WAIT_V
#undef PG8_WAIT_L
#undef PG8_BAR
#undef PG8_SCHED
}

struct EpiResF32 {
    static constexpr bool PERM = false, AFTER_DRAIN = false;
    const float* base; float* out; int ldc;
    __device__ __forceinline__ void operator()(const f32x4 (&acc)[2][2][4][2], const Unit& u, int wr, int wc, int fr, int fq) const {
        const int col0 = u.pn * BM + wc * 32 + 4 * fq;
#pragma unroll
        for (int ai = 0; ai < 2; ++ai)
#pragma unroll
            for (int m = 0; m < 4; ++m) { const int r = ai * HALF + wr * 64 + m * 16 + fr; const size_t off = (size_t)(u.pm * BM + r) * ldc + col0;
#pragma unroll
                for (int bj = 0; bj < 2; ++bj)
#pragma unroll
                    for (int n = 0; n < 2; ++n) { const f32x4 bs = *(const f32x4*)(base + off + bj * HALF + n * 16); *(f32x4*)(out + off + bj * HALF + n * 16) = bs + acc[ai][bj][m][n]; } }
    }
};
}

constexpr int BATCH = 4, SEQ = 8192, DM = 1024, M = BATCH * SEQ;
constexpr int NIN = 3088, NIN_PAD = 3328;
constexpr int C_GQ = 0, C_GK = 256, C_GV = 512, C_GG = 1024, C_AQ = 1536, C_AK = 2048, C_AV = 2560, C_GLR = 3072;
constexpr int NEXP = 16384;
constexpr float NORM_EPS = 1e-6f;
constexpr int NWAVES = 8, NTHREADS = 512;

constexpr size_t MiB = 1u << 20;
constexpr size_t WS_CTL = 0, CTL_ZERO_BYTES = 1 * MiB;
constexpr size_t WS_WT_IN = 1 * MiB;
constexpr size_t WS_WT_OUT = 8 * MiB;
constexpr size_t WS_WT_CIN = 10 * MiB;
constexpr size_t WS_WT_COUT = 14 * MiB;
constexpr size_t WS_WT_Q0 = 16 * MiB;
constexpr size_t WS_WT_Q1 = 20 * MiB;
constexpr size_t WS_ACT = 32 * MiB;
constexpr size_t WS_S = 96 * MiB;
constexpr size_t WS_PROJ = WS_S;
constexpr size_t WS_GLAO = WS_S + 208 * MiB;
constexpr size_t WS_TOPS = WS_S + 128 * MiB;
constexpr size_t WS_TOPI = WS_S + 160 * MiB;
constexpr size_t WS_IDS = WS_S + 192 * MiB;
constexpr size_t WS_G = WS_S + 208 * MiB;
constexpr size_t WS_XC = WS_ACT;
constexpr size_t WS_A = WS_S + 128 * MiB;
constexpr size_t WS_U = WS_S + 256 * MiB;
constexpr size_t WS_TAB = 448 * MiB;
constexpr size_t WS_TAB8 = 448 * MiB;
constexpr size_t WS_WG = 24 * MiB;
constexpr size_t WS_AGG = WS_S + 128 * MiB;
constexpr size_t WS_SCL = 26 * MiB;
constexpr size_t WS_END = 512 * MiB;
constexpr int CW_BAR = 4096, CW_RANK = 8192;

constexpr int RING_BYTES = 131072;
constexpr int LDS_BYTES = 147456;
constexpr int LDSCTL_OFF = LDS_BYTES - 512, MISC_OFF = LDSCTL_OFF + 320;

#define LAS __attribute__((address_space(3)))
#define GAS __attribute__((address_space(1)))
typedef unsigned short bf16_t;
typedef float f32x4 __attribute__((ext_vector_type(4)));
typedef unsigned u32x4 __attribute__((ext_vector_type(4)));
typedef unsigned u32x2 __attribute__((ext_vector_type(2)));
typedef short bf16x8 __attribute__((ext_vector_type(8)));
typedef float f32x2 __attribute__((ext_vector_type(2)));

struct Params {
    const float *x, *mix_norm, *ffn_norm, *ab_w_in, *gla_w_alpha, *gla_b_alpha, *gla_head_gain, *ab_w_out;
    const float *c_w_in, *c_conv_w, *c_conv_b, *c_w_rgate, *c_b_rgate, *c_w_igate, *c_b_igate, *c_lambda, *c_w_out;
    const float *peer_w_query, *peer_sub_keys, *peer_u, *peer_v, *final_norm;
    float* out; unsigned char* ws;
    int ph_lo, ph_hi;
};

typedef float f32x2_cv __attribute__((ext_vector_type(2))); typedef __bf16 bf16x2_cv __attribute__((ext_vector_type(2)));
__device__ __forceinline__ unsigned pk2(float lo, float hi) { const f32x2_cv v = {lo, hi}; const bf16x2_cv b = __builtin_convertvector(v, bf16x2_cv); return __builtin_bit_cast(unsigned, b); }
__device__ __forceinline__ unsigned f2bf(float f) { return pk2(f, f) & 0xffffu; }
__device__ __forceinline__ float bf2f(bf16_t b) { return __builtin_bit_cast(float, (unsigned)b << 16); }
__device__ __forceinline__ float bflo(unsigned w) { return __builtin_bit_cast(float, w << 16); }
__device__ __forceinline__ float bfhi(unsigned w) { return __builtin_bit_cast(float, w & 0xffff0000u); }
__device__ __forceinline__ float wave_sum(float v) {
#pragma unroll
    for (int o = 1; o < 64; o <<= 1) v += __shfl_xor(v, o);
    return v;
}
__device__ __forceinline__ float gelu_tanh(float x) {
    const float x2 = x * x, u2 = x * (2.3022082f + 0.10294324f * x2);
    const float e = __builtin_amdgcn_exp2f(u2);
    return x - x * __builtin_amdgcn_rcpf(e + 1.f);
}
__device__ __forceinline__ float sigmoidf_(float x) { return __builtin_amdgcn_rcpf(1.f + __expf(-x)); }

struct Ctx { int tid, lane, wave, blk, nblk, gtid, gthreads, gwave, gwaves; LAS unsigned char* lds; };

template <class F> __device__ __forceinline__ void transpose_cvt(const float* W, int K, int Nsrc, bf16_t* WT, int Ndst, F srcmap, int gtid, int gthreads) {
    const int total = (K / 8) * Ndst;
    for (int idx = gtid; idx < total; idx += gthreads) {
        const int ko = idx / Ndst, n = idx - ko * Ndst; const int sn = srcmap(n);
        u32x4 w = {0u, 0u, 0u, 0u};
        if (sn >= 0) { const float* s = W + (size_t)(ko * 8) * Nsrc + sn;
            w.x = pk2(s[0], s[(size_t)Nsrc]); w.y = pk2(s[2 * (size_t)Nsrc], s[3 * (size_t)Nsrc]); w.z = pk2(s[4 * (size_t)Nsrc], s[5 * (size_t)Nsrc]); w.w = pk2(s[6 * (size_t)Nsrc], s[7 * (size_t)Nsrc]); }
        *(u32x4*)(WT + (size_t)n * K + ko * 8) = w;
    }
}
__device__ __forceinline__ void cvt_bf16(const float* src, bf16_t* dst, size_t n8, int gtid, int gthreads) {
    for (size_t i = gtid; i < n8; i += gthreads) { const f32x4 a = *(const f32x4*)(src + i * 8), b = *(const f32x4*)(src + i * 8 + 4);
        u32x4 w; w.x = pk2(a.x, a.y); w.y = pk2(a.z, a.w); w.z = pk2(b.x, b.y); w.w = pk2(b.z, b.w); *(u32x4*)(dst + i * 8) = w; }
}
__device__ __forceinline__ void norm_rows_bf16(const float* src, const float* gain, bf16_t* dst, const Ctx& c, unsigned char* x8 = nullptr) {
    for (int m0 = c.gwave; m0 < M; m0 += 4 * c.gwaves) {
        f32x4 v[4][4]; float s[4];
#pragma unroll
        for (int u = 0; u < 4; ++u) { const f32x4* xr = (const f32x4*)(src + (size_t)min(m0 + u * c.gwaves, M - 1) * DM) + c.lane;
#pragma unroll
            for (int j = 0; j < 4; ++j) v[u][j] = xr[64 * j]; }
#pragma unroll
        for (int u = 0; u < 4; ++u) { s[u] = 0.f;
#pragma unroll
            for (int j = 0; j < 4; ++j) s[u] += (v[u][j].x * v[u][j].x + v[u][j].y * v[u][j].y) + (v[u][j].z * v[u][j].z + v[u][j].w * v[u][j].w); }
#pragma unroll
        for (int o = 1; o < 64; o <<= 1) {
#pragma unroll
            for (int u = 0; u < 4; ++u) s[u] += __shfl_xor(s[u], o); }
#pragma unroll
        for (int u = 0; u < 4; ++u) { const int m = m0 + u * c.gwaves; if (m >= M) break; const float rstd = __builtin_amdgcn_rsqf(s[u] * (1.f / DM) + NORM_EPS);
            u32x2* o8 = (u32x2*)(dst + (size_t)m * DM) + c.lane;
#pragma unroll
            for (int j = 0; j < 4; ++j) { const f32x4 g = *((const f32x4*)gain + 64 * j + c.lane); const unsigned w0 = pk2(v[u][j].x * rstd * g.x, v[u][j].y * rstd * g.y), w1 = pk2(v[u][j].z * rstd * g.z, v[u][j].w * rstd * g.w);
                u32x2 w; w.x = w0; w.y = w1; o8[64 * j] = w;
                if (x8) {
                    const float f0 = bflo(w0), f1 = bfhi(w0), f2 = bflo(w1), f3 = bfhi(w1);
                    int hq = __builtin_amdgcn_cvt_pk_fp8_f32(f0, f1, 0, false); hq = __builtin_amdgcn_cvt_pk_fp8_f32(f2, f3, hq, true);
                    const f32x2 d0 = __builtin_amdgcn_cvt_pk_f32_fp8(hq, false), d1 = __builtin_amdgcn_cvt_pk_f32_fp8(hq, true);
                    int lq = __builtin_amdgcn_cvt_pk_fp8_f32((f0 - d0.x) * 16.f, (f1 - d0.y) * 16.f, 0, false); lq = __builtin_amdgcn_cvt_pk_fp8_f32((f2 - d1.x) * 16.f, (f3 - d1.y) * 16.f, lq, true);
                    unsigned* xo = (unsigned*)(x8 + (size_t)m * 2048) + 64 * j + c.lane; xo[0] = (unsigned)hq; xo[256] = (unsigned)lq; } } }
    }
}
__device__ __forceinline__ void norm_rows_f32(float* buf, const float* gain, const Ctx& c) {
    for (int m0 = c.gwave; m0 < M; m0 += 4 * c.gwaves) {
        f32x4 v[4][4]; float s[4];
#pragma unroll
        for (int u = 0; u < 4; ++u) { const f32x4* xr = (const f32x4*)(buf + (size_t)min(m0 + u * c.gwaves, M - 1) * DM) + c.lane;
#pragma unroll
            for (int j = 0; j < 4; ++j) v[u][j] = xr[64 * j]; }
#pragma unroll
        for (int u = 0; u < 4; ++u) { s[u] = 0.f;
#pragma unroll
            for (int j = 0; j < 4; ++j) s[u] += (v[u][j].x * v[u][j].x + v[u][j].y * v[u][j].y) + (v[u][j].z * v[u][j].z + v[u][j].w * v[u][j].w); }
#pragma unroll
        for (int o = 1; o < 64; o <<= 1) {
#pragma unroll
            for (int u = 0; u < 4; ++u) s[u] += __shfl_xor(s[u], o); }
#pragma unroll
        for (int u = 0; u < 4; ++u) { if (m0 + u * c.gwaves >= M) break; const float rstd = __builtin_amdgcn_rsqf(s[u] * (1.f / DM) + NORM_EPS); f32x4* xw = (f32x4*)(buf + (size_t)(m0 + u * c.gwaves) * DM) + c.lane;
#pragma unroll
            for (int j = 0; j < 4; ++j) { const f32x4 g = *((const f32x4*)gain + 64 * j + c.lane); xw[64 * j] = v[u][j] * rstd * g; } }
    }
}

constexpr size_t WS_GLRB = 30 * MiB;
__device__ __forceinline__ void ph_glr(const Params& p, const Ctx& c) {
    const bf16_t* XN = (const bf16_t*)(p.ws + WS_ACT); const bf16_t* WG = (const bf16_t*)(p.ws + WS_WT_IN) + (size_t)3072 * DM; bf16_t* GL = (bf16_t*)(p.ws + WS_GLRB);
    const int lane = c.lane, r = lane & 15, q = lane >> 4;
    for (int tile = c.gwave; tile < M / 16; tile += c.gwaves) {
        const bf16_t* ap = XN + (size_t)(tile * 16 + r) * DM + 8 * q; const bf16_t* bp = WG + (size_t)r * DM + 8 * q;
        f32x4 acc = {0.f, 0.f, 0.f, 0.f};
#pragma unroll 8
        for (int s2 = 0; s2 < 32; ++s2) acc = __builtin_amdgcn_mfma_f32_16x16x32_bf16(__builtin_bit_cast(bf16x8, *(const u32x4*)(ap + 32 * s2)), __builtin_bit_cast(bf16x8, *(const u32x4*)(bp + 32 * s2)), acc, 0, 0, 0);
#pragma unroll
        for (int i = 0; i < 4; ++i) GL[(size_t)(tile * 16 + 4 * q + i) * 16 + r] = (bf16_t)f2bf(acc[i]);
    }
}

__device__ __forceinline__ void ph_gla_naive(const Params& p, const Ctx& c) {
    const int b = c.blk >> 2, h = c.blk & 3;
    LAS float* sq = (LAS float*)c.lds; LAS float* sk = sq + 4096; LAS float* sa = sk + 4096; LAS float* sv = sa + 4096;
    const bf16_t* proj = (const bf16_t*)(p.ws + WS_PROJ);
    float* go = (float*)(p.ws + WS_GLAO);
    const int tid = c.tid, v = tid >> 2, kq = tid & 3;
    float S[16];
#pragma unroll
    for (int i = 0; i < 16; ++i) S[i] = 0.f;
    for (int t0 = 0; t0 < SEQ; t0 += 64) {
        __syncthreads();
        for (int e = tid; e < 4096; e += NTHREADS) { const int tt = e >> 6, kk = e & 63; const bf16_t* pr = proj + (size_t)(b * SEQ + t0 + tt) * NIN_PAD;
            sq[e] = bf2f(pr[C_GQ + h * 64 + kk]); sk[e] = bf2f(pr[C_GK + h * 64 + kk]);
            float z = p.gla_b_alpha[h * 64 + kk];
#pragma unroll
            for (int r = 0; r < 16; ++r) z += bf2f(pr[C_GLR + r]) * p.gla_w_alpha[r * 256 + h * 64 + kk];
            const float ls = fminf(z, 0.f) - log1pf(expf(-fabsf(z)));
            sa[e] = expf(ls * (1.f / 16.f)); }
        for (int e = tid; e < 8192; e += NTHREADS) { const int tt = e >> 7, vv = e & 127; sv[e] = bf2f(proj[(size_t)(b * SEQ + t0 + tt) * NIN_PAD + C_GV + h * 128 + vv]); }
        __syncthreads();
        for (int tt = 0; tt < 64; ++tt) {
            const float vv = sv[tt * 128 + v]; float part = 0.f;
#pragma unroll
            for (int i = 0; i < 16; ++i) { const int kk = kq * 16 + i; S[i] = sa[tt * 64 + kk] * S[i] + sk[tt * 64 + kk] * vv; part += sq[tt * 64 + kk] * S[i]; }
            part += __shfl_xor(part, 1); part += __shfl_xor(part, 2);
            if (kq == 0) go[(size_t)(b * SEQ + t0 + tt) * 512 + h * 128 + v] = part * 0.125f;
        }
    }
}
__device__ __forceinline__ void ph_attn_naive(const Params& p, int gtid, int gthreads) {
    const bf16_t* proj = (const bf16_t*)(p.ws + WS_PROJ); bf16_t* mixed = (bf16_t*)(p.ws + WS_ACT);
    for (int idx = gtid; idx < M * 8; idx += gthreads) {
        const int t = idx & 8191, h = (idx >> 13) & 7, b = idx >> 16;
        const size_t row = (size_t)b * SEQ + t;
        float q[64], o[64];
        { const u32x4* qp = (const u32x4*)(proj + row * NIN_PAD + C_AQ + h * 64);
#pragma unroll
          for (int i = 0; i < 8; ++i) { const u32x4 w = qp[i]; q[8*i] = bflo(w.x); q[8*i+1] = bfhi(w.x); q[8*i+2] = bflo(w.y); q[8*i+3] = bfhi(w.y); q[8*i+4] = bflo(w.z); q[8*i+5] = bfhi(w.z); q[8*i+6] = bflo(w.w); q[8*i+7] = bfhi(w.w); } }
#pragma unroll
        for (int d = 0; d < 64; ++d) o[d] = 0.f;
        float mx = -1e30f, l = 0.f;
        const float slope = exp2f(-(float)(h + 1));
        for (int br = 0; br < 3; ++br) { const int dil = 1 << (2 * br);
            for (int j = 0; j <= 128; ++j) { const int tk = t - j * dil; if (tk < 0) break;
                const u32x4* kp = (const u32x4*)(proj + ((size_t)b * SEQ + tk) * NIN_PAD + C_AK + h * 64); const u32x4* vp = kp + 64;
                float s = 0.f;
#pragma unroll
                for (int i = 0; i < 8; ++i) { const u32x4 w = kp[i]; s += q[8*i] * bflo(w.x) + q[8*i+1] * bfhi(w.x) + q[8*i+2] * bflo(w.y) + q[8*i+3] * bfhi(w.y) + q[8*i+4] * bflo(w.z) + q[8*i+5] * bfhi(w.z) + q[8*i+6] * bflo(w.w) + q[8*i+7] * bfhi(w.w); }
                s = s * 0.125f - slope * (float)(j * dil);
                const float mn = fmaxf(mx, s), corr = __expf(mx - mn), pp = __expf(s - mn);
                l = l * corr + pp; mx = mn;
#pragma unroll
                for (int i = 0; i < 8; ++i) { const u32x4 w = vp[i];
                    o[8*i] = o[8*i] * corr + pp * bflo(w.x); o[8*i+1] = o[8*i+1] * corr + pp * bfhi(w.x); o[8*i+2] = o[8*i+2] * corr + pp * bflo(w.y); o[8*i+3] = o[8*i+3] * corr + pp * bfhi(w.y);
                    o[8*i+4] = o[8*i+4] * corr + pp * bflo(w.z); o[8*i+5] = o[8*i+5] * corr + pp * bfhi(w.z); o[8*i+6] = o[8*i+6] * corr + pp * bflo(w.w); o[8*i+7] = o[8*i+7] * corr + pp * bfhi(w.w); }
            } }
        const float rl = 1.f / l;
        u32x4* op = (u32x4*)(mixed + row * DM + 512 + h * 64);
#pragma unroll
        for (int i = 0; i < 8; ++i) { u32x4 w; w.x = pk2(o[8*i] * rl, o[8*i+1] * rl); w.y = pk2(o[8*i+2] * rl, o[8*i+3] * rl); w.z = pk2(o[8*i+4] * rl, o[8*i+5] * rl); w.w = pk2(o[8*i+6] * rl, o[8*i+7] * rl); op[i] = w; }
    }
}

constexpr int AT_K = 0, AT_V = 272 * 144, AT_END = 2 * 272 * 144;
typedef short s16x4 __attribute__((ext_vector_type(4)));
__device__ __forceinline__ s16x4 lds_tr16(LAS const unsigned char* pbyte) { return __builtin_bit_cast(s16x4, __builtin_amdgcn_ds_read_tr16_b64_v4i16((LAS s16x4*)pbyte)); }
__device__ __forceinline__ void ph_attn(const Params& p, const Ctx& c) {
    LAS unsigned char* L = c.lds;
    const bf16_t* proj = (const bf16_t*)(p.ws + WS_PROJ); bf16_t* AO = (bf16_t*)p.out; float* LSE = (float*)((unsigned char*)p.out + 96 * MiB);
    const int tid = c.tid, lane = c.lane, w = c.wave, r = lane & 15, qq = lane >> 4;
    constexpr float LOG2E = 1.4426950408889634f;
    __syncthreads();
    for (int i = tid; i < 16 * 144 / 4; i += NTHREADS) ((LAS unsigned*)(L + AT_V + 256 * 144))[i] = 0u;
    u32x4 kreg[4], vreg[4], qreg[2];
#define AT_DECODE(it_) const int h = (it_) & 7, rest = (it_) >> 3, br = rest >> 8, u = rest & 255, sh = 2 * br, dil = 1 << sh, nbm = (64 >> sh) - 1; \
        const int bres = u >> (6 - sh), blk = u & nbm, b = bres >> sh, res = bres & (dil - 1); const size_t rowb = (size_t)b * SEQ; const int l0 = blk * 128
#define AT_ISSUE(it_) do { AT_DECODE(it_); (void)br; \
        _Pragma("unroll") for (int k = 0; k < 4; ++k) { const int idx = tid + NTHREADS * k, row = idx >> 3, ch = idx & 7, l = l0 - 128 + row; kreg[k] = (u32x4){0u, 0u, 0u, 0u}; vreg[k] = kreg[k]; \
            if (l >= 0) { const bf16_t* src = proj + (rowb + (size_t)l * dil + res) * NIN_PAD + C_AK + h * 64 + ch * 8; kreg[k] = *(const u32x4*)src; vreg[k] = *(const u32x4*)(src + 512); } } \
        const bf16_t* qp = proj + (rowb + (size_t)(l0 + 16 * w + r) * dil + res) * NIN_PAD + C_AQ + h * 64 + 8 * qq; qreg[0] = *(const u32x4*)qp; qreg[1] = *(const u32x4*)(qp + 32); } while (0)
    if (c.blk < 6144) AT_ISSUE(c.blk);
    for (int item = c.blk; item < 6144; item += c.nblk) {
        AT_DECODE(item);
        __syncthreads();
#pragma unroll
        for (int k = 0; k < 4; ++k) { const int idx = tid + NTHREADS * k, row = idx >> 3, ch = idx & 7;
            *(LAS u32x4*)(L + AT_K + row * 144 + ch * 16) = kreg[k]; *(LAS u32x4*)(L + AT_V + row * 144 + ch * 16) = vreg[k]; }
        bf16x8 qf[2]; qf[0] = __builtin_bit_cast(bf16x8, qreg[0]); qf[1] = __builtin_bit_cast(bf16x8, qreg[1]);
        { const int nit = item + c.nblk; if (nit < 6144) AT_ISSUE(nit); }
        __syncthreads();
        f32x4 sa[9];
#pragma unroll
        for (int jn = 0; jn < 9; ++jn) { LAS const unsigned char* kp = L + AT_K + (16 * (w + jn) + r) * 144 + 16 * qq;
            const bf16x8 k0 = __builtin_bit_cast(bf16x8, *(const LAS u32x4*)kp), k1 = __builtin_bit_cast(bf16x8, *(const LAS u32x4*)(kp + 64));
            f32x4 z = {0.f, 0.f, 0.f, 0.f}; z = __builtin_amdgcn_mfma_f32_16x16x32_bf16(k0, qf[0], z, 0, 0, 0); sa[jn] = __builtin_amdgcn_mfma_f32_16x16x32_bf16(k1, qf[1], z, 0, 0, 0); }
        const float sc = 0.125f * LOG2E, sl = exp2f(-(float)(h + 1)) * (float)dil * LOG2E;
        const int delta0 = r + 128 - 4 * qq;
        const float b0 = -sl * (float)delta0;
        float mx = -1e30f;
        if (blk > 0) {
#pragma unroll
            for (int jn = 0; jn < 9; ++jn)
#pragma unroll
                for (int i = 0; i < 4; ++i) { const bool valid = (unsigned)(delta0 - (16 * jn + i)) <= 128u;
                    const float v = valid ? __builtin_fmaf(sa[jn][i], sc, __builtin_fmaf(sl, (float)(16 * jn + i), b0)) : -1e30f; sa[jn][i] = v; mx = fmaxf(mx, v); }
        } else {
#pragma unroll
            for (int jn = 0; jn < 9; ++jn)
#pragma unroll
                for (int i = 0; i < 4; ++i) { const bool valid = ((unsigned)(delta0 - (16 * jn + i)) <= 128u) && (16 * (w + jn) + 4 * qq + i >= 128);
                    const float v = valid ? __builtin_fmaf(sa[jn][i], sc, __builtin_fmaf(sl, (float)(16 * jn + i), b0)) : -1e30f; sa[jn][i] = v; mx = fmaxf(mx, v); }
        }
        mx = fmaxf(mx, __shfl_xor(mx, 16)); mx = fmaxf(mx, __shfl_xor(mx, 32));
        float sum = 0.f;
#pragma unroll
        for (int jn = 0; jn < 9; ++jn)
#pragma unroll
            for (int i = 0; i < 4; ++i) { const float e = __builtin_amdgcn_exp2f(sa[jn][i] - mx); sa[jn][i] = e; sum += e; }
        sum += __shfl_xor(sum, 16); sum += __shfl_xor(sum, 32);
        { const int qi = 16 * w + r; if (qq == 0) LSE[((size_t)br * M + rowb + (size_t)(l0 + qi) * dil + res) * 8 + h] = (mx + __builtin_amdgcn_logf(sum)) * (1.f / LOG2E); }
        f32x4 oa[4];
#pragma unroll
        for (int dt = 0; dt < 4; ++dt) oa[dt] = (f32x4){0.f, 0.f, 0.f, 0.f};
#pragma unroll
        for (int s2 = 0; s2 < 5; ++s2) { u32x4 pw; pw.x = pk2(sa[2 * s2][0], sa[2 * s2][1]); pw.y = pk2(sa[2 * s2][2], sa[2 * s2][3]);
            if (s2 < 4) { pw.z = pk2(sa[2 * s2 + 1][0], sa[2 * s2 + 1][1]); pw.w = pk2(sa[2 * s2 + 1][2], sa[2 * s2 + 1][3]); } else { pw.z = 0u; pw.w = 0u; }
            LAS const unsigned char* vp = L + AT_V + (16 * (w + 2 * s2) + 4 * qq + (r >> 2)) * 144 + 8 * (r & 3);
#pragma unroll
            for (int dt = 0; dt < 4; ++dt) { const s16x4 v0 = lds_tr16(vp + 32 * dt), v1 = lds_tr16(vp + 32 * dt + 16 * 144);
                const bf16x8 vf = {v0[0], v0[1], v0[2], v0[3], v1[0], v1[1], v1[2], v1[3]};
                oa[dt] = __builtin_amdgcn_mfma_f32_16x16x32_bf16(__builtin_bit_cast(bf16x8, pw), vf, oa[dt], 0, 0, 0); } }
        const float rs = __builtin_amdgcn_rcpf(sum);
        LAS bf16_t* ost = (LAS bf16_t*)(L + AT_END + w * 2304);
#pragma unroll
        for (int i = 0; i < 4; ++i) { const float ri = __shfl(rs, 4 * qq + i);
#pragma unroll
            for (int dt = 0; dt < 4; ++dt) ost[(4 * qq + i) * 72 + 16 * dt + r] = (bf16_t)f2bf(oa[dt][i] * ri); }
        asm volatile("" ::: "memory");
        { const int qi = lane >> 2, dc = (lane & 3) * 16;
          const u32x4 o0 = *(const LAS u32x4*)(ost + qi * 72 + dc), o1 = *(const LAS u32x4*)(ost + qi * 72 + dc + 8);
          bf16_t* op = AO + ((size_t)br * M + rowb + (size_t)(l0 + 16 * w + qi) * dil + res) * 512 + h * 64 + dc;
          *(u32x4*)op = o0; *(u32x4*)(op + 8) = o1; }
        asm volatile("" ::: "memory");
    }
#undef AT_DECODE
#undef AT_ISSUE
}

constexpr size_t WS_CKV = WS_S + 272 * MiB;
constexpr size_t WS_DEC = WS_S + 336 * MiB;
constexpr size_t WS_SPREV = WS_ACT;
constexpr int GL_SEGT = 0, GL_V = 2048, GL_KT = GL_V + 64 * 272, GL_QD = GL_KT + 64 * 144, GL_KI = GL_QD + 64 * 144, GL_END = GL_KI + 64 * 144;
#ifdef GLR_FROM_PROJ
#define GLR_SRC (prow0 + C_GLR), NIN_PAD
#else
#define GLR_SRC ((const bf16_t*)(p.ws + WS_GLRB) + (size_t)bn * 64 * 16), 16
#endif
__device__ __forceinline__ void gla_cumdecay(const Params& p, const Ctx& c, const bf16_t* glr0, int gstride, int h, float (&bcum)[8], float& blast) {
    LAS float* SEGT = (LAS float*)(c.lds + GL_SEGT);
    const int kk = c.tid & 63, w = c.wave;
    float wa[16];
#pragma unroll
    for (int r = 0; r < 16; ++r) wa[r] = p.gla_w_alpha[r * 256 + h * 64 + kk];
    const float ba = p.gla_b_alpha[h * 64 + kk];
    float run = 0.f;
#pragma unroll
    for (int k = 0; k < 8; ++k) { const bf16_t* pr = glr0 + (size_t)(8 * w + k) * gstride;
        const u32x4 g0 = *(const u32x4*)pr, g1 = *(const u32x4*)(pr + 8);
        float z = ba + bflo(g0.x) * wa[0] + bfhi(g0.x) * wa[1] + bflo(g0.y) * wa[2] + bfhi(g0.y) * wa[3] + bflo(g0.z) * wa[4] + bfhi(g0.z) * wa[5] + bflo(g0.w) * wa[6] + bfhi(g0.w) * wa[7]
                     + bflo(g1.x) * wa[8] + bfhi(g1.x) * wa[9] + bflo(g1.y) * wa[10] + bfhi(g1.y) * wa[11] + bflo(g1.z) * wa[12] + bfhi(g1.z) * wa[13] + bflo(g1.w) * wa[14] + bfhi(g1.w) * wa[15];
        const float ls = fminf(z, 0.f) - __logf(1.f + __expf(-fabsf(z)));
        run += ls * (1.f / 16.f); bcum[k] = run; }
    __syncthreads();
    SEGT[w * 64 + kk] = run;
    __syncthreads();
    float off = 0.f, tot = 0.f;
#pragma unroll
    for (int sg = 0; sg < 8; ++sg) { const float v = SEGT[sg * 64 + kk]; off += (sg < w) ? v : 0.f; tot += v; }
#pragma unroll
    for (int k = 0; k < 8; ++k) bcum[k] += off;
    blast = tot;
}
__device__ __forceinline__ void gla_stage_v(const Ctx& c, const bf16_t* prow0, int h) {
#pragma unroll
    for (int k = 0; k < 2; ++k) { const int idx = c.tid + NTHREADS * k, row = idx >> 4, ch = idx & 15;
        *(LAS u32x4*)(c.lds + GL_V + row * 272 + ch * 16) = *(const u32x4*)(prow0 + (size_t)row * NIN_PAD + C_GV + h * 128 + ch * 8); }
}
__device__ __forceinline__ void ph_gla_a(const Params& p, const Ctx& c) {
    LAS unsigned char* L = c.lds; const bf16_t* proj = (const bf16_t*)(p.ws + WS_PROJ);
    float* CKV = (float*)(p.ws + WS_CKV); float* DEC = (float*)(p.ws + WS_DEC);
    const int tid = c.tid, lane = c.lane, w = c.wave, r = lane & 15, qq = lane >> 4, kk = tid & 63;
    for (int item = c.blk; item < 2048; item += c.nblk) {
        const int h = item & 3, bn = item >> 2; const bf16_t* prow0 = proj + (size_t)bn * 64 * NIN_PAD;
        float bcum[8], blast; gla_cumdecay(p, c, GLR_SRC, h, bcum, blast);
        gla_stage_v(c, prow0, h);
        { u32x4 o; float e[8];
#pragma unroll
          for (int k = 0; k < 8; ++k) e[k] = bf2f(prow0[(size_t)(8 * w + k) * NIN_PAD + C_GK + h * 64 + kk]) * __expf(blast - bcum[k]);
          o.x = pk2(e[0], e[1]); o.y = pk2(e[2], e[3]); o.z = pk2(e[4], e[5]); o.w = pk2(e[6], e[7]);
          *(LAS u32x4*)(L + GL_KT + kk * 144 + 16 * w) = o; }
        if (w == 0) DEC[(size_t)item * 64 + kk] = __expf(blast);
        __syncthreads();
        f32x4 acc[4];
#pragma unroll
        for (int n = 0; n < 4; ++n) acc[n] = (f32x4){0.f, 0.f, 0.f, 0.f};
#pragma unroll
        for (int s2 = 0; s2 < 2; ++s2) { LAS const unsigned char* vp = L + GL_V + (32 * s2 + 8 * qq + (r >> 2)) * 272 + (16 * w + 4 * (r & 3)) * 2;
            const s16x4 v0 = lds_tr16(vp), v1 = lds_tr16(vp + 4 * 272); const bf16x8 af = {v0[0], v0[1], v0[2], v0[3], v1[0], v1[1], v1[2], v1[3]};
#pragma unroll
            for (int n = 0; n < 4; ++n) { const bf16x8 bfr = __builtin_bit_cast(bf16x8, *(const LAS u32x4*)(L + GL_KT + (16 * n + r) * 144 + (32 * s2 + 8 * qq) * 2));
                acc[n] = __builtin_amdgcn_mfma_f32_16x16x32_bf16(af, bfr, acc[n], 0, 0, 0); } }
        float* outp = CKV + (size_t)item * 8192 + (16 * w + 4 * qq) * 64 + r;
#pragma unroll
        for (int n = 0; n < 4; ++n)
#pragma unroll
            for (int i = 0; i < 4; ++i) outp[i * 64 + 16 * n] = acc[n][i];
    }
}
__device__ __forceinline__ void ph_gla_b(const Params& p, const Ctx& c) {
    const float* CKV = (const float*)(p.ws + WS_CKV); const float* DEC = (const float*)(p.ws + WS_DEC); bf16_t* SP = (bf16_t*)(p.ws + WS_SPREV);
    for (int idx = c.gtid; idx < 16 * 8192; idx += c.gthreads) { const int bh = idx >> 13, e = idx & 8191, b = bh >> 2, h = bh & 3; float S = 0.f;
        for (int n0 = 0; n0 < 128; n0 += 8) { float cv[8], dv[8];
#pragma unroll
            for (int k = 0; k < 8; ++k) { const size_t item = (size_t)(b * 128 + n0 + k) * 4 + h; cv[k] = CKV[item * 8192 + e]; dv[k] = DEC[item * 64 + (e & 63)]; }
#pragma unroll
            for (int k = 0; k < 8; ++k) { const size_t item = (size_t)(b * 128 + n0 + k) * 4 + h; SP[item * 8192 + e] = (bf16_t)f2bf(S); S = dv[k] * S + cv[k]; } } }
}
__device__ __forceinline__ void ph_gla_c(const Params& p, const Ctx& c) {
    LAS unsigned char* L = c.lds; const bf16_t* proj = (const bf16_t*)(p.ws + WS_PROJ); const bf16_t* SP = (const bf16_t*)(p.ws + WS_SPREV); float* go = (float*)(p.ws + WS_GLAO);
    const int tid = c.tid, lane = c.lane, w = c.wave, r = lane & 15, qq = lane >> 4, kk = tid & 63;
    for (int item = c.blk; item < 2048; item += c.nblk) {
        const int h = item & 3, bn = item >> 2; const bf16_t* prow0 = proj + (size_t)bn * 64 * NIN_PAD;
        float bcum[8], blast; gla_cumdecay(p, c, GLR_SRC, h, bcum, blast);
        gla_stage_v(c, prow0, h);
#pragma unroll
        for (int k = 0; k < 8; ++k) { const int i = 8 * w + k; const bf16_t* pr = prow0 + (size_t)i * NIN_PAD;
            const float qv = bf2f(pr[C_GQ + h * 64 + kk]) * 0.125f * __expf(bcum[k]), kv = bf2f(pr[C_GK + h * 64 + kk]) * __expf(-bcum[k]);
            *(LAS bf16_t*)(L + GL_QD + i * 144 + kk * 2) = (bf16_t)f2bf(qv); *(LAS bf16_t*)(L + GL_KI + i * 144 + kk * 2) = (bf16_t)f2bf(kv); }
        __syncthreads();
        const int it = w & 3, vh = w >> 2;
        bf16x8 qf[2];
#pragma unroll
        for (int s2 = 0; s2 < 2; ++s2) qf[s2] = __builtin_bit_cast(bf16x8, *(const LAS u32x4*)(L + GL_QD + (16 * it + r) * 144 + (32 * s2 + 8 * qq) * 2));
        u32x2 pw[4];
#pragma unroll
        for (int jt = 0; jt < 4; ++jt) { f32x4 z = {0.f, 0.f, 0.f, 0.f};
            if (jt <= it) {
#pragma unroll
                for (int s2 = 0; s2 < 2; ++s2) { const bf16x8 kf = __builtin_bit_cast(bf16x8, *(const LAS u32x4*)(L + GL_KI + (16 * jt + r) * 144 + (32 * s2 + 8 * qq) * 2));
                    z = __builtin_amdgcn_mfma_f32_16x16x32_bf16(kf, qf[s2], z, 0, 0, 0); }
#pragma unroll
                for (int ii = 0; ii < 4; ++ii) z[ii] = (16 * jt + 4 * qq + ii <= 16 * it + r) ? z[ii] : 0.f; }
            pw[jt].x = pk2(z[0], z[1]); pw[jt].y = pk2(z[2], z[3]); }
        f32x4 acc[4];
#pragma unroll
        for (int n = 0; n < 4; ++n) acc[n] = (f32x4){0.f, 0.f, 0.f, 0.f};
#pragma unroll
        for (int s2 = 0; s2 < 2; ++s2) { if (2 * s2 <= it) {
            const u32x4 pq = {pw[2 * s2].x, pw[2 * s2].y, pw[2 * s2 + 1].x, pw[2 * s2 + 1].y};
            LAS const unsigned char* vp = L + GL_V + (32 * s2 + 4 * qq + (r >> 2)) * 272 + (64 * vh + 4 * (r & 3)) * 2;
#pragma unroll
            for (int n = 0; n < 4; ++n) { const s16x4 v0 = lds_tr16(vp + 32 * n), v1 = lds_tr16(vp + 32 * n + 16 * 272);
                const bf16x8 vf = {v0[0], v0[1], v0[2], v0[3], v1[0], v1[1], v1[2], v1[3]};
                acc[n] = __builtin_amdgcn_mfma_f32_16x16x32_bf16(__builtin_bit_cast(bf16x8, pq), vf, acc[n], 0, 0, 0); } } }
#pragma unroll
        for (int s2 = 0; s2 < 2; ++s2)
#pragma unroll
            for (int n = 0; n < 4; ++n) { const bf16x8 sf = __builtin_bit_cast(bf16x8, *(const u32x4*)(SP + (size_t)item * 8192 + (64 * vh + 16 * n + r) * 64 + 32 * s2 + 8 * qq));
                acc[n] = __builtin_amdgcn_mfma_f32_16x16x32_bf16(qf[s2], sf, acc[n], 0, 0, 0); }
        float* outp = go + ((size_t)bn * 64 + 16 * it + 4 * qq) * 512 + h * 128 + 64 * vh + r;
#pragma unroll
        for (int n = 0; n < 4; ++n)
#pragma unroll
            for (int ii = 0; ii < 4; ++ii) outp[ii * 512 + 16 * n] = acc[n][ii];
    }
}
#ifndef ATT_COMBINE
#define ATT_COMBINE 1
#endif
__device__ __forceinline__ void ph_mix(const Params& p, const Ctx& c) {
    const bf16_t* proj = (const bf16_t*)(p.ws + WS_PROJ); const float* go = (const float*)(p.ws + WS_GLAO); bf16_t* mixed = (bf16_t*)(p.ws + WS_ACT);
    for (int m = c.gwave; m < M; m += c.gwaves) {
#pragma unroll
        for (int h = 0; h < 4; ++h) { const int col = h * 128 + 2 * c.lane;
            const float o0 = go[(size_t)m * 512 + col], o1 = go[(size_t)m * 512 + col + 1];
            const float rstd = 1.f / sqrtf(wave_sum(o0 * o0 + o1 * o1) * (1.f / 128.f) + NORM_EPS);
            const unsigned gw = *(const unsigned*)(proj + (size_t)m * NIN_PAD + C_GG + col); const float g0 = bflo(gw), g1 = bfhi(gw);
            const float r0 = o0 * rstd * p.gla_head_gain[col] * (g0 * sigmoidf_(g0)), r1 = o1 * rstd * p.gla_head_gain[col + 1] * (g1 * sigmoidf_(g1));
            *(unsigned*)(mixed + (size_t)m * DM + col) = pk2(r0, r1); }
        if (ATT_COMBINE) {
            const bf16_t* AO = (const bf16_t*)p.out; const float* LSE = (const float*)((const unsigned char*)p.out + 96 * MiB); const int hh = c.lane >> 3;
            const float l0 = LSE[((size_t)0 * M + m) * 8 + hh], l1 = LSE[((size_t)1 * M + m) * 8 + hh], l2 = LSE[((size_t)2 * M + m) * 8 + hh];
            const float lm = fmaxf(l0, fmaxf(l1, l2)), e0 = __expf(l0 - lm), e1 = __expf(l1 - lm), e2 = __expf(l2 - lm), rd = __builtin_amdgcn_rcpf(e0 + e1 + e2);
            const float w0 = e0 * rd, w1 = e1 * rd, w2 = e2 * rd;
            const u32x4 a0 = *((const u32x4*)(AO + ((size_t)0 * M + m) * 512) + c.lane), a1 = *((const u32x4*)(AO + ((size_t)1 * M + m) * 512) + c.lane), a2 = *((const u32x4*)(AO + ((size_t)2 * M + m) * 512) + c.lane);
            u32x4 o;
            o.x = pk2(w0 * bflo(a0.x) + w1 * bflo(a1.x) + w2 * bflo(a2.x), w0 * bfhi(a0.x) + w1 * bfhi(a1.x) + w2 * bfhi(a2.x));
            o.y = pk2(w0 * bflo(a0.y) + w1 * bflo(a1.y) + w2 * bflo(a2.y), w0 * bfhi(a0.y) + w1 * bfhi(a1.y) + w2 * bfhi(a2.y));
            o.z = pk2(w0 * bflo(a0.z) + w1 * bflo(a1.z) + w2 * bflo(a2.z), w0 * bfhi(a0.z) + w1 * bfhi(a1.z) + w2 * bfhi(a2.z));
            o.w = pk2(w0 * bflo(a0.w) + w1 * bflo(a1.w) + w2 * bflo(a2.w), w0 * bfhi(a0.w) + w1 * bfhi(a1.w) + w2 * bfhi(a2.w));
            *((u32x4*)(mixed + (size_t)m * DM + 512) + c.lane) = o; }
    }
}


constexpr int GR_WGT = 0, GR_XC = 65536, GR_A = 81920, GR_U = 115712, GR_SEG = 132608, GR_CW = 136704, GR_GB = 139264;
__device__ __forceinline__ float fast_sigmoid(float x) { return __builtin_amdgcn_rcpf(1.f + __expf(-x)); }
template <bool FULL> __device__ __forceinline__ void griffin_pass(const Params& p, const Ctx& c) {
    LAS unsigned char* L = c.lds;
    const int tid = c.tid, lane = c.lane, wave = c.wave, g = c.blk & 7;
    const bf16_t* proj = (const bf16_t*)(p.ws + WS_PROJ); bf16_t* yout = (bf16_t*)(p.ws + WS_ACT);
    float* AGA = (float*)(p.ws + WS_AGG); float* AGH = AGA + BATCH * 128 * 1024; const float* CAR = AGH + BATCH * 128 * 1024;
    LAS float* A_ = (LAS float*)(L + GR_A); LAS bf16_t* U_ = (LAS bf16_t*)(L + GR_U); LAS float* SEG = (LAS float*)(L + GR_SEG); LAS float* CW = (LAS float*)(L + GR_CW); LAS float* GB = (LAS float*)(L + GR_GB);
    __syncthreads();
    { const bf16_t* wg = (const bf16_t*)(p.ws + WS_WG);
      for (int ch = tid; ch < 4096; ch += NTHREADS) { const int gate = ch >> 11, j = (ch >> 4) & 127, cc = ch & 15;
          const u32x4 v = *(const u32x4*)(wg + ((size_t)(gate * 8 + g) * 128 + j) * 128 + cc * 8);
          *(LAS u32x4*)(L + GR_WGT + gate * 32768 + j * 256 + ((cc ^ (j & 15)) << 4)) = v; }
      if (tid < 128) { const int ch = g * 128 + tid;
#pragma unroll
          for (int jj = 0; jj < 4; ++jj) CW[jj * 128 + tid] = p.c_conv_w[jj * 1024 + ch];
          CW[4 * 128 + tid] = p.c_conv_b[ch]; GB[tid] = p.c_b_rgate[ch]; GB[128 + tid] = p.c_b_igate[ch];
          const float lam = p.c_lambda[ch]; GB[256 + tid] = fmaxf(-lam, 0.f) + log1pf(expf(-fabsf(lam))); } }
    __syncthreads();
    const int nslot = BATCH * 128, sstep = c.nblk >> 3;
    u32x4 xr[5];
#define GR_XLOAD(sl_) do { const int b_ = (sl_) >> 7, t0_ = ((sl_) & 127) * 64; const size_t r0_ = (size_t)b_ * SEQ + t0_; const int co_ = tid & 15, tp_ = tid >> 4; \
        _Pragma("unroll") for (int jj = 0; jj < 5; ++jj) { const int tt = t0_ + 2 * tp_ - 3 + jj; xr[jj] = (u32x4){0u, 0u, 0u, 0u}; \
            if (tt >= 0) xr[jj] = *(const u32x4*)(proj + (r0_ + 2 * tp_ - 3 + jj) * 2048 + 1024 + g * 128 + co_ * 8); } } while (0)
    if ((c.blk >> 3) < nslot) GR_XLOAD(c.blk >> 3);
    for (int slot = c.blk >> 3; slot < nslot; slot += sstep) {
        const int b = slot >> 7, tile = slot & 127, t0 = tile * 64; const size_t row0 = (size_t)b * SEQ + t0;
        u32x4 gpre[2];
        if (FULL) { const int co = tid & 15, tp = tid >> 4;
#pragma unroll
            for (int tl = 0; tl < 2; ++tl) gpre[tl] = *(const u32x4*)(proj + (row0 + 2 * tp + tl) * 2048 + g * 128 + co * 8); }
        { const int co = tid & 15, tp = tid >> 4;
          f32x4 w[5][2];
#pragma unroll
          for (int jj = 0; jj < 5; ++jj) { w[jj][0] = *(const LAS f32x4*)(CW + jj * 128 + co * 8); w[jj][1] = *(const LAS f32x4*)(CW + jj * 128 + co * 8 + 4); }
#pragma unroll
          for (int tl = 0; tl < 2; ++tl) { float a8[8];
#pragma unroll
              for (int e = 0; e < 8; ++e) a8[e] = w[4][e >> 2][e & 3];
#pragma unroll
              for (int jj = 0; jj < 4; ++jj) { const u32x4 xv = xr[tl + jj]; const unsigned xw[4] = {xv.x, xv.y, xv.z, xv.w};
#pragma unroll
                  for (int e = 0; e < 8; ++e) { const float xe = (e & 1) ? bfhi(xw[e >> 1]) : bflo(xw[e >> 1]); a8[e] += w[jj][e >> 2][e & 3] * xe; } }
              const int t = 2 * tp + tl; u32x4 o; o.x = pk2(a8[0], a8[1]); o.y = pk2(a8[2], a8[3]); o.z = pk2(a8[4], a8[5]); o.w = pk2(a8[6], a8[7]);
              *(LAS u32x4*)(L + GR_XC + t * 256 + ((co ^ (t & 15)) << 4)) = o; } }
        if (slot + sstep < nslot) GR_XLOAD(slot + sstep);
        __syncthreads();
        { const int tt = wave & 3, jh = wave >> 2, r = lane & 15, q = lane >> 4, t = 16 * tt + r;
          f32x4 ar[4], ai[4];
#pragma unroll
          for (int n = 0; n < 4; ++n) { ar[n] = (f32x4){0.f, 0.f, 0.f, 0.f}; ai[n] = (f32x4){0.f, 0.f, 0.f, 0.f}; }
#pragma unroll
          for (int s = 0; s < 4; ++s) { const bf16x8 xb = __builtin_bit_cast(bf16x8, *(const LAS u32x4*)(L + GR_XC + t * 256 + (((4 * s + q) ^ (t & 15)) << 4)));
#pragma unroll
              for (int n = 0; n < 4; ++n) { const int j = 64 * jh + 16 * n + r;
                  const bf16x8 wr = __builtin_bit_cast(bf16x8, *(const LAS u32x4*)(L + GR_WGT + j * 256 + (((4 * s + q) ^ (j & 15)) << 4)));
                  const bf16x8 wi = __builtin_bit_cast(bf16x8, *(const LAS u32x4*)(L + GR_WGT + 32768 + j * 256 + (((4 * s + q) ^ (j & 15)) << 4)));
                  ar[n] = __builtin_amdgcn_mfma_f32_16x16x32_bf16(wr, xb, ar[n], 0, 0, 0); ai[n] = __builtin_amdgcn_mfma_f32_16x16x32_bf16(wi, xb, ai[n], 0, 0, 0); } }
#pragma unroll
          for (int n = 0; n < 4; ++n) { const int j0 = 64 * jh + 16 * n + 4 * q;
              const f32x4 br = *(const LAS f32x4*)(GB + j0), bi = *(const LAS f32x4*)(GB + 128 + j0), sp = *(const LAS f32x4*)(GB + 256 + j0);
              const u32x2 xw = *(const LAS u32x2*)(L + GR_XC + t * 256 + ((((j0 >> 3) ^ (t & 15)) << 4) + (j0 & 7) * 2));
              const float xc[4] = {bflo(xw.x), bfhi(xw.x), bflo(xw.y), bfhi(xw.y)};
              f32x4 av; float uv[4];
#pragma unroll
              for (int i = 0; i < 4; ++i) { const float rr = fast_sigmoid(ar[n][i] + br[i]), ii = fast_sigmoid(ai[n][i] + bi[i]);
                  const float a = __expf(-8.f * rr * sp[i]); av[i] = a; uv[i] = __builtin_amdgcn_sqrtf(fmaxf(1.f - a * a, 0.f)) * (ii * xc[i]); }
              *(LAS f32x4*)(A_ + t * 132 + j0) = av; u32x2 uo; uo.x = pk2(uv[0], uv[1]); uo.y = pk2(uv[2], uv[3]); *(LAS u32x2*)(U_ + t * 132 + j0) = uo; } }
        __syncthreads();
        const int j = tid & 127, seg = tid >> 7;
        { float aa = 1.f, hh = 0.f;
#pragma unroll
          for (int i = 0; i < 16; ++i) { const int t = seg * 16 + i; const float a = A_[t * 132 + j], u = bf2f(U_[t * 132 + j]); hh = a * hh + u; aa *= a; }
          SEG[seg * 128 + j] = aa; SEG[512 + seg * 128 + j] = hh; }
        __syncthreads();
        if (!FULL) {
            if (tid < 128) { float A = 1.f, H = 0.f;
#pragma unroll
                for (int sgi = 0; sgi < 4; ++sgi) { H = SEG[sgi * 128 + tid] * H + SEG[512 + sgi * 128 + tid]; A *= SEG[sgi * 128 + tid]; }
                const size_t e = ((size_t)b * 128 + tile) * 1024 + g * 128 + tid; AGA[e] = A; AGH[e] = H; }
        } else {
            float h = CAR[((size_t)b * 128 + tile) * 1024 + g * 128 + j];
            for (int sgi = 0; sgi < seg; ++sgi) h = SEG[sgi * 128 + j] * h + SEG[512 + sgi * 128 + j];
#pragma unroll
            for (int i = 0; i < 16; ++i) { const int t = seg * 16 + i; const float a = A_[t * 132 + j], u = bf2f(U_[t * 132 + j]); h = a * h + u; A_[t * 132 + j] = h; }
            __syncthreads();
            { const int co = tid & 15, tp = tid >> 4;
#pragma unroll
              for (int tl = 0; tl < 2; ++tl) { const int t = 2 * tp + tl;
                  const f32x4 h0 = *(const LAS f32x4*)(A_ + t * 132 + co * 8), h1 = *(const LAS f32x4*)(A_ + t * 132 + co * 8 + 4);
                  const u32x4 gw = gpre[tl];
                  u32x4 o; o.x = pk2(gelu_tanh(bflo(gw.x)) * h0.x, gelu_tanh(bfhi(gw.x)) * h0.y); o.y = pk2(gelu_tanh(bflo(gw.y)) * h0.z, gelu_tanh(bfhi(gw.y)) * h0.w);
                  o.z = pk2(gelu_tanh(bflo(gw.z)) * h1.x, gelu_tanh(bfhi(gw.z)) * h1.y); o.w = pk2(gelu_tanh(bflo(gw.w)) * h1.z, gelu_tanh(bfhi(gw.w)) * h1.w);
                  *(u32x4*)(yout + (row0 + t) * DM + g * 128 + co * 8) = o; } }
        }
    }
#undef GR_XLOAD
}
__device__ __forceinline__ void ph_carry(const Params& p, const Ctx& c) {
    const float* AGA = (const float*)(p.ws + WS_AGG); const float* AGH = AGA + BATCH * 128 * 1024; float* CAR = (float*)(AGH + BATCH * 128 * 1024);
    for (int idx = c.gtid; idx < BATCH * 1024; idx += c.gthreads) { const int b = idx >> 10, ch = idx & 1023; float cy = 0.f;
        for (int t0 = 0; t0 < 128; t0 += 8) { float a[8], h[8];
#pragma unroll
            for (int k = 0; k < 8; ++k) { const size_t e = ((size_t)b * 128 + t0 + k) * 1024 + ch; a[k] = AGA[e]; h[k] = AGH[e]; }
#pragma unroll
            for (int k = 0; k < 8; ++k) { CAR[((size_t)b * 128 + t0 + k) * 1024 + ch] = cy; cy = a[k] * cy + h[k]; } } }
}
__device__ __forceinline__ void cvt_gate_weights(const Params& p, const Ctx& c) {
    bf16_t* wg = (bf16_t*)(p.ws + WS_WG);
    for (int idx = c.gtid; idx < 2 * 8 * 16 * 128; idx += c.gthreads) { const int j = idx & 127, io = (idx >> 7) & 15, g = (idx >> 11) & 7, gate = idx >> 14;
        const float* s = (gate ? p.c_w_igate : p.c_w_rgate) + (size_t)g * 16384 + (io * 8) * 128 + j;
        u32x4 w; w.x = pk2(s[0], s[128]); w.y = pk2(s[256], s[384]); w.z = pk2(s[512], s[640]); w.w = pk2(s[768], s[896]);
        *(u32x4*)(wg + ((size_t)(gate * 8 + g) * 128 + j) * 128 + io * 8) = w; }
}


constexpr size_t WS_SK = 25 * MiB;
constexpr int TK_SK = 0, TK_Q = 69632, TK_S = 86528, TK_L = 119552  , TK_O = 135936, TK_TAB = 144128;
typedef int i32x4 __attribute__((ext_vector_type(4)));
__device__ __forceinline__ int key_xform(int b) { return b ^ ((b >> 31) & 0x7fffffff); }
#define CEX(a, b) do { const int hi_ = max((a), (b)), lo_ = min((a), (b)); (a) = hi_; (b) = lo_; } while (0)
__device__ __forceinline__ void bitonic_merge16_desc(int (&v)[16]) {
#pragma unroll
    for (int j = 8; j >= 1; j >>= 1)
#pragma unroll
        for (int i = 0; i < 16; ++i) if ((i & j) == 0) CEX(v[i], v[i | j]);
}
__device__ __forceinline__ void bitonic_sort16_desc(int (&v)[16]) {
#pragma unroll
    for (int k = 2; k <= 16; k <<= 1)
#pragma unroll
        for (int j = k >> 1; j >= 1; j >>= 1)
#pragma unroll
            for (int i = 0; i < 16; ++i) { const int l = i ^ j; if (l > i) { if ((i & k) == 0 || k == 16) CEX(v[i], v[l]); else CEX(v[l], v[i]); } }
}
__device__ __forceinline__ void ph_topk(const Params& p, int layer, const Ctx& c) {
    LAS unsigned char* L = c.lds; const bf16_t* Q = (const bf16_t*)(p.ws + WS_PROJ);
    int* ids = (int*)(p.ws + WS_IDS); float* gg = (float*)(p.ws + WS_G);
    const int tid = c.tid, lane = c.lane, w = c.wave, r = lane & 15, qq = lane >> 4, h = c.blk & 7;
    LAS float* S = (LAS float*)(L + TK_S); LAS int* LST = (LAS int*)(L + TK_L); LAS int* OUTK = (LAS int*)(L + TK_O); LAS int* TAB = (LAS int*)(L + TK_TAB);
    __syncthreads();
    { const bf16_t* sk = (const bf16_t*)(p.ws + WS_SK) + ((size_t)layer * 8 + h) * 2 * 128 * 128;
      for (int ch = tid; ch < 4096; ch += NTHREADS) { const int row = ch >> 4, cc = ch & 15;
          *(LAS u32x4*)(L + TK_SK + row * 272 + cc * 16) = *(const u32x4*)(sk + (size_t)row * 128 + cc * 8); }
      if (tid < 64) { int cnt = 0, code = -1;
          for (int i = 0; i < 16; ++i) for (int j = 0; j < 16 / (i + 1); ++j) { if (cnt == tid) code = i * 16 + j; ++cnt; }
          TAB[tid] = code; } }
    const int nslot = M / 32, sstep = c.nblk >> 3;
    u32x4 qpre[2];
#define TK_QLOAD(sl_) do { _Pragma("unroll") for (int k = 0; k < 2; ++k) { const int idx = tid + NTHREADS * k, row = idx >> 5, ch = idx & 31; \
        qpre[k] = *(const u32x4*)(Q + (size_t)(min((sl_), nslot - 1) * 32 + row) * 2048 + h * 256 + ch * 8); } } while (0)
#define TK_MERGE(CTRL) do { int o_[16]; _Pragma("unroll") for (int i = 0; i < 16; ++i) o_[i] = __builtin_amdgcn_update_dpp(0, v[15 - i], (CTRL), 0xf, 0xf, false); \
        _Pragma("unroll") for (int i = 0; i < 16; ++i) v[i] = max(v[i], o_[i]); bitonic_merge16_desc(v); } while (0)
    TK_QLOAD(c.blk >> 3);
    int gfirst = 0, gi = 0;
    for (int slot = c.blk >> 3; slot < nslot; slot += sstep) {
        __syncthreads();
#pragma unroll
        for (int k = 0; k < 2; ++k) { const int idx = tid + NTHREADS * k, row = idx >> 5, ch = idx & 31; *(LAS u32x4*)(L + TK_Q + row * 528 + ch * 16) = qpre[k]; }
        TK_QLOAD(slot + sstep);
        __syncthreads();
        { const int pp = w >> 2, mt = (w >> 1) & 1, nh = w & 1;
          f32x4 acc[4];
#pragma unroll
          for (int nt = 0; nt < 4; ++nt) acc[nt] = (f32x4){0.f, 0.f, 0.f, 0.f};
#pragma unroll
          for (int s2 = 0; s2 < 4; ++s2) { const bf16x8 af = __builtin_bit_cast(bf16x8, *(const LAS u32x4*)(L + TK_Q + (16 * mt + r) * 528 + (pp * 128 + 32 * s2 + 8 * qq) * 2));
#pragma unroll
              for (int nt = 0; nt < 4; ++nt) { const bf16x8 bfr = __builtin_bit_cast(bf16x8, *(const LAS u32x4*)(L + TK_SK + (pp * 128 + 16 * (4 * nh + nt) + r) * 272 + (32 * s2 + 8 * qq) * 2));
                  acc[nt] = __builtin_amdgcn_mfma_f32_16x16x32_bf16(af, bfr, acc[nt], 0, 0, 0); } }
#pragma unroll
          for (int nt = 0; nt < 4; ++nt)
#pragma unroll
              for (int i = 0; i < 4; ++i) S[(pp * 32 + 16 * mt + 4 * qq + i) * 129 + 16 * (4 * nh + nt) + r] = acc[nt][i]; }
        __syncthreads();
        {
          const int m = tid >> 4, sub = tid & 15, pp = sub >> 3, part = sub & 7; int v[16];
#pragma unroll
          for (int k = 0; k < 16; ++k) { const int n = 8 * k + part; v[k] = key_xform((__builtin_bit_cast(int, S[(pp * 32 + m) * 129 + n]) & ~127) | n); }
          bitonic_sort16_desc(v);
          TK_MERGE(0xB1);
          TK_MERGE(0x4E);
          TK_MERGE(0x141);
          if (part == 0) {
#pragma unroll
              for (int k = 0; k < 16; ++k) LST[((gi * 32 + m) * 2 + pp) * 16 + k] = key_xform(v[k]); } }
        if (gi == 0) gfirst = slot;
        ++gi;
        if (gi < 4 && slot + sstep < nslot) continue;
        __syncthreads();
        {
          const int tq = tid >> 2, sub = tid & 3, grp = tq >> 5, m = tq & 31;
          if (grp < gi) {
              const int slot_g = gfirst + grp * sstep;
              LAS const int* L1 = LST + (tq * 2 + 0) * 16; LAS const int* L2 = LST + (tq * 2 + 1) * 16;
              int v[16];
#pragma unroll
              for (int k = 0; k < 16; ++k) { const int ci = sub * 16 + k; const int code = TAB[ci]; int key = (int)0x80000000;
                  if (code >= 0) { const float s1 = __builtin_bit_cast(float, L1[code >> 4] & ~127), s2v = __builtin_bit_cast(float, L2[code & 15] & ~127);
                      key = key_xform((__builtin_bit_cast(int, s1 + s2v) & ~63) | (63 - ci)); }
                  v[k] = key; }
              bitonic_sort16_desc(v);
              TK_MERGE(0xB1); TK_MERGE(0x4E);
              const float smax = __builtin_bit_cast(float, key_xform(v[0]) & ~63);
              if (sub == 0) {
#pragma unroll
                  for (int k4 = 0; k4 < 4; ++k4) *(LAS i32x4*)(OUTK + tq * 16 + 4 * k4) = (i32x4){v[4 * k4], v[4 * k4 + 1], v[4 * k4 + 2], v[4 * k4 + 3]}; }
              asm volatile("s_waitcnt lgkmcnt(0)" ::: "memory");
              const i32x4 mine = *(const LAS i32x4*)(OUTK + tq * 16 + 4 * sub);
              float e[4]; int kb[4];
#pragma unroll
              for (int j = 0; j < 4; ++j) { kb[j] = key_xform(mine[j]); e[j] = __expf(__builtin_bit_cast(float, kb[j] & ~63) - smax); }
              float den = (e[0] + e[1]) + (e[2] + e[3]);
              den += __builtin_bit_cast(float, __builtin_amdgcn_update_dpp(0, __builtin_bit_cast(int, den), 0xB1, 0xf, 0xf, false));
              den += __builtin_bit_cast(float, __builtin_amdgcn_update_dpp(0, __builtin_bit_cast(int, den), 0x4E, 0xf, 0xf, false));
              const float rden = __builtin_amdgcn_rcpf(den); i32x4 oi; f32x4 og;
#pragma unroll
              for (int j = 0; j < 4; ++j) { const int code = TAB[63 - (kb[j] & 63)]; oi[j] = (L1[code >> 4] & 127) * 128 + (L2[code & 15] & 127); og[j] = e[j] * rden; }
              const size_t o = (size_t)(slot_g * 32 + m) * 128 + h * 16 + 4 * sub;
              *(i32x4*)(ids + o) = oi; *(f32x4*)(gg + o) = og; } }
        gi = 0;
    }
#undef TK_QLOAD
#undef TK_MERGE
}

__device__ __forceinline__ void ph_topk1(const Params& p, int layer, const Ctx& c) {
    const bf16_t* Q = (const bf16_t*)(p.ws + WS_PROJ); float* tops = (float*)(p.ws + WS_TOPS); int* topi = (int*)(p.ws + WS_TOPI);
    const float* keys = p.peer_sub_keys + (size_t)layer * 16 * 128 * 128;
    for (int gid = c.gtid; gid < M * 32; gid += c.gthreads) {
        const int idx = gid >> 1, half = gid & 1;
        const int t = idx & (M - 1), hp = __builtin_amdgcn_readfirstlane(idx >> 15);
        float q[64];
        { const u32x4* qp = (const u32x4*)(Q + (size_t)t * 2048 + hp * 128 + half * 64);
#pragma unroll
          for (int i = 0; i < 8; ++i) { const u32x4 w = qp[i]; q[8*i] = bflo(w.x); q[8*i+1] = bfhi(w.x); q[8*i+2] = bflo(w.y); q[8*i+3] = bfhi(w.y); q[8*i+4] = bflo(w.z); q[8*i+5] = bfhi(w.z); q[8*i+6] = bflo(w.w); q[8*i+7] = bfhi(w.w); } }
        float ls[16]; int li[16];
#pragma unroll
        for (int j = 0; j < 16; ++j) { ls[j] = -3.0e38f; li[j] = 0; }
        for (int n = 0; n < 128; ++n) { const float* kr = keys + ((size_t)hp * 128 + n) * 128 + half * 64;
            float s = 0.f;
#pragma unroll
            for (int cc = 0; cc < 64; ++cc) s += q[cc] * kr[cc];
            s += __shfl_xor(s, 1);
            int ni = n;
#pragma unroll
            for (int j = 0; j < 16; ++j) { const bool gt = s > ls[j]; const float ts = gt ? ls[j] : s; const int ti = gt ? li[j] : ni; ls[j] = gt ? s : ls[j]; li[j] = gt ? ni : li[j]; s = ts; ni = ti; }
        }
        if (half == 0) { float* os = tops + ((size_t)t * 16 + hp) * 16; int* oi = topi + ((size_t)t * 16 + hp) * 16;
#pragma unroll
            for (int j = 0; j < 16; ++j) { os[j] = ls[j]; oi[j] = li[j]; } }
    }
}
__device__ __forceinline__ void ph_topk2(const Params& p, const Ctx& c) {
    const float* tops = (const float*)(p.ws + WS_TOPS); const int* topi = (const int*)(p.ws + WS_TOPI);
    int* ids = (int*)(p.ws + WS_IDS); float* gg = (float*)(p.ws + WS_G);
    for (int idx = c.gtid; idx < M * 8; idx += c.gthreads) {
        const int t = idx >> 3, h = idx & 7;
        float s1[16], s2[16]; int i1[16], i2[16];
        { const float* a = tops + ((size_t)t * 16 + h * 2) * 16; const int* ai = topi + ((size_t)t * 16 + h * 2) * 16;
#pragma unroll
          for (int j = 0; j < 16; ++j) { s1[j] = a[j]; s2[j] = a[16 + j]; i1[j] = ai[j]; i2[j] = ai[16 + j]; } }
        float ls[16]; int lc[16];
#pragma unroll
        for (int j = 0; j < 16; ++j) { ls[j] = -3.0e38f; lc[j] = 0; }
#pragma unroll
        for (int i = 0; i < 16; ++i)
#pragma unroll
            for (int j = 0; j < 16 / (i + 1); ++j) { float s = s1[i] + s2[j]; int cd = i * 16 + j;
#pragma unroll
                for (int k = 0; k < 16; ++k) { const bool gt = s > ls[k]; const float ts = gt ? ls[k] : s; const int tc = gt ? lc[k] : cd; ls[k] = gt ? s : ls[k]; lc[k] = gt ? cd : lc[k]; s = ts; cd = tc; } }
        float den = 0.f, e[16];
#pragma unroll
        for (int k = 0; k < 16; ++k) { e[k] = __expf(ls[k] - ls[0]); den += e[k]; }
        const float rd = 1.f / den;
#pragma unroll
        for (int k = 0; k < 16; ++k) { const int ci = lc[k] >> 4, cj = lc[k] & 15; int a = 0, bq = 0;
#pragma unroll
            for (int z = 0; z < 16; ++z) { a = (ci == z) ? i1[z] : a; bq = (cj == z) ? i2[z] : bq; }
            ids[(size_t)t * 128 + h * 16 + k] = a * 128 + bq; gg[(size_t)t * 128 + h * 16 + k] = e[k] * rd; }
    }
}
__device__ __forceinline__ void ph_gather(const Params& p, const Ctx& c) {
    const bf16_t* XN = (const bf16_t*)(p.ws + WS_ACT); const bf16_t* UT = (const bf16_t*)(p.ws + WS_TAB); const bf16_t* VT = UT + (size_t)NEXP * DM;
    const int* ids = (const int*)(p.ws + WS_IDS); const float* gg = (const float*)(p.ws + WS_G);
    for (int m = c.gwave; m < M; m += c.gwaves) {
        float x[16], o[16];
        { const u32x4 a = *((const u32x4*)(XN + (size_t)m * DM) + c.lane), b = *((const u32x4*)(XN + (size_t)m * DM + 512) + c.lane);
          x[0] = bflo(a.x); x[1] = bfhi(a.x); x[2] = bflo(a.y); x[3] = bfhi(a.y); x[4] = bflo(a.z); x[5] = bfhi(a.z); x[6] = bflo(a.w); x[7] = bfhi(a.w);
          x[8] = bflo(b.x); x[9] = bfhi(b.x); x[10] = bflo(b.y); x[11] = bfhi(b.y); x[12] = bflo(b.z); x[13] = bfhi(b.z); x[14] = bflo(b.w); x[15] = bfhi(b.w); }
#pragma unroll
        for (int i = 0; i < 16; ++i) o[i] = 0.f;
        const int id0 = ids[(size_t)m * 128 + c.lane], id1 = ids[(size_t)m * 128 + 64 + c.lane];
        const float g0 = gg[(size_t)m * 128 + c.lane], g1 = gg[(size_t)m * 128 + 64 + c.lane];
        for (int k0 = 0; k0 < 128; k0 += 4) {
            u32x4 ua[4], ub[4], va[4], vb[4]; float gk[4];
#pragma unroll
            for (int j = 0; j < 4; ++j) { const int k = k0 + j; const int id = (k < 64) ? __shfl(id0, k) : __shfl(id1, k - 64); gk[j] = (k < 64) ? __shfl(g0, k) : __shfl(g1, k - 64);
                const u32x4* ur = (const u32x4*)(UT + (size_t)id * DM); const u32x4* vr = (const u32x4*)(VT + (size_t)id * DM);
                ua[j] = ur[c.lane]; ub[j] = ur[64 + c.lane]; va[j] = vr[c.lane]; vb[j] = vr[64 + c.lane]; }
#pragma unroll
            for (int j = 0; j < 4; ++j) {
                float d = x[0] * bflo(ua[j].x) + x[1] * bfhi(ua[j].x) + x[2] * bflo(ua[j].y) + x[3] * bfhi(ua[j].y) + x[4] * bflo(ua[j].z) + x[5] * bfhi(ua[j].z) + x[6] * bflo(ua[j].w) + x[7] * bfhi(ua[j].w)
                        + x[8] * bflo(ub[j].x) + x[9] * bfhi(ub[j].x) + x[10] * bflo(ub[j].y) + x[11] * bfhi(ub[j].y) + x[12] * bflo(ub[j].z) + x[13] * bfhi(ub[j].z) + x[14] * bflo(ub[j].w) + x[15] * bfhi(ub[j].w);
                d = wave_sum(d);
                const float act = gelu_tanh(d) * gk[j];
                o[0] += act * bflo(va[j].x); o[1] += act * bfhi(va[j].x); o[2] += act * bflo(va[j].y); o[3] += act * bfhi(va[j].y); o[4] += act * bflo(va[j].z); o[5] += act * bfhi(va[j].z); o[6] += act * bflo(va[j].w); o[7] += act * bfhi(va[j].w);
                o[8] += act * bflo(vb[j].x); o[9] += act * bfhi(vb[j].x); o[10] += act * bflo(vb[j].y); o[11] += act * bfhi(vb[j].y); o[12] += act * bflo(vb[j].z); o[13] += act * bfhi(vb[j].z); o[14] += act * bflo(vb[j].w); o[15] += act * bfhi(vb[j].w);
            }
        }
        f32x4* hp = (f32x4*)(p.out + (size_t)m * DM);
        f32x4 h0 = hp[2 * c.lane], h1 = hp[2 * c.lane + 1], h2 = hp[128 + 2 * c.lane], h3 = hp[128 + 2 * c.lane + 1];
        h0 += (f32x4){o[0], o[1], o[2], o[3]}; h1 += (f32x4){o[4], o[5], o[6], o[7]}; h2 += (f32x4){o[8], o[9], o[10], o[11]}; h3 += (f32x4){o[12], o[13], o[14], o[15]};
        hp[2 * c.lane] = h0; hp[2 * c.lane + 1] = h1; hp[128 + 2 * c.lane] = h2; hp[128 + 2 * c.lane + 1] = h3;
    }
}

__device__ __forceinline__ void ph_gather2(const Params& p, const Ctx& c) {
    const bf16_t* XN = (const bf16_t*)(p.ws + WS_ACT); const bf16_t* UT = (const bf16_t*)(p.ws + WS_TAB); const bf16_t* VT = UT + (size_t)NEXP * DM;
    const int* ids = (const int*)(p.ws + WS_IDS); const float* gg = (const float*)(p.ws + WS_G);
    LAS unsigned char* wl = c.lds + c.wave * 4096;
    LAS bf16_t* xs = (LAS bf16_t*)wl; LAS float* dsm = (LAS float*)(wl + 2048);
    const int lane = c.lane, r = lane & 15, q = lane >> 4;
    for (int m = c.gwave; m < M; m += c.gwaves) {
        { const u32x4 xa = *((const u32x4*)(XN + (size_t)m * DM) + lane), xb = *((const u32x4*)(XN + (size_t)m * DM + 512) + lane);
          *((LAS u32x4*)xs + lane) = xa; *((LAS u32x4*)(xs + 512) + lane) = xb; }
        const int id0 = ids[(size_t)m * 128 + lane], id1 = ids[(size_t)m * 128 + 64 + lane];
        const float g0 = gg[(size_t)m * 128 + lane], g1 = gg[(size_t)m * 128 + 64 + lane];
        const char* rowp[8];
#pragma unroll
        for (int g = 0; g < 8; ++g) { const int idg = __shfl(g < 4 ? id0 : id1, 16 * (g & 3) + r); rowp[g] = (const char*)(UT + (size_t)idg * DM) + q * 16; }
        f32x4 acc[8];
#pragma unroll
        for (int g = 0; g < 8; ++g) acc[g] = (f32x4){0.f, 0.f, 0.f, 0.f};
#pragma unroll 1
        for (int kc = 0; kc < 4; ++kc) {
            bf16x8 xb8[8];
#pragma unroll
            for (int s = 0; s < 8; ++s) xb8[s] = *(const LAS bf16x8*)(xs + (kc * 8 + s) * 32 + 8 * q);
#pragma unroll
            for (int g = 0; g < 8; ++g) { bf16x8 a[8];
#pragma unroll
                for (int s = 0; s < 8; ++s) a[s] = *(const bf16x8*)(rowp[g] + (kc * 8 + s) * 64);
#pragma unroll
                for (int s = 0; s < 8; ++s) acc[g] = __builtin_amdgcn_mfma_f32_16x16x32_bf16(a[s], xb8[s], acc[g], 0, 0, 0); }
        }
#pragma unroll
        for (int g = 0; g < 8; ++g) if (r == 0) *(LAS f32x4*)(dsm + 16 * g + 4 * q) = acc[g];
        const float d0 = dsm[lane], d1 = dsm[64 + lane];
        const int act0 = __builtin_bit_cast(int, gelu_tanh(d0) * g0), act1 = __builtin_bit_cast(int, gelu_tanh(d1) * g1);
        float o[16];
#pragma unroll
        for (int i = 0; i < 16; ++i) o[i] = 0.f;
#pragma unroll
        for (int hh = 0; hh < 2; ++hh) { const int idv = hh ? id1 : id0; const int actv = hh ? act1 : act0;
#pragma unroll 1
            for (int e0 = 0; e0 < 64; e0 += 8) {
                u32x4 va[8], vb[8]; float ae[8];
#pragma unroll
                for (int j = 0; j < 8; ++j) { const int id = __builtin_amdgcn_readlane(idv, e0 + j); ae[j] = __builtin_bit_cast(float, __builtin_amdgcn_readlane(actv, e0 + j));
                    const u32x4* vr = (const u32x4*)(VT + (size_t)id * DM); va[j] = vr[lane]; vb[j] = vr[64 + lane]; }
#pragma unroll
                for (int j = 0; j < 8; ++j) { const float act = ae[j];
                    o[0] += act * bflo(va[j].x); o[1] += act * bfhi(va[j].x); o[2] += act * bflo(va[j].y); o[3] += act * bfhi(va[j].y); o[4] += act * bflo(va[j].z); o[5] += act * bfhi(va[j].z); o[6] += act * bflo(va[j].w); o[7] += act * bfhi(va[j].w);
                    o[8] += act * bflo(vb[j].x); o[9] += act * bfhi(vb[j].x); o[10] += act * bflo(vb[j].y); o[11] += act * bfhi(vb[j].y); o[12] += act * bflo(vb[j].z); o[13] += act * bfhi(vb[j].z); o[14] += act * bflo(vb[j].w); o[15] += act * bfhi(vb[j].w); }
            } }
        f32x4* hp = (f32x4*)(p.out + (size_t)m * DM);
        f32x4 h0 = hp[2 * lane], h1 = hp[2 * lane + 1], h2 = hp[128 + 2 * lane], h3 = hp[128 + 2 * lane + 1];
        h0 += (f32x4){o[0], o[1], o[2], o[3]}; h1 += (f32x4){o[4], o[5], o[6], o[7]}; h2 += (f32x4){o[8], o[9], o[10], o[11]}; h3 += (f32x4){o[12], o[13], o[14], o[15]};
        hp[2 * lane] = h0; hp[2 * lane + 1] = h1; hp[128 + 2 * lane] = h2; hp[128 + 2 * lane + 1] = h3;
    }
}

__device__ __forceinline__ float wave_max(float v) {
#pragma unroll
    for (int o = 1; o < 64; o <<= 1) v = fmaxf(v, __shfl_xor(v, o));
    return v;
}
__device__ __forceinline__ void cvt_fp8_rows(const float* src, unsigned char* dst, float* scl, int nrows, const Ctx& c) {
    for (int row = c.gwave; row < nrows; row += c.gwaves) {
        const f32x4* sp = (const f32x4*)(src + (size_t)row * DM) + 4 * c.lane; f32x4 v[4]; float mx = 0.f;
#pragma unroll
        for (int j = 0; j < 4; ++j) { v[j] = sp[j]; mx = fmaxf(mx, fmaxf(fmaxf(fabsf(v[j].x), fabsf(v[j].y)), fmaxf(fabsf(v[j].z), fabsf(v[j].w)))); }
        mx = wave_max(mx);
        const float sc = mx > 0.f ? mx * (1.f / 416.f) : 1.f, inv = 1.f / sc;
        u32x4 w; int t;
        t = __builtin_amdgcn_cvt_pk_fp8_f32(v[0].x * inv, v[0].y * inv, 0, false); t = __builtin_amdgcn_cvt_pk_fp8_f32(v[0].z * inv, v[0].w * inv, t, true); w.x = (unsigned)t;
        t = __builtin_amdgcn_cvt_pk_fp8_f32(v[1].x * inv, v[1].y * inv, 0, false); t = __builtin_amdgcn_cvt_pk_fp8_f32(v[1].z * inv, v[1].w * inv, t, true); w.y = (unsigned)t;
        t = __builtin_amdgcn_cvt_pk_fp8_f32(v[2].x * inv, v[2].y * inv, 0, false); t = __builtin_amdgcn_cvt_pk_fp8_f32(v[2].z * inv, v[2].w * inv, t, true); w.z = (unsigned)t;
        t = __builtin_amdgcn_cvt_pk_fp8_f32(v[3].x * inv, v[3].y * inv, 0, false); t = __builtin_amdgcn_cvt_pk_fp8_f32(v[3].z * inv, v[3].w * inv, t, true); w.w = (unsigned)t;
        *(u32x4*)(dst + (size_t)(c.lane >> 3) * NEXP * 128 + (size_t)row * 128 + (c.lane & 7) * 16) = w;
        if (c.lane == 0) scl[row] = sc;
    }
}
typedef float f32x2 __attribute__((ext_vector_type(2)));
__device__ __forceinline__ void cvt_fp8_roundtrip_rows(const float* src, bf16_t* dst, int nrows, const Ctx& c) {
    for (int row = c.gwave; row < nrows; row += c.gwaves) {
        const f32x4* sp = (const f32x4*)(src + (size_t)row * DM) + 4 * c.lane; f32x4 v[4]; float mx = 0.f;
#pragma unroll
        for (int j = 0; j < 4; ++j) { v[j] = sp[j]; mx = fmaxf(mx, fmaxf(fmaxf(fabsf(v[j].x), fabsf(v[j].y)), fmaxf(fabsf(v[j].z), fabsf(v[j].w)))); }
        mx = wave_max(mx);
        const float sc = mx > 0.f ? mx * (1.f / 416.f) : 1.f, inv = 1.f / sc;
        u32x4 o0, o1;
#pragma unroll
        for (int j = 0; j < 4; ++j) { int t = __builtin_amdgcn_cvt_pk_fp8_f32(v[j].x * inv, v[j].y * inv, 0, false); t = __builtin_amdgcn_cvt_pk_fp8_f32(v[j].z * inv, v[j].w * inv, t, true);
            const f32x2 a = __builtin_amdgcn_cvt_pk_f32_fp8(t, false), b = __builtin_amdgcn_cvt_pk_f32_fp8(t, true);
            const unsigned lo = pk2(a.x * sc, a.y * sc), hi = pk2(b.x * sc, b.y * sc);
            if (j == 0) { o0.x = lo; o0.y = hi; } else if (j == 1) { o0.z = lo; o0.w = hi; } else if (j == 2) { o1.x = lo; o1.y = hi; } else { o1.z = lo; o1.w = hi; } }
        u32x4* dp = (u32x4*)(dst + (size_t)row * DM) + 2 * c.lane; dp[0] = o0; dp[1] = o1;
    }
}
__device__ __forceinline__ u32x2 fp8x4_to_bf16x4(unsigned w) {
    const f32x2 a = __builtin_amdgcn_cvt_pk_f32_fp8((int)w, false), b = __builtin_amdgcn_cvt_pk_f32_fp8((int)w, true);
    u32x2 o;
    asm("v_cvt_pk_bf16_f32 %0, %1, %2" : "=v"(o.x) : "v"(a.x), "v"(a.y));
    asm("v_cvt_pk_bf16_f32 %0, %1, %2" : "=v"(o.y) : "v"(b.x), "v"(b.y));
    return o;
}
__device__ __forceinline__ void ph_gather3(const Params& p, int layer, const Ctx& c, float* hdst) {
    const bf16_t* XN = (const bf16_t*)(p.ws + WS_ACT);
    const unsigned char* UT = p.ws + WS_TAB8 + (size_t)layer * 2 * NEXP * DM; const unsigned char* VT = UT + (size_t)NEXP * DM;
    const float* SU = (const float*)(p.ws + WS_SCL) + (size_t)layer * 2 * NEXP; const float* SV = SU + NEXP;
    const int* ids = (const int*)(p.ws + WS_IDS); const float* gg = (const float*)(p.ws + WS_G);
    LAS unsigned char* wl = c.lds + c.wave * 4096;
    LAS bf16_t* xs = (LAS bf16_t*)wl; LAS float* dsm = (LAS float*)(wl + 2048);
    const int lane = c.lane, r = lane & 15, q = lane >> 4;
    for (int m = c.gwave; m < M; m += c.gwaves) {
        { const u32x4 xa = *((const u32x4*)(XN + (size_t)m * DM) + lane), xb = *((const u32x4*)(XN + (size_t)m * DM + 512) + lane);
          asm volatile("" ::: "memory"); *((LAS u32x4*)xs + lane) = xa; *((LAS u32x4*)(xs + 512) + lane) = xb; asm volatile("" ::: "memory"); }
        const int id0 = ids[(size_t)m * 128 + lane], id1 = ids[(size_t)m * 128 + 64 + lane];
#ifdef PROBE_VF32
        const float g0 = gg[(size_t)m * 128 + lane], g1 = gg[(size_t)m * 128 + 64 + lane];
#else
        const float g0 = gg[(size_t)m * 128 + lane] * SV[id0], g1 = gg[(size_t)m * 128 + 64 + lane] * SV[id1];
#endif
        const float su0 = SU[id0], su1 = SU[id1];
#pragma unroll 1
        for (int gp = 0; gp < 4; ++gp) {
            const int idsel = gp < 2 ? id0 : id1;
            const int ida = __shfl(idsel, (gp & 1) * 32 + r), idb = __shfl(idsel, (gp & 1) * 32 + 16 + r);
            const unsigned char* rowa = UT + (size_t)ida * DM + q * 16; const unsigned char* rowb = UT + (size_t)idb * DM + q * 16;
            f32x4 acca = {0.f, 0.f, 0.f, 0.f}, accb = {0.f, 0.f, 0.f, 0.f};
#pragma unroll 1
            for (int kc = 0; kc < 4; ++kc) {
                u32x4 a[4], bb[4];
#pragma unroll
                for (int s = 0; s < 4; ++s) { a[s] = *(const u32x4*)(rowa + (kc * 4 + s) * 64); bb[s] = *(const u32x4*)(rowb + (kc * 4 + s) * 64); }
                bf16x8 xb8[8];
#pragma unroll
                for (int s = 0; s < 4; ++s) { xb8[2 * s] = __builtin_bit_cast(bf16x8, *(const LAS u32x4*)(xs + (kc * 4 + s) * 64 + 16 * q)); xb8[2 * s + 1] = __builtin_bit_cast(bf16x8, *(const LAS u32x4*)(xs + (kc * 4 + s) * 64 + 16 * q + 8)); }
#pragma unroll
                for (int s = 0; s < 4; ++s) {
                    { const u32x2 c0 = fp8x4_to_bf16x4(a[s].x), c1 = fp8x4_to_bf16x4(a[s].y), c2 = fp8x4_to_bf16x4(a[s].z), c3 = fp8x4_to_bf16x4(a[s].w); const u32x4 b0 = {c0.x, c0.y, c1.x, c1.y}, b1 = {c2.x, c2.y, c3.x, c3.y};
                      acca = __builtin_amdgcn_mfma_f32_16x16x32_bf16(__builtin_bit_cast(bf16x8, b0), xb8[2 * s], acca, 0, 0, 0);
                      acca = __builtin_amdgcn_mfma_f32_16x16x32_bf16(__builtin_bit_cast(bf16x8, b1), xb8[2 * s + 1], acca, 0, 0, 0); }
                    { const u32x2 c0 = fp8x4_to_bf16x4(bb[s].x), c1 = fp8x4_to_bf16x4(bb[s].y), c2 = fp8x4_to_bf16x4(bb[s].z), c3 = fp8x4_to_bf16x4(bb[s].w); const u32x4 b0 = {c0.x, c0.y, c1.x, c1.y}, b1 = {c2.x, c2.y, c3.x, c3.y};
                      accb = __builtin_amdgcn_mfma_f32_16x16x32_bf16(__builtin_bit_cast(bf16x8, b0), xb8[2 * s], accb, 0, 0, 0);
                      accb = __builtin_amdgcn_mfma_f32_16x16x32_bf16(__builtin_bit_cast(bf16x8, b1), xb8[2 * s + 1], accb, 0, 0, 0); }
                    __builtin_amdgcn_sched_barrier(0); }
            }
            if (r == 0) { *(LAS f32x4*)(dsm + 32 * gp + 4 * q) = acca; *(LAS f32x4*)(dsm + 32 * gp + 16 + 4 * q) = accb; }
        }
        asm volatile("" ::: "memory");
        const float d0 = dsm[lane] * su0, d1 = dsm[64 + lane] * su1;
        asm volatile("" ::: "memory");
        const int act0 = __builtin_bit_cast(int, gelu_tanh(d0) * g0), act1 = __builtin_bit_cast(int, gelu_tanh(d1) * g1);
        float o[16];
#pragma unroll
        for (int i = 0; i < 16; ++i) o[i] = 0.f;
#pragma unroll
        for (int hh = 0; hh < 2; ++hh) { const int idv = hh ? id1 : id0; const int actv = hh ? act1 : act0;
#ifdef PROBE_VF32
#pragma unroll 1
            for (int e0 = 0; e0 < 64; ++e0) { const int id = __builtin_amdgcn_readlane(idv, e0); const float act = __builtin_bit_cast(float, __builtin_amdgcn_readlane(actv, e0));
                const f32x4* vr = (const f32x4*)(p.peer_v + ((size_t)layer * NEXP + id) * DM) + 4 * lane; const f32x4 v0 = vr[0], v1 = vr[1], v2 = vr[2], v3 = vr[3];
                o[0] += act * v0.x; o[1] += act * v0.y; o[2] += act * v0.z; o[3] += act * v0.w; o[4] += act * v1.x; o[5] += act * v1.y; o[6] += act * v1.z; o[7] += act * v1.w;
                o[8] += act * v2.x; o[9] += act * v2.y; o[10] += act * v2.z; o[11] += act * v2.w; o[12] += act * v3.x; o[13] += act * v3.y; o[14] += act * v3.z; o[15] += act * v3.w; } }
#else
#pragma unroll 1
            for (int e0 = 0; e0 < 64; e0 += 16) {
                u32x4 va[16]; float ae[16];
#pragma unroll
                for (int j = 0; j < 16; ++j) { const int id = __builtin_amdgcn_readlane(idv, e0 + j); ae[j] = __builtin_bit_cast(float, __builtin_amdgcn_readlane(actv, e0 + j));
                    va[j] = *((const u32x4*)(VT + (size_t)id * DM) + lane); }
#pragma unroll
                for (int j = 0; j < 16; ++j) { const float act = ae[j];
                    f32x2 t;
                    t = __builtin_amdgcn_cvt_pk_f32_fp8((int)va[j].x, false); o[0] += act * t.x; o[1] += act * t.y; t = __builtin_amdgcn_cvt_pk_f32_fp8((int)va[j].x, true); o[2] += act * t.x; o[3] += act * t.y;
                    t = __builtin_amdgcn_cvt_pk_f32_fp8((int)va[j].y, false); o[4] += act * t.x; o[5] += act * t.y; t = __builtin_amdgcn_cvt_pk_f32_fp8((int)va[j].y, true); o[6] += act * t.x; o[7] += act * t.y;
                    t = __builtin_amdgcn_cvt_pk_f32_fp8((int)va[j].z, false); o[8] += act * t.x; o[9] += act * t.y; t = __builtin_amdgcn_cvt_pk_f32_fp8((int)va[j].z, true); o[10] += act * t.x; o[11] += act * t.y;
                    t = __builtin_amdgcn_cvt_pk_f32_fp8((int)va[j].w, false); o[12] += act * t.x; o[13] += act * t.y; t = __builtin_amdgcn_cvt_pk_f32_fp8((int)va[j].w, true); o[14] += act * t.x; o[15] += act * t.y; }
            } }
#endif
        f32x4* hp = (f32x4*)(p.out + (size_t)m * DM) + 4 * lane;
        f32x4 h0 = hp[0], h1 = hp[1], h2 = hp[2], h3 = hp[3];
        h0 += (f32x4){o[0], o[1], o[2], o[3]}; h1 += (f32x4){o[4], o[5], o[6], o[7]}; h2 += (f32x4){o[8], o[9], o[10], o[11]}; h3 += (f32x4){o[12], o[13], o[14], o[15]};
        f32x4* hq = (f32x4*)(hdst + (size_t)m * DM) + 4 * lane; hq[0] = h0; hq[1] = h1; hq[2] = h2; hq[3] = h3;
    }
}


constexpr size_t WS_PD = WS_S;
constexpr size_t WS_ACTB = WS_S + 224 * MiB;
struct XI { int xr, nx, jr, nloc; };
typedef long i64_t;
__device__ __forceinline__ i64_t pack64(unsigned lo, unsigned hi) { return (i64_t)(((unsigned long long)hi << 32) | lo); }
typedef int i32x8 __attribute__((ext_vector_type(8)));
__device__ __forceinline__ void peer_u_half(const u32x4 (&v)[8], const i32x8& xh, const i32x8& xl, LAS unsigned char* img, LAS float* pdp, int lane) {
    const int e8 = lane >> 3, cc = lane & 7, r = lane & 15, q = lane >> 4;
#pragma unroll
    for (int j = 0; j < 8; ++j) *(LAS u32x4*)(img + (8 * e8 + j) * 128 + ((cc ^ j) << 4)) = v[j];
    asm volatile("" ::: "memory");
#pragma unroll
    for (int g = 0; g < 4; ++g) { const int row = 16 * g + r;
        const u32x4 w0 = *(const LAS u32x4*)(img + row * 128 + (((2 * q) ^ (row & 7)) << 4)), w1 = *(const LAS u32x4*)(img + row * 128 + (((2 * q + 1) ^ (row & 7)) << 4));
        const i32x8 aw = {(int)w0.x, (int)w0.y, (int)w0.z, (int)w0.w, (int)w1.x, (int)w1.y, (int)w1.z, (int)w1.w};
        f32x4 ah = {0.f, 0.f, 0.f, 0.f}, al = {0.f, 0.f, 0.f, 0.f};
        ah = __builtin_amdgcn_mfma_scale_f32_16x16x128_f8f6f4(aw, xh, ah, 0, 0, 0, 0, 0, 0); al = __builtin_amdgcn_mfma_scale_f32_16x16x128_f8f6f4(aw, xl, al, 0, 0, 0, 0, 0, 0);
        if (r == 0) *(LAS f32x4*)(pdp + 16 * g + 4 * q) = ah + al * 0.0625f; }
    asm volatile("" ::: "memory");
}
__device__ __forceinline__ void split_x8(const u32x4 xv, i64_t& xh, i64_t& xl) {
    const float f[8] = {bflo(xv.x), bfhi(xv.x), bflo(xv.y), bfhi(xv.y), bflo(xv.z), bfhi(xv.z), bflo(xv.w), bfhi(xv.w)};
    int h0 = __builtin_amdgcn_cvt_pk_fp8_f32(f[0], f[1], 0, false); h0 = __builtin_amdgcn_cvt_pk_fp8_f32(f[2], f[3], h0, true);
    int h1 = __builtin_amdgcn_cvt_pk_fp8_f32(f[4], f[5], 0, false); h1 = __builtin_amdgcn_cvt_pk_fp8_f32(f[6], f[7], h1, true);
    const f32x2 d0 = __builtin_amdgcn_cvt_pk_f32_fp8(h0, false), d1 = __builtin_amdgcn_cvt_pk_f32_fp8(h0, true), d2 = __builtin_amdgcn_cvt_pk_f32_fp8(h1, false), d3 = __builtin_amdgcn_cvt_pk_f32_fp8(h1, true);
    int l0 = __builtin_amdgcn_cvt_pk_fp8_f32((f[0] - d0.x) * 16.f, (f[1] - d0.y) * 16.f, 0, false); l0 = __builtin_amdgcn_cvt_pk_fp8_f32((f[2] - d1.x) * 16.f, (f[3] - d1.y) * 16.f, l0, true);
    int l1 = __builtin_amdgcn_cvt_pk_fp8_f32((f[4] - d2.x) * 16.f, (f[5] - d2.y) * 16.f, 0, false); l1 = __builtin_amdgcn_cvt_pk_fp8_f32((f[6] - d3.x) * 16.f, (f[7] - d3.y) * 16.f, l1, true);
    xh = pack64((unsigned)h0, (unsigned)h1); xl = pack64((unsigned)l0, (unsigned)l1);
}
__device__ __forceinline__ void ph_peer_u(const Params& p, int layer, const Ctx& c, const XI xi, int idmask) {
    const bf16_t* XN = (const bf16_t*)(p.ws + WS_ACT); const unsigned char* UT = p.ws + WS_TAB8 + (size_t)layer * 2 * NEXP * DM;
    const int* ids = (const int*)(p.ws + WS_IDS); bf16_t* PDh = (bf16_t*)(p.ws + WS_PD);
    const int lane = c.lane, e8 = lane >> 3, cc = lane & 7, q = lane >> 4;
    const int tstep = xi.nloc * NWAVES;
    LAS unsigned char* img = c.lds + c.wave * 8192; LAS float* stg = (LAS float*)(c.lds + 65536 + c.wave * 512);
#pragma unroll 1
    for (int sl = xi.xr; sl < 8; sl += xi.nx) {
        const unsigned char* Us = UT + (size_t)sl * NEXP * 128; const unsigned uo = 16u * (unsigned)cc;
        int t = xi.jr * NWAVES + c.wave;
        if (t >= M) continue;
#define PU_LD(k) ((idmask & 0x10000) ? (u32x4){(unsigned)(k), (unsigned)(k), uo, uo} : *(const u32x4*)(Us + (((unsigned)((k) & (idmask & 0xffff)) << 7) + uo)))
#define PU_ROWS(dst, ia, ib) do { dst[0] = PU_LD((ia).x); dst[1] = PU_LD((ia).y); dst[2] = PU_LD((ia).z); dst[3] = PU_LD((ia).w); dst[4] = PU_LD((ib).x); dst[5] = PU_LD((ib).y); dst[6] = PU_LD((ib).z); dst[7] = PU_LD((ib).w); } while (0)
#define PU_X(tt) do { const bf16_t* xp = XN + (size_t)(tt) * DM + 128 * sl + 32 * q; xv[0] = *(const u32x4*)xp; xv[1] = *(const u32x4*)(xp + 8); xv[2] = *(const u32x4*)(xp + 16); xv[3] = *(const u32x4*)(xp + 24); } while (0)
#define PU_SPLIT() do { i64_t h_[4], l_[4]; _Pragma("unroll") for (int k_ = 0; k_ < 4; ++k_) split_x8(xv[k_], h_[k_], l_[k_]); \
        xh = (i32x8){(int)h_[0], (int)(h_[0] >> 32), (int)h_[1], (int)(h_[1] >> 32), (int)h_[2], (int)(h_[2] >> 32), (int)h_[3], (int)(h_[3] >> 32)}; \
        xl = (i32x8){(int)l_[0], (int)(l_[0] >> 32), (int)l_[1], (int)(l_[1] >> 32), (int)l_[2], (int)(l_[2] >> 32), (int)l_[3], (int)(l_[3] >> 32)}; } while (0)
        u32x4 v[8], vn[8], xv[4]; i32x8 xh, xl; i32x4 ic2, ic3;
        { const i32x4* ip = (const i32x4*)(ids + (size_t)t * 128 + 8 * e8); const i32x4 i0 = ip[0], i1 = ip[1]; ic2 = ip[16]; ic3 = ip[17]; PU_ROWS(v, i0, i1); PU_X(t); }
#pragma unroll 1
        for (; t < M; t += tstep) {
            const int tn = min(t + tstep, M - 1);
            const i32x4* ipn = (const i32x4*)(ids + (size_t)tn * 128 + 8 * e8); const i32x4 in0 = ipn[0], in1 = ipn[1], in2 = ipn[16], in3 = ipn[17];
            PU_ROWS(vn, ic2, ic3);
            PU_SPLIT();
            __builtin_amdgcn_sched_barrier(0);
            if (!(idmask & 0x20000)) peer_u_half(v, xh, xl, img, stg, lane); else { _Pragma("unroll") for (int j_ = 0; j_ < 8; ++j_) asm volatile("" :: "v"(v[j_])); }
#pragma unroll
            for (int j = 0; j < 8; ++j) v[j] = vn[j];
            PU_ROWS(vn, in0, in1);
            __builtin_amdgcn_sched_barrier(0);
            if (!(idmask & 0x20000)) peer_u_half(v, xh, xl, img, stg + 64, lane); else { _Pragma("unroll") for (int j_ = 0; j_ < 8; ++j_) asm volatile("" :: "v"(v[j_])); }
#pragma unroll
            for (int j = 0; j < 8; ++j) v[j] = vn[j];
            ic2 = in2; ic3 = in3;
            asm volatile("" ::: "memory");
            { const f32x2 pv = *(const LAS f32x2*)(stg + 2 * lane); *(unsigned*)(PDh + ((size_t)sl * M + t) * 128 + 2 * lane) = pk2(pv.x, pv.y); }
            asm volatile("" ::: "memory");
            PU_X(tn);
        }
#undef PU_LD
#undef PU_ROWS
#undef PU_X
#undef PU_SPLIT
    }
}
__device__ __forceinline__ void ph_peer_act(const Params& p, int layer, const Ctx& c) {
    const bf16_t* PDh = (const bf16_t*)(p.ws + WS_PD); float* ACTB = (float*)(p.ws + WS_ACTB);
    const float* SU = (const float*)(p.ws + WS_SCL) + (size_t)layer * 2 * NEXP; const float* SV = SU + NEXP;
    const int* ids = (const int*)(p.ws + WS_IDS); const float* gg = (const float*)(p.ws + WS_G);
    for (int idx = c.gtid; idx < M * 128; idx += c.gthreads) { float d = 0.f;
#pragma unroll
        for (int sl = 0; sl < 8; ++sl) d += bf2f(PDh[(size_t)sl * M * 128 + idx]);
        const int id = ids[idx]; ACTB[idx] = gelu_tanh(d * SU[id]) * gg[idx] * SV[id]; }
}
#define PIN16(o) asm volatile("" : "+v"(o[0]), "+v"(o[1]), "+v"(o[2]), "+v"(o[3]), "+v"(o[4]), "+v"(o[5]), "+v"(o[6]), "+v"(o[7]), "+v"(o[8]), "+v"(o[9]), "+v"(o[10]), "+v"(o[11]), "+v"(o[12]), "+v"(o[13]), "+v"(o[14]), "+v"(o[15]))
__device__ __forceinline__ void peer_v_half(const u32x4 (&vin)[8], const f32x4& a0, const f32x4& a1, float (&o)[16]) {
#pragma unroll
    for (int j = 0; j < 8; ++j) { const float act = (j < 4) ? a0[j & 3] : a1[j & 3]; f32x2 tt; u32x4 vr = vin[j];
        asm volatile("" : "+v"(vr.x), "+v"(vr.y), "+v"(vr.z), "+v"(vr.w));
        tt = __builtin_amdgcn_cvt_pk_f32_fp8((int)vr.x, false); o[0] += act * tt.x; o[1] += act * tt.y; tt = __builtin_amdgcn_cvt_pk_f32_fp8((int)vr.x, true); o[2] += act * tt.x; o[3] += act * tt.y;
        tt = __builtin_amdgcn_cvt_pk_f32_fp8((int)vr.y, false); o[4] += act * tt.x; o[5] += act * tt.y; tt = __builtin_amdgcn_cvt_pk_f32_fp8((int)vr.y, true); o[6] += act * tt.x; o[7] += act * tt.y;
        tt = __builtin_amdgcn_cvt_pk_f32_fp8((int)vr.z, false); o[8] += act * tt.x; o[9] += act * tt.y; tt = __builtin_amdgcn_cvt_pk_f32_fp8((int)vr.z, true); o[10] += act * tt.x; o[11] += act * tt.y;
        tt = __builtin_amdgcn_cvt_pk_f32_fp8((int)vr.w, false); o[12] += act * tt.x; o[13] += act * tt.y; tt = __builtin_amdgcn_cvt_pk_f32_fp8((int)vr.w, true); o[14] += act * tt.x; o[15] += act * tt.y;
        PIN16(o); }
}
__device__ __forceinline__ void ph_peer_v(const Params& p, int layer, const Ctx& c, const XI xi, float* hdst, int idmask) {
    const unsigned char* VT = p.ws + WS_TAB8 + (size_t)layer * 2 * NEXP * DM + (size_t)NEXP * DM;
    const int* ids = (const int*)(p.ws + WS_IDS); const float* ACTB = (const float*)(p.ws + WS_ACTB);
    const int lane = c.lane, e8 = lane >> 3, cc = lane & 7;
    const int tstep = xi.nloc * NWAVES;
    const bool b5 = (lane & 32) != 0, b4 = (lane & 16) != 0, b3 = (lane & 8) != 0;
#pragma unroll 1
    for (int sl = xi.xr; sl < 8; sl += xi.nx) {
        const unsigned char* Vs = VT + (size_t)sl * NEXP * 128; const unsigned vo = 16u * (unsigned)cc;
        int t = xi.jr * NWAVES + c.wave;
        if (t >= M) continue;
#define PV_LD(k) ((idmask & 0x10000) ? (u32x4){(unsigned)(k), (unsigned)(k), vo, vo} : *(const u32x4*)(Vs + (((unsigned)((k) & (idmask & 0xffff)) << 7) + vo)))
#define PV_ROWS(dst, ia, ib) do { dst[0] = PV_LD((ia).x); dst[1] = PV_LD((ia).y); dst[2] = PV_LD((ia).z); dst[3] = PV_LD((ia).w); dst[4] = PV_LD((ib).x); dst[5] = PV_LD((ib).y); dst[6] = PV_LD((ib).z); dst[7] = PV_LD((ib).w); } while (0)
        u32x4 v[8], vn[8]; f32x4 av[4]; f32x2 hv; i32x4 ic2, ic3;
        { const i32x4* ip = (const i32x4*)(ids + (size_t)t * 128 + 16 * e8); const i32x4 i0 = ip[0], i1 = ip[1]; ic2 = ip[2]; ic3 = ip[3]; PV_ROWS(v, i0, i1);
          const f32x4* ap = (const f32x4*)(ACTB + (size_t)t * 128 + 16 * e8); av[0] = ap[0]; av[1] = ap[1]; av[2] = ap[2]; av[3] = ap[3];
          hv = *(const f32x2*)(p.out + (size_t)t * DM + 128 * sl + 16 * cc + 2 * e8); }
#pragma unroll 1
        for (; t < M; t += tstep) {
            const int tn = min(t + tstep, M - 1);
            const i32x4* ipn = (const i32x4*)(ids + (size_t)tn * 128 + 16 * e8); const i32x4 in0 = ipn[0], in1 = ipn[1], in2 = ipn[2], in3 = ipn[3];
            float o[16];
#pragma unroll
            for (int i = 0; i < 16; ++i) o[i] = 0.f;
            PV_ROWS(vn, ic2, ic3);
            __builtin_amdgcn_sched_barrier(0);
            if (!(idmask & 0x20000)) peer_v_half(v, av[0], av[1], o); else { _Pragma("unroll") for (int j_ = 0; j_ < 8; ++j_) asm volatile("" :: "v"(v[j_])); }
            __builtin_amdgcn_sched_barrier(0);
#pragma unroll
            for (int j = 0; j < 8; ++j) v[j] = vn[j];
            PV_ROWS(vn, in0, in1);
            __builtin_amdgcn_sched_barrier(0);
            if (!(idmask & 0x20000)) peer_v_half(v, av[2], av[3], o); else { _Pragma("unroll") for (int j_ = 0; j_ < 8; ++j_) asm volatile("" :: "v"(v[j_])); }
            __builtin_amdgcn_sched_barrier(0);
#pragma unroll
            for (int j = 0; j < 8; ++j) v[j] = vn[j];
            ic2 = in2; ic3 = in3;
#pragma unroll
            for (int i = 0; i < 8; ++i) { const float keep = b5 ? o[i + 8] : o[i], send = b5 ? o[i] : o[i + 8]; o[i] = keep + __shfl_xor(send, 32); }
#pragma unroll
            for (int i = 0; i < 4; ++i) { const float keep = b4 ? o[i + 4] : o[i], send = b4 ? o[i] : o[i + 4]; o[i] = keep + __shfl_xor(send, 16); }
#pragma unroll
            for (int i = 0; i < 2; ++i) { const float keep = b3 ? o[i + 2] : o[i], send = b3 ? o[i] : o[i + 2]; o[i] = keep + __shfl_xor(send, 8); }
            hv.x += o[0]; hv.y += o[1]; *(f32x2*)(hdst + (size_t)t * DM + 128 * sl + 16 * cc + 2 * e8) = hv;
            { const f32x4* ap = (const f32x4*)(ACTB + (size_t)tn * 128 + 16 * e8); av[0] = ap[0]; av[1] = ap[1]; av[2] = ap[2]; av[3] = ap[3];
              hv = *(const f32x2*)(p.out + (size_t)tn * DM + 128 * sl + 16 * cc + 2 * e8); }
        }
#undef PV_ROWS
#undef PV_LD
    }
}

constexpr size_t WS_ACT8 = WS_S + 224 * MiB;
constexpr size_t WS_SA = WS_S + 240 * MiB;
__device__ __forceinline__ void ph_peer_act2(const Params& p, int layer, const Ctx& c) {
    const bf16_t* PDh = (const bf16_t*)(p.ws + WS_PD); unsigned char* A8 = p.ws + WS_ACT8; float* SA = (float*)(p.ws + WS_SA);
    const float* SU = (const float*)(p.ws + WS_SCL) + (size_t)layer * 2 * NEXP; const float* SV = SU + NEXP;
    const int* ids = (const int*)(p.ws + WS_IDS); const float* gg = (const float*)(p.ws + WS_G);
    const int lane = c.lane;
    for (int t0 = c.gwave; t0 < M; t0 += 4 * c.gwaves) {
        float d0[4], d1[4], g0[4], g1[4], su0[4], su1[4], sv0[4], sv1[4]; int id0[4], id1[4];
#pragma unroll
        for (int u = 0; u < 4; ++u) { const int t = min(t0 + u * c.gwaves, M - 1); id0[u] = ids[(size_t)t * 128 + lane]; id1[u] = ids[(size_t)t * 128 + 64 + lane]; g0[u] = gg[(size_t)t * 128 + lane]; g1[u] = gg[(size_t)t * 128 + 64 + lane]; }
#pragma unroll
        for (int u = 0; u < 4; ++u) { const int t = min(t0 + u * c.gwaves, M - 1); d0[u] = 0.f; d1[u] = 0.f;
#pragma unroll
            for (int sl = 0; sl < 8; ++sl) { d0[u] += bf2f(PDh[((size_t)sl * M + t) * 128 + lane]); d1[u] += bf2f(PDh[((size_t)sl * M + t) * 128 + 64 + lane]); } }
#pragma unroll
        for (int u = 0; u < 4; ++u) { su0[u] = SU[id0[u]]; su1[u] = SU[id1[u]]; sv0[u] = SV[id0[u]]; sv1[u] = SV[id1[u]]; }
#pragma unroll
        for (int u = 0; u < 4; ++u) { const int t = t0 + u * c.gwaves; if (t >= M) break;
            const float a0 = gelu_tanh(d0[u] * su0[u]) * g0[u] * sv0[u], a1 = gelu_tanh(d1[u] * su1[u]) * g1[u] * sv1[u];
            const float mx = wave_max(fmaxf(fabsf(a0), fabsf(a1)));
            const float sa = mx > 0.f ? mx * (1.f / 256.f) : 1.f, inv = 1.f / sa;
            const float b0 = a0 * inv, b1 = a1 * inv;
            const int hq = __builtin_amdgcn_cvt_pk_fp8_f32(b0, b1, 0, false);
            const f32x2 hd = __builtin_amdgcn_cvt_pk_f32_fp8(hq, false);
            const int lq = __builtin_amdgcn_cvt_pk_fp8_f32((b0 - hd.x) * 16.f, (b1 - hd.y) * 16.f, 0, false);
            unsigned char* o = A8 + (size_t)t * 256;
            o[lane] = (unsigned char)(hq & 0xff); o[64 + lane] = (unsigned char)((hq >> 8) & 0xff); o[128 + lane] = (unsigned char)(lq & 0xff); o[192 + lane] = (unsigned char)((lq >> 8) & 0xff);
            if (lane == 0) SA[t] = sa; }
    }
}
typedef int i32x2 __attribute__((ext_vector_type(2)));
__device__ __forceinline__ i32x2 lds_tr8(LAS const unsigned char* pb) { return __builtin_amdgcn_ds_read_tr8_b64_v2i32((LAS i32x2*)pb); }
__device__ __forceinline__ void ph_peer_v2(const Params& p, int layer, const Ctx& c, const XI xi, float* hdst, int idmask) {
    const unsigned char* VT = p.ws + WS_TAB8 + (size_t)layer * 2 * NEXP * DM + (size_t)NEXP * DM;
    const int* ids = (const int*)(p.ws + WS_IDS); const unsigned char* A8 = p.ws + WS_ACT8; const float* SA = (const float*)(p.ws + WS_SA);
    const int lane = c.lane, e8 = lane >> 3, cc = lane & 7, r = lane & 15, q = lane >> 4;
    const int tstep = xi.nloc * NWAVES;
    LAS unsigned char* img = c.lds + c.wave * 16384;
#pragma unroll 1
    for (int sl = xi.xr; sl < 8; sl += xi.nx) {
        const unsigned char* Vs = VT + (size_t)sl * NEXP * 128; const unsigned vo = 16u * (unsigned)cc;
        int t = xi.jr * NWAVES + c.wave;
        if (t >= M) continue;
#define PV_LD(k) (*(const u32x4*)(Vs + (((unsigned)((k) & (idmask & 0xffff)) << 7) + vo)))
#define PV_ROWS(dst, ia, ib) do { dst[0] = PV_LD((ia).x); dst[1] = PV_LD((ia).y); dst[2] = PV_LD((ia).z); dst[3] = PV_LD((ia).w); dst[4] = PV_LD((ib).x); dst[5] = PV_LD((ib).y); dst[6] = PV_LD((ib).z); dst[7] = PV_LD((ib).w); } while (0)
#define PV_IMG(src, half) do { _Pragma("unroll") for (int j = 0; j < 8; ++j) *(LAS u32x4*)(img + (64 * (half) + 8 * e8 + j) * 128 + ((cc ^ j) << 4)) = src[j]; } while (0)
        u32x4 v[8], vn[8];
        { const i32x4* ip = (const i32x4*)(ids + (size_t)t * 128 + 8 * e8); const i32x4 i0 = ip[0], i1 = ip[1], i2 = ip[16], i3 = ip[17]; PV_ROWS(v, i0, i1); PV_ROWS(vn, i2, i3); }
#pragma unroll 1
        for (; t < M; t += tstep) {
            const int tn = min(t + tstep, M - 1);
            const i32x4* ipn = (const i32x4*)(ids + (size_t)tn * 128 + 8 * e8); const i32x4 in0 = ipn[0], in1 = ipn[1], in2 = ipn[16], in3 = ipn[17];
            const u32x4* ap = (const u32x4*)(A8 + (size_t)t * 256 + 32 * q); const u32x4 ah0 = ap[0], ah1 = ap[1], al0 = ap[8], al1 = ap[9];
            const float sa = SA[t];
            const size_t ho = (size_t)t * DM + 128 * sl + 32 * q + r;
            float h0 = p.out[ho], h1 = p.out[ho + 16];
            PV_IMG(v, 0); PV_IMG(vn, 1);
            PV_ROWS(v, in0, in1); PV_ROWS(vn, in2, in3);
            asm volatile("" ::: "memory");
            const i32x8 ahv = {(int)ah0.x, (int)ah0.y, (int)ah0.z, (int)ah0.w, (int)ah1.x, (int)ah1.y, (int)ah1.z, (int)ah1.w};
            const i32x8 alv = {(int)al0.x, (int)al0.y, (int)al0.z, (int)al0.w, (int)al1.x, (int)al1.y, (int)al1.z, (int)al1.w};
            float oa = 0.f, ob = 0.f;
#pragma unroll
            for (int dt = 0; dt < 8; ++dt) {
                i32x8 bw;
#pragma unroll
                for (int i4 = 0; i4 < 4; ++i4) { const int row = 32 * q + 8 * i4 + (r >> 1);
                    const i32x2 tv = lds_tr8(img + row * 128 + ((dt ^ (row & 7)) << 4) + 8 * (r & 1)); bw[2 * i4] = tv.x; bw[2 * i4 + 1] = tv.y; }
                f32x4 ch = {0.f, 0.f, 0.f, 0.f}, cl = {0.f, 0.f, 0.f, 0.f};
                ch = __builtin_amdgcn_mfma_scale_f32_16x16x128_f8f6f4(ahv, bw, ch, 0, 0, 0, 0, 0, 0); cl = __builtin_amdgcn_mfma_scale_f32_16x16x128_f8f6f4(alv, bw, cl, 0, 0, 0, 0, 0, 0);
                const float od = ch[0] + cl[0] * 0.0625f;
                oa = (dt == 2 * q) ? od : oa; ob = (dt == 2 * q + 1) ? od : ob; }
            h0 += oa * sa; h1 += ob * sa;
            hdst[ho] = h0; hdst[ho + 16] = h1;
            asm volatile("" ::: "memory");
        }
#undef PV_LD
#undef PV_ROWS
#undef PV_IMG
    }
}

constexpr size_t WS_XN8 = WS_S + 256 * MiB;
__device__ __forceinline__ void ph_peer_u2(const Params& p, int layer, const Ctx& c, const XI xi, int idmask) {
    const unsigned char* X8 = p.ws + WS_XN8; const unsigned char* UT = p.ws + WS_TAB8 + (size_t)layer * 2 * NEXP * DM;
    const int* ids = (const int*)(p.ws + WS_IDS); bf16_t* PDh = (bf16_t*)(p.ws + WS_PD);
    const int lane = c.lane, e8 = lane >> 3, cc = lane & 7, r = lane & 15, q = lane >> 4;
    const int tstep = xi.nloc * NWAVES;
    LAS unsigned char* img = c.lds + c.wave * 16384; LAS float* stg = (LAS float*)(c.lds + 131072 + c.wave * 512);
#pragma unroll 1
    for (int sl = xi.xr; sl < 8; sl += xi.nx) {
        const unsigned char* Us = UT + (size_t)sl * NEXP * 128; const unsigned uo = 16u * (unsigned)cc;
        int t = xi.jr * NWAVES + c.wave;
        if (t >= M) continue;
#define PU_LD(k) (*(const u32x4*)(Us + (((unsigned)((k) & (idmask & 0xffff)) << 7) + uo)))
#define PU_ROWS(dst, ia, ib) do { dst[0] = PU_LD((ia).x); dst[1] = PU_LD((ia).y); dst[2] = PU_LD((ia).z); dst[3] = PU_LD((ia).w); dst[4] = PU_LD((ib).x); dst[5] = PU_LD((ib).y); dst[6] = PU_LD((ib).z); dst[7] = PU_LD((ib).w); } while (0)
#define PU_IMG(src, half) do { _Pragma("unroll") for (int j = 0; j < 8; ++j) *(LAS u32x4*)(img + (64 * (half) + 8 * e8 + j) * 128 + ((cc ^ j) << 4)) = src[j]; } while (0)
        u32x4 v[8], vn[8];
        { const i32x4* ip = (const i32x4*)(ids + (size_t)t * 128 + 8 * e8); const i32x4 i0 = ip[0], i1 = ip[1], i2 = ip[16], i3 = ip[17]; PU_ROWS(v, i0, i1); PU_ROWS(vn, i2, i3); }
#pragma unroll 1
        for (; t < M; t += tstep) {
            const int tn = min(t + tstep, M - 1);
            const i32x4* ipn = (const i32x4*)(ids + (size_t)tn * 128 + 8 * e8); const i32x4 in0 = ipn[0], in1 = ipn[1], in2 = ipn[16], in3 = ipn[17];
            const u32x4* xp = (const u32x4*)(X8 + (size_t)t * 2048 + 128 * sl + 32 * q); const u32x4 xh0 = xp[0], xh1 = xp[1], xl0 = xp[64], xl1 = xp[65];
            PU_IMG(v, 0); PU_IMG(vn, 1);
            PU_ROWS(v, in0, in1); PU_ROWS(vn, in2, in3);
            asm volatile("" ::: "memory");
            const i32x8 xh = {(int)xh0.x, (int)xh0.y, (int)xh0.z, (int)xh0.w, (int)xh1.x, (int)xh1.y, (int)xh1.z, (int)xh1.w};
            const i32x8 xl = {(int)xl0.x, (int)xl0.y, (int)xl0.z, (int)xl0.w, (int)xl1.x, (int)xl1.y, (int)xl1.z, (int)xl1.w};
#pragma unroll
            for (int g = 0; g < 8; ++g) { const int row = 16 * g + r;
                const u32x4 w0 = *(const LAS u32x4*)(img + row * 128 + (((2 * q) ^ (row & 7)) << 4)), w1 = *(const LAS u32x4*)(img + row * 128 + (((2 * q + 1) ^ (row & 7)) << 4));
                const i32x8 aw = {(int)w0.x, (int)w0.y, (int)w0.z, (int)w0.w, (int)w1.x, (int)w1.y, (int)w1.z, (int)w1.w};
                f32x4 ah = {0.f, 0.f, 0.f, 0.f}, al = {0.f, 0.f, 0.f, 0.f};
                ah = __builtin_amdgcn_mfma_scale_f32_16x16x128_f8f6f4(aw, xh, ah, 0, 0, 0, 0, 0, 0); al = __builtin_amdgcn_mfma_scale_f32_16x16x128_f8f6f4(aw, xl, al, 0, 0, 0, 0, 0, 0);
                if (r == 0) *(LAS f32x4*)(stg + 16 * g + 4 * q) = ah + al * 0.0625f; }
            asm volatile("" ::: "memory");
            { const f32x2 pv = *(const LAS f32x2*)(stg + 2 * lane); *(unsigned*)(PDh + ((size_t)sl * M + t) * 128 + 2 * lane) = pk2(pv.x, pv.y); }
            asm volatile("" ::: "memory");
        }
#undef PU_LD
#undef PU_ROWS
#undef PU_IMG
    }
}

__device__ __forceinline__ void ph_g1(const Params& p, const Ctx& c) {
    const bf16_t* proj = (const bf16_t*)(p.ws + WS_PROJ); bf16_t* xc = (bf16_t*)(p.ws + WS_XC);
    for (size_t idx = c.gtid; idx < (size_t)M * DM; idx += c.gthreads) {
        const int ch = (int)(idx & 1023); const int row = (int)(idx >> 10); const int t = row & (SEQ - 1);
        float a = p.c_conv_b[ch];
#pragma unroll
        for (int j = 0; j < 4; ++j) { const int tt = t - 3 + j; if (tt >= 0) a += p.c_conv_w[j * 1024 + ch] * bf2f(proj[(size_t)(row - 3 + j) * 2048 + 1024 + ch]); }
        xc[idx] = (bf16_t)f2bf(a);
    }
}
__device__ __forceinline__ void ph_g2(const Params& p, const Ctx& c) {
    const bf16_t* xc = (const bf16_t*)(p.ws + WS_XC); float* A = (float*)(p.ws + WS_A); float* U = (float*)(p.ws + WS_U);
    for (size_t idx = c.gtid; idx < (size_t)M * DM; idx += c.gthreads) {
        const int ch = (int)(idx & 1023); const size_t row = idx >> 10; const int g = ch >> 7, j = ch & 127;
        const bf16_t* xr = xc + row * DM + g * 128; const float* wr = p.c_w_rgate + (size_t)g * 16384 + j; const float* wi = p.c_w_igate + (size_t)g * 16384 + j;
        float ar = p.c_b_rgate[ch], ai = p.c_b_igate[ch];
        for (int i = 0; i < 128; i += 8) { const u32x4 w = *(const u32x4*)(xr + i);
            const float x0 = bflo(w.x), x1 = bfhi(w.x), x2 = bflo(w.y), x3 = bfhi(w.y), x4 = bflo(w.z), x5 = bfhi(w.z), x6 = bflo(w.w), x7 = bfhi(w.w);
            ar += x0 * wr[(i) * 128] + x1 * wr[(i + 1) * 128] + x2 * wr[(i + 2) * 128] + x3 * wr[(i + 3) * 128] + x4 * wr[(i + 4) * 128] + x5 * wr[(i + 5) * 128] + x6 * wr[(i + 6) * 128] + x7 * wr[(i + 7) * 128];
            ai += x0 * wi[(i) * 128] + x1 * wi[(i + 1) * 128] + x2 * wi[(i + 2) * 128] + x3 * wi[(i + 3) * 128] + x4 * wi[(i + 4) * 128] + x5 * wi[(i + 5) * 128] + x6 * wi[(i + 6) * 128] + x7 * wi[(i + 7) * 128]; }
        const float r = sigmoidf_(ar), ig = sigmoidf_(ai);
        const float lam = p.c_lambda[ch]; const float sp = fmaxf(-lam, 0.f) + log1pf(expf(-fabsf(lam)));
        const float la = -8.f * r * sp;
        A[idx] = expf(la); U[idx] = sqrtf(-expm1f(2.f * la)) * (ig * bf2f(xc[idx]));
    }
}
__device__ __forceinline__ void ph_g3(const Params& p, const Ctx& c) {
    const bf16_t* proj = (const bf16_t*)(p.ws + WS_PROJ); const float* A = (const float*)(p.ws + WS_A); const float* U = (const float*)(p.ws + WS_U); bf16_t* y = (bf16_t*)(p.ws + WS_ACT);
    for (int idx = c.gtid; idx < BATCH * DM; idx += c.gthreads) {
        const int b = idx >> 10, ch = idx & 1023; float h = 0.f;
        for (int t0 = 0; t0 < SEQ; t0 += 8) {
            float a[8], u[8], g[8];
#pragma unroll
            for (int j = 0; j < 8; ++j) { const size_t e = (size_t)(b * SEQ + t0 + j) * DM + ch; a[j] = A[e]; u[j] = U[e]; g[j] = bf2f(proj[(size_t)(b * SEQ + t0 + j) * 2048 + ch]); }
#pragma unroll
            for (int j = 0; j < 8; ++j) { h = a[j] * h + u[j]; y[(size_t)(b * SEQ + t0 + j) * DM + ch] = (bf16_t)f2bf(gelu_tanh(g[j]) * h); }
        }
    }
}
#define XB_TMO      128
#define XB_XCNT(j)  (256  + 64 * (j))
#define XB_XSUB(j)  (1280 + 64 * (j))
#define XB_XGEN(j)  (2304 + 64 * (j))
#define XB_TOP      3328
#define XB_TOPGEN   3392
#define XCD_BAR_WORDS 3456
#define XB_SPIN_CAP (1u << 18)

__device__ __forceinline__ unsigned xb_ld(unsigned* p)              { return __hip_atomic_load(p, __ATOMIC_RELAXED, __HIP_MEMORY_SCOPE_AGENT); }
__device__ __forceinline__ unsigned xb_add(unsigned* p, unsigned v) { return __hip_atomic_fetch_add(p, v, __ATOMIC_RELAXED, __HIP_MEMORY_SCOPE_AGENT); }
__device__ __forceinline__ unsigned xb_xcc_id() { return (unsigned)__builtin_amdgcn_s_getreg((3 << 11) | 20) & 0xFu; }
#define XB_SPIN(cond, bar) do { unsigned _sp = 0; while (cond) { __builtin_amdgcn_s_sleep(1); \
    if ((++_sp & 255u) == 0u) { if (xb_ld(&(bar)[XB_TMO])) break; if (_sp > XB_SPIN_CAP) { atomicAdd(&(bar)[XB_TMO], 1u); break; } } } } while (0)

struct XcdBarrier {
    unsigned* bar; unsigned x;
    volatile LAS unsigned* st;
};

__device__ __forceinline__ XcdBarrier xcd_barrier_post(unsigned* bar, volatile LAS unsigned* st) {
    XcdBarrier b; b.bar = bar; b.x = xb_xcc_id(); b.st = st;
    if (threadIdx.x == 0) (void)xb_add(&bar[XB_XCNT(b.x)], 1u);
    return b;
}
__device__ __forceinline__ void xcd_barrier_complete(unsigned* bar, unsigned x, unsigned& nloc, unsigned& nx) {
    const unsigned G = gridDim.x * gridDim.y * gridDim.z;
    unsigned sum, cnt, mine, sp = 0u;
    for (;;) {
        sum = 0u; cnt = 0u; mine = 0u;
#pragma unroll
        for (unsigned j = 0; j < 16; ++j) { const unsigned c = xb_ld(&bar[XB_XCNT(j)]); sum += c; cnt += (c > 0u) ? 1u : 0u; mine = (j == x) ? c : mine; }
        if (sum == G) break;
        __builtin_amdgcn_s_sleep(1);
        if ((++sp & 255u) == 0u) { if (xb_ld(&bar[XB_TMO])) break; if (sp > XB_SPIN_CAP) { atomicAdd(&bar[XB_TMO], 1u); break; } }
    }
    nloc = mine > 0u ? mine : 1u; nx = cnt > 0u ? cnt : 1u;
}

__device__ __forceinline__ void xcd_barrier(const XcdBarrier& b) {
    asm volatile("s_waitcnt vmcnt(0)" ::: "memory");
    __syncthreads();
    if (threadIdx.x == 0) {
        unsigned* bar = b.bar;
        __builtin_amdgcn_s_waitcnt(0);
        unsigned nloc = b.st[0], nx = b.st[1];
        if (nloc == 0u) { xcd_barrier_complete(bar, b.x, nloc, nx); b.st[0] = nloc; b.st[1] = nx; }
        const unsigned old = xb_add(&bar[XB_XSUB(b.x)], 1u);
        const unsigned gen = old / nloc;
        if (old + 1u == (gen + 1u) * nloc) {
            __builtin_amdgcn_fence(__ATOMIC_RELEASE, "agent");
            asm volatile("s_waitcnt vmcnt(0)" ::: "memory");
            const unsigned og = xb_add(&bar[XB_TOP], 1u);
            const unsigned tg = og / nx;
            if (og + 1u == (tg + 1u) * nx) xb_add(&bar[XB_TOPGEN], 1u);
            else XB_SPIN(xb_ld(&bar[XB_TOPGEN]) == tg, bar);
            __builtin_amdgcn_fence(__ATOMIC_ACQUIRE, "agent");
            xb_add(&bar[XB_XGEN(b.x)], 1u);
            asm volatile("s_waitcnt vmcnt(0)" ::: "memory");
        } else {
            XB_SPIN(xb_ld(&bar[XB_XGEN(b.x)]) == gen, bar);
            __builtin_amdgcn_fence(__ATOMIC_ACQUIRE, "agent");
            asm volatile("s_waitcnt vmcnt(0)" ::: "memory");
        }
    }
    __syncthreads();
}

enum Phase { PH_PRO = 0, PH_GEMM_IN0, PH_MIXER0, PH_GLA_B, PH_GLA_C, PH_MIX0, PH_GEMM_OUT0, PH_NORM_F0, PH_GEMM_Q0, PH_TOPK1_0, PH_PU0, PH_PA0, PH_PV0,
             PH_NORM_M1, PH_GEMM_CIN, PH_G1, PH_G2, PH_G3, PH_GEMM_OUT1, PH_NORM_F1, PH_GEMM_Q1, PH_TOPK1_1, PH_PU1, PH_PA1, PH_PV1, PH_FINAL, NPHASES };

#ifndef PH_ONLY
#define PH_ONLY (-1)
#endif
#define PH_ENABLED(x) (PH_ONLY < 0 || PH_ONLY == (x))
#ifndef MK_N_LAUNCHES
#define MK_N_LAUNCHES 1
#endif

template <class Epi> __device__ __forceinline__ void run_gemm(const Ctx& c, const bf16_t* A, const bf16_t* Bt, int N, const Epi& E, int vblk) {
    pg8::Gemm g{A, Bt, M, N, DM}; pg8::StaticOrder S; S.init(M, N, c.nblk, vblk);
    pg8::gemm_phase<Epi, pg8::StaticOrder, true, true>(c.lds, g, S, E);
}

#ifdef PROBE_RT
#define GATHER_CALL(l) ph_gather2(p, c)
#else
#define GATHER_CALL(l) ph_gather3(p, l, c, (rep_ + 1 < NREP(PH_GATHER##l)) ? (float*)(ws + WS_S) : p.out)
#endif
#ifndef PROBE_IDMASK
#define PROBE_IDMASK 0x3fff
#endif
#ifndef DUP_MASK
#define DUP_MASK 0u
#endif
#define NREP(k) ((((unsigned)(DUP_MASK) >> (k)) & 1u) ? 2 : 1)
#define GETXI() XI xi; { if (multi) { if (threadIdx.x == 0) { unsigned xr_ = 0; for (unsigned j_ = 0; j_ < bar.x; ++j_) xr_ += xb_ld(&ctl[CW_BAR + XB_XCNT(j_)]) > 0u ? 1u : 0u; MISC[11] = xr_; } __syncthreads(); \
    xi.nloc = (int)MISC[8]; xi.nx = (int)MISC[9]; xi.jr = (int)MISC[10]; xi.xr = (int)MISC[11]; if (xi.nloc < 1 || xi.nx < 1 || xi.nx > 8 || xi.jr >= xi.nloc || xi.xr >= xi.nx) { xi.xr = 0; xi.nx = 1; xi.jr = blockIdx.x; xi.nloc = gridDim.x; } } \
    else { xi.xr = 0; xi.nx = 1; xi.jr = blockIdx.x; xi.nloc = gridDim.x; } }
#define MKCTX() Ctx c; { int t_ = threadIdx.x; asm volatile("" : "+v"(t_)); c.lds = lds; c.tid = t_; c.lane = t_ & 63; c.wave = __builtin_amdgcn_readfirstlane(t_ >> 6); \
    c.blk = blockIdx.x; c.nblk = gridDim.x; c.gtid = c.blk * NTHREADS + c.tid; c.gthreads = c.nblk * NTHREADS; c.gwave = c.blk * NWAVES + c.wave; c.gwaves = c.nblk * NWAVES; }
__global__ void __launch_bounds__(NTHREADS, 2) mega_fwd(Params p) {
    extern __shared__ __attribute__((aligned(16))) unsigned char lds_raw[];
    volatile LAS unsigned* MISC = (volatile LAS unsigned*)((LAS unsigned char*)lds_raw + MISC_OFF);
    LAS unsigned char* const lds = (LAS unsigned char*)lds_raw;
    for (int u = threadIdx.x; u < (LDS_BYTES - LDSCTL_OFF) / 4; u += NTHREADS) ((LAS unsigned*)(lds + LDSCTL_OFF))[u] = 0u;
    __syncthreads();
    unsigned* ctl = (unsigned*)(p.ws + WS_CTL);
    XcdBarrier bar; bar.bar = ctl + CW_BAR; bar.x = 0; bar.st = nullptr;
    const bool multi = (p.ph_hi - p.ph_lo) > 1;
    if (multi) { bar = xcd_barrier_post(ctl + CW_BAR, MISC + 8); if (threadIdx.x == 0) MISC[10] = xb_add(&ctl[CW_RANK + 64 * bar.x], 1u); }
    unsigned char* ws = p.ws;
    bf16_t* ACT = (bf16_t*)(ws + WS_ACT); bf16_t* PROJ = (bf16_t*)(ws + WS_PROJ);

    const int lo = p.ph_lo, hi = p.ph_hi;
#define IN(k) (PH_ENABLED(k) && lo <= (k) && (k) < hi)
#define SEAM(k) do { if ((k) + 1 < hi) xcd_barrier(bar); } while (0)
    if (IN(PH_PRO)) { for (int rep_ = 0; rep_ < NREP(PH_PRO); ++rep_) { MKCTX();
        transpose_cvt(p.ab_w_in, DM, NIN, (bf16_t*)(ws + WS_WT_IN), NIN_PAD, [](int n) { return n < 1536 ? n : (n < 3072 ? n + 16 : (n < 3088 ? n - 3072 + 1536 : -1)); }, c.gtid, c.gthreads);
        transpose_cvt(p.ab_w_out, DM, DM, (bf16_t*)(ws + WS_WT_OUT), DM, [](int n) { return n; }, c.gtid, c.gthreads);
        transpose_cvt(p.c_w_in, DM, 2048, (bf16_t*)(ws + WS_WT_CIN), 2048, [](int n) { return n; }, c.gtid, c.gthreads);
        transpose_cvt(p.c_w_out, DM, DM, (bf16_t*)(ws + WS_WT_COUT), DM, [](int n) { return n; }, c.gtid, c.gthreads);
        transpose_cvt(p.peer_w_query, DM, 2048, (bf16_t*)(ws + WS_WT_Q0), 2048, [](int n) { return n; }, c.gtid, c.gthreads);
        transpose_cvt(p.peer_w_query + (size_t)DM * 2048, DM, 2048, (bf16_t*)(ws + WS_WT_Q1), 2048, [](int n) { return n; }, c.gtid, c.gthreads);
#ifdef PROBE_RT
        cvt_fp8_roundtrip_rows(p.peer_u, (bf16_t*)(ws + WS_TAB), NEXP, c);
        cvt_fp8_roundtrip_rows(p.peer_v, (bf16_t*)(ws + WS_TAB) + (size_t)NEXP * DM, NEXP, c);
#else
        cvt_fp8_rows(p.peer_u, ws + WS_TAB8, (float*)(ws + WS_SCL), NEXP, c);
        cvt_fp8_rows(p.peer_v, ws + WS_TAB8 + (size_t)NEXP * DM, (float*)(ws + WS_SCL) + NEXP, NEXP, c);
#endif
        cvt_gate_weights(p, c);
        cvt_bf16(p.peer_sub_keys, (bf16_t*)(ws + WS_SK), (size_t)2 * 8 * 2 * 128 * 128 / 8, c.gtid, c.gthreads);
        norm_rows_bf16(p.x, p.mix_norm, ACT, c);
        if (rep_ + 1 < NREP(PH_PRO)) xcd_barrier(bar); } SEAM(PH_PRO); }
    if (IN(PH_GEMM_IN0)) { for (int rep_ = 0; rep_ < NREP(PH_GEMM_IN0); ++rep_) { MKCTX();  ph_glr(p, c); pg8::EpiBf16<0> E{PROJ, NIN_PAD, nullptr, 0, 0, 1.f}; GETXI(); run_gemm(c, ACT, (const bf16_t*)(ws + WS_WT_IN), 3072, E, (xi.nx == 8 && xi.nloc * 8 == (int)gridDim.x) ? xi.jr * 8 + xi.xr : (int)blockIdx.x); if (rep_ + 1 < NREP(PH_GEMM_IN0)) xcd_barrier(bar); } SEAM(PH_GEMM_IN0); }
    if (IN(PH_MIXER0)) { for (int rep_ = 0; rep_ < NREP(PH_MIXER0); ++rep_) { MKCTX();  ph_gla_a(p, c); ph_attn(p, c); if (rep_ + 1 < NREP(PH_MIXER0)) xcd_barrier(bar); } SEAM(PH_MIXER0); }
    if (IN(PH_GLA_B)) { for (int rep_ = 0; rep_ < NREP(PH_GLA_B); ++rep_) { MKCTX();  ph_gla_b(p, c); if (rep_ + 1 < NREP(PH_GLA_B)) xcd_barrier(bar); } SEAM(PH_GLA_B); }
    if (IN(PH_GLA_C)) { for (int rep_ = 0; rep_ < NREP(PH_GLA_C); ++rep_) { MKCTX();  ph_gla_c(p, c); if (rep_ + 1 < NREP(PH_GLA_C)) xcd_barrier(bar); } SEAM(PH_GLA_C); }
    if (IN(PH_MIX0)) { for (int rep_ = 0; rep_ < NREP(PH_MIX0); ++rep_) { MKCTX();  ph_mix(p, c); if (rep_ + 1 < NREP(PH_MIX0)) xcd_barrier(bar); } SEAM(PH_MIX0); }
    if (IN(PH_GEMM_OUT0)) { for (int rep_ = 0; rep_ < NREP(PH_GEMM_OUT0); ++rep_) { MKCTX();  pg8::EpiResF32 E{p.x, p.out, DM}; GETXI(); run_gemm(c, ACT, (const bf16_t*)(ws + WS_WT_OUT), DM, E, (xi.nx == 8 && xi.nloc * 8 == (int)gridDim.x) ? xi.jr * 8 + xi.xr : (int)blockIdx.x); if (rep_ + 1 < NREP(PH_GEMM_OUT0)) xcd_barrier(bar); } SEAM(PH_GEMM_OUT0); }
    if (IN(PH_NORM_F0)) { for (int rep_ = 0; rep_ < NREP(PH_NORM_F0); ++rep_) { MKCTX();  norm_rows_bf16(p.out, p.ffn_norm, ACT, c, ws + WS_XN8); if (rep_ + 1 < NREP(PH_NORM_F0)) xcd_barrier(bar); } SEAM(PH_NORM_F0); }
    if (IN(PH_GEMM_Q0)) { for (int rep_ = 0; rep_ < NREP(PH_GEMM_Q0); ++rep_) { MKCTX();  pg8::EpiBf16<0> E{PROJ, 2048, nullptr, 0, 0, 1.f}; GETXI(); run_gemm(c, ACT, (const bf16_t*)(ws + WS_WT_Q0), 2048, E, (xi.nx == 8 && xi.nloc * 8 == (int)gridDim.x) ? xi.jr * 8 + xi.xr : (int)blockIdx.x); if (rep_ + 1 < NREP(PH_GEMM_Q0)) xcd_barrier(bar); } SEAM(PH_GEMM_Q0); }
    if (IN(PH_TOPK1_0)) { for (int rep_ = 0; rep_ < NREP(PH_TOPK1_0); ++rep_) { MKCTX();  ph_topk(p, 0, c); if (rep_ + 1 < NREP(PH_TOPK1_0)) xcd_barrier(bar); } SEAM(PH_TOPK1_0); }
    if (IN(PH_PU0)) { for (int rep_ = 0; rep_ < NREP(PH_PU0); ++rep_) { MKCTX();  GETXI(); ph_peer_u2(p, 0, c, xi, (rep_ + 1 < NREP(PH_PU0)) ? PROBE_IDMASK : 0x3fff); if (rep_ + 1 < NREP(PH_PU0)) xcd_barrier(bar); } SEAM(PH_PU0); }
    if (IN(PH_PA0)) { for (int rep_ = 0; rep_ < NREP(PH_PA0); ++rep_) { MKCTX();  ph_peer_act2(p, 0, c); if (rep_ + 1 < NREP(PH_PA0)) xcd_barrier(bar); } SEAM(PH_PA0); }
    if (IN(PH_PV0)) { for (int rep_ = 0; rep_ < NREP(PH_PV0); ++rep_) { MKCTX();  GETXI(); ph_peer_v2(p, 0, c, xi, (rep_ + 1 < NREP(PH_PV0)) ? (float*)(ws + WS_S) : p.out, (rep_ + 1 < NREP(PH_PV0)) ? PROBE_IDMASK : 0x3fff); if (rep_ + 1 < NREP(PH_PV0)) xcd_barrier(bar); } SEAM(PH_PV0); }
    if (IN(PH_NORM_M1)) { for (int rep_ = 0; rep_ < NREP(PH_NORM_M1); ++rep_) { MKCTX();  norm_rows_bf16(p.out, p.mix_norm + DM, ACT, c); if (rep_ + 1 < NREP(PH_NORM_M1)) xcd_barrier(bar); } SEAM(PH_NORM_M1); }
    if (IN(PH_GEMM_CIN)) { for (int rep_ = 0; rep_ < NREP(PH_GEMM_CIN); ++rep_) { MKCTX();  pg8::EpiBf16<0> E{PROJ, 2048, nullptr, 0, 0, 1.f}; GETXI(); run_gemm(c, ACT, (const bf16_t*)(ws + WS_WT_CIN), 2048, E, (xi.nx == 8 && xi.nloc * 8 == (int)gridDim.x) ? xi.jr * 8 + xi.xr : (int)blockIdx.x); if (rep_ + 1 < NREP(PH_GEMM_CIN)) xcd_barrier(bar); } SEAM(PH_GEMM_CIN); }
    if (IN(PH_G1)) { for (int rep_ = 0; rep_ < NREP(PH_G1); ++rep_) { MKCTX();  griffin_pass<false>(p, c); if (rep_ + 1 < NREP(PH_G1)) xcd_barrier(bar); } SEAM(PH_G1); }
    if (IN(PH_G2)) { for (int rep_ = 0; rep_ < NREP(PH_G2); ++rep_) { MKCTX();  ph_carry(p, c); if (rep_ + 1 < NREP(PH_G2)) xcd_barrier(bar); } SEAM(PH_G2); }
    if (IN(PH_G3)) { for (int rep_ = 0; rep_ < NREP(PH_G3); ++rep_) { MKCTX();  griffin_pass<true>(p, c); if (rep_ + 1 < NREP(PH_G3)) xcd_barrier(bar); } SEAM(PH_G3); }
    if (IN(PH_GEMM_OUT1)) { for (int rep_ = 0; rep_ < NREP(PH_GEMM_OUT1); ++rep_) { MKCTX();  pg8::EpiResF32 E{p.out, p.out, DM}; GETXI(); run_gemm(c, ACT, (const bf16_t*)(ws + WS_WT_COUT), DM, E, (xi.nx == 8 && xi.nloc * 8 == (int)gridDim.x) ? xi.jr * 8 + xi.xr : (int)blockIdx.x); if (rep_ + 1 < NREP(PH_GEMM_OUT1)) xcd_barrier(bar); } SEAM(PH_GEMM_OUT1); }
    if (IN(PH_NORM_F1)) { for (int rep_ = 0; rep_ < NREP(PH_NORM_F1); ++rep_) { MKCTX();
        norm_rows_bf16(p.out, p.ffn_norm + DM, ACT, c, ws + WS_XN8);
#ifdef PROBE_RT
        cvt_fp8_roundtrip_rows(p.peer_u + (size_t)NEXP * DM, (bf16_t*)(ws + WS_TAB), NEXP, c);
        cvt_fp8_roundtrip_rows(p.peer_v + (size_t)NEXP * DM, (bf16_t*)(ws + WS_TAB) + (size_t)NEXP * DM, NEXP, c);
#else
        cvt_fp8_rows(p.peer_u + (size_t)NEXP * DM, ws + WS_TAB8 + (size_t)2 * NEXP * DM, (float*)(ws + WS_SCL) + 2 * NEXP, NEXP, c);
        cvt_fp8_rows(p.peer_v + (size_t)NEXP * DM, ws + WS_TAB8 + (size_t)3 * NEXP * DM, (float*)(ws + WS_SCL) + 3 * NEXP, NEXP, c);
#endif
        if (rep_ + 1 < NREP(PH_NORM_F1)) xcd_barrier(bar); } SEAM(PH_NORM_F1); }
    if (IN(PH_GEMM_Q1)) { for (int rep_ = 0; rep_ < NREP(PH_GEMM_Q1); ++rep_) { MKCTX();  pg8::EpiBf16<0> E{PROJ, 2048, nullptr, 0, 0, 1.f}; GETXI(); run_gemm(c, ACT, (const bf16_t*)(ws + WS_WT_Q1), 2048, E, (xi.nx == 8 && xi.nloc * 8 == (int)gridDim.x) ? xi.jr * 8 + xi.xr : (int)blockIdx.x); if (rep_ + 1 < NREP(PH_GEMM_Q1)) xcd_barrier(bar); } SEAM(PH_GEMM_Q1); }
    if (IN(PH_TOPK1_1)) { for (int rep_ = 0; rep_ < NREP(PH_TOPK1_1); ++rep_) { MKCTX();  ph_topk(p, 1, c); if (rep_ + 1 < NREP(PH_TOPK1_1)) xcd_barrier(bar); } SEAM(PH_TOPK1_1); }
    if (IN(PH_PU1)) { for (int rep_ = 0; rep_ < NREP(PH_PU1); ++rep_) { MKCTX();  GETXI(); ph_peer_u2(p, 1, c, xi, (rep_ + 1 < NREP(PH_PU1)) ? PROBE_IDMASK : 0x3fff); if (rep_ + 1 < NREP(PH_PU1)) xcd_barrier(bar); } SEAM(PH_PU1); }
    if (IN(PH_PA1)) { for (int rep_ = 0; rep_ < NREP(PH_PA1); ++rep_) { MKCTX();  ph_peer_act2(p, 1, c); if (rep_ + 1 < NREP(PH_PA1)) xcd_barrier(bar); } SEAM(PH_PA1); }
    if (IN(PH_PV1)) { for (int rep_ = 0; rep_ < NREP(PH_PV1); ++rep_) { MKCTX();  GETXI(); ph_peer_v2(p, 1, c, xi, (rep_ + 1 < NREP(PH_PV1)) ? (float*)(ws + WS_S) : p.out, (rep_ + 1 < NREP(PH_PV1)) ? PROBE_IDMASK : 0x3fff); if (rep_ + 1 < NREP(PH_PV1)) xcd_barrier(bar); } SEAM(PH_PV1); }
    if (IN(PH_FINAL)) { MKCTX(); norm_rows_f32(p.out, p.final_norm, c); }
#undef IN
#undef SEAM
}

extern "C" void kernel_launch(void* const* d_in, const int* in_sizes, int n_in, void* d_out, int out_size, void* d_ws, size_t ws_size, hipStream_t stream) {
    static int grid = 0;
    if (grid == 0) {
        if (n_in != 22 || out_size != M * DM || ws_size < WS_END) { fprintf(stderr, "kernel_launch: unexpected shapes: n_in %d out %d ws %zu (need %zu)\n", n_in, out_size, ws_size, (size_t)WS_END); grid = -1; return; }
        int dev = 0, cus = 0, per_cu = 0;
        if (hipGetDevice(&dev) != hipSuccess || hipDeviceGetAttribute(&cus, hipDeviceAttributeMultiprocessorCount, dev) != hipSuccess) { grid = -1; return; }
        if (hipFuncSetAttribute((const void*)mega_fwd, hipFuncAttributeMaxDynamicSharedMemorySize, LDS_BYTES) != hipSuccess) { fprintf(stderr, "kernel_launch: hipFuncSetAttribute failed\n"); grid = -1; return; }
        if (hipOccupancyMaxActiveBlocksPerMultiprocessor(&per_cu, (const void*)mega_fwd, NTHREADS, LDS_BYTES) != hipSuccess || per_cu < 1) { fprintf(stderr, "kernel_launch: occupancy query says %d blocks per CU\n", per_cu); per_cu = 1; }
        (void)hipGetLastError();
        grid = cus;
        if (grid % 8 != 0 || grid < 32) { fprintf(stderr, "kernel_launch: unexpected CU count %d\n", cus); }
    }
    if (grid < 0) return;
    (void)hipMemsetAsync((char*)d_ws + WS_CTL, 0, CTL_ZERO_BYTES, stream);
    Params p{};
    const float** pp = (const float**)&p;
    for (int i = 0; i < 22; ++i) pp[i] = (const float*)d_in[i];
    p.out = (float*)d_out; p.ws = (unsigned char*)d_ws;
#if MK_N_LAUNCHES == 1
    p.ph_lo = 0; p.ph_hi = NPHASES;
    void* args[] = {&p};
    hipError_t e = hipLaunchCooperativeKernel((const void*)mega_fwd, dim3(grid), dim3(NTHREADS), args, LDS_BYTES, stream);
    if (e != hipSuccess) fprintf(stderr, "cooperative launch failed: %s (grid %d)\n", hipGetErrorString(e), grid);
#else
    for (int ph = 0; ph < NPHASES; ++ph) { p.ph_lo = ph; p.ph_hi = ph + 1; hipLaunchKernelGGL(mega_fwd, dim3(grid), dim3(NTHREADS), LDS_BYTES, stream, p); }
#endif
}
```

```cpp
#include <hip/hip_runtime.h>
#include <hip/hip_bf16.h>
#include <cstdio>
#include <cstdint>
#include <cmath>
namespace pg8 {
#define PG8_LAS __attribute__((address_space(3)))
typedef unsigned short bf16_t;
typedef short bf16x8 __attribute__((ext_vector_type(8)));
typedef float f32x4 __attribute__((ext_vector_type(4)));
typedef unsigned u32x4 __attribute__((ext_vector_type(4)));
constexpr int BM = 256, BK = 64, HALF = 128, HTB = HALF * BK * 2  , STAGE_BYTES = 8 * HTB, NXCD = 8, WGM = 8;

__host__ __device__ __forceinline__ int lds_byte(int r, int c) { const int st = (r >> 4) * 2 + (c >> 5), rr = r & 15, cc = c & 31, ob = rr * 64 + cc * 2; return st * 1024 + (ob ^ (((ob >> 9) & 1) << 5)); }
__host__ __device__ __forceinline__ void stage_rc(int b, int& R, int& C) { const int st = b / 1024, sb = b % 1024, swz = sb ^ (((sb >> 9) & 1) << 5); R = (st >> 1) * 16 + swz / 64; C = (st & 1) * 32 + (swz % 64) / 2; }
__host__ __device__ __forceinline__ int perm32(int rho) { const int n = rho >> 4, i = rho & 15; return 8 * (i >> 2) + 4 * n + (i & 3); }

struct Unit { int pm, pn; };
struct Gemm { const bf16_t* A; const bf16_t* Bt; int M, N, K; };

struct StaticOrder {
    int nM, nN, nwg, G, c;
    __host__ __device__ void init(int M, int N, int G_, int c_) { nM = M / BM; nN = N / BM; nwg = nM * nN; G = G_; c = c_; }
    __host__ __device__ bool next(int i, Unit& u) const {
        const long L = (long)i * G + c; if (L >= nwg) return false;
        int wgid = (int)L; { const int q = nwg / NXCD, r = nwg % NXCD, xcd = wgid % NXCD, off = wgid / NXCD; wgid = (xcd < r ? xcd * (q + 1) : r * (q + 1) + (xcd - r) * q) + off; }
        const int nig = WGM * nN, gid = wgid / nig, fm = gid * WGM, gsz = (nM - fm) < WGM ? (nM - fm) : WGM;
        u.pm = fm + ((wgid % nig) % gsz); u.pn = (wgid % nig) / gsz; return true;
    }
    __device__ __forceinline__ void a_ready(const Unit&) const {}
    __device__ __forceinline__ void done(const Unit&) const {}
};

__device__ __forceinline__ unsigned cvt_pk_bf16(float lo, float hi) { unsigned r; asm volatile("v_cvt_pk_bf16_f32 %0, %1, %2" : "=v"(r) : "v"(lo), "v"(hi)); return r; }
typedef float f32x2 __attribute__((ext_vector_type(2)));
__device__ __forceinline__ f32x2 gelu_pk(f32x2 v) {
    const f32x2 av = __builtin_elementwise_abs(v), d = av * 0.2316418882f + 1.0f;
    f32x2 t; t.x = __builtin_amdgcn_rcpf(d.x); t.y = __builtin_amdgcn_rcpf(d.y);
    f32x2 q = t * 0.5307027145f + (-0.7265760135f); q = q * t + 0.7107068705f; q = q * t + (-0.142248368f); q = q * t + 0.127414796f; q = q * t;
    const f32x2 s = (v * v) * (-0.72134752044f);
    f32x2 e; e.x = __builtin_amdgcn_exp2f(s.x); e.y = __builtin_amdgcn_exp2f(s.y);
    const f32x2 m = v * (q * e), r = v - m;
    f32x2 o; o.x = v.x < 0.f ? m.x : r.x; o.y = v.y < 0.f ? m.y : r.y; return o;
}
template <int ACT  > struct EpiBf16 {
    static constexpr bool PERM = true, AFTER_DRAIN = false; static_assert(ACT == 0 || ACT == 1, "EpiBf16: ACT is 0 (none) or 1 (gelu_pk)");
    bf16_t* O; int ldc; const float* bias; int split_cols; size_t split_stride; float scale0;
    __device__ __forceinline__ void operator()(const f32x4 (&acc)[2][2][4][2], const Unit& u, int wr, int wc, int fr, int fq) const {
        const int row0 = u.pm * BM + wr * 64 + fr; int colt = u.pn * BM; bf16_t* base = O;
        float sc = 1.f; if (split_cols) { const int t = colt / split_cols; base += (size_t)t * split_stride; colt -= t * split_cols; if (t == 0) sc = scale0; }
        const int col0 = colt + wc * 32 + 8 * fq, bcol0 = u.pn * BM + wc * 32 + 8 * fq;
        f32x4 bv[2][2];
#pragma unroll
        for (int bj = 0; bj < 2; ++bj)
#pragma unroll
            for (int n = 0; n < 2; ++n) bv[bj][n] = bias ? *(const f32x4*)(bias + bcol0 + bj * HALF + 4 * n) : (f32x4){0.f, 0.f, 0.f, 0.f};
#pragma unroll
        for (int ai = 0; ai < 2; ++ai)
#pragma unroll
            for (int m = 0; m < 4; ++m) { bf16_t* rowp = base + (size_t)(row0 + ai * HALF + m * 16) * ldc + col0;
#pragma unroll
                for (int bj = 0; bj < 2; ++bj) { f32x4 v0 = acc[ai][bj][m][0] + bv[bj][0], v1 = acc[ai][bj][m][1] + bv[bj][1];
                    if (ACT == 1) { f32x2 a = gelu_pk((f32x2){v0[0], v0[1]}), b = gelu_pk((f32x2){v0[2], v0[3]}), c = gelu_pk((f32x2){v1[0], v1[1]}), d = gelu_pk((f32x2){v1[2], v1[3]});
                        v0 = (f32x4){a.x, a.y, b.x, b.y}; v1 = (f32x4){c.x, c.y, d.x, d.y}; }
                    v0 = v0 * sc; v1 = v1 * sc; u32x4 w; w.x = cvt_pk_bf16(v0[0], v0[1]); w.y = cvt_pk_bf16(v0[2], v0[3]); w.z = cvt_pk_bf16(v1[0], v1[1]); w.w = cvt_pk_bf16(v1[2], v1[3]);
                    *(u32x4*)(rowp + bj * HALF) = w; } }
    }
};
template <class Epi, class Sched, bool ALIGN_EPI = false, bool SP2 = false>
__device__ __forceinline__ void gemm_phase(PG8_LAS unsigned char* lds, const Gemm g, const Sched& S, const Epi& E) {
    const int tid = threadIdx.x, wid = __builtin_amdgcn_readfirstlane(tid >> 6), lane = tid & 63, wr = wid >> 2, wc = wid & 3, fr = lane & 15, fq = lane >> 4;
    const int K = g.K, nt = K / BK;
    unsigned voffA[2], voffB[2];
#pragma unroll
    for (int i = 0; i < 2; ++i) { int R, C; stage_rc(tid * 16 + i * 8192, R, C); const int Rb = Epi::PERM ? ((R & ~31) + perm32(R & 31)) : R;
        voffA[i] = (unsigned)(R * K + C) * 2u; voffB[i] = (unsigned)(Rb * K + C) * 2u; }
    const size_t kstep = (size_t)(BK * 2);
    const size_t hstep = (size_t)HALF * K * 2;
    const size_t tstep = 2 * hstep;
    const unsigned ldsw = (unsigned)wid * 1024u;
    const int aoff = lds_byte(wr * 64 + fr, fq * 8), boff = lds_byte(wc * 32 + fr, fq * 8);
#define PG8_SA(b, h) (((b) * 2 + (h)) * HTB)
#define PG8_SB(b, h) ((4 + (b) * 2 + (h)) * HTB)
#define PG8_STAGE(bufoff, gbase, voff) do { _Pragma("unroll") for (int _i = 0; _i < 2; ++_i) \
        __builtin_amdgcn_global_load_lds((const unsigned*)((const char*)(gbase) + (voff)[_i]), (PG8_LAS unsigned*)(lds + (bufoff) + ldsw + _i * 8192), 16, 0, 0); } while (0)
#define PG8_LDA(dst, b, h) do { _Pragma("unroll") for (int m = 0; m < 4; ++m) _Pragma("unroll") for (int k = 0; k < 2; ++k) dst[m][k] = *(const PG8_LAS bf16x8*)(lds + PG8_SA(b, h) + aoff + m * 2048 + k * 1024); } while (0)
#define PG8_LDB(dst, b, h) do { _Pragma("unroll") for (int n = 0; n < 2; ++n) _Pragma("unroll") for (int k = 0; k < 2; ++k) dst[n][k] = *(const PG8_LAS bf16x8*)(lds + PG8_SB(b, h) + boff + n * 2048 + k * 1024); } while (0)
#define PG8_MMA(ai, bj, At, Bt) do { __builtin_amdgcn_s_setprio(1); _Pragma("unroll") for (int m = 0; m < 4; ++m) _Pragma("unroll") for (int n = 0; n < 2; ++n) _Pragma("unroll") for (int k = 0; k < 2; ++k) \
        acc[ai][bj][m][n] = __builtin_amdgcn_mfma_f32_16x16x32_bf16(Bt[n][k], At[m][k], acc[ai][bj][m][n], 0, 0, 0); __builtin_amdgcn_s_setprio(0); } while (0)
#define PG8_WAIT_V(n) asm volatile("s_waitcnt vmcnt(" #n ")" ::: "memory")
#define PG8_WAIT_L(n) asm volatile("s_waitcnt lgkmcnt(" #n ")" ::: "memory")
#define PG8_BAR __builtin_amdgcn_s_barrier()
#define PG8_SCHED __builtin_amdgcn_sched_barrier(0)
    Unit cur, nxt; int ui = 0;
    if (!S.next(0, cur)) return;
    f32x4 acc[2][2][4][2];
#pragma unroll
    for (int a = 0; a < 2; ++a)
#pragma unroll
        for (int b = 0; b < 2; ++b)
#pragma unroll
            for (int m = 0; m < 4; ++m)
#pragma unroll
                for (int n = 0; n < 2; ++n) acc[a][b][m][n] = (f32x4){0.f, 0.f, 0.f, 0.f};
    bf16x8 At[4][2], B0[2][2], B1[2][2];
    const char* cA = (const char*)g.A + (size_t)cur.pm * tstep; const char* cB = (const char*)g.Bt + (size_t)cur.pn * tstep;
    S.a_ready(cur);
    if constexpr (SP2) {
        PG8_STAGE(PG8_SB(0, 0), cB, voffB); PG8_STAGE(PG8_SB(0, 1), cB + hstep, voffB); PG8_STAGE(PG8_SA(0, 0), cA, voffA); PG8_STAGE(PG8_SA(0, 1), cA + hstep, voffA);
        if (wr == 1) PG8_BAR;
        PG8_WAIT_V(2); PG8_BAR;
        PG8_STAGE(PG8_SB(1, 0), cB + kstep, voffB); PG8_STAGE(PG8_SA(1, 0), cA + kstep, voffA); PG8_STAGE(PG8_SB(1, 1), cB + hstep + kstep, voffB);
        PG8_WAIT_V(6); PG8_BAR;
    } else {
        PG8_STAGE(PG8_SB(0, 0), cB, voffB); PG8_STAGE(PG8_SA(0, 0), cA, voffA); PG8_STAGE(PG8_SB(0, 1), cB + hstep, voffB); PG8_STAGE(PG8_SA(0, 1), cA + hstep, voffA);
        if (wr == 1) PG8_BAR;
        PG8_WAIT_V(4); PG8_BAR;
        PG8_STAGE(PG8_SB(1, 0), cB + kstep, voffB); PG8_STAGE(PG8_SA(1, 0), cA + kstep, voffA); PG8_STAGE(PG8_SB(1, 1), cB + hstep + kstep, voffB);
        PG8_WAIT_V(6); PG8_BAR;
    }
    for (;;) {
        const bool has_next = S.next(ui + 1, nxt);
        const char* nA = has_next ? (const char*)g.A + (size_t)nxt.pm * tstep : cA; const char* nB = has_next ? (const char*)g.Bt + (size_t)nxt.pn * tstep : cB;
        for (int t = 0; t < nt; t += 2) {
            const bool last = (t == nt - 2);
            const char* a1 = cA + (size_t)(t + 1) * kstep;
            const char* a2 = last ? nA : cA + (size_t)(t + 2) * kstep; const char* b2 = last ? nB : cB + (size_t)(t + 2) * kstep;
            const char* a3 = a2 + kstep; const char* b3 = b2 + kstep;
            if (last && has_next) S.a_ready(nxt);
            if constexpr (SP2) {
            PG8_LDB(B0, 0, 0); PG8_LDB(B1, 0, 1); PG8_SCHED; PG8_LDA(At, 0, 0); PG8_STAGE(PG8_SA(1, 1), a1 + hstep, voffA);
            PG8_WAIT_V(8); PG8_WAIT_L(0); PG8_BAR; PG8_MMA(0, 0, At, B0); PG8_MMA(0, 1, At, B1); PG8_BAR; PG8_SCHED;
            PG8_LDA(At, 0, 1); PG8_STAGE(PG8_SB(0, 0), b2, voffB); PG8_STAGE(PG8_SB(0, 1), b2 + hstep, voffB); PG8_STAGE(PG8_SA(0, 0), a2, voffA);
            PG8_WAIT_V(8); PG8_WAIT_L(0); PG8_BAR; PG8_MMA(1, 0, At, B0); PG8_MMA(1, 1, At, B1); PG8_BAR; PG8_SCHED;
            PG8_LDB(B0, 1, 0); PG8_LDB(B1, 1, 1); PG8_SCHED; PG8_LDA(At, 1, 0); PG8_STAGE(PG8_SA(0, 1), a2 + hstep, voffA);
            PG8_WAIT_V(8); PG8_WAIT_L(0); PG8_BAR; PG8_MMA(0, 0, At, B0); PG8_MMA(0, 1, At, B1); PG8_BAR; PG8_SCHED;
            PG8_LDA(At, 1, 1); PG8_STAGE(PG8_SB(1, 0), b3, voffB); PG8_STAGE(PG8_SB(1, 1), b3 + hstep, voffB); PG8_STAGE(PG8_SA(1, 0), a3, voffA);
            PG8_WAIT_V(8); PG8_WAIT_L(0); PG8_BAR; PG8_MMA(1, 0, At, B0); PG8_MMA(1, 1, At, B1); PG8_BAR; PG8_SCHED;
            } else {
            PG8_LDB(B0, 0, 0); PG8_SCHED; PG8_LDA(At, 0, 0); PG8_STAGE(PG8_SA(1, 1), a1 + hstep, voffA);
            PG8_WAIT_L(8); PG8_BAR; PG8_WAIT_L(0); PG8_MMA(0, 0, At, B0); PG8_BAR; PG8_SCHED;
            PG8_LDB(B1, 0, 1); PG8_STAGE(PG8_SB(0, 0), b2, voffB);
            PG8_BAR; PG8_WAIT_L(0); PG8_MMA(0, 1, At, B1); PG8_BAR;
            PG8_LDA(At, 0, 1); PG8_STAGE(PG8_SA(0, 0), a2, voffA);
            PG8_BAR; PG8_WAIT_L(0); PG8_MMA(1, 0, At, B0); PG8_BAR; PG8_SCHED;
            PG8_STAGE(PG8_SB(0, 1), b2 + hstep, voffB);
            PG8_WAIT_V(6); PG8_BAR; PG8_MMA(1, 1, At, B1); PG8_BAR;
            PG8_LDB(B0, 1, 0); PG8_SCHED; PG8_LDA(At, 1, 0); PG8_STAGE(PG8_SA(0, 1), a2 + hstep, voffA);
            PG8_WAIT_L(8); PG8_BAR; PG8_WAIT_L(0); PG8_MMA(0, 0, At, B0); PG8_BAR; PG8_SCHED;
            PG8_LDB(B1, 1, 1); PG8_STAGE(PG8_SB(1, 0), b3, voffB);
            PG8_BAR; PG8_WAIT_L(0); PG8_MMA(0, 1, At, B1); PG8_BAR;
            PG8_LDA(At, 1, 1); PG8_STAGE(PG8_SA(1, 0), a3, voffA);
            PG8_BAR; PG8_WAIT_L(0); PG8_MMA(1, 0, At, B0); PG8_BAR; PG8_SCHED;
            PG8_STAGE(PG8_SB(1, 1), b3 + hstep, voffB);
            PG8_WAIT_V(6); PG8_BAR; PG8_MMA(1, 1, At, B1); PG8_BAR;
            }
        }
        if constexpr (ALIGN_EPI) { if (wr == 0) PG8_BAR; }
        if constexpr (!Epi::AFTER_DRAIN) { E(acc, cur, wr, wc, fr, fq); S.done(cur); }
        if (!has_next) break;
#pragma unroll
        for (int a = 0; a < 2; ++a)
#pragma unroll
            for (int b = 0; b < 2; ++b)
#pragma unroll
                for (int m = 0; m < 4; ++m)
#pragma unroll
                    for (int n = 0; n < 2; ++n) acc[a][b][m][n] = (f32x4){0.f, 0.f, 0.f, 0.f};
        cur = nxt; cA = nA; cB = nB; ++ui;
        if constexpr (ALIGN_EPI) { if (wr == 1) PG8_BAR; }
    }
    PG8_WAIT_V(0);
    if constexpr (!ALIGN_EPI) { if (wr == 0) PG8_BAR; }
    PG8_BAR;
    if constexpr (Epi::AFTER_DRAIN) { E.fused(acc, cur, wr, wc, fr, fq, lds, wid, lane); S.done(cur); }
#undef PG8_SA
#undef PG8_SB
#undef PG8_STAGE
#undef PG8_LDA
#undef PG8_LDB
#undef PG8_MMA
#undef PG8_WAIT_V
#undef PG8_WAIT_L
#undef PG8_BAR
#undef PG8_SCHED
}

struct EpiResF32 {
    static constexpr bool PERM = false, AFTER_DRAIN = false;
    const float* base; float* out; int ldc;
    __device__ __forceinline__ void operator()(const f32x4 (&acc)[2][2][4][2], const Unit& u, int wr, int wc, int fr, int fq) const {
        const int col0 = u.pn * BM + wc * 32 + 4 * fq;
#pragma unroll
        for (int ai = 0; ai < 2; ++ai)
#pragma unroll
            for (int m = 0; m < 4; ++m) { const int r = ai * HALF + wr * 64 + m * 16 + fr; const size_t off = (size_t)(u.pm * BM + r) * ldc + col0;
#pragma unroll
                for (int bj = 0; bj < 2; ++bj)
#pragma unroll
                    for (int n = 0; n < 2; ++n) { const f32x4 bs = *(const f32x4*)(base + off + bj * HALF + n * 16); *(f32x4*)(out + off + bj * HALF + n * 16) = bs + acc[ai][bj][m][n]; } }
    }
};
}

constexpr int BATCH = 4, SEQ = 8192, DM = 1024, M = BATCH * SEQ;
constexpr int NIN = 3088, NIN_PAD = 3328;
constexpr int C_GQ = 0, C_GK = 256, C_GV = 512, C_GG = 1024, C_AQ = 1536, C_AK = 2048, C_AV = 2560, C_GLR = 3072;
constexpr int NEXP = 16384;
constexpr float NORM_EPS = 1e-6f;
constexpr int NWAVES = 8, NTHREADS = 512;

constexpr size_t MiB = 1u << 20;
constexpr size_t WS_CTL = 0, CTL_ZERO_BYTES = 1 * MiB;
constexpr size_t WS_WT_IN = 1 * MiB;
constexpr size_t WS_WT_OUT = 8 * MiB;
constexpr size_t WS_WT_CIN = 10 * MiB;
constexpr size_t WS_WT_COUT = 14 * MiB;
constexpr size_t WS_WT_Q0 = 16 * MiB;
constexpr size_t WS_WT_Q1 = 20 * MiB;
constexpr size_t WS_ACT = 32 * MiB;
constexpr size_t WS_S = 96 * MiB;
constexpr size_t WS_PROJ = WS_S;
constexpr size_t WS_GLAO = WS_S + 208 * MiB;
constexpr size_t WS_TOPS = WS_S + 128 * MiB;
constexpr size_t WS_TOPI = WS_S + 160 * MiB;
constexpr size_t WS_IDS = WS_S + 192 * MiB;
constexpr size_t WS_G = WS_S + 208 * MiB;
constexpr size_t WS_XC = WS_ACT;
constexpr size_t WS_A = WS_S + 128 * MiB;
constexpr size_t WS_U = WS_S + 256 * MiB;
constexpr size_t WS_TAB = 448 * MiB;
constexpr size_t WS_TAB8 = 448 * MiB;
constexpr size_t WS_WG = 24 * MiB;
constexpr size_t WS_AGG = WS_S + 128 * MiB;
constexpr size_t WS_SCL = 26 * MiB;
constexpr size_t WS_END = 512 * MiB;
constexpr int CW_BAR = 4096, CW_RANK = 8192;

constexpr int RING_BYTES = 131072;
constexpr int LDS_BYTES = 147456;
constexpr int LDSCTL_OFF = LDS_BYTES - 512, MISC_OFF = LDSCTL_OFF + 320;

#define LAS __attribute__((address_space(3)))
#define GAS __attribute__((address_space(1)))
typedef unsigned short bf16_t;
typedef float f32x4 __attribute__((ext_vector_type(4)));
typedef unsigned u32x4 __attribute__((ext_vector_type(4)));
typedef unsigned u32x2 __attribute__((ext_vector_type(2)));
typedef short bf16x8 __attribute__((ext_vector_type(8)));
typedef float f32x2 __attribute__((ext_vector_type(2)));

struct Params {
    const float *x, *mix_norm, *ffn_norm, *ab_w_in, *gla_w_alpha, *gla_b_alpha, *gla_head_gain, *ab_w_out;
    const float *c_w_in, *c_conv_w, *c_conv_b, *c_w_rgate, *c_b_rgate, *c_w_igate, *c_b_igate, *c_lambda, *c_w_out;
    const float *peer_w_query, *peer_sub_keys, *peer_u, *peer_v, *final_norm;
    float* out; unsigned char* ws;
    int ph_lo, ph_hi;
};

typedef float f32x2_cv __attribute__((ext_vector_type(2))); typedef __bf16 bf16x2_cv __attribute__((ext_vector_type(2)));
__device__ __forceinline__ unsigned pk2(float lo, float hi) { const f32x2_cv v = {lo, hi}; const bf16x2_cv b = __builtin_convertvector(v, bf16x2_cv); return __builtin_bit_cast(unsigned, b); }
__device__ __forceinline__ unsigned f2bf(float f) { return pk2(f, f) & 0xffffu; }
__device__ __forceinline__ float bf2f(bf16_t b) { return __builtin_bit_cast(float, (unsigned)b << 16); }
__device__ __forceinline__ float bflo(unsigned w) { return __builtin_bit_cast(float, w << 16); }
__device__ __forceinline__ float bfhi(unsigned w) { return __builtin_bit_cast(float, w & 0xffff0000u); }
__device__ __forceinline__ float wave_sum(float v) {
#pragma unroll
    for (int o = 1; o < 64; o <<= 1) v += __shfl_xor(v, o);
    return v;
}
__device__ __forceinline__ float gelu_tanh(float x) {
    const float x2 = x * x, u2 = x * (2.3022082f + 0.10294324f * x2);
    const float e = __builtin_amdgcn_exp2f(u2);
    return x - x * __builtin_amdgcn_rcpf(e + 1.f);
}
__device__ __forceinline__ float sigmoidf_(float x) { return __builtin_amdgcn_rcpf(1.f + __expf(-x)); }

struct Ctx { int tid, lane, wave, blk, nblk, gtid, gthreads, gwave, gwaves; LAS unsigned char* lds; };

template <class F> __device__ __forceinline__ void transpose_cvt(const float* W, int K, int Nsrc, bf16_t* WT, int Ndst, F srcmap, int gtid, int gthreads) {
    const int total = (K / 8) * Ndst;
    for (int idx = gtid; idx < total; idx += gthreads) {
        const int ko = idx / Ndst, n = idx - ko * Ndst; const int sn = srcmap(n);
        u32x4 w = {0u, 0u, 0u, 0u};
        if (sn >= 0) { const float* s = W + (size_t)(ko * 8) * Nsrc + sn;
            w.x = pk2(s[0], s[(size_t)Nsrc]); w.y = pk2(s[2 * (size_t)Nsrc], s[3 * (size_t)Nsrc]); w.z = pk2(s[4 * (size_t)Nsrc], s[5 * (size_t)Nsrc]); w.w = pk2(s[6 * (size_t)Nsrc], s[7 * (size_t)Nsrc]); }
        *(u32x4*)(WT + (size_t)n * K + ko * 8) = w;
    }
}
__device__ __forceinline__ void cvt_bf16(const float* src, bf16_t* dst, size_t n8, int gtid, int gthreads) {
    for (size_t i = gtid; i < n8; i += gthreads) { const f32x4 a = *(const f32x4*)(src + i * 8), b = *(const f32x4*)(src + i * 8 + 4);
        u32x4 w; w.x = pk2(a.x, a.y); w.y = pk2(a.z, a.w); w.z = pk2(b.x, b.y); w.w = pk2(b.z, b.w); *(u32x4*)(dst + i * 8) = w; }
}
__device__ __forceinline__ void norm_rows_bf16(const float* src, const float* gain, bf16_t* dst, const Ctx& c, unsigned char* x8 = nullptr) {
    for (int m0 = c.gwave; m0 < M; m0 += 4 * c.gwaves) {
        f32x4 v[4][4]; float s[4];
#pragma unroll
        for (int u = 0; u < 4; ++u) { const f32x4* xr = (const f32x4*)(src + (size_t)min(m0 + u * c.gwaves, M - 1) * DM) + c.lane;
#pragma unroll
            for (int j = 0; j < 4; ++j) v[u][j] = xr[64 * j]; }
#pragma unroll
        for (int u = 0; u < 4; ++u) { s[u] = 0.f;
#pragma unroll
            for (int j = 0; j < 4; ++j) s[u] += (v[u][j].x * v[u][j].x + v[u][j].y * v[u][j].y) + (v[u][j].z * v[u][j].z + v[u][j].w * v[u][j].w); }
#pragma unroll
        for (int o = 1; o < 64; o <<= 1) {
#pragma unroll
            for (int u = 0; u < 4; ++u) s[u] += __shfl_xor(s[u], o); }
#pragma unroll
        for (int u = 0; u < 4; ++u) { const int m = m0 + u * c.gwaves; if (m >= M) break; const float rstd = __builtin_amdgcn_rsqf(s[u] * (1.f / DM) + NORM_EPS);
            u32x2* o8 = (u32x2*)(dst + (size_t)m * DM) + c.lane;
#pragma unroll
            for (int j = 0; j < 4; ++j) { const f32x4 g = *((const f32x4*)gain + 64 * j + c.lane); const unsigned w0 = pk2(v[u][j].x * rstd * g.x, v[u][j].y * rstd * g.y), w1 = pk2(v[u][j].z * rstd * g.z, v[u][j].w * rstd * g.w);
                u32x2 w; w.x = w0; w.y = w1; o8[64 * j] = w;
                if (x8) {
                    const float f0 = bflo(w0), f1 = bfhi(w0), f2 = bflo(w1), f3 = bfhi(w1);
                    int hq = __builtin_amdgcn_cvt_pk_fp8_f32(f0, f1, 0, false); hq = __builtin_amdgcn_cvt_pk_fp8_f32(f2, f3, hq, true);
                    const f32x2 d0 = __builtin_amdgcn_cvt_pk_f32_fp8(hq, false), d1 = __builtin_amdgcn_cvt_pk_f32_fp8(hq, true);
                    int lq = __builtin_amdgcn_cvt_pk_fp8_f32((f0 - d0.x) * 16.f, (f1 - d0.y) * 16.f, 0, false); lq = __builtin_amdgcn_cvt_pk_fp8_f32((f2 - d1.x) * 16.f, (f3 - d1.y) * 16.f, lq, true);
                    unsigned* xo = (unsigned*)(x8 + (size_t)m * 2048) + 64 * j + c.lane; xo[0] = (unsigned)hq; xo[256] = (unsigned)lq; } } }
    }
}
__device__ __forceinline__ void norm_rows_f32(float* buf, const float* gain, const Ctx& c) {
    for (int m0 = c.gwave; m0 < M; m0 += 4 * c.gwaves) {
        f32x4 v[4][4]; float s[4];
#pragma unroll
        for (int u = 0; u < 4; ++u) { const f32x4* xr = (const f32x4*)(buf + (size_t)min(m0 + u * c.gwaves, M - 1) * DM) + c.lane;
#pragma unroll
            for (int j = 0; j < 4; ++j) v[u][j] = xr[64 * j]; }
#pragma unroll
        for (int u = 0; u < 4; ++u) { s[u] = 0.f;
#pragma unroll
            for (int j = 0; j < 4; ++j) s[u] += (v[u][j].x * v[u][j].x + v[u][j].y * v[u][j].y) + (v[u][j].z * v[u][j].z + v[u][j].w * v[u][j].w); }
#pragma unroll
        for (int o = 1; o < 64; o <<= 1) {
#pragma unroll
            for (int u = 0; u < 4; ++u) s[u] += __shfl_xor(s[u], o); }
#pragma unroll
        for (int u = 0; u < 4; ++u) { if (m0 + u * c.gwaves >= M) break; const float rstd = __builtin_amdgcn_rsqf(s[u] * (1.f / DM) + NORM_EPS); f32x4* xw = (f32x4*)(buf + (size_t)(m0 + u * c.gwaves) * DM) + c.lane;
#pragma unroll
            for (int j = 0; j < 4; ++j) { const f32x4 g = *((const f32x4*)gain + 64 * j + c.lane); xw[64 * j] = v[u][j] * rstd * g; } }
    }
}

constexpr size_t WS_GLRB = 30 * MiB;
__device__ __forceinline__ void ph_glr(const Params& p, const Ctx& c) {
    const bf16_t* XN = (const bf16_t*)(p.ws + WS_ACT); const bf16_t* WG = (const bf16_t*)(p.ws + WS_WT_IN) + (size_t)3072 * DM; bf16_t* GL = (bf16_t*)(p.ws + WS_GLRB);
    const int lane = c.lane, r = lane & 15, q = lane >> 4;
    for (int tile = c.gwave; tile < M / 16; tile += c.gwaves) {
        const bf16_t* ap = XN + (size_t)(tile * 16 + r) * DM + 8 * q; const bf16_t* bp = WG + (size_t)r * DM + 8 * q;
        f32x4 acc = {0.f, 0.f, 0.f, 0.f};
#pragma unroll 8
        for (int s2 = 0; s2 < 32; ++s2) acc = __builtin_amdgcn_mfma_f32_16x16x32_bf16(__builtin_bit_cast(bf16x8, *(const u32x4*)(ap + 32 * s2)), __builtin_bit_cast(bf16x8, *(const u32x4*)(bp + 32 * s2)), acc, 0, 0, 0);
#pragma unroll
        for (int i = 0; i < 4; ++i) GL[(size_t)(tile * 16 + 4 * q + i) * 16 + r] = (bf16_t)f2bf(acc[i]);
    }
}


constexpr int AT_K = 0, AT_V = 272 * 144, AT_END = 2 * 272 * 144;
typedef short s16x4 __attribute__((ext_vector_type(4)));
__device__ __forceinline__ s16x4 lds_tr16(LAS const unsigned char* pbyte) { return __builtin_bit_cast(s16x4, __builtin_amdgcn_ds_read_tr16_b64_v4i16((LAS s16x4*)pbyte)); }
__device__ __forceinline__ void ph_attn(const Params& p, const Ctx& c) {
    LAS unsigned char* L = c.lds;
    const bf16_t* proj = (const bf16_t*)(p.ws + WS_PROJ); bf16_t* AO = (bf16_t*)p.out; float* LSE = (float*)((unsigned char*)p.out + 96 * MiB);
    const int tid = c.tid, lane = c.lane, w = c.wave, r = lane & 15, qq = lane >> 4;
    constexpr float LOG2E = 1.4426950408889634f;
    __syncthreads();
    for (int i = tid; i < 16 * 144 / 4; i += NTHREADS) ((LAS unsigned*)(L + AT_V + 256 * 144))[i] = 0u;
    u32x4 kreg[4], vreg[4], qreg[2];
#define AT_DECODE(it_) const int h = (it_) & 7, rest = (it_) >> 3, br = rest >> 8, u = rest & 255, sh = 2 * br, dil = 1 << sh, nbm = (64 >> sh) - 1; \
        const int bres = u >> (6 - sh), blk = u & nbm, b = bres >> sh, res = bres & (dil - 1); const size_t rowb = (size_t)b * SEQ; const int l0 = blk * 128
#define AT_ISSUE(it_) do { AT_DECODE(it_); (void)br; \
        _Pragma("unroll") for (int k = 0; k < 4; ++k) { const int idx = tid + NTHREADS * k, row = idx >> 3, ch = idx & 7, l = l0 - 128 + row; kreg[k] = (u32x4){0u, 0u, 0u, 0u}; vreg[k] = kreg[k]; \
            if (l >= 0) { const bf16_t* src = proj + (rowb + (size_t)l * dil + res) * NIN_PAD + C_AK + h * 64 + ch * 8; kreg[k] = *(const u32x4*)src; vreg[k] = *(const u32x4*)(src + 512); } } \
        const bf16_t* qp = proj + (rowb + (size_t)(l0 + 16 * w + r) * dil + res) * NIN_PAD + C_AQ + h * 64 + 8 * qq; qreg[0] = *(const u32x4*)qp; qreg[1] = *(const u32x4*)(qp + 32); } while (0)
    if (c.blk < 6144) AT_ISSUE(c.blk);
    for (int item = c.blk; item < 6144; item += c.nblk) {
        AT_DECODE(item);
        __syncthreads();
#pragma unroll
        for (int k = 0; k < 4; ++k) { const int idx = tid + NTHREADS * k, row = idx >> 3, ch = idx & 7;
            *(LAS u32x4*)(L + AT_K + row * 144 + ch * 16) = kreg[k]; *(LAS u32x4*)(L + AT_V + row * 144 + ch * 16) = vreg[k]; }
        bf16x8 qf[2]; qf[0] = __builtin_bit_cast(bf16x8, qreg[0]); qf[1] = __builtin_bit_cast(bf16x8, qreg[1]);
        { const int nit = item + c.nblk; if (nit < 6144) AT_ISSUE(nit); }
        __syncthreads();
        f32x4 sa[9];
#pragma unroll
        for (int jn = 0; jn < 9; ++jn) { LAS const unsigned char* kp = L + AT_K + (16 * (w + jn) + r) * 144 + 16 * qq;
            const bf16x8 k0 = __builtin_bit_cast(bf16x8, *(const LAS u32x4*)kp), k1 = __builtin_bit_cast(bf16x8, *(const LAS u32x4*)(kp + 64));
            f32x4 z = {0.f, 0.f, 0.f, 0.f}; z = __builtin_amdgcn_mfma_f32_16x16x32_bf16(k0, qf[0], z, 0, 0, 0); sa[jn] = __builtin_amdgcn_mfma_f32_16x16x32_bf16(k1, qf[1], z, 0, 0, 0); }
        const float sc = 0.125f * LOG2E, sl = exp2f(-(float)(h + 1)) * (float)dil * LOG2E;
        const int delta0 = r + 128 - 4 * qq;
        const float b0 = -sl * (float)delta0;
        float mx = -1e30f;
        if (blk > 0) {
#pragma unroll
            for (int jn = 0; jn < 9; ++jn)
#pragma unroll
                for (int i = 0; i < 4; ++i) { const bool valid = (unsigned)(delta0 - (16 * jn + i)) <= 128u;
                    const float v = valid ? __builtin_fmaf(sa[jn][i], sc, __builtin_fmaf(sl, (float)(16 * jn + i), b0)) : -1e30f; sa[jn][i] = v; mx = fmaxf(mx, v); }
        } else {
#pragma unroll
            for (int jn = 0; jn < 9; ++jn)
#pragma unroll
                for (int i = 0; i < 4; ++i) { const bool valid = ((unsigned)(delta0 - (16 * jn + i)) <= 128u) && (16 * (w + jn) + 4 * qq + i >= 128);
                    const float v = valid ? __builtin_fmaf(sa[jn][i], sc, __builtin_fmaf(sl, (float)(16 * jn + i), b0)) : -1e30f; sa[jn][i] = v; mx = fmaxf(mx, v); }
        }
        mx = fmaxf(mx, __shfl_xor(mx, 16)); mx = fmaxf(mx, __shfl_xor(mx, 32));
        float sum = 0.f;
#pragma unroll
        for (int jn = 0; jn < 9; ++jn)
#pragma unroll
            for (int i = 0; i < 4; ++i) { const float e = __builtin_amdgcn_exp2f(sa[jn][i] - mx); sa[jn][i] = e; sum += e; }
        sum += __shfl_xor(sum, 16); sum += __shfl_xor(sum, 32);
        { const int qi = 16 * w + r; if (qq == 0) LSE[((size_t)br * M + rowb + (size_t)(l0 + qi) * dil + res) * 8 + h] = (mx + __builtin_amdgcn_logf(sum)) * (1.f / LOG2E); }
        f32x4 oa[4];
#pragma unroll
        for (int dt = 0; dt < 4; ++dt) oa[dt] = (f32x4){0.f, 0.f, 0.f, 0.f};
#pragma unroll
        for (int s2 = 0; s2 < 5; ++s2) { u32x4 pw; pw.x = pk2(sa[2 * s2][0], sa[2 * s2][1]); pw.y = pk2(sa[2 * s2][2], sa[2 * s2][3]);
            if (s2 < 4) { pw.z = pk2(sa[2 * s2 + 1][0], sa[2 * s2 + 1][1]); pw.w = pk2(sa[2 * s2 + 1][2], sa[2 * s2 + 1][3]); } else { pw.z = 0u; pw.w = 0u; }
            LAS const unsigned char* vp = L + AT_V + (16 * (w + 2 * s2) + 4 * qq + (r >> 2)) * 144 + 8 * (r & 3);
#pragma unroll
            for (int dt = 0; dt < 4; ++dt) { const s16x4 v0 = lds_tr16(vp + 32 * dt), v1 = lds_tr16(vp + 32 * dt + 16 * 144);
                const bf16x8 vf = {v0[0], v0[1], v0[2], v0[3], v1[0], v1[1], v1[2], v1[3]};
                oa[dt] = __builtin_amdgcn_mfma_f32_16x16x32_bf16(__builtin_bit_cast(bf16x8, pw), vf, oa[dt], 0, 0, 0); } }
        const float rs = __builtin_amdgcn_rcpf(sum);
        LAS bf16_t* ost = (LAS bf16_t*)(L + AT_END + w * 2304);
#pragma unroll
        for (int i = 0; i < 4; ++i) { const float ri = __shfl(rs, 4 * qq + i);
#pragma unroll
            for (int dt = 0; dt < 4; ++dt) ost[(4 * qq + i) * 72 + 16 * dt + r] = (bf16_t)f2bf(oa[dt][i] * ri); }
        asm volatile("" ::: "memory");
        { const int qi = lane >> 2, dc = (lane & 3) * 16;
          const u32x4 o0 = *(const LAS u32x4*)(ost + qi * 72 + dc), o1 = *(const LAS u32x4*)(ost + qi * 72 + dc + 8);
          bf16_t* op = AO + ((size_t)br * M + rowb + (size_t)(l0 + 16 * w + qi) * dil + res) * 512 + h * 64 + dc;
          *(u32x4*)op = o0; *(u32x4*)(op + 8) = o1; }
        asm volatile("" ::: "memory");
    }
#undef AT_DECODE
#undef AT_ISSUE
}

constexpr size_t WS_CKV = WS_S + 272 * MiB;
constexpr size_t WS_DEC = WS_S + 336 * MiB;
constexpr size_t WS_SPREV = WS_ACT;
constexpr int GL_SEGT = 0, GL_V = 2048, GL_KT = GL_V + 64 * 272, GL_QD = GL_KT + 64 * 144, GL_KI = GL_QD + 64 * 144, GL_END = GL_KI + 64 * 144;
#ifdef GLR_FROM_PROJ
#define GLR_SRC (prow0 + C_GLR), NIN_PAD
#else
#define GLR_SRC ((const bf16_t*)(p.ws + WS_GLRB) + (size_t)bn * 64 * 16), 16
#endif
__device__ __forceinline__ void gla_cumdecay(const Params& p, const Ctx& c, const bf16_t* glr0, int gstride, int h, float (&bcum)[8], float& blast) {
    LAS float* SEGT = (LAS float*)(c.lds + GL_SEGT);
    const int kk = c.tid & 63, w = c.wave;
    float wa[16];
#pragma unroll
    for (int r = 0; r < 16; ++r) wa[r] = p.gla_w_alpha[r * 256 + h * 64 + kk];
    const float ba = p.gla_b_alpha[h * 64 + kk];
    float run = 0.f;
#pragma unroll
    for (int k = 0; k < 8; ++k) { const bf16_t* pr = glr0 + (size_t)(8 * w + k) * gstride;
        const u32x4 g0 = *(const u32x4*)pr, g1 = *(const u32x4*)(pr + 8);
        float z = ba + bflo(g0.x) * wa[0] + bfhi(g0.x) * wa[1] + bflo(g0.y) * wa[2] + bfhi(g0.y) * wa[3] + bflo(g0.z) * wa[4] + bfhi(g0.z) * wa[5] + bflo(g0.w) * wa[6] + bfhi(g0.w) * wa[7]
                     + bflo(g1.x) * wa[8] + bfhi(g1.x) * wa[9] + bflo(g1.y) * wa[10] + bfhi(g1.y) * wa[11] + bflo(g1.z) * wa[12] + bfhi(g1.z) * wa[13] + bflo(g1.w) * wa[14] + bfhi(g1.w) * wa[15];
        const float ls = fminf(z, 0.f) - __logf(1.f + __expf(-fabsf(z)));
        run += ls * (1.f / 16.f); bcum[k] = run; }
    __syncthreads();
    SEGT[w * 64 + kk] = run;
    __syncthreads();
    float off = 0.f, tot = 0.f;
#pragma unroll
    for (int sg = 0; sg < 8; ++sg) { const float v = SEGT[sg * 64 + kk]; off += (sg < w) ? v : 0.f; tot += v; }
#pragma unroll
    for (int k = 0; k < 8; ++k) bcum[k] += off;
    blast = tot;
}
__device__ __forceinline__ void gla_stage_v(const Ctx& c, const bf16_t* prow0, int h) {
#pragma unroll
    for (int k = 0; k < 2; ++k) { const int idx = c.tid + NTHREADS * k, row = idx >> 4, ch = idx & 15;
        *(LAS u32x4*)(c.lds + GL_V + row * 272 + ch * 16) = *(const u32x4*)(prow0 + (size_t)row * NIN_PAD + C_GV + h * 128 + ch * 8); }
}
__device__ __forceinline__ void ph_gla_a(const Params& p, const Ctx& c) {
    LAS unsigned char* L = c.lds; const bf16_t* proj = (const bf16_t*)(p.ws + WS_PROJ);
    float* CKV = (float*)(p.ws + WS_CKV); float* DEC = (float*)(p.ws + WS_DEC);
    const int tid = c.tid, lane = c.lane, w = c.wave, r = lane & 15, qq = lane >> 4, kk = tid & 63;
    for (int item = c.blk; item < 2048; item += c.nblk) {
        const int h = item & 3, bn = item >> 2; const bf16_t* prow0 = proj + (size_t)bn * 64 * NIN_PAD;
        float bcum[8], blast; gla_cumdecay(p, c, GLR_SRC, h, bcum, blast);
        gla_stage_v(c, prow0, h);
        { u32x4 o; float e[8];
#pragma unroll
          for (int k = 0; k < 8; ++k) e[k] = bf2f(prow0[(size_t)(8 * w + k) * NIN_PAD + C_GK + h * 64 + kk]) * __expf(blast - bcum[k]);
          o.x = pk2(e[0], e[1]); o.y = pk2(e[2], e[3]); o.z = pk2(e[4], e[5]); o.w = pk2(e[6], e[7]);
          *(LAS u32x4*)(L + GL_KT + kk * 144 + 16 * w) = o; }
        if (w == 0) DEC[(size_t)item * 64 + kk] = __expf(blast);
        __syncthreads();
        f32x4 acc[4];
#pragma unroll
        for (int n = 0; n < 4; ++n) acc[n] = (f32x4){0.f, 0.f, 0.f, 0.f};
#pragma unroll
        for (int s2 = 0; s2 < 2; ++s2) { LAS const unsigned char* vp = L + GL_V + (32 * s2 + 8 * qq + (r >> 2)) * 272 + (16 * w + 4 * (r & 3)) * 2;
            const s16x4 v0 = lds_tr16(vp), v1 = lds_tr16(vp + 4 * 272); const bf16x8 af = {v0[0], v0[1], v0[2], v0[3], v1[0], v1[1], v1[2], v1[3]};
#pragma unroll
            for (int n = 0; n < 4; ++n) { const bf16x8 bfr = __builtin_bit_cast(bf16x8, *(const LAS u32x4*)(L + GL_KT + (16 * n + r) * 144 + (32 * s2 + 8 * qq) * 2));
                acc[n] = __builtin_amdgcn_mfma_f32_16x16x32_bf16(af, bfr, acc[n], 0, 0, 0); } }
        float* outp = CKV + (size_t)item * 8192 + (16 * w + 4 * qq) * 64 + r;
#pragma unroll
        for (int n = 0; n < 4; ++n)
#pragma unroll
            for (int i = 0; i < 4; ++i) outp[i * 64 + 16 * n] = acc[n][i];
    }
}
__device__ __forceinline__ void ph_gla_b(const Params& p, const Ctx& c) {
    const float* CKV = (const float*)(p.ws + WS_CKV); const float* DEC = (const float*)(p.ws + WS_DEC); bf16_t* SP = (bf16_t*)(p.ws + WS_SPREV);
    for (int idx = c.gtid; idx < 16 * 8192; idx += c.gthreads) { const int bh = idx >> 13, e = idx & 8191, b = bh >> 2, h = bh & 3; float S = 0.f;
        for (int n0 = 0; n0 < 128; n0 += 8) { float cv[8], dv[8];
#pragma unroll
            for (int k = 0; k < 8; ++k) { const size_t item = (size_t)(b * 128 + n0 + k) * 4 + h; cv[k] = CKV[item * 8192 + e]; dv[k] = DEC[item * 64 + (e & 63)]; }
#pragma unroll
            for (int k = 0; k < 8; ++k) { const size_t item = (size_t)(b * 128 + n0 + k) * 4 + h; SP[item * 8192 + e] = (bf16_t)f2bf(S); S = dv[k] * S + cv[k]; } } }
}
__device__ __forceinline__ void ph_gla_c(const Params& p, const Ctx& c) {
    LAS unsigned char* L = c.lds; const bf16_t* proj = (const bf16_t*)(p.ws + WS_PROJ); const bf16_t* SP = (const bf16_t*)(p.ws + WS_SPREV); float* go = (float*)(p.ws + WS_GLAO);
    const int tid = c.tid, lane = c.lane, w = c.wave, r = lane & 15, qq = lane >> 4, kk = tid & 63;
    for (int item = c.blk; item < 2048; item += c.nblk) {
        const int h = item & 3, bn = item >> 2; const bf16_t* prow0 = proj + (size_t)bn * 64 * NIN_PAD;
        float bcum[8], blast; gla_cumdecay(p, c, GLR_SRC, h, bcum, blast);
        gla_stage_v(c, prow0, h);
#pragma unroll
        for (int k = 0; k < 8; ++k) { const int i = 8 * w + k; const bf16_t* pr = prow0 + (size_t)i * NIN_PAD;
            const float qv = bf2f(pr[C_GQ + h * 64 + kk]) * 0.125f * __expf(bcum[k]), kv = bf2f(pr[C_GK + h * 64 + kk]) * __expf(-bcum[k]);
            *(LAS bf16_t*)(L + GL_QD + i * 144 + kk * 2) = (bf16_t)f2bf(qv); *(LAS bf16_t*)(L + GL_KI + i * 144 + kk * 2) = (bf16_t)f2bf(kv); }
        __syncthreads();
        const int it = w & 3, vh = w >> 2;
        bf16x8 qf[2];
#pragma unroll
        for (int s2 = 0; s2 < 2; ++s2) qf[s2] = __builtin_bit_cast(bf16x8, *(const LAS u32x4*)(L + GL_QD + (16 * it + r) * 144 + (32 * s2 + 8 * qq) * 2));
        u32x2 pw[4];
#pragma unroll
        for (int jt = 0; jt < 4; ++jt) { f32x4 z = {0.f, 0.f, 0.f, 0.f};
            if (jt <= it) {
#pragma unroll
                for (int s2 = 0; s2 < 2; ++s2) { const bf16x8 kf = __builtin_bit_cast(bf16x8, *(const LAS u32x4*)(L + GL_KI + (16 * jt + r) * 144 + (32 * s2 + 8 * qq) * 2));
                    z = __builtin_amdgcn_mfma_f32_16x16x32_bf16(kf, qf[s2], z, 0, 0, 0); }
#pragma unroll
                for (int ii = 0; ii < 4; ++ii) z[ii] = (16 * jt + 4 * qq + ii <= 16 * it + r) ? z[ii] : 0.f; }
            pw[jt].x = pk2(z[0], z[1]); pw[jt].y = pk2(z[2], z[3]); }
        f32x4 acc[4];
#pragma unroll
        for (int n = 0; n < 4; ++n) acc[n] = (f32x4){0.f, 0.f, 0.f, 0.f};
#pragma unroll
        for (int s2 = 0; s2 < 2; ++s2) { if (2 * s2 <= it) {
            const u32x4 pq = {pw[2 * s2].x, pw[2 * s2].y, pw[2 * s2 + 1].x, pw[2 * s2 + 1].y};
            LAS const unsigned char* vp = L + GL_V + (32 * s2 + 4 * qq + (r >> 2)) * 272 + (64 * vh + 4 * (r & 3)) * 2;
#pragma unroll
            for (int n = 0; n < 4; ++n) { const s16x4 v0 = lds_tr16(vp + 32 * n), v1 = lds_tr16(vp + 32 * n + 16 * 272);
                const bf16x8 vf = {v0[0], v0[1], v0[2], v0[3], v1[0], v1[1], v1[2], v1[3]};
                acc[n] = __builtin_amdgcn_mfma_f32_16x16x32_bf16(__builtin_bit_cast(bf16x8, pq), vf, acc[n], 0, 0, 0); } } }
#pragma unroll
        for (int s2 = 0; s2 < 2; ++s2)
#pragma unroll
            for (int n = 0; n < 4; ++n) { const bf16x8 sf = __builtin_bit_cast(bf16x8, *(const u32x4*)(SP + (size_t)item * 8192 + (64 * vh + 16 * n + r) * 64 + 32 * s2 + 8 * qq));
                acc[n] = __builtin_amdgcn_mfma_f32_16x16x32_bf16(qf[s2], sf, acc[n], 0, 0, 0); }
        float* outp = go + ((size_t)bn * 64 + 16 * it + 4 * qq) * 512 + h * 128 + 64 * vh + r;
#pragma unroll
        for (int n = 0; n < 4; ++n)
#pragma unroll
            for (int ii = 0; ii < 4; ++ii) outp[ii * 512 + 16 * n] = acc[n][ii];
    }
}
#ifndef ATT_COMBINE
#define ATT_COMBINE 1
#endif
__device__ __forceinline__ void ph_mix(const Params& p, const Ctx& c) {
    const bf16_t* proj = (const bf16_t*)(p.ws + WS_PROJ); const float* go = (const float*)(p.ws + WS_GLAO); bf16_t* mixed = (bf16_t*)(p.ws + WS_ACT);
    for (int m = c.gwave; m < M; m += c.gwaves) {
#pragma unroll
        for (int h = 0; h < 4; ++h) { const int col = h * 128 + 2 * c.lane;
            const float o0 = go[(size_t)m * 512 + col], o1 = go[(size_t)m * 512 + col + 1];
            const float rstd = 1.f / sqrtf(wave_sum(o0 * o0 + o1 * o1) * (1.f / 128.f) + NORM_EPS);
            const unsigned gw = *(const unsigned*)(proj + (size_t)m * NIN_PAD + C_GG + col); const float g0 = bflo(gw), g1 = bfhi(gw);
            const float r0 = o0 * rstd * p.gla_head_gain[col] * (g0 * sigmoidf_(g0)), r1 = o1 * rstd * p.gla_head_gain[col + 1] * (g1 * sigmoidf_(g1));
            *(unsigned*)(mixed + (size_t)m * DM + col) = pk2(r0, r1); }
        if (ATT_COMBINE) {
            const bf16_t* AO = (const bf16_t*)p.out; const float* LSE = (const float*)((const unsigned char*)p.out + 96 * MiB); const int hh = c.lane >> 3;
            const float l0 = LSE[((size_t)0 * M + m) * 8 + hh], l1 = LSE[((size_t)1 * M + m) * 8 + hh], l2 = LSE[((size_t)2 * M + m) * 8 + hh];
            const float lm = fmaxf(l0, fmaxf(l1, l2)), e0 = __expf(l0 - lm), e1 = __expf(l1 - lm), e2 = __expf(l2 - lm), rd = __builtin_amdgcn_rcpf(e0 + e1 + e2);
            const float w0 = e0 * rd, w1 = e1 * rd, w2 = e2 * rd;
            const u32x4 a0 = *((const u32x4*)(AO + ((size_t)0 * M + m) * 512) + c.lane), a1 = *((const u32x4*)(AO + ((size_t)1 * M + m) * 512) + c.lane), a2 = *((const u32x4*)(AO + ((size_t)2 * M + m) * 512) + c.lane);
            u32x4 o;
            o.x = pk2(w0 * bflo(a0.x) + w1 * bflo(a1.x) + w2 * bflo(a2.x), w0 * bfhi(a0.x) + w1 * bfhi(a1.x) + w2 * bfhi(a2.x));
            o.y = pk2(w0 * bflo(a0.y) + w1 * bflo(a1.y) + w2 * bflo(a2.y), w0 * bfhi(a0.y) + w1 * bfhi(a1.y) + w2 * bfhi(a2.y));
            o.z = pk2(w0 * bflo(a0.z) + w1 * bflo(a1.z) + w2 * bflo(a2.z), w0 * bfhi(a0.z) + w1 * bfhi(a1.z) + w2 * bfhi(a2.z));
            o.w = pk2(w0 * bflo(a0.w) + w1 * bflo(a1.w) + w2 * bflo(a2.w), w0 * bfhi(a0.w) + w1 * bfhi(a1.w) + w2 * bfhi(a2.w));
            *((u32x4*)(mixed + (size_t)m * DM + 512) + c.lane) = o; }
    }
}


constexpr int GR_WGT = 0, GR_XC = 65536, GR_A = 81920, GR_U = 115712, GR_SEG = 132608, GR_CW = 136704, GR_GB = 139264;
__device__ __forceinline__ float fast_sigmoid(float x) { return __builtin_amdgcn_rcpf(1.f + __expf(-x)); }
template <bool FULL> __device__ __forceinline__ void griffin_pass(const Params& p, const Ctx& c) {
    LAS unsigned char* L = c.lds;
    const int tid = c.tid, lane = c.lane, wave = c.wave, g = c.blk & 7;
    const bf16_t* proj = (const bf16_t*)(p.ws + WS_PROJ); bf16_t* yout = (bf16_t*)(p.ws + WS_ACT);
    float* AGA = (float*)(p.ws + WS_AGG); float* AGH = AGA + BATCH * 128 * 1024; const float* CAR = AGH + BATCH * 128 * 1024;
    LAS float* A_ = (LAS float*)(L + GR_A); LAS bf16_t* U_ = (LAS bf16_t*)(L + GR_U); LAS float* SEG = (LAS float*)(L + GR_SEG); LAS float* CW = (LAS float*)(L + GR_CW); LAS float* GB = (LAS float*)(L + GR_GB);
    __syncthreads();
    { const bf16_t* wg = (const bf16_t*)(p.ws + WS_WG);
      for (int ch = tid; ch < 4096; ch += NTHREADS) { const int gate = ch >> 11, j = (ch >> 4) & 127, cc = ch & 15;
          const u32x4 v = *(const u32x4*)(wg + ((size_t)(gate * 8 + g) * 128 + j) * 128 + cc * 8);
          *(LAS u32x4*)(L + GR_WGT + gate * 32768 + j * 256 + ((cc ^ (j & 15)) << 4)) = v; }
      if (tid < 128) { const int ch = g * 128 + tid;
#pragma unroll
          for (int jj = 0; jj < 4; ++jj) CW[jj * 128 + tid] = p.c_conv_w[jj * 1024 + ch];
          CW[4 * 128 + tid] = p.c_conv_b[ch]; GB[tid] = p.c_b_rgate[ch]; GB[128 + tid] = p.c_b_igate[ch];
          const float lam = p.c_lambda[ch]; GB[256 + tid] = fmaxf(-lam, 0.f) + log1pf(expf(-fabsf(lam))); } }
    __syncthreads();
    const int nslot = BATCH * 128, sstep = c.nblk >> 3;
    u32x4 xr[5];
#define GR_XLOAD(sl_) do { const int b_ = (sl_) >> 7, t0_ = ((sl_) & 127) * 64; const size_t r0_ = (size_t)b_ * SEQ + t0_; const int co_ = tid & 15, tp_ = tid >> 4; \
        _Pragma("unroll") for (int jj = 0; jj < 5; ++jj) { const int tt = t0_ + 2 * tp_ - 3 + jj; xr[jj] = (u32x4){0u, 0u, 0u, 0u}; \
            if (tt >= 0) xr[jj] = *(const u32x4*)(proj + (r0_ + 2 * tp_ - 3 + jj) * 2048 + 1024 + g * 128 + co_ * 8); } } while (0)
    if ((c.blk >> 3) < nslot) GR_XLOAD(c.blk >> 3);
    for (int slot = c.blk >> 3; slot < nslot; slot += sstep) {
        const int b = slot >> 7, tile = slot & 127, t0 = tile * 64; const size_t row0 = (size_t)b * SEQ + t0;
        u32x4 gpre[2];
        if (FULL) { const int co = tid & 15, tp = tid >> 4;
#pragma unroll
            for (int tl = 0; tl < 2; ++tl) gpre[tl] = *(const u32x4*)(proj + (row0 + 2 * tp + tl) * 2048 + g * 128 + co * 8); }
        { const int co = tid & 15, tp = tid >> 4;
          f32x4 w[5][2];
#pragma unroll
          for (int jj = 0; jj < 5; ++jj) { w[jj][0] = *(const LAS f32x4*)(CW + jj * 128 + co * 8); w[jj][1] = *(const LAS f32x4*)(CW + jj * 128 + co * 8 + 4); }
#pragma unroll
          for (int tl = 0; tl < 2; ++tl) { float a8[8];
#pragma unroll
              for (int e = 0; e < 8; ++e) a8[e] = w[4][e >> 2][e & 3];
#pragma unroll
              for (int jj = 0; jj < 4; ++jj) { const u32x4 xv = xr[tl + jj]; const unsigned xw[4] = {xv.x, xv.y, xv.z, xv.w};
#pragma unroll
                  for (int e = 0; e < 8; ++e) { const float xe = (e & 1) ? bfhi(xw[e >> 1]) : bflo(xw[e >> 1]); a8[e] += w[jj][e >> 2][e & 3] * xe; } }
              const int t = 2 * tp + tl; u32x4 o; o.x = pk2(a8[0], a8[1]); o.y = pk2(a8[2], a8[3]); o.z = pk2(a8[4], a8[5]); o.w = pk2(a8[6], a8[7]);
              *(LAS u32x4*)(L + GR_XC + t * 256 + ((co ^ (t & 15)) << 4)) = o; } }
        if (slot + sstep < nslot) GR_XLOAD(slot + sstep);
        __syncthreads();
        { const int tt = wave & 3, jh = wave >> 2, r = lane & 15, q = lane >> 4, t = 16 * tt + r;
          f32x4 ar[4], ai[4];
#pragma unroll
          for (int n = 0; n < 4; ++n) { ar[n] = (f32x4){0.f, 0.f, 0.f, 0.f}; ai[n] = (f32x4){0.f, 0.f, 0.f, 0.f}; }
#pragma unroll
          for (int s = 0; s < 4; ++s) { const bf16x8 xb = __builtin_bit_cast(bf16x8, *(const LAS u32x4*)(L + GR_XC + t * 256 + (((4 * s + q) ^ (t & 15)) << 4)));
#pragma unroll
              for (int n = 0; n < 4; ++n) { const int j = 64 * jh + 16 * n + r;
                  const bf16x8 wr = __builtin_bit_cast(bf16x8, *(const LAS u32x4*)(L + GR_WGT + j * 256 + (((4 * s + q) ^ (j & 15)) << 4)));
                  const bf16x8 wi = __builtin_bit_cast(bf16x8, *(const LAS u32x4*)(L + GR_WGT + 32768 + j * 256 + (((4 * s + q) ^ (j & 15)) << 4)));
                  ar[n] = __builtin_amdgcn_mfma_f32_16x16x32_bf16(wr, xb, ar[n], 0, 0, 0); ai[n] = __builtin_amdgcn_mfma_f32_16x16x32_bf16(wi, xb, ai[n], 0, 0, 0); } }
#pragma unroll
          for (int n = 0; n < 4; ++n) { const int j0 = 64 * jh + 16 * n + 4 * q;
              const f32x4 br = *(const LAS f32x4*)(GB + j0), bi = *(const LAS f32x4*)(GB + 128 + j0), sp = *(const LAS f32x4*)(GB + 256 + j0);
              const u32x2 xw = *(const LAS u32x2*)(L + GR_XC + t * 256 + ((((j0 >> 3) ^ (t & 15)) << 4) + (j0 & 7) * 2));
              const float xc[4] = {bflo(xw.x), bfhi(xw.x), bflo(xw.y), bfhi(xw.y)};
              f32x4 av; float uv[4];
#pragma unroll
              for (int i = 0; i < 4; ++i) { const float rr = fast_sigmoid(ar[n][i] + br[i]), ii = fast_sigmoid(ai[n][i] + bi[i]);
                  const float a = __expf(-8.f * rr * sp[i]); av[i] = a; uv[i] = __builtin_amdgcn_sqrtf(fmaxf(1.f - a * a, 0.f)) * (ii * xc[i]); }
              *(LAS f32x4*)(A_ + t * 132 + j0) = av; u32x2 uo; uo.x = pk2(uv[0], uv[1]); uo.y = pk2(uv[2], uv[3]); *(LAS u32x2*)(U_ + t * 132 + j0) = uo; } }
        __syncthreads();
        const int j = tid & 127, seg = tid >> 7;
        { float aa = 1.f, hh = 0.f;
#pragma unroll
          for (int i = 0; i < 16; ++i) { const int t = seg * 16 + i; const float a = A_[t * 132 + j], u = bf2f(U_[t * 132 + j]); hh = a * hh + u; aa *= a; }
          SEG[seg * 128 + j] = aa; SEG[512 + seg * 128 + j] = hh; }
        __syncthreads();
        if (!FULL) {
            if (tid < 128) { float A = 1.f, H = 0.f;
#pragma unroll
                for (int sgi = 0; sgi < 4; ++sgi) { H = SEG[sgi * 128 + tid] * H + SEG[512 + sgi * 128 + tid]; A *= SEG[sgi * 128 + tid]; }
                const size_t e = ((size_t)b * 128 + tile) * 1024 + g * 128 + tid; AGA[e] = A; AGH[e] = H; }
        } else {
            float h = CAR[((size_t)b * 128 + tile) * 1024 + g * 128 + j];
            for (int sgi = 0; sgi < seg; ++sgi) h = SEG[sgi * 128 + j] * h + SEG[512 + sgi * 128 + j];
#pragma unroll
            for (int i = 0; i < 16; ++i) { const int t = seg * 16 + i; const float a = A_[t * 132 + j], u = bf2f(U_[t * 132 + j]); h = a * h + u; A_[t * 132 + j] = h; }
            __syncthreads();
            { const int co = tid & 15, tp = tid >> 4;
#pragma unroll
              for (int tl = 0; tl < 2; ++tl) { const int t = 2 * tp + tl;
                  const f32x4 h0 = *(const LAS f32x4*)(A_ + t * 132 + co * 8), h1 = *(const LAS f32x4*)(A_ + t * 132 + co * 8 + 4);
                  const u32x4 gw = gpre[tl];
                  u32x4 o; o.x = pk2(gelu_tanh(bflo(gw.x)) * h0.x, gelu_tanh(bfhi(gw.x)) * h0.y); o.y = pk2(gelu_tanh(bflo(gw.y)) * h0.z, gelu_tanh(bfhi(gw.y)) * h0.w);
                  o.z = pk2(gelu_tanh(bflo(gw.z)) * h1.x, gelu_tanh(bfhi(gw.z)) * h1.y); o.w = pk2(gelu_tanh(bflo(gw.w)) * h1.z, gelu_tanh(bfhi(gw.w)) * h1.w);
                  *(u32x4*)(yout + (row0 + t) * DM + g * 128 + co * 8) = o; } }
        }
    }
#undef GR_XLOAD
}
__device__ __forceinline__ void ph_carry(const Params& p, const Ctx& c) {
    const float* AGA = (const float*)(p.ws + WS_AGG); const float* AGH = AGA + BATCH * 128 * 1024; float* CAR = (float*)(AGH + BATCH * 128 * 1024);
    for (int idx = c.gtid; idx < BATCH * 1024; idx += c.gthreads) { const int b = idx >> 10, ch = idx & 1023; float cy = 0.f;
        for (int t0 = 0; t0 < 128; t0 += 8) { float a[8], h[8];
#pragma unroll
            for (int k = 0; k < 8; ++k) { const size_t e = ((size_t)b * 128 + t0 + k) * 1024 + ch; a[k] = AGA[e]; h[k] = AGH[e]; }
#pragma unroll
            for (int k = 0; k < 8; ++k) { CAR[((size_t)b * 128 + t0 + k) * 1024 + ch] = cy; cy = a[k] * cy + h[k]; } } }
}
__device__ __forceinline__ void cvt_gate_weights(const Params& p, const Ctx& c) {
    bf16_t* wg = (bf16_t*)(p.ws + WS_WG);
    for (int idx = c.gtid; idx < 2 * 8 * 16 * 128; idx += c.gthreads) { const int j = idx & 127, io = (idx >> 7) & 15, g = (idx >> 11) & 7, gate = idx >> 14;
        const float* s = (gate ? p.c_w_igate : p.c_w_rgate) + (size_t)g * 16384 + (io * 8) * 128 + j;
        u32x4 w; w.x = pk2(s[0], s[128]); w.y = pk2(s[256], s[384]); w.z = pk2(s[512], s[640]); w.w = pk2(s[768], s[896]);
        *(u32x4*)(wg + ((size_t)(gate * 8 + g) * 128 + j) * 128 + io * 8) = w; }
}


constexpr size_t WS_SK = 25 * MiB;
constexpr int TK_SK = 0, TK_Q = 69632, TK_S = 86528, TK_L = 119552  , TK_O = 135936, TK_TAB = 144128;
typedef int i32x4 __attribute__((ext_vector_type(4)));
__device__ __forceinline__ int key_xform(int b) { return b ^ ((b >> 31) & 0x7fffffff); }
#define CEX(a, b) do { const int hi_ = max((a), (b)), lo_ = min((a), (b)); (a) = hi_; (b) = lo_; } while (0)
__device__ __forceinline__ void bitonic_merge16_desc(int (&v)[16]) {
#pragma unroll
    for (int j = 8; j >= 1; j >>= 1)
#pragma unroll
        for (int i = 0; i < 16; ++i) if ((i & j) == 0) CEX(v[i], v[i | j]);
}
__device__ __forceinline__ void bitonic_sort16_desc(int (&v)[16]) {
#pragma unroll
    for (int k = 2; k <= 16; k <<= 1)
#pragma unroll
        for (int j = k >> 1; j >= 1; j >>= 1)
#pragma unroll
            for (int i = 0; i < 16; ++i) { const int l = i ^ j; if (l > i) { if ((i & k) == 0 || k == 16) CEX(v[i], v[l]); else CEX(v[l], v[i]); } }
}
__device__ __forceinline__ void ph_topk(const Params& p, int layer, const Ctx& c) {
    LAS unsigned char* L = c.lds; const bf16_t* Q = (const bf16_t*)(p.ws + WS_PROJ);
    int* ids = (int*)(p.ws + WS_IDS); float* gg = (float*)(p.ws + WS_G);
    const int tid = c.tid, lane = c.lane, w = c.wave, r = lane & 15, qq = lane >> 4, h = c.blk & 7;
    LAS float* S = (LAS float*)(L + TK_S); LAS int* LST = (LAS int*)(L + TK_L); LAS int* OUTK = (LAS int*)(L + TK_O); LAS int* TAB = (LAS int*)(L + TK_TAB);
    __syncthreads();
    { const bf16_t* sk = (const bf16_t*)(p.ws + WS_SK) + ((size_t)layer * 8 + h) * 2 * 128 * 128;
      for (int ch = tid; ch < 4096; ch += NTHREADS) { const int row = ch >> 4, cc = ch & 15;
          *(LAS u32x4*)(L + TK_SK + row * 272 + cc * 16) = *(const u32x4*)(sk + (size_t)row * 128 + cc * 8); }
      if (tid < 64) { int cnt = 0, code = -1;
          for (int i = 0; i < 16; ++i) for (int j = 0; j < 16 / (i + 1); ++j) { if (cnt == tid) code = i * 16 + j; ++cnt; }
          TAB[tid] = code; } }
    const int nslot = M / 32, sstep = c.nblk >> 3;
    u32x4 qpre[2];
#define TK_QLOAD(sl_) do { _Pragma("unroll") for (int k = 0; k < 2; ++k) { const int idx = tid + NTHREADS * k, row = idx >> 5, ch = idx & 31; \
        qpre[k] = *(const u32x4*)(Q + (size_t)(min((sl_), nslot - 1) * 32 + row) * 2048 + h * 256 + ch * 8); } } while (0)
#define TK_MERGE(CTRL) do { int o_[16]; _Pragma("unroll") for (int i = 0; i < 16; ++i) o_[i] = __builtin_amdgcn_update_dpp(0, v[15 - i], (CTRL), 0xf, 0xf, false); \
        _Pragma("unroll") for (int i = 0; i < 16; ++i) v[i] = max(v[i], o_[i]); bitonic_merge16_desc(v); } while (0)
    TK_QLOAD(c.blk >> 3);
    int gfirst = 0, gi = 0;
    for (int slot = c.blk >> 3; slot < nslot; slot += sstep) {
        __syncthreads();
#pragma unroll
        for (int k = 0; k < 2; ++k) { const int idx = tid + NTHREADS * k, row = idx >> 5, ch = idx & 31; *(LAS u32x4*)(L + TK_Q + row * 528 + ch * 16) = qpre[k]; }
        TK_QLOAD(slot + sstep);
        __syncthreads();
        { const int pp = w >> 2, mt = (w >> 1) & 1, nh = w & 1;
          f32x4 acc[4];
#pragma unroll
          for (int nt = 0; nt < 4; ++nt) acc[nt] = (f32x4){0.f, 0.f, 0.f, 0.f};
#pragma unroll
          for (int s2 = 0; s2 < 4; ++s2) { const bf16x8 af = __builtin_bit_cast(bf16x8, *(const LAS u32x4*)(L + TK_Q + (16 * mt + r) * 528 + (pp * 128 + 32 * s2 + 8 * qq) * 2));
#pragma unroll
              for (int nt = 0; nt < 4; ++nt) { const bf16x8 bfr = __builtin_bit_cast(bf16x8, *(const LAS u32x4*)(L + TK_SK + (pp * 128 + 16 * (4 * nh + nt) + r) * 272 + (32 * s2 + 8 * qq) * 2));
                  acc[nt] = __builtin_amdgcn_mfma_f32_16x16x32_bf16(af, bfr, acc[nt], 0, 0, 0); } }
#pragma unroll
          for (int nt = 0; nt < 4; ++nt)
#pragma unroll
              for (int i = 0; i < 4; ++i) S[(pp * 32 + 16 * mt + 4 * qq + i) * 129 + 16 * (4 * nh + nt) + r] = acc[nt][i]; }
        __syncthreads();
        {
          const int m = tid >> 4, sub = tid & 15, pp = sub >> 3, part = sub & 7; int v[16];
#pragma unroll
          for (int k = 0; k < 16; ++k) { const int n = 8 * k + part; v[k] = key_xform((__builtin_bit_cast(int, S[(pp * 32 + m) * 129 + n]) & ~127) | n); }
          bitonic_sort16_desc(v);
          TK_MERGE(0xB1);
          TK_MERGE(0x4E);
          TK_MERGE(0x141);
          if (part == 0) {
#pragma unroll
              for (int k = 0; k < 16; ++k) LST[((gi * 32 + m) * 2 + pp) * 16 + k] = key_xform(v[k]); } }
        if (gi == 0) gfirst = slot;
        ++gi;
        if (gi < 4 && slot + sstep < nslot) continue;
        __syncthreads();
        {
          const int tq = tid >> 2, sub = tid & 3, grp = tq >> 5, m = tq & 31;
          if (grp < gi) {
              const int slot_g = gfirst + grp * sstep;
              LAS const int* L1 = LST + (tq * 2 + 0) * 16; LAS const int* L2 = LST + (tq * 2 + 1) * 16;
              int v[16];
#pragma unroll
              for (int k = 0; k < 16; ++k) { const int ci = sub * 16 + k; const int code = TAB[ci]; int key = (int)0x80000000;
                  if (code >= 0) { const float s1 = __builtin_bit_cast(float, L1[code >> 4] & ~127), s2v = __builtin_bit_cast(float, L2[code & 15] & ~127);
                      key = key_xform((__builtin_bit_cast(int, s1 + s2v) & ~63) | (63 - ci)); }
                  v[k] = key; }
              bitonic_sort16_desc(v);
              TK_MERGE(0xB1); TK_MERGE(0x4E);
              const float smax = __builtin_bit_cast(float, key_xform(v[0]) & ~63);
              if (sub == 0) {
#pragma unroll
                  for (int k4 = 0; k4 < 4; ++k4) *(LAS i32x4*)(OUTK + tq * 16 + 4 * k4) = (i32x4){v[4 * k4], v[4 * k4 + 1], v[4 * k4 + 2], v[4 * k4 + 3]}; }
              asm volatile("s_waitcnt lgkmcnt(0)" ::: "memory");
              const i32x4 mine = *(const LAS i32x4*)(OUTK + tq * 16 + 4 * sub);
              float e[4]; int kb[4];
#pragma unroll
              for (int j = 0; j < 4; ++j) { kb[j] = key_xform(mine[j]); e[j] = __expf(__builtin_bit_cast(float, kb[j] & ~63) - smax); }
              float den = (e[0] + e[1]) + (e[2] + e[3]);
              den += __builtin_bit_cast(float, __builtin_amdgcn_update_dpp(0, __builtin_bit_cast(int, den), 0xB1, 0xf, 0xf, false));
              den += __builtin_bit_cast(float, __builtin_amdgcn_update_dpp(0, __builtin_bit_cast(int, den), 0x4E, 0xf, 0xf, false));
              const float rden = __builtin_amdgcn_rcpf(den); i32x4 oi; f32x4 og;
#pragma unroll
              for (int j = 0; j < 4; ++j) { const int code = TAB[63 - (kb[j] & 63)]; oi[j] = (L1[code >> 4] & 127) * 128 + (L2[code & 15] & 127); og[j] = e[j] * rden; }
              const size_t o = (size_t)(slot_g * 32 + m) * 128 + h * 16 + 4 * sub;
              *(i32x4*)(ids + o) = oi; *(f32x4*)(gg + o) = og; } }
        gi = 0;
    }
#undef TK_QLOAD
#undef TK_MERGE
}


__device__ __forceinline__ float wave_max(float v) {
#pragma unroll
    for (int o = 1; o < 64; o <<= 1) v = fmaxf(v, __shfl_xor(v, o));
    return v;
}
__device__ __forceinline__ void cvt_fp8_rows(const float* src, unsigned char* dst, float* scl, int nrows, const Ctx& c) {
    for (int row = c.gwave; row < nrows; row += c.gwaves) {
        const f32x4* sp = (const f32x4*)(src + (size_t)row * DM) + 4 * c.lane; f32x4 v[4]; float mx = 0.f;
#pragma unroll
        for (int j = 0; j < 4; ++j) { v[j] = sp[j]; mx = fmaxf(mx, fmaxf(fmaxf(fabsf(v[j].x), fabsf(v[j].y)), fmaxf(fabsf(v[j].z), fabsf(v[j].w)))); }
        mx = wave_max(mx);
        const float sc = mx > 0.f ? mx * (1.f / 416.f) : 1.f, inv = 1.f / sc;
        u32x4 w; int t;
        t = __builtin_amdgcn_cvt_pk_fp8_f32(v[0].x * inv, v[0].y * inv, 0, false); t = __builtin_amdgcn_cvt_pk_fp8_f32(v[0].z * inv, v[0].w * inv, t, true); w.x = (unsigned)t;
        t = __builtin_amdgcn_cvt_pk_fp8_f32(v[1].x * inv, v[1].y * inv, 0, false); t = __builtin_amdgcn_cvt_pk_fp8_f32(v[1].z * inv, v[1].w * inv, t, true); w.y = (unsigned)t;
        t = __builtin_amdgcn_cvt_pk_fp8_f32(v[2].x * inv, v[2].y * inv, 0, false); t = __builtin_amdgcn_cvt_pk_fp8_f32(v[2].z * inv, v[2].w * inv, t, true); w.z = (unsigned)t;
        t = __builtin_amdgcn_cvt_pk_fp8_f32(v[3].x * inv, v[3].y * inv, 0, false); t = __builtin_amdgcn_cvt_pk_fp8_f32(v[3].z * inv, v[3].w * inv, t, true); w.w = (unsigned)t;
        *(u32x4*)(dst + (size_t)(c.lane >> 3) * NEXP * 128 + (size_t)row * 128 + (c.lane & 7) * 16) = w;
        if (c.lane == 0) scl[row] = sc;
    }
}
typedef float f32x2 __attribute__((ext_vector_type(2)));
__device__ __forceinline__ u32x2 fp8x4_to_bf16x4(unsigned w) {
    const f32x2 a = __builtin_amdgcn_cvt_pk_f32_fp8((int)w, false), b = __builtin_amdgcn_cvt_pk_f32_fp8((int)w, true);
    u32x2 o;
    asm("v_cvt_pk_bf16_f32 %0, %1, %2" : "=v"(o.x) : "v"(a.x), "v"(a.y));
    asm("v_cvt_pk_bf16_f32 %0, %1, %2" : "=v"(o.y) : "v"(b.x), "v"(b.y));
    return o;
}


constexpr size_t WS_PD = WS_S;
constexpr size_t WS_ACTB = WS_S + 224 * MiB;
struct XI { int xr, nx, jr, nloc; };
typedef long i64_t;
__device__ __forceinline__ i64_t pack64(unsigned lo, unsigned hi) { return (i64_t)(((unsigned long long)hi << 32) | lo); }
typedef int i32x8 __attribute__((ext_vector_type(8)));
#define PIN16(o) asm volatile("" : "+v"(o[0]), "+v"(o[1]), "+v"(o[2]), "+v"(o[3]), "+v"(o[4]), "+v"(o[5]), "+v"(o[6]), "+v"(o[7]), "+v"(o[8]), "+v"(o[9]), "+v"(o[10]), "+v"(o[11]), "+v"(o[12]), "+v"(o[13]), "+v"(o[14]), "+v"(o[15]))

constexpr size_t WS_ACT8 = WS_S + 224 * MiB;
constexpr size_t WS_SA = WS_S + 240 * MiB;
__device__ __forceinline__ void ph_peer_act2(const Params& p, int layer, const Ctx& c) {
    const bf16_t* PDh = (const bf16_t*)(p.ws + WS_PD); unsigned char* A8 = p.ws + WS_ACT8; float* SA = (float*)(p.ws + WS_SA);
    const float* SU = (const float*)(p.ws + WS_SCL) + (size_t)layer * 2 * NEXP; const float* SV = SU + NEXP;
    const int* ids = (const int*)(p.ws + WS_IDS); const float* gg = (const float*)(p.ws + WS_G);
    const int lane = c.lane;
    for (int t0 = c.gwave; t0 < M; t0 += 4 * c.gwaves) {
        float d0[4], d1[4], g0[4], g1[4], su0[4], su1[4], sv0[4], sv1[4]; int id0[4], id1[4];
#pragma unroll
        for (int u = 0; u < 4; ++u) { const int t = min(t0 + u * c.gwaves, M - 1); id0[u] = ids[(size_t)t * 128 + lane]; id1[u] = ids[(size_t)t * 128 + 64 + lane]; g0[u] = gg[(size_t)t * 128 + lane]; g1[u] = gg[(size_t)t * 128 + 64 + lane]; }
#pragma unroll
        for (int u = 0; u < 4; ++u) { const int t = min(t0 + u * c.gwaves, M - 1); d0[u] = 0.f; d1[u] = 0.f;
#pragma unroll
            for (int sl = 0; sl < 8; ++sl) { d0[u] += bf2f(PDh[((size_t)sl * M + t) * 128 + lane]); d1[u] += bf2f(PDh[((size_t)sl * M + t) * 128 + 64 + lane]); } }
#pragma unroll
        for (int u = 0; u < 4; ++u) { su0[u] = SU[id0[u]]; su1[u] = SU[id1[u]]; sv0[u] = SV[id0[u]]; sv1[u] = SV[id1[u]]; }
#pragma unroll
        for (int u = 0; u < 4; ++u) { const int t = t0 + u * c.gwaves; if (t >= M) break;
            const float a0 = gelu_tanh(d0[u] * su0[u]) * g0[u] * sv0[u], a1 = gelu_tanh(d1[u] * su1[u]) * g1[u] * sv1[u];
            const float mx = wave_max(fmaxf(fabsf(a0), fabsf(a1)));
            const float sa = mx > 0.f ? mx * (1.f / 256.f) : 1.f, inv = 1.f / sa;
            const float b0 = a0 * inv, b1 = a1 * inv;
            const int hq = __builtin_amdgcn_cvt_pk_fp8_f32(b0, b1, 0, false);
            const f32x2 hd = __builtin_amdgcn_cvt_pk_f32_fp8(hq, false);
            const int lq = __builtin_amdgcn_cvt_pk_fp8_f32((b0 - hd.x) * 16.f, (b1 - hd.y) * 16.f, 0, false);
            unsigned char* o = A8 + (size_t)t * 256;
            o[lane] = (unsigned char)(hq & 0xff); o[64 + lane] = (unsigned char)((hq >> 8) & 0xff); o[128 + lane] = (unsigned char)(lq & 0xff); o[192 + lane] = (unsigned char)((lq >> 8) & 0xff);
            if (lane == 0) SA[t] = sa; }
    }
}
typedef int i32x2 __attribute__((ext_vector_type(2)));
__device__ __forceinline__ i32x2 lds_tr8(LAS const unsigned char* pb) { return __builtin_amdgcn_ds_read_tr8_b64_v2i32((LAS i32x2*)pb); }
__device__ __forceinline__ void ph_peer_v2(const Params& p, int layer, const Ctx& c, const XI xi, float* hdst, int idmask) {
    const unsigned char* VT = p.ws + WS_TAB8 + (size_t)layer * 2 * NEXP * DM + (size_t)NEXP * DM;
    const int* ids = (const int*)(p.ws + WS_IDS); const unsigned char* A8 = p.ws + WS_ACT8; const float* SA = (const float*)(p.ws + WS_SA);
    const int lane = c.lane, e8 = lane >> 3, cc = lane & 7, r = lane & 15, q = lane >> 4;
    const int tstep = xi.nloc * NWAVES;
    LAS unsigned char* img = c.lds + c.wave * 16384;
#pragma unroll 1
    for (int sl = xi.xr; sl < 8; sl += xi.nx) {
        const unsigned char* Vs = VT + (size_t)sl * NEXP * 128; const unsigned vo = 16u * (unsigned)cc;
        int t = xi.jr * NWAVES + c.wave;
        if (t >= M) continue;
#define PV_LD(k) (*(const u32x4*)(Vs + (((unsigned)((k) & (idmask & 0xffff)) << 7) + vo)))
#define PV_ROWS(dst, ia, ib) do { dst[0] = PV_LD((ia).x); dst[1] = PV_LD((ia).y); dst[2] = PV_LD((ia).z); dst[3] = PV_LD((ia).w); dst[4] = PV_LD((ib).x); dst[5] = PV_LD((ib).y); dst[6] = PV_LD((ib).z); dst[7] = PV_LD((ib).w); } while (0)
#define PV_IMG(src, half) do { _Pragma("unroll") for (int j = 0; j < 8; ++j) *(LAS u32x4*)(img + (64 * (half) + 8 * e8 + j) * 128 + ((cc ^ j) << 4)) = src[j]; } while (0)
        u32x4 v[8], vn[8];
        { const i32x4* ip = (const i32x4*)(ids + (size_t)t * 128 + 8 * e8); const i32x4 i0 = ip[0], i1 = ip[1], i2 = ip[16], i3 = ip[17]; PV_ROWS(v, i0, i1); PV_ROWS(vn, i2, i3); }
#pragma unroll 1
        for (; t < M; t += tstep) {
            const int tn = min(t + tstep, M - 1);
            const i32x4* ipn = (const i32x4*)(ids + (size_t)tn * 128 + 8 * e8); const i32x4 in0 = ipn[0], in1 = ipn[1], in2 = ipn[16], in3 = ipn[17];
            const u32x4* ap = (const u32x4*)(A8 + (size_t)t * 256 + 32 * q); const u32x4 ah0 = ap[0], ah1 = ap[1], al0 = ap[8], al1 = ap[9];
            const float sa = SA[t];
            const size_t ho = (size_t)t * DM + 128 * sl + 32 * q + r;
            float h0 = p.out[ho], h1 = p.out[ho + 16];
            PV_IMG(v, 0); PV_IMG(vn, 1);
            PV_ROWS(v, in0, in1); PV_ROWS(vn, in2, in3);
            asm volatile("" ::: "memory");
            const i32x8 ahv = {(int)ah0.x, (int)ah0.y, (int)ah0.z, (int)ah0.w, (int)ah1.x, (int)ah1.y, (int)ah1.z, (int)ah1.w};
            const i32x8 alv = {(int)al0.x, (int)al0.y, (int)al0.z, (int)al0.w, (int)al1.x, (int)al1.y, (int)al1.z, (int)al1.w};
            float oa = 0.f, ob = 0.f;
#pragma unroll
            for (int dt = 0; dt < 8; ++dt) {
                i32x8 bw;
#pragma unroll
                for (int i4 = 0; i4 < 4; ++i4) { const int row = 32 * q + 8 * i4 + (r >> 1);
                    const i32x2 tv = lds_tr8(img + row * 128 + ((dt ^ (row & 7)) << 4) + 8 * (r & 1)); bw[2 * i4] = tv.x; bw[2 * i4 + 1] = tv.y; }
                f32x4 ch = {0.f, 0.f, 0.f, 0.f}, cl = {0.f, 0.f, 0.f, 0.f};
                ch = __builtin_amdgcn_mfma_scale_f32_16x16x128_f8f6f4(ahv, bw, ch, 0, 0, 0, 0, 0, 0); cl = __builtin_amdgcn_mfma_scale_f32_16x16x128_f8f6f4(alv, bw, cl, 0, 0, 0, 0, 0, 0);
                const float od = ch[0] + cl[0] * 0.0625f;
                oa = (dt == 2 * q) ? od : oa; ob = (dt == 2 * q + 1) ? od : ob; }
            h0 += oa * sa; h1 += ob * sa;
            hdst[ho] = h0; hdst[ho + 16] = h1;
            asm volatile("" ::: "memory");
        }
#undef PV_LD
#undef PV_ROWS
#undef PV_IMG
    }
}

constexpr size_t WS_XN8 = WS_S + 256 * MiB;
__device__ __forceinline__ void ph_peer_u2(const Params& p, int layer, const Ctx& c, const XI xi, int idmask) {
    const unsigned char* X8 = p.ws + WS_XN8; const unsigned char* UT = p.ws + WS_TAB8 + (size_t)layer * 2 * NEXP * DM;
    const int* ids = (const int*)(p.ws + WS_IDS); bf16_t* PDh = (bf16_t*)(p.ws + WS_PD);
    const int lane = c.lane, e8 = lane >> 3, cc = lane & 7, r = lane & 15, q = lane >> 4;
    const int tstep = xi.nloc * NWAVES;
    LAS unsigned char* img = c.lds + c.wave * 16384; LAS float* stg = (LAS float*)(c.lds + 131072 + c.wave * 512);
#pragma unroll 1
    for (int sl = xi.xr; sl < 8; sl += xi.nx) {
        const unsigned char* Us = UT + (size_t)sl * NEXP * 128; const unsigned uo = 16u * (unsigned)cc;
        int t = xi.jr * NWAVES + c.wave;
        if (t >= M) continue;
#define PU_LD(k) (*(const u32x4*)(Us + (((unsigned)((k) & (idmask & 0xffff)) << 7) + uo)))
#define PU_ROWS(dst, ia, ib) do { dst[0] = PU_LD((ia).x); dst[1] = PU_LD((ia).y); dst[2] = PU_LD((ia).z); dst[3] = PU_LD((ia).w); dst[4] = PU_LD((ib).x); dst[5] = PU_LD((ib).y); dst[6] = PU_LD((ib).z); dst[7] = PU_LD((ib).w); } while (0)
#define PU_IMG(src, half) do { _Pragma("unroll") for (int j = 0; j < 8; ++j) *(LAS u32x4*)(img + (64 * (half) + 8 * e8 + j) * 128 + ((cc ^ j) << 4)) = src[j]; } while (0)
        u32x4 v[8], vn[8];
        { const i32x4* ip = (const i32x4*)(ids + (size_t)t * 128 + 8 * e8); const i32x4 i0 = ip[0], i1 = ip[1], i2 = ip[16], i3 = ip[17]; PU_ROWS(v, i0, i1); PU_ROWS(vn, i2, i3); }
#pragma unroll 1
        for (; t < M; t += tstep) {
            const int tn = min(t + tstep, M - 1);
            const i32x4* ipn = (const i32x4*)(ids + (size_t)tn * 128 + 8 * e8); const i32x4 in0 = ipn[0], in1 = ipn[1], in2 = ipn[16], in3 = ipn[17];
            const u32x4* xp = (const u32x4*)(X8 + (size_t)t * 2048 + 128 * sl + 32 * q); const u32x4 xh0 = xp[0], xh1 = xp[1], xl0 = xp[64], xl1 = xp[65];
            PU_IMG(v, 0); PU_IMG(vn, 1);
            PU_ROWS(v, in0, in1); PU_ROWS(vn, in2, in3);
            asm volatile("" ::: "memory");
            const i32x8 xh = {(int)xh0.x, (int)xh0.y, (int)xh0.z, (int)xh0.w, (int)xh1.x, (int)xh1.y, (int)xh1.z, (int)xh1.w};
            const i32x8 xl = {(int)xl0.x, (int)xl0.y, (int)xl0.z, (int)xl0.w, (int)xl1.x, (int)xl1.y, (int)xl1.z, (int)xl1.w};
#pragma unroll
            for (int g = 0; g < 8; ++g) { const int row = 16 * g + r;
                const u32x4 w0 = *(const LAS u32x4*)(img + row * 128 + (((2 * q) ^ (row & 7)) << 4)), w1 = *(const LAS u32x4*)(img + row * 128 + (((2 * q + 1) ^ (row & 7)) << 4));
                const i32x8 aw = {(int)w0.x, (int)w0.y, (int)w0.z, (int)w0.w, (int)w1.x, (int)w1.y, (int)w1.z, (int)w1.w};
                f32x4 ah = {0.f, 0.f, 0.f, 0.f}, al = {0.f, 0.f, 0.f, 0.f};
                ah = __builtin_amdgcn_mfma_scale_f32_16x16x128_f8f6f4(aw, xh, ah, 0, 0, 0, 0, 0, 0); al = __builtin_amdgcn_mfma_scale_f32_16x16x128_f8f6f4(aw, xl, al, 0, 0, 0, 0, 0, 0);
                if (r == 0) *(LAS f32x4*)(stg + 16 * g + 4 * q) = ah + al * 0.0625f; }
            asm volatile("" ::: "memory");
            { const f32x2 pv = *(const LAS f32x2*)(stg + 2 * lane); *(unsigned*)(PDh + ((size_t)sl * M + t) * 128 + 2 * lane) = pk2(pv.x, pv.y); }
            asm volatile("" ::: "memory");
        }
#undef PU_LD
#undef PU_ROWS
#undef PU_IMG
    }
}

#define XB_TMO      128
#define XB_XCNT(j)  (256  + 64 * (j))
#define XB_XSUB(j)  (1280 + 64 * (j))
#define XB_XGEN(j)  (2304 + 64 * (j))
#define XB_TOP      3328
#define XB_TOPGEN   3392
#define XCD_BAR_WORDS 3456
#define XB_SPIN_CAP (1u << 18)

__device__ __forceinline__ unsigned xb_ld(unsigned* p)              { return __hip_atomic_load(p, __ATOMIC_RELAXED, __HIP_MEMORY_SCOPE_AGENT); }
__device__ __forceinline__ unsigned xb_add(unsigned* p, unsigned v) { return __hip_atomic_fetch_add(p, v, __ATOMIC_RELAXED, __HIP_MEMORY_SCOPE_AGENT); }
__device__ __forceinline__ unsigned xb_xcc_id() { return (unsigned)__builtin_amdgcn_s_getreg((3 << 11) | 20) & 0xFu; }
#define XB_SPIN(cond, bar) do { unsigned _sp = 0; while (cond) { __builtin_amdgcn_s_sleep(1); \
    if ((++_sp & 255u) == 0u) { if (xb_ld(&(bar)[XB_TMO])) break; if (_sp > XB_SPIN_CAP) { atomicAdd(&(bar)[XB_TMO], 1u); break; } } } } while (0)

struct XcdBarrier {
    unsigned* bar; unsigned x;
    volatile LAS unsigned* st;
};

__device__ __forceinline__ XcdBarrier xcd_barrier_post(unsigned* bar, volatile LAS unsigned* st) {
    XcdBarrier b; b.bar = bar; b.x = xb_xcc_id(); b.st = st;
    if (threadIdx.x == 0) (void)xb_add(&bar[XB_XCNT(b.x)], 1u);
    return b;
}
__device__ __forceinline__ void xcd_barrier_complete(unsigned* bar, unsigned x, unsigned& nloc, unsigned& nx) {
    const unsigned G = gridDim.x * gridDim.y * gridDim.z;
    unsigned sum, cnt, mine, sp = 0u;
    for (;;) {
        sum = 0u; cnt = 0u; mine = 0u;
#pragma unroll
        for (unsigned j = 0; j < 16; ++j) { const unsigned c = xb_ld(&bar[XB_XCNT(j)]); sum += c; cnt += (c > 0u) ? 1u : 0u; mine = (j == x) ? c : mine; }
        if (sum == G) break;
        __builtin_amdgcn_s_sleep(1);
        if ((++sp & 255u) == 0u) { if (xb_ld(&bar[XB_TMO])) break; if (sp > XB_SPIN_CAP) { atomicAdd(&bar[XB_TMO], 1u); break; } }
    }
    nloc = mine > 0u ? mine : 1u; nx = cnt > 0u ? cnt : 1u;
}

__device__ __forceinline__ void xcd_barrier(const XcdBarrier& b) {
    asm volatile("s_waitcnt vmcnt(0)" ::: "memory");
    __syncthreads();
    if (threadIdx.x == 0) {
        unsigned* bar = b.bar;
        __builtin_amdgcn_s_waitcnt(0);
        unsigned nloc = b.st[0], nx = b.st[1];
        if (nloc == 0u) { xcd_barrier_complete(bar, b.x, nloc, nx); b.st[0] = nloc; b.st[1] = nx; }
        const unsigned old = xb_add(&bar[XB_XSUB(b.x)], 1u);
        const unsigned gen = old / nloc;
        if (old + 1u == (gen + 1u) * nloc) {
            __builtin_amdgcn_fence(__ATOMIC_RELEASE, "agent");
            asm volatile("s_waitcnt vmcnt(0)" ::: "memory");
            const unsigned og = xb_add(&bar[XB_TOP], 1u);
            const unsigned tg = og / nx;
            if (og + 1u == (tg + 1u) * nx) xb_add(&bar[XB_TOPGEN], 1u);
            else XB_SPIN(xb_ld(&bar[XB_TOPGEN]) == tg, bar);
            __builtin_amdgcn_fence(__ATOMIC_ACQUIRE, "agent");
            xb_add(&bar[XB_XGEN(b.x)], 1u);
            asm volatile("s_waitcnt vmcnt(0)" ::: "memory");
        } else {
            XB_SPIN(xb_ld(&bar[XB_XGEN(b.x)]) == gen, bar);
            __builtin_amdgcn_fence(__ATOMIC_ACQUIRE, "agent");
            asm volatile("s_waitcnt vmcnt(0)" ::: "memory");
        }
    }
    __syncthreads();
}

enum Phase { PH_PRO = 0, PH_GEMM_IN0, PH_MIXER0, PH_GLA_B, PH_GLA_C, PH_MIX0, PH_GEMM_OUT0, PH_NORM_F0, PH_GEMM_Q0, PH_TOPK1_0, PH_PU0, PH_PA0, PH_PV0,
             PH_NORM_M1, PH_GEMM_CIN, PH_G1, PH_G2, PH_G3, PH_GEMM_OUT1, PH_NORM_F1, PH_GEMM_Q1, PH_TOPK1_1, PH_PU1, PH_PA1, PH_PV1, PH_FINAL, NPHASES };

#ifndef PH_ONLY
#define PH_ONLY (-1)
#endif
#define PH_ENABLED(x) (PH_ONLY < 0 || PH_ONLY == (x))
#ifndef MK_N_LAUNCHES
#define MK_N_LAUNCHES 1
#endif

template <class Epi> __device__ __forceinline__ void run_gemm(const Ctx& c, const bf16_t* A, const bf16_t* Bt, int N, const Epi& E, int vblk) {
    pg8::Gemm g{A, Bt, M, N, DM}; pg8::StaticOrder S; S.init(M, N, c.nblk, vblk);
    pg8::gemm_phase<Epi, pg8::StaticOrder, true, true>(c.lds, g, S, E);
}

#define GATHER_CALL(l) ph_gather3(p, l, c, (rep_ + 1 < NREP(PH_GATHER##l)) ? (float*)(ws + WS_S) : p.out)
#ifndef PROBE_IDMASK
#define PROBE_IDMASK 0x3fff
#endif
#ifndef DUP_MASK
#define DUP_MASK 0u
#endif
#define NREP(k) ((((unsigned)(DUP_MASK) >> (k)) & 1u) ? 2 : 1)
#define GETXI() XI xi; { if (multi) { if (threadIdx.x == 0) { unsigned xr_ = 0; for (unsigned j_ = 0; j_ < bar.x; ++j_) xr_ += xb_ld(&ctl[CW_BAR + XB_XCNT(j_)]) > 0u ? 1u : 0u; MISC[11] = xr_; } __syncthreads(); \
    xi.nloc = (int)MISC[8]; xi.nx = (int)MISC[9]; xi.jr = (int)MISC[10]; xi.xr = (int)MISC[11]; if (xi.nloc < 1 || xi.nx < 1 || xi.nx > 8 || xi.jr >= xi.nloc || xi.xr >= xi.nx) { xi.xr = 0; xi.nx = 1; xi.jr = blockIdx.x; xi.nloc = gridDim.x; } } \
    else { xi.xr = 0; xi.nx = 1; xi.jr = blockIdx.x; xi.nloc = gridDim.x; } }
#define MKCTX() Ctx c; { int t_ = threadIdx.x; asm volatile("" : "+v"(t_)); c.lds = lds; c.tid = t_; c.lane = t_ & 63; c.wave = __builtin_amdgcn_readfirstlane(t_ >> 6); \
    c.blk = blockIdx.x; c.nblk = gridDim.x; c.gtid = c.blk * NTHREADS + c.tid; c.gthreads = c.nblk * NTHREADS; c.gwave = c.blk * NWAVES + c.wave; c.gwaves = c.nblk * NWAVES; }
__global__ void __launch_bounds__(NTHREADS, 2) mega_fwd(Params p) {
    extern __shared__ __attribute__((aligned(16))) unsigned char lds_raw[];
    volatile LAS unsigned* MISC = (volatile LAS unsigned*)((LAS unsigned char*)lds_raw + MISC_OFF);
    LAS unsigned char* const lds = (LAS unsigned char*)lds_raw;
    for (int u = threadIdx.x; u < (LDS_BYTES - LDSCTL_OFF) / 4; u += NTHREADS) ((LAS unsigned*)(lds + LDSCTL_OFF))[u] = 0u;
    __syncthreads();
    unsigned* ctl = (unsigned*)(p.ws + WS_CTL);
    XcdBarrier bar; bar.bar = ctl + CW_BAR; bar.x = 0; bar.st = nullptr;
    const bool multi = (p.ph_hi - p.ph_lo) > 1;
    if (multi) { bar = xcd_barrier_post(ctl + CW_BAR, MISC + 8); if (threadIdx.x == 0) MISC[10] = xb_add(&ctl[CW_RANK + 64 * bar.x], 1u); }
    unsigned char* ws = p.ws;
    bf16_t* ACT = (bf16_t*)(ws + WS_ACT); bf16_t* PROJ = (bf16_t*)(ws + WS_PROJ);

    const int lo = p.ph_lo, hi = p.ph_hi;
#define IN(k) (PH_ENABLED(k) && lo <= (k) && (k) < hi)
#define SEAM(k) do { if ((k) + 1 < hi) xcd_barrier(bar); } while (0)
    if (IN(PH_PRO)) { for (int rep_ = 0; rep_ < NREP(PH_PRO); ++rep_) { MKCTX();
        transpose_cvt(p.ab_w_in, DM, NIN, (bf16_t*)(ws + WS_WT_IN), NIN_PAD, [](int n) { return n < 1536 ? n : (n < 3072 ? n + 16 : (n < 3088 ? n - 3072 + 1536 : -1)); }, c.gtid, c.gthreads);
        transpose_cvt(p.ab_w_out, DM, DM, (bf16_t*)(ws + WS_WT_OUT), DM, [](int n) { return n; }, c.gtid, c.gthreads);
        transpose_cvt(p.c_w_in, DM, 2048, (bf16_t*)(ws + WS_WT_CIN), 2048, [](int n) { return n; }, c.gtid, c.gthreads);
        transpose_cvt(p.c_w_out, DM, DM, (bf16_t*)(ws + WS_WT_COUT), DM, [](int n) { return n; }, c.gtid, c.gthreads);
        transpose_cvt(p.peer_w_query, DM, 2048, (bf16_t*)(ws + WS_WT_Q0), 2048, [](int n) { return n; }, c.gtid, c.gthreads);
        transpose_cvt(p.peer_w_query + (size_t)DM * 2048, DM, 2048, (bf16_t*)(ws + WS_WT_Q1), 2048, [](int n) { return n; }, c.gtid, c.gthreads);
        cvt_fp8_rows(p.peer_u, ws + WS_TAB8, (float*)(ws + WS_SCL), NEXP, c);
        cvt_fp8_rows(p.peer_v, ws + WS_TAB8 + (size_t)NEXP * DM, (float*)(ws + WS_SCL) + NEXP, NEXP, c);
        cvt_gate_weights(p, c);
        cvt_bf16(p.peer_sub_keys, (bf16_t*)(ws + WS_SK), (size_t)2 * 8 * 2 * 128 * 128 / 8, c.gtid, c.gthreads);
        norm_rows_bf16(p.x, p.mix_norm, ACT, c);
        if (rep_ + 1 < NREP(PH_PRO)) xcd_barrier(bar); } SEAM(PH_PRO); }
    if (IN(PH_GEMM_IN0)) { for (int rep_ = 0; rep_ < NREP(PH_GEMM_IN0); ++rep_) { MKCTX();  ph_glr(p, c); pg8::EpiBf16<0> E{PROJ, NIN_PAD, nullptr, 0, 0, 1.f}; GETXI(); run_gemm(c, ACT, (const bf16_t*)(ws + WS_WT_IN), 3072, E, (xi.nx == 8 && xi.nloc * 8 == (int)gridDim.x) ? xi.jr * 8 + xi.xr : (int)blockIdx.x); if (rep_ + 1 < NREP(PH_GEMM_IN0)) xcd_barrier(bar); } SEAM(PH_GEMM_IN0); }
    if (IN(PH_MIXER0)) { for (int rep_ = 0; rep_ < NREP(PH_MIXER0); ++rep_) { MKCTX();  ph_gla_a(p, c); ph_attn(p, c); if (rep_ + 1 < NREP(PH_MIXER0)) xcd_barrier(bar); } SEAM(PH_MIXER0); }
    if (IN(PH_GLA_B)) { for (int rep_ = 0; rep_ < NREP(PH_GLA_B); ++rep_) { MKCTX();  ph_gla_b(p, c); if (rep_ + 1 < NREP(PH_GLA_B)) xcd_barrier(bar); } SEAM(PH_GLA_B); }
    if (IN(PH_GLA_C)) { for (int rep_ = 0; rep_ < NREP(PH_GLA_C); ++rep_) { MKCTX();  ph_gla_c(p, c); if (rep_ + 1 < NREP(PH_GLA_C)) xcd_barrier(bar); } SEAM(PH_GLA_C); }
    if (IN(PH_MIX0)) { for (int rep_ = 0; rep_ < NREP(PH_MIX0); ++rep_) { MKCTX();  ph_mix(p, c); if (rep_ + 1 < NREP(PH_MIX0)) xcd_barrier(bar); } SEAM(PH_MIX0); }
    if (IN(PH_GEMM_OUT0)) { for (int rep_ = 0; rep_ < NREP(PH_GEMM_OUT0); ++rep_) { MKCTX();  pg8::EpiResF32 E{p.x, p.out, DM}; GETXI(); run_gemm(c, ACT, (const bf16_t*)(ws + WS_WT_OUT), DM, E, (xi.nx == 8 && xi.nloc * 8 == (int)gridDim.x) ? xi.jr * 8 + xi.xr : (int)blockIdx.x); if (rep_ + 1 < NREP(PH_GEMM_OUT0)) xcd_barrier(bar); } SEAM(PH_GEMM_OUT0); }
    if (IN(PH_NORM_F0)) { for (int rep_ = 0; rep_ < NREP(PH_NORM_F0); ++rep_) { MKCTX();  norm_rows_bf16(p.out, p.ffn_norm, ACT, c, ws + WS_XN8); if (rep_ + 1 < NREP(PH_NORM_F0)) xcd_barrier(bar); } SEAM(PH_NORM_F0); }
    if (IN(PH_GEMM_Q0)) { for (int rep_ = 0; rep_ < NREP(PH_GEMM_Q0); ++rep_) { MKCTX();  pg8::EpiBf16<0> E{PROJ, 2048, nullptr, 0, 0, 1.f}; GETXI(); run_gemm(c, ACT, (const bf16_t*)(ws + WS_WT_Q0), 2048, E, (xi.nx == 8 && xi.nloc * 8 == (int)gridDim.x) ? xi.jr * 8 + xi.xr : (int)blockIdx.x); if (rep_ + 1 < NREP(PH_GEMM_Q0)) xcd_barrier(bar); } SEAM(PH_GEMM_Q0); }
    if (IN(PH_TOPK1_0)) { for (int rep_ = 0; rep_ < NREP(PH_TOPK1_0); ++rep_) { MKCTX();  ph_topk(p, 0, c); if (rep_ + 1 < NREP(PH_TOPK1_0)) xcd_barrier(bar); } SEAM(PH_TOPK1_0); }
    if (IN(PH_PU0)) { for (int rep_ = 0; rep_ < NREP(PH_PU0); ++rep_) { MKCTX();  GETXI(); ph_peer_u2(p, 0, c, xi, (rep_ + 1 < NREP(PH_PU0)) ? PROBE_IDMASK : 0x3fff); if (rep_ + 1 < NREP(PH_PU0)) xcd_barrier(bar); } SEAM(PH_PU0); }
    if (IN(PH_PA0)) { for (int rep_ = 0; rep_ < NREP(PH_PA0); ++rep_) { MKCTX();  ph_peer_act2(p, 0, c); if (rep_ + 1 < NREP(PH_PA0)) xcd_barrier(bar); } SEAM(PH_PA0); }
    if (IN(PH_PV0)) { for (int rep_ = 0; rep_ < NREP(PH_PV0); ++rep_) { MKCTX();  GETXI(); ph_peer_v2(p, 0, c, xi, (rep_ + 1 < NREP(PH_PV0)) ? (float*)(ws + WS_S) : p.out, (rep_ + 1 < NREP(PH_PV0)) ? PROBE_IDMASK : 0x3fff); if (rep_ + 1 < NREP(PH_PV0)) xcd_barrier(bar); } SEAM(PH_PV0); }
    if (IN(PH_NORM_M1)) { for (int rep_ = 0; rep_ < NREP(PH_NORM_M1); ++rep_) { MKCTX();  norm_rows_bf16(p.out, p.mix_norm + DM, ACT, c); if (rep_ + 1 < NREP(PH_NORM_M1)) xcd_barrier(bar); } SEAM(PH_NORM_M1); }
    if (IN(PH_GEMM_CIN)) { for (int rep_ = 0; rep_ < NREP(PH_GEMM_CIN); ++rep_) { MKCTX();  pg8::EpiBf16<0> E{PROJ, 2048, nullptr, 0, 0, 1.f}; GETXI(); run_gemm(c, ACT, (const bf16_t*)(ws + WS_WT_CIN), 2048, E, (xi.nx == 8 && xi.nloc * 8 == (int)gridDim.x) ? xi.jr * 8 + xi.xr : (int)blockIdx.x); if (rep_ + 1 < NREP(PH_GEMM_CIN)) xcd_barrier(bar); } SEAM(PH_GEMM_CIN); }
    if (IN(PH_G1)) { for (int rep_ = 0; rep_ < NREP(PH_G1); ++rep_) { MKCTX();  griffin_pass<false>(p, c); if (rep_ + 1 < NREP(PH_G1)) xcd_barrier(bar); } SEAM(PH_G1); }
    if (IN(PH_G2)) { for (int rep_ = 0; rep_ < NREP(PH_G2); ++rep_) { MKCTX();  ph_carry(p, c); if (rep_ + 1 < NREP(PH_G2)) xcd_barrier(bar); } SEAM(PH_G2); }
    if (IN(PH_G3)) { for (int rep_ = 0; rep_ < NREP(PH_G3); ++rep_) { MKCTX();  griffin_pass<true>(p, c); if (rep_ + 1 < NREP(PH_G3)) xcd_barrier(bar); } SEAM(PH_G3); }
    if (IN(PH_GEMM_OUT1)) { for (int rep_ = 0; rep_ < NREP(PH_GEMM_OUT1); ++rep_) { MKCTX();  pg8::EpiResF32 E{p.out, p.out, DM}; GETXI(); run_gemm(c, ACT, (const bf16_t*)(ws + WS_WT_COUT), DM, E, (xi.nx == 8 && xi.nloc * 8 == (int)gridDim.x) ? xi.jr * 8 + xi.xr : (int)blockIdx.x); if (rep_ + 1 < NREP(PH_GEMM_OUT1)) xcd_barrier(bar); } SEAM(PH_GEMM_OUT1); }
    if (IN(PH_NORM_F1)) { for (int rep_ = 0; rep_ < NREP(PH_NORM_F1); ++rep_) { MKCTX();
        norm_rows_bf16(p.out, p.ffn_norm + DM, ACT, c, ws + WS_XN8);
        cvt_fp8_rows(p.peer_u + (size_t)NEXP * DM, ws + WS_TAB8 + (size_t)2 * NEXP * DM, (float*)(ws + WS_SCL) + 2 * NEXP, NEXP, c);
        cvt_fp8_rows(p.peer_v + (size_t)NEXP * DM, ws + WS_TAB8 + (size_t)3 * NEXP * DM, (float*)(ws + WS_SCL) + 3 * NEXP, NEXP, c);
        if (rep_ + 1 < NREP(PH_NORM_F1)) xcd_barrier(bar); } SEAM(PH_NORM_F1); }
    if (IN(PH_GEMM_Q1)) { for (int rep_ = 0; rep_ < NREP(PH_GEMM_Q1); ++rep_) { MKCTX();  pg8::EpiBf16<0> E{PROJ, 2048, nullptr, 0, 0, 1.f}; GETXI(); run_gemm(c, ACT, (const bf16_t*)(ws + WS_WT_Q1), 2048, E, (xi.nx == 8 && xi.nloc * 8 == (int)gridDim.x) ? xi.jr * 8 + xi.xr : (int)blockIdx.x); if (rep_ + 1 < NREP(PH_GEMM_Q1)) xcd_barrier(bar); } SEAM(PH_GEMM_Q1); }
    if (IN(PH_TOPK1_1)) { for (int rep_ = 0; rep_ < NREP(PH_TOPK1_1); ++rep_) { MKCTX();  ph_topk(p, 1, c); if (rep_ + 1 < NREP(PH_TOPK1_1)) xcd_barrier(bar); } SEAM(PH_TOPK1_1); }
    if (IN(PH_PU1)) { for (int rep_ = 0; rep_ < NREP(PH_PU1); ++rep_) { MKCTX();  GETXI(); ph_peer_u2(p, 1, c, xi, (rep_ + 1 < NREP(PH_PU1)) ? PROBE_IDMASK : 0x3fff); if (rep_ + 1 < NREP(PH_PU1)) xcd_barrier(bar); } SEAM(PH_PU1); }
    if (IN(PH_PA1)) { for (int rep_ = 0; rep_ < NREP(PH_PA1); ++rep_) { MKCTX();  ph_peer_act2(p, 1, c); if (rep_ + 1 < NREP(PH_PA1)) xcd_barrier(bar); } SEAM(PH_PA1); }
    if (IN(PH_PV1)) { for (int rep_ = 0; rep_ < NREP(PH_PV1); ++rep_) { MKCTX();  GETXI(); ph_peer_v2(p, 1, c, xi, (rep_ + 1 < NREP(PH_PV1)) ? (float*)(ws + WS_S) : p.out, (rep_ + 1 < NREP(PH_PV1)) ? PROBE_IDMASK : 0x3fff); if (rep_ + 1 < NREP(PH_PV1)) xcd_barrier(bar); } SEAM(PH_PV1); }
    if (IN(PH_FINAL)) { MKCTX(); norm_rows_f32(p.out, p.final_norm, c); }
#undef IN
#undef SEAM
}

extern "C" void kernel_launch(void* const* d_in, const int* in_sizes, int n_in, void* d_out, int out_size, void* d_ws, size_t ws_size, hipStream_t stream) {
    static int grid = 0;
    if (grid == 0) {
        if (n_in != 22 || out_size != M * DM || ws_size < WS_END) { fprintf(stderr, "kernel_launch: unexpected shapes: n_in %d out %d ws %zu (need %zu)\n", n_in, out_size, ws_size, (size_t)WS_END); grid = -1; return; }
        int dev = 0, cus = 0, per_cu = 0;
        if (hipGetDevice(&dev) != hipSuccess || hipDeviceGetAttribute(&cus, hipDeviceAttributeMultiprocessorCount, dev) != hipSuccess) { grid = -1; return; }
        if (hipFuncSetAttribute((const void*)mega_fwd, hipFuncAttributeMaxDynamicSharedMemorySize, LDS_BYTES) != hipSuccess) { fprintf(stderr, "kernel_launch: hipFuncSetAttribute failed\n"); grid = -1; return; }
        if (hipOccupancyMaxActiveBlocksPerMultiprocessor(&per_cu, (const void*)mega_fwd, NTHREADS, LDS_BYTES) != hipSuccess || per_cu < 1) { fprintf(stderr, "kernel_launch: occupancy query says %d blocks per CU\n", per_cu); per_cu = 1; }
        (void)hipGetLastError();
        grid = cus;
        if (grid % 8 != 0 || grid < 32) { fprintf(stderr, "kernel_launch: unexpected CU count %d\n", cus); }
    }
    if (grid < 0) return;
    (void)hipMemsetAsync((char*)d_ws + WS_CTL, 0, CTL_ZERO_BYTES, stream);
    Params p{};
    const float** pp = (const float**)&p;
    for (int i = 0; i < 22; ++i) pp[i] = (const float*)d_in[i];
    p.out = (float*)d_out; p.ws = (unsigned char*)d_ws;
#if MK_N_LAUNCHES == 1
    p.ph_lo = 0; p.ph_hi = NPHASES;
    void* args[] = {&p};
    hipError_t e = hipLaunchCooperativeKernel((const void*)mega_fwd, dim3(grid), dim3(NTHREADS), args, LDS_BYTES, stream);
    if (e != hipSuccess) fprintf(stderr, "cooperative launch failed: %s (grid %d)\n", hipGetErrorString(e), grid);
#else
    for (int ph = 0; ph < NPHASES; ++ph) { p.ph_lo = ph; p.ph_hi = ph + 1; hipLaunchKernelGGL(mega_fwd, dim3(grid), dim3(NTHREADS), LDS_BYTES, stream, p); }
#endif
}
```

```cpp
#include <hip/hip_runtime.h>
#include <hip/hip_bf16.h>
#include <cstdio>
#include <cstdint>
#include <cmath>
namespace pg8 {
#define PG8_LAS __attribute__((address_space(3)))
typedef unsigned short bf16_t;
typedef short bf16x8 __attribute__((ext_vector_type(8)));
typedef float f32x4 __attribute__((ext_vector_type(4)));
typedef unsigned u32x4 __attribute__((ext_vector_type(4)));
constexpr int BM = 256, BK = 64, HALF = 128, HTB = HALF * BK * 2  , STAGE_BYTES = 8 * HTB, NXCD = 8, WGM = 8;

__host__ __device__ __forceinline__ int lds_byte(int r, int c) { const int st = (r >> 4) * 2 + (c >> 5), rr = r & 15, cc = c & 31, ob = rr * 64 + cc * 2; return st * 1024 + (ob ^ (((ob >> 9) & 1) << 5)); }
__host__ __device__ __forceinline__ void stage_rc(int b, int& R, int& C) { const int st = b / 1024, sb = b % 1024, swz = sb ^ (((sb >> 9) & 1) << 5); R = (st >> 1) * 16 + swz / 64; C = (st & 1) * 32 + (swz % 64) / 2; }
__host__ __device__ __forceinline__ int perm32(int rho) { const int n = rho >> 4, i = rho & 15; return 8 * (i >> 2) + 4 * n + (i & 3); }

struct Unit { int pm, pn; };
struct Gemm { const bf16_t* A; const bf16_t* Bt; int M, N, K; };

struct StaticOrder {
    int nM, nN, nwg, G, c;
    __host__ __device__ void init(int M, int N, int G_, int c_) { nM = M / BM; nN = N / BM; nwg = nM * nN; G = G_; c = c_; }
    __host__ __device__ bool next(int i, Unit& u) const {
        const long L = (long)i * G + c; if (L >= nwg) return false;
        int wgid = (int)L; { const int q = nwg / NXCD, r = nwg % NXCD, xcd = wgid % NXCD, off = wgid / NXCD; wgid = (xcd < r ? xcd * (q + 1) : r * (q + 1) + (xcd - r) * q) + off; }
        const int nig = WGM * nN, gid = wgid / nig, fm = gid * WGM, gsz = (nM - fm) < WGM ? (nM - fm) : WGM;
        u.pm = fm + ((wgid % nig) % gsz); u.pn = (wgid % nig) / gsz; return true;
    }
    __device__ __forceinline__ void a_ready(const Unit&) const {}
    __device__ __forceinline__ void done(const Unit&) const {}
};

__device__ __forceinline__ unsigned cvt_pk_bf16(float lo, float hi) { unsigned r; asm volatile("v_cvt_pk_bf16_f32 %0, %1, %2" : "=v"(r) : "v"(lo), "v"(hi)); return r; }
typedef float f32x2 __attribute__((ext_vector_type(2)));
__device__ __forceinline__ f32x2 gelu_pk(f32x2 v) {
    const f32x2 av = __builtin_elementwise_abs(v), d = av * 0.2316418882f + 1.0f;
    f32x2 t; t.x = __builtin_amdgcn_rcpf(d.x); t.y = __builtin_amdgcn_rcpf(d.y);
    f32x2 q = t * 0.5307027145f + (-0.7265760135f); q = q * t + 0.7107068705f; q = q * t + (-0.142248368f); q = q * t + 0.127414796f; q = q * t;
    const f32x2 s = (v * v) * (-0.72134752044f);
    f32x2 e; e.x = __builtin_amdgcn_exp2f(s.x); e.y = __builtin_amdgcn_exp2f(s.y);
    const f32x2 m = v * (q * e), r = v - m;
    f32x2 o; o.x = v.x < 0.f ? m.x : r.x; o.y = v.y < 0.f ? m.y : r.y; return o;
}
template <int ACT  > struct EpiBf16 {
    static constexpr bool PERM = true, AFTER_DRAIN = false; static_assert(ACT == 0 || ACT == 1, "EpiBf16: ACT is 0 (none) or 1 (gelu_pk)");
    bf16_t* O; int ldc; const float* bias; int split_cols; size_t split_stride; float scale0;
    __device__ __forceinline__ void operator()(const f32x4 (&acc)[2][2][4][2], const Unit& u, int wr, int wc, int fr, int fq) const {
        const int row0 = u.pm * BM + wr * 64 + fr; int colt = u.pn * BM; bf16_t* base = O;
        float sc = 1.f; if (split_cols) { const int t = colt / split_cols; base += (size_t)t * split_stride; colt -= t * split_cols; if (t == 0) sc = scale0; }
        const int col0 = colt + wc * 32 + 8 * fq, bcol0 = u.pn * BM + wc * 32 + 8 * fq;
        f32x4 bv[2][2];
#pragma unroll
        for (int bj = 0; bj < 2; ++bj)
#pragma unroll
            for (int n = 0; n < 2; ++n) bv[bj][n] = bias ? *(const f32x4*)(bias + bcol0 + bj * HALF + 4 * n) : (f32x4){0.f, 0.f, 0.f, 0.f};
#pragma unroll
        for (int ai = 0; ai < 2; ++ai)
#pragma unroll
            for (int m = 0; m < 4; ++m) { bf16_t* rowp = base + (size_t)(row0 + ai * HALF + m * 16) * ldc + col0;
#pragma unroll
                for (int bj = 0; bj < 2; ++bj) { f32x4 v0 = acc[ai][bj][m][0] + bv[bj][0], v1 = acc[ai][bj][m][1] + bv[bj][1];
                    if (ACT == 1) { f32x2 a = gelu_pk((f32x2){v0[0], v0[1]}), b = gelu_pk((f32x2){v0[2], v0[3]}), c = gelu_pk((f32x2){v1[0], v1[1]}), d = gelu_pk((f32x2){v1[2], v1[3]});
                        v0 = (f32x4){a.x, a.y, b.x, b.y}; v1 = (f32x4){c.x, c.y, d.x, d.y}; }
                    v0 = v0 * sc; v1 = v1 * sc; u32x4 w; w.x = cvt_pk_bf16(v0[0], v0[1]); w.y = cvt_pk_bf16(v0[2], v0[3]); w.z = cvt_pk_bf16(v1[0], v1[1]); w.w = cvt_pk_bf16(v1[2], v1[3]);
                    *(u32x4*)(rowp + bj * HALF) = w; } }
    }
};
template <class Epi, class Sched, bool ALIGN_EPI = false, bool SP2 = false>
__device__ __forceinline__ void gemm_phase(PG8_LAS unsigned char* lds, const Gemm g, const Sched& S, const Epi& E) {
    const int tid = threadIdx.x, wid = __builtin_amdgcn_readfirstlane(tid >> 6), lane = tid & 63, wr = wid >> 2, wc = wid & 3, fr = lane & 15, fq = lane >> 4;
    const int K = g.K, nt = K / BK;
    unsigned voffA[2], voffB[2];
#pragma unroll
    for (int i = 0; i < 2; ++i) { int R, C; stage_rc(tid * 16 + i * 8192, R, C); const int Rb = Epi::PERM ? ((R & ~31) + perm32(R & 31)) : R;
        voffA[i] = (unsigned)(R * K + C) * 2u; voffB[i] = (unsigned)(Rb * K + C) * 2u; }
    const size_t kstep = (size_t)(BK * 2);
    const size_t hstep = (size_t)HALF * K * 2;
    const size_t tstep = 2 * hstep;
    const unsigned ldsw = (unsigned)wid * 1024u;
    const int aoff = lds_byte(wr * 64 + fr, fq * 8), boff = lds_byte(wc * 32 + fr, fq * 8);
#define PG8_SA(b, h) (((b) * 2 + (h)) * HTB)
#define PG8_SB(b, h) ((4 + (b) * 2 + (h)) * HTB)
#define PG8_STAGE(bufoff, gbase, voff) do { _Pragma("unroll") for (int _i = 0; _i < 2; ++_i) \
        __builtin_amdgcn_global_load_lds((const unsigned*)((const char*)(gbase) + (voff)[_i]), (PG8_LAS unsigned*)(lds + (bufoff) + ldsw + _i * 8192), 16, 0, 0); } while (0)
#define PG8_LDA(dst, b, h) do { _Pragma("unroll") for (int m = 0; m < 4; ++m) _Pragma("unroll") for (int k = 0; k < 2; ++k) dst[m][k] = *(const PG8_LAS bf16x8*)(lds + PG8_SA(b, h) + aoff + m * 2048 + k * 1024); } while (0)
#define PG8_LDB(dst, b, h) do { _Pragma("unroll") for (int n = 0; n < 2; ++n) _Pragma("unroll") for (int k = 0; k < 2; ++k) dst[n][k] = *(const PG8_LAS bf16x8*)(lds + PG8_SB(b, h) + boff + n * 2048 + k * 1024); } while (0)
#define PG8_MMA(ai, bj, At, Bt) do { __builtin_amdgcn_s_setprio(1); _Pragma("unroll") for (int m = 0; m < 4; ++m) _Pragma("unroll") for (int n = 0; n < 2; ++n) _Pragma("unroll") for (int k = 0; k < 2; ++k) \
        acc[ai][bj][m][n] = __builtin_amdgcn_mfma_f32_16x16x32_bf16(Bt[n][k], At[m][k], acc[ai][bj][m][n], 0, 0, 0); __builtin_amdgcn_s_setprio(0); } while (0)
#define PG8_WAIT_V(n) asm volatile("s_waitcnt vmcnt(" #n ")" ::: "memory")
#define PG8_WAIT_L(n) asm volatile("s_waitcnt lgkmcnt(" #n ")" ::: "memory")
#define PG8_BAR __builtin_amdgcn_s_barrier()
#define PG8_SCHED __builtin_amdgcn_sched_barrier(0)
    Unit cur, nxt; int ui = 0;
    if (!S.next(0, cur)) return;
    f32x4 acc[2][2][4][2];
#pragma unroll
    for (int a = 0; a < 2; ++a)
#pragma unroll
        for (int b = 0; b < 2; ++b)
#pragma unroll
            for (int m = 0; m < 4; ++m)
#pragma unroll
                for (int n = 0; n < 2; ++n) acc[a][b][m][n] = (f32x4){0.f, 0.f, 0.f, 0.f};
    bf16x8 At[4][2], B0[2][2], B1[2][2];
    const char* cA = (const char*)g.A + (size_t)cur.pm * tstep; const char* cB = (const char*)g.Bt + (size_t)cur.pn * tstep;
    S.a_ready(cur);
    if constexpr (SP2) {
        PG8_STAGE(PG8_SB(0, 0), cB, voffB); PG8_STAGE(PG8_SB(0, 1), cB + hstep, voffB); PG8_STAGE(PG8_SA(0, 0), cA, voffA); PG8_STAGE(PG8_SA(0, 1), cA + hstep, voffA);
        if (wr == 1) PG8_BAR;
        PG8_WAIT_V(2); PG8_BAR;
        PG8_STAGE(PG8_SB(1, 0), cB + kstep, voffB); PG8_STAGE(PG8_SA(1, 0), cA + kstep, voffA); PG8_STAGE(PG8_SB(1, 1), cB + hstep + kstep, voffB);
        PG8_WAIT_V(6); PG8_BAR;
    } else {
        PG8_STAGE(PG8_SB(0, 0), cB, voffB); PG8_STAGE(PG8_SA(0, 0), cA, voffA); PG8_STAGE(PG8_SB(0, 1), cB + hstep, voffB); PG8_STAGE(PG8_SA(0, 1), cA + hstep, voffA);
        if (wr == 1) PG8_BAR;
        PG8_WAIT_V(4); PG8_BAR;
        PG8_STAGE(PG8_SB(1, 0), cB + kstep, voffB); PG8_STAGE(PG8_SA(1, 0), cA + kstep, voffA); PG8_STAGE(PG8_SB(1, 1), cB + hstep + kstep, voffB);
        PG8_WAIT_V(6); PG8_BAR;
    }
    for (;;) {
        const bool has_next = S.next(ui + 1, nxt);
        const char* nA = has_next ? (const char*)g.A + (size_t)nxt.pm * tstep : cA; const char* nB = has_next ? (const char*)g.Bt + (size_t)nxt.pn * tstep : cB;
        for (int t = 0; t < nt; t += 2) {
            const bool last = (t == nt - 2);
            const char* a1 = cA + (size_t)(t + 1) * kstep;
            const char* a2 = last ? nA : cA + (size_t)(t + 2) * kstep; const char* b2 = last ? nB : cB + (size_t)(t + 2) * kstep;
            const char* a3 = a2 + kstep; const char* b3 = b2 + kstep;
            if (last && has_next) S.a_ready(nxt);
            if constexpr (SP2) {
            PG8_LDB(B0, 0, 0); PG8_LDB(B1, 0, 1); PG8_SCHED; PG8_LDA(At, 0, 0); PG8_STAGE(PG8_SA(1, 1), a1 + hstep, voffA);
            PG8_WAIT_V(8); PG8_WAIT_L(0); PG8_BAR; PG8_MMA(0, 0, At, B0); PG8_MMA(0, 1, At, B1); PG8_BAR; PG8_SCHED;
            PG8_LDA(At, 0, 1); PG8_STAGE(PG8_SB(0, 0), b2, voffB); PG8_STAGE(PG8_SB(0, 1), b2 + hstep, voffB); PG8_STAGE(PG8_SA(0, 0), a2, voffA);
            PG8_WAIT_V(8); PG8_WAIT_L(0); PG8_BAR; PG8_MMA(1, 0, At, B0); PG8_MMA(1, 1, At, B1); PG8_BAR; PG8_SCHED;
            PG8_LDB(B0, 1, 0); PG8_LDB(B1, 1, 1); PG8_SCHED; PG8_LDA(At, 1, 0); PG8_STAGE(PG8_SA(0, 1), a2 + hstep, voffA);
            PG8_WAIT_V(8); PG8_WAIT_L(0); PG8_BAR; PG8_MMA(0, 0, At, B0); PG8_MMA(0, 1, At, B1); PG8_BAR; PG8_SCHED;
            PG8_LDA(At, 1, 1); PG8_STAGE(PG8_SB(1, 0), b3, voffB); PG8_STAGE(PG8_SB(1, 1), b3 + hstep, voffB); PG8_STAGE(PG8_SA(1, 0), a3, voffA);
            PG8_WAIT_V(8); PG8_WAIT_L(0); PG8_BAR; PG8_MMA(1, 0, At, B0); PG8_MMA(1, 1, At, B1); PG8_BAR; PG8_SCHED;
            } else {
            PG8_LDB(B0, 0, 0); PG8_SCHED; PG8_LDA(At, 0, 0); PG8_STAGE(PG8_SA(1, 1), a1 + hstep, voffA);
            PG8_WAIT_L(8); PG8_BAR; PG8_WAIT_L(0); PG8_MMA(0, 0, At, B0); PG8_BAR; PG8_SCHED;
            PG8_LDB(B1, 0, 1); PG8_STAGE(PG8_SB(0, 0), b2, voffB);
            PG8_BAR; PG8_WAIT_L(0); PG8_MMA(0, 1, At, B1); PG8_BAR;
            PG8_LDA(At, 0, 1); PG8_STAGE(PG8_SA(0, 0), a2, voffA);
            PG8_BAR; PG8_WAIT_L(0); PG8_MMA(1, 0, At, B0); PG8_BAR; PG8_SCHED;
            PG8_STAGE(PG8_SB(0, 1), b2 + hstep, voffB);
            PG8_WAIT_V(6); PG8_BAR; PG8_MMA(1, 1, At, B1); PG8_BAR;
            PG8_LDB(B0, 1, 0); PG8_SCHED; PG8_LDA(At, 1, 0); PG8_STAGE(PG8_SA(0, 1), a2 + hstep, voffA);
            PG8_WAIT_L(8); PG8_BAR; PG8_WAIT_L(0); PG8_MMA(0, 0, At, B0); PG8_BAR; PG8_SCHED;
            PG8_LDB(B1, 1, 1); PG8_STAGE(PG8_SB(1, 0), b3, voffB);
            PG8_BAR; PG8_WAIT_L(0); PG8_MMA(0, 1, At, B1); PG8_BAR;
            PG8_LDA(At, 1, 1); PG8_STAGE(PG8_SA(1, 0), a3, voffA);
            PG8_BAR; PG8_WAIT_L(0); PG8_MMA(1, 0, At, B0); PG8_BAR; PG8_SCHED;
            PG8_STAGE(PG8_SB(1, 1), b3 + hstep, voffB);
            PG8_WAIT_V(6); PG8_BAR; PG8_MMA(1, 1, At, B1); PG8_BAR;
            }
        }
        if constexpr (ALIGN_EPI) { if (wr == 0) PG8_BAR; }
        if constexpr (!Epi::AFTER_DRAIN) { E(acc, cur, wr, wc, fr, fq); S.done(cur); }
        if (!has_next) break;
#pragma unroll
        for (int a = 0; a < 2; ++a)
#pragma unroll
            for (int b = 0; b < 2; ++b)
#pragma unroll
                for (int m = 0; m < 4; ++m)
#pragma unroll
                    for (int n = 0; n < 2; ++n) acc[a][b][m][n] = (f32x4){0.f, 0.f, 0.f, 0.f};
        cur = nxt; cA = nA; cB = nB; ++ui;
        if constexpr (ALIGN_EPI) { if (wr == 1) PG8_BAR; }
    }
    PG8_WAIT_V(0);
    if constexpr (!ALIGN_EPI) { if (wr == 0) PG8_BAR; }
    PG8_BAR;
    if constexpr (Epi::AFTER_DRAIN) { E.fused(acc, cur, wr, wc, fr, fq, lds, wid, lane); S.done(cur); }
#undef PG8_SA
#undef PG8_SB
#undef PG8_STAGE
#undef PG8_LDA
#undef PG8_LDB
#undef PG8_MMA
#undef PG8_WAIT_V
#undef PG8_WAIT_L
#undef PG8_BAR
#undef PG8_SCHED
}

struct EpiResF32 {
    static constexpr bool PERM = false, AFTER_DRAIN = false;
    const float* base; float* out; int ldc;
    __device__ __forceinline__ void operator()(const f32x4 (&acc)[2][2][4][2], const Unit& u, int wr, int wc, int fr, int fq) const {
        const int col0 = u.pn * BM + wc * 32 + 4 * fq;
#pragma unroll
        for (int ai = 0; ai < 2; ++ai)
#pragma unroll
            for (int m = 0; m < 4; ++m) { const int r = ai * HALF + wr * 64 + m * 16 + fr; const size_t off = (size_t)(u.pm * BM + r) * ldc + col0;
#pragma unroll
                for (int bj = 0; bj < 2; ++bj)
#pragma unroll
                    for (int n = 0; n < 2; ++n) { const f32x4 bs = *(const f32x4*)(base + off + bj * HALF + n * 16); *(f32x4*)(out + off + bj * HALF + n * 16) = bs + acc[ai][bj][m][n]; } }
    }
};
}

constexpr int BATCH = 4, SEQ = 8192, DM = 1024, M = BATCH * SEQ;
constexpr int NIN = 3088, NIN_PAD = 3328;
constexpr int C_GQ = 0, C_GK = 256, C_GV = 512, C_GG = 1024, C_AQ = 1536, C_AK = 2048, C_AV = 2560, C_GLR = 3072;
constexpr int NEXP = 16384;
constexpr float NORM_EPS = 1e-6f;
constexpr int NWAVES = 8, NTHREADS = 512;

constexpr size_t MiB = 1u << 20;
constexpr size_t WS_CTL = 0, CTL_ZERO_BYTES = 1 * MiB;
constexpr size_t WS_WT_IN = 1 * MiB;
constexpr size_t WS_WT_OUT = 8 * MiB;
constexpr size_t WS_WT_CIN = 10 * MiB;
constexpr size_t WS_WT_COUT = 14 * MiB;
constexpr size_t WS_WT_Q0 = 16 * MiB;
constexpr size_t WS_WT_Q1 = 20 * MiB;
constexpr size_t WS_ACT = 32 * MiB;
constexpr size_t WS_S = 96 * MiB;
constexpr size_t WS_PROJ = WS_S;
constexpr size_t WS_GLAO = WS_S + 208 * MiB;
constexpr size_t WS_TOPS = WS_S + 128 * MiB;
constexpr size_t WS_TOPI = WS_S + 160 * MiB;
constexpr size_t WS_IDS = WS_S + 192 * MiB;
constexpr size_t WS_G = WS_S + 208 * MiB;
constexpr size_t WS_XC = WS_ACT;
constexpr size_t WS_A = WS_S + 128 * MiB;
constexpr size_t WS_YP = WS_S + 256 * MiB;
constexpr size_t WS_Y0 = WS_S + 320 * MiB;
constexpr size_t WS_U = WS_S + 256 * MiB;
constexpr size_t WS_TAB = 448 * MiB;
constexpr size_t WS_TAB8 = 448 * MiB;
constexpr size_t WS_WG = 24 * MiB;
constexpr size_t WS_AGG = WS_S + 128 * MiB;
constexpr size_t WS_SCL = 26 * MiB;
constexpr size_t WS_END = 512 * MiB;
constexpr int CW_BAR = 4096, CW_RANK = 8192;

constexpr int RING_BYTES = 131072;
constexpr int LDS_BYTES = 147456;
constexpr int LDSCTL_OFF = LDS_BYTES - 512, MISC_OFF = LDSCTL_OFF + 320;

#define LAS __attribute__((address_space(3)))
#define GAS __attribute__((address_space(1)))
typedef unsigned short bf16_t;
typedef float f32x4 __attribute__((ext_vector_type(4)));
typedef unsigned u32x4 __attribute__((ext_vector_type(4)));
typedef unsigned u32x2 __attribute__((ext_vector_type(2)));
typedef short bf16x8 __attribute__((ext_vector_type(8)));
typedef float f32x2 __attribute__((ext_vector_type(2)));

struct Params {
    const float *x, *mix_norm, *ffn_norm, *ab_w_in, *gla_w_alpha, *gla_b_alpha, *gla_head_gain, *ab_w_out;
    const float *c_w_in, *c_conv_w, *c_conv_b, *c_w_rgate, *c_b_rgate, *c_w_igate, *c_b_igate, *c_lambda, *c_w_out;
    const float *peer_w_query, *peer_sub_keys, *peer_u, *peer_v, *final_norm;
    float* out; unsigned char* ws;
    int ph_lo, ph_hi;
};

typedef float f32x2_cv __attribute__((ext_vector_type(2))); typedef __bf16 bf16x2_cv __attribute__((ext_vector_type(2)));
__device__ __forceinline__ unsigned pk2(float lo, float hi) { const f32x2_cv v = {lo, hi}; const bf16x2_cv b = __builtin_convertvector(v, bf16x2_cv); return __builtin_bit_cast(unsigned, b); }
__device__ __forceinline__ unsigned f2bf(float f) { return pk2(f, f) & 0xffffu; }
__device__ __forceinline__ float bf2f(bf16_t b) { return __builtin_bit_cast(float, (unsigned)b << 16); }
__device__ __forceinline__ float bflo(unsigned w) { return __builtin_bit_cast(float, w << 16); }
__device__ __forceinline__ float bfhi(unsigned w) { return __builtin_bit_cast(float, w & 0xffff0000u); }
__device__ __forceinline__ float wave_sum(float v) {
#pragma unroll
    for (int o = 1; o < 64; o <<= 1) v += __shfl_xor(v, o);
    return v;
}
__device__ __forceinline__ float gelu_tanh(float x) {
    const float x2 = x * x, u2 = x * (2.3022082f + 0.10294324f * x2);
    const float e = __builtin_amdgcn_exp2f(u2);
    return x - x * __builtin_amdgcn_rcpf(e + 1.f);
}
__device__ __forceinline__ float sigmoidf_(float x) { return __builtin_amdgcn_rcpf(1.f + __expf(-x)); }

struct Ctx { int tid, lane, wave, blk, nblk, gtid, gthreads, gwave, gwaves; LAS unsigned char* lds; };

template <class F> __device__ __forceinline__ void transpose_cvt(const float* W, int K, int Nsrc, bf16_t* WT, int Ndst, F srcmap, int gtid, int gthreads) {
    const int total = (K / 8) * Ndst;
    for (int idx = gtid; idx < total; idx += gthreads) {
        const int ko = idx / Ndst, n = idx - ko * Ndst; const int sn = srcmap(n);
        u32x4 w = {0u, 0u, 0u, 0u};
        if (sn >= 0) { const float* s = W + (size_t)(ko * 8) * Nsrc + sn;
            w.x = pk2(s[0], s[(size_t)Nsrc]); w.y = pk2(s[2 * (size_t)Nsrc], s[3 * (size_t)Nsrc]); w.z = pk2(s[4 * (size_t)Nsrc], s[5 * (size_t)Nsrc]); w.w = pk2(s[6 * (size_t)Nsrc], s[7 * (size_t)Nsrc]); }
        *(u32x4*)(WT + (size_t)n * K + ko * 8) = w;
    }
}
__device__ __forceinline__ void cvt_bf16(const float* src, bf16_t* dst, size_t n8, int gtid, int gthreads) {
    for (size_t i = gtid; i < n8; i += gthreads) { const f32x4 a = *(const f32x4*)(src + i * 8), b = *(const f32x4*)(src + i * 8 + 4);
        u32x4 w; w.x = pk2(a.x, a.y); w.y = pk2(a.z, a.w); w.z = pk2(b.x, b.y); w.w = pk2(b.z, b.w); *(u32x4*)(dst + i * 8) = w; }
}
__device__ __forceinline__ void norm_rows_bf16(const float* src, const float* gain, bf16_t* dst, const Ctx& c, unsigned char* x8 = nullptr) {
    for (int m0 = c.gwave; m0 < M; m0 += 4 * c.gwaves) {
        f32x4 v[4][4]; float s[4];
#pragma unroll
        for (int u = 0; u < 4; ++u) { const f32x4* xr = (const f32x4*)(src + (size_t)min(m0 + u * c.gwaves, M - 1) * DM) + c.lane;
#pragma unroll
            for (int j = 0; j < 4; ++j) v[u][j] = xr[64 * j]; }
#pragma unroll
        for (int u = 0; u < 4; ++u) { s[u] = 0.f;
#pragma unroll
            for (int j = 0; j < 4; ++j) s[u] += (v[u][j].x * v[u][j].x + v[u][j].y * v[u][j].y) + (v[u][j].z * v[u][j].z + v[u][j].w * v[u][j].w); }
#pragma unroll
        for (int o = 1; o < 64; o <<= 1) {
#pragma unroll
            for (int u = 0; u < 4; ++u) s[u] += __shfl_xor(s[u], o); }
#pragma unroll
        for (int u = 0; u < 4; ++u) { const int m = m0 + u * c.gwaves; if (m >= M) break; const float rstd = __builtin_amdgcn_rsqf(s[u] * (1.f / DM) + NORM_EPS);
            u32x2* o8 = (u32x2*)(dst + (size_t)m * DM) + c.lane;
#pragma unroll
            for (int j = 0; j < 4; ++j) { const f32x4 g = *((const f32x4*)gain + 64 * j + c.lane); const unsigned w0 = pk2(v[u][j].x * rstd * g.x, v[u][j].y * rstd * g.y), w1 = pk2(v[u][j].z * rstd * g.z, v[u][j].w * rstd * g.w);
                u32x2 w; w.x = w0; w.y = w1; o8[64 * j] = w;
                if (x8) {
                    const float f0 = bflo(w0), f1 = bfhi(w0), f2 = bflo(w1), f3 = bfhi(w1);
                    int hq = __builtin_amdgcn_cvt_pk_fp8_f32(f0, f1, 0, false); hq = __builtin_amdgcn_cvt_pk_fp8_f32(f2, f3, hq, true);
                    const f32x2 d0 = __builtin_amdgcn_cvt_pk_f32_fp8(hq, false), d1 = __builtin_amdgcn_cvt_pk_f32_fp8(hq, true);
                    int lq = __builtin_amdgcn_cvt_pk_fp8_f32((f0 - d0.x) * 16.f, (f1 - d0.y) * 16.f, 0, false); lq = __builtin_amdgcn_cvt_pk_fp8_f32((f2 - d1.x) * 16.f, (f3 - d1.y) * 16.f, lq, true);
                    unsigned* xo = (unsigned*)(x8 + (size_t)m * 2048) + 64 * j + c.lane; xo[0] = (unsigned)hq; xo[256] = (unsigned)lq; } } }
    }
}
__device__ __forceinline__ void norm_rows_f32(float* buf, const float* gain, const Ctx& c) {
    for (int m0 = c.gwave; m0 < M; m0 += 4 * c.gwaves) {
        f32x4 v[4][4]; float s[4];
#pragma unroll
        for (int u = 0; u < 4; ++u) { const f32x4* xr = (const f32x4*)(buf + (size_t)min(m0 + u * c.gwaves, M - 1) * DM) + c.lane;
#pragma unroll
            for (int j = 0; j < 4; ++j) v[u][j] = xr[64 * j]; }
#pragma unroll
        for (int u = 0; u < 4; ++u) { s[u] = 0.f;
#pragma unroll
            for (int j = 0; j < 4; ++j) s[u] += (v[u][j].x * v[u][j].x + v[u][j].y * v[u][j].y) + (v[u][j].z * v[u][j].z + v[u][j].w * v[u][j].w); }
#pragma unroll
        for (int o = 1; o < 64; o <<= 1) {
#pragma unroll
            for (int u = 0; u < 4; ++u) s[u] += __shfl_xor(s[u], o); }
#pragma unroll
        for (int u = 0; u < 4; ++u) { if (m0 + u * c.gwaves >= M) break; const float rstd = __builtin_amdgcn_rsqf(s[u] * (1.f / DM) + NORM_EPS); f32x4* xw = (f32x4*)(buf + (size_t)(m0 + u * c.gwaves) * DM) + c.lane;
#pragma unroll
            for (int j = 0; j < 4; ++j) { const f32x4 g = *((const f32x4*)gain + 64 * j + c.lane); xw[64 * j] = v[u][j] * rstd * g; } }
    }
}

constexpr size_t WS_GLRB = 30 * MiB;
__device__ __forceinline__ void ph_glr(const Params& p, const Ctx& c) {
    const bf16_t* XN = (const bf16_t*)(p.ws + WS_ACT); const bf16_t* WG = (const bf16_t*)(p.ws + WS_WT_IN) + (size_t)3072 * DM; bf16_t* GL = (bf16_t*)(p.ws + WS_GLRB);
    const int lane = c.lane, r = lane & 15, q = lane >> 4;
    for (int tile = c.gwave; tile < M / 16; tile += c.gwaves) {
        const bf16_t* ap = XN + (size_t)(tile * 16 + r) * DM + 8 * q; const bf16_t* bp = WG + (size_t)r * DM + 8 * q;
        f32x4 acc = {0.f, 0.f, 0.f, 0.f};
#pragma unroll 8
        for (int s2 = 0; s2 < 32; ++s2) acc = __builtin_amdgcn_mfma_f32_16x16x32_bf16(__builtin_bit_cast(bf16x8, *(const u32x4*)(ap + 32 * s2)), __builtin_bit_cast(bf16x8, *(const u32x4*)(bp + 32 * s2)), acc, 0, 0, 0);
#pragma unroll
        for (int i = 0; i < 4; ++i) GL[(size_t)(tile * 16 + 4 * q + i) * 16 + r] = (bf16_t)f2bf(acc[i]);
    }
}


constexpr int AT_K = 0, AT_V = 272 * 144, AT_END = 2 * 272 * 144;
typedef short s16x4 __attribute__((ext_vector_type(4)));
__device__ __forceinline__ s16x4 lds_tr16(LAS const unsigned char* pbyte) { return __builtin_bit_cast(s16x4, __builtin_amdgcn_ds_read_tr16_b64_v4i16((LAS s16x4*)pbyte)); }
__device__ __forceinline__ void ph_attn(const Params& p, const Ctx& c) {
    LAS unsigned char* L = c.lds;
    const bf16_t* proj = (const bf16_t*)(p.ws + WS_PROJ); bf16_t* AO = (bf16_t*)p.out; float* LSE = (float*)((unsigned char*)p.out + 96 * MiB);
    const int tid = c.tid, lane = c.lane, w = c.wave, r = lane & 15, qq = lane >> 4;
    constexpr float LOG2E = 1.4426950408889634f;
    __syncthreads();
    for (int i = tid; i < 16 * 144 / 4; i += NTHREADS) ((LAS unsigned*)(L + AT_V + 256 * 144))[i] = 0u;
    u32x4 kreg[4], vreg[4], qreg[2];
#define AT_DECODE(it_) const int h = (it_) & 7, rest = (it_) >> 3, br = rest >> 8, u = rest & 255, sh = 2 * br, dil = 1 << sh, nbm = (64 >> sh) - 1; \
        const int bres = u >> (6 - sh), blk = u & nbm, b = bres >> sh, res = bres & (dil - 1); const size_t rowb = (size_t)b * SEQ; const int l0 = blk * 128
#define AT_ISSUE(it_) do { AT_DECODE(it_); (void)br; \
        _Pragma("unroll") for (int k = 0; k < 4; ++k) { const int idx = tid + NTHREADS * k, row = idx >> 3, ch = idx & 7, l = l0 - 128 + row; kreg[k] = (u32x4){0u, 0u, 0u, 0u}; vreg[k] = kreg[k]; \
            if (l >= 0) { const bf16_t* src = proj + (rowb + (size_t)l * dil + res) * NIN_PAD + C_AK + h * 64 + ch * 8; kreg[k] = *(const u32x4*)src; vreg[k] = *(const u32x4*)(src + 512); } } \
        const bf16_t* qp = proj + (rowb + (size_t)(l0 + 16 * w + r) * dil + res) * NIN_PAD + C_AQ + h * 64 + 8 * qq; qreg[0] = *(const u32x4*)qp; qreg[1] = *(const u32x4*)(qp + 32); } while (0)
    if (c.blk < 6144) AT_ISSUE(c.blk);
    for (int item = c.blk; item < 6144; item += c.nblk) {
        AT_DECODE(item);
        __syncthreads();
#pragma unroll
        for (int k = 0; k < 4; ++k) { const int idx = tid + NTHREADS * k, row = idx >> 3, ch = idx & 7;
            *(LAS u32x4*)(L + AT_K + row * 144 + ch * 16) = kreg[k]; *(LAS u32x4*)(L + AT_V + row * 144 + ch * 16) = vreg[k]; }
        bf16x8 qf[2]; qf[0] = __builtin_bit_cast(bf16x8, qreg[0]); qf[1] = __builtin_bit_cast(bf16x8, qreg[1]);
        { const int nit = item + c.nblk; if (nit < 6144) AT_ISSUE(nit); }
        __syncthreads();
        f32x4 sa[9];
#pragma unroll
        for (int jn = 0; jn < 9; ++jn) { LAS const unsigned char* kp = L + AT_K + (16 * (w + jn) + r) * 144 + 16 * qq;
            const bf16x8 k0 = __builtin_bit_cast(bf16x8, *(const LAS u32x4*)kp), k1 = __builtin_bit_cast(bf16x8, *(const LAS u32x4*)(kp + 64));
            f32x4 z = {0.f, 0.f, 0.f, 0.f}; z = __builtin_amdgcn_mfma_f32_16x16x32_bf16(k0, qf[0], z, 0, 0, 0); sa[jn] = __builtin_amdgcn_mfma_f32_16x16x32_bf16(k1, qf[1], z, 0, 0, 0); }
        const float sc = 0.125f * LOG2E, sl = exp2f(-(float)(h + 1)) * (float)dil * LOG2E;
        const int delta0 = r + 128 - 4 * qq;
        const float b0 = -sl * (float)delta0;
        float mx = -1e30f;
        if (blk > 0) {
#pragma unroll
            for (int jn = 0; jn < 9; ++jn)
#pragma unroll
                for (int i = 0; i < 4; ++i) { const bool valid = (unsigned)(delta0 - (16 * jn + i)) <= 128u;
                    const float v = valid ? __builtin_fmaf(sa[jn][i], sc, __builtin_fmaf(sl, (float)(16 * jn + i), b0)) : -1e30f; sa[jn][i] = v; mx = fmaxf(mx, v); }
        } else {
#pragma unroll
            for (int jn = 0; jn < 9; ++jn)
#pragma unroll
                for (int i = 0; i < 4; ++i) { const bool valid = ((unsigned)(delta0 - (16 * jn + i)) <= 128u) && (16 * (w + jn) + 4 * qq + i >= 128);
                    const float v = valid ? __builtin_fmaf(sa[jn][i], sc, __builtin_fmaf(sl, (float)(16 * jn + i), b0)) : -1e30f; sa[jn][i] = v; mx = fmaxf(mx, v); }
        }
        mx = fmaxf(mx, __shfl_xor(mx, 16)); mx = fmaxf(mx, __shfl_xor(mx, 32));
        float sum = 0.f;
#pragma unroll
        for (int jn = 0; jn < 9; ++jn)
#pragma unroll
            for (int i = 0; i < 4; ++i) { const float e = __builtin_amdgcn_exp2f(sa[jn][i] - mx); sa[jn][i] = e; sum += e; }
        sum += __shfl_xor(sum, 16); sum += __shfl_xor(sum, 32);
        { const int qi = 16 * w + r; if (qq == 0) LSE[((size_t)br * M + rowb + (size_t)(l0 + qi) * dil + res) * 8 + h] = (mx + __builtin_amdgcn_logf(sum)) * (1.f / LOG2E); }
        f32x4 oa[4];
#pragma unroll
        for (int dt = 0; dt < 4; ++dt) oa[dt] = (f32x4){0.f, 0.f, 0.f, 0.f};
#pragma unroll
        for (int s2 = 0; s2 < 5; ++s2) { u32x4 pw; pw.x = pk2(sa[2 * s2][0], sa[2 * s2][1]); pw.y = pk2(sa[2 * s2][2], sa[2 * s2][3]);
            if (s2 < 4) { pw.z = pk2(sa[2 * s2 + 1][0], sa[2 * s2 + 1][1]); pw.w = pk2(sa[2 * s2 + 1][2], sa[2 * s2 + 1][3]); } else { pw.z = 0u; pw.w = 0u; }
            LAS const unsigned char* vp = L + AT_V + (16 * (w + 2 * s2) + 4 * qq + (r >> 2)) * 144 + 8 * (r & 3);
#pragma unroll
            for (int dt = 0; dt < 4; ++dt) { const s16x4 v0 = lds_tr16(vp + 32 * dt), v1 = lds_tr16(vp + 32 * dt + 16 * 144);
                const bf16x8 vf = {v0[0], v0[1], v0[2], v0[3], v1[0], v1[1], v1[2], v1[3]};
                oa[dt] = __builtin_amdgcn_mfma_f32_16x16x32_bf16(__builtin_bit_cast(bf16x8, pw), vf, oa[dt], 0, 0, 0); } }
        const float rs = __builtin_amdgcn_rcpf(sum);
        LAS bf16_t* ost = (LAS bf16_t*)(L + AT_END + w * 2304);
#pragma unroll
        for (int i = 0; i < 4; ++i) { const float ri = __shfl(rs, 4 * qq + i);
#pragma unroll
            for (int dt = 0; dt < 4; ++dt) ost[(4 * qq + i) * 72 + 16 * dt + r] = (bf16_t)f2bf(oa[dt][i] * ri); }
        asm volatile("" ::: "memory");
        { const int qi = lane >> 2, dc = (lane & 3) * 16;
          const u32x4 o0 = *(const LAS u32x4*)(ost + qi * 72 + dc), o1 = *(const LAS u32x4*)(ost + qi * 72 + dc + 8);
          bf16_t* op = AO + ((size_t)br * M + rowb + (size_t)(l0 + 16 * w + qi) * dil + res) * 512 + h * 64 + dc;
          *(u32x4*)op = o0; *(u32x4*)(op + 8) = o1; }
        asm volatile("" ::: "memory");
    }
#undef AT_DECODE
#undef AT_ISSUE
}

constexpr size_t WS_CKV = WS_S + 272 * MiB;
constexpr size_t WS_DEC = WS_S + 336 * MiB;
constexpr size_t WS_SPREV = WS_ACT;
constexpr int GL_SEGT = 0, GL_V = 2048, GL_KT = GL_V + 64 * 272, GL_QD = GL_KT + 64 * 144, GL_KI = GL_QD + 64 * 144, GL_END = GL_KI + 64 * 144;
#ifdef GLR_FROM_PROJ
#define GLR_SRC (prow0 + C_GLR), NIN_PAD
#else
#define GLR_SRC ((const bf16_t*)(p.ws + WS_GLRB) + (size_t)bn * 64 * 16), 16
#endif
__device__ __forceinline__ void gla_cumdecay(const Params& p, const Ctx& c, const bf16_t* glr0, int gstride, int h, float (&bcum)[8], float& blast) {
    LAS float* SEGT = (LAS float*)(c.lds + GL_SEGT);
    const int kk = c.tid & 63, w = c.wave;
    float wa[16];
#pragma unroll
    for (int r = 0; r < 16; ++r) wa[r] = p.gla_w_alpha[r * 256 + h * 64 + kk];
    const float ba = p.gla_b_alpha[h * 64 + kk];
    float run = 0.f;
#pragma unroll
    for (int k = 0; k < 8; ++k) { const bf16_t* pr = glr0 + (size_t)(8 * w + k) * gstride;
        const u32x4 g0 = *(const u32x4*)pr, g1 = *(const u32x4*)(pr + 8);
        float z = ba + bflo(g0.x) * wa[0] + bfhi(g0.x) * wa[1] + bflo(g0.y) * wa[2] + bfhi(g0.y) * wa[3] + bflo(g0.z) * wa[4] + bfhi(g0.z) * wa[5] + bflo(g0.w) * wa[6] + bfhi(g0.w) * wa[7]
                     + bflo(g1.x) * wa[8] + bfhi(g1.x) * wa[9] + bflo(g1.y) * wa[10] + bfhi(g1.y) * wa[11] + bflo(g1.z) * wa[12] + bfhi(g1.z) * wa[13] + bflo(g1.w) * wa[14] + bfhi(g1.w) * wa[15];
        const float ls = fminf(z, 0.f) - __logf(1.f + __expf(-fabsf(z)));
        run += ls * (1.f / 16.f); bcum[k] = run; }
    __syncthreads();
    SEGT[w * 64 + kk] = run;
    __syncthreads();
    float off = 0.f, tot = 0.f;
#pragma unroll
    for (int sg = 0; sg < 8; ++sg) { const float v = SEGT[sg * 64 + kk]; off += (sg < w) ? v : 0.f; tot += v; }
#pragma unroll
    for (int k = 0; k < 8; ++k) bcum[k] += off;
    blast = tot;
}
__device__ __forceinline__ void gla_stage_v(const Ctx& c, const bf16_t* prow0, int h) {
#pragma unroll
    for (int k = 0; k < 2; ++k) { const int idx = c.tid + NTHREADS * k, row = idx >> 4, ch = idx & 15;
        *(LAS u32x4*)(c.lds + GL_V + row * 272 + ch * 16) = *(const u32x4*)(prow0 + (size_t)row * NIN_PAD + C_GV + h * 128 + ch * 8); }
}
__device__ __forceinline__ void ph_gla_a(const Params& p, const Ctx& c) {
    LAS unsigned char* L = c.lds; const bf16_t* proj = (const bf16_t*)(p.ws + WS_PROJ);
    float* CKV = (float*)(p.ws + WS_CKV); float* DEC = (float*)(p.ws + WS_DEC);
    const int tid = c.tid, lane = c.lane, w = c.wave, r = lane & 15, qq = lane >> 4, kk = tid & 63;
    for (int item = c.blk; item < 2048; item += c.nblk) {
        const int h = item & 3, bn = item >> 2; const bf16_t* prow0 = proj + (size_t)bn * 64 * NIN_PAD;
        float bcum[8], blast; gla_cumdecay(p, c, GLR_SRC, h, bcum, blast);
        gla_stage_v(c, prow0, h);
        { u32x4 o; float e[8];
#pragma unroll
          for (int k = 0; k < 8; ++k) e[k] = bf2f(prow0[(size_t)(8 * w + k) * NIN_PAD + C_GK + h * 64 + kk]) * __expf(blast - bcum[k]);
          o.x = pk2(e[0], e[1]); o.y = pk2(e[2], e[3]); o.z = pk2(e[4], e[5]); o.w = pk2(e[6], e[7]);
          *(LAS u32x4*)(L + GL_KT + kk * 144 + 16 * w) = o; }
        if (w == 0) DEC[(size_t)item * 64 + kk] = __expf(blast);
        __syncthreads();
        f32x4 acc[4];
#pragma unroll
        for (int n = 0; n < 4; ++n) acc[n] = (f32x4){0.f, 0.f, 0.f, 0.f};
#pragma unroll
        for (int s2 = 0; s2 < 2; ++s2) { LAS const unsigned char* vp = L + GL_V + (32 * s2 + 8 * qq + (r >> 2)) * 272 + (16 * w + 4 * (r & 3)) * 2;
            const s16x4 v0 = lds_tr16(vp), v1 = lds_tr16(vp + 4 * 272); const bf16x8 af = {v0[0], v0[1], v0[2], v0[3], v1[0], v1[1], v1[2], v1[3]};
#pragma unroll
            for (int n = 0; n < 4; ++n) { const bf16x8 bfr = __builtin_bit_cast(bf16x8, *(const LAS u32x4*)(L + GL_KT + (16 * n + r) * 144 + (32 * s2 + 8 * qq) * 2));
                acc[n] = __builtin_amdgcn_mfma_f32_16x16x32_bf16(af, bfr, acc[n], 0, 0, 0); } }
        float* outp = CKV + (size_t)item * 8192 + (16 * w + 4 * qq) * 64 + r;
#pragma unroll
        for (int n = 0; n < 4; ++n)
#pragma unroll
            for (int i = 0; i < 4; ++i) outp[i * 64 + 16 * n] = acc[n][i];
    }
}
__device__ __forceinline__ void ph_gla_b(const Params& p, const Ctx& c) {
    const float* CKV = (const float*)(p.ws + WS_CKV); const float* DEC = (const float*)(p.ws + WS_DEC); bf16_t* SP = (bf16_t*)(p.ws + WS_SPREV);
    for (int idx = c.gtid; idx < 16 * 8192; idx += c.gthreads) { const int bh = idx >> 13, e = idx & 8191, b = bh >> 2, h = bh & 3; float S = 0.f;
        for (int n0 = 0; n0 < 128; n0 += 8) { float cv[8], dv[8];
#pragma unroll
            for (int k = 0; k < 8; ++k) { const size_t item = (size_t)(b * 128 + n0 + k) * 4 + h; cv[k] = CKV[item * 8192 + e]; dv[k] = DEC[item * 64 + (e & 63)]; }
#pragma unroll
            for (int k = 0; k < 8; ++k) { const size_t item = (size_t)(b * 128 + n0 + k) * 4 + h; SP[item * 8192 + e] = (bf16_t)f2bf(S); S = dv[k] * S + cv[k]; } } }
}
__device__ __forceinline__ void ph_gla_c(const Params& p, const Ctx& c) {
    LAS unsigned char* L = c.lds; const bf16_t* proj = (const bf16_t*)(p.ws + WS_PROJ); const bf16_t* SP = (const bf16_t*)(p.ws + WS_SPREV); bf16_t* go = (bf16_t*)(p.ws + WS_GLAO);
    const int tid = c.tid, lane = c.lane, w = c.wave, r = lane & 15, qq = lane >> 4, kk = tid & 63;
    for (int item = c.blk; item < 2048; item += c.nblk) {
        const int h = item & 3, bn = item >> 2; const bf16_t* prow0 = proj + (size_t)bn * 64 * NIN_PAD;
        float bcum[8], blast; gla_cumdecay(p, c, GLR_SRC, h, bcum, blast);
        gla_stage_v(c, prow0, h);
#pragma unroll
        for (int k = 0; k < 8; ++k) { const int i = 8 * w + k; const bf16_t* pr = prow0 + (size_t)i * NIN_PAD;
            const float qv = bf2f(pr[C_GQ + h * 64 + kk]) * 0.125f * __expf(bcum[k]), kv = bf2f(pr[C_GK + h * 64 + kk]) * __expf(-bcum[k]);
            *(LAS bf16_t*)(L + GL_QD + i * 144 + kk * 2) = (bf16_t)f2bf(qv); *(LAS bf16_t*)(L + GL_KI + i * 144 + kk * 2) = (bf16_t)f2bf(kv); }
        __syncthreads();
        const int it = w & 3, vh = w >> 2;
        bf16x8 qf[2];
#pragma unroll
        for (int s2 = 0; s2 < 2; ++s2) qf[s2] = __builtin_bit_cast(bf16x8, *(const LAS u32x4*)(L + GL_QD + (16 * it + r) * 144 + (32 * s2 + 8 * qq) * 2));
        u32x2 pw[4];
#pragma unroll
        for (int jt = 0; jt < 4; ++jt) { f32x4 z = {0.f, 0.f, 0.f, 0.f};
            if (jt <= it) {
#pragma unroll
                for (int s2 = 0; s2 < 2; ++s2) { const bf16x8 kf = __builtin_bit_cast(bf16x8, *(const LAS u32x4*)(L + GL_KI + (16 * jt + r) * 144 + (32 * s2 + 8 * qq) * 2));
                    z = __builtin_amdgcn_mfma_f32_16x16x32_bf16(kf, qf[s2], z, 0, 0, 0); }
#pragma unroll
                for (int ii = 0; ii < 4; ++ii) z[ii] = (16 * jt + 4 * qq + ii <= 16 * it + r) ? z[ii] : 0.f; }
            pw[jt].x = pk2(z[0], z[1]); pw[jt].y = pk2(z[2], z[3]); }
        f32x4 acc[4];
#pragma unroll
        for (int n = 0; n < 4; ++n) acc[n] = (f32x4){0.f, 0.f, 0.f, 0.f};
#pragma unroll
        for (int s2 = 0; s2 < 2; ++s2) { if (2 * s2 <= it) {
            const u32x4 pq = {pw[2 * s2].x, pw[2 * s2].y, pw[2 * s2 + 1].x, pw[2 * s2 + 1].y};
            LAS const unsigned char* vp = L + GL_V + (32 * s2 + 4 * qq + (r >> 2)) * 272 + (64 * vh + 4 * (r & 3)) * 2;
#pragma unroll
            for (int n = 0; n < 4; ++n) { const s16x4 v0 = lds_tr16(vp + 32 * n), v1 = lds_tr16(vp + 32 * n + 16 * 272);
                const bf16x8 vf = {v0[0], v0[1], v0[2], v0[3], v1[0], v1[1], v1[2], v1[3]};
                acc[n] = __builtin_amdgcn_mfma_f32_16x16x32_bf16(__builtin_bit_cast(bf16x8, pq), vf, acc[n], 0, 0, 0); } } }
#pragma unroll
        for (int s2 = 0; s2 < 2; ++s2)
#pragma unroll
            for (int n = 0; n < 4; ++n) { const bf16x8 sf = __builtin_bit_cast(bf16x8, *(const u32x4*)(SP + (size_t)item * 8192 + (64 * vh + 16 * n + r) * 64 + 32 * s2 + 8 * qq));
                acc[n] = __builtin_amdgcn_mfma_f32_16x16x32_bf16(qf[s2], sf, acc[n], 0, 0, 0); }
        bf16_t* outp = go + ((size_t)bn * 64 + 16 * it + 4 * qq) * 512 + h * 128 + 64 * vh + r;
#pragma unroll
        for (int n = 0; n < 4; ++n)
#pragma unroll
            for (int ii = 0; ii < 4; ++ii) outp[ii * 512 + 16 * n] = (bf16_t)f2bf(acc[n][ii]);
    }
}
#ifndef ATT_COMBINE
#define ATT_COMBINE 1
#endif
__device__ __forceinline__ void ph_mix(const Params& p, const Ctx& c) {
    const bf16_t* proj = (const bf16_t*)(p.ws + WS_PROJ); const bf16_t* go = (const bf16_t*)(p.ws + WS_GLAO); bf16_t* mixed = (bf16_t*)(p.ws + WS_ACT);
    for (int m = c.gwave; m < M; m += c.gwaves) {
#pragma unroll
        for (int h = 0; h < 4; ++h) { const int col = h * 128 + 2 * c.lane;
            const unsigned ow = *(const unsigned*)(go + (size_t)m * 512 + col); const float o0 = bflo(ow), o1 = bfhi(ow);
            const float rstd = 1.f / sqrtf(wave_sum(o0 * o0 + o1 * o1) * (1.f / 128.f) + NORM_EPS);
            const unsigned gw = *(const unsigned*)(proj + (size_t)m * NIN_PAD + C_GG + col); const float g0 = bflo(gw), g1 = bfhi(gw);
            const float r0 = o0 * rstd * p.gla_head_gain[col] * (g0 * sigmoidf_(g0)), r1 = o1 * rstd * p.gla_head_gain[col + 1] * (g1 * sigmoidf_(g1));
            *(unsigned*)(mixed + (size_t)m * DM + col) = pk2(r0, r1); }
        if (ATT_COMBINE) {
            const bf16_t* AO = (const bf16_t*)p.out; const float* LSE = (const float*)((const unsigned char*)p.out + 96 * MiB); const int hh = c.lane >> 3;
            const float l0 = LSE[((size_t)0 * M + m) * 8 + hh], l1 = LSE[((size_t)1 * M + m) * 8 + hh], l2 = LSE[((size_t)2 * M + m) * 8 + hh];
            const float lm = fmaxf(l0, fmaxf(l1, l2)), e0 = __expf(l0 - lm), e1 = __expf(l1 - lm), e2 = __expf(l2 - lm), rd = __builtin_amdgcn_rcpf(e0 + e1 + e2);
            const float w0 = e0 * rd, w1 = e1 * rd, w2 = e2 * rd;
            const u32x4 a0 = *((const u32x4*)(AO + ((size_t)0 * M + m) * 512) + c.lane), a1 = *((const u32x4*)(AO + ((size_t)1 * M + m) * 512) + c.lane), a2 = *((const u32x4*)(AO + ((size_t)2 * M + m) * 512) + c.lane);
            u32x4 o;
            o.x = pk2(w0 * bflo(a0.x) + w1 * bflo(a1.x) + w2 * bflo(a2.x), w0 * bfhi(a0.x) + w1 * bfhi(a1.x) + w2 * bfhi(a2.x));
            o.y = pk2(w0 * bflo(a0.y) + w1 * bflo(a1.y) + w2 * bflo(a2.y), w0 * bfhi(a0.y) + w1 * bfhi(a1.y) + w2 * bfhi(a2.y));
            o.z = pk2(w0 * bflo(a0.z) + w1 * bflo(a1.z) + w2 * bflo(a2.z), w0 * bfhi(a0.z) + w1 * bfhi(a1.z) + w2 * bfhi(a2.z));
            o.w = pk2(w0 * bflo(a0.w) + w1 * bflo(a1.w) + w2 * bflo(a2.w), w0 * bfhi(a0.w) + w1 * bfhi(a1.w) + w2 * bfhi(a2.w));
            *((u32x4*)(mixed + (size_t)m * DM + 512) + c.lane) = o; }
    }
}


constexpr int GR_WGT = 0, GR_XC = 65536, GR_A = 81920, GR_U = 115712, GR_SEG = 132608, GR_CW = 136704, GR_GB = 139264;
__device__ __forceinline__ float fast_sigmoid(float x) { return __builtin_amdgcn_rcpf(1.f + __expf(-x)); }
__device__ __forceinline__ void griffin_pass(const Params& p, const Ctx& c) {
    LAS unsigned char* L = c.lds;
    const int tid = c.tid, lane = c.lane, wave = c.wave, g = c.blk & 7;
    const bf16_t* proj = (const bf16_t*)(p.ws + WS_PROJ); bf16_t* yout = (bf16_t*)(p.ws + WS_Y0); bf16_t* ypout = (bf16_t*)(p.ws + WS_YP);
    float* AGA = (float*)(p.ws + WS_AGG); float* AGH = AGA + BATCH * 128 * 1024;
    LAS float* A_ = (LAS float*)(L + GR_A); LAS bf16_t* U_ = (LAS bf16_t*)(L + GR_U); LAS float* SEG = (LAS float*)(L + GR_SEG); LAS float* CW = (LAS float*)(L + GR_CW); LAS float* GB = (LAS float*)(L + GR_GB);
    __syncthreads();
    { const bf16_t* wg = (const bf16_t*)(p.ws + WS_WG);
      for (int ch = tid; ch < 4096; ch += NTHREADS) { const int gate = ch >> 11, j = (ch >> 4) & 127, cc = ch & 15;
          const u32x4 v = *(const u32x4*)(wg + ((size_t)(gate * 8 + g) * 128 + j) * 128 + cc * 8);
          *(LAS u32x4*)(L + GR_WGT + gate * 32768 + j * 256 + ((cc ^ (j & 15)) << 4)) = v; }
      if (tid < 128) { const int ch = g * 128 + tid;
#pragma unroll
          for (int jj = 0; jj < 4; ++jj) CW[jj * 128 + tid] = p.c_conv_w[jj * 1024 + ch];
          CW[4 * 128 + tid] = p.c_conv_b[ch]; GB[tid] = p.c_b_rgate[ch]; GB[128 + tid] = p.c_b_igate[ch];
          const float lam = p.c_lambda[ch]; GB[256 + tid] = fmaxf(-lam, 0.f) + log1pf(expf(-fabsf(lam))); } }
    __syncthreads();
    const int nslot = BATCH * 128, sstep = c.nblk >> 3;
    u32x4 xr[5];
#define GR_XLOAD(sl_) do { const int b_ = (sl_) >> 7, t0_ = ((sl_) & 127) * 64; const size_t r0_ = (size_t)b_ * SEQ + t0_; const int co_ = tid & 15, tp_ = tid >> 4; \
        _Pragma("unroll") for (int jj = 0; jj < 5; ++jj) { const int tt = t0_ + 2 * tp_ - 3 + jj; xr[jj] = (u32x4){0u, 0u, 0u, 0u}; \
            if (tt >= 0) xr[jj] = *(const u32x4*)(proj + (r0_ + 2 * tp_ - 3 + jj) * 2048 + 1024 + g * 128 + co_ * 8); } } while (0)
    if ((c.blk >> 3) < nslot) GR_XLOAD(c.blk >> 3);
    for (int slot = c.blk >> 3; slot < nslot; slot += sstep) {
        const int b = slot >> 7, tile = slot & 127, t0 = tile * 64; const size_t row0 = (size_t)b * SEQ + t0;
        u32x4 gpre[2];
        { const int co = tid & 15, tp = tid >> 4;
#pragma unroll
            for (int tl = 0; tl < 2; ++tl) gpre[tl] = *(const u32x4*)(proj + (row0 + 2 * tp + tl) * 2048 + g * 128 + co * 8); }
        { const int co = tid & 15, tp = tid >> 4;
          f32x4 w[5][2];
#pragma unroll
          for (int jj = 0; jj < 5; ++jj) { w[jj][0] = *(const LAS f32x4*)(CW + jj * 128 + co * 8); w[jj][1] = *(const LAS f32x4*)(CW + jj * 128 + co * 8 + 4); }
#pragma unroll
          for (int tl = 0; tl < 2; ++tl) { float a8[8];
#pragma unroll
              for (int e = 0; e < 8; ++e) a8[e] = w[4][e >> 2][e & 3];
#pragma unroll
              for (int jj = 0; jj < 4; ++jj) { const u32x4 xv = xr[tl + jj]; const unsigned xw[4] = {xv.x, xv.y, xv.z, xv.w};
#pragma unroll
                  for (int e = 0; e < 8; ++e) { const float xe = (e & 1) ? bfhi(xw[e >> 1]) : bflo(xw[e >> 1]); a8[e] += w[jj][e >> 2][e & 3] * xe; } }
              const int t = 2 * tp + tl; u32x4 o; o.x = pk2(a8[0], a8[1]); o.y = pk2(a8[2], a8[3]); o.z = pk2(a8[4], a8[5]); o.w = pk2(a8[6], a8[7]);
              *(LAS u32x4*)(L + GR_XC + t * 256 + ((co ^ (t & 15)) << 4)) = o; } }
        if (slot + sstep < nslot) GR_XLOAD(slot + sstep);
        __syncthreads();
        { const int tt = wave & 3, jh = wave >> 2, r = lane & 15, q = lane >> 4, t = 16 * tt + r;
          f32x4 ar[4], ai[4];
#pragma unroll
          for (int n = 0; n < 4; ++n) { ar[n] = (f32x4){0.f, 0.f, 0.f, 0.f}; ai[n] = (f32x4){0.f, 0.f, 0.f, 0.f}; }
#pragma unroll
          for (int s = 0; s < 4; ++s) { const bf16x8 xb = __builtin_bit_cast(bf16x8, *(const LAS u32x4*)(L + GR_XC + t * 256 + (((4 * s + q) ^ (t & 15)) << 4)));
#pragma unroll
              for (int n = 0; n < 4; ++n) { const int j = 64 * jh + 16 * n + r;
                  const bf16x8 wr = __builtin_bit_cast(bf16x8, *(const LAS u32x4*)(L + GR_WGT + j * 256 + (((4 * s + q) ^ (j & 15)) << 4)));
                  const bf16x8 wi = __builtin_bit_cast(bf16x8, *(const LAS u32x4*)(L + GR_WGT + 32768 + j * 256 + (((4 * s + q) ^ (j & 15)) << 4)));
                  ar[n] = __builtin_amdgcn_mfma_f32_16x16x32_bf16(wr, xb, ar[n], 0, 0, 0); ai[n] = __builtin_amdgcn_mfma_f32_16x16x32_bf16(wi, xb, ai[n], 0, 0, 0); } }
#pragma unroll
          for (int n = 0; n < 4; ++n) { const int j0 = 64 * jh + 16 * n + 4 * q;
              const f32x4 br = *(const LAS f32x4*)(GB + j0), bi = *(const LAS f32x4*)(GB + 128 + j0), sp = *(const LAS f32x4*)(GB + 256 + j0);
              const u32x2 xw = *(const LAS u32x2*)(L + GR_XC + t * 256 + ((((j0 >> 3) ^ (t & 15)) << 4) + (j0 & 7) * 2));
              const float xc[4] = {bflo(xw.x), bfhi(xw.x), bflo(xw.y), bfhi(xw.y)};
              f32x4 av; float uv[4];
#pragma unroll
              for (int i = 0; i < 4; ++i) { const float rr = fast_sigmoid(ar[n][i] + br[i]), ii = fast_sigmoid(ai[n][i] + bi[i]);
                  const float a = __expf(-8.f * rr * sp[i]); av[i] = a; uv[i] = __builtin_amdgcn_sqrtf(fmaxf(1.f - a * a, 0.f)) * (ii * xc[i]); }
              *(LAS f32x4*)(A_ + t * 132 + j0) = av; u32x2 uo; uo.x = pk2(uv[0], uv[1]); uo.y = pk2(uv[2], uv[3]); *(LAS u32x2*)(U_ + t * 132 + j0) = uo; } }
        __syncthreads();
        const int j = tid & 127, seg = tid >> 7;
        float hl[16], pl[16];
        { float aa = 1.f, hh = 0.f;
#pragma unroll
          for (int i = 0; i < 16; ++i) { const int t = seg * 16 + i; const float a = A_[t * 132 + j], u = bf2f(U_[t * 132 + j]); hh = a * hh + u; aa *= a; hl[i] = hh; pl[i] = aa; }
          SEG[seg * 128 + j] = aa; SEG[512 + seg * 128 + j] = hh; }
        __syncthreads();
        { float hin = 0.f, pin = 1.f;
          for (int sgi = 0; sgi < seg; ++sgi) { const float sa = SEG[sgi * 128 + j]; hin = sa * hin + SEG[512 + sgi * 128 + j]; pin *= sa; }
#pragma unroll
          for (int i = 0; i < 16; ++i) { const int t = seg * 16 + i; A_[t * 132 + j] = hl[i] + pl[i] * hin; U_[t * 132 + j] = (bf16_t)f2bf(pl[i] * pin); }
          if (seg == 3) { const size_t e = ((size_t)b * 128 + tile) * 1024 + g * 128 + j; AGA[e] = pl[15] * pin; AGH[e] = hl[15] + pl[15] * hin; } }
        __syncthreads();
        { const int co = tid & 15, tp = tid >> 4;
#pragma unroll
          for (int tl = 0; tl < 2; ++tl) { const int t = 2 * tp + tl;
              const f32x4 h0 = *(const LAS f32x4*)(A_ + t * 132 + co * 8), h1 = *(const LAS f32x4*)(A_ + t * 132 + co * 8 + 4);
              const u32x2 pa = *(const LAS u32x2*)(U_ + t * 132 + co * 8), pb = *(const LAS u32x2*)(U_ + t * 132 + co * 8 + 4);
              const u32x4 gw = gpre[tl];
              const float g0 = gelu_tanh(bflo(gw.x)), g1 = gelu_tanh(bfhi(gw.x)), g2 = gelu_tanh(bflo(gw.y)), g3 = gelu_tanh(bfhi(gw.y));
              const float g4 = gelu_tanh(bflo(gw.z)), g5 = gelu_tanh(bfhi(gw.z)), g6 = gelu_tanh(bflo(gw.w)), g7 = gelu_tanh(bfhi(gw.w));
              u32x4 o; o.x = pk2(g0 * h0.x, g1 * h0.y); o.y = pk2(g2 * h0.z, g3 * h0.w); o.z = pk2(g4 * h1.x, g5 * h1.y); o.w = pk2(g6 * h1.z, g7 * h1.w);
              u32x4 q; q.x = pk2(g0 * bflo(pa.x), g1 * bfhi(pa.x)); q.y = pk2(g2 * bflo(pa.y), g3 * bfhi(pa.y)); q.z = pk2(g4 * bflo(pb.x), g5 * bfhi(pb.x)); q.w = pk2(g6 * bflo(pb.y), g7 * bfhi(pb.y));
              *(u32x4*)(yout + (row0 + t) * DM + g * 128 + co * 8) = o; *(u32x4*)(ypout + (row0 + t) * DM + g * 128 + co * 8) = q; } }
    }
#undef GR_XLOAD
}
__device__ __forceinline__ void ph_carry(const Params& p, const Ctx& c) {
    const float* AGA = (const float*)(p.ws + WS_AGG); const float* AGH = AGA + BATCH * 128 * 1024; float* CAR = (float*)(AGH + BATCH * 128 * 1024);
    for (int idx = c.gtid; idx < BATCH * 1024; idx += c.gthreads) { const int b = idx >> 10, ch = idx & 1023; float cy = 0.f;
        for (int t0 = 0; t0 < 128; t0 += 8) { float a[8], h[8];
#pragma unroll
            for (int k = 0; k < 8; ++k) { const size_t e = ((size_t)b * 128 + t0 + k) * 1024 + ch; a[k] = AGA[e]; h[k] = AGH[e]; }
#pragma unroll
            for (int k = 0; k < 8; ++k) { CAR[((size_t)b * 128 + t0 + k) * 1024 + ch] = cy; cy = a[k] * cy + h[k]; } } }
}
__device__ __forceinline__ void ph_gr_fix(const Params& p, const Ctx& c) {
    bf16_t* y = (bf16_t*)(p.ws + WS_ACT); const bf16_t* y0 = (const bf16_t*)(p.ws + WS_Y0); const bf16_t* yp = (const bf16_t*)(p.ws + WS_YP);
    const float* CAR = (const float*)(p.ws + WS_AGG) + 2 * BATCH * 128 * 1024;
#pragma unroll 2
    for (size_t idx = c.gtid; idx < (size_t)M * 128; idx += c.gthreads) { const int cg = (int)(idx & 127); const size_t row = idx >> 7; const int b = (int)(row >> 13), tile = (int)((row & 8191) >> 6);
        const float* cr = CAR + ((size_t)b * 128 + tile) * 1024 + cg * 8; const f32x4 c0 = *(const f32x4*)cr, c1 = *(const f32x4*)(cr + 4);
        const u32x4 a = *(const u32x4*)(y0 + row * DM + cg * 8), q = *(const u32x4*)(yp + row * DM + cg * 8);
        u32x4 o; o.x = pk2(bflo(a.x) + bflo(q.x) * c0.x, bfhi(a.x) + bfhi(q.x) * c0.y); o.y = pk2(bflo(a.y) + bflo(q.y) * c0.z, bfhi(a.y) + bfhi(q.y) * c0.w);
        o.z = pk2(bflo(a.z) + bflo(q.z) * c1.x, bfhi(a.z) + bfhi(q.z) * c1.y); o.w = pk2(bflo(a.w) + bflo(q.w) * c1.z, bfhi(a.w) + bfhi(q.w) * c1.w);
        *(u32x4*)(y + row * DM + cg * 8) = o; }
}
__device__ __forceinline__ void cvt_gate_weights(const Params& p, const Ctx& c) {
    bf16_t* wg = (bf16_t*)(p.ws + WS_WG);
    for (int idx = c.gtid; idx < 2 * 8 * 16 * 128; idx += c.gthreads) { const int j = idx & 127, io = (idx >> 7) & 15, g = (idx >> 11) & 7, gate = idx >> 14;
        const float* s = (gate ? p.c_w_igate : p.c_w_rgate) + (size_t)g * 16384 + (io * 8) * 128 + j;
        u32x4 w; w.x = pk2(s[0], s[128]); w.y = pk2(s[256], s[384]); w.z = pk2(s[512], s[640]); w.w = pk2(s[768], s[896]);
        *(u32x4*)(wg + ((size_t)(gate * 8 + g) * 128 + j) * 128 + io * 8) = w; }
}


constexpr size_t WS_SK = 25 * MiB;
constexpr int TK_SK = 0, TK_Q = 69632, TK_S = 86528, TK_L = 119552  , TK_O = 135936, TK_TAB = 144128;
typedef int i32x4 __attribute__((ext_vector_type(4)));
__device__ __forceinline__ int key_xform(int b) { return b ^ ((b >> 31) & 0x7fffffff); }
#define CEX(a, b) do { const int hi_ = max((a), (b)), lo_ = min((a), (b)); (a) = hi_; (b) = lo_; } while (0)
__device__ __forceinline__ void bitonic_merge16_desc(int (&v)[16]) {
#pragma unroll
    for (int j = 8; j >= 1; j >>= 1)
#pragma unroll
        for (int i = 0; i < 16; ++i) if ((i & j) == 0) CEX(v[i], v[i | j]);
}
__device__ __forceinline__ void bitonic_sort16_desc(int (&v)[16]) {
#pragma unroll
    for (int k = 2; k <= 16; k <<= 1)
#pragma unroll
        for (int j = k >> 1; j >= 1; j >>= 1)
#pragma unroll
            for (int i = 0; i < 16; ++i) { const int l = i ^ j; if (l > i) { if ((i & k) == 0 || k == 16) CEX(v[i], v[l]); else CEX(v[l], v[i]); } }
}
__device__ __forceinline__ void ph_topk(const Params& p, int layer, const Ctx& c) {
    LAS unsigned char* L = c.lds; const bf16_t* Q = (const bf16_t*)(p.ws + WS_PROJ);
    int* ids = (int*)(p.ws + WS_IDS); float* gg = (float*)(p.ws + WS_G);
    const int tid = c.tid, lane = c.lane, w = c.wave, r = lane & 15, qq = lane >> 4, h = c.blk & 7;
    LAS float* S = (LAS float*)(L + TK_S); LAS int* LST = (LAS int*)(L + TK_L); LAS int* OUTK = (LAS int*)(L + TK_O); LAS int* TAB = (LAS int*)(L + TK_TAB);
    __syncthreads();
    { const bf16_t* sk = (const bf16_t*)(p.ws + WS_SK) + ((size_t)layer * 8 + h) * 2 * 128 * 128;
      for (int ch = tid; ch < 4096; ch += NTHREADS) { const int row = ch >> 4, cc = ch & 15;
          *(LAS u32x4*)(L + TK_SK + row * 272 + cc * 16) = *(const u32x4*)(sk + (size_t)row * 128 + cc * 8); }
      if (tid < 64) { int cnt = 0, code = -1;
          for (int i = 0; i < 16; ++i) for (int j = 0; j < 16 / (i + 1); ++j) { if (cnt == tid) code = i * 16 + j; ++cnt; }
          TAB[tid] = code; } }
    const int nslot = M / 32, sstep = c.nblk >> 3;
    u32x4 qpre[2];
#define TK_QLOAD(sl_) do { _Pragma("unroll") for (int k = 0; k < 2; ++k) { const int idx = tid + NTHREADS * k, row = idx >> 5, ch = idx & 31; \
        qpre[k] = *(const u32x4*)(Q + (size_t)(min((sl_), nslot - 1) * 32 + row) * 2048 + h * 256 + ch * 8); } } while (0)
#define TK_MERGE(CTRL) do { int o_[16]; _Pragma("unroll") for (int i = 0; i < 16; ++i) o_[i] = __builtin_amdgcn_update_dpp(0, v[15 - i], (CTRL), 0xf, 0xf, false); \
        _Pragma("unroll") for (int i = 0; i < 16; ++i) v[i] = max(v[i], o_[i]); bitonic_merge16_desc(v); } while (0)
    TK_QLOAD(c.blk >> 3);
    int gfirst = 0, gi = 0;
    for (int slot = c.blk >> 3; slot < nslot; slot += sstep) {
        __syncthreads();
#pragma unroll
        for (int k = 0; k < 2; ++k) { const int idx = tid + NTHREADS * k, row = idx >> 5, ch = idx & 31; *(LAS u32x4*)(L + TK_Q + row * 528 + ch * 16) = qpre[k]; }
        TK_QLOAD(slot + sstep);
        __syncthreads();
        { const int pp = w >> 2, mt = (w >> 1) & 1, nh = w & 1;
          f32x4 acc[4];
#pragma unroll
          for (int nt = 0; nt < 4; ++nt) acc[nt] = (f32x4){0.f, 0.f, 0.f, 0.f};
#pragma unroll
          for (int s2 = 0; s2 < 4; ++s2) { const bf16x8 af = __builtin_bit_cast(bf16x8, *(const LAS u32x4*)(L + TK_Q + (16 * mt + r) * 528 + (pp * 128 + 32 * s2 + 8 * qq) * 2));
#pragma unroll
              for (int nt = 0; nt < 4; ++nt) { const bf16x8 bfr = __builtin_bit_cast(bf16x8, *(const LAS u32x4*)(L + TK_SK + (pp * 128 + 16 * (4 * nh + nt) + r) * 272 + (32 * s2 + 8 * qq) * 2));
                  acc[nt] = __builtin_amdgcn_mfma_f32_16x16x32_bf16(af, bfr, acc[nt], 0, 0, 0); } }
#pragma unroll
          for (int nt = 0; nt < 4; ++nt)
#pragma unroll
              for (int i = 0; i < 4; ++i) S[(pp * 32 + 16 * mt + 4 * qq + i) * 129 + 16 * (4 * nh + nt) + r] = acc[nt][i]; }
        __syncthreads();
        {
          const int m = tid >> 4, sub = tid & 15, pp = sub >> 3, part = sub & 7; int v[16];
#pragma unroll
          for (int k = 0; k < 16; ++k) { const int n = 8 * k + part; v[k] = key_xform((__builtin_bit_cast(int, S[(pp * 32 + m) * 129 + n]) & ~127) | n); }
          bitonic_sort16_desc(v);
          TK_MERGE(0xB1);
          TK_MERGE(0x4E);
          TK_MERGE(0x141);
          if (part == 0) {
#pragma unroll
              for (int k = 0; k < 16; ++k) LST[((gi * 32 + m) * 2 + pp) * 16 + k] = key_xform(v[k]); } }
        if (gi == 0) gfirst = slot;
        ++gi;
        if (gi < 4 && slot + sstep < nslot) continue;
        __syncthreads();
        {
          const int tq = tid >> 2, sub = tid & 3, grp = tq >> 5, m = tq & 31;
          if (grp < gi) {
              const int slot_g = gfirst + grp * sstep;
              LAS const int* L1 = LST + (tq * 2 + 0) * 16; LAS const int* L2 = LST + (tq * 2 + 1) * 16;
              int v[16];
#pragma unroll
              for (int k = 0; k < 16; ++k) { const int ci = sub * 16 + k; const int code = TAB[ci]; int key = (int)0x80000000;
                  if (code >= 0) { const float s1 = __builtin_bit_cast(float, L1[code >> 4] & ~127), s2v = __builtin_bit_cast(float, L2[code & 15] & ~127);
                      key = key_xform((__builtin_bit_cast(int, s1 + s2v) & ~63) | (63 - ci)); }
                  v[k] = key; }
              bitonic_sort16_desc(v);
              TK_MERGE(0xB1); TK_MERGE(0x4E);
              const float smax = __builtin_bit_cast(float, key_xform(v[0]) & ~63);
              if (sub == 0) {
#pragma unroll
                  for (int k4 = 0; k4 < 4; ++k4) *(LAS i32x4*)(OUTK + tq * 16 + 4 * k4) = (i32x4){v[4 * k4], v[4 * k4 + 1], v[4 * k4 + 2], v[4 * k4 + 3]}; }
              asm volatile("s_waitcnt lgkmcnt(0)" ::: "memory");
              const i32x4 mine = *(const LAS i32x4*)(OUTK + tq * 16 + 4 * sub);
              float e[4]; int kb[4];
#pragma unroll
              for (int j = 0; j < 4; ++j) { kb[j] = key_xform(mine[j]); e[j] = __expf(__builtin_bit_cast(float, kb[j] & ~63) - smax); }
              float den = (e[0] + e[1]) + (e[2] + e[3]);
              den += __builtin_bit_cast(float, __builtin_amdgcn_update_dpp(0, __builtin_bit_cast(int, den), 0xB1, 0xf, 0xf, false));
              den += __builtin_bit_cast(float, __builtin_amdgcn_update_dpp(0, __builtin_bit_cast(int, den), 0x4E, 0xf, 0xf, false));
              const float rden = __builtin_amdgcn_rcpf(den); i32x4 oi; f32x4 og;
#pragma unroll
              for (int j = 0; j < 4; ++j) { const int code = TAB[63 - (kb[j] & 63)]; oi[j] = (L1[code >> 4] & 127) * 128 + (L2[code & 15] & 127); og[j] = e[j] * rden; }
              const size_t o = (size_t)(slot_g * 32 + m) * 128 + h * 16 + 4 * sub;
              *(i32x4*)(ids + o) = oi; *(f32x4*)(gg + o) = og; } }
        gi = 0;
    }
#undef TK_QLOAD
#undef TK_MERGE
}


__device__ __forceinline__ float wave_max(float v) {
#pragma unroll
    for (int o = 1; o < 64; o <<= 1) v = fmaxf(v, __shfl_xor(v, o));
    return v;
}
__device__ __forceinline__ void cvt_fp8_rows(const float* src, unsigned char* dst, float* scl, int nrows, const Ctx& c) {
    for (int row = c.gwave; row < nrows; row += c.gwaves) {
        const f32x4* sp = (const f32x4*)(src + (size_t)row * DM) + 4 * c.lane; f32x4 v[4]; float mx = 0.f;
#pragma unroll
        for (int j = 0; j < 4; ++j) { v[j] = sp[j]; mx = fmaxf(mx, fmaxf(fmaxf(fabsf(v[j].x), fabsf(v[j].y)), fmaxf(fabsf(v[j].z), fabsf(v[j].w)))); }
        mx = wave_max(mx);
        const float sc = mx > 0.f ? mx * (1.f / 416.f) : 1.f, inv = 1.f / sc;
        u32x4 w; int t;
        t = __builtin_amdgcn_cvt_pk_fp8_f32(v[0].x * inv, v[0].y * inv, 0, false); t = __builtin_amdgcn_cvt_pk_fp8_f32(v[0].z * inv, v[0].w * inv, t, true); w.x = (unsigned)t;
        t = __builtin_amdgcn_cvt_pk_fp8_f32(v[1].x * inv, v[1].y * inv, 0, false); t = __builtin_amdgcn_cvt_pk_fp8_f32(v[1].z * inv, v[1].w * inv, t, true); w.y = (unsigned)t;
        t = __builtin_amdgcn_cvt_pk_fp8_f32(v[2].x * inv, v[2].y * inv, 0, false); t = __builtin_amdgcn_cvt_pk_fp8_f32(v[2].z * inv, v[2].w * inv, t, true); w.z = (unsigned)t;
        t = __builtin_amdgcn_cvt_pk_fp8_f32(v[3].x * inv, v[3].y * inv, 0, false); t = __builtin_amdgcn_cvt_pk_fp8_f32(v[3].z * inv, v[3].w * inv, t, true); w.w = (unsigned)t;
        *(u32x4*)(dst + (size_t)(c.lane >> 3) * NEXP * 128 + (size_t)row * 128 + (c.lane & 7) * 16) = w;
        if (c.lane == 0) scl[row] = sc;
    }
}
typedef float f32x2 __attribute__((ext_vector_type(2)));
__device__ __forceinline__ u32x2 fp8x4_to_bf16x4(unsigned w) {
    const f32x2 a = __builtin_amdgcn_cvt_pk_f32_fp8((int)w, false), b = __builtin_amdgcn_cvt_pk_f32_fp8((int)w, true);
    u32x2 o;
    asm("v_cvt_pk_bf16_f32 %0, %1, %2" : "=v"(o.x) : "v"(a.x), "v"(a.y));
    asm("v_cvt_pk_bf16_f32 %0, %1, %2" : "=v"(o.y) : "v"(b.x), "v"(b.y));
    return o;
}


constexpr size_t WS_PD = WS_S;
constexpr size_t WS_ACTB = WS_S + 224 * MiB;
struct XI { int xr, nx, jr, nloc; };
typedef long i64_t;
__device__ __forceinline__ i64_t pack64(unsigned lo, unsigned hi) { return (i64_t)(((unsigned long long)hi << 32) | lo); }
typedef int i32x8 __attribute__((ext_vector_type(8)));
#define PIN16(o) asm volatile("" : "+v"(o[0]), "+v"(o[1]), "+v"(o[2]), "+v"(o[3]), "+v"(o[4]), "+v"(o[5]), "+v"(o[6]), "+v"(o[7]), "+v"(o[8]), "+v"(o[9]), "+v"(o[10]), "+v"(o[11]), "+v"(o[12]), "+v"(o[13]), "+v"(o[14]), "+v"(o[15]))

constexpr size_t WS_ACT8 = WS_S + 224 * MiB;
constexpr size_t WS_SA = WS_S + 240 * MiB;
__device__ __forceinline__ void ph_peer_act2(const Params& p, int layer, const Ctx& c) {
    const bf16_t* PDh = (const bf16_t*)(p.ws + WS_PD); unsigned char* A8 = p.ws + WS_ACT8; float* SA = (float*)(p.ws + WS_SA);
    const float* SU = (const float*)(p.ws + WS_SCL) + (size_t)layer * 2 * NEXP; const float* SV = SU + NEXP;
    const int* ids = (const int*)(p.ws + WS_IDS); const float* gg = (const float*)(p.ws + WS_G);
    const int lane = c.lane;
    for (int t0 = c.gwave; t0 < M; t0 += 4 * c.gwaves) {
        float d0[4], d1[4], g0[4], g1[4], su0[4], su1[4], sv0[4], sv1[4]; int id0[4], id1[4];
#pragma unroll
        for (int u = 0; u < 4; ++u) { const int t = min(t0 + u * c.gwaves, M - 1); id0[u] = ids[(size_t)t * 128 + lane]; id1[u] = ids[(size_t)t * 128 + 64 + lane]; g0[u] = gg[(size_t)t * 128 + lane]; g1[u] = gg[(size_t)t * 128 + 64 + lane]; }
#pragma unroll
        for (int u = 0; u < 4; ++u) { const int t = min(t0 + u * c.gwaves, M - 1); d0[u] = 0.f; d1[u] = 0.f;
#pragma unroll
            for (int sl = 0; sl < 8; ++sl) { d0[u] += bf2f(PDh[((size_t)sl * M + t) * 128 + lane]); d1[u] += bf2f(PDh[((size_t)sl * M + t) * 128 + 64 + lane]); } }
#pragma unroll
        for (int u = 0; u < 4; ++u) { su0[u] = SU[id0[u]]; su1[u] = SU[id1[u]]; sv0[u] = SV[id0[u]]; sv1[u] = SV[id1[u]]; }
#pragma unroll
        for (int u = 0; u < 4; ++u) { const int t = t0 + u * c.gwaves; if (t >= M) break;
            const float a0 = gelu_tanh(d0[u] * su0[u]) * g0[u] * sv0[u], a1 = gelu_tanh(d1[u] * su1[u]) * g1[u] * sv1[u];
            const float mx = wave_max(fmaxf(fabsf(a0), fabsf(a1)));
            const float sa = mx > 0.f ? mx * (1.f / 256.f) : 1.f, inv = 1.f / sa;
            const float b0 = a0 * inv, b1 = a1 * inv;
            const int hq = __builtin_amdgcn_cvt_pk_fp8_f32(b0, b1, 0, false);
            const f32x2 hd = __builtin_amdgcn_cvt_pk_f32_fp8(hq, false);
            const int lq = __builtin_amdgcn_cvt_pk_fp8_f32((b0 - hd.x) * 16.f, (b1 - hd.y) * 16.f, 0, false);
            unsigned char* o = A8 + (size_t)t * 256;
            o[lane] = (unsigned char)(hq & 0xff); o[64 + lane] = (unsigned char)((hq >> 8) & 0xff); o[128 + lane] = (unsigned char)(lq & 0xff); o[192 + lane] = (unsigned char)((lq >> 8) & 0xff);
            if (lane == 0) SA[t] = sa; }
    }
}
typedef int i32x2 __attribute__((ext_vector_type(2)));
__device__ __forceinline__ i32x2 lds_tr8(LAS const unsigned char* pb) { return __builtin_amdgcn_ds_read_tr8_b64_v2i32((LAS i32x2*)pb); }
__device__ __forceinline__ void ph_peer_v2(const Params& p, int layer, const Ctx& c, const XI xi, float* hdst, int idmask) {
    const unsigned char* VT = p.ws + WS_TAB8 + (size_t)layer * 2 * NEXP * DM + (size_t)NEXP * DM;
    const int* ids = (const int*)(p.ws + WS_IDS); const unsigned char* A8 = p.ws + WS_ACT8; const float* SA = (const float*)(p.ws + WS_SA);
    const int lane = c.lane, e8 = lane >> 3, cc = lane & 7, r = lane & 15, q = lane >> 4;
    const int tstep = xi.nloc * NWAVES;
    LAS unsigned char* img = c.lds + c.wave * 16384;
#pragma unroll 1
    for (int sl = xi.xr; sl < 8; sl += xi.nx) {
        const unsigned char* Vs = VT + (size_t)sl * NEXP * 128; const unsigned vo = 16u * (unsigned)cc;
        int t = xi.jr * NWAVES + c.wave;
        if (t >= M) continue;
#define PV_LD(k) (*(const u32x4*)(Vs + (((unsigned)((k) & (idmask & 0xffff)) << 7) + vo)))
#define PV_ROWS(dst, ia, ib) do { dst[0] = PV_LD((ia).x); dst[1] = PV_LD((ia).y); dst[2] = PV_LD((ia).z); dst[3] = PV_LD((ia).w); dst[4] = PV_LD((ib).x); dst[5] = PV_LD((ib).y); dst[6] = PV_LD((ib).z); dst[7] = PV_LD((ib).w); } while (0)
#define PV_IMG(src, half) do { _Pragma("unroll") for (int j = 0; j < 8; ++j) *(LAS u32x4*)(img + (64 * (half) + 8 * e8 + j) * 128 + ((cc ^ j) << 4)) = src[j]; } while (0)
        u32x4 v[8], vn[8];
        { const i32x4* ip = (const i32x4*)(ids + (size_t)t * 128 + 8 * e8); const i32x4 i0 = ip[0], i1 = ip[1], i2 = ip[16], i3 = ip[17]; PV_ROWS(v, i0, i1); PV_ROWS(vn, i2, i3); }
#pragma unroll 1
        for (; t < M; t += tstep) {
            const int tn = min(t + tstep, M - 1);
            const i32x4* ipn = (const i32x4*)(ids + (size_t)tn * 128 + 8 * e8); const i32x4 in0 = ipn[0], in1 = ipn[1], in2 = ipn[16], in3 = ipn[17];
            const u32x4* ap = (const u32x4*)(A8 + (size_t)t * 256 + 32 * q); const u32x4 ah0 = ap[0], ah1 = ap[1], al0 = ap[8], al1 = ap[9];
            const float sa = SA[t];
            const size_t ho = (size_t)t * DM + 128 * sl + 32 * q + r;
            float h0 = p.out[ho], h1 = p.out[ho + 16];
            PV_IMG(v, 0); PV_IMG(vn, 1);
            PV_ROWS(v, in0, in1); PV_ROWS(vn, in2, in3);
            asm volatile("" ::: "memory");
            const i32x8 ahv = {(int)ah0.x, (int)ah0.y, (int)ah0.z, (int)ah0.w, (int)ah1.x, (int)ah1.y, (int)ah1.z, (int)ah1.w};
            const i32x8 alv = {(int)al0.x, (int)al0.y, (int)al0.z, (int)al0.w, (int)al1.x, (int)al1.y, (int)al1.z, (int)al1.w};
            float oa = 0.f, ob = 0.f;
#pragma unroll
            for (int dt = 0; dt < 8; ++dt) {
                i32x8 bw;
#pragma unroll
                for (int i4 = 0; i4 < 4; ++i4) { const int row = 32 * q + 8 * i4 + (r >> 1);
                    const i32x2 tv = lds_tr8(img + row * 128 + ((dt ^ (row & 7)) << 4) + 8 * (r & 1)); bw[2 * i4] = tv.x; bw[2 * i4 + 1] = tv.y; }
                f32x4 ch = {0.f, 0.f, 0.f, 0.f}, cl = {0.f, 0.f, 0.f, 0.f};
                ch = __builtin_amdgcn_mfma_scale_f32_16x16x128_f8f6f4(ahv, bw, ch, 0, 0, 0, 0, 0, 0); cl = __builtin_amdgcn_mfma_scale_f32_16x16x128_f8f6f4(alv, bw, cl, 0, 0, 0, 0, 0, 0);
                const float od = ch[0] + cl[0] * 0.0625f;
                oa = (dt == 2 * q) ? od : oa; ob = (dt == 2 * q + 1) ? od : ob; }
            h0 += oa * sa; h1 += ob * sa;
            hdst[ho] = h0; hdst[ho + 16] = h1;
            asm volatile("" ::: "memory");
        }
#undef PV_LD
#undef PV_ROWS
#undef PV_IMG
    }
}

constexpr size_t WS_XN8 = WS_S + 256 * MiB;
__device__ __forceinline__ void ph_peer_u2(const Params& p, int layer, const Ctx& c, const XI xi, int idmask) {
    const unsigned char* X8 = p.ws + WS_XN8; const unsigned char* UT = p.ws + WS_TAB8 + (size_t)layer * 2 * NEXP * DM;
    const int* ids = (const int*)(p.ws + WS_IDS); bf16_t* PDh = (bf16_t*)(p.ws + WS_PD);
    const int lane = c.lane, e8 = lane >> 3, cc = lane & 7, r = lane & 15, q = lane >> 4;
    const int tstep = xi.nloc * NWAVES;
    LAS unsigned char* img = c.lds + c.wave * 16384; LAS float* stg = (LAS float*)(c.lds + 131072 + c.wave * 512);
#pragma unroll 1
    for (int sl = xi.xr; sl < 8; sl += xi.nx) {
        const unsigned char* Us = UT + (size_t)sl * NEXP * 128; const unsigned uo = 16u * (unsigned)cc;
        int t = xi.jr * NWAVES + c.wave;
        if (t >= M) continue;
#define PU_LD(k) (*(const u32x4*)(Us + (((unsigned)((k) & (idmask & 0xffff)) << 7) + uo)))
#define PU_ROWS(dst, ia, ib) do { dst[0] = PU_LD((ia).x); dst[1] = PU_LD((ia).y); dst[2] = PU_LD((ia).z); dst[3] = PU_LD((ia).w); dst[4] = PU_LD((ib).x); dst[5] = PU_LD((ib).y); dst[6] = PU_LD((ib).z); dst[7] = PU_LD((ib).w); } while (0)
#define PU_IMG(src, half) do { _Pragma("unroll") for (int j = 0; j < 8; ++j) *(LAS u32x4*)(img + (64 * (half) + 8 * e8 + j) * 128 + ((cc ^ j) << 4)) = src[j]; } while (0)
        u32x4 v[8], vn[8];
        { const i32x4* ip = (const i32x4*)(ids + (size_t)t * 128 + 8 * e8); const i32x4 i0 = ip[0], i1 = ip[1], i2 = ip[16], i3 = ip[17]; PU_ROWS(v, i0, i1); PU_ROWS(vn, i2, i3); }
#pragma unroll 1
        for (; t < M; t += tstep) {
            const int tn = min(t + tstep, M - 1);
            const i32x4* ipn = (const i32x4*)(ids + (size_t)tn * 128 + 8 * e8); const i32x4 in0 = ipn[0], in1 = ipn[1], in2 = ipn[16], in3 = ipn[17];
            const u32x4* xp = (const u32x4*)(X8 + (size_t)t * 2048 + 128 * sl + 32 * q); const u32x4 xh0 = xp[0], xh1 = xp[1], xl0 = xp[64], xl1 = xp[65];
            PU_IMG(v, 0); PU_IMG(vn, 1);
            PU_ROWS(v, in0, in1); PU_ROWS(vn, in2, in3);
            asm volatile("" ::: "memory");
            const i32x8 xh = {(int)xh0.x, (int)xh0.y, (int)xh0.z, (int)xh0.w, (int)xh1.x, (int)xh1.y, (int)xh1.z, (int)xh1.w};
            const i32x8 xl = {(int)xl0.x, (int)xl0.y, (int)xl0.z, (int)xl0.w, (int)xl1.x, (int)xl1.y, (int)xl1.z, (int)xl1.w};
#pragma unroll
            for (int g = 0; g < 8; ++g) { const int row = 16 * g + r;
                const u32x4 w0 = *(const LAS u32x4*)(img + row * 128 + (((2 * q) ^ (row & 7)) << 4)), w1 = *(const LAS u32x4*)(img + row * 128 + (((2 * q + 1) ^ (row & 7)) << 4));
                const i32x8 aw = {(int)w0.x, (int)w0.y, (int)w0.z, (int)w0.w, (int)w1.x, (int)w1.y, (int)w1.z, (int)w1.w};
                f32x4 ah = {0.f, 0.f, 0.f, 0.f}, al = {0.f, 0.f, 0.f, 0.f};
                ah = __builtin_amdgcn_mfma_scale_f32_16x16x128_f8f6f4(aw, xh, ah, 0, 0, 0, 0, 0, 0); al = __builtin_amdgcn_mfma_scale_f32_16x16x128_f8f6f4(aw, xl, al, 0, 0, 0, 0, 0, 0);
                if (r == 0) *(LAS f32x4*)(stg + 16 * g + 4 * q) = ah + al * 0.0625f; }
            asm volatile("" ::: "memory");
            { const f32x2 pv = *(const LAS f32x2*)(stg + 2 * lane); *(unsigned*)(PDh + ((size_t)sl * M + t) * 128 + 2 * lane) = pk2(pv.x, pv.y); }
            asm volatile("" ::: "memory");
        }
#undef PU_LD
#undef PU_ROWS
#undef PU_IMG
    }
}

#define XB_TMO      128
#define XB_XCNT(j)  (256  + 64 * (j))
#define XB_XSUB(j)  (1280 + 64 * (j))
#define XB_XGEN(j)  (2304 + 64 * (j))
#define XB_TOP      3328
#define XB_TOPGEN   3392
#define XCD_BAR_WORDS 3456
#define XB_SPIN_CAP (1u << 18)

__device__ __forceinline__ unsigned xb_ld(unsigned* p)              { return __hip_atomic_load(p, __ATOMIC_RELAXED, __HIP_MEMORY_SCOPE_AGENT); }
__device__ __forceinline__ unsigned xb_add(unsigned* p, unsigned v) { return __hip_atomic_fetch_add(p, v, __ATOMIC_RELAXED, __HIP_MEMORY_SCOPE_AGENT); }
__device__ __forceinline__ unsigned xb_xcc_id() { return (unsigned)__builtin_amdgcn_s_getreg((3 << 11) | 20) & 0xFu; }
#define XB_SPIN(cond, bar) do { unsigned _sp = 0; while (cond) { __builtin_amdgcn_s_sleep(1); \
    if ((++_sp & 255u) == 0u) { if (xb_ld(&(bar)[XB_TMO])) break; if (_sp > XB_SPIN_CAP) { atomicAdd(&(bar)[XB_TMO], 1u); break; } } } } while (0)

struct XcdBarrier {
    unsigned* bar; unsigned x;
    volatile LAS unsigned* st;
};

__device__ __forceinline__ XcdBarrier xcd_barrier_post(unsigned* bar, volatile LAS unsigned* st) {
    XcdBarrier b; b.bar = bar; b.x = xb_xcc_id(); b.st = st;
    if (threadIdx.x == 0) (void)xb_add(&bar[XB_XCNT(b.x)], 1u);
    return b;
}
__device__ __forceinline__ void xcd_barrier_complete(unsigned* bar, unsigned x, unsigned& nloc, unsigned& nx) {
    const unsigned G = gridDim.x * gridDim.y * gridDim.z;
    unsigned sum, cnt, mine, sp = 0u;
    for (;;) {
        sum = 0u; cnt = 0u; mine = 0u;
#pragma unroll
        for (unsigned j = 0; j < 16; ++j) { const unsigned c = xb_ld(&bar[XB_XCNT(j)]); sum += c; cnt += (c > 0u) ? 1u : 0u; mine = (j == x) ? c : mine; }
        if (sum == G) break;
        __builtin_amdgcn_s_sleep(1);
        if ((++sp & 255u) == 0u) { if (xb_ld(&bar[XB_TMO])) break; if (sp > XB_SPIN_CAP) { atomicAdd(&bar[XB_TMO], 1u); break; } }
    }
    nloc = mine > 0u ? mine : 1u; nx = cnt > 0u ? cnt : 1u;
}

__device__ __forceinline__ void xcd_barrier(const XcdBarrier& b) {
    asm volatile("s_waitcnt vmcnt(0)" ::: "memory");
    __syncthreads();
    if (threadIdx.x == 0) {
        unsigned* bar = b.bar;
        __builtin_amdgcn_s_waitcnt(0);
        unsigned nloc = b.st[0], nx = b.st[1];
        if (nloc == 0u) { xcd_barrier_complete(bar, b.x, nloc, nx); b.st[0] = nloc; b.st[1] = nx; }
        const unsigned old = xb_add(&bar[XB_XSUB(b.x)], 1u);
        const unsigned gen = old / nloc;
        if (old + 1u == (gen + 1u) * nloc) {
            __builtin_amdgcn_fence(__ATOMIC_RELEASE, "agent");
            asm volatile("s_waitcnt vmcnt(0)" ::: "memory");
            const unsigned og = xb_add(&bar[XB_TOP], 1u);
            const unsigned tg = og / nx;
            if (og + 1u == (tg + 1u) * nx) xb_add(&bar[XB_TOPGEN], 1u);
            else XB_SPIN(xb_ld(&bar[XB_TOPGEN]) == tg, bar);
            __builtin_amdgcn_fence(__ATOMIC_ACQUIRE, "agent");
            xb_add(&bar[XB_XGEN(b.x)], 1u);
            asm volatile("s_waitcnt vmcnt(0)" ::: "memory");
        } else {
            XB_SPIN(xb_ld(&bar[XB_XGEN(b.x)]) == gen, bar);
            __builtin_amdgcn_fence(__ATOMIC_ACQUIRE, "agent");
            asm volatile("s_waitcnt vmcnt(0)" ::: "memory");
        }
    }
    __syncthreads();
}

enum Phase { PH_PRO = 0, PH_GEMM_IN0, PH_MIXER0, PH_GLA_B, PH_GLA_C, PH_MIX0, PH_GEMM_OUT0, PH_NORM_F0, PH_GEMM_Q0, PH_TOPK1_0, PH_PU0, PH_PA0, PH_PV0,
             PH_NORM_M1, PH_GEMM_CIN, PH_G1, PH_G2, PH_G3, PH_GEMM_OUT1, PH_NORM_F1, PH_GEMM_Q1, PH_TOPK1_1, PH_PU1, PH_PA1, PH_PV1, PH_FINAL, NPHASES };

#ifndef PH_ONLY
#define PH_ONLY (-1)
#endif
#define PH_ENABLED(x) (PH_ONLY < 0 || PH_ONLY == (x))
#ifndef MK_N_LAUNCHES
#define MK_N_LAUNCHES 1
#endif

template <class Epi> __device__ __forceinline__ void run_gemm(const Ctx& c, const bf16_t* A, const bf16_t* Bt, int N, const Epi& E, int vblk) {
    pg8::Gemm g{A, Bt, M, N, DM}; pg8::StaticOrder S; S.init(M, N, c.nblk, vblk);
    pg8::gemm_phase<Epi, pg8::StaticOrder, true, true>(c.lds, g, S, E);
}

#define GATHER_CALL(l) ph_gather3(p, l, c, (rep_ + 1 < NREP(PH_GATHER##l)) ? (float*)(ws + WS_S) : p.out)
#ifndef PROBE_IDMASK
#define PROBE_IDMASK 0x3fff
#endif
#ifndef DUP_MASK
#define DUP_MASK 0u
#endif
#define NREP(k) ((((unsigned)(DUP_MASK) >> (k)) & 1u) ? 2 : 1)
#define GETXI() XI xi; { if (multi) { if (threadIdx.x == 0) { unsigned xr_ = 0; for (unsigned j_ = 0; j_ < bar.x; ++j_) xr_ += xb_ld(&ctl[CW_BAR + XB_XCNT(j_)]) > 0u ? 1u : 0u; MISC[11] = xr_; } __syncthreads(); \
    xi.nloc = (int)MISC[8]; xi.nx = (int)MISC[9]; xi.jr = (int)MISC[10]; xi.xr = (int)MISC[11]; if (xi.nloc < 1 || xi.nx < 1 || xi.nx > 8 || xi.jr >= xi.nloc || xi.xr >= xi.nx) { xi.xr = 0; xi.nx = 1; xi.jr = blockIdx.x; xi.nloc = gridDim.x; } } \
    else { xi.xr = 0; xi.nx = 1; xi.jr = blockIdx.x; xi.nloc = gridDim.x; } }
#define MKCTX() Ctx c; { int t_ = threadIdx.x; asm volatile("" : "+v"(t_)); c.lds = lds; c.tid = t_; c.lane = t_ & 63; c.wave = __builtin_amdgcn_readfirstlane(t_ >> 6); \
    c.blk = blockIdx.x; c.nblk = gridDim.x; c.gtid = c.blk * NTHREADS + c.tid; c.gthreads = c.nblk * NTHREADS; c.gwave = c.blk * NWAVES + c.wave; c.gwaves = c.nblk * NWAVES; }
__global__ void __launch_bounds__(NTHREADS, 2) mega_fwd(Params p) {
    extern __shared__ __attribute__((aligned(16))) unsigned char lds_raw[];
    volatile LAS unsigned* MISC = (volatile LAS unsigned*)((LAS unsigned char*)lds_raw + MISC_OFF);
    LAS unsigned char* const lds = (LAS unsigned char*)lds_raw;
    for (int u = threadIdx.x; u < (LDS_BYTES - LDSCTL_OFF) / 4; u += NTHREADS) ((LAS unsigned*)(lds + LDSCTL_OFF))[u] = 0u;
    __syncthreads();
    unsigned* ctl = (unsigned*)(p.ws + WS_CTL);
    XcdBarrier bar; bar.bar = ctl + CW_BAR; bar.x = 0; bar.st = nullptr;
    const bool multi = (p.ph_hi - p.ph_lo) > 1;
    if (multi) { bar = xcd_barrier_post(ctl + CW_BAR, MISC + 8); if (threadIdx.x == 0) MISC[10] = xb_add(&ctl[CW_RANK + 64 * bar.x], 1u); }
    unsigned char* ws = p.ws;
    bf16_t* ACT = (bf16_t*)(ws + WS_ACT); bf16_t* PROJ = (bf16_t*)(ws + WS_PROJ);

    const int lo = p.ph_lo, hi = p.ph_hi;
#define IN(k) (PH_ENABLED(k) && lo <= (k) && (k) < hi)
#define SEAM(k) do { if ((k) + 1 < hi) xcd_barrier(bar); } while (0)
    if (IN(PH_PRO)) { for (int rep_ = 0; rep_ < NREP(PH_PRO); ++rep_) { MKCTX();
        transpose_cvt(p.ab_w_in, DM, NIN, (bf16_t*)(ws + WS_WT_IN), NIN_PAD, [](int n) { return n < 1536 ? n : (n < 3072 ? n + 16 : (n < 3088 ? n - 3072 + 1536 : -1)); }, c.gtid, c.gthreads);
        transpose_cvt(p.ab_w_out, DM, DM, (bf16_t*)(ws + WS_WT_OUT), DM, [](int n) { return n; }, c.gtid, c.gthreads);
        transpose_cvt(p.c_w_in, DM, 2048, (bf16_t*)(ws + WS_WT_CIN), 2048, [](int n) { return n; }, c.gtid, c.gthreads);
        transpose_cvt(p.c_w_out, DM, DM, (bf16_t*)(ws + WS_WT_COUT), DM, [](int n) { return n; }, c.gtid, c.gthreads);
        transpose_cvt(p.peer_w_query, DM, 2048, (bf16_t*)(ws + WS_WT_Q0), 2048, [](int n) { return n; }, c.gtid, c.gthreads);
        transpose_cvt(p.peer_w_query + (size_t)DM * 2048, DM, 2048, (bf16_t*)(ws + WS_WT_Q1), 2048, [](int n) { return n; }, c.gtid, c.gthreads);
        cvt_fp8_rows(p.peer_u, ws + WS_TAB8, (float*)(ws + WS_SCL), NEXP, c);
        cvt_fp8_rows(p.peer_v, ws + WS_TAB8 + (size_t)NEXP * DM, (float*)(ws + WS_SCL) + NEXP, NEXP, c);
        cvt_gate_weights(p, c);
        cvt_bf16(p.peer_sub_keys, (bf16_t*)(ws + WS_SK), (size_t)2 * 8 * 2 * 128 * 128 / 8, c.gtid, c.gthreads);
        norm_rows_bf16(p.x, p.mix_norm, ACT, c);
        if (rep_ + 1 < NREP(PH_PRO)) xcd_barrier(bar); } SEAM(PH_PRO); }
    if (IN(PH_GEMM_IN0)) { for (int rep_ = 0; rep_ < NREP(PH_GEMM_IN0); ++rep_) { MKCTX();  ph_glr(p, c); pg8::EpiBf16<0> E{PROJ, NIN_PAD, nullptr, 0, 0, 1.f}; GETXI(); run_gemm(c, ACT, (const bf16_t*)(ws + WS_WT_IN), 3072, E, (xi.nx == 8 && xi.nloc * 8 == (int)gridDim.x) ? xi.jr * 8 + xi.xr : (int)blockIdx.x); if (rep_ + 1 < NREP(PH_GEMM_IN0)) xcd_barrier(bar); } SEAM(PH_GEMM_IN0); }
    if (IN(PH_MIXER0)) { for (int rep_ = 0; rep_ < NREP(PH_MIXER0); ++rep_) { MKCTX();  ph_gla_a(p, c); ph_attn(p, c); if (rep_ + 1 < NREP(PH_MIXER0)) xcd_barrier(bar); } SEAM(PH_MIXER0); }
    if (IN(PH_GLA_B)) { for (int rep_ = 0; rep_ < NREP(PH_GLA_B); ++rep_) { MKCTX();  ph_gla_b(p, c); if (rep_ + 1 < NREP(PH_GLA_B)) xcd_barrier(bar); } SEAM(PH_GLA_B); }
    if (IN(PH_GLA_C)) { for (int rep_ = 0; rep_ < NREP(PH_GLA_C); ++rep_) { MKCTX();  ph_gla_c(p, c); if (rep_ + 1 < NREP(PH_GLA_C)) xcd_barrier(bar); } SEAM(PH_GLA_C); }
    if (IN(PH_MIX0)) { for (int rep_ = 0; rep_ < NREP(PH_MIX0); ++rep_) { MKCTX();  ph_mix(p, c); if (rep_ + 1 < NREP(PH_MIX0)) xcd_barrier(bar); } SEAM(PH_MIX0); }
    if (IN(PH_GEMM_OUT0)) { for (int rep_ = 0; rep_ < NREP(PH_GEMM_OUT0); ++rep_) { MKCTX();  pg8::EpiResF32 E{p.x, p.out, DM}; GETXI(); run_gemm(c, ACT, (const bf16_t*)(ws + WS_WT_OUT), DM, E, (xi.nx == 8 && xi.nloc * 8 == (int)gridDim.x) ? xi.jr * 8 + xi.xr : (int)blockIdx.x); if (rep_ + 1 < NREP(PH_GEMM_OUT0)) xcd_barrier(bar); } SEAM(PH_GEMM_OUT0); }
    if (IN(PH_NORM_F0)) { for (int rep_ = 0; rep_ < NREP(PH_NORM_F0); ++rep_) { MKCTX();  norm_rows_bf16(p.out, p.ffn_norm, ACT, c, ws + WS_XN8); if (rep_ + 1 < NREP(PH_NORM_F0)) xcd_barrier(bar); } SEAM(PH_NORM_F0); }
    if (IN(PH_GEMM_Q0)) { for (int rep_ = 0; rep_ < NREP(PH_GEMM_Q0); ++rep_) { MKCTX();  pg8::EpiBf16<0> E{PROJ, 2048, nullptr, 0, 0, 1.f}; GETXI(); run_gemm(c, ACT, (const bf16_t*)(ws + WS_WT_Q0), 2048, E, (xi.nx == 8 && xi.nloc * 8 == (int)gridDim.x) ? xi.jr * 8 + xi.xr : (int)blockIdx.x); if (rep_ + 1 < NREP(PH_GEMM_Q0)) xcd_barrier(bar); } SEAM(PH_GEMM_Q0); }
    if (IN(PH_TOPK1_0)) { for (int rep_ = 0; rep_ < NREP(PH_TOPK1_0); ++rep_) { MKCTX();  ph_topk(p, 0, c); if (rep_ + 1 < NREP(PH_TOPK1_0)) xcd_barrier(bar); } SEAM(PH_TOPK1_0); }
    if (IN(PH_PU0)) { for (int rep_ = 0; rep_ < NREP(PH_PU0); ++rep_) { MKCTX();  GETXI(); ph_peer_u2(p, 0, c, xi, (rep_ + 1 < NREP(PH_PU0)) ? PROBE_IDMASK : 0x3fff); if (rep_ + 1 < NREP(PH_PU0)) xcd_barrier(bar); } SEAM(PH_PU0); }
    if (IN(PH_PA0)) { for (int rep_ = 0; rep_ < NREP(PH_PA0); ++rep_) { MKCTX();  ph_peer_act2(p, 0, c); if (rep_ + 1 < NREP(PH_PA0)) xcd_barrier(bar); } SEAM(PH_PA0); }
    if (IN(PH_PV0)) { for (int rep_ = 0; rep_ < NREP(PH_PV0); ++rep_) { MKCTX();  GETXI(); ph_peer_v2(p, 0, c, xi, (rep_ + 1 < NREP(PH_PV0)) ? (float*)(ws + WS_S) : p.out, (rep_ + 1 < NREP(PH_PV0)) ? PROBE_IDMASK : 0x3fff); if (rep_ + 1 < NREP(PH_PV0)) xcd_barrier(bar); } SEAM(PH_PV0); }
    if (IN(PH_NORM_M1)) { for (int rep_ = 0; rep_ < NREP(PH_NORM_M1); ++rep_) { MKCTX();  norm_rows_bf16(p.out, p.mix_norm + DM, ACT, c); if (rep_ + 1 < NREP(PH_NORM_M1)) xcd_barrier(bar); } SEAM(PH_NORM_M1); }
    if (IN(PH_GEMM_CIN)) { for (int rep_ = 0; rep_ < NREP(PH_GEMM_CIN); ++rep_) { MKCTX();  pg8::EpiBf16<0> E{PROJ, 2048, nullptr, 0, 0, 1.f}; GETXI(); run_gemm(c, ACT, (const bf16_t*)(ws + WS_WT_CIN), 2048, E, (xi.nx == 8 && xi.nloc * 8 == (int)gridDim.x) ? xi.jr * 8 + xi.xr : (int)blockIdx.x); if (rep_ + 1 < NREP(PH_GEMM_CIN)) xcd_barrier(bar); } SEAM(PH_GEMM_CIN); }
    if (IN(PH_G1)) { for (int rep_ = 0; rep_ < NREP(PH_G1); ++rep_) { MKCTX();  griffin_pass(p, c); if (rep_ + 1 < NREP(PH_G1)) xcd_barrier(bar); } SEAM(PH_G1); }
    if (IN(PH_G2)) { for (int rep_ = 0; rep_ < NREP(PH_G2); ++rep_) { MKCTX();  ph_carry(p, c); if (rep_ + 1 < NREP(PH_G2)) xcd_barrier(bar); } SEAM(PH_G2); }
    if (IN(PH_G3)) { for (int rep_ = 0; rep_ < NREP(PH_G3); ++rep_) { MKCTX();  ph_gr_fix(p, c); if (rep_ + 1 < NREP(PH_G3)) xcd_barrier(bar); } SEAM(PH_G3); }
    if (IN(PH_GEMM_OUT1)) { for (int rep_ = 0; rep_ < NREP(PH_GEMM_OUT1); ++rep_) { MKCTX();  pg8::EpiResF32 E{p.out, p.out, DM}; GETXI(); run_gemm(c, ACT, (const bf16_t*)(ws + WS_WT_COUT), DM, E, (xi.nx == 8 && xi.nloc * 8 == (int)gridDim.x) ? xi.jr * 8 + xi.xr : (int)blockIdx.x); if (rep_ + 1 < NREP(PH_GEMM_OUT1)) xcd_barrier(bar); } SEAM(PH_GEMM_OUT1); }
    if (IN(PH_NORM_F1)) { for (int rep_ = 0; rep_ < NREP(PH_NORM_F1); ++rep_) { MKCTX();
        norm_rows_bf16(p.out, p.ffn_norm + DM, ACT, c, ws + WS_XN8);
        cvt_fp8_rows(p.peer_u + (size_t)NEXP * DM, ws + WS_TAB8 + (size_t)2 * NEXP * DM, (float*)(ws + WS_SCL) + 2 * NEXP, NEXP, c);
        cvt_fp8_rows(p.peer_v + (size_t)NEXP * DM, ws + WS_TAB8 + (size_t)3 * NEXP * DM, (float*)(ws + WS_SCL) + 3 * NEXP, NEXP, c);
        if (rep_ + 1 < NREP(PH_NORM_F1)) xcd_barrier(bar); } SEAM(PH_NORM_F1); }
    if (IN(PH_GEMM_Q1)) { for (int rep_ = 0; rep_ < NREP(PH_GEMM_Q1); ++rep_) { MKCTX();  pg8::EpiBf16<0> E{PROJ, 2048, nullptr, 0, 0, 1.f}; GETXI(); run_gemm(c, ACT, (const bf16_t*)(ws + WS_WT_Q1), 2048, E, (xi.nx == 8 && xi.nloc * 8 == (int)gridDim.x) ? xi.jr * 8 + xi.xr : (int)blockIdx.x); if (rep_ + 1 < NREP(PH_GEMM_Q1)) xcd_barrier(bar); } SEAM(PH_GEMM_Q1); }
    if (IN(PH_TOPK1_1)) { for (int rep_ = 0; rep_ < NREP(PH_TOPK1_1); ++rep_) { MKCTX();  ph_topk(p, 1, c); if (rep_ + 1 < NREP(PH_TOPK1_1)) xcd_barrier(bar); } SEAM(PH_TOPK1_1); }
    if (IN(PH_PU1)) { for (int rep_ = 0; rep_ < NREP(PH_PU1); ++rep_) { MKCTX();  GETXI(); ph_peer_u2(p, 1, c, xi, (rep_ + 1 < NREP(PH_PU1)) ? PROBE_IDMASK : 0x3fff); if (rep_ + 1 < NREP(PH_PU1)) xcd_barrier(bar); } SEAM(PH_PU1); }
    if (IN(PH_PA1)) { for (int rep_ = 0; rep_ < NREP(PH_PA1); ++rep_) { MKCTX();  ph_peer_act2(p, 1, c); if (rep_ + 1 < NREP(PH_PA1)) xcd_barrier(bar); } SEAM(PH_PA1); }
    if (IN(PH_PV1)) { for (int rep_ = 0; rep_ < NREP(PH_PV1); ++rep_) { MKCTX();  GETXI(); ph_peer_v2(p, 1, c, xi, (rep_ + 1 < NREP(PH_PV1)) ? (float*)(ws + WS_S) : p.out, (rep_ + 1 < NREP(PH_PV1)) ? PROBE_IDMASK : 0x3fff); if (rep_ + 1 < NREP(PH_PV1)) xcd_barrier(bar); } SEAM(PH_PV1); }
    if (IN(PH_FINAL)) { MKCTX(); norm_rows_f32(p.out, p.final_norm, c); }
#undef IN
#undef SEAM
}

extern "C" void kernel_launch(void* const* d_in, const int* in_sizes, int n_in, void* d_out, int out_size, void* d_ws, size_t ws_size, hipStream_t stream) {
    static int grid = 0;
    if (grid == 0) {
        if (n_in != 22 || out_size != M * DM || ws_size < WS_END) { fprintf(stderr, "kernel_launch: unexpected shapes: n_in %d out %d ws %zu (need %zu)\n", n_in, out_size, ws_size, (size_t)WS_END); grid = -1; return; }
        int dev = 0, cus = 0, per_cu = 0;
        if (hipGetDevice(&dev) != hipSuccess || hipDeviceGetAttribute(&cus, hipDeviceAttributeMultiprocessorCount, dev) != hipSuccess) { grid = -1; return; }
        if (hipFuncSetAttribute((const void*)mega_fwd, hipFuncAttributeMaxDynamicSharedMemorySize, LDS_BYTES) != hipSuccess) { fprintf(stderr, "kernel_launch: hipFuncSetAttribute failed\n"); grid = -1; return; }
        if (hipOccupancyMaxActiveBlocksPerMultiprocessor(&per_cu, (const void*)mega_fwd, NTHREADS, LDS_BYTES) != hipSuccess || per_cu < 1) { fprintf(stderr, "kernel_launch: occupancy query says %d blocks per CU\n", per_cu); per_cu = 1; }
        (void)hipGetLastError();
        grid = cus;
        if (grid % 8 != 0 || grid < 32) { fprintf(stderr, "kernel_launch: unexpected CU count %d\n", cus); }
    }
    if (grid < 0) return;
    (void)hipMemsetAsync((char*)d_ws + WS_CTL, 0, CTL_ZERO_BYTES, stream);
    Params p{};
    const float** pp = (const float**)&p;
    for (int i = 0; i < 22; ++i) pp[i] = (const float*)d_in[i];
    p.out = (float*)d_out; p.ws = (unsigned char*)d_ws;
#if MK_N_LAUNCHES == 1
    p.ph_lo = 0; p.ph_hi = NPHASES;
    void* args[] = {&p};
    hipError_t e = hipLaunchCooperativeKernel((const void*)mega_fwd, dim3(grid), dim3(NTHREADS), args, LDS_BYTES, stream);
    if (e != hipSuccess) fprintf(stderr, "cooperative launch failed: %s (grid %d)\n", hipGetErrorString(e), grid);
#else
    for (int ph = 0; ph < NPHASES; ++ph) { p.ph_lo = ph; p.ph_hi = ph + 1; hipLaunchKernelGGL(mega_fwd, dim3(grid), dim3(NTHREADS), LDS_BYTES, stream, p); }
#endif
}
```

```cpp
#include <hip/hip_runtime.h>
#include <hip/hip_bf16.h>
#include <cstdio>
#include <cstdint>
#include <cmath>
namespace pg8 {
#define PG8_LAS __attribute__((address_space(3)))
typedef unsigned short bf16_t;
typedef short bf16x8 __attribute__((ext_vector_type(8)));
typedef float f32x4 __attribute__((ext_vector_type(4)));
typedef unsigned u32x4 __attribute__((ext_vector_type(4)));
constexpr int BM = 256, BK = 64, HALF = 128, HTB = HALF * BK * 2  , STAGE_BYTES = 8 * HTB, NXCD = 8, WGM = 8;

__host__ __device__ __forceinline__ int lds_byte(int r, int c) { const int st = (r >> 4) * 2 + (c >> 5), rr = r & 15, cc = c & 31, ob = rr * 64 + cc * 2; return st * 1024 + (ob ^ (((ob >> 9) & 1) << 5)); }
__host__ __device__ __forceinline__ void stage_rc(int b, int& R, int& C) { const int st = b / 1024, sb = b % 1024, swz = sb ^ (((sb >> 9) & 1) << 5); R = (st >> 1) * 16 + swz / 64; C = (st & 1) * 32 + (swz % 64) / 2; }
__host__ __device__ __forceinline__ int perm32(int rho) { const int n = rho >> 4, i = rho & 15; return 8 * (i >> 2) + 4 * n + (i & 3); }

struct Unit { int pm, pn; };
struct Gemm { const bf16_t* A; const bf16_t* Bt; int M, N, K; };

struct StaticOrder {
    int nM, nN, nwg, G, c;
    __host__ __device__ void init(int M, int N, int G_, int c_) { nM = M / BM; nN = N / BM; nwg = nM * nN; G = G_; c = c_; }
    __host__ __device__ bool next(int i, Unit& u) const {
        const long L = (long)i * G + c; if (L >= nwg) return false;
        int wgid = (int)L; { const int q = nwg / NXCD, r = nwg % NXCD, xcd = wgid % NXCD, off = wgid / NXCD; wgid = (xcd < r ? xcd * (q + 1) : r * (q + 1) + (xcd - r) * q) + off; }
        const int nig = WGM * nN, gid = wgid / nig, fm = gid * WGM, gsz = (nM - fm) < WGM ? (nM - fm) : WGM;
        u.pm = fm + ((wgid % nig) % gsz); u.pn = (wgid % nig) / gsz; return true;
    }
    __device__ __forceinline__ void a_ready(const Unit&) const {}
    __device__ __forceinline__ void done(const Unit&) const {}
};

__device__ __forceinline__ unsigned cvt_pk_bf16(float lo, float hi) { unsigned r; asm volatile("v_cvt_pk_bf16_f32 %0, %1, %2" : "=v"(r) : "v"(lo), "v"(hi)); return r; }
typedef float f32x2 __attribute__((ext_vector_type(2)));
__device__ __forceinline__ f32x2 gelu_pk(f32x2 v) {
    const f32x2 av = __builtin_elementwise_abs(v), d = av * 0.2316418882f + 1.0f;
    f32x2 t; t.x = __builtin_amdgcn_rcpf(d.x); t.y = __builtin_amdgcn_rcpf(d.y);
    f32x2 q = t * 0.5307027145f + (-0.7265760135f); q = q * t + 0.7107068705f; q = q * t + (-0.142248368f); q = q * t + 0.127414796f; q = q * t;
    const f32x2 s = (v * v) * (-0.72134752044f);
    f32x2 e; e.x = __builtin_amdgcn_exp2f(s.x); e.y = __builtin_amdgcn_exp2f(s.y);
    const f32x2 m = v * (q * e), r = v - m;
    f32x2 o; o.x = v.x < 0.f ? m.x : r.x; o.y = v.y < 0.f ? m.y : r.y; return o;
}
template <int ACT  > struct EpiBf16 {
    static constexpr bool PERM = true, AFTER_DRAIN = false; static_assert(ACT == 0 || ACT == 1, "EpiBf16: ACT is 0 (none) or 1 (gelu_pk)");
    bf16_t* O; int ldc; const float* bias; int split_cols; size_t split_stride; float scale0;
    __device__ __forceinline__ void operator()(const f32x4 (&acc)[2][2][4][2], const Unit& u, int wr, int wc, int fr, int fq) const {
        const int row0 = u.pm * BM + wr * 64 + fr; int colt = u.pn * BM; bf16_t* base = O;
        float sc = 1.f; if (split_cols) { const int t = colt / split_cols; base += (size_t)t * split_stride; colt -= t * split_cols; if (t == 0) sc = scale0; }
        const int col0 = colt + wc * 32 + 8 * fq, bcol0 = u.pn * BM + wc * 32 + 8 * fq;
        f32x4 bv[2][2];
#pragma unroll
        for (int bj = 0; bj < 2; ++bj)
#pragma unroll
            for (int n = 0; n < 2; ++n) bv[bj][n] = bias ? *(const f32x4*)(bias + bcol0 + bj * HALF + 4 * n) : (f32x4){0.f, 0.f, 0.f, 0.f};
#pragma unroll
        for (int ai = 0; ai < 2; ++ai)
#pragma unroll
            for (int m = 0; m < 4; ++m) { bf16_t* rowp = base + (size_t)(row0 + ai * HALF + m * 16) * ldc + col0;
#pragma unroll
                for (int bj = 0; bj < 2; ++bj) { f32x4 v0 = acc[ai][bj][m][0] + bv[bj][0], v1 = acc[ai][bj][m][1] + bv[bj][1];
                    if (ACT == 1) { f32x2 a = gelu_pk((f32x2){v0[0], v0[1]}), b = gelu_pk((f32x2){v0[2], v0[3]}), c = gelu_pk((f32x2){v1[0], v1[1]}), d = gelu_pk((f32x2){v1[2], v1[3]});
                        v0 = (f32x4){a.x, a.y, b.x, b.y}; v1 = (f32x4){c.x, c.y, d.x, d.y}; }
                    v0 = v0 * sc; v1 = v1 * sc; u32x4 w; w.x = cvt_pk_bf16(v0[0], v0[1]); w.y = cvt_pk_bf16(v0[2], v0[3]); w.z = cvt_pk_bf16(v1[0], v1[1]); w.w = cvt_pk_bf16(v1[2], v1[3]);
                    *(u32x4*)(rowp + bj * HALF) = w; } }
    }
};
template <class Epi, class Sched, bool ALIGN_EPI = false, bool SP2 = false>
__device__ __forceinline__ void gemm_phase(PG8_LAS unsigned char* lds, const Gemm g, const Sched& S, const Epi& E) {
    const int tid = threadIdx.x, wid = __builtin_amdgcn_readfirstlane(tid >> 6), lane = tid & 63, wr = wid >> 2, wc = wid & 3, fr = lane & 15, fq = lane >> 4;
    const int K = g.K, nt = K / BK;
    unsigned voffA[2], voffB[2];
#pragma unroll
    for (int i = 0; i < 2; ++i) { int R, C; stage_rc(tid * 16 + i * 8192, R, C); const int Rb = Epi::PERM ? ((R & ~31) + perm32(R & 31)) : R;
        voffA[i] = (unsigned)(R * K + C) * 2u; voffB[i] = (unsigned)(Rb * K + C) * 2u; }
    const size_t kstep = (size_t)(BK * 2);
    const size_t hstep = (size_t)HALF * K * 2;
    const size_t tstep = 2 * hstep;
    const unsigned ldsw = (unsigned)wid * 1024u;
    const int aoff = lds_byte(wr * 64 + fr, fq * 8), boff = lds_byte(wc * 32 + fr, fq * 8);
#define PG8_SA(b, h) (((b) * 2 + (h)) * HTB)
#define PG8_SB(b, h) ((4 + (b) * 2 + (h)) * HTB)
#define PG8_STAGE(bufoff, gbase, voff) do { _Pragma("unroll") for (int _i = 0; _i < 2; ++_i) \
        __builtin_amdgcn_global_load_lds((const unsigned*)((const char*)(gbase) + (voff)[_i]), (PG8_LAS unsigned*)(lds + (bufoff) + ldsw + _i * 8192), 16, 0, 0); } while (0)
#define PG8_LDA(dst, b, h) do { _Pragma("unroll") for (int m = 0; m < 4; ++m) _Pragma("unroll") for (int k = 0; k < 2; ++k) dst[m][k] = *(const PG8_LAS bf16x8*)(lds + PG8_SA(b, h) + aoff + m * 2048 + k * 1024); } while (0)
#define PG8_LDB(dst, b, h) do { _Pragma("unroll") for (int n = 0; n < 2; ++n) _Pragma("unroll") for (int k = 0; k < 2; ++k) dst[n][k] = *(const PG8_LAS bf16x8*)(lds + PG8_SB(b, h) + boff + n * 2048 + k * 1024); } while (0)
#define PG8_MMA(ai, bj, At, Bt) do { __builtin_amdgcn_s_setprio(1); _Pragma("unroll") for (int m = 0; m < 4; ++m) _Pragma("unroll") for (int n = 0; n < 2; ++n) _Pragma("unroll") for (int k = 0; k < 2; ++k) \
        acc[ai][bj][m][n] = __builtin_amdgcn_mfma_f32_16x16x32_bf16(Bt[n][k], At[m][k], acc[ai][bj][m][n], 0, 0, 0); __builtin_amdgcn_s_setprio(0); } while (0)
#define PG8_WAIT_V(n) asm volatile("s_waitcnt vmcnt(" #n ")" ::: "memory")
#define PG8_WAIT_L(n) asm volatile("s_waitcnt lgkmcnt(" #n ")" ::: "memory")
#define PG8_BAR __builtin_amdgcn_s_barrier()
#define PG8_SCHED __builtin_amdgcn_sched_barrier(0)
    Unit cur, nxt; int ui = 0;
    if (!S.next(0, cur)) return;
    f32x4 acc[2][2][4][2];
#pragma unroll
    for (int a = 0; a < 2; ++a)
#pragma unroll
        for (int b = 0; b < 2; ++b)
#pragma unroll
            for (int m = 0; m < 4; ++m)
#pragma unroll
                for (int n = 0; n < 2; ++n) acc[a][b][m][n] = (f32x4){0.f, 0.f, 0.f, 0.f};
    bf16x8 At[4][2], B0[2][2], B1[2][2];
    const char* cA = (const char*)g.A + (size_t)cur.pm * tstep; const char* cB = (const char*)g.Bt + (size_t)cur.pn * tstep;
    S.a_ready(cur);
    if constexpr (SP2) {
        PG8_STAGE(PG8_SB(0, 0), cB, voffB); PG8_STAGE(PG8_SB(0, 1), cB + hstep, voffB); PG8_STAGE(PG8_SA(0, 0), cA, voffA); PG8_STAGE(PG8_SA(0, 1), cA + hstep, voffA);
        if (wr == 1) PG8_BAR;
        PG8_WAIT_V(2); PG8_BAR;
        PG8_STAGE(PG8_SB(1, 0), cB + kstep, voffB); PG8_STAGE(PG8_SA(1, 0), cA + kstep, voffA); PG8_STAGE(PG8_SB(1, 1), cB + hstep + kstep, voffB);
        PG8_WAIT_V(6); PG8_BAR;
    } else {
        PG8_STAGE(PG8_SB(0, 0), cB, voffB); PG8_STAGE(PG8_SA(0, 0), cA, voffA); PG8_STAGE(PG8_SB(0, 1), cB + hstep, voffB); PG8_STAGE(PG8_SA(0, 1), cA + hstep, voffA);
        if (wr == 1) PG8_BAR;
        PG8_WAIT_V(4); PG8_BAR;
        PG8_STAGE(PG8_SB(1, 0), cB + kstep, voffB); PG8_STAGE(PG8_SA(1, 0), cA + kstep, voffA); PG8_STAGE(PG8_SB(1, 1), cB + hstep + kstep, voffB);
        PG8_WAIT_V(6); PG8_BAR;
    }
    for (;;) {
        const bool has_next = S.next(ui + 1, nxt);
        const char* nA = has_next ? (const char*)g.A + (size_t)nxt.pm * tstep : cA; const char* nB = has_next ? (const char*)g.Bt + (size_t)nxt.pn * tstep : cB;
        for (int t = 0; t < nt; t += 2) {
            const bool last = (t == nt - 2);
            const char* a1 = cA + (size_t)(t + 1) * kstep;
            const char* a2 = last ? nA : cA + (size_t)(t + 2) * kstep; const char* b2 = last ? nB : cB + (size_t)(t + 2) * kstep;
            const char* a3 = a2 + kstep; const char* b3 = b2 + kstep;
            if (last && has_next) S.a_ready(nxt);
            if constexpr (SP2) {
            PG8_LDB(B0, 0, 0); PG8_LDB(B1, 0, 1); PG8_SCHED; PG8_LDA(At, 0, 0); PG8_STAGE(PG8_SA(1, 1), a1 + hstep, voffA);
            PG8_WAIT_V(8); PG8_WAIT_L(0); PG8_BAR; PG8_MMA(0, 0, At, B0); PG8_MMA(0, 1, At, B1); PG8_BAR; PG8_SCHED;
            PG8_LDA(At, 0, 1); PG8_STAGE(PG8_SB(0, 0), b2, voffB); PG8_STAGE(PG8_SB(0, 1), b2 + hstep, voffB); PG8_STAGE(PG8_SA(0, 0), a2, voffA);
            PG8_WAIT_V(8); PG8_WAIT_L(0); PG8_BAR; PG8_MMA(1, 0, At, B0); PG8_MMA(1, 1, At, B1); PG8_BAR; PG8_SCHED;
            PG8_LDB(B0, 1, 0); PG8_LDB(B1, 1, 1); PG8_SCHED; PG8_LDA(At, 1, 0); PG8_STAGE(PG8_SA(0, 1), a2 + hstep, voffA);
            PG8_WAIT_V(8); PG8_WAIT_L(0); PG8_BAR; PG8_MMA(0, 0, At, B0); PG8_MMA(0, 1, At, B1); PG8_BAR; PG8_SCHED;
            PG8_LDA(At, 1, 1); PG8_STAGE(PG8_SB(1, 0), b3, voffB); PG8_STAGE(PG8_SB(1, 1), b3 + hstep, voffB); PG8_STAGE(PG8_SA(1, 0), a3, voffA);
            PG8_WAIT_V(8); PG8_WAIT_L(0); PG8_BAR; PG8_MMA(1, 0, At, B0); PG8_MMA(1, 1, At, B1); PG8_BAR; PG8_SCHED;
            } else {
            PG8_LDB(B0, 0, 0); PG8_SCHED; PG8_LDA(At, 0, 0); PG8_STAGE(PG8_SA(1, 1), a1 + hstep, voffA);
            PG8_WAIT_L(8); PG8_BAR; PG8_WAIT_L(0); PG8_MMA(0, 0, At, B0); PG8_BAR; PG8_SCHED;
            PG8_LDB(B1, 0, 1); PG8_STAGE(PG8_SB(0, 0), b2, voffB);
            PG8_BAR; PG8_WAIT_L(0); PG8_MMA(0, 1, At, B1); PG8_BAR;
            PG8_LDA(At, 0, 1); PG8_STAGE(PG8_SA(0, 0), a2, voffA);
            PG8_BAR; PG8_WAIT_L(0); PG8_MMA(1, 0, At, B0); PG8_BAR; PG8_SCHED;
            PG8_STAGE(PG8_SB(0, 1), b2 + hstep, voffB);
            PG8_WAIT_V(6); PG8_BAR; PG8_MMA(1, 1, At, B1); PG8_BAR;
            PG8_LDB(B0, 1, 0); PG8_SCHED; PG8_LDA(At, 1, 0); PG8_STAGE(PG8_SA(0, 1), a2 + hstep, voffA);
            PG8_WAIT_L(8); PG8_BAR; PG8_WAIT_L(0); PG8_MMA(0, 0, At, B0); PG8_BAR; PG8_SCHED;
            PG8_LDB(B1, 1, 1); PG8_STAGE(PG8_SB(1, 0), b3, voffB);
            PG8_BAR; PG8_WAIT_L(0); PG8_MMA(0, 1, At, B1); PG8_BAR;
            PG8_LDA(At, 1, 1); PG8_STAGE(PG8_SA(1, 0), a3, voffA);
            PG8_BAR; PG8_WAIT_L(0); PG8_MMA(1, 0, At, B0); PG8_BAR; PG8_SCHED;
            PG8_STAGE(PG8_SB(1, 1), b3 + hstep, voffB);
            PG8_WAIT_V(6); PG8_BAR; PG8_MMA(1, 1, At, B1); PG8_BAR;
            }
        }
        if constexpr (ALIGN_EPI) { if (wr == 0) PG8_BAR; }
        if constexpr (!Epi::AFTER_DRAIN) { E(acc, cur, wr, wc, fr, fq); S.done(cur); }
        if (!has_next) break;
#pragma unroll
        for (int a = 0; a < 2; ++a)
#pragma unroll
            for (int b = 0; b < 2; ++b)
#pragma unroll
                for (int m = 0; m < 4; ++m)
#pragma unroll
                    for (int n = 0; n < 2; ++n) acc[a][b][m][n] = (f32x4){0.f, 0.f, 0.f, 0.f};
        cur = nxt; cA = nA; cB = nB; ++ui;
        if constexpr (ALIGN_EPI) { if (wr == 1) PG8_BAR; }
    }
    PG8_WAIT_V(0);
    if constexpr (!ALIGN_EPI) { if (wr == 0) PG8_BAR; }
    PG8_BAR;
    if constexpr (Epi::AFTER_DRAIN) { E.fused(acc, cur, wr, wc, fr, fq, lds, wid, lane); S.done(cur); }
#undef PG8_SA
#undef PG8_SB
#undef PG8_STAGE
#undef PG8_LDA
#undef PG8_LDB
#undef PG8_MMA
#undef PG8_WAIT_V
#undef PG8_WAIT_L
#undef PG8_BAR
#undef PG8_SCHED
}

template <bool F32BASE> struct EpiResBf {
    static constexpr bool PERM = true, AFTER_DRAIN = false;
    const void* base; bf16_t* out; int ldc;
    __device__ __forceinline__ void operator()(const f32x4 (&acc)[2][2][4][2], const Unit& u, int wr, int wc, int fr, int fq) const {
        const int row0 = u.pm * BM + wr * 64 + fr, col0 = u.pn * BM + wc * 32 + 8 * fq;
#pragma unroll
        for (int ai = 0; ai < 2; ++ai)
#pragma unroll
            for (int m = 0; m < 4; ++m) { const size_t off = (size_t)(row0 + ai * HALF + m * 16) * ldc + col0;
#pragma unroll
                for (int bj = 0; bj < 2; ++bj) { f32x4 v0 = acc[ai][bj][m][0], v1 = acc[ai][bj][m][1];
                    if (F32BASE) { const float* b = (const float*)base + off + bj * HALF; v0 = v0 + *(const f32x4*)b; v1 = v1 + *(const f32x4*)(b + 4); }
                    else { const u32x4 rw = *(const u32x4*)((const bf16_t*)base + off + bj * HALF);
                        v0 = v0 + (f32x4){__builtin_bit_cast(float, rw.x << 16), __builtin_bit_cast(float, rw.x & 0xffff0000u), __builtin_bit_cast(float, rw.y << 16), __builtin_bit_cast(float, rw.y & 0xffff0000u)};
                        v1 = v1 + (f32x4){__builtin_bit_cast(float, rw.z << 16), __builtin_bit_cast(float, rw.z & 0xffff0000u), __builtin_bit_cast(float, rw.w << 16), __builtin_bit_cast(float, rw.w & 0xffff0000u)}; }
                    u32x4 w; w.x = cvt_pk_bf16(v0[0], v0[1]); w.y = cvt_pk_bf16(v0[2], v0[3]); w.z = cvt_pk_bf16(v1[0], v1[1]); w.w = cvt_pk_bf16(v1[2], v1[3]);
                    *(u32x4*)(out + off + bj * HALF) = w; } }
    }
};
}

constexpr int BATCH = 4, SEQ = 8192, DM = 1024, M = BATCH * SEQ;
constexpr int NIN = 3088, NIN_PAD = 3328;
constexpr int C_GQ = 0, C_GK = 256, C_GV = 512, C_GG = 1024, C_AQ = 1536, C_AK = 2048, C_AV = 2560, C_GLR = 3072;
constexpr int NEXP = 16384;
constexpr float NORM_EPS = 1e-6f;
constexpr int NWAVES = 8, NTHREADS = 512;

constexpr size_t MiB = 1u << 20;
constexpr size_t WS_CTL = 0, CTL_ZERO_BYTES = 1 * MiB;
constexpr size_t WS_WT_IN = 1 * MiB;
constexpr size_t WS_WT_OUT = 8 * MiB;
constexpr size_t WS_WT_CIN = 10 * MiB;
constexpr size_t WS_WT_COUT = 14 * MiB;
constexpr size_t WS_WT_Q0 = 16 * MiB;
constexpr size_t WS_WT_Q1 = 20 * MiB;
constexpr size_t WS_ACT = 32 * MiB;
constexpr size_t WS_S = 96 * MiB;
constexpr size_t WS_PROJ = WS_S;
constexpr size_t WS_GLAO = WS_S + 208 * MiB;
constexpr size_t WS_TOPS = WS_S + 128 * MiB;
constexpr size_t WS_TOPI = WS_S + 160 * MiB;
constexpr size_t WS_IDS = WS_S + 192 * MiB;
constexpr size_t WS_G = WS_S + 208 * MiB;
constexpr size_t WS_XC = WS_ACT;
constexpr size_t WS_A = WS_S + 128 * MiB;
constexpr size_t WS_HB = WS_S + 256 * MiB;
constexpr size_t WS_Y0 = WS_S + 320 * MiB;
constexpr size_t WS_U = WS_S + 256 * MiB;
constexpr size_t WS_TAB = 448 * MiB;
constexpr size_t WS_TAB8 = 448 * MiB;
constexpr size_t WS_WG = 24 * MiB;
constexpr size_t WS_AGG = WS_S + 128 * MiB;
constexpr size_t WS_SCL = 26 * MiB;
constexpr size_t WS_END = 512 * MiB;
constexpr int CW_BAR = 4096, CW_RANK = 8192;

constexpr int RING_BYTES = 131072;
constexpr int LDS_BYTES = 147456;
constexpr int LDSCTL_OFF = LDS_BYTES - 512, MISC_OFF = LDSCTL_OFF + 320;

#define LAS __attribute__((address_space(3)))
#define GAS __attribute__((address_space(1)))
typedef unsigned short bf16_t;
typedef float f32x4 __attribute__((ext_vector_type(4)));
typedef unsigned u32x4 __attribute__((ext_vector_type(4)));
typedef unsigned u32x2 __attribute__((ext_vector_type(2)));
typedef short bf16x8 __attribute__((ext_vector_type(8)));
typedef float f32x2 __attribute__((ext_vector_type(2)));

struct Params {
    const float *x, *mix_norm, *ffn_norm, *ab_w_in, *gla_w_alpha, *gla_b_alpha, *gla_head_gain, *ab_w_out;
    const float *c_w_in, *c_conv_w, *c_conv_b, *c_w_rgate, *c_b_rgate, *c_w_igate, *c_b_igate, *c_lambda, *c_w_out;
    const float *peer_w_query, *peer_sub_keys, *peer_u, *peer_v, *final_norm;
    float* out; unsigned char* ws; bf16_t* hb;
    int ph_lo, ph_hi;
};

typedef float f32x2_cv __attribute__((ext_vector_type(2))); typedef __bf16 bf16x2_cv __attribute__((ext_vector_type(2)));
__device__ __forceinline__ unsigned pk2(float lo, float hi) { const f32x2_cv v = {lo, hi}; const bf16x2_cv b = __builtin_convertvector(v, bf16x2_cv); return __builtin_bit_cast(unsigned, b); }
__device__ __forceinline__ unsigned f2bf(float f) { return pk2(f, f) & 0xffffu; }
__device__ __forceinline__ float bf2f(bf16_t b) { return __builtin_bit_cast(float, (unsigned)b << 16); }
__device__ __forceinline__ float bflo(unsigned w) { return __builtin_bit_cast(float, w << 16); }
__device__ __forceinline__ float bfhi(unsigned w) { return __builtin_bit_cast(float, w & 0xffff0000u); }
__device__ __forceinline__ float wave_sum(float v) {
#pragma unroll
    for (int o = 1; o < 64; o <<= 1) v += __shfl_xor(v, o);
    return v;
}
__device__ __forceinline__ float gelu_tanh(float x) {
    const float x2 = x * x, u2 = x * (2.3022082f + 0.10294324f * x2);
    const float e = __builtin_amdgcn_exp2f(u2);
    return x - x * __builtin_amdgcn_rcpf(e + 1.f);
}
__device__ __forceinline__ float sigmoidf_(float x) { return __builtin_amdgcn_rcpf(1.f + __expf(-x)); }

struct Ctx { int tid, lane, wave, blk, nblk, gtid, gthreads, gwave, gwaves; LAS unsigned char* lds; };

template <class F> __device__ __forceinline__ void transpose_cvt(const float* W, int K, int Nsrc, bf16_t* WT, int Ndst, F srcmap, int gtid, int gthreads) {
    const int total = (K / 8) * Ndst;
    for (int idx = gtid; idx < total; idx += gthreads) {
        const int ko = idx / Ndst, n = idx - ko * Ndst; const int sn = srcmap(n);
        u32x4 w = {0u, 0u, 0u, 0u};
        if (sn >= 0) { const float* s = W + (size_t)(ko * 8) * Nsrc + sn;
            w.x = pk2(s[0], s[(size_t)Nsrc]); w.y = pk2(s[2 * (size_t)Nsrc], s[3 * (size_t)Nsrc]); w.z = pk2(s[4 * (size_t)Nsrc], s[5 * (size_t)Nsrc]); w.w = pk2(s[6 * (size_t)Nsrc], s[7 * (size_t)Nsrc]); }
        *(u32x4*)(WT + (size_t)n * K + ko * 8) = w;
    }
}
__device__ __forceinline__ void cvt_bf16(const float* src, bf16_t* dst, size_t n8, int gtid, int gthreads) {
    for (size_t i = gtid; i < n8; i += gthreads) { const f32x4 a = *(const f32x4*)(src + i * 8), b = *(const f32x4*)(src + i * 8 + 4);
        u32x4 w; w.x = pk2(a.x, a.y); w.y = pk2(a.z, a.w); w.z = pk2(b.x, b.y); w.w = pk2(b.z, b.w); *(u32x4*)(dst + i * 8) = w; }
}
__device__ __forceinline__ void ld_row4(const float* row, int lane, int j, f32x4& v) { v = ((const f32x4*)row)[64 * j + lane]; }
__device__ __forceinline__ void ld_row4(const bf16_t* row, int lane, int j, f32x4& v) { const u32x2 w = ((const u32x2*)row)[64 * j + lane]; v = (f32x4){bflo(w.x), bfhi(w.x), bflo(w.y), bfhi(w.y)}; }
template <class T> __device__ __forceinline__ void norm_rows_bf16(const T* src, const float* gain, bf16_t* dst, const Ctx& c, unsigned char* x8 = nullptr) {
    for (int m0 = c.gwave; m0 < M; m0 += 4 * c.gwaves) {
        f32x4 v[4][4]; float s[4];
#pragma unroll
        for (int u = 0; u < 4; ++u) { const T* xr = src + (size_t)min(m0 + u * c.gwaves, M - 1) * DM;
#pragma unroll
            for (int j = 0; j < 4; ++j) ld_row4(xr, c.lane, j, v[u][j]); }
#pragma unroll
        for (int u = 0; u < 4; ++u) { s[u] = 0.f;
#pragma unroll
            for (int j = 0; j < 4; ++j) s[u] += (v[u][j].x * v[u][j].x + v[u][j].y * v[u][j].y) + (v[u][j].z * v[u][j].z + v[u][j].w * v[u][j].w); }
#pragma unroll
        for (int o = 1; o < 64; o <<= 1) {
#pragma unroll
            for (int u = 0; u < 4; ++u) s[u] += __shfl_xor(s[u], o); }
#pragma unroll
        for (int u = 0; u < 4; ++u) { const int m = m0 + u * c.gwaves; if (m >= M) break; const float rstd = __builtin_amdgcn_rsqf(s[u] * (1.f / DM) + NORM_EPS);
            u32x2* o8 = (u32x2*)(dst + (size_t)m * DM) + c.lane;
#pragma unroll
            for (int j = 0; j < 4; ++j) { const f32x4 g = *((const f32x4*)gain + 64 * j + c.lane); const unsigned w0 = pk2(v[u][j].x * rstd * g.x, v[u][j].y * rstd * g.y), w1 = pk2(v[u][j].z * rstd * g.z, v[u][j].w * rstd * g.w);
                u32x2 w; w.x = w0; w.y = w1; o8[64 * j] = w;
                if (x8) {
                    const float f0 = bflo(w0), f1 = bfhi(w0), f2 = bflo(w1), f3 = bfhi(w1);
                    int hq = __builtin_amdgcn_cvt_pk_fp8_f32(f0, f1, 0, false); hq = __builtin_amdgcn_cvt_pk_fp8_f32(f2, f3, hq, true);
                    const f32x2 d0 = __builtin_amdgcn_cvt_pk_f32_fp8(hq, false), d1 = __builtin_amdgcn_cvt_pk_f32_fp8(hq, true);
                    int lq = __builtin_amdgcn_cvt_pk_fp8_f32((f0 - d0.x) * 16.f, (f1 - d0.y) * 16.f, 0, false); lq = __builtin_amdgcn_cvt_pk_fp8_f32((f2 - d1.x) * 16.f, (f3 - d1.y) * 16.f, lq, true);
                    unsigned* xo = (unsigned*)(x8 + (size_t)m * 2048) + 64 * j + c.lane; xo[0] = (unsigned)hq; xo[256] = (unsigned)lq; } } }
    }
}
__device__ __forceinline__ void norm_rows_f32(const bf16_t* src, float* dst, const float* gain, const Ctx& c) {
    for (int m0 = c.gwave; m0 < M; m0 += 4 * c.gwaves) {
        f32x4 v[4][4]; float s[4];
#pragma unroll
        for (int u = 0; u < 4; ++u) { const bf16_t* xr = src + (size_t)min(m0 + u * c.gwaves, M - 1) * DM;
#pragma unroll
            for (int j = 0; j < 4; ++j) ld_row4(xr, c.lane, j, v[u][j]); }
#pragma unroll
        for (int u = 0; u < 4; ++u) { s[u] = 0.f;
#pragma unroll
            for (int j = 0; j < 4; ++j) s[u] += (v[u][j].x * v[u][j].x + v[u][j].y * v[u][j].y) + (v[u][j].z * v[u][j].z + v[u][j].w * v[u][j].w); }
#pragma unroll
        for (int o = 1; o < 64; o <<= 1) {
#pragma unroll
            for (int u = 0; u < 4; ++u) s[u] += __shfl_xor(s[u], o); }
#pragma unroll
        for (int u = 0; u < 4; ++u) { if (m0 + u * c.gwaves >= M) break; const float rstd = __builtin_amdgcn_rsqf(s[u] * (1.f / DM) + NORM_EPS); f32x4* xw = (f32x4*)(dst + (size_t)(m0 + u * c.gwaves) * DM) + c.lane;
#pragma unroll
            for (int j = 0; j < 4; ++j) { const f32x4 g = *((const f32x4*)gain + 64 * j + c.lane); xw[64 * j] = v[u][j] * rstd * g; } }
    }
}

constexpr size_t WS_GLRB = 30 * MiB;
__device__ __forceinline__ void ph_glr(const Params& p, const Ctx& c) {
    const bf16_t* XN = (const bf16_t*)(p.ws + WS_ACT); const bf16_t* WG = (const bf16_t*)(p.ws + WS_WT_IN) + (size_t)3072 * DM; bf16_t* GL = (bf16_t*)(p.ws + WS_GLRB);
    const int lane = c.lane, r = lane & 15, q = lane >> 4;
    for (int tile = c.gwave; tile < M / 16; tile += c.gwaves) {
        const bf16_t* ap = XN + (size_t)(tile * 16 + r) * DM + 8 * q; const bf16_t* bp = WG + (size_t)r * DM + 8 * q;
        f32x4 acc = {0.f, 0.f, 0.f, 0.f};
#pragma unroll 8
        for (int s2 = 0; s2 < 32; ++s2) acc = __builtin_amdgcn_mfma_f32_16x16x32_bf16(__builtin_bit_cast(bf16x8, *(const u32x4*)(ap + 32 * s2)), __builtin_bit_cast(bf16x8, *(const u32x4*)(bp + 32 * s2)), acc, 0, 0, 0);
#pragma unroll
        for (int i = 0; i < 4; ++i) GL[(size_t)(tile * 16 + 4 * q + i) * 16 + r] = (bf16_t)f2bf(acc[i]);
    }
}


constexpr int AT_K = 0, AT_V = 272 * 144, AT_END = 2 * 272 * 144;
typedef short s16x4 __attribute__((ext_vector_type(4)));
__device__ __forceinline__ s16x4 lds_tr16(LAS const unsigned char* pbyte) { return __builtin_bit_cast(s16x4, __builtin_amdgcn_ds_read_tr16_b64_v4i16((LAS s16x4*)pbyte)); }
__device__ __forceinline__ void ph_attn(const Params& p, const Ctx& c) {
    LAS unsigned char* L = c.lds;
    const bf16_t* proj = (const bf16_t*)(p.ws + WS_PROJ); bf16_t* AO = (bf16_t*)p.out; float* LSE = (float*)((unsigned char*)p.out + 96 * MiB);
    const int tid = c.tid, lane = c.lane, w = c.wave, r = lane & 15, qq = lane >> 4;
    constexpr float LOG2E = 1.4426950408889634f;
    __syncthreads();
    for (int i = tid; i < 16 * 144 / 4; i += NTHREADS) ((LAS unsigned*)(L + AT_V + 256 * 144))[i] = 0u;
    u32x4 kreg[4], vreg[4], qreg[2];
#define AT_DECODE(it_) const int h = (it_) & 7, rest = (it_) >> 3, br = rest >> 8, u = rest & 255, sh = 2 * br, dil = 1 << sh, nbm = (64 >> sh) - 1; \
        const int bres = u >> (6 - sh), blk = u & nbm, b = bres >> sh, res = bres & (dil - 1); const size_t rowb = (size_t)b * SEQ; const int l0 = blk * 128
#define AT_ISSUE(it_) do { AT_DECODE(it_); (void)br; \
        _Pragma("unroll") for (int k = 0; k < 4; ++k) { const int idx = tid + NTHREADS * k, row = idx >> 3, ch = idx & 7, l = l0 - 128 + row; kreg[k] = (u32x4){0u, 0u, 0u, 0u}; vreg[k] = kreg[k]; \
            if (l >= 0) { const bf16_t* src = proj + (rowb + (size_t)l * dil + res) * NIN_PAD + C_AK + h * 64 + ch * 8; kreg[k] = *(const u32x4*)src; vreg[k] = *(const u32x4*)(src + 512); } } \
        const bf16_t* qp = proj + (rowb + (size_t)(l0 + 16 * w + r) * dil + res) * NIN_PAD + C_AQ + h * 64 + 8 * qq; qreg[0] = *(const u32x4*)qp; qreg[1] = *(const u32x4*)(qp + 32); } while (0)
    if (c.blk < 6144) AT_ISSUE(c.blk);
    for (int item = c.blk; item < 6144; item += c.nblk) {
        AT_DECODE(item);
        __syncthreads();
#pragma unroll
        for (int k = 0; k < 4; ++k) { const int idx = tid + NTHREADS * k, row = idx >> 3, ch = idx & 7;
            *(LAS u32x4*)(L + AT_K + row * 144 + ch * 16) = kreg[k]; *(LAS u32x4*)(L + AT_V + row * 144 + ch * 16) = vreg[k]; }
        bf16x8 qf[2]; qf[0] = __builtin_bit_cast(bf16x8, qreg[0]); qf[1] = __builtin_bit_cast(bf16x8, qreg[1]);
        { const int nit = item + c.nblk; if (nit < 6144) AT_ISSUE(nit); }
        __syncthreads();
        f32x4 sa[9];
#pragma unroll
        for (int jn = 0; jn < 9; ++jn) { LAS const unsigned char* kp = L + AT_K + (16 * (w + jn) + r) * 144 + 16 * qq;
            const bf16x8 k0 = __builtin_bit_cast(bf16x8, *(const LAS u32x4*)kp), k1 = __builtin_bit_cast(bf16x8, *(const LAS u32x4*)(kp + 64));
            f32x4 z = {0.f, 0.f, 0.f, 0.f}; z = __builtin_amdgcn_mfma_f32_16x16x32_bf16(k0, qf[0], z, 0, 0, 0); sa[jn] = __builtin_amdgcn_mfma_f32_16x16x32_bf16(k1, qf[1], z, 0, 0, 0); }
        const float sc = 0.125f * LOG2E, sl = exp2f(-(float)(h + 1)) * (float)dil * LOG2E;
        const int delta0 = r + 128 - 4 * qq;
        const float b0 = -sl * (float)delta0;
        float mx = -1e30f;
        if (blk > 0) {
#pragma unroll
            for (int jn = 0; jn < 9; ++jn)
#pragma unroll
                for (int i = 0; i < 4; ++i) { const bool valid = (unsigned)(delta0 - (16 * jn + i)) <= 128u;
                    const float v = valid ? __builtin_fmaf(sa[jn][i], sc, __builtin_fmaf(sl, (float)(16 * jn + i), b0)) : -1e30f; sa[jn][i] = v; mx = fmaxf(mx, v); }
        } else {
#pragma unroll
            for (int jn = 0; jn < 9; ++jn)
#pragma unroll
                for (int i = 0; i < 4; ++i) { const bool valid = ((unsigned)(delta0 - (16 * jn + i)) <= 128u) && (16 * (w + jn) + 4 * qq + i >= 128);
                    const float v = valid ? __builtin_fmaf(sa[jn][i], sc, __builtin_fmaf(sl, (float)(16 * jn + i), b0)) : -1e30f; sa[jn][i] = v; mx = fmaxf(mx, v); }
        }
        mx = fmaxf(mx, __shfl_xor(mx, 16)); mx = fmaxf(mx, __shfl_xor(mx, 32));
        float sum = 0.f;
#pragma unroll
        for (int jn = 0; jn < 9; ++jn)
#pragma unroll
            for (int i = 0; i < 4; ++i) { const float e = __builtin_amdgcn_exp2f(sa[jn][i] - mx); sa[jn][i] = e; sum += e; }
        sum += __shfl_xor(sum, 16); sum += __shfl_xor(sum, 32);
        { const int qi = 16 * w + r; if (qq == 0) LSE[((size_t)br * M + rowb + (size_t)(l0 + qi) * dil + res) * 8 + h] = (mx + __builtin_amdgcn_logf(sum)) * (1.f / LOG2E); }
        f32x4 oa[4];
#pragma unroll
        for (int dt = 0; dt < 4; ++dt) oa[dt] = (f32x4){0.f, 0.f, 0.f, 0.f};
#pragma unroll
        for (int s2 = 0; s2 < 5; ++s2) { u32x4 pw; pw.x = pk2(sa[2 * s2][0], sa[2 * s2][1]); pw.y = pk2(sa[2 * s2][2], sa[2 * s2][3]);
            if (s2 < 4) { pw.z = pk2(sa[2 * s2 + 1][0], sa[2 * s2 + 1][1]); pw.w = pk2(sa[2 * s2 + 1][2], sa[2 * s2 + 1][3]); } else { pw.z = 0u; pw.w = 0u; }
            LAS const unsigned char* vp = L + AT_V + (16 * (w + 2 * s2) + 4 * qq + (r >> 2)) * 144 + 8 * (r & 3);
#pragma unroll
            for (int dt = 0; dt < 4; ++dt) { const s16x4 v0 = lds_tr16(vp + 32 * dt), v1 = lds_tr16(vp + 32 * dt + 16 * 144);
                const bf16x8 vf = {v0[0], v0[1], v0[2], v0[3], v1[0], v1[1], v1[2], v1[3]};
                oa[dt] = __builtin_amdgcn_mfma_f32_16x16x32_bf16(__builtin_bit_cast(bf16x8, pw), vf, oa[dt], 0, 0, 0); } }
        const float rs = __builtin_amdgcn_rcpf(sum);
        LAS bf16_t* ost = (LAS bf16_t*)(L + AT_END + w * 2304);
#pragma unroll
        for (int i = 0; i < 4; ++i) { const float ri = __shfl(rs, 4 * qq + i);
#pragma unroll
            for (int dt = 0; dt < 4; ++dt) ost[(4 * qq + i) * 72 + 16 * dt + r] = (bf16_t)f2bf(oa[dt][i] * ri); }
        asm volatile("" ::: "memory");
        { const int qi = lane >> 2, dc = (lane & 3) * 16;
          const u32x4 o0 = *(const LAS u32x4*)(ost + qi * 72 + dc), o1 = *(const LAS u32x4*)(ost + qi * 72 + dc + 8);
          bf16_t* op = AO + ((size_t)br * M + rowb + (size_t)(l0 + 16 * w + qi) * dil + res) * 512 + h * 64 + dc;
          *(u32x4*)op = o0; *(u32x4*)(op + 8) = o1; }
        asm volatile("" ::: "memory");
    }
#undef AT_DECODE
#undef AT_ISSUE
}

constexpr size_t WS_CKV = WS_S + 272 * MiB;
constexpr size_t WS_DEC = WS_S + 336 * MiB;
constexpr size_t WS_SPREV = WS_ACT;
constexpr int GL_SEGT = 0, GL_V = 2048, GL_KT = GL_V + 64 * 272, GL_QD = GL_KT + 64 * 144, GL_KI = GL_QD + 64 * 144, GL_END = GL_KI + 64 * 144;
#ifdef GLR_FROM_PROJ
#define GLR_SRC (prow0 + C_GLR), NIN_PAD
#else
#define GLR_SRC ((const bf16_t*)(p.ws + WS_GLRB) + (size_t)bn * 64 * 16), 16
#endif
__device__ __forceinline__ void gla_cumdecay(const Params& p, const Ctx& c, const bf16_t* glr0, int gstride, int h, float (&bcum)[8], float& blast) {
    LAS float* SEGT = (LAS float*)(c.lds + GL_SEGT);
    const int kk = c.tid & 63, w = c.wave;
    float wa[16];
#pragma unroll
    for (int r = 0; r < 16; ++r) wa[r] = p.gla_w_alpha[r * 256 + h * 64 + kk];
    const float ba = p.gla_b_alpha[h * 64 + kk];
    float run = 0.f;
#pragma unroll
    for (int k = 0; k < 8; ++k) { const bf16_t* pr = glr0 + (size_t)(8 * w + k) * gstride;
        const u32x4 g0 = *(const u32x4*)pr, g1 = *(const u32x4*)(pr + 8);
        float z = ba + bflo(g0.x) * wa[0] + bfhi(g0.x) * wa[1] + bflo(g0.y) * wa[2] + bfhi(g0.y) * wa[3] + bflo(g0.z) * wa[4] + bfhi(g0.z) * wa[5] + bflo(g0.w) * wa[6] + bfhi(g0.w) * wa[7]
                     + bflo(g1.x) * wa[8] + bfhi(g1.x) * wa[9] + bflo(g1.y) * wa[10] + bfhi(g1.y) * wa[11] + bflo(g1.z) * wa[12] + bfhi(g1.z) * wa[13] + bflo(g1.w) * wa[14] + bfhi(g1.w) * wa[15];
        const float ls = fminf(z, 0.f) - __logf(1.f + __expf(-fabsf(z)));
        run += ls * (1.f / 16.f); bcum[k] = run; }
    __syncthreads();
    SEGT[w * 64 + kk] = run;
    __syncthreads();
    float off = 0.f, tot = 0.f;
#pragma unroll
    for (int sg = 0; sg < 8; ++sg) { const float v = SEGT[sg * 64 + kk]; off += (sg < w) ? v : 0.f; tot += v; }
#pragma unroll
    for (int k = 0; k < 8; ++k) bcum[k] += off;
    blast = tot;
}
__device__ __forceinline__ void gla_stage_v(const Ctx& c, const bf16_t* prow0, int h) {
#pragma unroll
    for (int k = 0; k < 2; ++k) { const int idx = c.tid + NTHREADS * k, row = idx >> 4, ch = idx & 15;
        *(LAS u32x4*)(c.lds + GL_V + row * 272 + ch * 16) = *(const u32x4*)(prow0 + (size_t)row * NIN_PAD + C_GV + h * 128 + ch * 8); }
}
__device__ __forceinline__ void ph_gla_a(const Params& p, const Ctx& c) {
    LAS unsigned char* L = c.lds; const bf16_t* proj = (const bf16_t*)(p.ws + WS_PROJ);
    float* CKV = (float*)(p.ws + WS_CKV); float* DEC = (float*)(p.ws + WS_DEC);
    const int tid = c.tid, lane = c.lane, w = c.wave, r = lane & 15, qq = lane >> 4, kk = tid & 63;
    for (int item = c.blk; item < 2048; item += c.nblk) {
        const int h = item & 3, bn = item >> 2; const bf16_t* prow0 = proj + (size_t)bn * 64 * NIN_PAD;
        float bcum[8], blast; gla_cumdecay(p, c, GLR_SRC, h, bcum, blast);
        gla_stage_v(c, prow0, h);
        { u32x4 o; float e[8];
#pragma unroll
          for (int k = 0; k < 8; ++k) e[k] = bf2f(prow0[(size_t)(8 * w + k) * NIN_PAD + C_GK + h * 64 + kk]) * __expf(blast - bcum[k]);
          o.x = pk2(e[0], e[1]); o.y = pk2(e[2], e[3]); o.z = pk2(e[4], e[5]); o.w = pk2(e[6], e[7]);
          *(LAS u32x4*)(L + GL_KT + kk * 144 + 16 * w) = o; }
        if (w == 0) DEC[(size_t)item * 64 + kk] = __expf(blast);
        __syncthreads();
        f32x4 acc[4];
#pragma unroll
        for (int n = 0; n < 4; ++n) acc[n] = (f32x4){0.f, 0.f, 0.f, 0.f};
#pragma unroll
        for (int s2 = 0; s2 < 2; ++s2) { LAS const unsigned char* vp = L + GL_V + (32 * s2 + 8 * qq + (r >> 2)) * 272 + (16 * w + 4 * (r & 3)) * 2;
            const s16x4 v0 = lds_tr16(vp), v1 = lds_tr16(vp + 4 * 272); const bf16x8 af = {v0[0], v0[1], v0[2], v0[3], v1[0], v1[1], v1[2], v1[3]};
#pragma unroll
            for (int n = 0; n < 4; ++n) { const bf16x8 bfr = __builtin_bit_cast(bf16x8, *(const LAS u32x4*)(L + GL_KT + (16 * n + r) * 144 + (32 * s2 + 8 * qq) * 2));
                acc[n] = __builtin_amdgcn_mfma_f32_16x16x32_bf16(af, bfr, acc[n], 0, 0, 0); } }
        float* outp = CKV + (size_t)item * 8192 + (16 * w + 4 * qq) * 64 + r;
#pragma unroll
        for (int n = 0; n < 4; ++n)
#pragma unroll
            for (int i = 0; i < 4; ++i) outp[i * 64 + 16 * n] = acc[n][i];
    }
}
__device__ __forceinline__ void ph_gla_b(const Params& p, const Ctx& c) {
    const float* CKV = (const float*)(p.ws + WS_CKV); const float* DEC = (const float*)(p.ws + WS_DEC); bf16_t* SP = (bf16_t*)(p.ws + WS_SPREV);
    for (int idx = c.gtid; idx < 16 * 8192; idx += c.gthreads) { const int bh = idx >> 13, e = idx & 8191, b = bh >> 2, h = bh & 3; float S = 0.f;
        for (int n0 = 0; n0 < 128; n0 += 8) { float cv[8], dv[8];
#pragma unroll
            for (int k = 0; k < 8; ++k) { const size_t item = (size_t)(b * 128 + n0 + k) * 4 + h; cv[k] = CKV[item * 8192 + e]; dv[k] = DEC[item * 64 + (e & 63)]; }
#pragma unroll
            for (int k = 0; k < 8; ++k) { const size_t item = (size_t)(b * 128 + n0 + k) * 4 + h; SP[item * 8192 + e] = (bf16_t)f2bf(S); S = dv[k] * S + cv[k]; } } }
}
__device__ __forceinline__ void ph_gla_c(const Params& p, const Ctx& c) {
    LAS unsigned char* L = c.lds; const bf16_t* proj = (const bf16_t*)(p.ws + WS_PROJ); const bf16_t* SP = (const bf16_t*)(p.ws + WS_SPREV); bf16_t* go = (bf16_t*)(p.ws + WS_GLAO);
    const int tid = c.tid, lane = c.lane, w = c.wave, r = lane & 15, qq = lane >> 4, kk = tid & 63;
    for (int item = c.blk; item < 2048; item += c.nblk) {
        const int h = item & 3, bn = item >> 2; const bf16_t* prow0 = proj + (size_t)bn * 64 * NIN_PAD;
        float bcum[8], blast; gla_cumdecay(p, c, GLR_SRC, h, bcum, blast);
        gla_stage_v(c, prow0, h);
#pragma unroll
        for (int k = 0; k < 8; ++k) { const int i = 8 * w + k; const bf16_t* pr = prow0 + (size_t)i * NIN_PAD;
            const float qv = bf2f(pr[C_GQ + h * 64 + kk]) * 0.125f * __expf(bcum[k]), kv = bf2f(pr[C_GK + h * 64 + kk]) * __expf(-bcum[k]);
            *(LAS bf16_t*)(L + GL_QD + i * 144 + kk * 2) = (bf16_t)f2bf(qv); *(LAS bf16_t*)(L + GL_KI + i * 144 + kk * 2) = (bf16_t)f2bf(kv); }
        __syncthreads();
        const int it = w & 3, vh = w >> 2;
        bf16x8 qf[2];
#pragma unroll
        for (int s2 = 0; s2 < 2; ++s2) qf[s2] = __builtin_bit_cast(bf16x8, *(const LAS u32x4*)(L + GL_QD + (16 * it + r) * 144 + (32 * s2 + 8 * qq) * 2));
        u32x2 pw[4];
#pragma unroll
        for (int jt = 0; jt < 4; ++jt) { f32x4 z = {0.f, 0.f, 0.f, 0.f};
            if (jt <= it) {
#pragma unroll
                for (int s2 = 0; s2 < 2; ++s2) { const bf16x8 kf = __builtin_bit_cast(bf16x8, *(const LAS u32x4*)(L + GL_KI + (16 * jt + r) * 144 + (32 * s2 + 8 * qq) * 2));
                    z = __builtin_amdgcn_mfma_f32_16x16x32_bf16(kf, qf[s2], z, 0, 0, 0); }
#pragma unroll
                for (int ii = 0; ii < 4; ++ii) z[ii] = (16 * jt + 4 * qq + ii <= 16 * it + r) ? z[ii] : 0.f; }
            pw[jt].x = pk2(z[0], z[1]); pw[jt].y = pk2(z[2], z[3]); }
        f32x4 acc[4];
#pragma unroll
        for (int n = 0; n < 4; ++n) acc[n] = (f32x4){0.f, 0.f, 0.f, 0.f};
#pragma unroll
        for (int s2 = 0; s2 < 2; ++s2) { if (2 * s2 <= it) {
            const u32x4 pq = {pw[2 * s2].x, pw[2 * s2].y, pw[2 * s2 + 1].x, pw[2 * s2 + 1].y};
            LAS const unsigned char* vp = L + GL_V + (32 * s2 + 4 * qq + (r >> 2)) * 272 + (64 * vh + 4 * (r & 3)) * 2;
#pragma unroll
            for (int n = 0; n < 4; ++n) { const s16x4 v0 = lds_tr16(vp + 32 * n), v1 = lds_tr16(vp + 32 * n + 16 * 272);
                const bf16x8 vf = {v0[0], v0[1], v0[2], v0[3], v1[0], v1[1], v1[2], v1[3]};
                acc[n] = __builtin_amdgcn_mfma_f32_16x16x32_bf16(__builtin_bit_cast(bf16x8, pq), vf, acc[n], 0, 0, 0); } } }
#pragma unroll
        for (int s2 = 0; s2 < 2; ++s2)
#pragma unroll
            for (int n = 0; n < 4; ++n) { const bf16x8 sf = __builtin_bit_cast(bf16x8, *(const u32x4*)(SP + (size_t)item * 8192 + (64 * vh + 16 * n + r) * 64 + 32 * s2 + 8 * qq));
                acc[n] = __builtin_amdgcn_mfma_f32_16x16x32_bf16(qf[s2], sf, acc[n], 0, 0, 0); }
        bf16_t* outp = go + ((size_t)bn * 64 + 16 * it + 4 * qq) * 512 + h * 128 + 64 * vh + r;
#pragma unroll
        for (int n = 0; n < 4; ++n)
#pragma unroll
            for (int ii = 0; ii < 4; ++ii) outp[ii * 512 + 16 * n] = (bf16_t)f2bf(acc[n][ii]);
    }
}
#ifndef ATT_COMBINE
#define ATT_COMBINE 1
#endif
__device__ __forceinline__ void ph_mix(const Params& p, const Ctx& c) {
    const bf16_t* proj = (const bf16_t*)(p.ws + WS_PROJ); const bf16_t* go = (const bf16_t*)(p.ws + WS_GLAO); bf16_t* mixed = (bf16_t*)(p.ws + WS_ACT);
    for (int m = c.gwave; m < M; m += c.gwaves) {
#pragma unroll
        for (int h = 0; h < 4; ++h) { const int col = h * 128 + 2 * c.lane;
            const unsigned ow = *(const unsigned*)(go + (size_t)m * 512 + col); const float o0 = bflo(ow), o1 = bfhi(ow);
            const float rstd = 1.f / sqrtf(wave_sum(o0 * o0 + o1 * o1) * (1.f / 128.f) + NORM_EPS);
            const unsigned gw = *(const unsigned*)(proj + (size_t)m * NIN_PAD + C_GG + col); const float g0 = bflo(gw), g1 = bfhi(gw);
            const float r0 = o0 * rstd * p.gla_head_gain[col] * (g0 * sigmoidf_(g0)), r1 = o1 * rstd * p.gla_head_gain[col + 1] * (g1 * sigmoidf_(g1));
            *(unsigned*)(mixed + (size_t)m * DM + col) = pk2(r0, r1); }
        if (ATT_COMBINE) {
            const bf16_t* AO = (const bf16_t*)p.out; const float* LSE = (const float*)((const unsigned char*)p.out + 96 * MiB); const int hh = c.lane >> 3;
            const float l0 = LSE[((size_t)0 * M + m) * 8 + hh], l1 = LSE[((size_t)1 * M + m) * 8 + hh], l2 = LSE[((size_t)2 * M + m) * 8 + hh];
            const float lm = fmaxf(l0, fmaxf(l1, l2)), e0 = __expf(l0 - lm), e1 = __expf(l1 - lm), e2 = __expf(l2 - lm), rd = __builtin_amdgcn_rcpf(e0 + e1 + e2);
            const float w0 = e0 * rd, w1 = e1 * rd, w2 = e2 * rd;
            const u32x4 a0 = *((const u32x4*)(AO + ((size_t)0 * M + m) * 512) + c.lane), a1 = *((const u32x4*)(AO + ((size_t)1 * M + m) * 512) + c.lane), a2 = *((const u32x4*)(AO + ((size_t)2 * M + m) * 512) + c.lane);
            u32x4 o;
            o.x = pk2(w0 * bflo(a0.x) + w1 * bflo(a1.x) + w2 * bflo(a2.x), w0 * bfhi(a0.x) + w1 * bfhi(a1.x) + w2 * bfhi(a2.x));
            o.y = pk2(w0 * bflo(a0.y) + w1 * bflo(a1.y) + w2 * bflo(a2.y), w0 * bfhi(a0.y) + w1 * bfhi(a1.y) + w2 * bfhi(a2.y));
            o.z = pk2(w0 * bflo(a0.z) + w1 * bflo(a1.z) + w2 * bflo(a2.z), w0 * bfhi(a0.z) + w1 * bfhi(a1.z) + w2 * bfhi(a2.z));
            o.w = pk2(w0 * bflo(a0.w) + w1 * bflo(a1.w) + w2 * bflo(a2.w), w0 * bfhi(a0.w) + w1 * bfhi(a1.w) + w2 * bfhi(a2.w));
            *((u32x4*)(mixed + (size_t)m * DM + 512) + c.lane) = o; }
    }
}


constexpr int GR_WGT = 0, GR_XC = 65536, GR_A = 81920, GR_U = 115712, GR_SEG = 132608, GR_CW = 136704, GR_GB = 139264;
__device__ __forceinline__ float fast_sigmoid(float x) { return __builtin_amdgcn_rcpf(1.f + __expf(-x)); }
__device__ __forceinline__ void griffin_pass(const Params& p, const Ctx& c) {
    LAS unsigned char* L = c.lds;
    const int tid = c.tid, lane = c.lane, wave = c.wave, g = c.blk & 7;
    const bf16_t* proj = (const bf16_t*)(p.ws + WS_PROJ); bf16_t* yout = (bf16_t*)(p.ws + WS_Y0); bf16_t* ypout = (bf16_t*)((unsigned char*)p.out + 64 * MiB);
    float* AGA = (float*)(p.ws + WS_AGG); float* AGH = AGA + BATCH * 128 * 1024;
    LAS float* A_ = (LAS float*)(L + GR_A); LAS bf16_t* U_ = (LAS bf16_t*)(L + GR_U); LAS float* SEG = (LAS float*)(L + GR_SEG); LAS float* CW = (LAS float*)(L + GR_CW); LAS float* GB = (LAS float*)(L + GR_GB);
    __syncthreads();
    { const bf16_t* wg = (const bf16_t*)(p.ws + WS_WG);
      for (int ch = tid; ch < 4096; ch += NTHREADS) { const int gate = ch >> 11, j = (ch >> 4) & 127, cc = ch & 15;
          const u32x4 v = *(const u32x4*)(wg + ((size_t)(gate * 8 + g) * 128 + j) * 128 + cc * 8);
          *(LAS u32x4*)(L + GR_WGT + gate * 32768 + j * 256 + ((cc ^ (j & 15)) << 4)) = v; }
      if (tid < 128) { const int ch = g * 128 + tid;
#pragma unroll
          for (int jj = 0; jj < 4; ++jj) CW[jj * 128 + tid] = p.c_conv_w[jj * 1024 + ch];
          CW[4 * 128 + tid] = p.c_conv_b[ch]; GB[tid] = p.c_b_rgate[ch]; GB[128 + tid] = p.c_b_igate[ch];
          const float lam = p.c_lambda[ch]; GB[256 + tid] = fmaxf(-lam, 0.f) + log1pf(expf(-fabsf(lam))); } }
    __syncthreads();
    const int nslot = BATCH * 128, sstep = c.nblk >> 3;
    u32x4 xr[5];
#define GR_XLOAD(sl_) do { const int b_ = (sl_) >> 7, t0_ = ((sl_) & 127) * 64; const size_t r0_ = (size_t)b_ * SEQ + t0_; const int co_ = tid & 15, tp_ = tid >> 4; \
        _Pragma("unroll") for (int jj = 0; jj < 5; ++jj) { const int tt = t0_ + 2 * tp_ - 3 + jj; xr[jj] = (u32x4){0u, 0u, 0u, 0u}; \
            if (tt >= 0) xr[jj] = *(const u32x4*)(proj + (r0_ + 2 * tp_ - 3 + jj) * 2048 + 1024 + g * 128 + co_ * 8); } } while (0)
    if ((c.blk >> 3) < nslot) GR_XLOAD(c.blk >> 3);
    for (int slot = c.blk >> 3; slot < nslot; slot += sstep) {
        const int b = slot >> 7, tile = slot & 127, t0 = tile * 64; const size_t row0 = (size_t)b * SEQ + t0;
        u32x4 gpre[2];
        { const int co = tid & 15, tp = tid >> 4;
#pragma unroll
            for (int tl = 0; tl < 2; ++tl) gpre[tl] = *(const u32x4*)(proj + (row0 + 2 * tp + tl) * 2048 + g * 128 + co * 8); }
        { const int co = tid & 15, tp = tid >> 4;
          f32x4 w[5][2];
#pragma unroll
          for (int jj = 0; jj < 5; ++jj) { w[jj][0] = *(const LAS f32x4*)(CW + jj * 128 + co * 8); w[jj][1] = *(const LAS f32x4*)(CW + jj * 128 + co * 8 + 4); }
#pragma unroll
          for (int tl = 0; tl < 2; ++tl) { float a8[8];
#pragma unroll
              for (int e = 0; e < 8; ++e) a8[e] = w[4][e >> 2][e & 3];
#pragma unroll
              for (int jj = 0; jj < 4; ++jj) { const u32x4 xv = xr[tl + jj]; const unsigned xw[4] = {xv.x, xv.y, xv.z, xv.w};
#pragma unroll
                  for (int e = 0; e < 8; ++e) { const float xe = (e & 1) ? bfhi(xw[e >> 1]) : bflo(xw[e >> 1]); a8[e] += w[jj][e >> 2][e & 3] * xe; } }
              const int t = 2 * tp + tl; u32x4 o; o.x = pk2(a8[0], a8[1]); o.y = pk2(a8[2], a8[3]); o.z = pk2(a8[4], a8[5]); o.w = pk2(a8[6], a8[7]);
              *(LAS u32x4*)(L + GR_XC + t * 256 + ((co ^ (t & 15)) << 4)) = o; } }
        if (slot + sstep < nslot) GR_XLOAD(slot + sstep);
        __syncthreads();
        { const int tt = wave & 3, jh = wave >> 2, r = lane & 15, q = lane >> 4, t = 16 * tt + r;
          f32x4 ar[4], ai[4];
#pragma unroll
          for (int n = 0; n < 4; ++n) { ar[n] = (f32x4){0.f, 0.f, 0.f, 0.f}; ai[n] = (f32x4){0.f, 0.f, 0.f, 0.f}; }
#pragma unroll
          for (int s = 0; s < 4; ++s) { const bf16x8 xb = __builtin_bit_cast(bf16x8, *(const LAS u32x4*)(L + GR_XC + t * 256 + (((4 * s + q) ^ (t & 15)) << 4)));
#pragma unroll
              for (int n = 0; n < 4; ++n) { const int j = 64 * jh + 16 * n + r;
                  const bf16x8 wr = __builtin_bit_cast(bf16x8, *(const LAS u32x4*)(L + GR_WGT + j * 256 + (((4 * s + q) ^ (j & 15)) << 4)));
                  const bf16x8 wi = __builtin_bit_cast(bf16x8, *(const LAS u32x4*)(L + GR_WGT + 32768 + j * 256 + (((4 * s + q) ^ (j & 15)) << 4)));
                  ar[n] = __builtin_amdgcn_mfma_f32_16x16x32_bf16(wr, xb, ar[n], 0, 0, 0); ai[n] = __builtin_amdgcn_mfma_f32_16x16x32_bf16(wi, xb, ai[n], 0, 0, 0); } }
#pragma unroll
          for (int n = 0; n < 4; ++n) { const int j0 = 64 * jh + 16 * n + 4 * q;
              const f32x4 br = *(const LAS f32x4*)(GB + j0), bi = *(const LAS f32x4*)(GB + 128 + j0), sp = *(const LAS f32x4*)(GB + 256 + j0);
              const u32x2 xw = *(const LAS u32x2*)(L + GR_XC + t * 256 + ((((j0 >> 3) ^ (t & 15)) << 4) + (j0 & 7) * 2));
              const float xc[4] = {bflo(xw.x), bfhi(xw.x), bflo(xw.y), bfhi(xw.y)};
              f32x4 av; float uv[4];
#pragma unroll
              for (int i = 0; i < 4; ++i) { const float rr = fast_sigmoid(ar[n][i] + br[i]), ii = fast_sigmoid(ai[n][i] + bi[i]);
                  const float a = __expf(-8.f * rr * sp[i]); av[i] = a; uv[i] = __builtin_amdgcn_sqrtf(fmaxf(1.f - a * a, 0.f)) * (ii * xc[i]); }
              *(LAS f32x4*)(A_ + t * 132 + j0) = av; u32x2 uo; uo.x = pk2(uv[0], uv[1]); uo.y = pk2(uv[2], uv[3]); *(LAS u32x2*)(U_ + t * 132 + j0) = uo; } }
        __syncthreads();
        const int j = tid & 127, seg = tid >> 7;
        float hl[16], pl[16];
        { float aa = 1.f, hh = 0.f;
#pragma unroll
          for (int i = 0; i < 16; ++i) { const int t = seg * 16 + i; const float a = A_[t * 132 + j], u = bf2f(U_[t * 132 + j]); hh = a * hh + u; aa *= a; hl[i] = hh; pl[i] = aa; }
          SEG[seg * 128 + j] = aa; SEG[512 + seg * 128 + j] = hh; }
        __syncthreads();
        { float hin = 0.f, pin = 1.f;
          for (int sgi = 0; sgi < seg; ++sgi) { const float sa = SEG[sgi * 128 + j]; hin = sa * hin + SEG[512 + sgi * 128 + j]; pin *= sa; }
#pragma unroll
          for (int i = 0; i < 16; ++i) { const int t = seg * 16 + i; A_[t * 132 + j] = hl[i] + pl[i] * hin; U_[t * 132 + j] = (bf16_t)f2bf(pl[i] * pin); }
          if (seg == 3) { const size_t e = ((size_t)b * 128 + tile) * 1024 + g * 128 + j; AGA[e] = pl[15] * pin; AGH[e] = hl[15] + pl[15] * hin; } }
        __syncthreads();
        { const int co = tid & 15, tp = tid >> 4;
#pragma unroll
          for (int tl = 0; tl < 2; ++tl) { const int t = 2 * tp + tl;
              const f32x4 h0 = *(const LAS f32x4*)(A_ + t * 132 + co * 8), h1 = *(const LAS f32x4*)(A_ + t * 132 + co * 8 + 4);
              const u32x2 pa = *(const LAS u32x2*)(U_ + t * 132 + co * 8), pb = *(const LAS u32x2*)(U_ + t * 132 + co * 8 + 4);
              const u32x4 gw = gpre[tl];
              const float g0 = gelu_tanh(bflo(gw.x)), g1 = gelu_tanh(bfhi(gw.x)), g2 = gelu_tanh(bflo(gw.y)), g3 = gelu_tanh(bfhi(gw.y));
              const float g4 = gelu_tanh(bflo(gw.z)), g5 = gelu_tanh(bfhi(gw.z)), g6 = gelu_tanh(bflo(gw.w)), g7 = gelu_tanh(bfhi(gw.w));
              u32x4 o; o.x = pk2(g0 * h0.x, g1 * h0.y); o.y = pk2(g2 * h0.z, g3 * h0.w); o.z = pk2(g4 * h1.x, g5 * h1.y); o.w = pk2(g6 * h1.z, g7 * h1.w);
              u32x4 q; q.x = pk2(g0 * bflo(pa.x), g1 * bfhi(pa.x)); q.y = pk2(g2 * bflo(pa.y), g3 * bfhi(pa.y)); q.z = pk2(g4 * bflo(pb.x), g5 * bfhi(pb.x)); q.w = pk2(g6 * bflo(pb.y), g7 * bfhi(pb.y));
              *(u32x4*)(yout + (row0 + t) * DM + g * 128 + co * 8) = o; *(u32x4*)(ypout + (row0 + t) * DM + g * 128 + co * 8) = q; } }
    }
#undef GR_XLOAD
}
__device__ __forceinline__ void ph_carry(const Params& p, const Ctx& c) {
    const float* AGA = (const float*)(p.ws + WS_AGG); const float* AGH = AGA + BATCH * 128 * 1024; float* CAR = (float*)(AGH + BATCH * 128 * 1024);
    for (int idx = c.gtid; idx < BATCH * 1024; idx += c.gthreads) { const int b = idx >> 10, ch = idx & 1023; float cy = 0.f;
        for (int t0 = 0; t0 < 128; t0 += 8) { float a[8], h[8];
#pragma unroll
            for (int k = 0; k < 8; ++k) { const size_t e = ((size_t)b * 128 + t0 + k) * 1024 + ch; a[k] = AGA[e]; h[k] = AGH[e]; }
#pragma unroll
            for (int k = 0; k < 8; ++k) { CAR[((size_t)b * 128 + t0 + k) * 1024 + ch] = cy; cy = a[k] * cy + h[k]; } } }
}
__device__ __forceinline__ void ph_gr_fix(const Params& p, const Ctx& c) {
    bf16_t* y = (bf16_t*)(p.ws + WS_ACT); const bf16_t* y0 = (const bf16_t*)(p.ws + WS_Y0); const bf16_t* yp = (const bf16_t*)((const unsigned char*)p.out + 64 * MiB);
    const float* CAR = (const float*)(p.ws + WS_AGG) + 2 * BATCH * 128 * 1024;
#pragma unroll 2
    for (size_t idx = c.gtid; idx < (size_t)M * 128; idx += c.gthreads) { const int cg = (int)(idx & 127); const size_t row = idx >> 7; const int b = (int)(row >> 13), tile = (int)((row & 8191) >> 6);
        const float* cr = CAR + ((size_t)b * 128 + tile) * 1024 + cg * 8; const f32x4 c0 = *(const f32x4*)cr, c1 = *(const f32x4*)(cr + 4);
        const u32x4 a = *(const u32x4*)(y0 + row * DM + cg * 8), q = *(const u32x4*)(yp + row * DM + cg * 8);
        u32x4 o; o.x = pk2(bflo(a.x) + bflo(q.x) * c0.x, bfhi(a.x) + bfhi(q.x) * c0.y); o.y = pk2(bflo(a.y) + bflo(q.y) * c0.z, bfhi(a.y) + bfhi(q.y) * c0.w);
        o.z = pk2(bflo(a.z) + bflo(q.z) * c1.x, bfhi(a.z) + bfhi(q.z) * c1.y); o.w = pk2(bflo(a.w) + bflo(q.w) * c1.z, bfhi(a.w) + bfhi(q.w) * c1.w);
        *(u32x4*)(y + row * DM + cg * 8) = o; }
}
__device__ __forceinline__ void cvt_gate_weights(const Params& p, const Ctx& c) {
    bf16_t* wg = (bf16_t*)(p.ws + WS_WG);
    for (int idx = c.gtid; idx < 2 * 8 * 16 * 128; idx += c.gthreads) { const int j = idx & 127, io = (idx >> 7) & 15, g = (idx >> 11) & 7, gate = idx >> 14;
        const float* s = (gate ? p.c_w_igate : p.c_w_rgate) + (size_t)g * 16384 + (io * 8) * 128 + j;
        u32x4 w; w.x = pk2(s[0], s[128]); w.y = pk2(s[256], s[384]); w.z = pk2(s[512], s[640]); w.w = pk2(s[768], s[896]);
        *(u32x4*)(wg + ((size_t)(gate * 8 + g) * 128 + j) * 128 + io * 8) = w; }
}


constexpr size_t WS_SK = 25 * MiB;
constexpr int TK_SK = 0, TK_Q = 69632, TK_S = 86528, TK_L = 119552  , TK_O = 135936, TK_TAB = 144128;
typedef int i32x4 __attribute__((ext_vector_type(4)));
__device__ __forceinline__ int key_xform(int b) { return b ^ ((b >> 31) & 0x7fffffff); }
#define CEX(a, b) do { const int hi_ = max((a), (b)), lo_ = min((a), (b)); (a) = hi_; (b) = lo_; } while (0)
__device__ __forceinline__ void bitonic_merge16_desc(int (&v)[16]) {
#pragma unroll
    for (int j = 8; j >= 1; j >>= 1)
#pragma unroll
        for (int i = 0; i < 16; ++i) if ((i & j) == 0) CEX(v[i], v[i | j]);
}
__device__ __forceinline__ void bitonic_sort16_desc(int (&v)[16]) {
#pragma unroll
    for (int k = 2; k <= 16; k <<= 1)
#pragma unroll
        for (int j = k >> 1; j >= 1; j >>= 1)
#pragma unroll
            for (int i = 0; i < 16; ++i) { const int l = i ^ j; if (l > i) { if ((i & k) == 0 || k == 16) CEX(v[i], v[l]); else CEX(v[l], v[i]); } }
}
__device__ __forceinline__ void ph_topk(const Params& p, int layer, const Ctx& c) {
    LAS unsigned char* L = c.lds; const bf16_t* Q = (const bf16_t*)(p.ws + WS_PROJ);
    int* ids = (int*)(p.ws + WS_IDS); float* gg = (float*)(p.ws + WS_G);
    const int tid = c.tid, lane = c.lane, w = c.wave, r = lane & 15, qq = lane >> 4, h = c.blk & 7;
    LAS float* S = (LAS float*)(L + TK_S); LAS int* LST = (LAS int*)(L + TK_L); LAS int* OUTK = (LAS int*)(L + TK_O); LAS int* TAB = (LAS int*)(L + TK_TAB);
    __syncthreads();
    { const bf16_t* sk = (const bf16_t*)(p.ws + WS_SK) + ((size_t)layer * 8 + h) * 2 * 128 * 128;
      for (int ch = tid; ch < 4096; ch += NTHREADS) { const int row = ch >> 4, cc = ch & 15;
          *(LAS u32x4*)(L + TK_SK + row * 272 + cc * 16) = *(const u32x4*)(sk + (size_t)row * 128 + cc * 8); }
      if (tid < 64) { int cnt = 0, code = -1;
          for (int i = 0; i < 16; ++i) for (int j = 0; j < 16 / (i + 1); ++j) { if (cnt == tid) code = i * 16 + j; ++cnt; }
          TAB[tid] = code; } }
    const int nslot = M / 32, sstep = c.nblk >> 3;
    u32x4 qpre[2];
#define TK_QLOAD(sl_) do { _Pragma("unroll") for (int k = 0; k < 2; ++k) { const int idx = tid + NTHREADS * k, row = idx >> 5, ch = idx & 31; \
        qpre[k] = *(const u32x4*)(Q + (size_t)(min((sl_), nslot - 1) * 32 + row) * 2048 + h * 256 + ch * 8); } } while (0)
#define TK_MERGE(CTRL) do { int o_[16]; _Pragma("unroll") for (int i = 0; i < 16; ++i) o_[i] = __builtin_amdgcn_update_dpp(0, v[15 - i], (CTRL), 0xf, 0xf, false); \
        _Pragma("unroll") for (int i = 0; i < 16; ++i) v[i] = max(v[i], o_[i]); bitonic_merge16_desc(v); } while (0)
    TK_QLOAD(c.blk >> 3);
    int gfirst = 0, gi = 0;
    for (int slot = c.blk >> 3; slot < nslot; slot += sstep) {
        __syncthreads();
#pragma unroll
        for (int k = 0; k < 2; ++k) { const int idx = tid + NTHREADS * k, row = idx >> 5, ch = idx & 31; *(LAS u32x4*)(L + TK_Q + row * 528 + ch * 16) = qpre[k]; }
        TK_QLOAD(slot + sstep);
        __syncthreads();
        { const int pp = w >> 2, mt = (w >> 1) & 1, nh = w & 1;
          f32x4 acc[4];
#pragma unroll
          for (int nt = 0; nt < 4; ++nt) acc[nt] = (f32x4){0.f, 0.f, 0.f, 0.f};
#pragma unroll
          for (int s2 = 0; s2 < 4; ++s2) { const bf16x8 af = __builtin_bit_cast(bf16x8, *(const LAS u32x4*)(L + TK_Q + (16 * mt + r) * 528 + (pp * 128 + 32 * s2 + 8 * qq) * 2));
#pragma unroll
              for (int nt = 0; nt < 4; ++nt) { const bf16x8 bfr = __builtin_bit_cast(bf16x8, *(const LAS u32x4*)(L + TK_SK + (pp * 128 + 16 * (4 * nh + nt) + r) * 272 + (32 * s2 + 8 * qq) * 2));
                  acc[nt] = __builtin_amdgcn_mfma_f32_16x16x32_bf16(af, bfr, acc[nt], 0, 0, 0); } }
#pragma unroll
          for (int nt = 0; nt < 4; ++nt)
#pragma unroll
              for (int i = 0; i < 4; ++i) S[(pp * 32 + 16 * mt + 4 * qq + i) * 129 + 16 * (4 * nh + nt) + r] = acc[nt][i]; }
        __syncthreads();
        {
          const int m = tid >> 4, sub = tid & 15, pp = sub >> 3, part = sub & 7; int v[16];
#pragma unroll
          for (int k = 0; k < 16; ++k) { const int n = 8 * k + part; v[k] = key_xform((__builtin_bit_cast(int, S[(pp * 32 + m) * 129 + n]) & ~127) | n); }
          bitonic_sort16_desc(v);
          TK_MERGE(0xB1);
          TK_MERGE(0x4E);
          TK_MERGE(0x141);
          if (part == 0) {
#pragma unroll
              for (int k = 0; k < 16; ++k) LST[((gi * 32 + m) * 2 + pp) * 16 + k] = key_xform(v[k]); } }
        if (gi == 0) gfirst = slot;
        ++gi;
        if (gi < 4 && slot + sstep < nslot) continue;
        __syncthreads();
        {
          const int tq = tid >> 2, sub = tid & 3, grp = tq >> 5, m = tq & 31;
          if (grp < gi) {
              const int slot_g = gfirst + grp * sstep;
              LAS const int* L1 = LST + (tq * 2 + 0) * 16; LAS const int* L2 = LST + (tq * 2 + 1) * 16;
              int v[16];
#pragma unroll
              for (int k = 0; k < 16; ++k) { const int ci = sub * 16 + k; const int code = TAB[ci]; int key = (int)0x80000000;
                  if (code >= 0) { const float s1 = __builtin_bit_cast(float, L1[code >> 4] & ~127), s2v = __builtin_bit_cast(float, L2[code & 15] & ~127);
                      key = key_xform((__builtin_bit_cast(int, s1 + s2v) & ~63) | (63 - ci)); }
                  v[k] = key; }
              bitonic_sort16_desc(v);
              TK_MERGE(0xB1); TK_MERGE(0x4E);
              const float smax = __builtin_bit_cast(float, key_xform(v[0]) & ~63);
              if (sub == 0) {
#pragma unroll
                  for (int k4 = 0; k4 < 4; ++k4) *(LAS i32x4*)(OUTK + tq * 16 + 4 * k4) = (i32x4){v[4 * k4], v[4 * k4 + 1], v[4 * k4 + 2], v[4 * k4 + 3]}; }
              asm volatile("s_waitcnt lgkmcnt(0)" ::: "memory");
              const i32x4 mine = *(const LAS i32x4*)(OUTK + tq * 16 + 4 * sub);
              float e[4]; int kb[4];
#pragma unroll
              for (int j = 0; j < 4; ++j) { kb[j] = key_xform(mine[j]); e[j] = __expf(__builtin_bit_cast(float, kb[j] & ~63) - smax); }
              float den = (e[0] + e[1]) + (e[2] + e[3]);
              den += __builtin_bit_cast(float, __builtin_amdgcn_update_dpp(0, __builtin_bit_cast(int, den), 0xB1, 0xf, 0xf, false));
              den += __builtin_bit_cast(float, __builtin_amdgcn_update_dpp(0, __builtin_bit_cast(int, den), 0x4E, 0xf, 0xf, false));
              const float rden = __builtin_amdgcn_rcpf(den); i32x4 oi; f32x4 og;
#pragma unroll
              for (int j = 0; j < 4; ++j) { const int code = TAB[63 - (kb[j] & 63)]; oi[j] = (L1[code >> 4] & 127) * 128 + (L2[code & 15] & 127); og[j] = e[j] * rden; }
              const size_t o = (size_t)(slot_g * 32 + m) * 128 + h * 16 + 4 * sub;
              *(i32x4*)(ids + o) = oi; *(f32x4*)(gg + o) = og; } }
        gi = 0;
    }
#undef TK_QLOAD
#undef TK_MERGE
}


__device__ __forceinline__ float wave_max(float v) {
#pragma unroll
    for (int o = 1; o < 64; o <<= 1) v = fmaxf(v, __shfl_xor(v, o));
    return v;
}
__device__ __forceinline__ void cvt_fp8_rows(const float* src, unsigned char* dst, float* scl, int nrows, const Ctx& c) {
    for (int row = c.gwave; row < nrows; row += c.gwaves) {
        const f32x4* sp = (const f32x4*)(src + (size_t)row * DM) + 4 * c.lane; f32x4 v[4]; float mx = 0.f;
#pragma unroll
        for (int j = 0; j < 4; ++j) { v[j] = sp[j]; mx = fmaxf(mx, fmaxf(fmaxf(fabsf(v[j].x), fabsf(v[j].y)), fmaxf(fabsf(v[j].z), fabsf(v[j].w)))); }
        mx = wave_max(mx);
        const float sc = mx > 0.f ? mx * (1.f / 416.f) : 1.f, inv = 1.f / sc;
        u32x4 w; int t;
        t = __builtin_amdgcn_cvt_pk_fp8_f32(v[0].x * inv, v[0].y * inv, 0, false); t = __builtin_amdgcn_cvt_pk_fp8_f32(v[0].z * inv, v[0].w * inv, t, true); w.x = (unsigned)t;
        t = __builtin_amdgcn_cvt_pk_fp8_f32(v[1].x * inv, v[1].y * inv, 0, false); t = __builtin_amdgcn_cvt_pk_fp8_f32(v[1].z * inv, v[1].w * inv, t, true); w.y = (unsigned)t;
        t = __builtin_amdgcn_cvt_pk_fp8_f32(v[2].x * inv, v[2].y * inv, 0, false); t = __builtin_amdgcn_cvt_pk_fp8_f32(v[2].z * inv, v[2].w * inv, t, true); w.z = (unsigned)t;
        t = __builtin_amdgcn_cvt_pk_fp8_f32(v[3].x * inv, v[3].y * inv, 0, false); t = __builtin_amdgcn_cvt_pk_fp8_f32(v[3].z * inv, v[3].w * inv, t, true); w.w = (unsigned)t;
        *(u32x4*)(dst + (size_t)(c.lane >> 3) * NEXP * 128 + (size_t)row * 128 + (c.lane & 7) * 16) = w;
        if (c.lane == 0) scl[row] = sc;
    }
}
typedef float f32x2 __attribute__((ext_vector_type(2)));
__device__ __forceinline__ u32x2 fp8x4_to_bf16x4(unsigned w) {
    const f32x2 a = __builtin_amdgcn_cvt_pk_f32_fp8((int)w, false), b = __builtin_amdgcn_cvt_pk_f32_fp8((int)w, true);
    u32x2 o;
    asm("v_cvt_pk_bf16_f32 %0, %1, %2" : "=v"(o.x) : "v"(a.x), "v"(a.y));
    asm("v_cvt_pk_bf16_f32 %0, %1, %2" : "=v"(o.y) : "v"(b.x), "v"(b.y));
    return o;
}


constexpr size_t WS_PD = WS_S;
constexpr size_t WS_ACTB = WS_S + 224 * MiB;
struct XI { int xr, nx, jr, nloc; };
typedef long i64_t;
__device__ __forceinline__ i64_t pack64(unsigned lo, unsigned hi) { return (i64_t)(((unsigned long long)hi << 32) | lo); }
typedef int i32x8 __attribute__((ext_vector_type(8)));
#define PIN16(o) asm volatile("" : "+v"(o[0]), "+v"(o[1]), "+v"(o[2]), "+v"(o[3]), "+v"(o[4]), "+v"(o[5]), "+v"(o[6]), "+v"(o[7]), "+v"(o[8]), "+v"(o[9]), "+v"(o[10]), "+v"(o[11]), "+v"(o[12]), "+v"(o[13]), "+v"(o[14]), "+v"(o[15]))

constexpr size_t WS_ACT8 = WS_S + 224 * MiB;
constexpr size_t WS_SA = WS_S + 240 * MiB;
__device__ __forceinline__ void ph_peer_act2(const Params& p, int layer, const Ctx& c) {
    const bf16_t* PDh = (const bf16_t*)(p.ws + WS_PD); unsigned char* A8 = p.ws + WS_ACT8; float* SA = (float*)(p.ws + WS_SA);
    const float* SU = (const float*)(p.ws + WS_SCL) + (size_t)layer * 2 * NEXP; const float* SV = SU + NEXP;
    const int* ids = (const int*)(p.ws + WS_IDS); const float* gg = (const float*)(p.ws + WS_G);
    const int lane = c.lane;
    for (int t0 = c.gwave; t0 < M; t0 += 4 * c.gwaves) {
        float d0[4], d1[4], g0[4], g1[4], su0[4], su1[4], sv0[4], sv1[4]; int id0[4], id1[4];
#pragma unroll
        for (int u = 0; u < 4; ++u) { const int t = min(t0 + u * c.gwaves, M - 1); id0[u] = ids[(size_t)t * 128 + lane]; id1[u] = ids[(size_t)t * 128 + 64 + lane]; g0[u] = gg[(size_t)t * 128 + lane]; g1[u] = gg[(size_t)t * 128 + 64 + lane]; }
#pragma unroll
        for (int u = 0; u < 4; ++u) { const int t = min(t0 + u * c.gwaves, M - 1); d0[u] = 0.f; d1[u] = 0.f;
#pragma unroll
            for (int sl = 0; sl < 8; ++sl) { d0[u] += bf2f(PDh[((size_t)sl * M + t) * 128 + lane]); d1[u] += bf2f(PDh[((size_t)sl * M + t) * 128 + 64 + lane]); } }
#pragma unroll
        for (int u = 0; u < 4; ++u) { su0[u] = SU[id0[u]]; su1[u] = SU[id1[u]]; sv0[u] = SV[id0[u]]; sv1[u] = SV[id1[u]]; }
#pragma unroll
        for (int u = 0; u < 4; ++u) { const int t = t0 + u * c.gwaves; if (t >= M) break;
            const float a0 = gelu_tanh(d0[u] * su0[u]) * g0[u] * sv0[u], a1 = gelu_tanh(d1[u] * su1[u]) * g1[u] * sv1[u];
            const float mx = wave_max(fmaxf(fabsf(a0), fabsf(a1)));
            const float sa = mx > 0.f ? mx * (1.f / 256.f) : 1.f, inv = 1.f / sa;
            const float b0 = a0 * inv, b1 = a1 * inv;
            const int hq = __builtin_amdgcn_cvt_pk_fp8_f32(b0, b1, 0, false);
            const f32x2 hd = __builtin_amdgcn_cvt_pk_f32_fp8(hq, false);
            const int lq = __builtin_amdgcn_cvt_pk_fp8_f32((b0 - hd.x) * 16.f, (b1 - hd.y) * 16.f, 0, false);
            unsigned char* o = A8 + (size_t)t * 256;
            o[lane] = (unsigned char)(hq & 0xff); o[64 + lane] = (unsigned char)((hq >> 8) & 0xff); o[128 + lane] = (unsigned char)(lq & 0xff); o[192 + lane] = (unsigned char)((lq >> 8) & 0xff);
            if (lane == 0) SA[t] = sa; }
    }
}
typedef int i32x2 __attribute__((ext_vector_type(2)));
__device__ __forceinline__ i32x2 lds_tr8(LAS const unsigned char* pb) { return __builtin_amdgcn_ds_read_tr8_b64_v2i32((LAS i32x2*)pb); }
__device__ __forceinline__ void ph_peer_v2(const Params& p, int layer, const Ctx& c, const XI xi, bf16_t* hdst, int idmask) {
    const unsigned char* VT = p.ws + WS_TAB8 + (size_t)layer * 2 * NEXP * DM + (size_t)NEXP * DM;
    const int* ids = (const int*)(p.ws + WS_IDS); const unsigned char* A8 = p.ws + WS_ACT8; const float* SA = (const float*)(p.ws + WS_SA);
    const int lane = c.lane, e8 = lane >> 3, cc = lane & 7, r = lane & 15, q = lane >> 4;
    const int tstep = xi.nloc * NWAVES;
    LAS unsigned char* img = c.lds + c.wave * 16384;
#pragma unroll 1
    for (int sl = xi.xr; sl < 8; sl += xi.nx) {
        const unsigned char* Vs = VT + (size_t)sl * NEXP * 128; const unsigned vo = 16u * (unsigned)cc;
        int t = xi.jr * NWAVES + c.wave;
        if (t >= M) continue;
#define PV_LD(k) (*(const u32x4*)(Vs + (((unsigned)((k) & (idmask & 0xffff)) << 7) + vo)))
#define PV_ROWS(dst, ia, ib) do { dst[0] = PV_LD((ia).x); dst[1] = PV_LD((ia).y); dst[2] = PV_LD((ia).z); dst[3] = PV_LD((ia).w); dst[4] = PV_LD((ib).x); dst[5] = PV_LD((ib).y); dst[6] = PV_LD((ib).z); dst[7] = PV_LD((ib).w); } while (0)
#define PV_IMG(src, half) do { _Pragma("unroll") for (int j = 0; j < 8; ++j) *(LAS u32x4*)(img + (64 * (half) + 8 * e8 + j) * 128 + ((cc ^ j) << 4)) = src[j]; } while (0)
        u32x4 v[8], vn[8];
        { const i32x4* ip = (const i32x4*)(ids + (size_t)t * 128 + 8 * e8); const i32x4 i0 = ip[0], i1 = ip[1], i2 = ip[16], i3 = ip[17]; PV_ROWS(v, i0, i1); PV_ROWS(vn, i2, i3); }
#pragma unroll 1
        for (; t < M; t += tstep) {
            const int tn = min(t + tstep, M - 1);
            const i32x4* ipn = (const i32x4*)(ids + (size_t)tn * 128 + 8 * e8); const i32x4 in0 = ipn[0], in1 = ipn[1], in2 = ipn[16], in3 = ipn[17];
            const u32x4* ap = (const u32x4*)(A8 + (size_t)t * 256 + 32 * q); const u32x4 ah0 = ap[0], ah1 = ap[1], al0 = ap[8], al1 = ap[9];
            const float sa = SA[t];
            const size_t ho = (size_t)t * DM + 128 * sl + 32 * q + ((r & 1) ? 15 + r : r);
            const unsigned hw = *(const unsigned*)(p.hb + ho);
            PV_IMG(v, 0); PV_IMG(vn, 1);
            PV_ROWS(v, in0, in1); PV_ROWS(vn, in2, in3);
            asm volatile("" ::: "memory");
            const i32x8 ahv = {(int)ah0.x, (int)ah0.y, (int)ah0.z, (int)ah0.w, (int)ah1.x, (int)ah1.y, (int)ah1.z, (int)ah1.w};
            const i32x8 alv = {(int)al0.x, (int)al0.y, (int)al0.z, (int)al0.w, (int)al1.x, (int)al1.y, (int)al1.z, (int)al1.w};
            float oa = 0.f, ob = 0.f;
#pragma unroll
            for (int dt = 0; dt < 8; ++dt) {
                i32x8 bw;
#pragma unroll
                for (int i4 = 0; i4 < 4; ++i4) { const int row = 32 * q + 8 * i4 + (r >> 1);
                    const i32x2 tv = lds_tr8(img + row * 128 + ((dt ^ (row & 7)) << 4) + 8 * (r & 1)); bw[2 * i4] = tv.x; bw[2 * i4 + 1] = tv.y; }
                f32x4 ch = {0.f, 0.f, 0.f, 0.f}, cl = {0.f, 0.f, 0.f, 0.f};
                ch = __builtin_amdgcn_mfma_scale_f32_16x16x128_f8f6f4(ahv, bw, ch, 0, 0, 0, 0, 0, 0); cl = __builtin_amdgcn_mfma_scale_f32_16x16x128_f8f6f4(alv, bw, cl, 0, 0, 0, 0, 0, 0);
                const float od = ch[0] + cl[0] * 0.0625f;
                oa = (dt == 2 * q) ? od : oa; ob = (dt == 2 * q + 1) ? od : ob; }
            { const float snd = (r & 1) ? oa : ob, rcv = __shfl_xor(snd, 1);
              const float e0 = (r & 1) ? rcv : oa, e1 = (r & 1) ? ob : rcv;
              *(unsigned*)(hdst + ho) = pk2(bflo(hw) + e0 * sa, bfhi(hw) + e1 * sa); }
            asm volatile("" ::: "memory");
        }
#undef PV_LD
#undef PV_ROWS
#undef PV_IMG
    }
}

__device__ __forceinline__ void ph_peer_u2(const Params& p, int layer, const Ctx& c, const XI xi, int idmask) {
    const unsigned char* X8 = (const unsigned char*)p.out; const unsigned char* UT = p.ws + WS_TAB8 + (size_t)layer * 2 * NEXP * DM;
    const int* ids = (const int*)(p.ws + WS_IDS); bf16_t* PDh = (bf16_t*)(p.ws + WS_PD);
    const int lane = c.lane, e8 = lane >> 3, cc = lane & 7, r = lane & 15, q = lane >> 4;
    const int tstep = xi.nloc * NWAVES;
    LAS unsigned char* img = c.lds + c.wave * 16384; LAS float* stg = (LAS float*)(c.lds + 131072 + c.wave * 512);
#pragma unroll 1
    for (int sl = xi.xr; sl < 8; sl += xi.nx) {
        const unsigned char* Us = UT + (size_t)sl * NEXP * 128; const unsigned uo = 16u * (unsigned)cc;
        int t = xi.jr * NWAVES + c.wave;
        if (t >= M) continue;
#define PU_LD(k) (*(const u32x4*)(Us + (((unsigned)((k) & (idmask & 0xffff)) << 7) + uo)))
#define PU_ROWS(dst, ia, ib) do { dst[0] = PU_LD((ia).x); dst[1] = PU_LD((ia).y); dst[2] = PU_LD((ia).z); dst[3] = PU_LD((ia).w); dst[4] = PU_LD((ib).x); dst[5] = PU_LD((ib).y); dst[6] = PU_LD((ib).z); dst[7] = PU_LD((ib).w); } while (0)
#define PU_IMG(src, half) do { _Pragma("unroll") for (int j = 0; j < 8; ++j) *(LAS u32x4*)(img + (64 * (half) + 8 * e8 + j) * 128 + ((cc ^ j) << 4)) = src[j]; } while (0)
        u32x4 v[8], vn[8];
        { const i32x4* ip = (const i32x4*)(ids + (size_t)t * 128 + 8 * e8); const i32x4 i0 = ip[0], i1 = ip[1], i2 = ip[16], i3 = ip[17]; PU_ROWS(v, i0, i1); PU_ROWS(vn, i2, i3); }
#pragma unroll 1
        for (; t < M; t += tstep) {
            const int tn = min(t + tstep, M - 1);
            const i32x4* ipn = (const i32x4*)(ids + (size_t)tn * 128 + 8 * e8); const i32x4 in0 = ipn[0], in1 = ipn[1], in2 = ipn[16], in3 = ipn[17];
            const u32x4* xp = (const u32x4*)(X8 + (size_t)t * 2048 + 128 * sl + 32 * q); const u32x4 xh0 = xp[0], xh1 = xp[1], xl0 = xp[64], xl1 = xp[65];
            PU_IMG(v, 0); PU_IMG(vn, 1);
            PU_ROWS(v, in0, in1); PU_ROWS(vn, in2, in3);
            asm volatile("" ::: "memory");
            const i32x8 xh = {(int)xh0.x, (int)xh0.y, (int)xh0.z, (int)xh0.w, (int)xh1.x, (int)xh1.y, (int)xh1.z, (int)xh1.w};
            const i32x8 xl = {(int)xl0.x, (int)xl0.y, (int)xl0.z, (int)xl0.w, (int)xl1.x, (int)xl1.y, (int)xl1.z, (int)xl1.w};
#pragma unroll
            for (int g = 0; g < 8; ++g) { const int row = 16 * g + r;
                const u32x4 w0 = *(const LAS u32x4*)(img + row * 128 + (((2 * q) ^ (row & 7)) << 4)), w1 = *(const LAS u32x4*)(img + row * 128 + (((2 * q + 1) ^ (row & 7)) << 4));
                const i32x8 aw = {(int)w0.x, (int)w0.y, (int)w0.z, (int)w0.w, (int)w1.x, (int)w1.y, (int)w1.z, (int)w1.w};
                f32x4 ah = {0.f, 0.f, 0.f, 0.f}, al = {0.f, 0.f, 0.f, 0.f};
                ah = __builtin_amdgcn_mfma_scale_f32_16x16x128_f8f6f4(aw, xh, ah, 0, 0, 0, 0, 0, 0); al = __builtin_amdgcn_mfma_scale_f32_16x16x128_f8f6f4(aw, xl, al, 0, 0, 0, 0, 0, 0);
                if (r == 0) *(LAS f32x4*)(stg + 16 * g + 4 * q) = ah + al * 0.0625f; }
            asm volatile("" ::: "memory");
            { const f32x2 pv = *(const LAS f32x2*)(stg + 2 * lane); *(unsigned*)(PDh + ((size_t)sl * M + t) * 128 + 2 * lane) = pk2(pv.x, pv.y); }
            asm volatile("" ::: "memory");
        }
#undef PU_LD
#undef PU_ROWS
#undef PU_IMG
    }
}

#define XB_TMO      128
#define XB_XCNT(j)  (256  + 64 * (j))
#define XB_XSUB(j)  (1280 + 64 * (j))
#define XB_XGEN(j)  (2304 + 64 * (j))
#define XB_TOP      3328
#define XB_TOPGEN   3392
#define XCD_BAR_WORDS 3456
#define XB_SPIN_CAP (1u << 18)

__device__ __forceinline__ unsigned xb_ld(unsigned* p)              { return __hip_atomic_load(p, __ATOMIC_RELAXED, __HIP_MEMORY_SCOPE_AGENT); }
__device__ __forceinline__ unsigned xb_add(unsigned* p, unsigned v) { return __hip_atomic_fetch_add(p, v, __ATOMIC_RELAXED, __HIP_MEMORY_SCOPE_AGENT); }
__device__ __forceinline__ unsigned xb_xcc_id() { return (unsigned)__builtin_amdgcn_s_getreg((3 << 11) | 20) & 0xFu; }
#define XB_SPIN(cond, bar) do { unsigned _sp = 0; while (cond) { __builtin_amdgcn_s_sleep(1); \
    if ((++_sp & 255u) == 0u) { if (xb_ld(&(bar)[XB_TMO])) break; if (_sp > XB_SPIN_CAP) { atomicAdd(&(bar)[XB_TMO], 1u); break; } } } } while (0)

struct XcdBarrier {
    unsigned* bar; unsigned x;
    volatile LAS unsigned* st;
};

__device__ __forceinline__ XcdBarrier xcd_barrier_post(unsigned* bar, volatile LAS unsigned* st) {
    XcdBarrier b; b.bar = bar; b.x = xb_xcc_id(); b.st = st;
    if (threadIdx.x == 0) (void)xb_add(&bar[XB_XCNT(b.x)], 1u);
    return b;
}
__device__ __forceinline__ void xcd_barrier_complete(unsigned* bar, unsigned x, unsigned& nloc, unsigned& nx) {
    const unsigned G = gridDim.x * gridDim.y * gridDim.z;
    unsigned sum, cnt, mine, sp = 0u;
    for (;;) {
        sum = 0u; cnt = 0u; mine = 0u;
#pragma unroll
        for (unsigned j = 0; j < 16; ++j) { const unsigned c = xb_ld(&bar[XB_XCNT(j)]); sum += c; cnt += (c > 0u) ? 1u : 0u; mine = (j == x) ? c : mine; }
        if (sum == G) break;
        __builtin_amdgcn_s_sleep(1);
        if ((++sp & 255u) == 0u) { if (xb_ld(&bar[XB_TMO])) break; if (sp > XB_SPIN_CAP) { atomicAdd(&bar[XB_TMO], 1u); break; } }
    }
    nloc = mine > 0u ? mine : 1u; nx = cnt > 0u ? cnt : 1u;
}

__device__ __forceinline__ void xcd_barrier(const XcdBarrier& b) {
    asm volatile("s_waitcnt vmcnt(0)" ::: "memory");
    __syncthreads();
    if (threadIdx.x == 0) {
        unsigned* bar = b.bar;
        __builtin_amdgcn_s_waitcnt(0);
        unsigned nloc = b.st[0], nx = b.st[1];
        if (nloc == 0u) { xcd_barrier_complete(bar, b.x, nloc, nx); b.st[0] = nloc; b.st[1] = nx; }
        const unsigned old = xb_add(&bar[XB_XSUB(b.x)], 1u);
        const unsigned gen = old / nloc;
        if (old + 1u == (gen + 1u) * nloc) {
            __builtin_amdgcn_fence(__ATOMIC_RELEASE, "agent");
            asm volatile("s_waitcnt vmcnt(0)" ::: "memory");
            const unsigned og = xb_add(&bar[XB_TOP], 1u);
            const unsigned tg = og / nx;
            if (og + 1u == (tg + 1u) * nx) xb_add(&bar[XB_TOPGEN], 1u);
            else XB_SPIN(xb_ld(&bar[XB_TOPGEN]) == tg, bar);
            __builtin_amdgcn_fence(__ATOMIC_ACQUIRE, "agent");
            xb_add(&bar[XB_XGEN(b.x)], 1u);
            asm volatile("s_waitcnt vmcnt(0)" ::: "memory");
        } else {
            XB_SPIN(xb_ld(&bar[XB_XGEN(b.x)]) == gen, bar);
            __builtin_amdgcn_fence(__ATOMIC_ACQUIRE, "agent");
            asm volatile("s_waitcnt vmcnt(0)" ::: "memory");
        }
    }
    __syncthreads();
}

enum Phase { PH_PRO = 0, PH_GEMM_IN0, PH_MIXER0, PH_GLA_B, PH_GLA_C, PH_MIX0, PH_GEMM_OUT0, PH_NORM_F0, PH_GEMM_Q0, PH_TOPK1_0, PH_PU0, PH_PA0, PH_PV0,
             PH_NORM_M1, PH_GEMM_CIN, PH_G1, PH_G2, PH_G3, PH_GEMM_OUT1, PH_NORM_F1, PH_GEMM_Q1, PH_TOPK1_1, PH_PU1, PH_PA1, PH_PV1, PH_FINAL, NPHASES };

#ifndef PH_ONLY
#define PH_ONLY (-1)
#endif
#define PH_ENABLED(x) (PH_ONLY < 0 || PH_ONLY == (x))
#ifndef MK_N_LAUNCHES
#define MK_N_LAUNCHES 1
#endif

template <class Epi> __device__ __forceinline__ void run_gemm(const Ctx& c, const bf16_t* A, const bf16_t* Bt, int N, const Epi& E, int vblk) {
    pg8::Gemm g{A, Bt, M, N, DM}; pg8::StaticOrder S; S.init(M, N, c.nblk, vblk);
    pg8::gemm_phase<Epi, pg8::StaticOrder, true, true>(c.lds, g, S, E);
}

#define GATHER_CALL(l) ph_gather3(p, l, c, (rep_ + 1 < NREP(PH_GATHER##l)) ? (float*)(ws + WS_S) : p.out)
#ifndef PROBE_IDMASK
#define PROBE_IDMASK 0x3fff
#endif
#ifndef DUP_MASK
#define DUP_MASK 0u
#endif
#define NREP(k) ((((unsigned)(DUP_MASK) >> (k)) & 1u) ? 2 : 1)
#define GETXI() XI xi; { if (multi) { if (threadIdx.x == 0) { unsigned xr_ = 0; for (unsigned j_ = 0; j_ < bar.x; ++j_) xr_ += xb_ld(&ctl[CW_BAR + XB_XCNT(j_)]) > 0u ? 1u : 0u; MISC[11] = xr_; } __syncthreads(); \
    xi.nloc = (int)MISC[8]; xi.nx = (int)MISC[9]; xi.jr = (int)MISC[10]; xi.xr = (int)MISC[11]; if (xi.nloc < 1 || xi.nx < 1 || xi.nx > 8 || xi.jr >= xi.nloc || xi.xr >= xi.nx) { xi.xr = 0; xi.nx = 1; xi.jr = blockIdx.x; xi.nloc = gridDim.x; } } \
    else { xi.xr = 0; xi.nx = 1; xi.jr = blockIdx.x; xi.nloc = gridDim.x; } }
#define MKCTX() Ctx c; { int t_ = threadIdx.x; asm volatile("" : "+v"(t_)); c.lds = lds; c.tid = t_; c.lane = t_ & 63; c.wave = __builtin_amdgcn_readfirstlane(t_ >> 6); \
    c.blk = blockIdx.x; c.nblk = gridDim.x; c.gtid = c.blk * NTHREADS + c.tid; c.gthreads = c.nblk * NTHREADS; c.gwave = c.blk * NWAVES + c.wave; c.gwaves = c.nblk * NWAVES; }
__global__ void __launch_bounds__(NTHREADS, 2) mega_fwd(Params p) {
    extern __shared__ __attribute__((aligned(16))) unsigned char lds_raw[];
    volatile LAS unsigned* MISC = (volatile LAS unsigned*)((LAS unsigned char*)lds_raw + MISC_OFF);
    LAS unsigned char* const lds = (LAS unsigned char*)lds_raw;
    for (int u = threadIdx.x; u < (LDS_BYTES - LDSCTL_OFF) / 4; u += NTHREADS) ((LAS unsigned*)(lds + LDSCTL_OFF))[u] = 0u;
    __syncthreads();
    unsigned* ctl = (unsigned*)(p.ws + WS_CTL);
    XcdBarrier bar; bar.bar = ctl + CW_BAR; bar.x = 0; bar.st = nullptr;
    const bool multi = (p.ph_hi - p.ph_lo) > 1;
    if (multi) { bar = xcd_barrier_post(ctl + CW_BAR, MISC + 8); if (threadIdx.x == 0) MISC[10] = xb_add(&ctl[CW_RANK + 64 * bar.x], 1u); }
    unsigned char* ws = p.ws;
    bf16_t* ACT = (bf16_t*)(ws + WS_ACT); bf16_t* PROJ = (bf16_t*)(ws + WS_PROJ);

    const int lo = p.ph_lo, hi = p.ph_hi;
#define IN(k) (PH_ENABLED(k) && lo <= (k) && (k) < hi)
#define SEAM(k) do { if ((k) + 1 < hi) xcd_barrier(bar); } while (0)
    if (IN(PH_PRO)) { for (int rep_ = 0; rep_ < NREP(PH_PRO); ++rep_) { MKCTX();
        transpose_cvt(p.ab_w_in, DM, NIN, (bf16_t*)(ws + WS_WT_IN), NIN_PAD, [](int n) { return n < 1536 ? n : (n < 3072 ? n + 16 : (n < 3088 ? n - 3072 + 1536 : -1)); }, c.gtid, c.gthreads);
        transpose_cvt(p.ab_w_out, DM, DM, (bf16_t*)(ws + WS_WT_OUT), DM, [](int n) { return n; }, c.gtid, c.gthreads);
        transpose_cvt(p.c_w_in, DM, 2048, (bf16_t*)(ws + WS_WT_CIN), 2048, [](int n) { return n; }, c.gtid, c.gthreads);
        transpose_cvt(p.c_w_out, DM, DM, (bf16_t*)(ws + WS_WT_COUT), DM, [](int n) { return n; }, c.gtid, c.gthreads);
        transpose_cvt(p.peer_w_query, DM, 2048, (bf16_t*)(ws + WS_WT_Q0), 2048, [](int n) { return n; }, c.gtid, c.gthreads);
        transpose_cvt(p.peer_w_query + (size_t)DM * 2048, DM, 2048, (bf16_t*)(ws + WS_WT_Q1), 2048, [](int n) { return n; }, c.gtid, c.gthreads);
        cvt_fp8_rows(p.peer_u, ws + WS_TAB8, (float*)(ws + WS_SCL), NEXP, c);
        cvt_fp8_rows(p.peer_v, ws + WS_TAB8 + (size_t)NEXP * DM, (float*)(ws + WS_SCL) + NEXP, NEXP, c);
        cvt_gate_weights(p, c);
        cvt_bf16(p.peer_sub_keys, (bf16_t*)(ws + WS_SK), (size_t)2 * 8 * 2 * 128 * 128 / 8, c.gtid, c.gthreads);
        norm_rows_bf16(p.x, p.mix_norm, ACT, c);
        if (rep_ + 1 < NREP(PH_PRO)) xcd_barrier(bar); } SEAM(PH_PRO); }
    if (IN(PH_GEMM_IN0)) { for (int rep_ = 0; rep_ < NREP(PH_GEMM_IN0); ++rep_) { MKCTX();  ph_glr(p, c); pg8::EpiBf16<0> E{PROJ, NIN_PAD, nullptr, 0, 0, 1.f}; GETXI(); run_gemm(c, ACT, (const bf16_t*)(ws + WS_WT_IN), 3072, E, (xi.nx == 8 && xi.nloc * 8 == (int)gridDim.x) ? xi.jr * 8 + xi.xr : (int)blockIdx.x); if (rep_ + 1 < NREP(PH_GEMM_IN0)) xcd_barrier(bar); } SEAM(PH_GEMM_IN0); }
    if (IN(PH_MIXER0)) { for (int rep_ = 0; rep_ < NREP(PH_MIXER0); ++rep_) { MKCTX();  ph_gla_a(p, c); ph_attn(p, c); if (rep_ + 1 < NREP(PH_MIXER0)) xcd_barrier(bar); } SEAM(PH_MIXER0); }
    if (IN(PH_GLA_B)) { for (int rep_ = 0; rep_ < NREP(PH_GLA_B); ++rep_) { MKCTX();  ph_gla_b(p, c); if (rep_ + 1 < NREP(PH_GLA_B)) xcd_barrier(bar); } SEAM(PH_GLA_B); }
    if (IN(PH_GLA_C)) { for (int rep_ = 0; rep_ < NREP(PH_GLA_C); ++rep_) { MKCTX();  ph_gla_c(p, c); if (rep_ + 1 < NREP(PH_GLA_C)) xcd_barrier(bar); } SEAM(PH_GLA_C); }
    if (IN(PH_MIX0)) { for (int rep_ = 0; rep_ < NREP(PH_MIX0); ++rep_) { MKCTX();  ph_mix(p, c); if (rep_ + 1 < NREP(PH_MIX0)) xcd_barrier(bar); } SEAM(PH_MIX0); }
    if (IN(PH_GEMM_OUT0)) { for (int rep_ = 0; rep_ < NREP(PH_GEMM_OUT0); ++rep_) { MKCTX();  pg8::EpiResBf<true> E{p.x, p.hb, DM}; GETXI(); run_gemm(c, ACT, (const bf16_t*)(ws + WS_WT_OUT), DM, E, (xi.nx == 8 && xi.nloc * 8 == (int)gridDim.x) ? xi.jr * 8 + xi.xr : (int)blockIdx.x); if (rep_ + 1 < NREP(PH_GEMM_OUT0)) xcd_barrier(bar); } SEAM(PH_GEMM_OUT0); }
    if (IN(PH_NORM_F0)) { for (int rep_ = 0; rep_ < NREP(PH_NORM_F0); ++rep_) { MKCTX();  norm_rows_bf16(p.hb, p.ffn_norm, ACT, c, (unsigned char*)p.out); if (rep_ + 1 < NREP(PH_NORM_F0)) xcd_barrier(bar); } SEAM(PH_NORM_F0); }
    if (IN(PH_GEMM_Q0)) { for (int rep_ = 0; rep_ < NREP(PH_GEMM_Q0); ++rep_) { MKCTX();  pg8::EpiBf16<0> E{PROJ, 2048, nullptr, 0, 0, 1.f}; GETXI(); run_gemm(c, ACT, (const bf16_t*)(ws + WS_WT_Q0), 2048, E, (xi.nx == 8 && xi.nloc * 8 == (int)gridDim.x) ? xi.jr * 8 + xi.xr : (int)blockIdx.x); if (rep_ + 1 < NREP(PH_GEMM_Q0)) xcd_barrier(bar); } SEAM(PH_GEMM_Q0); }
    if (IN(PH_TOPK1_0)) { for (int rep_ = 0; rep_ < NREP(PH_TOPK1_0); ++rep_) { MKCTX();  ph_topk(p, 0, c); if (rep_ + 1 < NREP(PH_TOPK1_0)) xcd_barrier(bar); } SEAM(PH_TOPK1_0); }
    if (IN(PH_PU0)) { for (int rep_ = 0; rep_ < NREP(PH_PU0); ++rep_) { MKCTX();  GETXI(); ph_peer_u2(p, 0, c, xi, (rep_ + 1 < NREP(PH_PU0)) ? PROBE_IDMASK : 0x3fff); if (rep_ + 1 < NREP(PH_PU0)) xcd_barrier(bar); } SEAM(PH_PU0); }
    if (IN(PH_PA0)) { for (int rep_ = 0; rep_ < NREP(PH_PA0); ++rep_) { MKCTX();  ph_peer_act2(p, 0, c); if (rep_ + 1 < NREP(PH_PA0)) xcd_barrier(bar); } SEAM(PH_PA0); }
    if (IN(PH_PV0)) { for (int rep_ = 0; rep_ < NREP(PH_PV0); ++rep_) { MKCTX();  GETXI(); ph_peer_v2(p, 0, c, xi, (rep_ + 1 < NREP(PH_PV0)) ? (bf16_t*)(ws + WS_S) : p.hb, (rep_ + 1 < NREP(PH_PV0)) ? PROBE_IDMASK : 0x3fff); if (rep_ + 1 < NREP(PH_PV0)) xcd_barrier(bar); } SEAM(PH_PV0); }
    if (IN(PH_NORM_M1)) { for (int rep_ = 0; rep_ < NREP(PH_NORM_M1); ++rep_) { MKCTX();  norm_rows_bf16(p.hb, p.mix_norm + DM, ACT, c); if (rep_ + 1 < NREP(PH_NORM_M1)) xcd_barrier(bar); } SEAM(PH_NORM_M1); }
    if (IN(PH_GEMM_CIN)) { for (int rep_ = 0; rep_ < NREP(PH_GEMM_CIN); ++rep_) { MKCTX();  pg8::EpiBf16<0> E{PROJ, 2048, nullptr, 0, 0, 1.f}; GETXI(); run_gemm(c, ACT, (const bf16_t*)(ws + WS_WT_CIN), 2048, E, (xi.nx == 8 && xi.nloc * 8 == (int)gridDim.x) ? xi.jr * 8 + xi.xr : (int)blockIdx.x); if (rep_ + 1 < NREP(PH_GEMM_CIN)) xcd_barrier(bar); } SEAM(PH_GEMM_CIN); }
    if (IN(PH_G1)) { for (int rep_ = 0; rep_ < NREP(PH_G1); ++rep_) { MKCTX();  griffin_pass(p, c); if (rep_ + 1 < NREP(PH_G1)) xcd_barrier(bar); } SEAM(PH_G1); }
    if (IN(PH_G2)) { for (int rep_ = 0; rep_ < NREP(PH_G2); ++rep_) { MKCTX();  ph_carry(p, c); if (rep_ + 1 < NREP(PH_G2)) xcd_barrier(bar); } SEAM(PH_G2); }
    if (IN(PH_G3)) { for (int rep_ = 0; rep_ < NREP(PH_G3); ++rep_) { MKCTX();  ph_gr_fix(p, c); if (rep_ + 1 < NREP(PH_G3)) xcd_barrier(bar); } SEAM(PH_G3); }
    if (IN(PH_GEMM_OUT1)) { for (int rep_ = 0; rep_ < NREP(PH_GEMM_OUT1); ++rep_) { MKCTX();  pg8::EpiResBf<false> E{p.hb, p.hb, DM}; GETXI(); run_gemm(c, ACT, (const bf16_t*)(ws + WS_WT_COUT), DM, E, (xi.nx == 8 && xi.nloc * 8 == (int)gridDim.x) ? xi.jr * 8 + xi.xr : (int)blockIdx.x); if (rep_ + 1 < NREP(PH_GEMM_OUT1)) xcd_barrier(bar); } SEAM(PH_GEMM_OUT1); }
    if (IN(PH_NORM_F1)) { for (int rep_ = 0; rep_ < NREP(PH_NORM_F1); ++rep_) { MKCTX();
        norm_rows_bf16(p.hb, p.ffn_norm + DM, ACT, c, (unsigned char*)p.out);
        cvt_fp8_rows(p.peer_u + (size_t)NEXP * DM, ws + WS_TAB8 + (size_t)2 * NEXP * DM, (float*)(ws + WS_SCL) + 2 * NEXP, NEXP, c);
        cvt_fp8_rows(p.peer_v + (size_t)NEXP * DM, ws + WS_TAB8 + (size_t)3 * NEXP * DM, (float*)(ws + WS_SCL) + 3 * NEXP, NEXP, c);
        if (rep_ + 1 < NREP(PH_NORM_F1)) xcd_barrier(bar); } SEAM(PH_NORM_F1); }
    if (IN(PH_GEMM_Q1)) { for (int rep_ = 0; rep_ < NREP(PH_GEMM_Q1); ++rep_) { MKCTX();  pg8::EpiBf16<0> E{PROJ, 2048, nullptr, 0, 0, 1.f}; GETXI(); run_gemm(c, ACT, (const bf16_t*)(ws + WS_WT_Q1), 2048, E, (xi.nx == 8 && xi.nloc * 8 == (int)gridDim.x) ? xi.jr * 8 + xi.xr : (int)blockIdx.x); if (rep_ + 1 < NREP(PH_GEMM_Q1)) xcd_barrier(bar); } SEAM(PH_GEMM_Q1); }
    if (IN(PH_TOPK1_1)) { for (int rep_ = 0; rep_ < NREP(PH_TOPK1_1); ++rep_) { MKCTX();  ph_topk(p, 1, c); if (rep_ + 1 < NREP(PH_TOPK1_1)) xcd_barrier(bar); } SEAM(PH_TOPK1_1); }
    if (IN(PH_PU1)) { for (int rep_ = 0; rep_ < NREP(PH_PU1); ++rep_) { MKCTX();  GETXI(); ph_peer_u2(p, 1, c, xi, (rep_ + 1 < NREP(PH_PU1)) ? PROBE_IDMASK : 0x3fff); if (rep_ + 1 < NREP(PH_PU1)) xcd_barrier(bar); } SEAM(PH_PU1); }
    if (IN(PH_PA1)) { for (int rep_ = 0; rep_ < NREP(PH_PA1); ++rep_) { MKCTX();  ph_peer_act2(p, 1, c); if (rep_ + 1 < NREP(PH_PA1)) xcd_barrier(bar); } SEAM(PH_PA1); }
    if (IN(PH_PV1)) { for (int rep_ = 0; rep_ < NREP(PH_PV1); ++rep_) { MKCTX();  GETXI(); ph_peer_v2(p, 1, c, xi, (rep_ + 1 < NREP(PH_PV1)) ? (bf16_t*)(ws + WS_S) : p.hb, (rep_ + 1 < NREP(PH_PV1)) ? PROBE_IDMASK : 0x3fff); if (rep_ + 1 < NREP(PH_PV1)) xcd_barrier(bar); } SEAM(PH_PV1); }
    if (IN(PH_FINAL)) { MKCTX(); norm_rows_f32(p.hb, p.out, p.final_norm, c); }
#undef IN
#undef SEAM
}

extern "C" void kernel_launch(void* const* d_in, const int* in_sizes, int n_in, void* d_out, int out_size, void* d_ws, size_t ws_size, hipStream_t stream) {
    static int grid = 0;
    if (grid == 0) {
        if (n_in != 22 || out_size != M * DM || ws_size < WS_END) { fprintf(stderr, "kernel_launch: unexpected shapes: n_in %d out %d ws %zu (need %zu)\n", n_in, out_size, ws_size, (size_t)WS_END); grid = -1; return; }
        int dev = 0, cus = 0, per_cu = 0;
        if (hipGetDevice(&dev) != hipSuccess || hipDeviceGetAttribute(&cus, hipDeviceAttributeMultiprocessorCount, dev) != hipSuccess) { grid = -1; return; }
        if (hipFuncSetAttribute((const void*)mega_fwd, hipFuncAttributeMaxDynamicSharedMemorySize, LDS_BYTES) != hipSuccess) { fprintf(stderr, "kernel_launch: hipFuncSetAttribute failed\n"); grid = -1; return; }
        if (hipOccupancyMaxActiveBlocksPerMultiprocessor(&per_cu, (const void*)mega_fwd, NTHREADS, LDS_BYTES) != hipSuccess || per_cu < 1) { fprintf(stderr, "kernel_launch: occupancy query says %d blocks per CU\n", per_cu); per_cu = 1; }
        (void)hipGetLastError();
        grid = cus;
        if (grid % 8 != 0 || grid < 32) { fprintf(stderr, "kernel_launch: unexpected CU count %d\n", cus); }
    }
    if (grid < 0) return;
    (void)hipMemsetAsync((char*)d_ws + WS_CTL, 0, CTL_ZERO_BYTES, stream);
    Params p{};
    const float** pp = (const float**)&p;
    for (int i = 0; i < 22; ++i) pp[i] = (const float*)d_in[i];
    p.out = (float*)d_out; p.ws = (unsigned char*)d_ws; p.hb = (bf16_t*)((unsigned char*)d_ws + WS_HB);
#if MK_N_LAUNCHES == 1
    p.ph_lo = 0; p.ph_hi = NPHASES;
    void* args[] = {&p};
    hipError_t e = hipLaunchCooperativeKernel((const void*)mega_fwd, dim3(grid), dim3(NTHREADS), args, LDS_BYTES, stream);
    if (e != hipSuccess) fprintf(stderr, "cooperative launch failed: %s (grid %d)\n", hipGetErrorString(e), grid);
#else
    for (int ph = 0; ph < NPHASES; ++ph) { p.ph_lo = ph; p.ph_hi = ph + 1; hipLaunchKernelGGL(mega_fwd, dim3(grid), dim3(NTHREADS), LDS_BYTES, stream, p); }
#endif
}
```

```cpp
#include <hip/hip_runtime.h>
#include <hip/hip_bf16.h>
#include <cstdio>
#include <cstdint>
#include <cmath>
namespace pg8 {
#define PG8_LAS __attribute__((address_space(3)))
typedef unsigned short bf16_t;
typedef short bf16x8 __attribute__((ext_vector_type(8)));
typedef float f32x4 __attribute__((ext_vector_type(4)));
typedef unsigned u32x4 __attribute__((ext_vector_type(4)));
constexpr int BM = 256, BK = 64, HALF = 128, HTB = HALF * BK * 2  , STAGE_BYTES = 8 * HTB, NXCD = 8, WGM = 8;

__host__ __device__ __forceinline__ int lds_byte(int r, int c) { const int st = (r >> 4) * 2 + (c >> 5), rr = r & 15, cc = c & 31, ob = rr * 64 + cc * 2; return st * 1024 + (ob ^ (((ob >> 9) & 1) << 5)); }
__host__ __device__ __forceinline__ void stage_rc(int b, int& R, int& C) { const int st = b / 1024, sb = b % 1024, swz = sb ^ (((sb >> 9) & 1) << 5); R = (st >> 1) * 16 + swz / 64; C = (st & 1) * 32 + (swz % 64) / 2; }
__host__ __device__ __forceinline__ int perm32(int rho) { const int n = rho >> 4, i = rho & 15; return 8 * (i >> 2) + 4 * n + (i & 3); }

struct Unit { int pm, pn; };
struct Gemm { const bf16_t* A; const bf16_t* Bt; int M, N, K; };

struct StaticOrder {
    int nM, nN, nwg, G, c;
    __host__ __device__ void init(int M, int N, int G_, int c_) { nM = M / BM; nN = N / BM; nwg = nM * nN; G = G_; c = c_; }
    __host__ __device__ bool next(int i, Unit& u) const {
        const long L = (long)i * G + c; if (L >= nwg) return false;
        int wgid = (int)L; { const int q = nwg / NXCD, r = nwg % NXCD, xcd = wgid % NXCD, off = wgid / NXCD; wgid = (xcd < r ? xcd * (q + 1) : r * (q + 1) + (xcd - r) * q) + off; }
        const int nig = WGM * nN, gid = wgid / nig, fm = gid * WGM, gsz = (nM - fm) < WGM ? (nM - fm) : WGM;
        u.pm = fm + ((wgid % nig) % gsz); u.pn = (wgid % nig) / gsz; return true;
    }
    __device__ __forceinline__ void a_ready(const Unit&) const {}
    __device__ __forceinline__ void done(const Unit&) const {}
};

__device__ __forceinline__ unsigned cvt_pk_bf16(float lo, float hi) { unsigned r; asm volatile("v_cvt_pk_bf16_f32 %0, %1, %2" : "=v"(r) : "v"(lo), "v"(hi)); return r; }
typedef float f32x2 __attribute__((ext_vector_type(2)));
__device__ __forceinline__ f32x2 gelu_pk(f32x2 v) {
    const f32x2 av = __builtin_elementwise_abs(v), d = av * 0.2316418882f + 1.0f;
    f32x2 t; t.x = __builtin_amdgcn_rcpf(d.x); t.y = __builtin_amdgcn_rcpf(d.y);
    f32x2 q = t * 0.5307027145f + (-0.7265760135f); q = q * t + 0.7107068705f; q = q * t + (-0.142248368f); q = q * t + 0.127414796f; q = q * t;
    const f32x2 s = (v * v) * (-0.72134752044f);
    f32x2 e; e.x = __builtin_amdgcn_exp2f(s.x); e.y = __builtin_amdgcn_exp2f(s.y);
    const f32x2 m = v * (q * e), r = v - m;
    f32x2 o; o.x = v.x < 0.f ? m.x : r.x; o.y = v.y < 0.f ? m.y : r.y; return o;
}
template <int ACT  > struct EpiBf16 {
    static constexpr bool PERM = true, AFTER_DRAIN = false; static_assert(ACT == 0 || ACT == 1, "EpiBf16: ACT is 0 (none) or 1 (gelu_pk)");
    bf16_t* O; int ldc; const float* bias; int split_cols; size_t split_stride; float scale0;
    __device__ __forceinline__ void operator()(const f32x4 (&acc)[2][2][4][2], const Unit& u, int wr, int wc, int fr, int fq) const {
        const int row0 = u.pm * BM + wr * 64 + fr; int colt = u.pn * BM; bf16_t* base = O;
        float sc = 1.f; if (split_cols) { const int t = colt / split_cols; base += (size_t)t * split_stride; colt -= t * split_cols; if (t == 0) sc = scale0; }
        const int col0 = colt + wc * 32 + 8 * fq, bcol0 = u.pn * BM + wc * 32 + 8 * fq;
        f32x4 bv[2][2];
#pragma unroll
        for (int bj = 0; bj < 2; ++bj)
#pragma unroll
            for (int n = 0; n < 2; ++n) bv[bj][n] = bias ? *(const f32x4*)(bias + bcol0 + bj * HALF + 4 * n) : (f32x4){0.f, 0.f, 0.f, 0.f};
#pragma unroll
        for (int ai = 0; ai < 2; ++ai)
#pragma unroll
            for (int m = 0; m < 4; ++m) { bf16_t* rowp = base + (size_t)(row0 + ai * HALF + m * 16) * ldc + col0;
#pragma unroll
                for (int bj = 0; bj < 2; ++bj) { f32x4 v0 = acc[ai][bj][m][0] + bv[bj][0], v1 = acc[ai][bj][m][1] + bv[bj][1];
                    if (ACT == 1) { f32x2 a = gelu_pk((f32x2){v0[0], v0[1]}), b = gelu_pk((f32x2){v0[2], v0[3]}), c = gelu_pk((f32x2){v1[0], v1[1]}), d = gelu_pk((f32x2){v1[2], v1[3]});
                        v0 = (f32x4){a.x, a.y, b.x, b.y}; v1 = (f32x4){c.x, c.y, d.x, d.y}; }
                    v0 = v0 * sc; v1 = v1 * sc; u32x4 w; w.x = cvt_pk_bf16(v0[0], v0[1]); w.y = cvt_pk_bf16(v0[2], v0[3]); w.z = cvt_pk_bf16(v1[0], v1[1]); w.w = cvt_pk_bf16(v1[2], v1[3]);
                    *(u32x4*)(rowp + bj * HALF) = w; } }
    }
};
template <class Epi, class Sched, bool ALIGN_EPI = false, bool SP2 = false>
__device__ __forceinline__ void gemm_phase(PG8_LAS unsigned char* lds, const Gemm g, const Sched& S, const Epi& E) {
    const int tid = threadIdx.x, wid = __builtin_amdgcn_readfirstlane(tid >> 6), lane = tid & 63, wr = wid >> 2, wc = wid & 3, fr = lane & 15, fq = lane >> 4;
    const int K = g.K, nt = K / BK;
    unsigned voffA[2], voffB[2];
#pragma unroll
    for (int i = 0; i < 2; ++i) { int R, C; stage_rc(tid * 16 + i * 8192, R, C); const int Rb = Epi::PERM ? ((R & ~31) + perm32(R & 31)) : R;
        voffA[i] = (unsigned)(R * K + C) * 2u; voffB[i] = (unsigned)(Rb * K + C) * 2u; }
    const size_t kstep = (size_t)(BK * 2);
    const size_t hstep = (size_t)HALF * K * 2;
    const size_t tstep = 2 * hstep;
    const unsigned ldsw = (unsigned)wid * 1024u;
    const int aoff = lds_byte(wr * 64 + fr, fq * 8), boff = lds_byte(wc * 32 + fr, fq * 8);
#define PG8_SA(b, h) (((b) * 2 + (h)) * HTB)
#define PG8_SB(b, h) ((4 + (b) * 2 + (h)) * HTB)
#define PG8_STAGE(bufoff, gbase, voff) do { _Pragma("unroll") for (int _i = 0; _i < 2; ++_i) \
        __builtin_amdgcn_global_load_lds((const unsigned*)((const char*)(gbase) + (voff)[_i]), (PG8_LAS unsigned*)(lds + (bufoff) + ldsw + _i * 8192), 16, 0, 0); } while (0)
#define PG8_LDA(dst, b, h) do { _Pragma("unroll") for (int m = 0; m < 4; ++m) _Pragma("unroll") for (int k = 0; k < 2; ++k) dst[m][k] = *(const PG8_LAS bf16x8*)(lds + PG8_SA(b, h) + aoff + m * 2048 + k * 1024); } while (0)
#define PG8_LDB(dst, b, h) do { _Pragma("unroll") for (int n = 0; n < 2; ++n) _Pragma("unroll") for (int k = 0; k < 2; ++k) dst[n][k] = *(const PG8_LAS bf16x8*)(lds + PG8_SB(b, h) + boff + n * 2048 + k * 1024); } while (0)
#define PG8_MMA(ai, bj, At, Bt) do { __builtin_amdgcn_s_setprio(1); _Pragma("unroll") for (int m = 0; m < 4; ++m) _Pragma("unroll") for (int n = 0; n < 2; ++n) _Pragma("unroll") for (int k = 0; k < 2; ++k) \
        acc[ai][bj][m][n] = __builtin_amdgcn_mfma_f32_16x16x32_bf16(Bt[n][k], At[m][k], acc[ai][bj][m][n], 0, 0, 0); __builtin_amdgcn_s_setprio(0); } while (0)
#define PG8_WAIT_V(n) asm volatile("s_waitcnt vmcnt(" #n ")" ::: "memory")
#define PG8_WAIT_L(n) asm volatile("s_waitcnt lgkmcnt(" #n ")" ::: "memory")
#define PG8_BAR __builtin_amdgcn_s_barrier()
#define PG8_SCHED __builtin_amdgcn_sched_barrier(0)
    Unit cur, nxt; int ui = 0;
    if (!S.next(0, cur)) return;
    f32x4 acc[2][2][4][2];
#pragma unroll
    for (int a = 0; a < 2; ++a)
#pragma unroll
        for (int b = 0; b < 2; ++b)
#pragma unroll
            for (int m = 0; m < 4; ++m)
#pragma unroll
                for (int n = 0; n < 2; ++n) acc[a][b][m][n] = (f32x4){0.f, 0.f, 0.f, 0.f};
    bf16x8 At[4][2], B0[2][2], B1[2][2];
    const char* cA = (const char*)g.A + (size_t)cur.pm * tstep; const char* cB = (const char*)g.Bt + (size_t)cur.pn * tstep;
    S.a_ready(cur);
    if constexpr (SP2) {
        PG8_STAGE(PG8_SB(0, 0), cB, voffB); PG8_STAGE(PG8_SB(0, 1), cB + hstep, voffB); PG8_STAGE(PG8_SA(0, 0), cA, voffA); PG8_STAGE(PG8_SA(0, 1), cA + hstep, voffA);
        if (wr == 1) PG8_BAR;
        PG8_WAIT_V(2); PG8_BAR;
        PG8_STAGE(PG8_SB(1, 0), cB + kstep, voffB); PG8_STAGE(PG8_SA(1, 0), cA + kstep, voffA); PG8_STAGE(PG8_SB(1, 1), cB + hstep + kstep, voffB);
        PG8_WAIT_V(6); PG8_BAR;
    } else {
        PG8_STAGE(PG8_SB(0, 0), cB, voffB); PG8_STAGE(PG8_SA(0, 0), cA, voffA); PG8_STAGE(PG8_SB(0, 1), cB + hstep, voffB); PG8_STAGE(PG8_SA(0, 1), cA + hstep, voffA);
        if (wr == 1) PG8_BAR;
        PG8_WAIT_V(4); PG8_BAR;
        PG8_STAGE(PG8_SB(1, 0), cB + kstep, voffB); PG8_STAGE(PG8_SA(1, 0), cA + kstep, voffA); PG8_STAGE(PG8_SB(1, 1), cB + hstep + kstep, voffB);
        PG8_WAIT_V(6); PG8_BAR;
    }
    for (;;) {
        const bool has_next = S.next(ui + 1, nxt);
        const char* nA = has_next ? (const char*)g.A + (size_t)nxt.pm * tstep : cA; const char* nB = has_next ? (const char*)g.Bt + (size_t)nxt.pn * tstep : cB;
        for (int t = 0; t < nt; t += 2) {
            const bool last = (t == nt - 2);
            const char* a1 = cA + (size_t)(t + 1) * kstep;
            const char* a2 = last ? nA : cA + (size_t)(t + 2) * kstep; const char* b2 = last ? nB : cB + (size_t)(t + 2) * kstep;
            const char* a3 = a2 + kstep; const char* b3 = b2 + kstep;
            if (last && has_next) S.a_ready(nxt);
            if constexpr (SP2) {
            PG8_LDB(B0, 0, 0); PG8_LDB(B1, 0, 1); PG8_SCHED; PG8_LDA(At, 0, 0); PG8_STAGE(PG8_SA(1, 1), a1 + hstep, voffA);
            PG8_WAIT_V(8); PG8_WAIT_L(0); PG8_BAR; PG8_MMA(0, 0, At, B0); PG8_MMA(0, 1, At, B1); PG8_BAR; PG8_SCHED;
            PG8_LDA(At, 0, 1); PG8_STAGE(PG8_SB(0, 0), b2, voffB); PG8_STAGE(PG8_SB(0, 1), b2 + hstep, voffB); PG8_STAGE(PG8_SA(0, 0), a2, voffA);
            PG8_WAIT_V(8); PG8_WAIT_L(0); PG8_BAR; PG8_MMA(1, 0, At, B0); PG8_MMA(1, 1, At, B1); PG8_BAR; PG8_SCHED;
            PG8_LDB(B0, 1, 0); PG8_LDB(B1, 1, 1); PG8_SCHED; PG8_LDA(At, 1, 0); PG8_STAGE(PG8_SA(0, 1), a2 + hstep, voffA);
            PG8_WAIT_V(8); PG8_WAIT_L(0); PG8_BAR; PG8_MMA(0, 0, At, B0); PG8_MMA(0, 1, At, B1); PG8_BAR; PG8_SCHED;
            PG8_LDA(At, 1, 1); PG8_STAGE(PG8_SB(1, 0), b3, voffB); PG8_STAGE(PG8_SB(1, 1), b3 + hstep, voffB); PG8_STAGE(PG8_SA(1, 0), a3, voffA);
            PG8_WAIT_V(8); PG8_WAIT_L(0); PG8_BAR; PG8_MMA(1, 0, At, B0); PG8_MMA(1, 1, At, B1); PG8_BAR; PG8_SCHED;
            } else {
            PG8_LDB(B0, 0, 0); PG8_SCHED; PG8_LDA(At, 0, 0); PG8_STAGE(PG8_SA(1, 1), a1 + hstep, voffA);
            PG8_WAIT_L(8); PG8_BAR; PG8_WAIT_L(0); PG8_MMA(0, 0, At, B0); PG8_BAR; PG8_SCHED;
            PG8_LDB(B1, 0, 1); PG8_STAGE(PG8_SB(0, 0), b2, voffB);
            PG8_BAR; PG8_WAIT_L(0); PG8_MMA(0, 1, At, B1); PG8_BAR;
            PG8_LDA(At, 0, 1); PG8_STAGE(PG8_SA(0, 0), a2, voffA);
            PG8_BAR; PG8_WAIT_L(0); PG8_MMA(1, 0, At, B0); PG8_BAR; PG8_SCHED;
            PG8_STAGE(PG8_SB(0, 1), b2 + hstep, voffB);
            PG8_WAIT_V(6); PG8_BAR; PG8_MMA(1, 1, At, B1); PG8_BAR;
            PG8_LDB(B0, 1, 0); PG8_SCHED; PG8_LDA(At, 1, 0); PG8_STAGE(PG8_SA(0, 1), a2 + hstep, voffA);
            PG8_WAIT_L(8); PG8_BAR; PG8_WAIT_L(0); PG8_MMA(0, 0, At, B0); PG8_BAR; PG8_SCHED;
            PG8_LDB(B1, 1, 1); PG8_STAGE(PG8_SB(1, 0), b3, voffB);
            PG8_BAR; PG8_WAIT_L(0); PG8_MMA(0, 1, At, B1); PG8_BAR;
            PG8_LDA(At, 1, 1); PG8_STAGE(PG8_SA(1, 0), a3, voffA);
            PG8_BAR; PG8_WAIT_L(0); PG8_MMA(1, 0, At, B0); PG8_BAR; PG8_SCHED;
            PG8_STAGE(PG8_SB(1, 1), b3 + hstep, voffB);
            PG8_WAIT_V(6); PG8_BAR; PG8_MMA(1, 1, At, B1); PG8_BAR;
            }
        }
        if constexpr (ALIGN_EPI) { if (wr == 0) PG8_BAR; }
        if constexpr (!Epi::AFTER_DRAIN) { E(acc, cur, wr, wc, fr, fq); S.done(cur); }
        if (!has_next) break;
#pragma unroll
        for (int a = 0; a < 2; ++a)
#pragma unroll
            for (int b = 0; b < 2; ++b)
#pragma unroll
                for (int m = 0; m < 4; ++m)
#pragma unroll
                    for (int n = 0; n < 2; ++n) acc[a][b][m][n] = (f32x4){0.f, 0.f, 0.f, 0.f};
        cur = nxt; cA = nA; cB = nB; ++ui;
        if constexpr (ALIGN_EPI) { if (wr == 1) PG8_BAR; }
    }
    PG8_WAIT_V(0);
    if constexpr (!ALIGN_EPI) { if (wr == 0) PG8_BAR; }
    PG8_BAR;
    if constexpr (Epi::AFTER_DRAIN) { E.fused(acc, cur, wr, wc, fr, fq, lds, wid, lane); S.done(cur); }
#undef PG8_SA
#undef PG8_SB
#undef PG8_STAGE
#undef PG8_LDA
#undef PG8_LDB
#undef PG8_MMA
#undef PG8_WAIT_V
#undef PG8_WAIT_L
#undef PG8_BAR
#undef PG8_SCHED
}

template <bool F32BASE> struct EpiResBf {
    static constexpr bool PERM = true, AFTER_DRAIN = false;
    const void* base; bf16_t* out; int ldc;
    typedef float f2_t __attribute__((ext_vector_type(2))); typedef __bf16 b2_t __attribute__((ext_vector_type(2)));
    static __device__ __forceinline__ unsigned pk(float lo, float hi) { const f2_t v = {lo, hi}; return __builtin_bit_cast(unsigned, __builtin_convertvector(v, b2_t)); }
    __device__ __forceinline__ void operator()(const f32x4 (&acc)[2][2][4][2], const Unit& u, int wr, int wc, int fr, int fq) const {
        const int row0 = u.pm * BM + wr * 64 + fr, col0 = u.pn * BM + wc * 32 + 8 * fq;
        if (F32BASE) {
#pragma unroll
            for (int ai = 0; ai < 2; ++ai) { f32x4 b0[4][2], b1[4][2];
#pragma unroll
                for (int m = 0; m < 4; ++m)
#pragma unroll
                    for (int bj = 0; bj < 2; ++bj) { const float* b = (const float*)base + (size_t)(row0 + ai * HALF + m * 16) * ldc + col0 + bj * HALF; b0[m][bj] = *(const f32x4*)b; b1[m][bj] = *(const f32x4*)(b + 4); }
                asm volatile("" ::: "memory");
#pragma unroll
                for (int m = 0; m < 4; ++m)
#pragma unroll
                    for (int bj = 0; bj < 2; ++bj) { const f32x4 v0 = acc[ai][bj][m][0] + b0[m][bj], v1 = acc[ai][bj][m][1] + b1[m][bj];
                        u32x4 w; w.x = pk(v0[0], v0[1]); w.y = pk(v0[2], v0[3]); w.z = pk(v1[0], v1[1]); w.w = pk(v1[2], v1[3]);
                        *(u32x4*)(out + (size_t)(row0 + ai * HALF + m * 16) * ldc + col0 + bj * HALF) = w; }
                asm volatile("" ::: "memory"); }
        } else {
            u32x4 rw[2][4][2];
#pragma unroll
            for (int ai = 0; ai < 2; ++ai)
#pragma unroll
                for (int m = 0; m < 4; ++m)
#pragma unroll
                    for (int bj = 0; bj < 2; ++bj) rw[ai][m][bj] = *(const u32x4*)((const bf16_t*)base + (size_t)(row0 + ai * HALF + m * 16) * ldc + col0 + bj * HALF);
            asm volatile("" ::: "memory");
#pragma unroll
            for (int ai = 0; ai < 2; ++ai)
#pragma unroll
                for (int m = 0; m < 4; ++m)
#pragma unroll
                    for (int bj = 0; bj < 2; ++bj) { const u32x4 r = rw[ai][m][bj];
                        const f32x4 v0 = acc[ai][bj][m][0] + (f32x4){__builtin_bit_cast(float, r.x << 16), __builtin_bit_cast(float, r.x & 0xffff0000u), __builtin_bit_cast(float, r.y << 16), __builtin_bit_cast(float, r.y & 0xffff0000u)};
                        const f32x4 v1 = acc[ai][bj][m][1] + (f32x4){__builtin_bit_cast(float, r.z << 16), __builtin_bit_cast(float, r.z & 0xffff0000u), __builtin_bit_cast(float, r.w << 16), __builtin_bit_cast(float, r.w & 0xffff0000u)};
                        u32x4 w; w.x = pk(v0[0], v0[1]); w.y = pk(v0[2], v0[3]); w.z = pk(v1[0], v1[1]); w.w = pk(v1[2], v1[3]);
                        *(u32x4*)(out + (size_t)(row0 + ai * HALF + m * 16) * ldc + col0 + bj * HALF) = w; }
        }
    }
};
}

constexpr int BATCH = 4, SEQ = 8192, DM = 1024, M = BATCH * SEQ;
constexpr int NIN = 3088, NIN_PAD = 3328;
constexpr int C_GQ = 0, C_GK = 256, C_GV = 512, C_GG = 1024, C_AQ = 1536, C_AK = 2048, C_AV = 2560, C_GLR = 3072;
constexpr int NEXP = 16384;
constexpr float NORM_EPS = 1e-6f;
constexpr int NWAVES = 8, NTHREADS = 512;

constexpr size_t MiB = 1u << 20;
constexpr size_t WS_CTL = 0, CTL_ZERO_BYTES = 1 * MiB;
constexpr size_t WS_WT_IN = 1 * MiB;
constexpr size_t WS_WT_OUT = 8 * MiB;
constexpr size_t WS_WT_CIN = 10 * MiB;
constexpr size_t WS_WT_COUT = 14 * MiB;
constexpr size_t WS_WT_Q0 = 16 * MiB;
constexpr size_t WS_WT_Q1 = 20 * MiB;
constexpr size_t WS_ACT = 32 * MiB;
constexpr size_t WS_S = 96 * MiB;
constexpr size_t WS_PROJ = WS_S;
constexpr size_t WS_GLAO = WS_S + 208 * MiB;
constexpr size_t WS_TOPS = WS_S + 128 * MiB;
constexpr size_t WS_TOPI = WS_S + 160 * MiB;
constexpr size_t WS_IDS = WS_S + 192 * MiB;
constexpr size_t WS_G = WS_S + 208 * MiB;
constexpr size_t WS_XC = WS_ACT;
constexpr size_t WS_A = WS_S + 128 * MiB;
constexpr size_t WS_HB = WS_S + 256 * MiB;
constexpr size_t WS_Y0 = WS_S + 320 * MiB;
constexpr size_t WS_U = WS_S + 256 * MiB;
constexpr size_t WS_TAB = 448 * MiB;
constexpr size_t WS_TAB8 = 448 * MiB;
constexpr size_t WS_WG = 24 * MiB;
constexpr size_t WS_AGG = WS_S + 128 * MiB;
constexpr size_t WS_SCL = 26 * MiB;
constexpr size_t WS_END = 512 * MiB;
constexpr int CW_BAR = 4096, CW_RANK = 8192;

constexpr int RING_BYTES = 131072;
constexpr int LDS_BYTES = 147456;
constexpr int LDSCTL_OFF = LDS_BYTES - 512, MISC_OFF = LDSCTL_OFF + 320;

#define LAS __attribute__((address_space(3)))
#define GAS __attribute__((address_space(1)))
typedef unsigned short bf16_t;
typedef float f32x4 __attribute__((ext_vector_type(4)));
typedef unsigned u32x4 __attribute__((ext_vector_type(4)));
typedef unsigned u32x2 __attribute__((ext_vector_type(2)));
typedef short bf16x8 __attribute__((ext_vector_type(8)));
typedef float f32x2 __attribute__((ext_vector_type(2)));

struct Params {
    const float *x, *mix_norm, *ffn_norm, *ab_w_in, *gla_w_alpha, *gla_b_alpha, *gla_head_gain, *ab_w_out;
    const float *c_w_in, *c_conv_w, *c_conv_b, *c_w_rgate, *c_b_rgate, *c_w_igate, *c_b_igate, *c_lambda, *c_w_out;
    const float *peer_w_query, *peer_sub_keys, *peer_u, *peer_v, *final_norm;
    float* out; unsigned char* ws; bf16_t* hb;
    int ph_lo, ph_hi;
};

typedef float f32x2_cv __attribute__((ext_vector_type(2))); typedef __bf16 bf16x2_cv __attribute__((ext_vector_type(2)));
__device__ __forceinline__ unsigned pk2(float lo, float hi) { const f32x2_cv v = {lo, hi}; const bf16x2_cv b = __builtin_convertvector(v, bf16x2_cv); return __builtin_bit_cast(unsigned, b); }
__device__ __forceinline__ unsigned f2bf(float f) { return pk2(f, f) & 0xffffu; }
__device__ __forceinline__ float bf2f(bf16_t b) { return __builtin_bit_cast(float, (unsigned)b << 16); }
__device__ __forceinline__ float bflo(unsigned w) { return __builtin_bit_cast(float, w << 16); }
__device__ __forceinline__ float bfhi(unsigned w) { return __builtin_bit_cast(float, w & 0xffff0000u); }
__device__ __forceinline__ float wave_sum(float v) {
#pragma unroll
    for (int o = 1; o < 64; o <<= 1) v += __shfl_xor(v, o);
    return v;
}
__device__ __forceinline__ float gelu_tanh(float x) {
    const float x2 = x * x, u2 = x * (2.3022082f + 0.10294324f * x2);
    const float e = __builtin_amdgcn_exp2f(u2);
    return x - x * __builtin_amdgcn_rcpf(e + 1.f);
}
__device__ __forceinline__ float sigmoidf_(float x) { return __builtin_amdgcn_rcpf(1.f + __expf(-x)); }

struct Ctx { int tid, lane, wave, blk, nblk, gtid, gthreads, gwave, gwaves; LAS unsigned char* lds; };

template <class F> __device__ __forceinline__ void transpose_cvt(const float* W, int K, int Nsrc, bf16_t* WT, int Ndst, F srcmap, int gtid, int gthreads) {
    const int total = (K / 8) * Ndst;
    for (int idx = gtid; idx < total; idx += gthreads) {
        const int ko = idx / Ndst, n = idx - ko * Ndst; const int sn = srcmap(n);
        u32x4 w = {0u, 0u, 0u, 0u};
        if (sn >= 0) { const float* s = W + (size_t)(ko * 8) * Nsrc + sn;
            w.x = pk2(s[0], s[(size_t)Nsrc]); w.y = pk2(s[2 * (size_t)Nsrc], s[3 * (size_t)Nsrc]); w.z = pk2(s[4 * (size_t)Nsrc], s[5 * (size_t)Nsrc]); w.w = pk2(s[6 * (size_t)Nsrc], s[7 * (size_t)Nsrc]); }
        *(u32x4*)(WT + (size_t)n * K + ko * 8) = w;
    }
}
__device__ __forceinline__ void cvt_bf16(const float* src, bf16_t* dst, size_t n8, int gtid, int gthreads) {
    for (size_t i = gtid; i < n8; i += gthreads) { const f32x4 a = *(const f32x4*)(src + i * 8), b = *(const f32x4*)(src + i * 8 + 4);
        u32x4 w; w.x = pk2(a.x, a.y); w.y = pk2(a.z, a.w); w.z = pk2(b.x, b.y); w.w = pk2(b.z, b.w); *(u32x4*)(dst + i * 8) = w; }
}
__device__ __forceinline__ void ld_row4(const float* row, int lane, int j, f32x4& v) { v = ((const f32x4*)row)[64 * j + lane]; }
__device__ __forceinline__ void ld_row4(const bf16_t* row, int lane, int j, f32x4& v) { const u32x2 w = ((const u32x2*)row)[64 * j + lane]; v = (f32x4){bflo(w.x), bfhi(w.x), bflo(w.y), bfhi(w.y)}; }
template <class T> __device__ __forceinline__ void norm_rows_bf16(const T* src, const float* gain, bf16_t* dst, const Ctx& c, unsigned char* x8 = nullptr) {
    f32x4 gn[4];
#pragma unroll
    for (int j = 0; j < 4; ++j) gn[j] = *((const f32x4*)gain + 64 * j + c.lane);
    for (int m0 = c.gwave; m0 < M; m0 += 4 * c.gwaves) {
        f32x4 v[4][4]; float s[4];
#pragma unroll
        for (int u = 0; u < 4; ++u) { const T* xr = src + (size_t)min(m0 + u * c.gwaves, M - 1) * DM;
#pragma unroll
            for (int j = 0; j < 4; ++j) ld_row4(xr, c.lane, j, v[u][j]); }
#pragma unroll
        for (int u = 0; u < 4; ++u) { s[u] = 0.f;
#pragma unroll
            for (int j = 0; j < 4; ++j) s[u] += (v[u][j].x * v[u][j].x + v[u][j].y * v[u][j].y) + (v[u][j].z * v[u][j].z + v[u][j].w * v[u][j].w); }
#pragma unroll
        for (int o = 1; o < 64; o <<= 1) {
#pragma unroll
            for (int u = 0; u < 4; ++u) s[u] += __shfl_xor(s[u], o); }
#pragma unroll
        for (int u = 0; u < 4; ++u) { const int m = m0 + u * c.gwaves; if (m >= M) break; const float rstd = __builtin_amdgcn_rsqf(s[u] * (1.f / DM) + NORM_EPS);
            u32x2* o8 = (u32x2*)(dst + (size_t)m * DM) + c.lane;
#pragma unroll
            for (int j = 0; j < 4; ++j) { const f32x4 g = gn[j]; const unsigned w0 = pk2(v[u][j].x * rstd * g.x, v[u][j].y * rstd * g.y), w1 = pk2(v[u][j].z * rstd * g.z, v[u][j].w * rstd * g.w);
                u32x2 w; w.x = w0; w.y = w1; o8[64 * j] = w;
                if (x8) {
                    const float f0 = bflo(w0), f1 = bfhi(w0), f2 = bflo(w1), f3 = bfhi(w1);
                    int hq = __builtin_amdgcn_cvt_pk_fp8_f32(f0, f1, 0, false); hq = __builtin_amdgcn_cvt_pk_fp8_f32(f2, f3, hq, true);
                    const f32x2 d0 = __builtin_amdgcn_cvt_pk_f32_fp8(hq, false), d1 = __builtin_amdgcn_cvt_pk_f32_fp8(hq, true);
                    int lq = __builtin_amdgcn_cvt_pk_fp8_f32((f0 - d0.x) * 16.f, (f1 - d0.y) * 16.f, 0, false); lq = __builtin_amdgcn_cvt_pk_fp8_f32((f2 - d1.x) * 16.f, (f3 - d1.y) * 16.f, lq, true);
                    unsigned* xo = (unsigned*)(x8 + (size_t)m * 2048) + 64 * j + c.lane; xo[0] = (unsigned)hq; xo[256] = (unsigned)lq; } } }
    }
}
__device__ __forceinline__ void norm_rows_f32(const bf16_t* src, float* dst, const float* gain, const Ctx& c) {
    f32x4 gn[4];
#pragma unroll
    for (int j = 0; j < 4; ++j) gn[j] = *((const f32x4*)gain + 64 * j + c.lane);
    for (int m0 = c.gwave; m0 < M; m0 += 4 * c.gwaves) {
        f32x4 v[4][4]; float s[4];
#pragma unroll
        for (int u = 0; u < 4; ++u) { const bf16_t* xr = src + (size_t)min(m0 + u * c.gwaves, M - 1) * DM;
#pragma unroll
            for (int j = 0; j < 4; ++j) ld_row4(xr, c.lane, j, v[u][j]); }
#pragma unroll
        for (int u = 0; u < 4; ++u) { s[u] = 0.f;
#pragma unroll
            for (int j = 0; j < 4; ++j) s[u] += (v[u][j].x * v[u][j].x + v[u][j].y * v[u][j].y) + (v[u][j].z * v[u][j].z + v[u][j].w * v[u][j].w); }
#pragma unroll
        for (int o = 1; o < 64; o <<= 1) {
#pragma unroll
            for (int u = 0; u < 4; ++u) s[u] += __shfl_xor(s[u], o); }
#pragma unroll
        for (int u = 0; u < 4; ++u) { if (m0 + u * c.gwaves >= M) break; const float rstd = __builtin_amdgcn_rsqf(s[u] * (1.f / DM) + NORM_EPS); f32x4* xw = (f32x4*)(dst + (size_t)(m0 + u * c.gwaves) * DM) + c.lane;
#pragma unroll
            for (int j = 0; j < 4; ++j) xw[64 * j] = v[u][j] * rstd * gn[j]; }
    }
}

constexpr size_t WS_GLRB = 30 * MiB;
__device__ __forceinline__ void ph_glr(const Params& p, const Ctx& c) {
    const bf16_t* XN = (const bf16_t*)(p.ws + WS_ACT); const bf16_t* WG = (const bf16_t*)(p.ws + WS_WT_IN) + (size_t)3072 * DM; bf16_t* GL = (bf16_t*)(p.ws + WS_GLRB);
    const int lane = c.lane, r = lane & 15, q = lane >> 4;
    for (int tile = c.gwave; tile < M / 16; tile += c.gwaves) {
        const bf16_t* ap = XN + (size_t)(tile * 16 + r) * DM + 8 * q; const bf16_t* bp = WG + (size_t)r * DM + 8 * q;
        f32x4 acc = {0.f, 0.f, 0.f, 0.f};
#pragma unroll 8
        for (int s2 = 0; s2 < 32; ++s2) acc = __builtin_amdgcn_mfma_f32_16x16x32_bf16(__builtin_bit_cast(bf16x8, *(const u32x4*)(ap + 32 * s2)), __builtin_bit_cast(bf16x8, *(const u32x4*)(bp + 32 * s2)), acc, 0, 0, 0);
#pragma unroll
        for (int i = 0; i < 4; ++i) GL[(size_t)(tile * 16 + 4 * q + i) * 16 + r] = (bf16_t)f2bf(acc[i]);
    }
}


constexpr int AT_K = 0, AT_V = 272 * 144, AT_END = 2 * 272 * 144;
typedef short s16x4 __attribute__((ext_vector_type(4)));
__device__ __forceinline__ s16x4 lds_tr16(LAS const unsigned char* pbyte) { return __builtin_bit_cast(s16x4, __builtin_amdgcn_ds_read_tr16_b64_v4i16((LAS s16x4*)pbyte)); }
__device__ __forceinline__ void ph_attn(const Params& p, const Ctx& c) {
    LAS unsigned char* L = c.lds;
    const bf16_t* proj = (const bf16_t*)(p.ws + WS_PROJ); bf16_t* AO = (bf16_t*)p.out; float* LSE = (float*)((unsigned char*)p.out + 96 * MiB);
    const int tid = c.tid, lane = c.lane, w = c.wave, r = lane & 15, qq = lane >> 4;
    constexpr float LOG2E = 1.4426950408889634f;
    __syncthreads();
    for (int i = tid; i < 16 * 144 / 4; i += NTHREADS) ((LAS unsigned*)(L + AT_V + 256 * 144))[i] = 0u;
    u32x4 kreg[4], vreg[4], qreg[2];
#define AT_DECODE(it_) const int h = (it_) & 7, rest = (it_) >> 3, br = rest >> 8, u = rest & 255, sh = 2 * br, dil = 1 << sh, nbm = (64 >> sh) - 1; \
        const int bres = u >> (6 - sh), blk = u & nbm, b = bres >> sh, res = bres & (dil - 1); const size_t rowb = (size_t)b * SEQ; const int l0 = blk * 128
#define AT_ISSUE(it_) do { AT_DECODE(it_); (void)br; \
        _Pragma("unroll") for (int k = 0; k < 4; ++k) { const int idx = tid + NTHREADS * k, row = idx >> 3, ch = idx & 7, l = l0 - 128 + row; kreg[k] = (u32x4){0u, 0u, 0u, 0u}; vreg[k] = kreg[k]; \
            if (l >= 0) { const bf16_t* src = proj + (rowb + (size_t)l * dil + res) * NIN_PAD + C_AK + h * 64 + ch * 8; kreg[k] = *(const u32x4*)src; vreg[k] = *(const u32x4*)(src + 512); } } \
        const bf16_t* qp = proj + (rowb + (size_t)(l0 + 16 * w + r) * dil + res) * NIN_PAD + C_AQ + h * 64 + 8 * qq; qreg[0] = *(const u32x4*)qp; qreg[1] = *(const u32x4*)(qp + 32); } while (0)
    if (c.blk < 6144) AT_ISSUE(c.blk);
    for (int item = c.blk; item < 6144; item += c.nblk) {
        AT_DECODE(item);
        __syncthreads();
#pragma unroll
        for (int k = 0; k < 4; ++k) { const int idx = tid + NTHREADS * k, row = idx >> 3, ch = idx & 7;
            *(LAS u32x4*)(L + AT_K + row * 144 + ch * 16) = kreg[k]; *(LAS u32x4*)(L + AT_V + row * 144 + ch * 16) = vreg[k]; }
        bf16x8 qf[2]; qf[0] = __builtin_bit_cast(bf16x8, qreg[0]); qf[1] = __builtin_bit_cast(bf16x8, qreg[1]);
        { const int nit = item + c.nblk; if (nit < 6144) AT_ISSUE(nit); }
        __syncthreads();
        f32x4 sa[9];
#pragma unroll
        for (int jn = 0; jn < 9; ++jn) { LAS const unsigned char* kp = L + AT_K + (16 * (w + jn) + r) * 144 + 16 * qq;
            const bf16x8 k0 = __builtin_bit_cast(bf16x8, *(const LAS u32x4*)kp), k1 = __builtin_bit_cast(bf16x8, *(const LAS u32x4*)(kp + 64));
            f32x4 z = {0.f, 0.f, 0.f, 0.f}; z = __builtin_amdgcn_mfma_f32_16x16x32_bf16(k0, qf[0], z, 0, 0, 0); sa[jn] = __builtin_amdgcn_mfma_f32_16x16x32_bf16(k1, qf[1], z, 0, 0, 0); }
        const float sc = 0.125f * LOG2E, sl = exp2f(-(float)(h + 1)) * (float)dil * LOG2E;
        const int delta0 = r + 128 - 4 * qq;
        const float b0 = -sl * (float)delta0;
        float mx = -1e30f;
        if (blk > 0) {
#pragma unroll
            for (int jn = 0; jn < 9; ++jn)
#pragma unroll
                for (int i = 0; i < 4; ++i) { const bool valid = (unsigned)(delta0 - (16 * jn + i)) <= 128u;
                    const float v = valid ? __builtin_fmaf(sa[jn][i], sc, __builtin_fmaf(sl, (float)(16 * jn + i), b0)) : -1e30f; sa[jn][i] = v; mx = fmaxf(mx, v); }
        } else {
#pragma unroll
            for (int jn = 0; jn < 9; ++jn)
#pragma unroll
                for (int i = 0; i < 4; ++i) { const bool valid = ((unsigned)(delta0 - (16 * jn + i)) <= 128u) && (16 * (w + jn) + 4 * qq + i >= 128);
                    const float v = valid ? __builtin_fmaf(sa[jn][i], sc, __builtin_fmaf(sl, (float)(16 * jn + i), b0)) : -1e30f; sa[jn][i] = v; mx = fmaxf(mx, v); }
        }
        mx = fmaxf(mx, __shfl_xor(mx, 16)); mx = fmaxf(mx, __shfl_xor(mx, 32));
        float sum = 0.f;
#pragma unroll
        for (int jn = 0; jn < 9; ++jn)
#pragma unroll
            for (int i = 0; i < 4; ++i) { const float e = __builtin_amdgcn_exp2f(sa[jn][i] - mx); sa[jn][i] = e; sum += e; }
        sum += __shfl_xor(sum, 16); sum += __shfl_xor(sum, 32);
        { const int qi = 16 * w + r; if (qq == 0) LSE[((size_t)br * M + rowb + (size_t)(l0 + qi) * dil + res) * 8 + h] = (mx + __builtin_amdgcn_logf(sum)) * (1.f / LOG2E); }
        f32x4 oa[4];
#pragma unroll
        for (int dt = 0; dt < 4; ++dt) oa[dt] = (f32x4){0.f, 0.f, 0.f, 0.f};
#pragma unroll
        for (int s2 = 0; s2 < 5; ++s2) { u32x4 pw; pw.x = pk2(sa[2 * s2][0], sa[2 * s2][1]); pw.y = pk2(sa[2 * s2][2], sa[2 * s2][3]);
            if (s2 < 4) { pw.z = pk2(sa[2 * s2 + 1][0], sa[2 * s2 + 1][1]); pw.w = pk2(sa[2 * s2 + 1][2], sa[2 * s2 + 1][3]); } else { pw.z = 0u; pw.w = 0u; }
            LAS const unsigned char* vp = L + AT_V + (16 * (w + 2 * s2) + 4 * qq + (r >> 2)) * 144 + 8 * (r & 3);
#pragma unroll
            for (int dt = 0; dt < 4; ++dt) { const s16x4 v0 = lds_tr16(vp + 32 * dt), v1 = lds_tr16(vp + 32 * dt + 16 * 144);
                const bf16x8 vf = {v0[0], v0[1], v0[2], v0[3], v1[0], v1[1], v1[2], v1[3]};
                oa[dt] = __builtin_amdgcn_mfma_f32_16x16x32_bf16(__builtin_bit_cast(bf16x8, pw), vf, oa[dt], 0, 0, 0); } }
        const float rs = __builtin_amdgcn_rcpf(sum);
        LAS bf16_t* ost = (LAS bf16_t*)(L + AT_END + w * 2304);
#pragma unroll
        for (int i = 0; i < 4; ++i) { const float ri = __shfl(rs, 4 * qq + i);
#pragma unroll
            for (int dt = 0; dt < 4; ++dt) ost[(4 * qq + i) * 72 + 16 * dt + r] = (bf16_t)f2bf(oa[dt][i] * ri); }
        asm volatile("" ::: "memory");
        { const int qi = lane >> 2, dc = (lane & 3) * 16;
          const u32x4 o0 = *(const LAS u32x4*)(ost + qi * 72 + dc), o1 = *(const LAS u32x4*)(ost + qi * 72 + dc + 8);
          bf16_t* op = AO + ((size_t)br * M + rowb + (size_t)(l0 + 16 * w + qi) * dil + res) * 512 + h * 64 + dc;
          *(u32x4*)op = o0; *(u32x4*)(op + 8) = o1; }
        asm volatile("" ::: "memory");
    }
#undef AT_DECODE
#undef AT_ISSUE
}

constexpr size_t WS_CKV = WS_S + 272 * MiB;
constexpr size_t WS_DEC = WS_S + 336 * MiB;
constexpr size_t WS_SPREV = WS_ACT;
constexpr int GL_SEGT = 0, GL_V = 2048, GL_KT = GL_V + 64 * 272, GL_QD = GL_KT + 64 * 144, GL_KI = GL_QD + 64 * 144, GL_END = GL_KI + 64 * 144;
#ifdef GLR_FROM_PROJ
#define GLR_SRC (prow0 + C_GLR), NIN_PAD
#else
#define GLR_SRC ((const bf16_t*)(p.ws + WS_GLRB) + (size_t)bn * 64 * 16), 16
#endif
__device__ __forceinline__ void gla_cumdecay(const Params& p, const Ctx& c, const bf16_t* glr0, int gstride, int h, float (&bcum)[8], float& blast) {
    LAS float* SEGT = (LAS float*)(c.lds + GL_SEGT);
    const int kk = c.tid & 63, w = c.wave;
    float wa[16];
#pragma unroll
    for (int r = 0; r < 16; ++r) wa[r] = p.gla_w_alpha[r * 256 + h * 64 + kk];
    const float ba = p.gla_b_alpha[h * 64 + kk];
    float run = 0.f;
    u32x4 ga[8], gb[8];
#pragma unroll
    for (int k = 0; k < 8; ++k) { const bf16_t* pr = glr0 + (size_t)(8 * w + k) * gstride; ga[k] = *(const u32x4*)pr; gb[k] = *(const u32x4*)(pr + 8); }
#pragma unroll
    for (int k = 0; k < 8; ++k) { const u32x4 g0 = ga[k], g1 = gb[k];
        float z = ba + bflo(g0.x) * wa[0] + bfhi(g0.x) * wa[1] + bflo(g0.y) * wa[2] + bfhi(g0.y) * wa[3] + bflo(g0.z) * wa[4] + bfhi(g0.z) * wa[5] + bflo(g0.w) * wa[6] + bfhi(g0.w) * wa[7]
                     + bflo(g1.x) * wa[8] + bfhi(g1.x) * wa[9] + bflo(g1.y) * wa[10] + bfhi(g1.y) * wa[11] + bflo(g1.z) * wa[12] + bfhi(g1.z) * wa[13] + bflo(g1.w) * wa[14] + bfhi(g1.w) * wa[15];
        const float ls = fminf(z, 0.f) - __logf(1.f + __expf(-fabsf(z)));
        run += ls * (1.f / 16.f); bcum[k] = run; }
    __syncthreads();
    SEGT[w * 64 + kk] = run;
    __syncthreads();
    float off = 0.f, tot = 0.f;
#pragma unroll
    for (int sg = 0; sg < 8; ++sg) { const float v = SEGT[sg * 64 + kk]; off += (sg < w) ? v : 0.f; tot += v; }
#pragma unroll
    for (int k = 0; k < 8; ++k) bcum[k] += off;
    blast = tot;
}
__device__ __forceinline__ void gla_stage_v(const Ctx& c, const bf16_t* prow0, int h) {
    u32x4 t[2];
#pragma unroll
    for (int k = 0; k < 2; ++k) { const int idx = c.tid + NTHREADS * k, row = idx >> 4, ch = idx & 15; t[k] = *(const u32x4*)(prow0 + (size_t)row * NIN_PAD + C_GV + h * 128 + ch * 8); }
#pragma unroll
    for (int k = 0; k < 2; ++k) { const int idx = c.tid + NTHREADS * k, row = idx >> 4, ch = idx & 15; *(LAS u32x4*)(c.lds + GL_V + row * 272 + ch * 16) = t[k]; }
}
__device__ __forceinline__ void ph_gla_a(const Params& p, const Ctx& c) {
    LAS unsigned char* L = c.lds; const bf16_t* proj = (const bf16_t*)(p.ws + WS_PROJ);
    float* CKV = (float*)(p.ws + WS_CKV); float* DEC = (float*)(p.ws + WS_DEC);
    const int tid = c.tid, lane = c.lane, w = c.wave, r = lane & 15, qq = lane >> 4, kk = tid & 63;
    for (int item = c.blk; item < 2048; item += c.nblk) {
        const int h = item & 3, bn = item >> 2; const bf16_t* prow0 = proj + (size_t)bn * 64 * NIN_PAD;
        bf16_t kraw[8];
#pragma unroll
        for (int k = 0; k < 8; ++k) kraw[k] = prow0[(size_t)(8 * w + k) * NIN_PAD + C_GK + h * 64 + kk];
        float bcum[8], blast; gla_cumdecay(p, c, GLR_SRC, h, bcum, blast);
        gla_stage_v(c, prow0, h);
        { u32x4 o; float e[8];
#pragma unroll
          for (int k = 0; k < 8; ++k) e[k] = bf2f(kraw[k]) * __expf(blast - bcum[k]);
          o.x = pk2(e[0], e[1]); o.y = pk2(e[2], e[3]); o.z = pk2(e[4], e[5]); o.w = pk2(e[6], e[7]);
          *(LAS u32x4*)(L + GL_KT + kk * 144 + 16 * w) = o; }
        if (w == 0) DEC[(size_t)item * 64 + kk] = __expf(blast);
        __syncthreads();
        f32x4 acc[4];
#pragma unroll
        for (int n = 0; n < 4; ++n) acc[n] = (f32x4){0.f, 0.f, 0.f, 0.f};
#pragma unroll
        for (int s2 = 0; s2 < 2; ++s2) { LAS const unsigned char* vp = L + GL_V + (32 * s2 + 8 * qq + (r >> 2)) * 272 + (16 * w + 4 * (r & 3)) * 2;
            const s16x4 v0 = lds_tr16(vp), v1 = lds_tr16(vp + 4 * 272); const bf16x8 af = {v0[0], v0[1], v0[2], v0[3], v1[0], v1[1], v1[2], v1[3]};
#pragma unroll
            for (int n = 0; n < 4; ++n) { const bf16x8 bfr = __builtin_bit_cast(bf16x8, *(const LAS u32x4*)(L + GL_KT + (16 * n + r) * 144 + (32 * s2 + 8 * qq) * 2));
                acc[n] = __builtin_amdgcn_mfma_f32_16x16x32_bf16(af, bfr, acc[n], 0, 0, 0); } }
        float* outp = CKV + (size_t)item * 8192 + (16 * w + 4 * qq) * 64 + r;
#pragma unroll
        for (int n = 0; n < 4; ++n)
#pragma unroll
            for (int i = 0; i < 4; ++i) outp[i * 64 + 16 * n] = acc[n][i];
    }
}
__device__ __forceinline__ void ph_gla_b(const Params& p, const Ctx& c) {
    const float* CKV = (const float*)(p.ws + WS_CKV); const float* DEC = (const float*)(p.ws + WS_DEC); bf16_t* SP = (bf16_t*)(p.ws + WS_SPREV);
    for (int idx = c.gtid; idx < 16 * 8192; idx += c.gthreads) { const int bh = idx >> 13, e = idx & 8191, b = bh >> 2, h = bh & 3; float S = 0.f;
        for (int n0 = 0; n0 < 128; n0 += 8) { float cv[8], dv[8];
#pragma unroll
            for (int k = 0; k < 8; ++k) { const size_t item = (size_t)(b * 128 + n0 + k) * 4 + h; cv[k] = CKV[item * 8192 + e]; dv[k] = DEC[item * 64 + (e & 63)]; }
#pragma unroll
            for (int k = 0; k < 8; ++k) { const size_t item = (size_t)(b * 128 + n0 + k) * 4 + h; SP[item * 8192 + e] = (bf16_t)f2bf(S); S = dv[k] * S + cv[k]; } } }
}
__device__ __forceinline__ void ph_gla_c(const Params& p, const Ctx& c) {
    LAS unsigned char* L = c.lds; const bf16_t* proj = (const bf16_t*)(p.ws + WS_PROJ); const bf16_t* SP = (const bf16_t*)(p.ws + WS_SPREV); bf16_t* go = (bf16_t*)(p.ws + WS_GLAO);
    const int tid = c.tid, lane = c.lane, w = c.wave, r = lane & 15, qq = lane >> 4, kk = tid & 63;
    for (int item = c.blk; item < 2048; item += c.nblk) {
        const int h = item & 3, bn = item >> 2; const bf16_t* prow0 = proj + (size_t)bn * 64 * NIN_PAD;
        const int it = w & 3, vh = w >> 2;
        bf16_t qraw[8], kraw[8]; u32x4 spf[2][4];
#pragma unroll
        for (int k = 0; k < 8; ++k) { const bf16_t* pr = prow0 + (size_t)(8 * w + k) * NIN_PAD; qraw[k] = pr[C_GQ + h * 64 + kk]; kraw[k] = pr[C_GK + h * 64 + kk]; }
#pragma unroll
        for (int s2 = 0; s2 < 2; ++s2)
#pragma unroll
            for (int n = 0; n < 4; ++n) spf[s2][n] = *(const u32x4*)(SP + (size_t)item * 8192 + (64 * vh + 16 * n + r) * 64 + 32 * s2 + 8 * qq);
        float bcum[8], blast; gla_cumdecay(p, c, GLR_SRC, h, bcum, blast);
        gla_stage_v(c, prow0, h);
#pragma unroll
        for (int k = 0; k < 8; ++k) { const int i = 8 * w + k;
            const float qv = bf2f(qraw[k]) * 0.125f * __expf(bcum[k]), kv = bf2f(kraw[k]) * __expf(-bcum[k]);
            *(LAS bf16_t*)(L + GL_QD + i * 144 + kk * 2) = (bf16_t)f2bf(qv); *(LAS bf16_t*)(L + GL_KI + i * 144 + kk * 2) = (bf16_t)f2bf(kv); }
        __syncthreads();
        bf16x8 qf[2];
#pragma unroll
        for (int s2 = 0; s2 < 2; ++s2) qf[s2] = __builtin_bit_cast(bf16x8, *(const LAS u32x4*)(L + GL_QD + (16 * it + r) * 144 + (32 * s2 + 8 * qq) * 2));
        u32x2 pw[4];
#pragma unroll
        for (int jt = 0; jt < 4; ++jt) { f32x4 z = {0.f, 0.f, 0.f, 0.f};
            if (jt <= it) {
#pragma unroll
                for (int s2 = 0; s2 < 2; ++s2) { const bf16x8 kf = __builtin_bit_cast(bf16x8, *(const LAS u32x4*)(L + GL_KI + (16 * jt + r) * 144 + (32 * s2 + 8 * qq) * 2));
                    z = __builtin_amdgcn_mfma_f32_16x16x32_bf16(kf, qf[s2], z, 0, 0, 0); }
#pragma unroll
                for (int ii = 0; ii < 4; ++ii) z[ii] = (16 * jt + 4 * qq + ii <= 16 * it + r) ? z[ii] : 0.f; }
            pw[jt].x = pk2(z[0], z[1]); pw[jt].y = pk2(z[2], z[3]); }
        f32x4 acc[4];
#pragma unroll
        for (int n = 0; n < 4; ++n) acc[n] = (f32x4){0.f, 0.f, 0.f, 0.f};
#pragma unroll
        for (int s2 = 0; s2 < 2; ++s2) { if (2 * s2 <= it) {
            const u32x4 pq = {pw[2 * s2].x, pw[2 * s2].y, pw[2 * s2 + 1].x, pw[2 * s2 + 1].y};
            LAS const unsigned char* vp = L + GL_V + (32 * s2 + 4 * qq + (r >> 2)) * 272 + (64 * vh + 4 * (r & 3)) * 2;
#pragma unroll
            for (int n = 0; n < 4; ++n) { const s16x4 v0 = lds_tr16(vp + 32 * n), v1 = lds_tr16(vp + 32 * n + 16 * 272);
                const bf16x8 vf = {v0[0], v0[1], v0[2], v0[3], v1[0], v1[1], v1[2], v1[3]};
                acc[n] = __builtin_amdgcn_mfma_f32_16x16x32_bf16(__builtin_bit_cast(bf16x8, pq), vf, acc[n], 0, 0, 0); } } }
#pragma unroll
        for (int s2 = 0; s2 < 2; ++s2)
#pragma unroll
            for (int n = 0; n < 4; ++n) { const bf16x8 sf = __builtin_bit_cast(bf16x8, spf[s2][n]);
                acc[n] = __builtin_amdgcn_mfma_f32_16x16x32_bf16(qf[s2], sf, acc[n], 0, 0, 0); }
        bf16_t* outp = go + ((size_t)bn * 64 + 16 * it + 4 * qq) * 512 + h * 128 + 64 * vh + r;
#pragma unroll
        for (int n = 0; n < 4; ++n)
#pragma unroll
            for (int ii = 0; ii < 4; ++ii) outp[ii * 512 + 16 * n] = (bf16_t)f2bf(acc[n][ii]);
    }
}
#ifndef ATT_COMBINE
#define ATT_COMBINE 1
#endif
__device__ __forceinline__ void ph_mix(const Params& p, const Ctx& c) {
    const bf16_t* proj = (const bf16_t*)(p.ws + WS_PROJ); const bf16_t* go = (const bf16_t*)(p.ws + WS_GLAO); bf16_t* mixed = (bf16_t*)(p.ws + WS_ACT);
    const bf16_t* AO = (const bf16_t*)p.out; const float* LSE = (const float*)((const unsigned char*)p.out + 96 * MiB); const int hh = c.lane >> 3;
    float hg0[4], hg1[4];
#pragma unroll
    for (int h = 0; h < 4; ++h) { hg0[h] = p.gla_head_gain[h * 128 + 2 * c.lane]; hg1[h] = p.gla_head_gain[h * 128 + 2 * c.lane + 1]; }
    for (int m0 = c.gwave; m0 < M; m0 += 4 * c.gwaves) {
        unsigned ow[4][4], gw[4][4]; float ls[4][3]; u32x4 av[4][3];
#pragma unroll
        for (int u = 0; u < 4; ++u) { const int m = min(m0 + u * c.gwaves, M - 1);
#pragma unroll
            for (int h = 0; h < 4; ++h) { const int col = h * 128 + 2 * c.lane; ow[u][h] = *(const unsigned*)(go + (size_t)m * 512 + col); gw[u][h] = *(const unsigned*)(proj + (size_t)m * NIN_PAD + C_GG + col); }
#pragma unroll
            for (int br = 0; br < 3; ++br) { ls[u][br] = LSE[((size_t)br * M + m) * 8 + hh]; av[u][br] = *((const u32x4*)(AO + ((size_t)br * M + m) * 512) + c.lane); } }
        asm volatile("" ::: "memory");
#pragma unroll
        for (int u = 0; u < 4; ++u) { const int m = m0 + u * c.gwaves; if (m >= M) break;
#pragma unroll
            for (int h = 0; h < 4; ++h) { const int col = h * 128 + 2 * c.lane;
                const float o0 = bflo(ow[u][h]), o1 = bfhi(ow[u][h]);
                const float rstd = 1.f / sqrtf(wave_sum(o0 * o0 + o1 * o1) * (1.f / 128.f) + NORM_EPS);
                const float g0 = bflo(gw[u][h]), g1 = bfhi(gw[u][h]);
                const float r0 = o0 * rstd * hg0[h] * (g0 * sigmoidf_(g0)), r1 = o1 * rstd * hg1[h] * (g1 * sigmoidf_(g1));
                *(unsigned*)(mixed + (size_t)m * DM + col) = pk2(r0, r1); }
            {
                const float l0 = ls[u][0], l1 = ls[u][1], l2 = ls[u][2];
                const float lm = fmaxf(l0, fmaxf(l1, l2)), e0 = __expf(l0 - lm), e1 = __expf(l1 - lm), e2 = __expf(l2 - lm), rd = __builtin_amdgcn_rcpf(e0 + e1 + e2);
                const float w0 = e0 * rd, w1 = e1 * rd, w2 = e2 * rd;
                const u32x4 a0 = av[u][0], a1 = av[u][1], a2 = av[u][2];
                u32x4 o;
                o.x = pk2(w0 * bflo(a0.x) + w1 * bflo(a1.x) + w2 * bflo(a2.x), w0 * bfhi(a0.x) + w1 * bfhi(a1.x) + w2 * bfhi(a2.x));
                o.y = pk2(w0 * bflo(a0.y) + w1 * bflo(a1.y) + w2 * bflo(a2.y), w0 * bfhi(a0.y) + w1 * bfhi(a1.y) + w2 * bfhi(a2.y));
                o.z = pk2(w0 * bflo(a0.z) + w1 * bflo(a1.z) + w2 * bflo(a2.z), w0 * bfhi(a0.z) + w1 * bfhi(a1.z) + w2 * bfhi(a2.z));
                o.w = pk2(w0 * bflo(a0.w) + w1 * bflo(a1.w) + w2 * bflo(a2.w), w0 * bfhi(a0.w) + w1 * bfhi(a1.w) + w2 * bfhi(a2.w));
                *((u32x4*)(mixed + (size_t)m * DM + 512) + c.lane) = o; } }
    }
}
constexpr int GR_WGT = 0, GR_XC = 65536, GR_A = 81920, GR_U = 115712, GR_SEG = 132608, GR_CW = 136704, GR_GB = 139264;
__device__ __forceinline__ float fast_sigmoid(float x) { return __builtin_amdgcn_rcpf(1.f + __expf(-x)); }
__device__ __forceinline__ void griffin_pass(const Params& p, const Ctx& c) {
    LAS unsigned char* L = c.lds;
    const int tid = c.tid, lane = c.lane, wave = c.wave, g = c.blk & 7;
    const bf16_t* proj = (const bf16_t*)(p.ws + WS_PROJ); bf16_t* yout = (bf16_t*)(p.ws + WS_Y0); bf16_t* ypout = (bf16_t*)((unsigned char*)p.out + 64 * MiB);
    float* AGA = (float*)(p.ws + WS_AGG); float* AGH = AGA + BATCH * 128 * 1024;
    LAS float* A_ = (LAS float*)(L + GR_A); LAS bf16_t* U_ = (LAS bf16_t*)(L + GR_U); LAS float* SEG = (LAS float*)(L + GR_SEG); LAS float* CW = (LAS float*)(L + GR_CW); LAS float* GB = (LAS float*)(L + GR_GB);
    __syncthreads();
    { const bf16_t* wg = (const bf16_t*)(p.ws + WS_WG);
      for (int ch = tid; ch < 4096; ch += NTHREADS) { const int gate = ch >> 11, j = (ch >> 4) & 127, cc = ch & 15;
          const u32x4 v = *(const u32x4*)(wg + ((size_t)(gate * 8 + g) * 128 + j) * 128 + cc * 8);
          *(LAS u32x4*)(L + GR_WGT + gate * 32768 + j * 256 + ((cc ^ (j & 15)) << 4)) = v; }
      if (tid < 128) { const int ch = g * 128 + tid;
#pragma unroll
          for (int jj = 0; jj < 4; ++jj) CW[jj * 128 + tid] = p.c_conv_w[jj * 1024 + ch];
          CW[4 * 128 + tid] = p.c_conv_b[ch]; GB[tid] = p.c_b_rgate[ch]; GB[128 + tid] = p.c_b_igate[ch];
          const float lam = p.c_lambda[ch]; GB[256 + tid] = fmaxf(-lam, 0.f) + log1pf(expf(-fabsf(lam))); } }
    __syncthreads();
    const int nslot = BATCH * 128, sstep = c.nblk >> 3;
    u32x4 xr[5];
#define GR_XLOAD(sl_) do { const int b_ = (sl_) >> 7, t0_ = ((sl_) & 127) * 64; const size_t r0_ = (size_t)b_ * SEQ + t0_; const int co_ = tid & 15, tp_ = tid >> 4; \
        _Pragma("unroll") for (int jj = 0; jj < 5; ++jj) { const int tt = t0_ + 2 * tp_ - 3 + jj; xr[jj] = (u32x4){0u, 0u, 0u, 0u}; \
            if (tt >= 0) xr[jj] = *(const u32x4*)(proj + (r0_ + 2 * tp_ - 3 + jj) * 2048 + 1024 + g * 128 + co_ * 8); } } while (0)
    if ((c.blk >> 3) < nslot) GR_XLOAD(c.blk >> 3);
    for (int slot = c.blk >> 3; slot < nslot; slot += sstep) {
        const int b = slot >> 7, tile = slot & 127, t0 = tile * 64; const size_t row0 = (size_t)b * SEQ + t0;
        u32x4 gpre[2];
        { const int co = tid & 15, tp = tid >> 4;
#pragma unroll
            for (int tl = 0; tl < 2; ++tl) gpre[tl] = *(const u32x4*)(proj + (row0 + 2 * tp + tl) * 2048 + g * 128 + co * 8); }
        { const int co = tid & 15, tp = tid >> 4;
          f32x4 w[5][2];
#pragma unroll
          for (int jj = 0; jj < 5; ++jj) { w[jj][0] = *(const LAS f32x4*)(CW + jj * 128 + co * 8); w[jj][1] = *(const LAS f32x4*)(CW + jj * 128 + co * 8 + 4); }
#pragma unroll
          for (int tl = 0; tl < 2; ++tl) { float a8[8];
#pragma unroll
              for (int e = 0; e < 8; ++e) a8[e] = w[4][e >> 2][e & 3];
#pragma unroll
              for (int jj = 0; jj < 4; ++jj) { const u32x4 xv = xr[tl + jj]; const unsigned xw[4] = {xv.x, xv.y, xv.z, xv.w};
#pragma unroll
                  for (int e = 0; e < 8; ++e) { const float xe = (e & 1) ? bfhi(xw[e >> 1]) : bflo(xw[e >> 1]); a8[e] += w[jj][e >> 2][e & 3] * xe; } }
              const int t = 2 * tp + tl; u32x4 o; o.x = pk2(a8[0], a8[1]); o.y = pk2(a8[2], a8[3]); o.z = pk2(a8[4], a8[5]); o.w = pk2(a8[6], a8[7]);
              *(LAS u32x4*)(L + GR_XC + t * 256 + ((co ^ (t & 15)) << 4)) = o; } }
        if (slot + sstep < nslot) GR_XLOAD(slot + sstep);
        __syncthreads();
        { const int tt = wave & 3, jh = wave >> 2, r = lane & 15, q = lane >> 4, t = 16 * tt + r;
          f32x4 ar[4], ai[4];
#pragma unroll
          for (int n = 0; n < 4; ++n) { ar[n] = (f32x4){0.f, 0.f, 0.f, 0.f}; ai[n] = (f32x4){0.f, 0.f, 0.f, 0.f}; }
#pragma unroll
          for (int s = 0; s < 4; ++s) { const bf16x8 xb = __builtin_bit_cast(bf16x8, *(const LAS u32x4*)(L + GR_XC + t * 256 + (((4 * s + q) ^ (t & 15)) << 4)));
#pragma unroll
              for (int n = 0; n < 4; ++n) { const int j = 64 * jh + 16 * n + r;
                  const bf16x8 wr = __builtin_bit_cast(bf16x8, *(const LAS u32x4*)(L + GR_WGT + j * 256 + (((4 * s + q) ^ (j & 15)) << 4)));
                  const bf16x8 wi = __builtin_bit_cast(bf16x8, *(const LAS u32x4*)(L + GR_WGT + 32768 + j * 256 + (((4 * s + q) ^ (j & 15)) << 4)));
                  ar[n] = __builtin_amdgcn_mfma_f32_16x16x32_bf16(wr, xb, ar[n], 0, 0, 0); ai[n] = __builtin_amdgcn_mfma_f32_16x16x32_bf16(wi, xb, ai[n], 0, 0, 0); } }
#pragma unroll
          for (int n = 0; n < 4; ++n) { const int j0 = 64 * jh + 16 * n + 4 * q;
              const f32x4 br = *(const LAS f32x4*)(GB + j0), bi = *(const LAS f32x4*)(GB + 128 + j0), sp = *(const LAS f32x4*)(GB + 256 + j0);
              const u32x2 xw = *(const LAS u32x2*)(L + GR_XC + t * 256 + ((((j0 >> 3) ^ (t & 15)) << 4) + (j0 & 7) * 2));
              const float xc[4] = {bflo(xw.x), bfhi(xw.x), bflo(xw.y), bfhi(xw.y)};
              f32x4 av; float uv[4];
#pragma unroll
              for (int i = 0; i < 4; ++i) { const float rr = fast_sigmoid(ar[n][i] + br[i]), ii = fast_sigmoid(ai[n][i] + bi[i]);
                  const float a = __expf(-8.f * rr * sp[i]); av[i] = a; uv[i] = __builtin_amdgcn_sqrtf(fmaxf(1.f - a * a, 0.f)) * (ii * xc[i]); }
              *(LAS f32x4*)(A_ + t * 132 + j0) = av; u32x2 uo; uo.x = pk2(uv[0], uv[1]); uo.y = pk2(uv[2], uv[3]); *(LAS u32x2*)(U_ + t * 132 + j0) = uo; } }
        __syncthreads();
        const int j = tid & 127, seg = tid >> 7;
        float hl[16], pl[16];
        { float aa = 1.f, hh = 0.f;
#pragma unroll
          for (int i = 0; i < 16; ++i) { const int t = seg * 16 + i; const float a = A_[t * 132 + j], u = bf2f(U_[t * 132 + j]); hh = a * hh + u; aa *= a; hl[i] = hh; pl[i] = aa; }
          SEG[seg * 128 + j] = aa; SEG[512 + seg * 128 + j] = hh; }
        __syncthreads();
        { float hin = 0.f, pin = 1.f;
          for (int sgi = 0; sgi < seg; ++sgi) { const float sa = SEG[sgi * 128 + j]; hin = sa * hin + SEG[512 + sgi * 128 + j]; pin *= sa; }
#pragma unroll
          for (int i = 0; i < 16; ++i) { const int t = seg * 16 + i; A_[t * 132 + j] = hl[i] + pl[i] * hin; U_[t * 132 + j] = (bf16_t)f2bf(pl[i] * pin); }
          if (seg == 3) { const size_t e = ((size_t)b * 128 + tile) * 1024 + g * 128 + j; AGA[e] = pl[15] * pin; AGH[e] = hl[15] + pl[15] * hin; } }
        __syncthreads();
        { const int co = tid & 15, tp = tid >> 4;
#pragma unroll
          for (int tl = 0; tl < 2; ++tl) { const int t = 2 * tp + tl;
              const f32x4 h0 = *(const LAS f32x4*)(A_ + t * 132 + co * 8), h1 = *(const LAS f32x4*)(A_ + t * 132 + co * 8 + 4);
              const u32x2 pa = *(const LAS u32x2*)(U_ + t * 132 + co * 8), pb = *(const LAS u32x2*)(U_ + t * 132 + co * 8 + 4);
              const u32x4 gw = gpre[tl];
              const float g0 = gelu_tanh(bflo(gw.x)), g1 = gelu_tanh(bfhi(gw.x)), g2 = gelu_tanh(bflo(gw.y)), g3 = gelu_tanh(bfhi(gw.y));
              const float g4 = gelu_tanh(bflo(gw.z)), g5 = gelu_tanh(bfhi(gw.z)), g6 = gelu_tanh(bflo(gw.w)), g7 = gelu_tanh(bfhi(gw.w));
              u32x4 o; o.x = pk2(g0 * h0.x, g1 * h0.y); o.y = pk2(g2 * h0.z, g3 * h0.w); o.z = pk2(g4 * h1.x, g5 * h1.y); o.w = pk2(g6 * h1.z, g7 * h1.w);
              u32x4 q; q.x = pk2(g0 * bflo(pa.x), g1 * bfhi(pa.x)); q.y = pk2(g2 * bflo(pa.y), g3 * bfhi(pa.y)); q.z = pk2(g4 * bflo(pb.x), g5 * bfhi(pb.x)); q.w = pk2(g6 * bflo(pb.y), g7 * bfhi(pb.y));
              *(u32x4*)(yout + (row0 + t) * DM + g * 128 + co * 8) = o; *(u32x4*)(ypout + (row0 + t) * DM + g * 128 + co * 8) = q; } }
    }
#undef GR_XLOAD
}
__device__ __forceinline__ void ph_carry(const Params& p, const Ctx& c) {
    const float* AGA = (const float*)(p.ws + WS_AGG); const float* AGH = AGA + BATCH * 128 * 1024; float* CAR = (float*)(AGH + BATCH * 128 * 1024);
    for (int idx = c.gtid; idx < BATCH * 1024; idx += c.gthreads) { const int b = idx >> 10, ch = idx & 1023; float cy = 0.f;
        for (int t0 = 0; t0 < 128; t0 += 8) { float a[8], h[8];
#pragma unroll
            for (int k = 0; k < 8; ++k) { const size_t e = ((size_t)b * 128 + t0 + k) * 1024 + ch; a[k] = AGA[e]; h[k] = AGH[e]; }
            asm volatile("" ::: "memory");
#pragma unroll
            for (int k = 0; k < 8; ++k) { CAR[((size_t)b * 128 + t0 + k) * 1024 + ch] = cy; cy = a[k] * cy + h[k]; } } }
}
__device__ __forceinline__ void ph_gr_fix(const Params& p, const Ctx& c) {
    bf16_t* y = (bf16_t*)(p.ws + WS_ACT); const bf16_t* y0 = (const bf16_t*)(p.ws + WS_Y0); const bf16_t* yp = (const bf16_t*)((const unsigned char*)p.out + 64 * MiB);
    const float* CAR = (const float*)(p.ws + WS_AGG) + 2 * BATCH * 128 * 1024;
#pragma unroll 2
    for (size_t idx = c.gtid; idx < (size_t)M * 128; idx += c.gthreads) { const int cg = (int)(idx & 127); const size_t row = idx >> 7; const int b = (int)(row >> 13), tile = (int)((row & 8191) >> 6);
        const float* cr = CAR + ((size_t)b * 128 + tile) * 1024 + cg * 8; const f32x4 c0 = *(const f32x4*)cr, c1 = *(const f32x4*)(cr + 4);
        const u32x4 a = *(const u32x4*)(y0 + row * DM + cg * 8), q = *(const u32x4*)(yp + row * DM + cg * 8);
        u32x4 o; o.x = pk2(bflo(a.x) + bflo(q.x) * c0.x, bfhi(a.x) + bfhi(q.x) * c0.y); o.y = pk2(bflo(a.y) + bflo(q.y) * c0.z, bfhi(a.y) + bfhi(q.y) * c0.w);
        o.z = pk2(bflo(a.z) + bflo(q.z) * c1.x, bfhi(a.z) + bfhi(q.z) * c1.y); o.w = pk2(bflo(a.w) + bflo(q.w) * c1.z, bfhi(a.w) + bfhi(q.w) * c1.w);
        *(u32x4*)(y + row * DM + cg * 8) = o; }
}
__device__ __forceinline__ void cvt_gate_weights(const Params& p, const Ctx& c) {
    bf16_t* wg = (bf16_t*)(p.ws + WS_WG);
    for (int idx = c.gtid; idx < 2 * 8 * 16 * 128; idx += c.gthreads) { const int j = idx & 127, io = (idx >> 7) & 15, g = (idx >> 11) & 7, gate = idx >> 14;
        const float* s = (gate ? p.c_w_igate : p.c_w_rgate) + (size_t)g * 16384 + (io * 8) * 128 + j;
        u32x4 w; w.x = pk2(s[0], s[128]); w.y = pk2(s[256], s[384]); w.z = pk2(s[512], s[640]); w.w = pk2(s[768], s[896]);
        *(u32x4*)(wg + ((size_t)(gate * 8 + g) * 128 + j) * 128 + io * 8) = w; }
}


constexpr size_t WS_SK = 25 * MiB;
constexpr int TK_SK = 0, TK_Q = 69632, TK_S = 86528, TK_L = 119552  , TK_O = 135936, TK_TAB = 144128;
typedef int i32x4 __attribute__((ext_vector_type(4)));
__device__ __forceinline__ int key_xform(int b) { return b ^ ((b >> 31) & 0x7fffffff); }
#define CEX(a, b) do { const int hi_ = max((a), (b)), lo_ = min((a), (b)); (a) = hi_; (b) = lo_; } while (0)
__device__ __forceinline__ void bitonic_merge16_desc(int (&v)[16]) {
#pragma unroll
    for (int j = 8; j >= 1; j >>= 1)
#pragma unroll
        for (int i = 0; i < 16; ++i) if ((i & j) == 0) CEX(v[i], v[i | j]);
}
__device__ __forceinline__ void bitonic_sort16_desc(int (&v)[16]) {
#pragma unroll
    for (int k = 2; k <= 16; k <<= 1)
#pragma unroll
        for (int j = k >> 1; j >= 1; j >>= 1)
#pragma unroll
            for (int i = 0; i < 16; ++i) { const int l = i ^ j; if (l > i) { if ((i & k) == 0 || k == 16) CEX(v[i], v[l]); else CEX(v[l], v[i]); } }
}
__device__ __forceinline__ void ph_topk(const Params& p, int layer, const Ctx& c) {
    LAS unsigned char* L = c.lds; const bf16_t* Q = (const bf16_t*)(p.ws + WS_PROJ);
    int* ids = (int*)(p.ws + WS_IDS); float* gg = (float*)(p.ws + WS_G);
    const int tid = c.tid, lane = c.lane, w = c.wave, r = lane & 15, qq = lane >> 4, h = c.blk & 7;
    LAS float* S = (LAS float*)(L + TK_S); LAS int* LST = (LAS int*)(L + TK_L); LAS int* OUTK = (LAS int*)(L + TK_O); LAS int* TAB = (LAS int*)(L + TK_TAB);
    __syncthreads();
    { const bf16_t* sk = (const bf16_t*)(p.ws + WS_SK) + ((size_t)layer * 8 + h) * 2 * 128 * 128;
      for (int ch = tid; ch < 4096; ch += NTHREADS) { const int row = ch >> 4, cc = ch & 15;
          *(LAS u32x4*)(L + TK_SK + row * 272 + cc * 16) = *(const u32x4*)(sk + (size_t)row * 128 + cc * 8); }
      if (tid < 64) { int cnt = 0, code = -1;
          for (int i = 0; i < 16; ++i) for (int j = 0; j < 16 / (i + 1); ++j) { if (cnt == tid) code = i * 16 + j; ++cnt; }
          TAB[tid] = code; } }
    const int nslot = M / 32, sstep = c.nblk >> 3;
    u32x4 qpre[2];
#define TK_QLOAD(sl_) do { _Pragma("unroll") for (int k = 0; k < 2; ++k) { const int idx = tid + NTHREADS * k, row = idx >> 5, ch = idx & 31; \
        qpre[k] = *(const u32x4*)(Q + (size_t)(min((sl_), nslot - 1) * 32 + row) * 2048 + h * 256 + ch * 8); } } while (0)
#define TK_MERGE(CTRL) do { int o_[16]; _Pragma("unroll") for (int i = 0; i < 16; ++i) o_[i] = __builtin_amdgcn_update_dpp(0, v[15 - i], (CTRL), 0xf, 0xf, false); \
        _Pragma("unroll") for (int i = 0; i < 16; ++i) v[i] = max(v[i], o_[i]); bitonic_merge16_desc(v); } while (0)
    TK_QLOAD(c.blk >> 3);
    int gfirst = 0, gi = 0;
    for (int slot = c.blk >> 3; slot < nslot; slot += sstep) {
        __syncthreads();
#pragma unroll
        for (int k = 0; k < 2; ++k) { const int idx = tid + NTHREADS * k, row = idx >> 5, ch = idx & 31; *(LAS u32x4*)(L + TK_Q + row * 528 + ch * 16) = qpre[k]; }
        TK_QLOAD(slot + sstep);
        __syncthreads();
        { const int pp = w >> 2, mt = (w >> 1) & 1, nh = w & 1;
          f32x4 acc[4];
#pragma unroll
          for (int nt = 0; nt < 4; ++nt) acc[nt] = (f32x4){0.f, 0.f, 0.f, 0.f};
#pragma unroll
          for (int s2 = 0; s2 < 4; ++s2) { const bf16x8 af = __builtin_bit_cast(bf16x8, *(const LAS u32x4*)(L + TK_Q + (16 * mt + r) * 528 + (pp * 128 + 32 * s2 + 8 * qq) * 2));
#pragma unroll
              for (int nt = 0; nt < 4; ++nt) { const bf16x8 bfr = __builtin_bit_cast(bf16x8, *(const LAS u32x4*)(L + TK_SK + (pp * 128 + 16 * (4 * nh + nt) + r) * 272 + (32 * s2 + 8 * qq) * 2));
                  acc[nt] = __builtin_amdgcn_mfma_f32_16x16x32_bf16(af, bfr, acc[nt], 0, 0, 0); } }
#pragma unroll
          for (int nt = 0; nt < 4; ++nt)
#pragma unroll
              for (int i = 0; i < 4; ++i) S[(pp * 32 + 16 * mt + 4 * qq + i) * 129 + 16 * (4 * nh + nt) + r] = acc[nt][i]; }
        __syncthreads();
        {
          const int m = tid >> 4, sub = tid & 15, pp = sub >> 3, part = sub & 7; int v[16];
#pragma unroll
          for (int k = 0; k < 16; ++k) { const int n = 8 * k + part; v[k] = key_xform((__builtin_bit_cast(int, S[(pp * 32 + m) * 129 + n]) & ~127) | n); }
          bitonic_sort16_desc(v);
          TK_MERGE(0xB1);
          TK_MERGE(0x4E);
          TK_MERGE(0x141);
          if (part == 0) {
#pragma unroll
              for (int k = 0; k < 16; ++k) LST[((gi * 32 + m) * 2 + pp) * 16 + k] = key_xform(v[k]); } }
        if (gi == 0) gfirst = slot;
        ++gi;
        if (gi < 4 && slot + sstep < nslot) continue;
        __syncthreads();
        {
          const int tq = tid >> 2, sub = tid & 3, grp = tq >> 5, m = tq & 31;
          if (grp < gi) {
              const int slot_g = gfirst + grp * sstep;
              LAS const int* L1 = LST + (tq * 2 + 0) * 16; LAS const int* L2 = LST + (tq * 2 + 1) * 16;
              int v[16];
#pragma unroll
              for (int k = 0; k < 16; ++k) { const int ci = sub * 16 + k; const int code = TAB[ci]; int key = (int)0x80000000;
                  if (code >= 0) { const float s1 = __builtin_bit_cast(float, L1[code >> 4] & ~127), s2v = __builtin_bit_cast(float, L2[code & 15] & ~127);
                      key = key_xform((__builtin_bit_cast(int, s1 + s2v) & ~63) | (63 - ci)); }
                  v[k] = key; }
              bitonic_sort16_desc(v);
              TK_MERGE(0xB1); TK_MERGE(0x4E);
              const float smax = __builtin_bit_cast(float, key_xform(v[0]) & ~63);
              if (sub == 0) {
#pragma unroll
                  for (int k4 = 0; k4 < 4; ++k4) *(LAS i32x4*)(OUTK + tq * 16 + 4 * k4) = (i32x4){v[4 * k4], v[4 * k4 + 1], v[4 * k4 + 2], v[4 * k4 + 3]}; }
              asm volatile("s_waitcnt lgkmcnt(0)" ::: "memory");
              const i32x4 mine = *(const LAS i32x4*)(OUTK + tq * 16 + 4 * sub);
              float e[4]; int kb[4];
#pragma unroll
              for (int j = 0; j < 4; ++j) { kb[j] = key_xform(mine[j]); e[j] = __expf(__builtin_bit_cast(float, kb[j] & ~63) - smax); }
              float den = (e[0] + e[1]) + (e[2] + e[3]);
              den += __builtin_bit_cast(float, __builtin_amdgcn_update_dpp(0, __builtin_bit_cast(int, den), 0xB1, 0xf, 0xf, false));
              den += __builtin_bit_cast(float, __builtin_amdgcn_update_dpp(0, __builtin_bit_cast(int, den), 0x4E, 0xf, 0xf, false));
              const float rden = __builtin_amdgcn_rcpf(den); i32x4 oi; f32x4 og;
#pragma unroll
              for (int j = 0; j < 4; ++j) { const int code = TAB[63 - (kb[j] & 63)]; oi[j] = (L1[code >> 4] & 127) * 128 + (L2[code & 15] & 127); og[j] = e[j] * rden; }
              const size_t o = (size_t)(slot_g * 32 + m) * 128 + h * 16 + 4 * sub;
              *(i32x4*)(ids + o) = oi; *(f32x4*)(gg + o) = og; } }
        gi = 0;
    }
#undef TK_QLOAD
#undef TK_MERGE
}


__device__ __forceinline__ float wave_max(float v) {
#pragma unroll
    for (int o = 1; o < 64; o <<= 1) v = fmaxf(v, __shfl_xor(v, o));
    return v;
}
__device__ __forceinline__ void cvt_fp8_rows(const float* src, unsigned char* dst, float* scl, int nrows, const Ctx& c) {
    for (int row = c.gwave; row < nrows; row += c.gwaves) {
        const f32x4* sp = (const f32x4*)(src + (size_t)row * DM) + 4 * c.lane; f32x4 v[4]; float mx = 0.f;
#pragma unroll
        for (int j = 0; j < 4; ++j) { v[j] = sp[j]; mx = fmaxf(mx, fmaxf(fmaxf(fabsf(v[j].x), fabsf(v[j].y)), fmaxf(fabsf(v[j].z), fabsf(v[j].w)))); }
        mx = wave_max(mx);
        const float sc = mx > 0.f ? mx * (1.f / 416.f) : 1.f, inv = 1.f / sc;
        u32x4 w; int t;
        t = __builtin_amdgcn_cvt_pk_fp8_f32(v[0].x * inv, v[0].y * inv, 0, false); t = __builtin_amdgcn_cvt_pk_fp8_f32(v[0].z * inv, v[0].w * inv, t, true); w.x = (unsigned)t;
        t = __builtin_amdgcn_cvt_pk_fp8_f32(v[1].x * inv, v[1].y * inv, 0, false); t = __builtin_amdgcn_cvt_pk_fp8_f32(v[1].z * inv, v[1].w * inv, t, true); w.y = (unsigned)t;
        t = __builtin_amdgcn_cvt_pk_fp8_f32(v[2].x * inv, v[2].y * inv, 0, false); t = __builtin_amdgcn_cvt_pk_fp8_f32(v[2].z * inv, v[2].w * inv, t, true); w.z = (unsigned)t;
        t = __builtin_amdgcn_cvt_pk_fp8_f32(v[3].x * inv, v[3].y * inv, 0, false); t = __builtin_amdgcn_cvt_pk_fp8_f32(v[3].z * inv, v[3].w * inv, t, true); w.w = (unsigned)t;
        *(u32x4*)(dst + (size_t)(c.lane >> 3) * NEXP * 128 + (size_t)row * 128 + (c.lane & 7) * 16) = w;
        if (c.lane == 0) scl[row] = sc;
    }
}
typedef float f32x2 __attribute__((ext_vector_type(2)));
__device__ __forceinline__ u32x2 fp8x4_to_bf16x4(unsigned w) {
    const f32x2 a = __builtin_amdgcn_cvt_pk_f32_fp8((int)w, false), b = __builtin_amdgcn_cvt_pk_f32_fp8((int)w, true);
    u32x2 o;
    asm("v_cvt_pk_bf16_f32 %0, %1, %2" : "=v"(o.x) : "v"(a.x), "v"(a.y));
    asm("v_cvt_pk_bf16_f32 %0, %1, %2" : "=v"(o.y) : "v"(b.x), "v"(b.y));
    return o;
}


constexpr size_t WS_PD = WS_S;
constexpr size_t WS_ACTB = WS_S + 224 * MiB;
struct XI { int xr, nx, jr, nloc; };
typedef long i64_t;
__device__ __forceinline__ i64_t pack64(unsigned lo, unsigned hi) { return (i64_t)(((unsigned long long)hi << 32) | lo); }
typedef int i32x8 __attribute__((ext_vector_type(8)));
#define PIN16(o) asm volatile("" : "+v"(o[0]), "+v"(o[1]), "+v"(o[2]), "+v"(o[3]), "+v"(o[4]), "+v"(o[5]), "+v"(o[6]), "+v"(o[7]), "+v"(o[8]), "+v"(o[9]), "+v"(o[10]), "+v"(o[11]), "+v"(o[12]), "+v"(o[13]), "+v"(o[14]), "+v"(o[15]))

constexpr size_t WS_ACT8 = WS_S + 224 * MiB;
constexpr size_t WS_SA = WS_S + 240 * MiB;
__device__ __forceinline__ void ph_peer_act2(const Params& p, int layer, const Ctx& c) {
    const bf16_t* PDh = (const bf16_t*)(p.ws + WS_PD); unsigned char* A8 = p.ws + WS_ACT8; float* SA = (float*)(p.ws + WS_SA);
    const float* SU = (const float*)(p.ws + WS_SCL) + (size_t)layer * 2 * NEXP; const float* SV = SU + NEXP;
    const int* ids = (const int*)(p.ws + WS_IDS); const float* gg = (const float*)(p.ws + WS_G);
    const int lane = c.lane;
    for (int t0 = c.gwave; t0 < M; t0 += 4 * c.gwaves) {
        float d0[4], d1[4], g0[4], g1[4], su0[4], su1[4], sv0[4], sv1[4]; int id0[4], id1[4];
#pragma unroll
        for (int u = 0; u < 4; ++u) { const int t = min(t0 + u * c.gwaves, M - 1); id0[u] = ids[(size_t)t * 128 + lane]; id1[u] = ids[(size_t)t * 128 + 64 + lane]; g0[u] = gg[(size_t)t * 128 + lane]; g1[u] = gg[(size_t)t * 128 + 64 + lane]; }
#pragma unroll
        for (int u = 0; u < 4; ++u) { const int t = min(t0 + u * c.gwaves, M - 1); d0[u] = 0.f; d1[u] = 0.f;
#pragma unroll
            for (int sl = 0; sl < 8; ++sl) { d0[u] += bf2f(PDh[((size_t)sl * M + t) * 128 + lane]); d1[u] += bf2f(PDh[((size_t)sl * M + t) * 128 + 64 + lane]); } }
#pragma unroll
        for (int u = 0; u < 4; ++u) { su0[u] = SU[id0[u]]; su1[u] = SU[id1[u]]; sv0[u] = SV[id0[u]]; sv1[u] = SV[id1[u]]; }
#pragma unroll
        for (int u = 0; u < 4; ++u) { const int t = t0 + u * c.gwaves; if (t >= M) break;
            const float a0 = gelu_tanh(d0[u] * su0[u]) * g0[u] * sv0[u], a1 = gelu_tanh(d1[u] * su1[u]) * g1[u] * sv1[u];
            const float mx = wave_max(fmaxf(fabsf(a0), fabsf(a1)));
            const float sa = mx > 0.f ? mx * (1.f / 256.f) : 1.f, inv = 1.f / sa;
            const float b0 = a0 * inv, b1 = a1 * inv;
            const int hq = __builtin_amdgcn_cvt_pk_fp8_f32(b0, b1, 0, false);
            const f32x2 hd = __builtin_amdgcn_cvt_pk_f32_fp8(hq, false);
            const int lq = __builtin_amdgcn_cvt_pk_fp8_f32((b0 - hd.x) * 16.f, (b1 - hd.y) * 16.f, 0, false);
            unsigned char* o = A8 + (size_t)t * 256;
            o[lane] = (unsigned char)(hq & 0xff); o[64 + lane] = (unsigned char)((hq >> 8) & 0xff); o[128 + lane] = (unsigned char)(lq & 0xff); o[192 + lane] = (unsigned char)((lq >> 8) & 0xff);
            if (lane == 0) SA[t] = sa; }
    }
}
typedef int i32x2 __attribute__((ext_vector_type(2)));
__device__ __forceinline__ i32x2 lds_tr8(LAS const unsigned char* pb) { return __builtin_amdgcn_ds_read_tr8_b64_v2i32((LAS i32x2*)pb); }
__device__ __forceinline__ void ph_peer_v2(const Params& p, int layer, const Ctx& c, const XI xi, bf16_t* hdst, int idmask) {
    const unsigned char* VT = p.ws + WS_TAB8 + (size_t)layer * 2 * NEXP * DM + (size_t)NEXP * DM;
    const int* ids = (const int*)(p.ws + WS_IDS); const unsigned char* A8 = p.ws + WS_ACT8; const float* SA = (const float*)(p.ws + WS_SA);
    const int lane = c.lane, e8 = lane >> 3, cc = lane & 7, r = lane & 15, q = lane >> 4;
    const int tstep = xi.nloc * NWAVES;
    LAS unsigned char* img = c.lds + c.wave * 16384;
#pragma unroll 1
    for (int sl = xi.xr; sl < 8; sl += xi.nx) {
        const unsigned char* Vs = VT + (size_t)sl * NEXP * 128; const unsigned vo = 16u * (unsigned)cc;
        int t = xi.jr * NWAVES + c.wave;
        if (t >= M) continue;
#define PV_LD(k) (*(const u32x4*)(Vs + (((unsigned)((k) & (idmask & 0xffff)) << 7) + vo)))
#define PV_ROWS(dst, ia, ib) do { dst[0] = PV_LD((ia).x); dst[1] = PV_LD((ia).y); dst[2] = PV_LD((ia).z); dst[3] = PV_LD((ia).w); dst[4] = PV_LD((ib).x); dst[5] = PV_LD((ib).y); dst[6] = PV_LD((ib).z); dst[7] = PV_LD((ib).w); } while (0)
#define PV_IMG(src, half) do { _Pragma("unroll") for (int j = 0; j < 8; ++j) *(LAS u32x4*)(img + (64 * (half) + 8 * e8 + j) * 128 + ((cc ^ j) << 4)) = src[j]; } while (0)
        u32x4 v[8], vn[8];
        { const i32x4* ip = (const i32x4*)(ids + (size_t)t * 128 + 8 * e8); const i32x4 i0 = ip[0], i1 = ip[1], i2 = ip[16], i3 = ip[17]; PV_ROWS(v, i0, i1); PV_ROWS(vn, i2, i3); }
#pragma unroll 1
        for (; t < M; t += tstep) {
            const int tn = min(t + tstep, M - 1);
            const i32x4* ipn = (const i32x4*)(ids + (size_t)tn * 128 + 8 * e8); const i32x4 in0 = ipn[0], in1 = ipn[1], in2 = ipn[16], in3 = ipn[17];
            const u32x4* ap = (const u32x4*)(A8 + (size_t)t * 256 + 32 * q); const u32x4 ah0 = ap[0], ah1 = ap[1], al0 = ap[8], al1 = ap[9];
            const float sa = SA[t];
            const size_t ho = (size_t)t * DM + 128 * sl + 32 * q + ((r & 1) ? 15 + r : r);
            const unsigned hw = *(const unsigned*)(p.hb + ho);
            PV_IMG(v, 0); PV_IMG(vn, 1);
            PV_ROWS(v, in0, in1); PV_ROWS(vn, in2, in3);
            asm volatile("" ::: "memory");
            const i32x8 ahv = {(int)ah0.x, (int)ah0.y, (int)ah0.z, (int)ah0.w, (int)ah1.x, (int)ah1.y, (int)ah1.z, (int)ah1.w};
            const i32x8 alv = {(int)al0.x, (int)al0.y, (int)al0.z, (int)al0.w, (int)al1.x, (int)al1.y, (int)al1.z, (int)al1.w};
            float oa = 0.f, ob = 0.f;
#pragma unroll
            for (int dt = 0; dt < 8; ++dt) {
                i32x8 bw;
#pragma unroll
                for (int i4 = 0; i4 < 4; ++i4) { const int row = 32 * q + 8 * i4 + (r >> 1);
                    const i32x2 tv = lds_tr8(img + row * 128 + ((dt ^ (row & 7)) << 4) + 8 * (r & 1)); bw[2 * i4] = tv.x; bw[2 * i4 + 1] = tv.y; }
                f32x4 ch = {0.f, 0.f, 0.f, 0.f}, cl = {0.f, 0.f, 0.f, 0.f};
                ch = __builtin_amdgcn_mfma_scale_f32_16x16x128_f8f6f4(ahv, bw, ch, 0, 0, 0, 0, 0, 0); cl = __builtin_amdgcn_mfma_scale_f32_16x16x128_f8f6f4(alv, bw, cl, 0, 0, 0, 0, 0, 0);
                const float od = ch[0] + cl[0] * 0.0625f;
                oa = (dt == 2 * q) ? od : oa; ob = (dt == 2 * q + 1) ? od : ob; }
            { const float snd = (r & 1) ? oa : ob, rcv = __shfl_xor(snd, 1);
              const float e0 = (r & 1) ? rcv : oa, e1 = (r & 1) ? ob : rcv;
              *(unsigned*)(hdst + ho) = pk2(bflo(hw) + e0 * sa, bfhi(hw) + e1 * sa); }
            asm volatile("" ::: "memory");
        }
#undef PV_LD
#undef PV_ROWS
#undef PV_IMG
    }
}

__device__ __forceinline__ void ph_peer_u2(const Params& p, int layer, const Ctx& c, const XI xi, int idmask) {
    const unsigned char* X8 = (const unsigned char*)p.out; const unsigned char* UT = p.ws + WS_TAB8 + (size_t)layer * 2 * NEXP * DM;
    const int* ids = (const int*)(p.ws + WS_IDS); bf16_t* PDh = (bf16_t*)(p.ws + WS_PD);
    const int lane = c.lane, e8 = lane >> 3, cc = lane & 7, r = lane & 15, q = lane >> 4;
    const int tstep = xi.nloc * NWAVES;
    LAS unsigned char* img = c.lds + c.wave * 16384; LAS float* stg = (LAS float*)(c.lds + 131072 + c.wave * 512);
#pragma unroll 1
    for (int sl = xi.xr; sl < 8; sl += xi.nx) {
        const unsigned char* Us = UT + (size_t)sl * NEXP * 128; const unsigned uo = 16u * (unsigned)cc;
        int t = xi.jr * NWAVES + c.wave;
        if (t >= M) continue;
#define PU_LD(k) (*(const u32x4*)(Us + (((unsigned)((k) & (idmask & 0xffff)) << 7) + uo)))
#define PU_ROWS(dst, ia, ib) do { dst[0] = PU_LD((ia).x); dst[1] = PU_LD((ia).y); dst[2] = PU_LD((ia).z); dst[3] = PU_LD((ia).w); dst[4] = PU_LD((ib).x); dst[5] = PU_LD((ib).y); dst[6] = PU_LD((ib).z); dst[7] = PU_LD((ib).w); } while (0)
#define PU_IMG(src, half) do { _Pragma("unroll") for (int j = 0; j < 8; ++j) *(LAS u32x4*)(img + (64 * (half) + 8 * e8 + j) * 128 + ((cc ^ j) << 4)) = src[j]; } while (0)
        u32x4 v[8], vn[8];
        { const i32x4* ip = (const i32x4*)(ids + (size_t)t * 128 + 8 * e8); const i32x4 i0 = ip[0], i1 = ip[1], i2 = ip[16], i3 = ip[17]; PU_ROWS(v, i0, i1); PU_ROWS(vn, i2, i3); }
#pragma unroll 1
        for (; t < M; t += tstep) {
            const int tn = min(t + tstep, M - 1);
            const i32x4* ipn = (const i32x4*)(ids + (size_t)tn * 128 + 8 * e8); const i32x4 in0 = ipn[0], in1 = ipn[1], in2 = ipn[16], in3 = ipn[17];
            const u32x4* xp = (const u32x4*)(X8 + (size_t)t * 2048 + 128 * sl + 32 * q); const u32x4 xh0 = xp[0], xh1 = xp[1], xl0 = xp[64], xl1 = xp[65];
            PU_IMG(v, 0); PU_IMG(vn, 1);
            PU_ROWS(v, in0, in1); PU_ROWS(vn, in2, in3);
            asm volatile("" ::: "memory");
            const i32x8 xh = {(int)xh0.x, (int)xh0.y, (int)xh0.z, (int)xh0.w, (int)xh1.x, (int)xh1.y, (int)xh1.z, (int)xh1.w};
            const i32x8 xl = {(int)xl0.x, (int)xl0.y, (int)xl0.z, (int)xl0.w, (int)xl1.x, (int)xl1.y, (int)xl1.z, (int)xl1.w};
#pragma unroll
            for (int g = 0; g < 8; ++g) { const int row = 16 * g + r;
                const u32x4 w0 = *(const LAS u32x4*)(img + row * 128 + (((2 * q) ^ (row & 7)) << 4)), w1 = *(const LAS u32x4*)(img + row * 128 + (((2 * q + 1) ^ (row & 7)) << 4));
                const i32x8 aw = {(int)w0.x, (int)w0.y, (int)w0.z, (int)w0.w, (int)w1.x, (int)w1.y, (int)w1.z, (int)w1.w};
                f32x4 ah = {0.f, 0.f, 0.f, 0.f}, al = {0.f, 0.f, 0.f, 0.f};
                ah = __builtin_amdgcn_mfma_scale_f32_16x16x128_f8f6f4(aw, xh, ah, 0, 0, 0, 0, 0, 0); al = __builtin_amdgcn_mfma_scale_f32_16x16x128_f8f6f4(aw, xl, al, 0, 0, 0, 0, 0, 0);
                if (r == 0) *(LAS f32x4*)(stg + 16 * g + 4 * q) = ah + al * 0.0625f; }
            asm volatile("" ::: "memory");
            { const f32x2 pv = *(const LAS f32x2*)(stg + 2 * lane); *(unsigned*)(PDh + ((size_t)sl * M + t) * 128 + 2 * lane) = pk2(pv.x, pv.y); }
            asm volatile("" ::: "memory");
        }
#undef PU_LD
#undef PU_ROWS
#undef PU_IMG
    }
}

#define XB_TMO      128
#define XB_XCNT(j)  (256  + 64 * (j))
#define XB_XSUB(j)  (1280 + 64 * (j))
#define XB_XGEN(j)  (2304 + 64 * (j))
#define XB_TOP      3328
#define XB_TOPGEN   3392
#define XCD_BAR_WORDS 3456
#define XB_SPIN_CAP (1u << 18)

__device__ __forceinline__ unsigned xb_ld(unsigned* p)              { return __hip_atomic_load(p, __ATOMIC_RELAXED, __HIP_MEMORY_SCOPE_AGENT); }
__device__ __forceinline__ unsigned xb_add(unsigned* p, unsigned v) { return __hip_atomic_fetch_add(p, v, __ATOMIC_RELAXED, __HIP_MEMORY_SCOPE_AGENT); }
__device__ __forceinline__ unsigned xb_xcc_id() { return (unsigned)__builtin_amdgcn_s_getreg((3 << 11) | 20) & 0xFu; }
#define XB_SPIN(cond, bar) do { unsigned _sp = 0; while (cond) { __builtin_amdgcn_s_sleep(1); \
    if ((++_sp & 255u) == 0u) { if (xb_ld(&(bar)[XB_TMO])) break; if (_sp > XB_SPIN_CAP) { atomicAdd(&(bar)[XB_TMO], 1u); break; } } } } while (0)

struct XcdBarrier {
    unsigned* bar; unsigned x;
    volatile LAS unsigned* st;
};

__device__ __forceinline__ XcdBarrier xcd_barrier_post(unsigned* bar, volatile LAS unsigned* st) {
    XcdBarrier b; b.bar = bar; b.x = xb_xcc_id(); b.st = st;
    if (threadIdx.x == 0) (void)xb_add(&bar[XB_XCNT(b.x)], 1u);
    return b;
}
__device__ __forceinline__ void xcd_barrier_complete(unsigned* bar, unsigned x, unsigned& nloc, unsigned& nx) {
    const unsigned G = gridDim.x * gridDim.y * gridDim.z;
    unsigned sum, cnt, mine, sp = 0u;
    for (;;) {
        sum = 0u; cnt = 0u; mine = 0u;
#pragma unroll
        for (unsigned j = 0; j < 16; ++j) { const unsigned c = xb_ld(&bar[XB_XCNT(j)]); sum += c; cnt += (c > 0u) ? 1u : 0u; mine = (j == x) ? c : mine; }
        if (sum == G) break;
        __builtin_amdgcn_s_sleep(1);
        if ((++sp & 255u) == 0u) { if (xb_ld(&bar[XB_TMO])) break; if (sp > XB_SPIN_CAP) { atomicAdd(&bar[XB_TMO], 1u); break; } }
    }
    nloc = mine > 0u ? mine : 1u; nx = cnt > 0u ? cnt : 1u;
}

__device__ __forceinline__ void xcd_barrier(const XcdBarrier& b) {
    asm volatile("s_waitcnt vmcnt(0)" ::: "memory");
    __syncthreads();
    if (threadIdx.x == 0) {
        unsigned* bar = b.bar;
        __builtin_amdgcn_s_waitcnt(0);
        unsigned nloc = b.st[0], nx = b.st[1];
        if (nloc == 0u) { xcd_barrier_complete(bar, b.x, nloc, nx); b.st[0] = nloc; b.st[1] = nx; }
        const unsigned old = xb_add(&bar[XB_XSUB(b.x)], 1u);
        const unsigned gen = old / nloc;
        if (old + 1u == (gen + 1u) * nloc) {
            __builtin_amdgcn_fence(__ATOMIC_RELEASE, "agent");
            asm volatile("s_waitcnt vmcnt(0)" ::: "memory");
            const unsigned og = xb_add(&bar[XB_TOP], 1u);
            const unsigned tg = og / nx;
            if (og + 1u == (tg + 1u) * nx) xb_add(&bar[XB_TOPGEN], 1u);
            else XB_SPIN(xb_ld(&bar[XB_TOPGEN]) == tg, bar);
            __builtin_amdgcn_fence(__ATOMIC_ACQUIRE, "agent");
            xb_add(&bar[XB_XGEN(b.x)], 1u);
            asm volatile("s_waitcnt vmcnt(0)" ::: "memory");
        } else {
            XB_SPIN(xb_ld(&bar[XB_XGEN(b.x)]) == gen, bar);
            __builtin_amdgcn_fence(__ATOMIC_ACQUIRE, "agent");
            asm volatile("s_waitcnt vmcnt(0)" ::: "memory");
        }
    }
    __syncthreads();
}

enum Phase { PH_PRO = 0, PH_GEMM_IN0, PH_MIXER0, PH_GLA_B, PH_GLA_C, PH_MIX0, PH_GEMM_OUT0, PH_NORM_F0, PH_GEMM_Q0, PH_TOPK1_0, PH_PU0, PH_PA0, PH_PV0,
             PH_NORM_M1, PH_GEMM_CIN, PH_G1, PH_G2, PH_G3, PH_GEMM_OUT1, PH_NORM_F1, PH_GEMM_Q1, PH_TOPK1_1, PH_PU1, PH_PA1, PH_PV1, PH_FINAL, NPHASES };

#ifndef PH_ONLY
#define PH_ONLY (-1)
#endif
#define PH_ENABLED(x) (PH_ONLY < 0 || PH_ONLY == (x))
#ifndef MK_N_LAUNCHES
#define MK_N_LAUNCHES 1
#endif

template <class Epi> __device__ __forceinline__ void run_gemm(const Ctx& c, const bf16_t* A, const bf16_t* Bt, int N, const Epi& E, int vblk) {
    pg8::Gemm g{A, Bt, M, N, DM}; pg8::StaticOrder S; S.init(M, N, c.nblk, vblk);
    pg8::gemm_phase<Epi, pg8::StaticOrder, true, true>(c.lds, g, S, E);
}

#define GATHER_CALL(l) ph_gather3(p, l, c, (rep_ + 1 < NREP(PH_GATHER##l)) ? (float*)(ws + WS_S) : p.out)
#ifndef PROBE_IDMASK
#define PROBE_IDMASK 0x3fff
#endif
#ifndef DUP_MASK
#define DUP_MASK 0u
#endif
#define NREP(k) ((((unsigned)(DUP_MASK) >> (k)) & 1u) ? 2 : 1)
#define GETXI() XI xi; { if (multi) { if (threadIdx.x == 0) { unsigned xr_ = 0; for (unsigned j_ = 0; j_ < bar.x; ++j_) xr_ += xb_ld(&ctl[CW_BAR + XB_XCNT(j_)]) > 0u ? 1u : 0u; MISC[11] = xr_; } __syncthreads(); \
    xi.nloc = (int)MISC[8]; xi.nx = (int)MISC[9]; xi.jr = (int)MISC[10]; xi.xr = (int)MISC[11]; if (xi.nloc < 1 || xi.nx < 1 || xi.nx > 8 || xi.jr >= xi.nloc || xi.xr >= xi.nx) { xi.xr = 0; xi.nx = 1; xi.jr = blockIdx.x; xi.nloc = gridDim.x; } } \
    else { xi.xr = 0; xi.nx = 1; xi.jr = blockIdx.x; xi.nloc = gridDim.x; } }
#define MKCTX() Ctx c; { int t_ = threadIdx.x; asm volatile("" : "+v"(t_)); c.lds = lds; c.tid = t_; c.lane = t_ & 63; c.wave = __builtin_amdgcn_readfirstlane(t_ >> 6); \
    c.blk = blockIdx.x; c.nblk = gridDim.x; c.gtid = c.blk * NTHREADS + c.tid; c.gthreads = c.nblk * NTHREADS; c.gwave = c.blk * NWAVES + c.wave; c.gwaves = c.nblk * NWAVES; }
__global__ void __launch_bounds__(NTHREADS, 2) mega_fwd(Params p) {
    extern __shared__ __attribute__((aligned(16))) unsigned char lds_raw[];
    volatile LAS unsigned* MISC = (volatile LAS unsigned*)((LAS unsigned char*)lds_raw + MISC_OFF);
    LAS unsigned char* const lds = (LAS unsigned char*)lds_raw;
    for (int u = threadIdx.x; u < (LDS_BYTES - LDSCTL_OFF) / 4; u += NTHREADS) ((LAS unsigned*)(lds + LDSCTL_OFF))[u] = 0u;
    __syncthreads();
    unsigned* ctl = (unsigned*)(p.ws + WS_CTL);
    XcdBarrier bar; bar.bar = ctl + CW_BAR; bar.x = 0; bar.st = nullptr;
    const bool multi = (p.ph_hi - p.ph_lo) > 1;
    if (multi) { bar = xcd_barrier_post(ctl + CW_BAR, MISC + 8); if (threadIdx.x == 0) MISC[10] = xb_add(&ctl[CW_RANK + 64 * bar.x], 1u); }
    unsigned char* ws = p.ws;
    bf16_t* ACT = (bf16_t*)(ws + WS_ACT); bf16_t* PROJ = (bf16_t*)(ws + WS_PROJ);

    const int lo = p.ph_lo, hi = p.ph_hi;
#define IN(k) (PH_ENABLED(k) && lo <= (k) && (k) < hi)
#define SEAM(k) do { if ((k) + 1 < hi) xcd_barrier(bar); } while (0)
    if (IN(PH_PRO)) { for (int rep_ = 0; rep_ < NREP(PH_PRO); ++rep_) { MKCTX();
        transpose_cvt(p.ab_w_in, DM, NIN, (bf16_t*)(ws + WS_WT_IN), NIN_PAD, [](int n) { return n < 1536 ? n : (n < 3072 ? n + 16 : (n < 3088 ? n - 3072 + 1536 : -1)); }, c.gtid, c.gthreads);
        transpose_cvt(p.ab_w_out, DM, DM, (bf16_t*)(ws + WS_WT_OUT), DM, [](int n) { return n; }, c.gtid, c.gthreads);
        transpose_cvt(p.c_w_in, DM, 2048, (bf16_t*)(ws + WS_WT_CIN), 2048, [](int n) { return n; }, c.gtid, c.gthreads);
        transpose_cvt(p.c_w_out, DM, DM, (bf16_t*)(ws + WS_WT_COUT), DM, [](int n) { return n; }, c.gtid, c.gthreads);
        transpose_cvt(p.peer_w_query, DM, 2048, (bf16_t*)(ws + WS_WT_Q0), 2048, [](int n) { return n; }, c.gtid, c.gthreads);
        transpose_cvt(p.peer_w_query + (size_t)DM * 2048, DM, 2048, (bf16_t*)(ws + WS_WT_Q1), 2048, [](int n) { return n; }, c.gtid, c.gthreads);
        cvt_fp8_rows(p.peer_u, ws + WS_TAB8, (float*)(ws + WS_SCL), NEXP, c);
        cvt_fp8_rows(p.peer_v, ws + WS_TAB8 + (size_t)NEXP * DM, (float*)(ws + WS_SCL) + NEXP, NEXP, c);
        cvt_gate_weights(p, c);
        cvt_bf16(p.peer_sub_keys, (bf16_t*)(ws + WS_SK), (size_t)2 * 8 * 2 * 128 * 128 / 8, c.gtid, c.gthreads);
        norm_rows_bf16(p.x, p.mix_norm, ACT, c);
        if (rep_ + 1 < NREP(PH_PRO)) xcd_barrier(bar); } SEAM(PH_PRO); }
    if (IN(PH_GEMM_IN0)) { for (int rep_ = 0; rep_ < NREP(PH_GEMM_IN0); ++rep_) { MKCTX();  ph_glr(p, c); pg8::EpiBf16<0> E{PROJ, NIN_PAD, nullptr, 0, 0, 1.f}; GETXI(); run_gemm(c, ACT, (const bf16_t*)(ws + WS_WT_IN), 3072, E, (xi.nx == 8 && xi.nloc * 8 == (int)gridDim.x) ? xi.jr * 8 + xi.xr : (int)blockIdx.x); if (rep_ + 1 < NREP(PH_GEMM_IN0)) xcd_barrier(bar); } SEAM(PH_GEMM_IN0); }
    if (IN(PH_MIXER0)) { for (int rep_ = 0; rep_ < NREP(PH_MIXER0); ++rep_) { MKCTX();  ph_gla_a(p, c); ph_attn(p, c); if (rep_ + 1 < NREP(PH_MIXER0)) xcd_barrier(bar); } SEAM(PH_MIXER0); }
    if (IN(PH_GLA_B)) { for (int rep_ = 0; rep_ < NREP(PH_GLA_B); ++rep_) { MKCTX();  ph_gla_b(p, c); if (rep_ + 1 < NREP(PH_GLA_B)) xcd_barrier(bar); } SEAM(PH_GLA_B); }
    if (IN(PH_GLA_C)) { for (int rep_ = 0; rep_ < NREP(PH_GLA_C); ++rep_) { MKCTX();  ph_gla_c(p, c); if (rep_ + 1 < NREP(PH_GLA_C)) xcd_barrier(bar); } SEAM(PH_GLA_C); }
    if (IN(PH_MIX0)) { for (int rep_ = 0; rep_ < NREP(PH_MIX0); ++rep_) { MKCTX();  ph_mix(p, c); if (rep_ + 1 < NREP(PH_MIX0)) xcd_barrier(bar); } SEAM(PH_MIX0); }
    if (IN(PH_GEMM_OUT0)) { for (int rep_ = 0; rep_ < NREP(PH_GEMM_OUT0); ++rep_) { MKCTX();  pg8::EpiResBf<true> E{p.x, p.hb, DM}; GETXI(); run_gemm(c, ACT, (const bf16_t*)(ws + WS_WT_OUT), DM, E, (xi.nx == 8 && xi.nloc * 8 == (int)gridDim.x) ? xi.jr * 8 + xi.xr : (int)blockIdx.x); if (rep_ + 1 < NREP(PH_GEMM_OUT0)) xcd_barrier(bar); } SEAM(PH_GEMM_OUT0); }
    if (IN(PH_NORM_F0)) { for (int rep_ = 0; rep_ < NREP(PH_NORM_F0); ++rep_) { MKCTX();  norm_rows_bf16(p.hb, p.ffn_norm, ACT, c, (unsigned char*)p.out); if (rep_ + 1 < NREP(PH_NORM_F0)) xcd_barrier(bar); } SEAM(PH_NORM_F0); }
    if (IN(PH_GEMM_Q0)) { for (int rep_ = 0; rep_ < NREP(PH_GEMM_Q0); ++rep_) { MKCTX();  pg8::EpiBf16<0> E{PROJ, 2048, nullptr, 0, 0, 1.f}; GETXI(); run_gemm(c, ACT, (const bf16_t*)(ws + WS_WT_Q0), 2048, E, (xi.nx == 8 && xi.nloc * 8 == (int)gridDim.x) ? xi.jr * 8 + xi.xr : (int)blockIdx.x); if (rep_ + 1 < NREP(PH_GEMM_Q0)) xcd_barrier(bar); } SEAM(PH_GEMM_Q0); }
    if (IN(PH_TOPK1_0)) { for (int rep_ = 0; rep_ < NREP(PH_TOPK1_0); ++rep_) { MKCTX();  ph_topk(p, 0, c); if (rep_ + 1 < NREP(PH_TOPK1_0)) xcd_barrier(bar); } SEAM(PH_TOPK1_0); }
    if (IN(PH_PU0)) { for (int rep_ = 0; rep_ < NREP(PH_PU0); ++rep_) { MKCTX();  GETXI(); ph_peer_u2(p, 0, c, xi, (rep_ + 1 < NREP(PH_PU0)) ? PROBE_IDMASK : 0x3fff); if (rep_ + 1 < NREP(PH_PU0)) xcd_barrier(bar); } SEAM(PH_PU0); }
    if (IN(PH_PA0)) { for (int rep_ = 0; rep_ < NREP(PH_PA0); ++rep_) { MKCTX();  ph_peer_act2(p, 0, c); if (rep_ + 1 < NREP(PH_PA0)) xcd_barrier(bar); } SEAM(PH_PA0); }
    if (IN(PH_PV0)) { for (int rep_ = 0; rep_ < NREP(PH_PV0); ++rep_) { MKCTX();  GETXI(); ph_peer_v2(p, 0, c, xi, (rep_ + 1 < NREP(PH_PV0)) ? (bf16_t*)(ws + WS_S) : p.hb, (rep_ + 1 < NREP(PH_PV0)) ? PROBE_IDMASK : 0x3fff); if (rep_ + 1 < NREP(PH_PV0)) xcd_barrier(bar); } SEAM(PH_PV0); }
    if (IN(PH_NORM_M1)) { for (int rep_ = 0; rep_ < NREP(PH_NORM_M1); ++rep_) { MKCTX();  norm_rows_bf16(p.hb, p.mix_norm + DM, ACT, c); if (rep_ + 1 < NREP(PH_NORM_M1)) xcd_barrier(bar); } SEAM(PH_NORM_M1); }
    if (IN(PH_GEMM_CIN)) { for (int rep_ = 0; rep_ < NREP(PH_GEMM_CIN); ++rep_) { MKCTX();  pg8::EpiBf16<0> E{PROJ, 2048, nullptr, 0, 0, 1.f}; GETXI(); run_gemm(c, ACT, (const bf16_t*)(ws + WS_WT_CIN), 2048, E, (xi.nx == 8 && xi.nloc * 8 == (int)gridDim.x) ? xi.jr * 8 + xi.xr : (int)blockIdx.x); if (rep_ + 1 < NREP(PH_GEMM_CIN)) xcd_barrier(bar); } SEAM(PH_GEMM_CIN); }
    if (IN(PH_G1)) { for (int rep_ = 0; rep_ < NREP(PH_G1); ++rep_) { MKCTX();  griffin_pass(p, c); if (rep_ + 1 < NREP(PH_G1)) xcd_barrier(bar); } SEAM(PH_G1); }
    if (IN(PH_G2)) { for (int rep_ = 0; rep_ < NREP(PH_G2); ++rep_) { MKCTX();  ph_carry(p, c); if (rep_ + 1 < NREP(PH_G2)) xcd_barrier(bar); } SEAM(PH_G2); }
    if (IN(PH_G3)) { for (int rep_ = 0; rep_ < NREP(PH_G3); ++rep_) { MKCTX();  ph_gr_fix(p, c); if (rep_ + 1 < NREP(PH_G3)) xcd_barrier(bar); } SEAM(PH_G3); }
    if (IN(PH_GEMM_OUT1)) { for (int rep_ = 0; rep_ < NREP(PH_GEMM_OUT1); ++rep_) { MKCTX();  pg8::EpiResBf<false> E{p.hb, p.hb, DM}; GETXI(); run_gemm(c, ACT, (const bf16_t*)(ws + WS_WT_COUT), DM, E, (xi.nx == 8 && xi.nloc * 8 == (int)gridDim.x) ? xi.jr * 8 + xi.xr : (int)blockIdx.x); if (rep_ + 1 < NREP(PH_GEMM_OUT1)) xcd_barrier(bar); } SEAM(PH_GEMM_OUT1); }
    if (IN(PH_NORM_F1)) { for (int rep_ = 0; rep_ < NREP(PH_NORM_F1); ++rep_) { MKCTX();
        norm_rows_bf16(p.hb, p.ffn_norm + DM, ACT, c, (unsigned char*)p.out);
        cvt_fp8_rows(p.peer_u + (size_t)NEXP * DM, ws + WS_TAB8 + (size_t)2 * NEXP * DM, (float*)(ws + WS_SCL) + 2 * NEXP, NEXP, c);
        cvt_fp8_rows(p.peer_v + (size_t)NEXP * DM, ws + WS_TAB8 + (size_t)3 * NEXP * DM, (float*)(ws + WS_SCL) + 3 * NEXP, NEXP, c);
        if (rep_ + 1 < NREP(PH_NORM_F1)) xcd_barrier(bar); } SEAM(PH_NORM_F1); }
    if (IN(PH_GEMM_Q1)) { for (int rep_ = 0; rep_ < NREP(PH_GEMM_Q1); ++rep_) { MKCTX();  pg8::EpiBf16<0> E{PROJ, 2048, nullptr, 0, 0, 1.f}; GETXI(); run_gemm(c, ACT, (const bf16_t*)(ws + WS_WT_Q1), 2048, E, (xi.nx == 8 && xi.nloc * 8 == (int)gridDim.x) ? xi.jr * 8 + xi.xr : (int)blockIdx.x); if (rep_ + 1 < NREP(PH_GEMM_Q1)) xcd_barrier(bar); } SEAM(PH_GEMM_Q1); }
    if (IN(PH_TOPK1_1)) { for (int rep_ = 0; rep_ < NREP(PH_TOPK1_1); ++rep_) { MKCTX();  ph_topk(p, 1, c); if (rep_ + 1 < NREP(PH_TOPK1_1)) xcd_barrier(bar); } SEAM(PH_TOPK1_1); }
    if (IN(PH_PU1)) { for (int rep_ = 0; rep_ < NREP(PH_PU1); ++rep_) { MKCTX();  GETXI(); ph_peer_u2(p, 1, c, xi, (rep_ + 1 < NREP(PH_PU1)) ? PROBE_IDMASK : 0x3fff); if (rep_ + 1 < NREP(PH_PU1)) xcd_barrier(bar); } SEAM(PH_PU1); }
    if (IN(PH_PA1)) { for (int rep_ = 0; rep_ < NREP(PH_PA1); ++rep_) { MKCTX();  ph_peer_act2(p, 1, c); if (rep_ + 1 < NREP(PH_PA1)) xcd_barrier(bar); } SEAM(PH_PA1); }
    if (IN(PH_PV1)) { for (int rep_ = 0; rep_ < NREP(PH_PV1); ++rep_) { MKCTX();  GETXI(); ph_peer_v2(p, 1, c, xi, (rep_ + 1 < NREP(PH_PV1)) ? (bf16_t*)(ws + WS_S) : p.hb, (rep_ + 1 < NREP(PH_PV1)) ? PROBE_IDMASK : 0x3fff); if (rep_ + 1 < NREP(PH_PV1)) xcd_barrier(bar); } SEAM(PH_PV1); }
    if (IN(PH_FINAL)) { MKCTX(); norm_rows_f32(p.hb, p.out, p.final_norm, c); }
#undef IN
#undef SEAM
}

extern "C" void kernel_launch(void* const* d_in, const int* in_sizes, int n_in, void* d_out, int out_size, void* d_ws, size_t ws_size, hipStream_t stream) {
    static int grid = 0;
    if (grid == 0) {
        if (n_in != 22 || out_size != M * DM || ws_size < WS_END) { fprintf(stderr, "kernel_launch: unexpected shapes: n_in %d out %d ws %zu (need %zu)\n", n_in, out_size, ws_size, (size_t)WS_END); grid = -1; return; }
        int dev = 0, cus = 0, per_cu = 0;
        if (hipGetDevice(&dev) != hipSuccess || hipDeviceGetAttribute(&cus, hipDeviceAttributeMultiprocessorCount, dev) != hipSuccess) { grid = -1; return; }
        if (hipFuncSetAttribute((const void*)mega_fwd, hipFuncAttributeMaxDynamicSharedMemorySize, LDS_BYTES) != hipSuccess) { fprintf(stderr, "kernel_launch: hipFuncSetAttribute failed\n"); grid = -1; return; }
        if (hipOccupancyMaxActiveBlocksPerMultiprocessor(&per_cu, (const void*)mega_fwd, NTHREADS, LDS_BYTES) != hipSuccess || per_cu < 1) { fprintf(stderr, "kernel_launch: occupancy query says %d blocks per CU\n", per_cu); per_cu = 1; }
        (void)hipGetLastError();
        grid = cus;
        if (grid % 8 != 0 || grid < 32) { fprintf(stderr, "kernel_launch: unexpected CU count %d\n", cus); }
    }
    if (grid < 0) return;
    (void)hipMemsetAsync((char*)d_ws + WS_CTL, 0, CTL_ZERO_BYTES, stream);
    Params p{};
    const float** pp = (const float**)&p;
    for (int i = 0; i < 22; ++i) pp[i] = (const float*)d_in[i];
    p.out = (float*)d_out; p.ws = (unsigned char*)d_ws; p.hb = (bf16_t*)((unsigned char*)d_ws + WS_HB);
#if MK_N_LAUNCHES == 1
    p.ph_lo = 0; p.ph_hi = NPHASES;
    void* args[] = {&p};
    hipError_t e = hipLaunchCooperativeKernel((const void*)mega_fwd, dim3(grid), dim3(NTHREADS), args, LDS_BYTES, stream);
    if (e != hipSuccess) fprintf(stderr, "cooperative launch failed: %s (grid %d)\n", hipGetErrorString(e), grid);
#else
    for (int ph = 0; ph < NPHASES; ++ph) { p.ph_lo = ph; p.ph_hi = ph + 1; hipLaunchKernelGGL(mega_fwd, dim3(grid), dim3(NTHREADS), LDS_BYTES, stream, p); }
#endif
}
```

```cpp
#include <hip/hip_runtime.h>
#include <hip/hip_bf16.h>
#include <cstdio>
#include <cstdint>
#include <cmath>
namespace pg8 {
#define PG8_LAS __attribute__((address_space(3)))
typedef unsigned short bf16_t;
typedef short bf16x8 __attribute__((ext_vector_type(8)));
typedef float f32x4 __attribute__((ext_vector_type(4)));
typedef unsigned u32x4 __attribute__((ext_vector_type(4)));
constexpr int BM = 256, BK = 64, HALF = 128, HTB = HALF * BK * 2  , STAGE_BYTES = 8 * HTB, NXCD = 8, WGM = 8;

__host__ __device__ __forceinline__ int lds_byte(int r, int c) { const int st = (r >> 4) * 2 + (c >> 5), rr = r & 15, cc = c & 31, ob = rr * 64 + cc * 2; return st * 1024 + (ob ^ (((ob >> 9) & 1) << 5)); }
__host__ __device__ __forceinline__ void stage_rc(int b, int& R, int& C) { const int st = b / 1024, sb = b % 1024, swz = sb ^ (((sb >> 9) & 1) << 5); R = (st >> 1) * 16 + swz / 64; C = (st & 1) * 32 + (swz % 64) / 2; }
__host__ __device__ __forceinline__ int perm32(int rho) { const int n = rho >> 4, i = rho & 15; return 8 * (i >> 2) + 4 * n + (i & 3); }

struct Unit { int pm, pn; };
struct Gemm { const bf16_t* A; const bf16_t* Bt; int M, N, K; };

struct StaticOrder {
    int nM, nN, nwg, G, c;
    __host__ __device__ void init(int M, int N, int G_, int c_) { nM = M / BM; nN = N / BM; nwg = nM * nN; G = G_; c = c_; }
    __host__ __device__ bool next(int i, Unit& u) const {
        const long L = (long)i * G + c; if (L >= nwg) return false;
        int wgid = (int)L; { const int q = nwg / NXCD, r = nwg % NXCD, xcd = wgid % NXCD, off = wgid / NXCD; wgid = (xcd < r ? xcd * (q + 1) : r * (q + 1) + (xcd - r) * q) + off; }
        const int nig = WGM * nN, gid = wgid / nig, fm = gid * WGM, gsz = (nM - fm) < WGM ? (nM - fm) : WGM;
        u.pm = fm + ((wgid % nig) % gsz); u.pn = (wgid % nig) / gsz; return true;
    }
    __device__ __forceinline__ void a_ready(const Unit&) const {}
    __device__ __forceinline__ void done(const Unit&) const {}
};

__device__ __forceinline__ unsigned cvt_pk_bf16(float lo, float hi) { unsigned r; asm volatile("v_cvt_pk_bf16_f32 %0, %1, %2" : "=v"(r) : "v"(lo), "v"(hi)); return r; }
typedef float f32x2 __attribute__((ext_vector_type(2)));
__device__ __forceinline__ f32x2 gelu_pk(f32x2 v) {
    const f32x2 av = __builtin_elementwise_abs(v), d = av * 0.2316418882f + 1.0f;
    f32x2 t; t.x = __builtin_amdgcn_rcpf(d.x); t.y = __builtin_amdgcn_rcpf(d.y);
    f32x2 q = t * 0.5307027145f + (-0.7265760135f); q = q * t + 0.7107068705f; q = q * t + (-0.142248368f); q = q * t + 0.127414796f; q = q * t;
    const f32x2 s = (v * v) * (-0.72134752044f);
    f32x2 e; e.x = __builtin_amdgcn_exp2f(s.x); e.y = __builtin_amdgcn_exp2f(s.y);
    const f32x2 m = v * (q * e), r = v - m;
    f32x2 o; o.x = v.x < 0.f ? m.x : r.x; o.y = v.y < 0.f ? m.y : r.y; return o;
}
template <int ACT  > struct EpiBf16 {
    static constexpr bool PERM = true, AFTER_DRAIN = false; static_assert(ACT == 0 || ACT == 1, "EpiBf16: ACT is 0 (none) or 1 (gelu_pk)");
    bf16_t* O; int ldc; const float* bias; int split_cols; size_t split_stride; float scale0;
    __device__ __forceinline__ void operator()(const f32x4 (&acc)[2][2][4][2], const Unit& u, int wr, int wc, int fr, int fq) const {
        const int row0 = u.pm * BM + wr * 64 + fr; int colt = u.pn * BM; bf16_t* base = O;
        float sc = 1.f; if (split_cols) { const int t = colt / split_cols; base += (size_t)t * split_stride; colt -= t * split_cols; if (t == 0) sc = scale0; }
        const int col0 = colt + wc * 32 + 8 * fq, bcol0 = u.pn * BM + wc * 32 + 8 * fq;
        f32x4 bv[2][2];
#pragma unroll
        for (int bj = 0; bj < 2; ++bj)
#pragma unroll
            for (int n = 0; n < 2; ++n) bv[bj][n] = bias ? *(const f32x4*)(bias + bcol0 + bj * HALF + 4 * n) : (f32x4){0.f, 0.f, 0.f, 0.f};
#pragma unroll
        for (int ai = 0; ai < 2; ++ai)
#pragma unroll
            for (int m = 0; m < 4; ++m) { bf16_t* rowp = base + (size_t)(row0 + ai * HALF + m * 16) * ldc + col0;
#pragma unroll
                for (int bj = 0; bj < 2; ++bj) { f32x4 v0 = acc[ai][bj][m][0] + bv[bj][0], v1 = acc[ai][bj][m][1] + bv[bj][1];
                    if (ACT == 1) { f32x2 a = gelu_pk((f32x2){v0[0], v0[1]}), b = gelu_pk((f32x2){v0[2], v0[3]}), c = gelu_pk((f32x2){v1[0], v1[1]}), d = gelu_pk((f32x2){v1[2], v1[3]});
                        v0 = (f32x4){a.x, a.y, b.x, b.y}; v1 = (f32x4){c.x, c.y, d.x, d.y}; }
                    v0 = v0 * sc; v1 = v1 * sc; u32x4 w; w.x = cvt_pk_bf16(v0[0], v0[1]); w.y = cvt_pk_bf16(v0[2], v0[3]); w.z = cvt_pk_bf16(v1[0], v1[1]); w.w = cvt_pk_bf16(v1[2], v1[3]);
                    *(u32x4*)(rowp + bj * HALF) = w; } }
    }
};
template <class Epi, class Sched, bool ALIGN_EPI = false, bool SP2 = false>
__device__ __forceinline__ void gemm_phase(PG8_LAS unsigned char* lds, const Gemm g, const Sched& S, const Epi& E) {
    const int tid = threadIdx.x, wid = __builtin_amdgcn_readfirstlane(tid >> 6), lane = tid & 63, wr = wid >> 2, wc = wid & 3, fr = lane & 15, fq = lane >> 4;
    const int K = g.K, nt = K / BK;
    unsigned voffA[2], voffB[2];
#pragma unroll
    for (int i = 0; i < 2; ++i) { int R, C; stage_rc(tid * 16 + i * 8192, R, C); const int Rb = Epi::PERM ? ((R & ~31) + perm32(R & 31)) : R;
        voffA[i] = (unsigned)(R * K + C) * 2u; voffB[i] = (unsigned)(Rb * K + C) * 2u; }
    const size_t kstep = (size_t)(BK * 2);
    const size_t hstep = (size_t)HALF * K * 2;
    const size_t tstep = 2 * hstep;
    const unsigned ldsw = (unsigned)wid * 1024u;
    const int aoff = lds_byte(wr * 64 + fr, fq * 8), boff = lds_byte(wc * 32 + fr, fq * 8);
#define PG8_SA(b, h) (((b) * 2 + (h)) * HTB)
#define PG8_SB(b, h) ((4 + (b) * 2 + (h)) * HTB)
#define PG8_STAGE(bufoff, gbase, voff) do { _Pragma("unroll") for (int _i = 0; _i < 2; ++_i) \
        __builtin_amdgcn_global_load_lds((const unsigned*)((const char*)(gbase) + (voff)[_i]), (PG8_LAS unsigned*)(lds + (bufoff) + ldsw + _i * 8192), 16, 0, 0); } while (0)
#define PG8_LDA(dst, b, h) do { _Pragma("unroll") for (int m = 0; m < 4; ++m) _Pragma("unroll") for (int k = 0; k < 2; ++k) dst[m][k] = *(const PG8_LAS bf16x8*)(lds + PG8_SA(b, h) + aoff + m * 2048 + k * 1024); } while (0)
#define PG8_LDB(dst, b, h) do { _Pragma("unroll") for (int n = 0; n < 2; ++n) _Pragma("unroll") for (int k = 0; k < 2; ++k) dst[n][k] = *(const PG8_LAS bf16x8*)(lds + PG8_SB(b, h) + boff + n * 2048 + k * 1024); } while (0)
#define PG8_MMA(ai, bj, At, Bt) do { __builtin_amdgcn_s_setprio(1); _Pragma("unroll") for (int m = 0; m < 4; ++m) _Pragma("unroll") for (int n = 0; n < 2; ++n) _Pragma("unroll") for (int k = 0; k < 2; ++k) \
        acc[ai][bj][m][n] = __builtin_amdgcn_mfma_f32_16x16x32_bf16(Bt[n][k], At[m][k], acc[ai][bj][m][n], 0, 0, 0); __builtin_amdgcn_s_setprio(0); } while (0)
#define PG8_WAIT_V(n) asm volatile("s_waitcnt vmcnt(" #n ")" ::: "memory")
#define PG8_WAIT_L(n) asm volatile("s_waitcnt lgkmcnt(" #n ")" ::: "memory")
#define PG8_BAR __builtin_amdgcn_s_barrier()
#define PG8_SCHED __builtin_amdgcn_sched_barrier(0)
    Unit cur, nxt; int ui = 0;
    if (!S.next(0, cur)) return;
    f32x4 acc[2][2][4][2];
#pragma unroll
    for (int a = 0; a < 2; ++a)
#pragma unroll
        for (int b = 0; b < 2; ++b)
#pragma unroll
            for (int m = 0; m < 4; ++m)
#pragma unroll
                for (int n = 0; n < 2; ++n) acc[a][b][m][n] = (f32x4){0.f, 0.f, 0.f, 0.f};
    bf16x8 At[4][2], B0[2][2], B1[2][2];
    const char* cA = (const char*)g.A + (size_t)cur.pm * tstep; const char* cB = (const char*)g.Bt + (size_t)cur.pn * tstep;
    S.a_ready(cur);
    if constexpr (SP2) {
        PG8_STAGE(PG8_SB(0, 0), cB, voffB); PG8_STAGE(PG8_SB(0, 1), cB + hstep, voffB); PG8_STAGE(PG8_SA(0, 0), cA, voffA); PG8_STAGE(PG8_SA(0, 1), cA + hstep, voffA);
        if (wr == 1) PG8_BAR;
        PG8_WAIT_V(2); PG8_BAR;
        PG8_STAGE(PG8_SB(1, 0), cB + kstep, voffB); PG8_STAGE(PG8_SA(1, 0), cA + kstep, voffA); PG8_STAGE(PG8_SB(1, 1), cB + hstep + kstep, voffB);
        PG8_WAIT_V(6); PG8_BAR;
    } else {
        PG8_STAGE(PG8_SB(0, 0), cB, voffB); PG8_STAGE(PG8_SA(0, 0), cA, voffA); PG8_STAGE(PG8_SB(0, 1), cB + hstep, voffB); PG8_STAGE(PG8_SA(0, 1), cA + hstep, voffA);
        if (wr == 1) PG8_BAR;
        PG8_WAIT_V(4); PG8_BAR;
        PG8_STAGE(PG8_SB(1, 0), cB + kstep, voffB); PG8_STAGE(PG8_SA(1, 0), cA + kstep, voffA); PG8_STAGE(PG8_SB(1, 1), cB + hstep + kstep, voffB);
        PG8_WAIT_V(6); PG8_BAR;
    }
    for (;;) {
        const bool has_next = S.next(ui + 1, nxt);
        const char* nA = has_next ? (const char*)g.A + (size_t)nxt.pm * tstep : cA; const char* nB = has_next ? (const char*)g.Bt + (size_t)nxt.pn * tstep : cB;
        for (int t = 0; t < nt; t += 2) {
            const bool last = (t == nt - 2);
            const char* a1 = cA + (size_t)(t + 1) * kstep;
            const char* a2 = last ? nA : cA + (size_t)(t + 2) * kstep; const char* b2 = last ? nB : cB + (size_t)(t + 2) * kstep;
            const char* a3 = a2 + kstep; const char* b3 = b2 + kstep;
            if (last && has_next) S.a_ready(nxt);
            if constexpr (SP2) {
            PG8_LDB(B0, 0, 0); PG8_LDB(B1, 0, 1); PG8_SCHED; PG8_LDA(At, 0, 0); PG8_STAGE(PG8_SA(1, 1), a1 + hstep, voffA);
            PG8_WAIT_V(8); PG8_WAIT_L(0); PG8_BAR; PG8_MMA(0, 0, At, B0); PG8_MMA(0, 1, At, B1); PG8_BAR; PG8_SCHED;
            PG8_LDA(At, 0, 1); PG8_STAGE(PG8_SB(0, 0), b2, voffB); PG8_STAGE(PG8_SB(0, 1), b2 + hstep, voffB); PG8_STAGE(PG8_SA(0, 0), a2, voffA);
            PG8_WAIT_V(8); PG8_WAIT_L(0); PG8_BAR; PG8_MMA(1, 0, At, B0); PG8_MMA(1, 1, At, B1); PG8_BAR; PG8_SCHED;
            PG8_LDB(B0, 1, 0); PG8_LDB(B1, 1, 1); PG8_SCHED; PG8_LDA(At, 1, 0); PG8_STAGE(PG8_SA(0, 1), a2 + hstep, voffA);
            PG8_WAIT_V(8); PG8_WAIT_L(0); PG8_BAR; PG8_MMA(0, 0, At, B0); PG8_MMA(0, 1, At, B1); PG8_BAR; PG8_SCHED;
            PG8_LDA(At, 1, 1); PG8_STAGE(PG8_SB(1, 0), b3, voffB); PG8_STAGE(PG8_SB(1, 1), b3 + hstep, voffB); PG8_STAGE(PG8_SA(1, 0), a3, voffA);
            PG8_WAIT_V(8); PG8_WAIT_L(0); PG8_BAR; PG8_MMA(1, 0, At, B0); PG8_MMA(1, 1, At, B1); PG8_BAR; PG8_SCHED;
            } else {
            PG8_LDB(B0, 0, 0); PG8_SCHED; PG8_LDA(At, 0, 0); PG8_STAGE(PG8_SA(1, 1), a1 + hstep, voffA);
            PG8_WAIT_L(8); PG8_BAR; PG8_WAIT_L(0); PG8_MMA(0, 0, At, B0); PG8_BAR; PG8_SCHED;
            PG8_LDB(B1, 0, 1); PG8_STAGE(PG8_SB(0, 0), b2, voffB);
            PG8_BAR; PG8_WAIT_L(0); PG8_MMA(0, 1, At, B1); PG8_BAR;
            PG8_LDA(At, 0, 1); PG8_STAGE(PG8_SA(0, 0), a2, voffA);
            PG8_BAR; PG8_WAIT_L(0); PG8_MMA(1, 0, At, B0); PG8_BAR; PG8_SCHED;
            PG8_STAGE(PG8_SB(0, 1), b2 + hstep, voffB);
            PG8_WAIT_V(6); PG8_BAR; PG8_MMA(1, 1, At, B1); PG8_BAR;
            PG8_LDB(B0, 1, 0); PG8_SCHED; PG8_LDA(At, 1, 0); PG8_STAGE(PG8_SA(0, 1), a2 + hstep, voffA);
            PG8_WAIT_L(8); PG8_BAR; PG8_WAIT_L(0); PG8_MMA(0, 0, At, B0); PG8_BAR; PG8_SCHED;
            PG8_LDB(B1, 1, 1); PG8_STAGE(PG8_SB(1, 0), b3, voffB);
            PG8_BAR; PG8_WAIT_L(0); PG8_MMA(0, 1, At, B1); PG8_BAR;
            PG8_LDA(At, 1, 1); PG8_STAGE(PG8_SA(1, 0), a3, voffA);
            PG8_BAR; PG8_WAIT_L(0); PG8_MMA(1, 0, At, B0); PG8_BAR; PG8_SCHED;
            PG8_STAGE(PG8_SB(1, 1), b3 + hstep, voffB);
            PG8_WAIT_V(6); PG8_BAR; PG8_MMA(1, 1, At, B1); PG8_BAR;
            }
        }
        if constexpr (ALIGN_EPI) { if (wr == 0) PG8_BAR; }
        if constexpr (!Epi::AFTER_DRAIN) { E(acc, cur, wr, wc, fr, fq); S.done(cur); }
        if (!has_next) break;
#pragma unroll
        for (int a = 0; a < 2; ++a)
#pragma unroll
            for (int b = 0; b < 2; ++b)
#pragma unroll
                for (int m = 0; m < 4; ++m)
#pragma unroll
                    for (int n = 0; n < 2; ++n) acc[a][b][m][n] = (f32x4){0.f, 0.f, 0.f, 0.f};
        cur = nxt; cA = nA; cB = nB; ++ui;
        if constexpr (ALIGN_EPI) { if (wr == 1) PG8_BAR; }
    }
    PG8_WAIT_V(0);
    if constexpr (!ALIGN_EPI) { if (wr == 0) PG8_BAR; }
    PG8_BAR;
    if constexpr (Epi::AFTER_DRAIN) { E.fused(acc, cur, wr, wc, fr, fq, lds, wid, lane); S.done(cur); }
#undef PG8_SA
#undef PG8_SB
#undef PG8_STAGE
#undef PG8_LDA
#undef PG8_LDB
#undef PG8_MMA
#undef PG8_WAIT_V
#undef PG8_WAIT_L
#undef PG8_BAR
#undef PG8_SCHED
}

template <bool F32BASE> struct EpiResBf {
    static constexpr bool PERM = true, AFTER_DRAIN = false;
    const void* base; bf16_t* out; int ldc;
    typedef float f2_t __attribute__((ext_vector_type(2))); typedef __bf16 b2_t __attribute__((ext_vector_type(2)));
    static __device__ __forceinline__ unsigned pk(float lo, float hi) { const f2_t v = {lo, hi}; return __builtin_bit_cast(unsigned, __builtin_convertvector(v, b2_t)); }
    __device__ __forceinline__ void operator()(const f32x4 (&acc)[2][2][4][2], const Unit& u, int wr, int wc, int fr, int fq) const {
        const int row0 = u.pm * BM + wr * 64 + fr, col0 = u.pn * BM + wc * 32 + 8 * fq;
        if (F32BASE) {
#pragma unroll
            for (int ai = 0; ai < 2; ++ai) { f32x4 b0[4][2], b1[4][2];
#pragma unroll
                for (int m = 0; m < 4; ++m)
#pragma unroll
                    for (int bj = 0; bj < 2; ++bj) { const float* b = (const float*)base + (size_t)(row0 + ai * HALF + m * 16) * ldc + col0 + bj * HALF; b0[m][bj] = *(const f32x4*)b; b1[m][bj] = *(const f32x4*)(b + 4); }
                asm volatile("" ::: "memory");
#pragma unroll
                for (int m = 0; m < 4; ++m)
#pragma unroll
                    for (int bj = 0; bj < 2; ++bj) { const f32x4 v0 = acc[ai][bj][m][0] + b0[m][bj], v1 = acc[ai][bj][m][1] + b1[m][bj];
                        u32x4 w; w.x = pk(v0[0], v0[1]); w.y = pk(v0[2], v0[3]); w.z = pk(v1[0], v1[1]); w.w = pk(v1[2], v1[3]);
                        *(u32x4*)(out + (size_t)(row0 + ai * HALF + m * 16) * ldc + col0 + bj * HALF) = w; }
                asm volatile("" ::: "memory"); }
        } else {
            u32x4 rw[2][4][2];
#pragma unroll
            for (int ai = 0; ai < 2; ++ai)
#pragma unroll
                for (int m = 0; m < 4; ++m)
#pragma unroll
                    for (int bj = 0; bj < 2; ++bj) rw[ai][m][bj] = *(const u32x4*)((const bf16_t*)base + (size_t)(row0 + ai * HALF + m * 16) * ldc + col0 + bj * HALF);
            asm volatile("" ::: "memory");
#pragma unroll
            for (int ai = 0; ai < 2; ++ai)
#pragma unroll
                for (int m = 0; m < 4; ++m)
#pragma unroll
                    for (int bj = 0; bj < 2; ++bj) { const u32x4 r = rw[ai][m][bj];
                        const f32x4 v0 = acc[ai][bj][m][0] + (f32x4){__builtin_bit_cast(float, r.x << 16), __builtin_bit_cast(float, r.x & 0xffff0000u), __builtin_bit_cast(float, r.y << 16), __builtin_bit_cast(float, r.y & 0xffff0000u)};
                        const f32x4 v1 = acc[ai][bj][m][1] + (f32x4){__builtin_bit_cast(float, r.z << 16), __builtin_bit_cast(float, r.z & 0xffff0000u), __builtin_bit_cast(float, r.w << 16), __builtin_bit_cast(float, r.w & 0xffff0000u)};
                        u32x4 w; w.x = pk(v0[0], v0[1]); w.y = pk(v0[2], v0[3]); w.z = pk(v1[0], v1[1]); w.w = pk(v1[2], v1[3]);
                        *(u32x4*)(out + (size_t)(row0 + ai * HALF + m * 16) * ldc + col0 + bj * HALF) = w; }
        }
    }
};
}

constexpr int BATCH = 4, SEQ = 8192, DM = 1024, M = BATCH * SEQ;
constexpr int NIN = 3088, NIN_PAD = 3328;
constexpr int C_GQ = 0, C_GK = 256, C_GV = 512, C_GG = 1024, C_AQ = 1536, C_AK = 2048, C_AV = 2560, C_GLR = 3072;
constexpr int NEXP = 16384;
constexpr float NORM_EPS = 1e-6f;
constexpr int NWAVES = 8, NTHREADS = 512;

constexpr size_t MiB = 1u << 20;
constexpr size_t WS_CTL = 0, CTL_ZERO_BYTES = 1 * MiB;
constexpr size_t WS_WT_IN = 1 * MiB;
constexpr size_t WS_WT_OUT = 8 * MiB;
constexpr size_t WS_WT_CIN = 10 * MiB;
constexpr size_t WS_WT_COUT = 14 * MiB;
constexpr size_t WS_WT_Q0 = 16 * MiB;
constexpr size_t WS_WT_Q1 = 20 * MiB;
constexpr size_t WS_ACT = 32 * MiB;
constexpr size_t WS_S = 96 * MiB;
constexpr size_t WS_PROJ = WS_S;
constexpr size_t WS_GLAO = WS_S + 208 * MiB;
constexpr size_t WS_TOPS = WS_S + 128 * MiB;
constexpr size_t WS_TOPI = WS_S + 160 * MiB;
constexpr size_t WS_IDS = WS_S + 192 * MiB;
constexpr size_t WS_G = WS_S + 208 * MiB;
constexpr size_t WS_XC = WS_ACT;
constexpr size_t WS_A = WS_S + 128 * MiB;
constexpr size_t WS_HB = WS_S + 256 * MiB;
constexpr size_t WS_Y0 = WS_S + 320 * MiB;
constexpr size_t WS_U = WS_S + 256 * MiB;
constexpr size_t WS_TAB = 448 * MiB;
constexpr size_t WS_TAB8 = 448 * MiB;
constexpr size_t WS_WG = 24 * MiB;
constexpr size_t WS_AGG = WS_S + 128 * MiB;
constexpr size_t WS_SCL = 26 * MiB;
constexpr size_t WS_END = 512 * MiB;
constexpr int CW_BAR = 4096, CW_RANK = 8192;

constexpr int RING_BYTES = 131072;
constexpr int LDS_BYTES = 147456;
constexpr int LDSCTL_OFF = LDS_BYTES - 512, MISC_OFF = LDSCTL_OFF + 320;

#define LAS __attribute__((address_space(3)))
#define GAS __attribute__((address_space(1)))
typedef unsigned short bf16_t;
typedef float f32x4 __attribute__((ext_vector_type(4)));
typedef unsigned u32x4 __attribute__((ext_vector_type(4)));
typedef unsigned u32x2 __attribute__((ext_vector_type(2)));
typedef short bf16x8 __attribute__((ext_vector_type(8)));
typedef float f32x2 __attribute__((ext_vector_type(2)));

struct Params {
    const float *x, *mix_norm, *ffn_norm, *ab_w_in, *gla_w_alpha, *gla_b_alpha, *gla_head_gain, *ab_w_out;
    const float *c_w_in, *c_conv_w, *c_conv_b, *c_w_rgate, *c_b_rgate, *c_w_igate, *c_b_igate, *c_lambda, *c_w_out;
    const float *peer_w_query, *peer_sub_keys, *peer_u, *peer_v, *final_norm;
    float* out; unsigned char* ws; bf16_t* hb;
    int ph_lo, ph_hi;
};

typedef float f32x2_cv __attribute__((ext_vector_type(2))); typedef __bf16 bf16x2_cv __attribute__((ext_vector_type(2)));
__device__ __forceinline__ unsigned pk2(float lo, float hi) { const f32x2_cv v = {lo, hi}; const bf16x2_cv b = __builtin_convertvector(v, bf16x2_cv); return __builtin_bit_cast(unsigned, b); }
__device__ __forceinline__ unsigned f2bf(float f) { return pk2(f, f) & 0xffffu; }
__device__ __forceinline__ float bf2f(bf16_t b) { return __builtin_bit_cast(float, (unsigned)b << 16); }
__device__ __forceinline__ float bflo(unsigned w) { return __builtin_bit_cast(float, w << 16); }
__device__ __forceinline__ float bfhi(unsigned w) { return __builtin_bit_cast(float, w & 0xffff0000u); }
__device__ __forceinline__ float wave_sum(float v) {
#pragma unroll
    for (int o = 1; o < 64; o <<= 1) v += __shfl_xor(v, o);
    return v;
}
__device__ __forceinline__ float gelu_tanh(float x) {
    const float x2 = x * x, u2 = x * (2.3022082f + 0.10294324f * x2);
    const float e = __builtin_amdgcn_exp2f(u2);
    return x - x * __builtin_amdgcn_rcpf(e + 1.f);
}
__device__ __forceinline__ float sigmoidf_(float x) { return __builtin_amdgcn_rcpf(1.f + __expf(-x)); }

struct Ctx { int tid, lane, wave, blk, nblk, gtid, gthreads, gwave, gwaves; LAS unsigned char* lds; };

template <class F> __device__ __forceinline__ void transpose_cvt(const float* W, int K, int Nsrc, bf16_t* WT, int Ndst, F srcmap, int gtid, int gthreads) {
    const int total = (K / 8) * Ndst;
    for (int idx = gtid; idx < total; idx += gthreads) {
        const int ko = idx / Ndst, n = idx - ko * Ndst; const int sn = srcmap(n);
        u32x4 w = {0u, 0u, 0u, 0u};
        if (sn >= 0) { const float* s = W + (size_t)(ko * 8) * Nsrc + sn;
            w.x = pk2(s[0], s[(size_t)Nsrc]); w.y = pk2(s[2 * (size_t)Nsrc], s[3 * (size_t)Nsrc]); w.z = pk2(s[4 * (size_t)Nsrc], s[5 * (size_t)Nsrc]); w.w = pk2(s[6 * (size_t)Nsrc], s[7 * (size_t)Nsrc]); }
        *(u32x4*)(WT + (size_t)n * K + ko * 8) = w;
    }
}
__device__ __forceinline__ void cvt_bf16(const float* src, bf16_t* dst, size_t n8, int gtid, int gthreads) {
    for (size_t i = gtid; i < n8; i += gthreads) { const f32x4 a = *(const f32x4*)(src + i * 8), b = *(const f32x4*)(src + i * 8 + 4);
        u32x4 w; w.x = pk2(a.x, a.y); w.y = pk2(a.z, a.w); w.z = pk2(b.x, b.y); w.w = pk2(b.z, b.w); *(u32x4*)(dst + i * 8) = w; }
}
__device__ __forceinline__ void ld_row4(const float* row, int lane, int j, f32x4& v) { v = ((const f32x4*)row)[64 * j + lane]; }
__device__ __forceinline__ void ld_row4(const bf16_t* row, int lane, int j, f32x4& v) { const u32x2 w = ((const u32x2*)row)[64 * j + lane]; v = (f32x4){bflo(w.x), bfhi(w.x), bflo(w.y), bfhi(w.y)}; }
template <class T> __device__ __forceinline__ void norm_rows_bf16(const T* src, const float* gain, bf16_t* dst, const Ctx& c, unsigned char* x8 = nullptr) {
    f32x4 gn[4];
#pragma unroll
    for (int j = 0; j < 4; ++j) gn[j] = *((const f32x4*)gain + 64 * j + c.lane);
    for (int m0 = c.gwave; m0 < M; m0 += 4 * c.gwaves) {
        f32x4 v[4][4]; float s[4];
#pragma unroll
        for (int u = 0; u < 4; ++u) { const T* xr = src + (size_t)min(m0 + u * c.gwaves, M - 1) * DM;
#pragma unroll
            for (int j = 0; j < 4; ++j) ld_row4(xr, c.lane, j, v[u][j]); }
#pragma unroll
        for (int u = 0; u < 4; ++u) { s[u] = 0.f;
#pragma unroll
            for (int j = 0; j < 4; ++j) s[u] += (v[u][j].x * v[u][j].x + v[u][j].y * v[u][j].y) + (v[u][j].z * v[u][j].z + v[u][j].w * v[u][j].w); }
#pragma unroll
        for (int o = 1; o < 64; o <<= 1) {
#pragma unroll
            for (int u = 0; u < 4; ++u) s[u] += __shfl_xor(s[u], o); }
#pragma unroll
        for (int u = 0; u < 4; ++u) { const int m = m0 + u * c.gwaves; if (m >= M) break; const float rstd = __builtin_amdgcn_rsqf(s[u] * (1.f / DM) + NORM_EPS);
            u32x2* o8 = (u32x2*)(dst + (size_t)m * DM) + c.lane;
#pragma unroll
            for (int j = 0; j < 4; ++j) { const f32x4 g = gn[j]; const unsigned w0 = pk2(v[u][j].x * rstd * g.x, v[u][j].y * rstd * g.y), w1 = pk2(v[u][j].z * rstd * g.z, v[u][j].w * rstd * g.w);
                u32x2 w; w.x = w0; w.y = w1; o8[64 * j] = w;
                if (x8) {
                    const float f0 = bflo(w0), f1 = bfhi(w0), f2 = bflo(w1), f3 = bfhi(w1);
                    int hq = __builtin_amdgcn_cvt_pk_fp8_f32(f0, f1, 0, false); hq = __builtin_amdgcn_cvt_pk_fp8_f32(f2, f3, hq, true);
                    const f32x2 d0 = __builtin_amdgcn_cvt_pk_f32_fp8(hq, false), d1 = __builtin_amdgcn_cvt_pk_f32_fp8(hq, true);
                    int lq = __builtin_amdgcn_cvt_pk_fp8_f32((f0 - d0.x) * 16.f, (f1 - d0.y) * 16.f, 0, false); lq = __builtin_amdgcn_cvt_pk_fp8_f32((f2 - d1.x) * 16.f, (f3 - d1.y) * 16.f, lq, true);
                    unsigned* xo = (unsigned*)(x8 + (size_t)m * 2048) + 64 * j + c.lane; xo[0] = (unsigned)hq; xo[256] = (unsigned)lq; } } }
    }
}
__device__ __forceinline__ void norm_rows_f32(const bf16_t* src, float* dst, const float* gain, const Ctx& c) {
    f32x4 gn[4];
#pragma unroll
    for (int j = 0; j < 4; ++j) gn[j] = *((const f32x4*)gain + 64 * j + c.lane);
    for (int m0 = c.gwave; m0 < M; m0 += 4 * c.gwaves) {
        f32x4 v[4][4]; float s[4];
#pragma unroll
        for (int u = 0; u < 4; ++u) { const bf16_t* xr = src + (size_t)min(m0 + u * c.gwaves, M - 1) * DM;
#pragma unroll
            for (int j = 0; j < 4; ++j) ld_row4(xr, c.lane, j, v[u][j]); }
#pragma unroll
        for (int u = 0; u < 4; ++u) { s[u] = 0.f;
#pragma unroll
            for (int j = 0; j < 4; ++j) s[u] += (v[u][j].x * v[u][j].x + v[u][j].y * v[u][j].y) + (v[u][j].z * v[u][j].z + v[u][j].w * v[u][j].w); }
#pragma unroll
        for (int o = 1; o < 64; o <<= 1) {
#pragma unroll
            for (int u = 0; u < 4; ++u) s[u] += __shfl_xor(s[u], o); }
#pragma unroll
        for (int u = 0; u < 4; ++u) { if (m0 + u * c.gwaves >= M) break; const float rstd = __builtin_amdgcn_rsqf(s[u] * (1.f / DM) + NORM_EPS); f32x4* xw = (f32x4*)(dst + (size_t)(m0 + u * c.gwaves) * DM) + c.lane;
#pragma unroll
            for (int j = 0; j < 4; ++j) xw[64 * j] = v[u][j] * rstd * gn[j]; }
    }
}

constexpr size_t WS_GLRB = 30 * MiB;
__device__ __forceinline__ void ph_glr(const Params& p, const Ctx& c) {
    const bf16_t* XN = (const bf16_t*)(p.ws + WS_ACT); const bf16_t* WG = (const bf16_t*)(p.ws + WS_WT_IN) + (size_t)3072 * DM; bf16_t* GL = (bf16_t*)(p.ws + WS_GLRB);
    const int lane = c.lane, r = lane & 15, q = lane >> 4;
    for (int tile = c.gwave; tile < M / 16; tile += c.gwaves) {
        const bf16_t* ap = XN + (size_t)(tile * 16 + r) * DM + 8 * q; const bf16_t* bp = WG + (size_t)r * DM + 8 * q;
        f32x4 acc = {0.f, 0.f, 0.f, 0.f};
#pragma unroll 8
        for (int s2 = 0; s2 < 32; ++s2) acc = __builtin_amdgcn_mfma_f32_16x16x32_bf16(__builtin_bit_cast(bf16x8, *(const u32x4*)(ap + 32 * s2)), __builtin_bit_cast(bf16x8, *(const u32x4*)(bp + 32 * s2)), acc, 0, 0, 0);
#pragma unroll
        for (int i = 0; i < 4; ++i) GL[(size_t)(tile * 16 + 4 * q + i) * 16 + r] = (bf16_t)f2bf(acc[i]);
    }
}


constexpr int AT_K = 0, AT_V = 272 * 144, AT_END = 2 * 272 * 144;
typedef short s16x4 __attribute__((ext_vector_type(4)));
__device__ __forceinline__ s16x4 lds_tr16(LAS const unsigned char* pbyte) { return __builtin_bit_cast(s16x4, __builtin_amdgcn_ds_read_tr16_b64_v4i16((LAS s16x4*)pbyte)); }
__device__ __forceinline__ void ph_attn(const Params& p, const Ctx& c) {
    LAS unsigned char* L = c.lds;
    const bf16_t* proj = (const bf16_t*)(p.ws + WS_PROJ); bf16_t* AO = (bf16_t*)p.out; float* LSE = (float*)((unsigned char*)p.out + 96 * MiB);
    const int tid = c.tid, lane = c.lane, w = c.wave, r = lane & 15, qq = lane >> 4;
    constexpr float LOG2E = 1.4426950408889634f;
    __syncthreads();
    for (int i = tid; i < 16 * 144 / 4; i += NTHREADS) ((LAS unsigned*)(L + AT_V + 256 * 144))[i] = 0u;
    u32x4 kreg[4], vreg[4], qreg[2];
#define AT_DECODE(it_) const int h = (it_) & 7, rest = (it_) >> 3, br = rest >> 8, u = rest & 255, sh = 2 * br, dil = 1 << sh, nbm = (64 >> sh) - 1; \
        const int bres = u >> (6 - sh), blk = u & nbm, b = bres >> sh, res = bres & (dil - 1); const size_t rowb = (size_t)b * SEQ; const int l0 = blk * 128
#define AT_ISSUE(it_) do { AT_DECODE(it_); (void)br; \
        _Pragma("unroll") for (int k = 0; k < 4; ++k) { const int idx = tid + NTHREADS * k, row = idx >> 3, ch = idx & 7, l = l0 - 128 + row; kreg[k] = (u32x4){0u, 0u, 0u, 0u}; vreg[k] = kreg[k]; \
            if (l >= 0) { const bf16_t* src = proj + (rowb + (size_t)l * dil + res) * NIN_PAD + C_AK + h * 64 + ch * 8; kreg[k] = *(const u32x4*)src; vreg[k] = *(const u32x4*)(src + 512); } } \
        const bf16_t* qp = proj + (rowb + (size_t)(l0 + 16 * w + r) * dil + res) * NIN_PAD + C_AQ + h * 64 + 8 * qq; qreg[0] = *(const u32x4*)qp; qreg[1] = *(const u32x4*)(qp + 32); } while (0)
    if (c.blk < 6144) AT_ISSUE(c.blk);
    for (int item = c.blk; item < 6144; item += c.nblk) {
        AT_DECODE(item);
        __syncthreads();
#pragma unroll
        for (int k = 0; k < 4; ++k) { const int idx = tid + NTHREADS * k, row = idx >> 3, ch = idx & 7;
            *(LAS u32x4*)(L + AT_K + row * 144 + ch * 16) = kreg[k]; *(LAS u32x4*)(L + AT_V + row * 144 + ch * 16) = vreg[k]; }
        bf16x8 qf[2]; qf[0] = __builtin_bit_cast(bf16x8, qreg[0]); qf[1] = __builtin_bit_cast(bf16x8, qreg[1]);
        { const int nit = item + c.nblk; if (nit < 6144) AT_ISSUE(nit); }
        __syncthreads();
        f32x4 sa[9];
#pragma unroll
        for (int jn = 0; jn < 9; ++jn) { LAS const unsigned char* kp = L + AT_K + (16 * (w + jn) + r) * 144 + 16 * qq;
            const bf16x8 k0 = __builtin_bit_cast(bf16x8, *(const LAS u32x4*)kp), k1 = __builtin_bit_cast(bf16x8, *(const LAS u32x4*)(kp + 64));
            f32x4 z = {0.f, 0.f, 0.f, 0.f}; z = __builtin_amdgcn_mfma_f32_16x16x32_bf16(k0, qf[0], z, 0, 0, 0); sa[jn] = __builtin_amdgcn_mfma_f32_16x16x32_bf16(k1, qf[1], z, 0, 0, 0); }
        const float sc = 0.125f * LOG2E, sl = exp2f(-(float)(h + 1)) * (float)dil * LOG2E;
        const int delta0 = r + 128 - 4 * qq;
        const float b0 = -sl * (float)delta0;
        float mx = -1e30f;
        if (blk > 0) {
#pragma unroll
            for (int jn = 0; jn < 9; ++jn)
#pragma unroll
                for (int i = 0; i < 4; ++i) { const bool valid = (unsigned)(delta0 - (16 * jn + i)) <= 128u;
                    const float v = valid ? __builtin_fmaf(sa[jn][i], sc, __builtin_fmaf(sl, (float)(16 * jn + i), b0)) : -1e30f; sa[jn][i] = v; mx = fmaxf(mx, v); }
        } else {
#pragma unroll
            for (int jn = 0; jn < 9; ++jn)
#pragma unroll
                for (int i = 0; i < 4; ++i) { const bool valid = ((unsigned)(delta0 - (16 * jn + i)) <= 128u) && (16 * (w + jn) + 4 * qq + i >= 128);
                    const float v = valid ? __builtin_fmaf(sa[jn][i], sc, __builtin_fmaf(sl, (float)(16 * jn + i), b0)) : -1e30f; sa[jn][i] = v; mx = fmaxf(mx, v); }
        }
        mx = fmaxf(mx, __shfl_xor(mx, 16)); mx = fmaxf(mx, __shfl_xor(mx, 32));
        float sum = 0.f;
#pragma unroll
        for (int jn = 0; jn < 9; ++jn)
#pragma unroll
            for (int i = 0; i < 4; ++i) { const float e = __builtin_amdgcn_exp2f(sa[jn][i] - mx); sa[jn][i] = e; sum += e; }
        sum += __shfl_xor(sum, 16); sum += __shfl_xor(sum, 32);
        { const int qi = 16 * w + r; if (qq == 0) LSE[((size_t)br * M + rowb + (size_t)(l0 + qi) * dil + res) * 8 + h] = (mx + __builtin_amdgcn_logf(sum)) * (1.f / LOG2E); }
        f32x4 oa[4];
#pragma unroll
        for (int dt = 0; dt < 4; ++dt) oa[dt] = (f32x4){0.f, 0.f, 0.f, 0.f};
#pragma unroll
        for (int s2 = 0; s2 < 5; ++s2) { u32x4 pw; pw.x = pk2(sa[2 * s2][0], sa[2 * s2][1]); pw.y = pk2(sa[2 * s2][2], sa[2 * s2][3]);
            if (s2 < 4) { pw.z = pk2(sa[2 * s2 + 1][0], sa[2 * s2 + 1][1]); pw.w = pk2(sa[2 * s2 + 1][2], sa[2 * s2 + 1][3]); } else { pw.z = 0u; pw.w = 0u; }
            LAS const unsigned char* vp = L + AT_V + (16 * (w + 2 * s2) + 4 * qq + (r >> 2)) * 144 + 8 * (r & 3);
#pragma unroll
            for (int dt = 0; dt < 4; ++dt) { const s16x4 v0 = lds_tr16(vp + 32 * dt), v1 = lds_tr16(vp + 32 * dt + 16 * 144);
                const bf16x8 vf = {v0[0], v0[1], v0[2], v0[3], v1[0], v1[1], v1[2], v1[3]};
                oa[dt] = __builtin_amdgcn_mfma_f32_16x16x32_bf16(__builtin_bit_cast(bf16x8, pw), vf, oa[dt], 0, 0, 0); } }
        const float rs = __builtin_amdgcn_rcpf(sum);
        LAS bf16_t* ost = (LAS bf16_t*)(L + AT_END + w * 2304);
#pragma unroll
        for (int i = 0; i < 4; ++i) { const float ri = __shfl(rs, 4 * qq + i);
#pragma unroll
            for (int dt = 0; dt < 4; ++dt) ost[(4 * qq + i) * 72 + 16 * dt + r] = (bf16_t)f2bf(oa[dt][i] * ri); }
        asm volatile("" ::: "memory");
        { const int qi = lane >> 2, dc = (lane & 3) * 16;
          const u32x4 o0 = *(const LAS u32x4*)(ost + qi * 72 + dc), o1 = *(const LAS u32x4*)(ost + qi * 72 + dc + 8);
          bf16_t* op = AO + ((size_t)br * M + rowb + (size_t)(l0 + 16 * w + qi) * dil + res) * 512 + h * 64 + dc;
          *(u32x4*)op = o0; *(u32x4*)(op + 8) = o1; }
        asm volatile("" ::: "memory");
    }
#undef AT_DECODE
#undef AT_ISSUE
}

constexpr size_t WS_CKV = WS_S + 272 * MiB;
constexpr size_t WS_DEC = WS_S + 336 * MiB;
constexpr size_t WS_SPREV = WS_ACT;
constexpr int GL_SEGT = 0, GL_V = 2048, GL_KT = GL_V + 64 * 272, GL_QD = GL_KT + 64 * 144, GL_KI = GL_QD + 64 * 144, GL_END = GL_KI + 64 * 144;
#ifdef GLR_FROM_PROJ
#define GLR_SRC (prow0 + C_GLR), NIN_PAD
#else
#define GLR_SRC ((const bf16_t*)(p.ws + WS_GLRB) + (size_t)bn * 64 * 16), 16
#endif
__device__ __forceinline__ void gla_cumdecay(const Params& p, const Ctx& c, const bf16_t* glr0, int gstride, int h, float (&bcum)[8], float& blast) {
    LAS float* SEGT = (LAS float*)(c.lds + GL_SEGT);
    const int kk = c.tid & 63, w = c.wave;
    float wa[16];
#pragma unroll
    for (int r = 0; r < 16; ++r) wa[r] = p.gla_w_alpha[r * 256 + h * 64 + kk];
    const float ba = p.gla_b_alpha[h * 64 + kk];
    float run = 0.f;
    u32x4 ga[8], gb[8];
#pragma unroll
    for (int k = 0; k < 8; ++k) { const bf16_t* pr = glr0 + (size_t)(8 * w + k) * gstride; ga[k] = *(const u32x4*)pr; gb[k] = *(const u32x4*)(pr + 8); }
#pragma unroll
    for (int k = 0; k < 8; ++k) { const u32x4 g0 = ga[k], g1 = gb[k];
        float z = ba + bflo(g0.x) * wa[0] + bfhi(g0.x) * wa[1] + bflo(g0.y) * wa[2] + bfhi(g0.y) * wa[3] + bflo(g0.z) * wa[4] + bfhi(g0.z) * wa[5] + bflo(g0.w) * wa[6] + bfhi(g0.w) * wa[7]
                     + bflo(g1.x) * wa[8] + bfhi(g1.x) * wa[9] + bflo(g1.y) * wa[10] + bfhi(g1.y) * wa[11] + bflo(g1.z) * wa[12] + bfhi(g1.z) * wa[13] + bflo(g1.w) * wa[14] + bfhi(g1.w) * wa[15];
        const float ls = fminf(z, 0.f) - __logf(1.f + __expf(-fabsf(z)));
        run += ls * (1.f / 16.f); bcum[k] = run; }
    __syncthreads();
    SEGT[w * 64 + kk] = run;
    __syncthreads();
    float off = 0.f, tot = 0.f;
#pragma unroll
    for (int sg = 0; sg < 8; ++sg) { const float v = SEGT[sg * 64 + kk]; off += (sg < w) ? v : 0.f; tot += v; }
#pragma unroll
    for (int k = 0; k < 8; ++k) bcum[k] += off;
    blast = tot;
}
__device__ __forceinline__ void gla_stage_v(const Ctx& c, const bf16_t* prow0, int h) {
    u32x4 t[2];
#pragma unroll
    for (int k = 0; k < 2; ++k) { const int idx = c.tid + NTHREADS * k, row = idx >> 4, ch = idx & 15; t[k] = *(const u32x4*)(prow0 + (size_t)row * NIN_PAD + C_GV + h * 128 + ch * 8); }
#pragma unroll
    for (int k = 0; k < 2; ++k) { const int idx = c.tid + NTHREADS * k, row = idx >> 4, ch = idx & 15; *(LAS u32x4*)(c.lds + GL_V + row * 272 + ch * 16) = t[k]; }
}
__device__ __forceinline__ void ph_gla_a(const Params& p, const Ctx& c) {
    LAS unsigned char* L = c.lds; const bf16_t* proj = (const bf16_t*)(p.ws + WS_PROJ);
    float* CKV = (float*)(p.ws + WS_CKV); float* DEC = (float*)(p.ws + WS_DEC);
    const int tid = c.tid, lane = c.lane, w = c.wave, r = lane & 15, qq = lane >> 4, kk = tid & 63;
    for (int item = c.blk; item < 2048; item += c.nblk) {
        const int h = item & 3, bn = item >> 2; const bf16_t* prow0 = proj + (size_t)bn * 64 * NIN_PAD;
        bf16_t kraw[8];
#pragma unroll
        for (int k = 0; k < 8; ++k) kraw[k] = prow0[(size_t)(8 * w + k) * NIN_PAD + C_GK + h * 64 + kk];
        float bcum[8], blast; gla_cumdecay(p, c, GLR_SRC, h, bcum, blast);
        gla_stage_v(c, prow0, h);
        { u32x4 o; float e[8];
#pragma unroll
          for (int k = 0; k < 8; ++k) e[k] = bf2f(kraw[k]) * __expf(blast - bcum[k]);
          o.x = pk2(e[0], e[1]); o.y = pk2(e[2], e[3]); o.z = pk2(e[4], e[5]); o.w = pk2(e[6], e[7]);
          *(LAS u32x4*)(L + GL_KT + kk * 144 + 16 * w) = o; }
        if (w == 0) DEC[(size_t)item * 64 + kk] = __expf(blast);
        __syncthreads();
        f32x4 acc[4];
#pragma unroll
        for (int n = 0; n < 4; ++n) acc[n] = (f32x4){0.f, 0.f, 0.f, 0.f};
#pragma unroll
        for (int s2 = 0; s2 < 2; ++s2) { LAS const unsigned char* vp = L + GL_V + (32 * s2 + 8 * qq + (r >> 2)) * 272 + (16 * w + 4 * (r & 3)) * 2;
            const s16x4 v0 = lds_tr16(vp), v1 = lds_tr16(vp + 4 * 272); const bf16x8 af = {v0[0], v0[1], v0[2], v0[3], v1[0], v1[1], v1[2], v1[3]};
#pragma unroll
            for (int n = 0; n < 4; ++n) { const bf16x8 bfr = __builtin_bit_cast(bf16x8, *(const LAS u32x4*)(L + GL_KT + (16 * n + r) * 144 + (32 * s2 + 8 * qq) * 2));
                acc[n] = __builtin_amdgcn_mfma_f32_16x16x32_bf16(af, bfr, acc[n], 0, 0, 0); } }
        float* outp = CKV + (size_t)item * 8192 + (16 * w + 4 * qq) * 64 + r;
#pragma unroll
        for (int n = 0; n < 4; ++n)
#pragma unroll
            for (int i = 0; i < 4; ++i) outp[i * 64 + 16 * n] = acc[n][i];
    }
}
__device__ __forceinline__ void ph_gla_b(const Params& p, const Ctx& c) {
    const float* CKV = (const float*)(p.ws + WS_CKV); const float* DEC = (const float*)(p.ws + WS_DEC); bf16_t* SP = (bf16_t*)(p.ws + WS_SPREV);
    for (int idx = c.gtid; idx < 16 * 8192; idx += c.gthreads) { const int bh = idx >> 13, e = idx & 8191, b = bh >> 2, h = bh & 3; float S = 0.f;
        for (int n0 = 0; n0 < 128; n0 += 8) { float cv[8], dv[8];
#pragma unroll
            for (int k = 0; k < 8; ++k) { const size_t item = (size_t)(b * 128 + n0 + k) * 4 + h; cv[k] = CKV[item * 8192 + e]; dv[k] = DEC[item * 64 + (e & 63)]; }
#pragma unroll
            for (int k = 0; k < 8; ++k) { const size_t item = (size_t)(b * 128 + n0 + k) * 4 + h; SP[item * 8192 + e] = (bf16_t)f2bf(S); S = dv[k] * S + cv[k]; } } }
}
__device__ __forceinline__ void ph_gla_c(const Params& p, const Ctx& c) {
    LAS unsigned char* L = c.lds; const bf16_t* proj = (const bf16_t*)(p.ws + WS_PROJ); const bf16_t* SP = (const bf16_t*)(p.ws + WS_SPREV); bf16_t* go = (bf16_t*)(p.ws + WS_GLAO);
    const int tid = c.tid, lane = c.lane, w = c.wave, r = lane & 15, qq = lane >> 4, kk = tid & 63;
    for (int item = c.blk; item < 2048; item += c.nblk) {
        const int h = item & 3, bn = item >> 2; const bf16_t* prow0 = proj + (size_t)bn * 64 * NIN_PAD;
        const int it = w & 3, vh = w >> 2;
        bf16_t qraw[8], kraw[8]; u32x4 spf[2][4];
#pragma unroll
        for (int k = 0; k < 8; ++k) { const bf16_t* pr = prow0 + (size_t)(8 * w + k) * NIN_PAD; qraw[k] = pr[C_GQ + h * 64 + kk]; kraw[k] = pr[C_GK + h * 64 + kk]; }
#pragma unroll
        for (int s2 = 0; s2 < 2; ++s2)
#pragma unroll
            for (int n = 0; n < 4; ++n) spf[s2][n] = *(const u32x4*)(SP + (size_t)item * 8192 + (64 * vh + 16 * n + r) * 64 + 32 * s2 + 8 * qq);
        float bcum[8], blast; gla_cumdecay(p, c, GLR_SRC, h, bcum, blast);
        gla_stage_v(c, prow0, h);
#pragma unroll
        for (int k = 0; k < 8; ++k) { const int i = 8 * w + k;
            const float qv = bf2f(qraw[k]) * 0.125f * __expf(bcum[k]), kv = bf2f(kraw[k]) * __expf(-bcum[k]);
            *(LAS bf16_t*)(L + GL_QD + i * 144 + kk * 2) = (bf16_t)f2bf(qv); *(LAS bf16_t*)(L + GL_KI + i * 144 + kk * 2) = (bf16_t)f2bf(kv); }
        __syncthreads();
        bf16x8 qf[2];
#pragma unroll
        for (int s2 = 0; s2 < 2; ++s2) qf[s2] = __builtin_bit_cast(bf16x8, *(const LAS u32x4*)(L + GL_QD + (16 * it + r) * 144 + (32 * s2 + 8 * qq) * 2));
        u32x2 pw[4];
#pragma unroll
        for (int jt = 0; jt < 4; ++jt) { f32x4 z = {0.f, 0.f, 0.f, 0.f};
            if (jt <= it) {
#pragma unroll
                for (int s2 = 0; s2 < 2; ++s2) { const bf16x8 kf = __builtin_bit_cast(bf16x8, *(const LAS u32x4*)(L + GL_KI + (16 * jt + r) * 144 + (32 * s2 + 8 * qq) * 2));
                    z = __builtin_amdgcn_mfma_f32_16x16x32_bf16(kf, qf[s2], z, 0, 0, 0); }
#pragma unroll
                for (int ii = 0; ii < 4; ++ii) z[ii] = (16 * jt + 4 * qq + ii <= 16 * it + r) ? z[ii] : 0.f; }
            pw[jt].x = pk2(z[0], z[1]); pw[jt].y = pk2(z[2], z[3]); }
        f32x4 acc[4];
#pragma unroll
        for (int n = 0; n < 4; ++n) acc[n] = (f32x4){0.f, 0.f, 0.f, 0.f};
#pragma unroll
        for (int s2 = 0; s2 < 2; ++s2) { if (2 * s2 <= it) {
            const u32x4 pq = {pw[2 * s2].x, pw[2 * s2].y, pw[2 * s2 + 1].x, pw[2 * s2 + 1].y};
            LAS const unsigned char* vp = L + GL_V + (32 * s2 + 4 * qq + (r >> 2)) * 272 + (64 * vh + 4 * (r & 3)) * 2;
#pragma unroll
            for (int n = 0; n < 4; ++n) { const s16x4 v0 = lds_tr16(vp + 32 * n), v1 = lds_tr16(vp + 32 * n + 16 * 272);
                const bf16x8 vf = {v0[0], v0[1], v0[2], v0[3], v1[0], v1[1], v1[2], v1[3]};
                acc[n] = __builtin_amdgcn_mfma_f32_16x16x32_bf16(__builtin_bit_cast(bf16x8, pq), vf, acc[n], 0, 0, 0); } } }
#pragma unroll
        for (int s2 = 0; s2 < 2; ++s2)
#pragma unroll
            for (int n = 0; n < 4; ++n) { const bf16x8 sf = __builtin_bit_cast(bf16x8, spf[s2][n]);
                acc[n] = __builtin_amdgcn_mfma_f32_16x16x32_bf16(qf[s2], sf, acc[n], 0, 0, 0); }
        bf16_t* outp = go + ((size_t)bn * 64 + 16 * it + 4 * qq) * 512 + h * 128 + 64 * vh + r;
#pragma unroll
        for (int n = 0; n < 4; ++n)
#pragma unroll
            for (int ii = 0; ii < 4; ++ii) outp[ii * 512 + 16 * n] = (bf16_t)f2bf(acc[n][ii]);
    }
}
#ifndef ATT_COMBINE
#define ATT_COMBINE 1
#endif
__device__ __forceinline__ void ph_mix(const Params& p, const Ctx& c) {
    const bf16_t* proj = (const bf16_t*)(p.ws + WS_PROJ); const bf16_t* go = (const bf16_t*)(p.ws + WS_GLAO); bf16_t* mixed = (bf16_t*)(p.ws + WS_ACT);
    const bf16_t* AO = (const bf16_t*)p.out; const float* LSE = (const float*)((const unsigned char*)p.out + 96 * MiB); const int hh = c.lane >> 3;
    float hg0[4], hg1[4];
#pragma unroll
    for (int h = 0; h < 4; ++h) { hg0[h] = p.gla_head_gain[h * 128 + 2 * c.lane]; hg1[h] = p.gla_head_gain[h * 128 + 2 * c.lane + 1]; }
    for (int m0 = c.gwave; m0 < M; m0 += 4 * c.gwaves) {
        unsigned ow[4][4], gw[4][4]; float ls[4][3]; u32x4 av[4][3];
#pragma unroll
        for (int u = 0; u < 4; ++u) { const int m = min(m0 + u * c.gwaves, M - 1);
#pragma unroll
            for (int h = 0; h < 4; ++h) { const int col = h * 128 + 2 * c.lane; ow[u][h] = *(const unsigned*)(go + (size_t)m * 512 + col); gw[u][h] = *(const unsigned*)(proj + (size_t)m * NIN_PAD + C_GG + col); }
#pragma unroll
            for (int br = 0; br < 3; ++br) { ls[u][br] = LSE[((size_t)br * M + m) * 8 + hh]; av[u][br] = *((const u32x4*)(AO + ((size_t)br * M + m) * 512) + c.lane); } }
        asm volatile("" ::: "memory");
#pragma unroll
        for (int u = 0; u < 4; ++u) { const int m = m0 + u * c.gwaves; if (m >= M) break;
#pragma unroll
            for (int h = 0; h < 4; ++h) { const int col = h * 128 + 2 * c.lane;
                const float o0 = bflo(ow[u][h]), o1 = bfhi(ow[u][h]);
                const float rstd = 1.f / sqrtf(wave_sum(o0 * o0 + o1 * o1) * (1.f / 128.f) + NORM_EPS);
                const float g0 = bflo(gw[u][h]), g1 = bfhi(gw[u][h]);
                const float r0 = o0 * rstd * hg0[h] * (g0 * sigmoidf_(g0)), r1 = o1 * rstd * hg1[h] * (g1 * sigmoidf_(g1));
                *(unsigned*)(mixed + (size_t)m * DM + col) = pk2(r0, r1); }
            {
                const float l0 = ls[u][0], l1 = ls[u][1], l2 = ls[u][2];
                const float lm = fmaxf(l0, fmaxf(l1, l2)), e0 = __expf(l0 - lm), e1 = __expf(l1 - lm), e2 = __expf(l2 - lm), rd = __builtin_amdgcn_rcpf(e0 + e1 + e2);
                const float w0 = e0 * rd, w1 = e1 * rd, w2 = e2 * rd;
                const u32x4 a0 = av[u][0], a1 = av[u][1], a2 = av[u][2];
                u32x4 o;
                o.x = pk2(w0 * bflo(a0.x) + w1 * bflo(a1.x) + w2 * bflo(a2.x), w0 * bfhi(a0.x) + w1 * bfhi(a1.x) + w2 * bfhi(a2.x));
                o.y = pk2(w0 * bflo(a0.y) + w1 * bflo(a1.y) + w2 * bflo(a2.y), w0 * bfhi(a0.y) + w1 * bfhi(a1.y) + w2 * bfhi(a2.y));
                o.z = pk2(w0 * bflo(a0.z) + w1 * bflo(a1.z) + w2 * bflo(a2.z), w0 * bfhi(a0.z) + w1 * bfhi(a1.z) + w2 * bfhi(a2.z));
                o.w = pk2(w0 * bflo(a0.w) + w1 * bflo(a1.w) + w2 * bflo(a2.w), w0 * bfhi(a0.w) + w1 * bfhi(a1.w) + w2 * bfhi(a2.w));
                *((u32x4*)(mixed + (size_t)m * DM + 512) + c.lane) = o; } }
    }
}
constexpr int GR_WGT = 0, GR_XC = 65536, GR_A = 81920, GR_U = 115712, GR_SEG = 132608, GR_CW = 136704, GR_GB = 139264;
__device__ __forceinline__ float fast_sigmoid(float x) { return __builtin_amdgcn_rcpf(1.f + __expf(-x)); }
__device__ __forceinline__ void griffin_pass(const Params& p, const Ctx& c) {
    LAS unsigned char* L = c.lds;
    const int tid = c.tid, lane = c.lane, wave = c.wave, g = c.blk & 7;
    const bf16_t* proj = (const bf16_t*)(p.ws + WS_PROJ); bf16_t* yout = (bf16_t*)(p.ws + WS_Y0); bf16_t* ypout = (bf16_t*)((unsigned char*)p.out + 64 * MiB);
    float* AGA = (float*)(p.ws + WS_AGG); float* AGH = AGA + BATCH * 128 * 1024;
    LAS float* A_ = (LAS float*)(L + GR_A); LAS bf16_t* U_ = (LAS bf16_t*)(L + GR_U); LAS float* SEG = (LAS float*)(L + GR_SEG); LAS float* CW = (LAS float*)(L + GR_CW); LAS float* GB = (LAS float*)(L + GR_GB);
    __syncthreads();
    { const bf16_t* wg = (const bf16_t*)(p.ws + WS_WG);
      for (int ch = tid; ch < 4096; ch += NTHREADS) { const int gate = ch >> 11, j = (ch >> 4) & 127, cc = ch & 15;
          const u32x4 v = *(const u32x4*)(wg + ((size_t)(gate * 8 + g) * 128 + j) * 128 + cc * 8);
          *(LAS u32x4*)(L + GR_WGT + gate * 32768 + j * 256 + ((cc ^ (j & 15)) << 4)) = v; }
      if (tid < 128) { const int ch = g * 128 + tid;
#pragma unroll
          for (int jj = 0; jj < 4; ++jj) CW[jj * 128 + tid] = p.c_conv_w[jj * 1024 + ch];
          CW[4 * 128 + tid] = p.c_conv_b[ch]; GB[tid] = p.c_b_rgate[ch]; GB[128 + tid] = p.c_b_igate[ch];
          const float lam = p.c_lambda[ch]; GB[256 + tid] = fmaxf(-lam, 0.f) + log1pf(expf(-fabsf(lam))); } }
    __syncthreads();
    const int nslot = BATCH * 128, sstep = c.nblk >> 3;
    u32x4 xr[5];
#define GR_XLOAD(sl_) do { const int b_ = (sl_) >> 7, t0_ = ((sl_) & 127) * 64; const size_t r0_ = (size_t)b_ * SEQ + t0_; const int co_ = tid & 15, tp_ = tid >> 4; \
        _Pragma("unroll") for (int jj = 0; jj < 5; ++jj) { const int tt = t0_ + 2 * tp_ - 3 + jj; xr[jj] = (u32x4){0u, 0u, 0u, 0u}; \
            if (tt >= 0) xr[jj] = *(const u32x4*)(proj + (r0_ + 2 * tp_ - 3 + jj) * 2048 + 1024 + g * 128 + co_ * 8); } } while (0)
    if ((c.blk >> 3) < nslot) GR_XLOAD(c.blk >> 3);
    for (int slot = c.blk >> 3; slot < nslot; slot += sstep) {
        const int b = slot >> 7, tile = slot & 127, t0 = tile * 64; const size_t row0 = (size_t)b * SEQ + t0;
        u32x4 gpre[2];
        { const int co = tid & 15, tp = tid >> 4;
#pragma unroll
            for (int tl = 0; tl < 2; ++tl) gpre[tl] = *(const u32x4*)(proj + (row0 + 2 * tp + tl) * 2048 + g * 128 + co * 8); }
        { const int co = tid & 15, tp = tid >> 4;
          f32x4 w[5][2];
#pragma unroll
          for (int jj = 0; jj < 5; ++jj) { w[jj][0] = *(const LAS f32x4*)(CW + jj * 128 + co * 8); w[jj][1] = *(const LAS f32x4*)(CW + jj * 128 + co * 8 + 4); }
#pragma unroll
          for (int tl = 0; tl < 2; ++tl) { float a8[8];
#pragma unroll
              for (int e = 0; e < 8; ++e) a8[e] = w[4][e >> 2][e & 3];
#pragma unroll
              for (int jj = 0; jj < 4; ++jj) { const u32x4 xv = xr[tl + jj]; const unsigned xw[4] = {xv.x, xv.y, xv.z, xv.w};
#pragma unroll
                  for (int e = 0; e < 8; ++e) { const float xe = (e & 1) ? bfhi(xw[e >> 1]) : bflo(xw[e >> 1]); a8[e] += w[jj][e >> 2][e & 3] * xe; } }
              const int t = 2 * tp + tl; u32x4 o; o.x = pk2(a8[0], a8[1]); o.y = pk2(a8[2], a8[3]); o.z = pk2(a8[4], a8[5]); o.w = pk2(a8[6], a8[7]);
              *(LAS u32x4*)(L + GR_XC + t * 256 + ((co ^ (t & 15)) << 4)) = o; } }
        if (slot + sstep < nslot) GR_XLOAD(slot + sstep);
        __syncthreads();
        { const int tt = wave & 3, jh = wave >> 2, r = lane & 15, q = lane >> 4, t = 16 * tt + r;
          f32x4 ar[4], ai[4];
#pragma unroll
          for (int n = 0; n < 4; ++n) { ar[n] = (f32x4){0.f, 0.f, 0.f, 0.f}; ai[n] = (f32x4){0.f, 0.f, 0.f, 0.f}; }
#pragma unroll
          for (int s = 0; s < 4; ++s) { const bf16x8 xb = __builtin_bit_cast(bf16x8, *(const LAS u32x4*)(L + GR_XC + t * 256 + (((4 * s + q) ^ (t & 15)) << 4)));
#pragma unroll
              for (int n = 0; n < 4; ++n) { const int j = 64 * jh + 16 * n + r;
                  const bf16x8 wr = __builtin_bit_cast(bf16x8, *(const LAS u32x4*)(L + GR_WGT + j * 256 + (((4 * s + q) ^ (j & 15)) << 4)));
                  const bf16x8 wi = __builtin_bit_cast(bf16x8, *(const LAS u32x4*)(L + GR_WGT + 32768 + j * 256 + (((4 * s + q) ^ (j & 15)) << 4)));
                  ar[n] = __builtin_amdgcn_mfma_f32_16x16x32_bf16(wr, xb, ar[n], 0, 0, 0); ai[n] = __builtin_amdgcn_mfma_f32_16x16x32_bf16(wi, xb, ai[n], 0, 0, 0); } }
#pragma unroll
          for (int n = 0; n < 4; ++n) { const int j0 = 64 * jh + 16 * n + 4 * q;
              const f32x4 br = *(const LAS f32x4*)(GB + j0), bi = *(const LAS f32x4*)(GB + 128 + j0), sp = *(const LAS f32x4*)(GB + 256 + j0);
              const u32x2 xw = *(const LAS u32x2*)(L + GR_XC + t * 256 + ((((j0 >> 3) ^ (t & 15)) << 4) + (j0 & 7) * 2));
              const float xc[4] = {bflo(xw.x), bfhi(xw.x), bflo(xw.y), bfhi(xw.y)};
              f32x4 av; float uv[4];
#pragma unroll
              for (int i = 0; i < 4; ++i) { const float rr = fast_sigmoid(ar[n][i] + br[i]), ii = fast_sigmoid(ai[n][i] + bi[i]);
                  const float a = __expf(-8.f * rr * sp[i]); av[i] = a; uv[i] = __builtin_amdgcn_sqrtf(fmaxf(1.f - a * a, 0.f)) * (ii * xc[i]); }
              *(LAS f32x4*)(A_ + t * 132 + j0) = av; u32x2 uo; uo.x = pk2(uv[0], uv[1]); uo.y = pk2(uv[2], uv[3]); *(LAS u32x2*)(U_ + t * 132 + j0) = uo; } }
        __syncthreads();
        const int j = tid & 127, seg = tid >> 7;
        float hl[16], pl[16];
        { float aa = 1.f, hh = 0.f;
#pragma unroll
          for (int i = 0; i < 16; ++i) { const int t = seg * 16 + i; const float a = A_[t * 132 + j], u = bf2f(U_[t * 132 + j]); hh = a * hh + u; aa *= a; hl[i] = hh; pl[i] = aa; }
          SEG[seg * 128 + j] = aa; SEG[512 + seg * 128 + j] = hh; }
        __syncthreads();
        { float hin = 0.f, pin = 1.f;
          for (int sgi = 0; sgi < seg; ++sgi) { const float sa = SEG[sgi * 128 + j]; hin = sa * hin + SEG[512 + sgi * 128 + j]; pin *= sa; }
#pragma unroll
          for (int i = 0; i < 16; ++i) { const int t = seg * 16 + i; A_[t * 132 + j] = hl[i] + pl[i] * hin; U_[t * 132 + j] = (bf16_t)f2bf(pl[i] * pin); }
          if (seg == 3) { const size_t e = ((size_t)b * 128 + tile) * 1024 + g * 128 + j; AGA[e] = pl[15] * pin; AGH[e] = hl[15] + pl[15] * hin; } }
        __syncthreads();
        { const int co = tid & 15, tp = tid >> 4;
#pragma unroll
          for (int tl = 0; tl < 2; ++tl) { const int t = 2 * tp + tl;
              const f32x4 h0 = *(const LAS f32x4*)(A_ + t * 132 + co * 8), h1 = *(const LAS f32x4*)(A_ + t * 132 + co * 8 + 4);
              const u32x2 pa = *(const LAS u32x2*)(U_ + t * 132 + co * 8), pb = *(const LAS u32x2*)(U_ + t * 132 + co * 8 + 4);
              const u32x4 gw = gpre[tl];
              const float g0 = gelu_tanh(bflo(gw.x)), g1 = gelu_tanh(bfhi(gw.x)), g2 = gelu_tanh(bflo(gw.y)), g3 = gelu_tanh(bfhi(gw.y));
              const float g4 = gelu_tanh(bflo(gw.z)), g5 = gelu_tanh(bfhi(gw.z)), g6 = gelu_tanh(bflo(gw.w)), g7 = gelu_tanh(bfhi(gw.w));
              u32x4 o; o.x = pk2(g0 * h0.x, g1 * h0.y); o.y = pk2(g2 * h0.z, g3 * h0.w); o.z = pk2(g4 * h1.x, g5 * h1.y); o.w = pk2(g6 * h1.z, g7 * h1.w);
              u32x4 q; q.x = pk2(g0 * bflo(pa.x), g1 * bfhi(pa.x)); q.y = pk2(g2 * bflo(pa.y), g3 * bfhi(pa.y)); q.z = pk2(g4 * bflo(pb.x), g5 * bfhi(pb.x)); q.w = pk2(g6 * bflo(pb.y), g7 * bfhi(pb.y));
              *(u32x4*)(yout + (row0 + t) * DM + g * 128 + co * 8) = o; *(u32x4*)(ypout + (row0 + t) * DM + g * 128 + co * 8) = q; } }
    }
#undef GR_XLOAD
}
__device__ __forceinline__ void ph_carry(const Params& p, const Ctx& c) {
    const float* AGA = (const float*)(p.ws + WS_AGG); const float* AGH = AGA + BATCH * 128 * 1024; float* CAR = (float*)(AGH + BATCH * 128 * 1024);
    for (int idx = c.gtid; idx < BATCH * 1024; idx += c.gthreads) { const int b = idx >> 10, ch = idx & 1023; float cy = 0.f;
        for (int t0 = 0; t0 < 128; t0 += 8) { float a[8], h[8];
#pragma unroll
            for (int k = 0; k < 8; ++k) { const size_t e = ((size_t)b * 128 + t0 + k) * 1024 + ch; a[k] = AGA[e]; h[k] = AGH[e]; }
            asm volatile("" : "+v"(a[0]), "+v"(a[1]), "+v"(a[2]), "+v"(a[3]), "+v"(a[4]), "+v"(a[5]), "+v"(a[6]), "+v"(a[7]), "+v"(h[0]), "+v"(h[1]), "+v"(h[2]), "+v"(h[3]), "+v"(h[4]), "+v"(h[5]), "+v"(h[6]), "+v"(h[7]));
#pragma unroll
            for (int k = 0; k < 8; ++k) { CAR[((size_t)b * 128 + t0 + k) * 1024 + ch] = cy; cy = a[k] * cy + h[k]; } } }
}
__device__ __forceinline__ void ph_gr_fix(const Params& p, const Ctx& c) {
    bf16_t* y = (bf16_t*)(p.ws + WS_ACT); const bf16_t* y0 = (const bf16_t*)(p.ws + WS_Y0); const bf16_t* yp = (const bf16_t*)((const unsigned char*)p.out + 64 * MiB);
    const float* CAR = (const float*)(p.ws + WS_AGG) + 2 * BATCH * 128 * 1024;
    const int cg = c.gtid & 127, rsub = c.gtid >> 7, rstep = c.gthreads >> 7;
    for (int r0 = rsub; r0 < M; r0 += 4 * rstep) {
        u32x4 a[4], q[4]; f32x4 c0[4], c1[4];
#pragma unroll
        for (int u = 0; u < 4; ++u) { const int row = min(r0 + u * rstep, M - 1), b = row >> 13, tile = (row & 8191) >> 6;
            const float* cr = CAR + ((size_t)b * 128 + tile) * 1024 + cg * 8; c0[u] = *(const f32x4*)cr; c1[u] = *(const f32x4*)(cr + 4);
            a[u] = *(const u32x4*)(y0 + (size_t)row * DM + cg * 8); q[u] = *(const u32x4*)(yp + (size_t)row * DM + cg * 8); }
        asm volatile("" : "+v"(a[0]), "+v"(a[1]), "+v"(a[2]), "+v"(a[3]), "+v"(q[0]), "+v"(q[1]), "+v"(q[2]), "+v"(q[3]));
#pragma unroll
        for (int u = 0; u < 4; ++u) { const int row = r0 + u * rstep; if (row >= M) break;
            u32x4 o; o.x = pk2(bflo(a[u].x) + bflo(q[u].x) * c0[u].x, bfhi(a[u].x) + bfhi(q[u].x) * c0[u].y); o.y = pk2(bflo(a[u].y) + bflo(q[u].y) * c0[u].z, bfhi(a[u].y) + bfhi(q[u].y) * c0[u].w);
            o.z = pk2(bflo(a[u].z) + bflo(q[u].z) * c1[u].x, bfhi(a[u].z) + bfhi(q[u].z) * c1[u].y); o.w = pk2(bflo(a[u].w) + bflo(q[u].w) * c1[u].z, bfhi(a[u].w) + bfhi(q[u].w) * c1[u].w);
            *(u32x4*)(y + (size_t)row * DM + cg * 8) = o; }
    }
}
__device__ __forceinline__ void cvt_gate_weights(const Params& p, const Ctx& c) {
    bf16_t* wg = (bf16_t*)(p.ws + WS_WG);
    for (int idx = c.gtid; idx < 2 * 8 * 16 * 128; idx += c.gthreads) { const int j = idx & 127, io = (idx >> 7) & 15, g = (idx >> 11) & 7, gate = idx >> 14;
        const float* s = (gate ? p.c_w_igate : p.c_w_rgate) + (size_t)g * 16384 + (io * 8) * 128 + j;
        u32x4 w; w.x = pk2(s[0], s[128]); w.y = pk2(s[256], s[384]); w.z = pk2(s[512], s[640]); w.w = pk2(s[768], s[896]);
        *(u32x4*)(wg + ((size_t)(gate * 8 + g) * 128 + j) * 128 + io * 8) = w; }
}


constexpr size_t WS_SK = 25 * MiB;
constexpr int TK_SK = 0, TK_Q = 69632, TK_S = 86528, TK_L = 119552  , TK_O = 135936, TK_TAB = 144128;
typedef int i32x4 __attribute__((ext_vector_type(4)));
__device__ __forceinline__ int key_xform(int b) { return b ^ ((b >> 31) & 0x7fffffff); }
#define CEX(a, b) do { const int hi_ = max((a), (b)), lo_ = min((a), (b)); (a) = hi_; (b) = lo_; } while (0)
__device__ __forceinline__ void bitonic_merge16_desc(int (&v)[16]) {
#pragma unroll
    for (int j = 8; j >= 1; j >>= 1)
#pragma unroll
        for (int i = 0; i < 16; ++i) if ((i & j) == 0) CEX(v[i], v[i | j]);
}
__device__ __forceinline__ void bitonic_sort16_desc(int (&v)[16]) {
#pragma unroll
    for (int k = 2; k <= 16; k <<= 1)
#pragma unroll
        for (int j = k >> 1; j >= 1; j >>= 1)
#pragma unroll
            for (int i = 0; i < 16; ++i) { const int l = i ^ j; if (l > i) { if ((i & k) == 0 || k == 16) CEX(v[i], v[l]); else CEX(v[l], v[i]); } }
}
__device__ __forceinline__ void ph_topk(const Params& p, int layer, const Ctx& c) {
    LAS unsigned char* L = c.lds; const bf16_t* Q = (const bf16_t*)(p.ws + WS_PROJ);
    int* ids = (int*)(p.ws + WS_IDS); float* gg = (float*)(p.ws + WS_G);
    const int tid = c.tid, lane = c.lane, w = c.wave, r = lane & 15, qq = lane >> 4, h = c.blk & 7;
    LAS float* S = (LAS float*)(L + TK_S); LAS int* LST = (LAS int*)(L + TK_L); LAS int* OUTK = (LAS int*)(L + TK_O); LAS int* TAB = (LAS int*)(L + TK_TAB);
    __syncthreads();
    { const bf16_t* sk = (const bf16_t*)(p.ws + WS_SK) + ((size_t)layer * 8 + h) * 2 * 128 * 128;
      for (int ch = tid; ch < 4096; ch += NTHREADS) { const int row = ch >> 4, cc = ch & 15;
          *(LAS u32x4*)(L + TK_SK + row * 272 + cc * 16) = *(const u32x4*)(sk + (size_t)row * 128 + cc * 8); }
      if (tid < 64) { int cnt = 0, code = -1;
          for (int i = 0; i < 16; ++i) for (int j = 0; j < 16 / (i + 1); ++j) { if (cnt == tid) code = i * 16 + j; ++cnt; }
          TAB[tid] = code; } }
    const int nslot = M / 32, sstep = c.nblk >> 3;
    u32x4 qpre[2];
#define TK_QLOAD(sl_) do { _Pragma("unroll") for (int k = 0; k < 2; ++k) { const int idx = tid + NTHREADS * k, row = idx >> 5, ch = idx & 31; \
        qpre[k] = *(const u32x4*)(Q + (size_t)(min((sl_), nslot - 1) * 32 + row) * 2048 + h * 256 + ch * 8); } } while (0)
#define TK_MERGE(CTRL) do { int o_[16]; _Pragma("unroll") for (int i = 0; i < 16; ++i) o_[i] = __builtin_amdgcn_update_dpp(0, v[15 - i], (CTRL), 0xf, 0xf, false); \
        _Pragma("unroll") for (int i = 0; i < 16; ++i) v[i] = max(v[i], o_[i]); bitonic_merge16_desc(v); } while (0)
    TK_QLOAD(c.blk >> 3);
    int gfirst = 0, gi = 0;
    for (int slot = c.blk >> 3; slot < nslot; slot += sstep) {
        __syncthreads();
#pragma unroll
        for (int k = 0; k < 2; ++k) { const int idx = tid + NTHREADS * k, row = idx >> 5, ch = idx & 31; *(LAS u32x4*)(L + TK_Q + row * 528 + ch * 16) = qpre[k]; }
        TK_QLOAD(slot + sstep);
        __syncthreads();
        { const int pp = w >> 2, mt = (w >> 1) & 1, nh = w & 1;
          f32x4 acc[4];
#pragma unroll
          for (int nt = 0; nt < 4; ++nt) acc[nt] = (f32x4){0.f, 0.f, 0.f, 0.f};
#pragma unroll
          for (int s2 = 0; s2 < 4; ++s2) { const bf16x8 af = __builtin_bit_cast(bf16x8, *(const LAS u32x4*)(L + TK_Q + (16 * mt + r) * 528 + (pp * 128 + 32 * s2 + 8 * qq) * 2));
#pragma unroll
              for (int nt = 0; nt < 4; ++nt) { const bf16x8 bfr = __builtin_bit_cast(bf16x8, *(const LAS u32x4*)(L + TK_SK + (pp * 128 + 16 * (4 * nh + nt) + r) * 272 + (32 * s2 + 8 * qq) * 2));
                  acc[nt] = __builtin_amdgcn_mfma_f32_16x16x32_bf16(af, bfr, acc[nt], 0, 0, 0); } }
#pragma unroll
          for (int nt = 0; nt < 4; ++nt)
#pragma unroll
              for (int i = 0; i < 4; ++i) S[(pp * 32 + 16 * mt + 4 * qq + i) * 129 + 16 * (4 * nh + nt) + r] = acc[nt][i]; }
        __syncthreads();
        {
          const int m = tid >> 4, sub = tid & 15, pp = sub >> 3, part = sub & 7; int v[16];
#pragma unroll
          for (int k = 0; k < 16; ++k) { const int n = 8 * k + part; v[k] = key_xform((__builtin_bit_cast(int, S[(pp * 32 + m) * 129 + n]) & ~127) | n); }
          bitonic_sort16_desc(v);
          TK_MERGE(0xB1);
          TK_MERGE(0x4E);
          TK_MERGE(0x141);
          if (part == 0) {
#pragma unroll
              for (int k = 0; k < 16; ++k) LST[((gi * 32 + m) * 2 + pp) * 16 + k] = key_xform(v[k]); } }
        if (gi == 0) gfirst = slot;
        ++gi;
        if (gi < 4 && slot + sstep < nslot) continue;
        __syncthreads();
        {
          const int tq = tid >> 2, sub = tid & 3, grp = tq >> 5, m = tq & 31;
          if (grp < gi) {
              const int slot_g = gfirst + grp * sstep;
              LAS const int* L1 = LST + (tq * 2 + 0) * 16; LAS const int* L2 = LST + (tq * 2 + 1) * 16;
              int v[16];
#pragma unroll
              for (int k = 0; k < 16; ++k) { const int ci = sub * 16 + k; const int code = TAB[ci]; int key = (int)0x80000000;
                  if (code >= 0) { const float s1 = __builtin_bit_cast(float, L1[code >> 4] & ~127), s2v = __builtin_bit_cast(float, L2[code & 15] & ~127);
                      key = key_xform((__builtin_bit_cast(int, s1 + s2v) & ~63) | (63 - ci)); }
                  v[k] = key; }
              bitonic_sort16_desc(v);
              TK_MERGE(0xB1); TK_MERGE(0x4E);
              const float smax = __builtin_bit_cast(float, key_xform(v[0]) & ~63);
              if (sub == 0) {
#pragma unroll
                  for (int k4 = 0; k4 < 4; ++k4) *(LAS i32x4*)(OUTK + tq * 16 + 4 * k4) = (i32x4){v[4 * k4], v[4 * k4 + 1], v[4 * k4 + 2], v[4 * k4 + 3]}; }
              asm volatile("s_waitcnt lgkmcnt(0)" ::: "memory");
              const i32x4 mine = *(const LAS i32x4*)(OUTK + tq * 16 + 4 * sub);
              float e[4]; int kb[4];
#pragma unroll
              for (int j = 0; j < 4; ++j) { kb[j] = key_xform(mine[j]); e[j] = __expf(__builtin_bit_cast(float, kb[j] & ~63) - smax); }
              float den = (e[0] + e[1]) + (e[2] + e[3]);
              den += __builtin_bit_cast(float, __builtin_amdgcn_update_dpp(0, __builtin_bit_cast(int, den), 0xB1, 0xf, 0xf, false));
              den += __builtin_bit_cast(float, __builtin_amdgcn_update_dpp(0, __builtin_bit_cast(int, den), 0x4E, 0xf, 0xf, false));
              const float rden = __builtin_amdgcn_rcpf(den); i32x4 oi; f32x4 og;
#pragma unroll
              for (int j = 0; j < 4; ++j) { const int code = TAB[63 - (kb[j] & 63)]; oi[j] = (L1[code >> 4] & 127) * 128 + (L2[code & 15] & 127); og[j] = e[j] * rden; }
              const size_t o = (size_t)(slot_g * 32 + m) * 128 + h * 16 + 4 * sub;
              *(i32x4*)(ids + o) = oi; *(f32x4*)(gg + o) = og; } }
        gi = 0;
    }
#undef TK_QLOAD
#undef TK_MERGE
}


__device__ __forceinline__ float wave_max(float v) {
#pragma unroll
    for (int o = 1; o < 64; o <<= 1) v = fmaxf(v, __shfl_xor(v, o));
    return v;
}
__device__ __forceinline__ void cvt_fp8_rows(const float* src, unsigned char* dst, float* scl, int nrows, const Ctx& c) {
    for (int row0 = c.gwave; row0 < nrows; row0 += 4 * c.gwaves) {
        f32x4 v[4][4];
#pragma unroll
        for (int u = 0; u < 4; ++u) { const f32x4* sp = (const f32x4*)(src + (size_t)min(row0 + u * c.gwaves, nrows - 1) * DM) + 4 * c.lane;
#pragma unroll
            for (int j = 0; j < 4; ++j) v[u][j] = sp[j]; }
#pragma unroll
        for (int u = 0; u < 4; ++u) { const int row = row0 + u * c.gwaves; if (row >= nrows) break;
            float mx = 0.f;
#pragma unroll
            for (int j = 0; j < 4; ++j) mx = fmaxf(mx, fmaxf(fmaxf(fabsf(v[u][j].x), fabsf(v[u][j].y)), fmaxf(fabsf(v[u][j].z), fabsf(v[u][j].w))));
            mx = wave_max(mx);
            const float sc = mx > 0.f ? mx * (1.f / 416.f) : 1.f, inv = 1.f / sc;
            u32x4 w; int t;
            t = __builtin_amdgcn_cvt_pk_fp8_f32(v[u][0].x * inv, v[u][0].y * inv, 0, false); t = __builtin_amdgcn_cvt_pk_fp8_f32(v[u][0].z * inv, v[u][0].w * inv, t, true); w.x = (unsigned)t;
            t = __builtin_amdgcn_cvt_pk_fp8_f32(v[u][1].x * inv, v[u][1].y * inv, 0, false); t = __builtin_amdgcn_cvt_pk_fp8_f32(v[u][1].z * inv, v[u][1].w * inv, t, true); w.y = (unsigned)t;
            t = __builtin_amdgcn_cvt_pk_fp8_f32(v[u][2].x * inv, v[u][2].y * inv, 0, false); t = __builtin_amdgcn_cvt_pk_fp8_f32(v[u][2].z * inv, v[u][2].w * inv, t, true); w.z = (unsigned)t;
            t = __builtin_amdgcn_cvt_pk_fp8_f32(v[u][3].x * inv, v[u][3].y * inv, 0, false); t = __builtin_amdgcn_cvt_pk_fp8_f32(v[u][3].z * inv, v[u][3].w * inv, t, true); w.w = (unsigned)t;
            *(u32x4*)(dst + (size_t)(c.lane >> 3) * NEXP * 128 + (size_t)row * 128 + (c.lane & 7) * 16) = w;
            if (c.lane == 0) scl[row] = sc; }
    }
}
typedef float f32x2 __attribute__((ext_vector_type(2)));
__device__ __forceinline__ u32x2 fp8x4_to_bf16x4(unsigned w) {
    const f32x2 a = __builtin_amdgcn_cvt_pk_f32_fp8((int)w, false), b = __builtin_amdgcn_cvt_pk_f32_fp8((int)w, true);
    u32x2 o;
    asm("v_cvt_pk_bf16_f32 %0, %1, %2" : "=v"(o.x) : "v"(a.x), "v"(a.y));
    asm("v_cvt_pk_bf16_f32 %0, %1, %2" : "=v"(o.y) : "v"(b.x), "v"(b.y));
    return o;
}


constexpr size_t WS_PD = WS_S;
constexpr size_t WS_ACTB = WS_S + 224 * MiB;
struct XI { int xr, nx, jr, nloc; };
typedef long i64_t;
__device__ __forceinline__ i64_t pack64(unsigned lo, unsigned hi) { return (i64_t)(((unsigned long long)hi << 32) | lo); }
typedef int i32x8 __attribute__((ext_vector_type(8)));
#define PIN16(o) asm volatile("" : "+v"(o[0]), "+v"(o[1]), "+v"(o[2]), "+v"(o[3]), "+v"(o[4]), "+v"(o[5]), "+v"(o[6]), "+v"(o[7]), "+v"(o[8]), "+v"(o[9]), "+v"(o[10]), "+v"(o[11]), "+v"(o[12]), "+v"(o[13]), "+v"(o[14]), "+v"(o[15]))

constexpr size_t WS_ACT8 = WS_S + 224 * MiB;
constexpr size_t WS_SA = WS_S + 240 * MiB;
__device__ __forceinline__ void ph_peer_act2(const Params& p, int layer, const Ctx& c) {
    const bf16_t* PDh = (const bf16_t*)(p.ws + WS_PD); unsigned char* A8 = p.ws + WS_ACT8; float* SA = (float*)(p.ws + WS_SA);
    const float* SU = (const float*)(p.ws + WS_SCL) + (size_t)layer * 2 * NEXP; const float* SV = SU + NEXP;
    const int* ids = (const int*)(p.ws + WS_IDS); const float* gg = (const float*)(p.ws + WS_G);
    const int lane = c.lane;
    for (int t0 = c.gwave; t0 < M; t0 += 4 * c.gwaves) {
        float d0[4], d1[4], g0[4], g1[4], su0[4], su1[4], sv0[4], sv1[4]; int id0[4], id1[4];
#pragma unroll
        for (int u = 0; u < 4; ++u) { const int t = min(t0 + u * c.gwaves, M - 1); id0[u] = ids[(size_t)t * 128 + lane]; id1[u] = ids[(size_t)t * 128 + 64 + lane]; g0[u] = gg[(size_t)t * 128 + lane]; g1[u] = gg[(size_t)t * 128 + 64 + lane]; }
#pragma unroll
        for (int u = 0; u < 4; ++u) { const int t = min(t0 + u * c.gwaves, M - 1); d0[u] = 0.f; d1[u] = 0.f;
#pragma unroll
            for (int sl = 0; sl < 8; ++sl) { d0[u] += bf2f(PDh[((size_t)sl * M + t) * 128 + lane]); d1[u] += bf2f(PDh[((size_t)sl * M + t) * 128 + 64 + lane]); } }
#pragma unroll
        for (int u = 0; u < 4; ++u) { su0[u] = SU[id0[u]]; su1[u] = SU[id1[u]]; sv0[u] = SV[id0[u]]; sv1[u] = SV[id1[u]]; }
#pragma unroll
        for (int u = 0; u < 4; ++u) { const int t = t0 + u * c.gwaves; if (t >= M) break;
            const float a0 = gelu_tanh(d0[u] * su0[u]) * g0[u] * sv0[u], a1 = gelu_tanh(d1[u] * su1[u]) * g1[u] * sv1[u];
            const float mx = wave_max(fmaxf(fabsf(a0), fabsf(a1)));
            const float sa = mx > 0.f ? mx * (1.f / 256.f) : 1.f, inv = 1.f / sa;
            const float b0 = a0 * inv, b1 = a1 * inv;
            const int hq = __builtin_amdgcn_cvt_pk_fp8_f32(b0, b1, 0, false);
            const f32x2 hd = __builtin_amdgcn_cvt_pk_f32_fp8(hq, false);
            const int lq = __builtin_amdgcn_cvt_pk_fp8_f32((b0 - hd.x) * 16.f, (b1 - hd.y) * 16.f, 0, false);
            unsigned char* o = A8 + (size_t)t * 256;
            o[lane] = (unsigned char)(hq & 0xff); o[64 + lane] = (unsigned char)((hq >> 8) & 0xff); o[128 + lane] = (unsigned char)(lq & 0xff); o[192 + lane] = (unsigned char)((lq >> 8) & 0xff);
            if (lane == 0) SA[t] = sa; }
    }
}
typedef int i32x2 __attribute__((ext_vector_type(2)));
__device__ __forceinline__ i32x2 lds_tr8(LAS const unsigned char* pb) { return __builtin_amdgcn_ds_read_tr8_b64_v2i32((LAS i32x2*)pb); }
__device__ __forceinline__ void ph_peer_v2(const Params& p, int layer, const Ctx& c, const XI xi, bf16_t* hdst, int idmask) {
    const unsigned char* VT = p.ws + WS_TAB8 + (size_t)layer * 2 * NEXP * DM + (size_t)NEXP * DM;
    const int* ids = (const int*)(p.ws + WS_IDS); const unsigned char* A8 = p.ws + WS_ACT8; const float* SA = (const float*)(p.ws + WS_SA);
    const int lane = c.lane, e8 = lane >> 3, cc = lane & 7, r = lane & 15, q = lane >> 4;
    const int tstep = xi.nloc * NWAVES;
    LAS unsigned char* img = c.lds + c.wave * 16384;
#pragma unroll 1
    for (int sl = xi.xr; sl < 8; sl += xi.nx) {
        const unsigned char* Vs = VT + (size_t)sl * NEXP * 128; const unsigned vo = 16u * (unsigned)cc;
        int t = xi.jr * NWAVES + c.wave;
        if (t >= M) continue;
#define PV_LD(k) (*(const u32x4*)(Vs + (((unsigned)((k) & (idmask & 0xffff)) << 7) + vo)))
#define PV_ROWS(dst, ia, ib) do { dst[0] = PV_LD((ia).x); dst[1] = PV_LD((ia).y); dst[2] = PV_LD((ia).z); dst[3] = PV_LD((ia).w); dst[4] = PV_LD((ib).x); dst[5] = PV_LD((ib).y); dst[6] = PV_LD((ib).z); dst[7] = PV_LD((ib).w); } while (0)
#define PV_IMG(src, half) do { _Pragma("unroll") for (int j = 0; j < 8; ++j) *(LAS u32x4*)(img + (64 * (half) + 8 * e8 + j) * 128 + ((cc ^ j) << 4)) = src[j]; } while (0)
        u32x4 v[8], vn[8];
        { const i32x4* ip = (const i32x4*)(ids + (size_t)t * 128 + 8 * e8); const i32x4 i0 = ip[0], i1 = ip[1], i2 = ip[16], i3 = ip[17]; PV_ROWS(v, i0, i1); PV_ROWS(vn, i2, i3); }
#pragma unroll 1
        for (; t < M; t += tstep) {
            const int tn = min(t + tstep, M - 1);
            const i32x4* ipn = (const i32x4*)(ids + (size_t)tn * 128 + 8 * e8); const i32x4 in0 = ipn[0], in1 = ipn[1], in2 = ipn[16], in3 = ipn[17];
            const u32x4* ap = (const u32x4*)(A8 + (size_t)t * 256 + 32 * q); const u32x4 ah0 = ap[0], ah1 = ap[1], al0 = ap[8], al1 = ap[9];
            const float sa = SA[t];
            const size_t ho = (size_t)t * DM + 128 * sl + 32 * q + ((r & 1) ? 15 + r : r);
            const unsigned hw = *(const unsigned*)(p.hb + ho);
            PV_IMG(v, 0); PV_IMG(vn, 1);
            PV_ROWS(v, in0, in1); PV_ROWS(vn, in2, in3);
            asm volatile("" ::: "memory");
            const i32x8 ahv = {(int)ah0.x, (int)ah0.y, (int)ah0.z, (int)ah0.w, (int)ah1.x, (int)ah1.y, (int)ah1.z, (int)ah1.w};
            const i32x8 alv = {(int)al0.x, (int)al0.y, (int)al0.z, (int)al0.w, (int)al1.x, (int)al1.y, (int)al1.z, (int)al1.w};
            float oa = 0.f, ob = 0.f;
#pragma unroll
            for (int dt = 0; dt < 8; ++dt) {
                i32x8 bw;
#pragma unroll
                for (int i4 = 0; i4 < 4; ++i4) { const int row = 32 * q + 8 * i4 + (r >> 1);
                    const i32x2 tv = lds_tr8(img + row * 128 + ((dt ^ (row & 7)) << 4) + 8 * (r & 1)); bw[2 * i4] = tv.x; bw[2 * i4 + 1] = tv.y; }
                f32x4 ch = {0.f, 0.f, 0.f, 0.f}, cl = {0.f, 0.f, 0.f, 0.f};
                ch = __builtin_amdgcn_mfma_scale_f32_16x16x128_f8f6f4(ahv, bw, ch, 0, 0, 0, 0, 0, 0); cl = __builtin_amdgcn_mfma_scale_f32_16x16x128_f8f6f4(alv, bw, cl, 0, 0, 0, 0, 0, 0);
                const float od = ch[0] + cl[0] * 0.0625f;
                oa = (dt == 2 * q) ? od : oa; ob = (dt == 2 * q + 1) ? od : ob; }
            { const float snd = (r & 1) ? oa : ob, rcv = __shfl_xor(snd, 1);
              const float e0 = (r & 1) ? rcv : oa, e1 = (r & 1) ? ob : rcv;
              *(unsigned*)(hdst + ho) = pk2(bflo(hw) + e0 * sa, bfhi(hw) + e1 * sa); }
            asm volatile("" ::: "memory");
        }
#undef PV_LD
#undef PV_ROWS
#undef PV_IMG
    }
}

__device__ __forceinline__ void ph_peer_u2(const Params& p, int layer, const Ctx& c, const XI xi, int idmask) {
    const unsigned char* X8 = (const unsigned char*)p.out; const unsigned char* UT = p.ws + WS_TAB8 + (size_t)layer * 2 * NEXP * DM;
    const int* ids = (const int*)(p.ws + WS_IDS); bf16_t* PDh = (bf16_t*)(p.ws + WS_PD);
    const int lane = c.lane, e8 = lane >> 3, cc = lane & 7, r = lane & 15, q = lane >> 4;
    const int tstep = xi.nloc * NWAVES;
    LAS unsigned char* img = c.lds + c.wave * 16384; LAS float* stg = (LAS float*)(c.lds + 131072 + c.wave * 512);
#pragma unroll 1
    for (int sl = xi.xr; sl < 8; sl += xi.nx) {
        const unsigned char* Us = UT + (size_t)sl * NEXP * 128; const unsigned uo = 16u * (unsigned)cc;
        int t = xi.jr * NWAVES + c.wave;
        if (t >= M) continue;
#define PU_LD(k) (*(const u32x4*)(Us + (((unsigned)((k) & (idmask & 0xffff)) << 7) + uo)))
#define PU_ROWS(dst, ia, ib) do { dst[0] = PU_LD((ia).x); dst[1] = PU_LD((ia).y); dst[2] = PU_LD((ia).z); dst[3] = PU_LD((ia).w); dst[4] = PU_LD((ib).x); dst[5] = PU_LD((ib).y); dst[6] = PU_LD((ib).z); dst[7] = PU_LD((ib).w); } while (0)
#define PU_IMG(src, half) do { _Pragma("unroll") for (int j = 0; j < 8; ++j) *(LAS u32x4*)(img + (64 * (half) + 8 * e8 + j) * 128 + ((cc ^ j) << 4)) = src[j]; } while (0)
        u32x4 v[8], vn[8];
        { const i32x4* ip = (const i32x4*)(ids + (size_t)t * 128 + 8 * e8); const i32x4 i0 = ip[0], i1 = ip[1], i2 = ip[16], i3 = ip[17]; PU_ROWS(v, i0, i1); PU_ROWS(vn, i2, i3); }
#pragma unroll 1
        for (; t < M; t += tstep) {
            const int tn = min(t + tstep, M - 1);
            const i32x4* ipn = (const i32x4*)(ids + (size_t)tn * 128 + 8 * e8); const i32x4 in0 = ipn[0], in1 = ipn[1], in2 = ipn[16], in3 = ipn[17];
            const u32x4* xp = (const u32x4*)(X8 + (size_t)t * 2048 + 128 * sl + 32 * q); const u32x4 xh0 = xp[0], xh1 = xp[1], xl0 = xp[64], xl1 = xp[65];
            PU_IMG(v, 0); PU_IMG(vn, 1);
            PU_ROWS(v, in0, in1); PU_ROWS(vn, in2, in3);
            asm volatile("" ::: "memory");
            const i32x8 xh = {(int)xh0.x, (int)xh0.y, (int)xh0.z, (int)xh0.w, (int)xh1.x, (int)xh1.y, (int)xh1.z, (int)xh1.w};
            const i32x8 xl = {(int)xl0.x, (int)xl0.y, (int)xl0.z, (int)xl0.w, (int)xl1.x, (int)xl1.y, (int)xl1.z, (int)xl1.w};
#pragma unroll
            for (int g = 0; g < 8; ++g) { const int row = 16 * g + r;
                const u32x4 w0 = *(const LAS u32x4*)(img + row * 128 + (((2 * q) ^ (row & 7)) << 4)), w1 = *(const LAS u32x4*)(img + row * 128 + (((2 * q + 1) ^ (row & 7)) << 4));
                const i32x8 aw = {(int)w0.x, (int)w0.y, (int)w0.z, (int)w0.w, (int)w1.x, (int)w1.y, (int)w1.z, (int)w1.w};
                f32x4 ah = {0.f, 0.f, 0.f, 0.f}, al = {0.f, 0.f, 0.f, 0.f};
                ah = __builtin_amdgcn_mfma_scale_f32_16x16x128_f8f6f4(aw, xh, ah, 0, 0, 0, 0, 0, 0); al = __builtin_amdgcn_mfma_scale_f32_16x16x128_f8f6f4(aw, xl, al, 0, 0, 0, 0, 0, 0);
                if (r == 0) *(LAS f32x4*)(stg + 16 * g + 4 * q) = ah + al * 0.0625f; }
            asm volatile("" ::: "memory");
            { const f32x2 pv = *(const LAS f32x2*)(stg + 2 * lane); *(unsigned*)(PDh + ((size_t)sl * M + t) * 128 + 2 * lane) = pk2(pv.x, pv.y); }
            asm volatile("" ::: "memory");
        }
#undef PU_LD
#undef PU_ROWS
#undef PU_IMG
    }
}

#define XB_TMO      128
#define XB_XCNT(j)  (256  + 64 * (j))
#define XB_XSUB(j)  (1280 + 64 * (j))
#define XB_XGEN(j)  (2304 + 64 * (j))
#define XB_TOP      3328
#define XB_TOPGEN   3392
#define XCD_BAR_WORDS 3456
#define XB_SPIN_CAP (1u << 18)

__device__ __forceinline__ unsigned xb_ld(unsigned* p)              { return __hip_atomic_load(p, __ATOMIC_RELAXED, __HIP_MEMORY_SCOPE_AGENT); }
__device__ __forceinline__ unsigned xb_add(unsigned* p, unsigned v) { return __hip_atomic_fetch_add(p, v, __ATOMIC_RELAXED, __HIP_MEMORY_SCOPE_AGENT); }
__device__ __forceinline__ unsigned xb_xcc_id() { return (unsigned)__builtin_amdgcn_s_getreg((3 << 11) | 20) & 0xFu; }
#define XB_SPIN(cond, bar) do { unsigned _sp = 0; while (cond) { __builtin_amdgcn_s_sleep(1); \
    if ((++_sp & 255u) == 0u) { if (xb_ld(&(bar)[XB_TMO])) break; if (_sp > XB_SPIN_CAP) { atomicAdd(&(bar)[XB_TMO], 1u); break; } } } } while (0)

struct XcdBarrier {
    unsigned* bar; unsigned x;
    volatile LAS unsigned* st;
};

__device__ __forceinline__ XcdBarrier xcd_barrier_post(unsigned* bar, volatile LAS unsigned* st) {
    XcdBarrier b; b.bar = bar; b.x = xb_xcc_id(); b.st = st;
    if (threadIdx.x == 0) (void)xb_add(&bar[XB_XCNT(b.x)], 1u);
    return b;
}
__device__ __forceinline__ void xcd_barrier_complete(unsigned* bar, unsigned x, unsigned& nloc, unsigned& nx) {
    const unsigned G = gridDim.x * gridDim.y * gridDim.z;
    unsigned sum, cnt, mine, sp = 0u;
    for (;;) {
        sum = 0u; cnt = 0u; mine = 0u;
#pragma unroll
        for (unsigned j = 0; j < 16; ++j) { const unsigned c = xb_ld(&bar[XB_XCNT(j)]); sum += c; cnt += (c > 0u) ? 1u : 0u; mine = (j == x) ? c : mine; }
        if (sum == G) break;
        __builtin_amdgcn_s_sleep(1);
        if ((++sp & 255u) == 0u) { if (xb_ld(&bar[XB_TMO])) break; if (sp > XB_SPIN_CAP) { atomicAdd(&bar[XB_TMO], 1u); break; } }
    }
    nloc = mine > 0u ? mine : 1u; nx = cnt > 0u ? cnt : 1u;
}

__device__ __forceinline__ void xcd_barrier(const XcdBarrier& b) {
    asm volatile("s_waitcnt vmcnt(0)" ::: "memory");
    __syncthreads();
    if (threadIdx.x == 0) {
        unsigned* bar = b.bar;
        __builtin_amdgcn_s_waitcnt(0);
        unsigned nloc = b.st[0], nx = b.st[1];
        if (nloc == 0u) { xcd_barrier_complete(bar, b.x, nloc, nx); b.st[0] = nloc; b.st[1] = nx; }
        const unsigned old = xb_add(&bar[XB_XSUB(b.x)], 1u);
        const unsigned gen = old / nloc;
        if (old + 1u == (gen + 1u) * nloc) {
            __builtin_amdgcn_fence(__ATOMIC_RELEASE, "agent");
            asm volatile("s_waitcnt vmcnt(0)" ::: "memory");
            const unsigned og = xb_add(&bar[XB_TOP], 1u);
            const unsigned tg = og / nx;
            if (og + 1u == (tg + 1u) * nx) xb_add(&bar[XB_TOPGEN], 1u);
            else XB_SPIN(xb_ld(&bar[XB_TOPGEN]) == tg, bar);
            __builtin_amdgcn_fence(__ATOMIC_ACQUIRE, "agent");
            xb_add(&bar[XB_XGEN(b.x)], 1u);
            asm volatile("s_waitcnt vmcnt(0)" ::: "memory");
        } else {
            XB_SPIN(xb_ld(&bar[XB_XGEN(b.x)]) == gen, bar);
            __builtin_amdgcn_fence(__ATOMIC_ACQUIRE, "agent");
            asm volatile("s_waitcnt vmcnt(0)" ::: "memory");
        }
    }
    __syncthreads();
}

enum Phase { PH_PRO = 0, PH_GEMM_IN0, PH_MIXER0, PH_GLA_B, PH_GLA_C, PH_MIX0, PH_GEMM_OUT0, PH_NORM_F0, PH_GEMM_Q0, PH_TOPK1_0, PH_PU0, PH_PA0, PH_PV0,
             PH_NORM_M1, PH_GEMM_CIN, PH_G1, PH_G2, PH_G3, PH_GEMM_OUT1, PH_NORM_F1, PH_GEMM_Q1, PH_TOPK1_1, PH_PU1, PH_PA1, PH_PV1, PH_FINAL, NPHASES };

#ifndef PH_ONLY
#define PH_ONLY (-1)
#endif
#define PH_ENABLED(x) (PH_ONLY < 0 || PH_ONLY == (x))
#ifndef MK_N_LAUNCHES
#define MK_N_LAUNCHES 1
#endif

template <class Epi> __device__ __forceinline__ void run_gemm(const Ctx& c, const bf16_t* A, const bf16_t* Bt, int N, const Epi& E, int vblk) {
    pg8::Gemm g{A, Bt, M, N, DM}; pg8::StaticOrder S; S.init(M, N, c.nblk, vblk);
    pg8::gemm_phase<Epi, pg8::StaticOrder, true, true>(c.lds, g, S, E);
}

#define GATHER_CALL(l) ph_gather3(p, l, c, (rep_ + 1 < NREP(PH_GATHER##l)) ? (float*)(ws + WS_S) : p.out)
#ifndef PROBE_IDMASK
#define PROBE_IDMASK 0x3fff
#endif
#ifndef DUP_MASK
#define DUP_MASK 0u
#endif
#define NREP(k) ((((unsigned)(DUP_MASK) >> (k)) & 1u) ? 2 : 1)
#define GETXI() XI xi; { if (multi) { if (threadIdx.x == 0) { unsigned xr_ = 0; for (unsigned j_ = 0; j_ < bar.x; ++j_) xr_ += xb_ld(&ctl[CW_BAR + XB_XCNT(j_)]) > 0u ? 1u : 0u; MISC[11] = xr_; } __syncthreads(); \
    xi.nloc = (int)MISC[8]; xi.nx = (int)MISC[9]; xi.jr = (int)MISC[10]; xi.xr = (int)MISC[11]; if (xi.nloc < 1 || xi.nx < 1 || xi.nx > 8 || xi.jr >= xi.nloc || xi.xr >= xi.nx) { xi.xr = 0; xi.nx = 1; xi.jr = blockIdx.x; xi.nloc = gridDim.x; } } \
    else { xi.xr = 0; xi.nx = 1; xi.jr = blockIdx.x; xi.nloc = gridDim.x; } }
#define MKCTX() Ctx c; { int t_ = threadIdx.x; asm volatile("" : "+v"(t_)); c.lds = lds; c.tid = t_; c.lane = t_ & 63; c.wave = __builtin_amdgcn_readfirstlane(t_ >> 6); \
    c.blk = blockIdx.x; c.nblk = gridDim.x; c.gtid = c.blk * NTHREADS + c.tid; c.gthreads = c.nblk * NTHREADS; c.gwave = c.blk * NWAVES + c.wave; c.gwaves = c.nblk * NWAVES; }
__global__ void __launch_bounds__(NTHREADS, 2) mega_fwd(Params p) {
    extern __shared__ __attribute__((aligned(16))) unsigned char lds_raw[];
    volatile LAS unsigned* MISC = (volatile LAS unsigned*)((LAS unsigned char*)lds_raw + MISC_OFF);
    LAS unsigned char* const lds = (LAS unsigned char*)lds_raw;
    for (int u = threadIdx.x; u < (LDS_BYTES - LDSCTL_OFF) / 4; u += NTHREADS) ((LAS unsigned*)(lds + LDSCTL_OFF))[u] = 0u;
    __syncthreads();
    unsigned* ctl = (unsigned*)(p.ws + WS_CTL);
    XcdBarrier bar; bar.bar = ctl + CW_BAR; bar.x = 0; bar.st = nullptr;
    const bool multi = (p.ph_hi - p.ph_lo) > 1;
    if (multi) { bar = xcd_barrier_post(ctl + CW_BAR, MISC + 8); if (threadIdx.x == 0) MISC[10] = xb_add(&ctl[CW_RANK + 64 * bar.x], 1u); }
    unsigned char* ws = p.ws;
    bf16_t* ACT = (bf16_t*)(ws + WS_ACT); bf16_t* PROJ = (bf16_t*)(ws + WS_PROJ);

    const int lo = p.ph_lo, hi = p.ph_hi;
#define IN(k) (PH_ENABLED(k) && lo <= (k) && (k) < hi)
#define SEAM(k) do { if ((k) + 1 < hi) xcd_barrier(bar); } while (0)
    if (IN(PH_PRO)) { for (int rep_ = 0; rep_ < NREP(PH_PRO); ++rep_) { MKCTX();
        transpose_cvt(p.ab_w_in, DM, NIN, (bf16_t*)(ws + WS_WT_IN), NIN_PAD, [](int n) { return n < 1536 ? n : (n < 3072 ? n + 16 : (n < 3088 ? n - 3072 + 1536 : -1)); }, c.gtid, c.gthreads);
        transpose_cvt(p.ab_w_out, DM, DM, (bf16_t*)(ws + WS_WT_OUT), DM, [](int n) { return n; }, c.gtid, c.gthreads);
        transpose_cvt(p.c_w_in, DM, 2048, (bf16_t*)(ws + WS_WT_CIN), 2048, [](int n) { return n; }, c.gtid, c.gthreads);
        transpose_cvt(p.c_w_out, DM, DM, (bf16_t*)(ws + WS_WT_COUT), DM, [](int n) { return n; }, c.gtid, c.gthreads);
        transpose_cvt(p.peer_w_query, DM, 2048, (bf16_t*)(ws + WS_WT_Q0), 2048, [](int n) { return n; }, c.gtid, c.gthreads);
        transpose_cvt(p.peer_w_query + (size_t)DM * 2048, DM, 2048, (bf16_t*)(ws + WS_WT_Q1), 2048, [](int n) { return n; }, c.gtid, c.gthreads);
        cvt_fp8_rows(p.peer_u, ws + WS_TAB8, (float*)(ws + WS_SCL), NEXP, c);
        cvt_fp8_rows(p.peer_v, ws + WS_TAB8 + (size_t)NEXP * DM, (float*)(ws + WS_SCL) + NEXP, NEXP, c);
        cvt_gate_weights(p, c);
        cvt_bf16(p.peer_sub_keys, (bf16_t*)(ws + WS_SK), (size_t)2 * 8 * 2 * 128 * 128 / 8, c.gtid, c.gthreads);
        norm_rows_bf16(p.x, p.mix_norm, ACT, c);
        if (rep_ + 1 < NREP(PH_PRO)) xcd_barrier(bar); } SEAM(PH_PRO); }
    if (IN(PH_GEMM_IN0)) { for (int rep_ = 0; rep_ < NREP(PH_GEMM_IN0); ++rep_) { MKCTX();  ph_glr(p, c); pg8::EpiBf16<0> E{PROJ, NIN_PAD, nullptr, 0, 0, 1.f}; GETXI(); run_gemm(c, ACT, (const bf16_t*)(ws + WS_WT_IN), 3072, E, (xi.nx == 8 && xi.nloc * 8 == (int)gridDim.x) ? xi.jr * 8 + xi.xr : (int)blockIdx.x); if (rep_ + 1 < NREP(PH_GEMM_IN0)) xcd_barrier(bar); } SEAM(PH_GEMM_IN0); }
    if (IN(PH_MIXER0)) { for (int rep_ = 0; rep_ < NREP(PH_MIXER0); ++rep_) { MKCTX();  ph_gla_a(p, c); ph_attn(p, c); if (rep_ + 1 < NREP(PH_MIXER0)) xcd_barrier(bar); } SEAM(PH_MIXER0); }
    if (IN(PH_GLA_B)) { for (int rep_ = 0; rep_ < NREP(PH_GLA_B); ++rep_) { MKCTX();  ph_gla_b(p, c); if (rep_ + 1 < NREP(PH_GLA_B)) xcd_barrier(bar); } SEAM(PH_GLA_B); }
    if (IN(PH_GLA_C)) { for (int rep_ = 0; rep_ < NREP(PH_GLA_C); ++rep_) { MKCTX();  ph_gla_c(p, c); if (rep_ + 1 < NREP(PH_GLA_C)) xcd_barrier(bar); } SEAM(PH_GLA_C); }
    if (IN(PH_MIX0)) { for (int rep_ = 0; rep_ < NREP(PH_MIX0); ++rep_) { MKCTX();  ph_mix(p, c); if (rep_ + 1 < NREP(PH_MIX0)) xcd_barrier(bar); } SEAM(PH_MIX0); }
    if (IN(PH_GEMM_OUT0)) { for (int rep_ = 0; rep_ < NREP(PH_GEMM_OUT0); ++rep_) { MKCTX();  pg8::EpiResBf<true> E{p.x, p.hb, DM}; GETXI(); run_gemm(c, ACT, (const bf16_t*)(ws + WS_WT_OUT), DM, E, (xi.nx == 8 && xi.nloc * 8 == (int)gridDim.x) ? xi.jr * 8 + xi.xr : (int)blockIdx.x); if (rep_ + 1 < NREP(PH_GEMM_OUT0)) xcd_barrier(bar); } SEAM(PH_GEMM_OUT0); }
    if (IN(PH_NORM_F0)) { for (int rep_ = 0; rep_ < NREP(PH_NORM_F0); ++rep_) { MKCTX();  norm_rows_bf16(p.hb, p.ffn_norm, ACT, c, (unsigned char*)p.out); if (rep_ + 1 < NREP(PH_NORM_F0)) xcd_barrier(bar); } SEAM(PH_NORM_F0); }
    if (IN(PH_GEMM_Q0)) { for (int rep_ = 0; rep_ < NREP(PH_GEMM_Q0); ++rep_) { MKCTX();  pg8::EpiBf16<0> E{PROJ, 2048, nullptr, 0, 0, 1.f}; GETXI(); run_gemm(c, ACT, (const bf16_t*)(ws + WS_WT_Q0), 2048, E, (xi.nx == 8 && xi.nloc * 8 == (int)gridDim.x) ? xi.jr * 8 + xi.xr : (int)blockIdx.x); if (rep_ + 1 < NREP(PH_GEMM_Q0)) xcd_barrier(bar); } SEAM(PH_GEMM_Q0); }
    if (IN(PH_TOPK1_0)) { for (int rep_ = 0; rep_ < NREP(PH_TOPK1_0); ++rep_) { MKCTX();  ph_topk(p, 0, c); if (rep_ + 1 < NREP(PH_TOPK1_0)) xcd_barrier(bar); } SEAM(PH_TOPK1_0); }
    if (IN(PH_PU0)) { for (int rep_ = 0; rep_ < NREP(PH_PU0); ++rep_) { MKCTX();  GETXI(); ph_peer_u2(p, 0, c, xi, (rep_ + 1 < NREP(PH_PU0)) ? PROBE_IDMASK : 0x3fff); if (rep_ + 1 < NREP(PH_PU0)) xcd_barrier(bar); } SEAM(PH_PU0); }
    if (IN(PH_PA0)) { for (int rep_ = 0; rep_ < NREP(PH_PA0); ++rep_) { MKCTX();  ph_peer_act2(p, 0, c); if (rep_ + 1 < NREP(PH_PA0)) xcd_barrier(bar); } SEAM(PH_PA0); }
    if (IN(PH_PV0)) { for (int rep_ = 0; rep_ < NREP(PH_PV0); ++rep_) { MKCTX();  GETXI(); ph_peer_v2(p, 0, c, xi, (rep_ + 1 < NREP(PH_PV0)) ? (bf16_t*)(ws + WS_S) : p.hb, (rep_ + 1 < NREP(PH_PV0)) ? PROBE_IDMASK : 0x3fff); if (rep_ + 1 < NREP(PH_PV0)) xcd_barrier(bar); } SEAM(PH_PV0); }
    if (IN(PH_NORM_M1)) { for (int rep_ = 0; rep_ < NREP(PH_NORM_M1); ++rep_) { MKCTX();  norm_rows_bf16(p.hb, p.mix_norm + DM, ACT, c); if (rep_ + 1 < NREP(PH_NORM_M1)) xcd_barrier(bar); } SEAM(PH_NORM_M1); }
    if (IN(PH_GEMM_CIN)) { for (int rep_ = 0; rep_ < NREP(PH_GEMM_CIN); ++rep_) { MKCTX();  pg8::EpiBf16<0> E{PROJ, 2048, nullptr, 0, 0, 1.f}; GETXI(); run_gemm(c, ACT, (const bf16_t*)(ws + WS_WT_CIN), 2048, E, (xi.nx == 8 && xi.nloc * 8 == (int)gridDim.x) ? xi.jr * 8 + xi.xr : (int)blockIdx.x); if (rep_ + 1 < NREP(PH_GEMM_CIN)) xcd_barrier(bar); } SEAM(PH_GEMM_CIN); }
    if (IN(PH_G1)) { for (int rep_ = 0; rep_ < NREP(PH_G1); ++rep_) { MKCTX();  griffin_pass(p, c); if (rep_ + 1 < NREP(PH_G1)) xcd_barrier(bar); } SEAM(PH_G1); }
    if (IN(PH_G2)) { for (int rep_ = 0; rep_ < NREP(PH_G2); ++rep_) { MKCTX();  ph_carry(p, c); if (rep_ + 1 < NREP(PH_G2)) xcd_barrier(bar); } SEAM(PH_G2); }
    if (IN(PH_G3)) { for (int rep_ = 0; rep_ < NREP(PH_G3); ++rep_) { MKCTX();  ph_gr_fix(p, c); if (rep_ + 1 < NREP(PH_G3)) xcd_barrier(bar); } SEAM(PH_G3); }
    if (IN(PH_GEMM_OUT1)) { for (int rep_ = 0; rep_ < NREP(PH_GEMM_OUT1); ++rep_) { MKCTX();  pg8::EpiResBf<false> E{p.hb, p.hb, DM}; GETXI(); run_gemm(c, ACT, (const bf16_t*)(ws + WS_WT_COUT), DM, E, (xi.nx == 8 && xi.nloc * 8 == (int)gridDim.x) ? xi.jr * 8 + xi.xr : (int)blockIdx.x); if (rep_ + 1 < NREP(PH_GEMM_OUT1)) xcd_barrier(bar); } SEAM(PH_GEMM_OUT1); }
    if (IN(PH_NORM_F1)) { for (int rep_ = 0; rep_ < NREP(PH_NORM_F1); ++rep_) { MKCTX();
        norm_rows_bf16(p.hb, p.ffn_norm + DM, ACT, c, (unsigned char*)p.out);
        cvt_fp8_rows(p.peer_u + (size_t)NEXP * DM, ws + WS_TAB8 + (size_t)2 * NEXP * DM, (float*)(ws + WS_SCL) + 2 * NEXP, NEXP, c);
        cvt_fp8_rows(p.peer_v + (size_t)NEXP * DM, ws + WS_TAB8 + (size_t)3 * NEXP * DM, (float*)(ws + WS_SCL) + 3 * NEXP, NEXP, c);
        if (rep_ + 1 < NREP(PH_NORM_F1)) xcd_barrier(bar); } SEAM(PH_NORM_F1); }
    if (IN(PH_GEMM_Q1)) { for (int rep_ = 0; rep_ < NREP(PH_GEMM_Q1); ++rep_) { MKCTX();  pg8::EpiBf16<0> E{PROJ, 2048, nullptr, 0, 0, 1.f}; GETXI(); run_gemm(c, ACT, (const bf16_t*)(ws + WS_WT_Q1), 2048, E, (xi.nx == 8 && xi.nloc * 8 == (int)gridDim.x) ? xi.jr * 8 + xi.xr : (int)blockIdx.x); if (rep_ + 1 < NREP(PH_GEMM_Q1)) xcd_barrier(bar); } SEAM(PH_GEMM_Q1); }
    if (IN(PH_TOPK1_1)) { for (int rep_ = 0; rep_ < NREP(PH_TOPK1_1); ++rep_) { MKCTX();  ph_topk(p, 1, c); if (rep_ + 1 < NREP(PH_TOPK1_1)) xcd_barrier(bar); } SEAM(PH_TOPK1_1); }
    if (IN(PH_PU1)) { for (int rep_ = 0; rep_ < NREP(PH_PU1); ++rep_) { MKCTX();  GETXI(); ph_peer_u2(p, 1, c, xi, (rep_ + 1 < NREP(PH_PU1)) ? PROBE_IDMASK : 0x3fff); if (rep_ + 1 < NREP(PH_PU1)) xcd_barrier(bar); } SEAM(PH_PU1); }
    if (IN(PH_PA1)) { for (int rep_ = 0; rep_ < NREP(PH_PA1); ++rep_) { MKCTX();  ph_peer_act2(p, 1, c); if (rep_ + 1 < NREP(PH_PA1)) xcd_barrier(bar); } SEAM(PH_PA1); }
    if (IN(PH_PV1)) { for (int rep_ = 0; rep_ < NREP(PH_PV1); ++rep_) { MKCTX();  GETXI(); ph_peer_v2(p, 1, c, xi, (rep_ + 1 < NREP(PH_PV1)) ? (bf16_t*)(ws + WS_S) : p.hb, (rep_ + 1 < NREP(PH_PV1)) ? PROBE_IDMASK : 0x3fff); if (rep_ + 1 < NREP(PH_PV1)) xcd_barrier(bar); } SEAM(PH_PV1); }
    if (IN(PH_FINAL)) { MKCTX(); norm_rows_f32(p.hb, p.out, p.final_norm, c); }
#undef IN
#undef SEAM
}

extern "C" void kernel_launch(void* const* d_in, const int* in_sizes, int n_in, void* d_out, int out_size, void* d_ws, size_t ws_size, hipStream_t stream) {
    static int grid = 0;
    if (grid == 0) {
        if (n_in != 22 || out_size != M * DM || ws_size < WS_END) { fprintf(stderr, "kernel_launch: unexpected shapes: n_in %d out %d ws %zu (need %zu)\n", n_in, out_size, ws_size, (size_t)WS_END); grid = -1; return; }
        int dev = 0, cus = 0, per_cu = 0;
        if (hipGetDevice(&dev) != hipSuccess || hipDeviceGetAttribute(&cus, hipDeviceAttributeMultiprocessorCount, dev) != hipSuccess) { grid = -1; return; }
        if (hipFuncSetAttribute((const void*)mega_fwd, hipFuncAttributeMaxDynamicSharedMemorySize, LDS_BYTES) != hipSuccess) { fprintf(stderr, "kernel_launch: hipFuncSetAttribute failed\n"); grid = -1; return; }
        if (hipOccupancyMaxActiveBlocksPerMultiprocessor(&per_cu, (const void*)mega_fwd, NTHREADS, LDS_BYTES) != hipSuccess || per_cu < 1) { fprintf(stderr, "kernel_launch: occupancy query says %d blocks per CU\n", per_cu); per_cu = 1; }
        (void)hipGetLastError();
        grid = cus;
        if (grid % 8 != 0 || grid < 32) { fprintf(stderr, "kernel_launch: unexpected CU count %d\n", cus); }
    }
    if (grid < 0) return;
    (void)hipMemsetAsync((char*)d_ws + WS_CTL, 0, CTL_ZERO_BYTES, stream);
    Params p{};
    const float** pp = (const float**)&p;
    for (int i = 0; i < 22; ++i) pp[i] = (const float*)d_in[i];
    p.out = (float*)d_out; p.ws = (unsigned char*)d_ws; p.hb = (bf16_t*)((unsigned char*)d_ws + WS_HB);
#if MK_N_LAUNCHES == 1
    p.ph_lo = 0; p.ph_hi = NPHASES;
    void* args[] = {&p};
    hipError_t e = hipLaunchCooperativeKernel((const void*)mega_fwd, dim3(grid), dim3(NTHREADS), args, LDS_BYTES, stream);
    if (e != hipSuccess) fprintf(stderr, "cooperative launch failed: %s (grid %d)\n", hipGetErrorString(e), grid);
#else
    for (int ph = 0; ph < NPHASES; ++ph) { p.ph_lo = ph; p.ph_hi = ph + 1; hipLaunchKernelGGL(mega_fwd, dim3(grid), dim3(NTHREADS), LDS_BYTES, stream, p); }
#endif
}
```
